# Optimizing an MI355X kernel written in HIP

```python
import jax, jax.numpy as jnp
from jax import lax
import numpy as np

D_MODEL = 1024
BATCH = 4
SEQ = 8192
DEPTH = 1

MIX_WIDTH = D_MODEL
HEAD_DIM = 64
ATTN_WIDTH = MIX_WIDTH // 2
GMLP_WIDTH = MIX_WIDTH - ATTN_WIDTH
N_ATTN_HEADS = ATTN_WIDTH // HEAD_DIM
N_GMLP_HEADS = GMLP_WIDTH // HEAD_DIM
GMLP_HEAD_DIM = GMLP_WIDTH // N_GMLP_HEADS
IN_PROJ_WIDTH = 3 * ATTN_WIDTH + 2 * GMLP_WIDTH
MOBA_BLOCK = 256
MOBA_TOPK = 3
Q_CHUNK = 32
GMLP_CHUNK = 128
D_FF = 2816
ROPE_THETA = 10000.0
NORM_EPS = 1e-6
N_MOD = 9
NEG_INF = -1e30

kernel_name = "hymba_moba_gmlp_macaron_adaln"


def rmsnorm(x, g):
    xf = x.astype(jnp.float32)
    y = xf * lax.rsqrt(jnp.mean(xf * xf, axis=-1, keepdims=True) + NORM_EPS)
    return (y * g.astype(jnp.float32)).astype(x.dtype)


def layernorm(x, g, b):
    xf = x.astype(jnp.float32)
    mu = jnp.mean(xf, axis=-1, keepdims=True)
    var = jnp.mean(jnp.square(xf - mu), axis=-1, keepdims=True)
    y = (xf - mu) * lax.rsqrt(var + NORM_EPS)
    return (y * g.astype(jnp.float32) + b.astype(jnp.float32)).astype(x.dtype)


def modulate(x, shift, scale):
    return x * (1 + scale[:, None, :]) + shift[:, None, :]


def swiglu(x, w_gu, w_down):
    g, u = jnp.split(x @ w_gu, 2, axis=-1)
    return (jax.nn.silu(g) * u) @ w_down


def rope(x, pos):
    half = x.shape[-1] // 2
    inv_freq = ROPE_THETA ** (-jnp.arange(half, dtype=jnp.float32) / half)
    ang = pos[:, None] * inv_freq[None, :]
    cos = jnp.cos(ang)[None, :, None, :]
    sin = jnp.sin(ang)[None, :, None, :]
    xf = x.astype(jnp.float32)
    x1, x2 = xf[..., :half], xf[..., half:]
    return jnp.concatenate([x1 * cos - x2 * sin, x2 * cos + x1 * sin], axis=-1).astype(x.dtype)


def moba_attention(q, k, v):
    B, S, H, dh = q.shape
    n_blk = -(-S // MOBA_BLOCK)
    s_pad = n_blk * MOBA_BLOCK
    k_sel = min(MOBA_TOPK, n_blk)
    pad = ((0, 0), (0, s_pad - S), (0, 0), (0, 0))
    q, k, v = (jnp.pad(t, pad).transpose(0, 2, 1, 3) for t in (q, k, v))
    kb = k.reshape(B, H, n_blk, MOBA_BLOCK, dh)
    vb = v.reshape(B, H, n_blk, MOBA_BLOCK, dh)
    k_mean = jnp.mean(kb.astype(jnp.float32), axis=3)
    n_chunks = s_pad // Q_CHUNK
    q_chunks = q.reshape(B, H, n_chunks, Q_CHUNK, dh).transpose(2, 0, 1, 3, 4)
    scale = dh ** -0.5
    b_idx = jnp.arange(B)[:, None, None, None]
    h_idx = jnp.arange(H)[None, :, None, None]
    blk_ids = jnp.arange(n_blk)

    def one_chunk(args):
        qc, ci = args
        q_pos = ci * Q_CHUNK + jnp.arange(Q_CHUNK)
        own = q_pos[0] // MOBA_BLOCK
        gate = jnp.einsum('bhqd,bhnd->bhqn', qc.astype(jnp.float32), k_mean)
        gate = jnp.where(blk_ids < own, gate, NEG_INF)
        _, top_idx = lax.top_k(gate, k_sel)
        sel_valid = jnp.arange(k_sel) < own
        own_idx = jnp.broadcast_to(own, top_idx.shape[:-1] + (1,)).astype(top_idx.dtype)
        idx = jnp.concatenate([top_idx, own_idx], axis=-1)
        kg = kb[b_idx, h_idx, idx]
        vg = vb[b_idx, h_idx, idx]
        s = jnp.einsum('bhqd,bhqnkd->bhqnk', qc, kg).astype(jnp.float32) * scale
        key_pos = own * MOBA_BLOCK + jnp.arange(MOBA_BLOCK)
        own_mask = key_pos[None, :] <= q_pos[:, None]
        sel_mask = jnp.broadcast_to(sel_valid[None, :, None], (Q_CHUNK, k_sel, MOBA_BLOCK))
        mask = jnp.concatenate([sel_mask, own_mask[:, None, :]], axis=1)
        s = jnp.where(mask, s, NEG_INF)
        p = jax.nn.softmax(s.reshape(B, H, Q_CHUNK, -1), axis=-1).reshape(s.shape)
        return jnp.einsum('bhqnk,bhqnkd->bhqd', p.astype(vg.dtype), vg)

    out = lax.map(one_chunk, (q_chunks, jnp.arange(n_chunks)))
    out = out.transpose(1, 0, 3, 2, 4).reshape(B, s_pad, H, dh)[:, :S]
    return out.reshape(B, S, H * dh)


def gmlp_spatial_gating(u, v, ln_g, ln_b, w_s, b_s):
    B, S, _ = u.shape
    v = layernorm(v, ln_g, ln_b)
    n_c = S // GMLP_CHUNK
    causal = jnp.tril(jnp.ones((GMLP_CHUNK, GMLP_CHUNK), dtype=bool))
    w = jnp.where(causal[None], w_s, 0)
    vc = v.reshape(B, n_c, GMLP_CHUNK, N_GMLP_HEADS, GMLP_HEAD_DIM)
    mixed = jnp.einsum('hts,bnshd->bnthd', w, vc) + b_s.T[None, None, :, :, None]
    return u * mixed.reshape(B, S, GMLP_WIDTH)


def setup_inputs(seed: int = 0) -> dict:
    key = jax.random.key(seed)
    ks = jax.random.split(key, 20)
    f32 = jnp.float32
    nrm = lambda k, shape, s: jax.random.normal(k, shape, f32) * s
    L, D = DEPTH, D_MODEL
    return {
        "x": nrm(ks[0], (BATCH, SEQ, D), 1.0),
        "c": nrm(ks[1], (BATCH, D), 1.0),
        "w_ada": nrm(ks[2], (L, D, N_MOD * D), 0.5 * D ** -0.5),
        "b_ada": nrm(ks[3], (L, N_MOD * D), 0.01),
        "norm_ffn1": 1.0 + nrm(ks[4], (L, D), 0.01),
        "w_ffn1_gu": nrm(ks[5], (L, D, 2 * D_FF), D ** -0.5),
        "w_ffn1_down": nrm(ks[6], (L, D_FF, D), D_FF ** -0.5),
        "norm_mix": 1.0 + nrm(ks[7], (L, D), 0.01),
        "w_in": nrm(ks[8], (L, D, IN_PROJ_WIDTH), D ** -0.5),
        "gmlp_ln_g": 1.0 + nrm(ks[9], (L, GMLP_WIDTH), 0.01),
        "gmlp_ln_b": nrm(ks[10], (L, GMLP_WIDTH), 0.01),
        "gmlp_w_s": nrm(ks[11], (L, N_GMLP_HEADS, GMLP_CHUNK, GMLP_CHUNK), GMLP_CHUNK ** -0.5),
        "gmlp_b_s": 1.0 + nrm(ks[12], (L, N_GMLP_HEADS, GMLP_CHUNK), 0.01),
        "g_attn_out": 1.0 + nrm(ks[13], (L, ATTN_WIDTH), 0.01),
        "g_gmlp_out": 1.0 + nrm(ks[14], (L, GMLP_WIDTH), 0.01),
        "w_out": nrm(ks[15], (L, MIX_WIDTH, D), MIX_WIDTH ** -0.5),
        "norm_ffn2": 1.0 + nrm(ks[16], (L, D), 0.01),
        "w_ffn2_gu": nrm(ks[17], (L, D, 2 * D_FF), D ** -0.5),
        "w_ffn2_down": nrm(ks[18], (L, D_FF, D), D_FF ** -0.5),
        "norm_final": 1.0 + nrm(ks[19], (D,), 0.01),
    }


def reference(x, c, w_ada, b_ada, norm_ffn1, w_ffn1_gu, w_ffn1_down, norm_mix, w_in,
              gmlp_ln_g, gmlp_ln_b, gmlp_w_s, gmlp_b_s, g_attn_out, g_gmlp_out, w_out,
              norm_ffn2, w_ffn2_gu, w_ffn2_down, norm_final):
    B, S, D = x.shape
    pos = jnp.arange(S, dtype=jnp.float32)
    c_act = jax.nn.silu(c)
    h = x
    for l in range(DEPTH):
        mod = c_act @ w_ada[l] + b_ada[l]
        (sh1, sc1, gt1, sh2, sc2, gt2, sh3, sc3, gt3) = jnp.split(mod, N_MOD, axis=-1)

        y = modulate(rmsnorm(h, norm_ffn1[l]), sh1, sc1)
        h = h + 0.5 * gt1[:, None, :] * swiglu(y, w_ffn1_gu[l], w_ffn1_down[l])

        y = modulate(rmsnorm(h, norm_mix[l]), sh2, sc2)
        proj = y @ w_in[l]
        q, k, v, gu, gv = jnp.split(
            proj, np.cumsum([ATTN_WIDTH, ATTN_WIDTH, ATTN_WIDTH, GMLP_WIDTH]).tolist(), axis=-1)
        q = rope(q.reshape(B, S, N_ATTN_HEADS, HEAD_DIM), pos)
        k = rope(k.reshape(B, S, N_ATTN_HEADS, HEAD_DIM), pos)
        v = v.reshape(B, S, N_ATTN_HEADS, HEAD_DIM)
        attn_out = moba_attention(q, k, v)
        gmlp_out = gmlp_spatial_gating(jax.nn.gelu(gu), jax.nn.gelu(gv), gmlp_ln_g[l],
                                       gmlp_ln_b[l], gmlp_w_s[l], gmlp_b_s[l])
        merged = jnp.concatenate([rmsnorm(attn_out, g_attn_out[l]),
                                  rmsnorm(gmlp_out, g_gmlp_out[l])], axis=-1)
        h = h + gt2[:, None, :] * (merged @ w_out[l])

        y = modulate(rmsnorm(h, norm_ffn2[l]), sh3, sc3)
        h = h + 0.5 * gt3[:, None, :] * swiglu(y, w_ffn2_gu[l], w_ffn2_down[l])
    return rmsnorm(h, norm_final)
```

```cpp
#include <hip/hip_runtime.h>
#include <cstdio>
#include <cstdint>

#ifndef MK_PER_PHASE
#define MK_PER_PHASE 0
#endif

#define GAS __attribute__((address_space(1)))
#define LAS __attribute__((address_space(3)))
typedef _Float16 h16;
typedef _Float16 h16x8 __attribute__((ext_vector_type(8)));
typedef _Float16 h16x4 __attribute__((ext_vector_type(4)));
typedef _Float16 h16x2 __attribute__((ext_vector_type(2)));
typedef float f32x4 __attribute__((ext_vector_type(4)));
typedef float f32x2 __attribute__((ext_vector_type(2)));
typedef unsigned u32x4 __attribute__((ext_vector_type(4)));
typedef unsigned u32x2 __attribute__((ext_vector_type(2)));

constexpr int D = 1024, NB = 4, S = 8192, M = NB * S, DFF = 2816, NGU = 2 * DFF, NMOD = 9;
constexpr int AW = 512, HD = 64, NH = 8, INW = 2560, MBLK = 256, NBLK = S / MBLK, GC = 128;
constexpr float EPS = 1e-6f;
constexpr float C2 = 0.125f * 1.4426950408889634f;
constexpr int PQ = 0, PU = 512, PK = 1024, PV = 1536, PG = 2048;

constexpr size_t MiB = 1u << 20, KiB = 1u << 10;
constexpr size_t WS_CTL = 0, CTL_ZERO_BYTES = 1 * MiB;
constexpr size_t WS_MODP = 1 * MiB;
constexpr size_t WS_GT = 2 * MiB, WS_GP = WS_GT + 64 * KiB;
constexpr size_t WS_BIAS1 = WS_GT + 128 * KiB, WS_BIAS2 = WS_GT + 256 * KiB, WS_BIAS3 = WS_GT + 320 * KiB;
constexpr size_t WS_R1 = 3 * MiB, WS_RG = WS_R1 + 128 * KiB;
constexpr size_t WS_SSQA = 4 * MiB;
constexpr size_t WS_SSQ2 = 5 * MiB, WS_SSQ3 = 7 * MiB, WS_SSQF = 9 * MiB;
constexpr size_t WS_KMP = 11 * MiB;
constexpr size_t WS_ROPE = 12 * MiB;
constexpr size_t WS_WS16 = 14 * MiB;
constexpr size_t WS_WGU1 = 16 * MiB, WS_WD1 = 27 * MiB, WS_WIN = 33 * MiB, WS_WOUT = 38 * MiB, WS_WGU2 = 40 * MiB, WS_WD2 = 51 * MiB;
constexpr size_t WS_HG = 64 * MiB, WS_H = 128 * MiB, WS_ACT = 192 * MiB, WS_PROJ = WS_ACT;
constexpr size_t WS_LISTS = 368 * MiB, WS_END = 384 * MiB;
static_assert(WS_WD2 + (size_t)D * DFF * 2 <= WS_HG && WS_ACT + (size_t)M * DFF * 2 <= WS_LISTS, "ws map");
constexpr int CW_TMO = 0, CW_BAR = 4096;

constexpr int RING_BYTES = 131072, LDSCTL_OFF = RING_BYTES, MISC_OFF = LDSCTL_OFF + 320, LDS_BYTES = 147456;
constexpr int NWAVES = 8;

#define LDS_WAIT() asm volatile("s_waitcnt lgkmcnt(0)" ::: "memory")
#define VM_WAIT() asm volatile("s_waitcnt vmcnt(0)" ::: "memory")

__device__ __forceinline__ float wave_sum(float v) {
#pragma unroll
    for (int o = 1; o < 64; o <<= 1) v += __shfl_xor(v, o);
    return v;
}
__device__ __forceinline__ unsigned pkh(float lo, float hi) { h16x2 v; v.x = (h16)lo; v.y = (h16)hi; return __builtin_bit_cast(unsigned, v); }
__device__ __forceinline__ float silu_fast(float x) { return x * __builtin_amdgcn_rcpf(1.f + __builtin_amdgcn_exp2f(-1.4426950408889634f * x)); }
__device__ __forceinline__ float gelu_fast(float x) {
    const float u2 = 1.5957691216057308f * (x + 0.044715f * x * x * x);
    return x * __builtin_amdgcn_rcpf(1.f + __builtin_amdgcn_exp2f(-1.4426950408889634f * u2));
}
__device__ __forceinline__ float rs16(const float* p) {
    const f32x4 s0 = *(const f32x4*)(p), s1 = *(const f32x4*)(p + 4), s2 = *(const f32x4*)(p + 8), s3 = *(const f32x4*)(p + 12);
    const f32x4 st = (s0 + s1) + (s2 + s3);
    return rsqrtf(((st[0] + st[1]) + (st[2] + st[3])) * (1.f / D) + EPS);
}

namespace pg8 {
constexpr int BM = 256, BK = 64, HALF = 128, HTB = HALF * BK * 2, STAGE_BYTES = 8 * HTB, NXCD = 8, WGM = 8;
__host__ __device__ __forceinline__ int lds_byte(int r, int c) { const int st = (r >> 4) * 2 + (c >> 5), rr = r & 15, cc = c & 31, ob = rr * 64 + cc * 2; return st * 1024 + (ob ^ (((ob >> 9) & 1) << 5)); }
__host__ __device__ __forceinline__ void stage_rc(int b, int& R, int& C) { const int st = b / 1024, sb = b % 1024, swz = sb ^ (((sb >> 9) & 1) << 5); R = (st >> 1) * 16 + swz / 64; C = (st & 1) * 32 + (swz % 64) / 2; }
struct Unit { int pm, pn; };
struct Gemm { const h16* A; const h16* Bt; int lda, N, K; };
struct StaticOrder {
    int nM, nN, nwg, G, c;
    __device__ void init(int M_, int N, int G_, int c_) { nM = M_ / BM; nN = N / BM; nwg = nM * nN; G = G_; c = c_; }
    __device__ bool next(int i, Unit& u) const {
        const long L = (long)i * G + c; if (L >= nwg) return false;
        int wgid = (int)L; { const int q = nwg / NXCD, r = nwg % NXCD, xcd = wgid % NXCD, off = wgid / NXCD; wgid = (xcd < r ? xcd * (q + 1) : r * (q + 1) + (xcd - r) * q) + off; }
        const int nig = WGM * nN, gid = wgid / nig, fm = gid * WGM, gsz = (nM - fm) < WGM ? (nM - fm) : WGM;
        u.pm = fm + ((wgid % nig) % gsz); u.pn = (wgid % nig) / gsz; return true;
    }
};
template <class Epi, bool ALIGN_EPI>
__device__ __forceinline__ void gemm_phase(LAS unsigned char* lds, const Gemm g, const StaticOrder& S, const Epi& E) {
    const int tid = threadIdx.x, wid = __builtin_amdgcn_readfirstlane(tid >> 6), lane = tid & 63, wr = wid >> 2, wc = wid & 3, fr = lane & 15, fq = lane >> 4;
    const int K = g.K, nt = K / BK;
    unsigned voffA[2], voffB[2];
#pragma unroll
    for (int i = 0; i < 2; ++i) { int R, C; stage_rc(tid * 16 + i * 8192, R, C); voffA[i] = (unsigned)(R * g.lda + C) * 2u; voffB[i] = (unsigned)(R * K + C) * 2u; }
    const size_t kstep = (size_t)(BK * 2);
    const size_t hstepA = (size_t)HALF * g.lda * 2, hstepB = (size_t)HALF * K * 2;
    const size_t tstepA = 2 * hstepA, tstepB = 2 * hstepB;
    const unsigned ldsw = (unsigned)wid * 1024u;
    const int aoff = lds_byte(wr * 64 + fr, fq * 8), boff = lds_byte(wc * 32 + fr, fq * 8);
#define PG8_SA(b, h) (((b) * 2 + (h)) * HTB)
#define PG8_SB(b, h) ((4 + (b) * 2 + (h)) * HTB)
#define PG8_STAGE(bufoff, gbase, voff) do { _Pragma("unroll") for (int _i = 0; _i < 2; ++_i) \
        __builtin_amdgcn_global_load_lds((const unsigned*)((const char*)(gbase) + (voff)[_i]), (LAS unsigned*)(lds + (bufoff) + ldsw + _i * 8192), 16, 0, 0); } while (0)
#define PG8_LDA(dst, b, h) do { _Pragma("unroll") for (int m = 0; m < 4; ++m) _Pragma("unroll") for (int k = 0; k < 2; ++k) dst[m][k] = *(const LAS h16x8*)(lds + PG8_SA(b, h) + aoff + m * 2048 + k * 1024); } while (0)
#define PG8_LDB(dst, b, h) do { _Pragma("unroll") for (int n = 0; n < 2; ++n) _Pragma("unroll") for (int k = 0; k < 2; ++k) dst[n][k] = *(const LAS h16x8*)(lds + PG8_SB(b, h) + boff + n * 2048 + k * 1024); } while (0)
#define PG8_MMA(ai, bj, At, Bt) do { __builtin_amdgcn_s_setprio(1); _Pragma("unroll") for (int m = 0; m < 4; ++m) _Pragma("unroll") for (int n = 0; n < 2; ++n) _Pragma("unroll") for (int k = 0; k < 2; ++k) \
        acc[ai][bj][m][n] = __builtin_amdgcn_mfma_f32_16x16x32_f16(Bt[n][k], At[m][k], acc[ai][bj][m][n], 0, 0, 0); __builtin_amdgcn_s_setprio(0); } while (0)
#define PG8_WAIT_V(n) asm volatile("s_waitcnt vmcnt(" #n ")" ::: "memory")
#define PG8_WAIT_L(n) asm volatile("s_waitcnt lgkmcnt(" #n ")" ::: "memory")
#define PG8_BAR __builtin_amdgcn_s_barrier()
#define PG8_SCHED __builtin_amdgcn_sched_barrier(0)
    Unit cur, nxt; int ui = 0;
    if (!S.next(0, cur)) return;
    f32x4 acc[2][2][4][2];
#pragma unroll
    for (int a = 0; a < 2; ++a)
#pragma unroll
        for (int b = 0; b < 2; ++b)
#pragma unroll
            for (int m = 0; m < 4; ++m)
#pragma unroll
                for (int n = 0; n < 2; ++n) acc[a][b][m][n] = (f32x4){0.f, 0.f, 0.f, 0.f};
    h16x8 At[4][2], B0[2][2], B1[2][2];
    const char* cA = (const char*)g.A + (size_t)cur.pm * tstepA; const char* cB = (const char*)g.Bt + (size_t)cur.pn * tstepB;
    PG8_STAGE(PG8_SB(0, 0), cB, voffB); PG8_STAGE(PG8_SB(0, 1), cB + hstepB, voffB); PG8_STAGE(PG8_SA(0, 0), cA, voffA); PG8_STAGE(PG8_SA(0, 1), cA + hstepA, voffA);
    if (wr == 1) PG8_BAR;
    PG8_WAIT_V(2); PG8_BAR;
    PG8_STAGE(PG8_SB(1, 0), cB + kstep, voffB); PG8_STAGE(PG8_SA(1, 0), cA + kstep, voffA); PG8_STAGE(PG8_SB(1, 1), cB + hstepB + kstep, voffB);
    PG8_WAIT_V(6); PG8_BAR;
    for (;;) {
        const bool has_next = S.next(ui + 1, nxt);
        const char* nA = has_next ? (const char*)g.A + (size_t)nxt.pm * tstepA : cA; const char* nB = has_next ? (const char*)g.Bt + (size_t)nxt.pn * tstepB : cB;
        for (int t = 0; t < nt; t += 2) {
            const bool last = (t == nt - 2);
            const char* a1 = cA + (size_t)(t + 1) * kstep;
            const char* a2 = last ? nA : cA + (size_t)(t + 2) * kstep; const char* b2 = last ? nB : cB + (size_t)(t + 2) * kstep;
            const char* a3 = a2 + kstep; const char* b3 = b2 + kstep;
            if constexpr (Epi::MID) { if (t == nt / 2) E.mid(acc, cur, ui, wr, wc, fr, fq); }
            PG8_LDB(B0, 0, 0); PG8_LDB(B1, 0, 1); PG8_SCHED; PG8_LDA(At, 0, 0); PG8_STAGE(PG8_SA(1, 1), a1 + hstepA, voffA);
            PG8_WAIT_V(8); PG8_WAIT_L(0); PG8_BAR; PG8_MMA(0, 0, At, B0); PG8_MMA(0, 1, At, B1); PG8_BAR; PG8_SCHED;
            PG8_LDA(At, 0, 1); PG8_STAGE(PG8_SB(0, 0), b2, voffB); PG8_STAGE(PG8_SB(0, 1), b2 + hstepB, voffB); PG8_STAGE(PG8_SA(0, 0), a2, voffA);
            PG8_WAIT_V(8); PG8_WAIT_L(0); PG8_BAR; PG8_MMA(1, 0, At, B0); PG8_MMA(1, 1, At, B1); PG8_BAR; PG8_SCHED;
            PG8_LDB(B0, 1, 0); PG8_LDB(B1, 1, 1); PG8_SCHED; PG8_LDA(At, 1, 0); PG8_STAGE(PG8_SA(0, 1), a2 + hstepA, voffA);
            PG8_WAIT_V(8); PG8_WAIT_L(0); PG8_BAR; PG8_MMA(0, 0, At, B0); PG8_MMA(0, 1, At, B1); PG8_BAR; PG8_SCHED;
            PG8_LDA(At, 1, 1); PG8_STAGE(PG8_SB(1, 0), b3, voffB); PG8_STAGE(PG8_SB(1, 1), b3 + hstepB, voffB); PG8_STAGE(PG8_SA(1, 0), a3, voffA);
            PG8_WAIT_V(8); PG8_WAIT_L(0); PG8_BAR; PG8_MMA(1, 0, At, B0); PG8_MMA(1, 1, At, B1); PG8_BAR; PG8_SCHED;
        }
        if constexpr (ALIGN_EPI) { if (wr == 0) PG8_BAR; }
        E(acc, cur, ui, wr, wc, fr, fq);
        if (!has_next) break;
#pragma unroll
        for (int a = 0; a < 2; ++a)
#pragma unroll
            for (int b = 0; b < 2; ++b)
#pragma unroll
                for (int m = 0; m < 4; ++m)
#pragma unroll
                    for (int n = 0; n < 2; ++n) acc[a][b][m][n] = (f32x4){0.f, 0.f, 0.f, 0.f};
        cur = nxt; cA = nA; cB = nB; ++ui;
        if constexpr (ALIGN_EPI) { if (wr == 1) PG8_BAR; }
    }
    PG8_WAIT_V(0);
    if constexpr (!ALIGN_EPI) { if (wr == 0) PG8_BAR; }
    PG8_BAR;
#undef PG8_SA
#undef PG8_SB
#undef PG8_STAGE
#undef PG8_LDA
#undef PG8_LDB
#undef PG8_MMA
#undef PG8_WAIT_V
#undef PG8_WAIT_L
#undef PG8_BAR
#undef PG8_SCHED
}
}

typedef const f32x4 (&AccRef)[2][2][4][2];
template <bool PART16> struct EpiSwiglu {
    static constexpr bool MID = false;
    h16* act; const float* r; const float* bias;
    __device__ __forceinline__ void mid(f32x4 (&)[2][2][4][2], const pg8::Unit&, int, int, int, int, int) const {}
    __device__ __forceinline__ void operator()(AccRef acc, const pg8::Unit& u, int ui, int wr, int wc, int fr, int fq) const {
        const int b = u.pm >> 5, row0 = u.pm * 256 + wr * 64 + fr;
        const float* bp = bias + b * NGU + u.pn * 256 + wc * 32 + 4 * fq;
        f32x4 bv[2][2];
#pragma unroll
        for (int bj = 0; bj < 2; ++bj)
#pragma unroll
            for (int n = 0; n < 2; ++n) bv[bj][n] = *(const f32x4*)(bp + bj * 128 + n * 16);
        h16* ob = act + (size_t)row0 * DFF + u.pn * 128 + wc * 32 + fq * 8;
#pragma unroll
        for (int ai = 0; ai < 2; ++ai)
#pragma unroll
            for (int m = 0; m < 4; ++m) {
                const int ro = ai * 128 + m * 16; const float rs = PART16 ? rs16(r + (size_t)(row0 + ro) * 16) : r[row0 + ro];
                u32x4 w;
#pragma unroll
                for (int n = 0; n < 2; ++n) {
                    const f32x4 gv = acc[ai][0][m][n] * rs + bv[0][n], uv = acc[ai][1][m][n] * rs + bv[1][n];
                    const float a0 = silu_fast(gv[0]) * uv[0], a1 = silu_fast(gv[1]) * uv[1], a2 = silu_fast(gv[2]) * uv[2], a3 = silu_fast(gv[3]) * uv[3];
                    w[2 * n] = pkh(a0, a1); w[2 * n + 1] = pkh(a2, a3);
                }
                *(u32x4*)(ob + (size_t)ro * DFF) = w;
            }
    }
};
template <bool RES_F32, bool TWOSCALE, bool WRITE_HG> struct EpiResid {
    static constexpr bool MID = TWOSCALE;
    const float* xres; h16* H; h16* HG; const float* cs; const float* gp; float* ssq; const LAS float* sct; float cmul;
    __device__ __forceinline__ void mid(f32x4 (&acc)[2][2][4][2], const pg8::Unit& u, int ui, int wr, int wc, int fr, int fq) const {
        if constexpr (TWOSCALE) {
            const LAS float* t = sct + ui * 512 + wr * 64 + fr;
#pragma unroll
            for (int ai = 0; ai < 2; ++ai)
#pragma unroll
                for (int m = 0; m < 4; ++m) { const float f = t[ai * 128 + m * 16];
#pragma unroll
                    for (int bj = 0; bj < 2; ++bj)
#pragma unroll
                        for (int n = 0; n < 2; ++n) acc[ai][bj][m][n] *= f; }
        }
    }
    __device__ __forceinline__ void operator()(AccRef acc, const pg8::Unit& u, int ui, int wr, int wc, int fr, int fq) const {
        const int b = u.pm >> 5, row0 = u.pm * 256 + wr * 64 + fr, col0 = u.pn * 256 + wc * 32 + 8 * fq;
        f32x4 csv[2][2], gpv[2][2];
#pragma unroll
        for (int bj = 0; bj < 2; ++bj)
#pragma unroll
            for (int n = 0; n < 2; ++n) { csv[bj][n] = *(const f32x4*)(cs + b * D + col0 + bj * 128 + 4 * n) * cmul; if constexpr (WRITE_HG) gpv[bj][n] = *(const f32x4*)(gp + b * D + col0 + bj * 128 + 4 * n); }
#pragma unroll
        for (int ai = 0; ai < 2; ++ai)
#pragma unroll
            for (int m = 0; m < 4; ++m) {
                const int row = row0 + ai * 128 + m * 16; const size_t off = (size_t)row * D + col0;
                float rsc = 1.f; if constexpr (TWOSCALE) rsc = sct[ui * 512 + 256 + wr * 64 + fr + ai * 128 + m * 16];
                float q = 0.f;
#pragma unroll
                for (int bj = 0; bj < 2; ++bj) {
                    f32x4 r0, r1;
                    if constexpr (RES_F32) { r0 = *(const f32x4*)(xres + off + bj * 128); r1 = *(const f32x4*)(xres + off + bj * 128 + 4); }
                    else { const h16x8 hv = *(const h16x8*)(H + off + bj * 128); r0 = (f32x4){(float)hv[0], (float)hv[1], (float)hv[2], (float)hv[3]}; r1 = (f32x4){(float)hv[4], (float)hv[5], (float)hv[6], (float)hv[7]}; }
                    const f32x4 v0 = r0 + csv[bj][0] * (acc[ai][bj][m][0] * rsc), v1 = r1 + csv[bj][1] * (acc[ai][bj][m][1] * rsc);
                    q += ((v0[0] * v0[0] + v0[1] * v0[1]) + (v0[2] * v0[2] + v0[3] * v0[3])) + ((v1[0] * v1[0] + v1[1] * v1[1]) + (v1[2] * v1[2] + v1[3] * v1[3]));
                    u32x4 w; w[0] = pkh(v0[0], v0[1]); w[1] = pkh(v0[2], v0[3]); w[2] = pkh(v1[0], v1[1]); w[3] = pkh(v1[2], v1[3]);
                    *(u32x4*)(H + off + bj * 128) = w;
                    if constexpr (WRITE_HG) { const f32x4 g0 = v0 * gpv[bj][0], g1 = v1 * gpv[bj][1];
                        u32x4 wg; wg[0] = pkh(g0[0], g0[1]); wg[1] = pkh(g0[2], g0[3]); wg[2] = pkh(g1[0], g1[1]); wg[3] = pkh(g1[2], g1[3]);
                        *(u32x4*)(HG + off + bj * 128) = wg; }
                }
                q += __shfl_xor(q, 16); q += __shfl_xor(q, 32);
                if (fq == 0) ssq[(size_t)row * 16 + u.pn * 4 + wc] = q;
            }
    }
};
struct EpiInproj {
    static constexpr bool MID = false;
    h16* proj; const float* ssq2; const float* bias; const float* rope; float* kmp;
    __device__ __forceinline__ void mid(f32x4 (&)[2][2][4][2], const pg8::Unit&, int, int, int, int, int) const {}
    __device__ __forceinline__ void operator()(AccRef acc, const pg8::Unit& u, int ui, int wr, int wc, int fr, int fq) const {
        const int b = u.pm >> 5, row0 = u.pm * 256 + wr * 64 + fr, region = u.pn >> 1;
        const float* bp = bias + b * INW + u.pn * 256 + wc * 32 + 4 * fq;
        f32x4 bv[2][2];
#pragma unroll
        for (int bj = 0; bj < 2; ++bj)
#pragma unroll
            for (int n = 0; n < 2; ++n) bv[bj][n] = *(const f32x4*)(bp + bj * 128 + n * 16);
        const bool is_rope = (region == 0) || (region == 2);
        f32x4 csum[2][2];
#pragma unroll
        for (int bj = 0; bj < 2; ++bj)
#pragma unroll
            for (int n = 0; n < 2; ++n) csum[bj][n] = (f32x4){0.f, 0.f, 0.f, 0.f};
#pragma unroll
        for (int ai = 0; ai < 2; ++ai)
#pragma unroll
            for (int m = 0; m < 4; ++m) {
                const int row = row0 + ai * 128 + m * 16;
                const float rs = rs16(ssq2 + (size_t)row * 16);
                f32x4 v[2][2];
#pragma unroll
                for (int bj = 0; bj < 2; ++bj)
#pragma unroll
                    for (int n = 0; n < 2; ++n) v[bj][n] = acc[ai][bj][m][n] * rs + bv[bj][n];
                h16* prow = proj + (size_t)row * INW + region * 512 + (u.pn & 1) * 256;
                if (is_rope) {
                    const float* rp = rope + (size_t)(row & (S - 1)) * 64 + 4 * fq;
                    const float qs = (region == 0) ? C2 : 1.f;
#pragma unroll
                    for (int n = 0; n < 2; ++n) {
                        const f32x4 cs4 = *(const f32x4*)(rp + 16 * n) * qs, sn4 = *(const f32x4*)(rp + 32 + 16 * n) * qs;
                        const f32x4 x1 = v[0][n], x2 = v[1][n];
                        v[0][n] = x1 * cs4 - x2 * sn4; v[1][n] = x2 * cs4 + x1 * sn4;
                    }
                    h16* hp = prow + wc * 64 + 16 * fq;
#pragma unroll
                    for (int bj = 0; bj < 2; ++bj) { u32x4 w; w[0] = pkh(v[bj][0][0], v[bj][0][1]); w[1] = pkh(v[bj][0][2], v[bj][0][3]); w[2] = pkh(v[bj][1][0], v[bj][1][1]); w[3] = pkh(v[bj][1][2], v[bj][1][3]);
                        *(u32x4*)(hp + 8 * bj) = w; }
                    if (region == 2) {
#pragma unroll
                        for (int bj = 0; bj < 2; ++bj)
#pragma unroll
                            for (int n = 0; n < 2; ++n) csum[bj][n] += v[bj][n];
                    }
                } else {
                    if (region == 1 || region == 4) {
#pragma unroll
                        for (int bj = 0; bj < 2; ++bj)
#pragma unroll
                            for (int n = 0; n < 2; ++n)
#pragma unroll
                                for (int j = 0; j < 4; ++j) v[bj][n][j] = gelu_fast(v[bj][n][j]);
                    }
                    h16* hp = prow + wc * 32 + 8 * fq;
#pragma unroll
                    for (int bj = 0; bj < 2; ++bj) { u32x4 w; w[0] = pkh(v[bj][0][0], v[bj][0][1]); w[1] = pkh(v[bj][0][2], v[bj][0][3]); w[2] = pkh(v[bj][1][0], v[bj][1][1]); w[3] = pkh(v[bj][1][2], v[bj][1][3]);
                        *(u32x4*)(hp + 128 * bj) = w; }
                }
            }
        if (region == 2) {
#pragma unroll
            for (int bj = 0; bj < 2; ++bj)
#pragma unroll
                for (int n = 0; n < 2; ++n)
#pragma unroll
                    for (int j = 0; j < 4; ++j) { float t = csum[bj][n][j]; t += __shfl_xor(t, 1); t += __shfl_xor(t, 2); t += __shfl_xor(t, 4); t += __shfl_xor(t, 8); csum[bj][n][j] = t; }
            if (fr == 0) {
                float* kp = kmp + ((size_t)((b * NBLK + (u.pm & 31)) * 2 + wr)) * 512 + ((u.pn & 1) * 4 + wc) * 64 + 16 * fq;
#pragma unroll
                for (int bj = 0; bj < 2; ++bj)
#pragma unroll
                    for (int n = 0; n < 2; ++n) *(f32x4*)(kp + 8 * bj + 4 * n) = csum[bj][n];
            }
        }
    }
};

#define XB_TMO      128
#define XB_XCNT(j)  (256  + 64 * (j))
#define XB_XSUB(j)  (1280 + 64 * (j))
#define XB_XGEN(j)  (2304 + 64 * (j))
#define XB_TOP      3328
#define XB_TOPGEN   3392
#define XCD_BAR_WORDS 3456
#define XB_SPIN_CAP (1u << 18)
__device__ __forceinline__ unsigned xb_ld(unsigned* p)              { return __hip_atomic_load(p, __ATOMIC_RELAXED, __HIP_MEMORY_SCOPE_AGENT); }
__device__ __forceinline__ unsigned xb_add(unsigned* p, unsigned v) { return __hip_atomic_fetch_add(p, v, __ATOMIC_RELAXED, __HIP_MEMORY_SCOPE_AGENT); }
__device__ __forceinline__ unsigned xb_xcc_id() { return (unsigned)__builtin_amdgcn_s_getreg((3 << 11) | 20) & 0xFu; }
#define XB_SPIN(cond, bar) do { unsigned _sp = 0; while (cond) { __builtin_amdgcn_s_sleep(1); \
    if ((++_sp & 255u) == 0u) { if (xb_ld(&(bar)[XB_TMO])) break; if (_sp > XB_SPIN_CAP) { atomicAdd(&(bar)[XB_TMO], 1u); break; } } } } while (0)
struct XcdBarrier { unsigned* bar; unsigned x; volatile LAS unsigned* st; };
__device__ __forceinline__ XcdBarrier xcd_barrier_post(unsigned* bar, volatile LAS unsigned* st) {
    XcdBarrier b; b.bar = bar; b.x = xb_xcc_id(); b.st = st;
    if (threadIdx.x == 0) (void)xb_add(&bar[XB_XCNT(b.x)], 1u);
    return b;
}
__device__ __forceinline__ void xcd_barrier_complete(unsigned* bar, unsigned x, unsigned& nloc, unsigned& nx) {
    const unsigned G = gridDim.x * gridDim.y * gridDim.z;
    unsigned sum, cnt, mine, sp = 0u;
    for (;;) {
        sum = 0u; cnt = 0u; mine = 0u;
#pragma unroll
        for (unsigned j = 0; j < 16; ++j) { const unsigned c = xb_ld(&bar[XB_XCNT(j)]); sum += c; cnt += (c > 0u) ? 1u : 0u; mine = (j == x) ? c : mine; }
        if (sum == G) break;
        __builtin_amdgcn_s_sleep(1);
        if ((++sp & 255u) == 0u) { if (xb_ld(&bar[XB_TMO])) break; if (sp > XB_SPIN_CAP) { atomicAdd(&bar[XB_TMO], 1u); break; } }
    }
    nloc = mine > 0u ? mine : 1u; nx = cnt > 0u ? cnt : 1u;
}
__device__ __forceinline__ void xcd_barrier(const XcdBarrier& b) {
    asm volatile("s_waitcnt vmcnt(0)" ::: "memory");
    __syncthreads();
    if (threadIdx.x == 0) {
        unsigned* bar = b.bar;
        __builtin_amdgcn_s_waitcnt(0);
        unsigned nloc = b.st[0], nx = b.st[1];
        if (nloc == 0u) { xcd_barrier_complete(bar, b.x, nloc, nx); b.st[0] = nloc; b.st[1] = nx; }
        const unsigned old = xb_add(&bar[XB_XSUB(b.x)], 1u);
        const unsigned gen = old / nloc;
        if (old + 1u == (gen + 1u) * nloc) {
            __builtin_amdgcn_fence(__ATOMIC_RELEASE, "agent");
            asm volatile("s_waitcnt vmcnt(0)" ::: "memory");
            const unsigned og = xb_add(&bar[XB_TOP], 1u);
            const unsigned tg = og / nx;
            if (og + 1u == (tg + 1u) * nx) xb_add(&bar[XB_TOPGEN], 1u);
            else XB_SPIN(xb_ld(&bar[XB_TOPGEN]) == tg, bar);
            __builtin_amdgcn_fence(__ATOMIC_ACQUIRE, "agent");
            xb_add(&bar[XB_XGEN(b.x)], 1u);
            asm volatile("s_waitcnt vmcnt(0)" ::: "memory");
        } else {
            XB_SPIN(xb_ld(&bar[XB_XGEN(b.x)]) == gen, bar);
            __builtin_amdgcn_fence(__ATOMIC_ACQUIRE, "agent");
            asm volatile("s_waitcnt vmcnt(0)" ::: "memory");
        }
    }
    __syncthreads();
}

struct Args { const float* in[20]; float* out; unsigned char* ws; int ph_lo, ph_hi; };
struct Frame {
    LAS unsigned char* lds; volatile LAS unsigned* MISC; unsigned* ctl;
    int tid, lane, wave, vcu, G;
    unsigned char* ws; float* out;
};

__device__ __forceinline__ int p8(int l) { return (l & ~31) + 16 * ((l >> 2) & 1) + 4 * ((l >> 3) & 3) + (l & 3); }
__device__ __forceinline__ int phys_gu(int L) { const int isu = L >= DFF, hid = isu ? L - DFF : L, pn = hid >> 7, hh = hid & 127; return 256 * pn + 128 * isu + p8(hh); }
__device__ __forceinline__ int phys_in(int L) {
    const int reg = L >> 9, l = L & 511;
    const int preg = reg == 0 ? 0 : reg == 1 ? 2 : reg == 2 ? 3 : reg == 3 ? 1 : 4;
    if (reg <= 1) { const int head = l >> 6, d = l & 63, bj = d >> 5, i = d & 31; return 512 * preg + 256 * (head >> 2) + 128 * bj + 32 * (head & 3) + i; }
    return 512 * preg + p8(l);
}
enum PhysKind { PH_GU = 0, PH_P8 = 1, PH_IN = 2 };
template <int KIND> __device__ __forceinline__ int physmap(int L) { return KIND == PH_GU ? phys_gu(L) : KIND == PH_P8 ? p8(L) : phys_in(L); }

template <int KIND> __device__ __forceinline__ void p0_transpose_item(const float* W, int K, int N, h16* WT, const float* kscale, LAS float* scr, int item, int lane) {
    const int nblk = N / 32, kb = item / nblk, nb = item % nblk, k0 = 64 * kb, n0 = 32 * nb;
#pragma unroll 8
    for (int i = 0; i < 32; ++i) { const int kk = 2 * i + (lane >> 5); float v = W[(size_t)(k0 + kk) * N + n0 + (lane & 31)]; if (kscale) v *= kscale[k0 + kk]; scr[kk * 33 + (lane & 31)] = v; }
    LDS_WAIT(); asm volatile("" ::: "memory");
    const int c = lane & 7;
#pragma unroll
    for (int j = 0; j < 4; ++j) { const int n = (lane >> 3) + 8 * j; const LAS float* s = scr + (8 * c) * 33 + n;
        u32x4 o; o.x = pkh(s[0 * 33], s[1 * 33]); o.y = pkh(s[2 * 33], s[3 * 33]); o.z = pkh(s[4 * 33], s[5 * 33]); o.w = pkh(s[6 * 33], s[7 * 33]);
        *(u32x4*)(WT + (size_t)physmap<KIND>(n0 + n) * K + k0 + 8 * c) = o; }
    LDS_WAIT(); asm volatile("" ::: "memory");
}

__device__ __forceinline__ void p0_prologue(const Frame& F0, const Args& a) {
    Frame F = F0; F.tid = threadIdx.x; F.lane = F.tid & 63; F.wave = __builtin_amdgcn_readfirstlane(F.tid >> 6);
    const float* c = a.in[1]; const float* w_ada = a.in[2];
    {
        LAS float* red = (LAS float*)F.lds;
        for (int item = F.vcu; item < 72 * 4; item += F.G) {
            const int cg = item % 72, kq = item / 72, hlf = F.lane >> 5, col = cg * 128 + (F.lane & 31) * 4;
            f32x4 acc[4] = {{0.f, 0.f, 0.f, 0.f}, {0.f, 0.f, 0.f, 0.f}, {0.f, 0.f, 0.f, 0.f}, {0.f, 0.f, 0.f, 0.f}};
            const int kbase = kq * 256 + F.wave * 32 + hlf;
#pragma unroll 4
            for (int i = 0; i < 16; ++i) { const int k = kbase + 2 * i; const f32x4 w4 = *(const f32x4*)(w_ada + (size_t)k * (NMOD * D) + col);
#pragma unroll
                for (int b = 0; b < 4; ++b) { const float cv = c[b * D + k]; const float sv = cv / (1.f + __expf(-cv)); acc[b] += w4 * sv; } }
#pragma unroll
            for (int b = 0; b < 4; ++b)
#pragma unroll
                for (int j = 0; j < 4; ++j) acc[b][j] += __shfl_xor(acc[b][j], 32);
            if (hlf == 0) {
#pragma unroll
                for (int b = 0; b < 4; ++b) *(LAS f32x4*)(red + (F.wave * 4 + b) * 128 + (F.lane & 31) * 4) = acc[b];
            }
            __syncthreads();
            { const int b = F.tid >> 7, cc = F.tid & 127; float s = 0.f;
#pragma unroll
              for (int w = 0; w < 8; ++w) s += red[(w * 4 + b) * 128 + cc];
              ((float*)(F.ws + WS_MODP))[(size_t)(kq * 4 + b) * (NMOD * D) + cg * 128 + cc] = s; }
            __syncthreads();
        }
    }
    LAS float* scr = (LAS float*)(F.lds + F.wave * 16384);
    const int gw = F.vcu * NWAVES + F.wave, NGW = F.G * NWAVES;
    constexpr int I_GU = (D / 64) * (NGU / 32), I_DN = (DFF / 64) * (D / 32), I_IN = (D / 64) * (INW / 32), I_OUT = (D / 64) * (D / 32);
    constexpr int NITEMS = 2 * I_GU + 2 * I_DN + I_IN + I_OUT;
    for (int it = gw; it < NITEMS; it += NGW) {
        int r = it;
        if (r < I_GU) { p0_transpose_item<PH_GU>(a.in[5], D, NGU, (h16*)(F.ws + WS_WGU1), nullptr, scr, r, F.lane); continue; } r -= I_GU;
        if (r < I_GU) { p0_transpose_item<PH_GU>(a.in[17], D, NGU, (h16*)(F.ws + WS_WGU2), nullptr, scr, r, F.lane); continue; } r -= I_GU;
        if (r < I_DN) { p0_transpose_item<PH_P8>(a.in[6], DFF, D, (h16*)(F.ws + WS_WD1), nullptr, scr, r, F.lane); continue; } r -= I_DN;
        if (r < I_DN) { p0_transpose_item<PH_P8>(a.in[18], DFF, D, (h16*)(F.ws + WS_WD2), nullptr, scr, r, F.lane); continue; } r -= I_DN;
        if (r < I_IN) { p0_transpose_item<PH_IN>(a.in[8], D, INW, (h16*)(F.ws + WS_WIN), nullptr, scr, r, F.lane); continue; } r -= I_IN;
        {
            const int kb = r / (D / 32); const float* ks = (kb < 8) ? a.in[13] : (a.in[14] - 512);
            p0_transpose_item<PH_P8>(a.in[15], D, D, (h16*)(F.ws + WS_WOUT), ks, scr, r, F.lane); }
    }
    for (int pos = gw; pos < S; pos += NGW) {
        const int i = F.lane & 31;
        const float inv = (float)exp(-(double)i / 32.0 * 9.210340371976184);
        const float ang = (float)pos * inv;
        const double da = (double)ang;
        ((float*)(F.ws + WS_ROPE))[(size_t)pos * 64 + F.lane] = (F.lane < 32) ? (float)cos(da) : (float)sin(da);
    }
    for (int e = gw * 64 + F.lane; e < NH * GC * GC; e += NGW * 64) { const int t = (e >> 7) & 127, s = e & 127; ((h16*)(F.ws + WS_WS16))[e] = (s <= t) ? (h16)a.in[11][e] : (h16)0.f; }
}

__device__ __forceinline__ void p1_prep(const Frame& F0, const Args& a) {
    Frame F = F0; F.tid = threadIdx.x; F.lane = F.tid & 63; F.wave = __builtin_amdgcn_readfirstlane(F.tid >> 6);
    LAS float* modl = (LAS float*)F.lds;
    const float* modp = (const float*)(F.ws + WS_MODP); const float* b_ada = a.in[3];
    const size_t st = (size_t)4 * NMOD * D;
    for (int e = F.tid; e < 4 * 6 * D; e += NWAVES * 64) {
        const int b = e / (6 * D), sl = (e / D) % 6, k = e % D; const int mi = (sl < 3) ? 3 * sl : 3 * (sl - 3) + 1;
        const size_t o = (size_t)b * (NMOD * D) + mi * D + k;
        modl[e] = ((modp[o] + modp[o + st]) + (modp[o + 2 * st] + modp[o + 3 * st])) + b_ada[mi * D + k];
    }
    __syncthreads();
    if (F.vcu == 0) {
        float* GT = (float*)(F.ws + WS_GT); float* GP = (float*)(F.ws + WS_GP);
        for (int e = F.tid; e < 3 * 4 * D; e += NWAVES * 64) {
            const int j = e / (4 * D), b = (e / D) % 4, k = e % D; const int mi = 3 * j + 2;
            const size_t o = (size_t)b * (NMOD * D) + mi * D + k;
            GT[e] = ((modp[o] + modp[o + st]) + (modp[o + 2 * st] + modp[o + 3 * st])) + b_ada[mi * D + k];
            const float* g = j == 0 ? a.in[4] : j == 1 ? a.in[7] : a.in[16];
            GP[e] = g[k] * (1.f + modl[(b * 6 + 3 + j) * D + k]);
        }
    }
    const float* x = a.in[0]; const float* g1 = a.in[4];
    h16* XG = (h16*)(F.ws + WS_HG); float* R1 = (float*)(F.ws + WS_R1);
    for (int chunk = F.vcu; chunk < M / 128; chunk += F.G) {
        const int b = chunk / (S / 128);
        for (int rr = 0; rr < 16; ++rr) {
            const int row = chunk * 128 + F.wave * 16 + rr;
            const float* xr = x + (size_t)row * D + 8 * F.lane;
            f32x4 v[2][2]; float q = 0.f;
#pragma unroll
            for (int j = 0; j < 2; ++j) { v[j][0] = *(const f32x4*)(xr + 512 * j); v[j][1] = *(const f32x4*)(xr + 512 * j + 4);
                q += ((v[j][0][0] * v[j][0][0] + v[j][0][1] * v[j][0][1]) + (v[j][0][2] * v[j][0][2] + v[j][0][3] * v[j][0][3])) + ((v[j][1][0] * v[j][1][0] + v[j][1][1] * v[j][1][1]) + (v[j][1][2] * v[j][1][2] + v[j][1][3] * v[j][1][3])); }
            q = wave_sum(q);
            if (F.lane == 0) R1[row] = rsqrtf(q * (1.f / D) + EPS);
#pragma unroll
            for (int j = 0; j < 2; ++j) {
                const int k = 8 * F.lane + 512 * j; u32x4 w;
#pragma unroll
                for (int h = 0; h < 2; ++h) { const f32x4 gg = *(const f32x4*)(g1 + k + 4 * h); const LAS float* sc = modl + (b * 6 + 3) * D + k + 4 * h;
                    const f32x4 o = v[j][h] * gg * ((f32x4){1.f + sc[0], 1.f + sc[1], 1.f + sc[2], 1.f + sc[3]});
                    w[2 * h] = pkh(o[0], o[1]); w[2 * h + 1] = pkh(o[2], o[3]); }
                *(u32x4*)(XG + (size_t)row * D + k) = w;
            }
        }
    }
    const int gw = F.vcu * NWAVES + F.wave, NGW = F.G * NWAVES;
    for (int it = gw; it < NGU + INW + NGU; it += NGW) {
        int n = it, j; const h16* W; float* B; int NN;
        if (n < NGU) { j = 0; W = (const h16*)(F.ws + WS_WGU1); B = (float*)(F.ws + WS_BIAS1); NN = NGU; }
        else if (n < NGU + INW) { n -= NGU; j = 1; W = (const h16*)(F.ws + WS_WIN); B = (float*)(F.ws + WS_BIAS2); NN = INW; }
        else { n -= NGU + INW; j = 2; W = (const h16*)(F.ws + WS_WGU2); B = (float*)(F.ws + WS_BIAS3); NN = NGU; }
        const h16x8 w0 = *(const h16x8*)(W + (size_t)n * D + 16 * F.lane), w1 = *(const h16x8*)(W + (size_t)n * D + 16 * F.lane + 8);
        float s[4];
#pragma unroll
        for (int b = 0; b < 4; ++b) { const LAS float* sh = modl + (b * 6 + j) * D + 16 * F.lane; float t = 0.f;
#pragma unroll
            for (int e = 0; e < 8; ++e) t += sh[e] * (float)w0[e] + sh[8 + e] * (float)w1[e];
            s[b] = wave_sum(t); }
        if (F.lane == 0) { B[0 * NN + n] = s[0]; B[1 * NN + n] = s[1]; B[2 * NN + n] = s[2]; B[3 * NN + n] = s[3]; }
    }
    __syncthreads();
}

__device__ __forceinline__ void p_final(const Frame& F0, const Args& a) {
    Frame F = F0; F.tid = threadIdx.x; F.lane = F.tid & 63; F.wave = __builtin_amdgcn_readfirstlane(F.tid >> 6);
    const h16* H = (const h16*)(F.ws + WS_H); const float* ssq = (const float*)(F.ws + WS_SSQF); const float* gf = a.in[19];
    const int gw = F.vcu * NWAVES + F.wave, NGW = F.G * NWAVES;
    f32x4 g[2][2];
#pragma unroll
    for (int j = 0; j < 2; ++j)
#pragma unroll
        for (int h = 0; h < 2; ++h) g[j][h] = *(const f32x4*)(gf + 8 * F.lane + 512 * j + 4 * h);
    for (int row = gw; row < M; row += NGW) {
        const float rs = rs16(ssq + (size_t)row * 16);
#pragma unroll
        for (int j = 0; j < 2; ++j) { const h16x8 hv = *(const h16x8*)(H + (size_t)row * D + 8 * F.lane + 512 * j);
            f32x4 o0 = (f32x4){(float)hv[0], (float)hv[1], (float)hv[2], (float)hv[3]} * rs * g[j][0], o1 = (f32x4){(float)hv[4], (float)hv[5], (float)hv[6], (float)hv[7]} * rs * g[j][1];
            *(f32x4*)(a.out + (size_t)row * D + 8 * F.lane + 512 * j) = o0; *(f32x4*)(a.out + (size_t)row * D + 8 * F.lane + 512 * j + 4) = o1; }
    }
}


typedef float f32x16 __attribute__((ext_vector_type(16)));
typedef short v4i16_t __attribute__((ext_vector_type(4)));
__device__ __forceinline__ h16x4 tr16(const LAS unsigned char* p) { return __builtin_bit_cast(h16x4, __builtin_amdgcn_ds_read_tr16_b64_v4i16((LAS v4i16_t*)p)); }
__device__ __forceinline__ int vt_off(int t, int c8) { return t * 128 + (((c8 >> 2) ^ ((t >> 1) & 1)) << 6) + ((c8 & 3) << 4); }

__device__ __forceinline__ void gmlp_phase(const Frame& F0, const Args& a) {
    const int tid = threadIdx.x, lane = tid & 63, wave = __builtin_amdgcn_readfirstlane(tid >> 6), r32 = lane & 31, hi = lane >> 5;
    h16* proj = (h16*)(F0.ws + WS_PROJ); const h16* W16 = (const h16*)(F0.ws + WS_WS16); float* RG = (float*)(F0.ws + WS_RG);
    const float* ln_g = a.in[9]; const float* ln_b = a.in[10]; const float* b_s = a.in[12];
    LAS unsigned char* lds = F0.lds;
    LAS float* rowsq = (LAS float*)(lds + MISC_OFF + 128);
    f32x4 g0 = *(const f32x4*)(ln_g + 8 * lane), g1 = *(const f32x4*)(ln_g + 8 * lane + 4), b0 = *(const f32x4*)(ln_b + 8 * lane), b1 = *(const f32x4*)(ln_b + 8 * lane + 4);
    for (int unit = F0.vcu; unit < M / GC; unit += F0.G) {
        const size_t row0 = (size_t)unit * GC;
        for (int rr = 0; rr < 16; ++rr) {
            const int t = wave * 16 + rr;
            const h16x8 hv = *(const h16x8*)(proj + (row0 + t) * INW + PG + 8 * lane);
            float v[8]; float sm = 0.f;
#pragma unroll
            for (int e = 0; e < 8; ++e) { v[e] = (float)hv[e]; sm += v[e]; }
            const float mu = wave_sum(sm) * (1.f / 512.f); float q = 0.f;
#pragma unroll
            for (int e = 0; e < 8; ++e) { v[e] -= mu; q += v[e] * v[e]; }
            const float rs = rsqrtf(wave_sum(q) * (1.f / 512.f) + EPS);
            u32x4 w; w[0] = pkh(v[0] * rs * g0[0] + b0[0], v[1] * rs * g0[1] + b0[1]); w[1] = pkh(v[2] * rs * g0[2] + b0[2], v[3] * rs * g0[3] + b0[3]);
            w[2] = pkh(v[4] * rs * g1[0] + b1[0], v[5] * rs * g1[1] + b1[1]); w[3] = pkh(v[6] * rs * g1[2] + b1[2], v[7] * rs * g1[3] + b1[3]);
            *(LAS u32x4*)(lds + (lane >> 3) * 16384 + vt_off(t, lane & 7)) = w;
        }
        __syncthreads();
        const h16* Wh = W16 + (size_t)wave * GC * GC;
        const LAS unsigned char* vt = lds + wave * 16384;
        const int q4 = (lane & 15) >> 2, p4 = lane & 3, g1b = (lane >> 4) & 1;
        for (int tb = 0; tb < 4; ++tb) {
            f32x16 acc[2];
#pragma unroll
            for (int d0 = 0; d0 < 2; ++d0)
#pragma unroll
                for (int e = 0; e < 16; ++e) acc[d0][e] = 0.f;
            for (int ks = 0; ks <= 2 * tb + 1; ++ks) {
                const h16x8 af = *(const h16x8*)(Wh + (size_t)(32 * tb + r32) * GC + 16 * ks + 8 * hi);
#pragma unroll
                for (int d0 = 0; d0 < 2; ++d0) {
                    const int srow = 16 * ks + 8 * hi + q4, c8 = 4 * d0 + 2 * g1b + (p4 >> 1);
                    const h16x4 lo = tr16(vt + vt_off(srow, c8) + (p4 & 1) * 8), hi4 = tr16(vt + vt_off(srow + 4, c8) + (p4 & 1) * 8);
                    const h16x8 bf = (h16x8){lo[0], lo[1], lo[2], lo[3], hi4[0], hi4[1], hi4[2], hi4[3]};
                    acc[d0] = __builtin_amdgcn_mfma_f32_32x32x16_f16(af, bf, acc[d0], 0, 0, 0);
                }
            }
#pragma unroll
            for (int e = 0; e < 16; ++e) {
                const int t = 32 * tb + (e & 3) + 8 * (e >> 2) + 4 * hi;
                const float bs = b_s[wave * GC + t];
                h16* up = proj + (row0 + t) * INW + PU + wave * 64 + r32;
                const float o0 = (float)up[0] * (acc[0][e] + bs), o1 = (float)up[32] * (acc[1][e] + bs);
                up[0] = (h16)o0; up[32] = (h16)o1;
                float q = o0 * o0 + o1 * o1;
                q += __shfl_xor(q, 1); q += __shfl_xor(q, 2); q += __shfl_xor(q, 4); q += __shfl_xor(q, 8); q += __shfl_xor(q, 16);
                if (r32 == 0) rowsq[wave * 128 + t] = q;
            }
        }
        __syncthreads();
        if (tid < 128) { float s8 = 0.f;
#pragma unroll
            for (int w = 0; w < 8; ++w) s8 += rowsq[w * 128 + tid];
            RG[row0 + tid] = s8; }
        __syncthreads();
    }
}


constexpr size_t DO_PO = 0, DO_PML = 96 * MiB;
constexpr int CW_CNT = 8192;
constexpr int LISTCAP = 8192;
constexpr int AL_K = 0, AL_V = 32768, AL_STG = 65536, AL_WSF = 98304, AL_START = 102400;
__device__ __forceinline__ int k_off(int key, int c8) { return key * 128 + ((c8 ^ (key & 7)) << 4); }

__device__ __forceinline__ void moba_gate_phase(const Frame& F0) {
    const int tid = threadIdx.x, lane = tid & 63;
    const h16* proj = (const h16*)(F0.ws + WS_PROJ); const float* kmp = (const float*)(F0.ws + WS_KMP);
    unsigned* cnt = F0.ctl + CW_CNT; unsigned short* lists = (unsigned short*)(F0.ws + WS_LISTS);
    LAS float* km = (LAS float*)F0.lds;
    for (int item = F0.vcu; item < NB * NH * (S / 512); item += F0.G) {
        const int span = item % (S / 512), bh = item / (S / 512), b = bh >> 3, h = bh & 7;
        __syncthreads();
        for (int e = tid; e < NBLK * 64; e += NWAVES * 64) { const int n = e >> 6, d = e & 63; const float* kp = kmp + (size_t)((b * NBLK + n) * 2) * 512 + h * 64 + d; km[e] = kp[0] + kp[512]; }
        __syncthreads();
        const int sq = span * 512 + tid, own = __builtin_amdgcn_readfirstlane(sq >> 8);
        float q[64];
        { const h16* qp = proj + (size_t)(b * S + sq) * INW + PQ + h * 64;
#pragma unroll
          for (int c = 0; c < 8; ++c) { const h16x8 v = *(const h16x8*)(qp + 8 * c);
#pragma unroll
              for (int e = 0; e < 8; ++e) q[8 * c + e] = (float)v[e]; } }
        float v0 = -3e38f, v1 = -3e38f, v2 = -3e38f; int i0 = -1, i1 = -1, i2 = -1;
        for (int n = 0; n < own; ++n) {
            float g0 = 0.f, g1 = 0.f, g2 = 0.f, g3 = 0.f;
#pragma unroll
            for (int c = 0; c < 16; ++c) { const f32x4 kv = *(const LAS f32x4*)(km + n * 64 + 4 * c); g0 += q[4 * c] * kv[0]; g1 += q[4 * c + 1] * kv[1]; g2 += q[4 * c + 2] * kv[2]; g3 += q[4 * c + 3] * kv[3]; }
            const float g = (g0 + g1) + (g2 + g3);
            if (g > v0) { v2 = v1; i2 = i1; v1 = v0; i1 = i0; v0 = g; i0 = n; }
            else if (g > v1) { v2 = v1; i2 = i1; v1 = g; i1 = n; }
            else if (g > v2) { v2 = g; i2 = n; }
        }
        for (int n = 0; n < own; ++n) {
            const bool sel = (i0 == n) || (i1 == n) || (i2 == n);
            const unsigned long long mask = __ballot(sel);
            if (mask) {
                const int nsel = __popcll(mask), leader = __ffsll((long long)mask) - 1;
                unsigned base = 0u;
                if (lane == leader) base = atomicAdd(cnt + bh * NBLK + n, (unsigned)nsel);
                base = (unsigned)__shfl((int)base, leader);
                if (sel) { const int rank = (i0 == n) ? 0 : (i1 == n) ? 1 : 2; const unsigned pos = base + (unsigned)__popcll(mask & ((1ull << lane) - 1ull));
                    lists[(size_t)(bh * NBLK + n) * LISTCAP + pos] = (unsigned short)(sq | (rank << 13)); }
            }
        }
    }
    __syncthreads();
}

template <bool CAUSAL>
__device__ __forceinline__ void attn_tile(const LAS unsigned char* ldsK, const LAS unsigned char* ldsV, const h16x8 (&qf)[4], int wave, int lane, f32x16 (&o)[2], float& m_out, float& l_out) {
    const int r32 = lane & 31, hi = lane >> 5;
    int kbase[4];
#pragma unroll
    for (int ks = 0; ks < 4; ++ks) kbase[ks] = r32 * 128 + (((2 * ks + hi) ^ (r32 & 7)) << 4);
    f32x16 sacc[8];
#pragma unroll
    for (int kb = 0; kb < 8; ++kb) {
        if (!CAUSAL || kb <= wave) {
            f32x16 acc;
#pragma unroll
            for (int e = 0; e < 16; ++e) acc[e] = 0.f;
#pragma unroll
            for (int ks = 0; ks < 4; ++ks) { const h16x8 kf = *(const LAS h16x8*)(ldsK + kbase[ks] + kb * 4096); acc = __builtin_amdgcn_mfma_f32_32x32x16_f16(kf, qf[ks], acc, 0, 0, 0); }
            if (CAUSAL && kb == wave) {
#pragma unroll
                for (int e = 0; e < 16; ++e) { const int key = (e & 3) + 8 * (e >> 2) + 4 * hi; if (key > r32) acc[e] = -1e30f; }
            }
            sacc[kb] = acc;
        } else {
#pragma unroll
            for (int e = 0; e < 16; ++e) sacc[kb][e] = -1e30f;
        }
    }
    float m = -3e38f;
#pragma unroll
    for (int kb = 0; kb < 8; ++kb)
#pragma unroll
        for (int e = 0; e < 16; ++e) m = fmaxf(m, sacc[kb][e]);
    m = fmaxf(m, __shfl_xor(m, 32));
    float ls = 0.f;
#pragma unroll
    for (int kb = 0; kb < 8; ++kb)
#pragma unroll
        for (int e = 0; e < 16; ++e) { const float pv = __builtin_amdgcn_exp2f(sacc[kb][e] - m); sacc[kb][e] = pv; ls += pv; }
    ls += __shfl_xor(ls, 32);
#pragma unroll
    for (int d0 = 0; d0 < 2; ++d0)
#pragma unroll
        for (int e = 0; e < 16; ++e) o[d0][e] = 0.f;
    const int q4 = (lane & 15) >> 2, p4 = lane & 3, g1b = (lane >> 4) & 1;
    int vbase[2];
#pragma unroll
    for (int d0 = 0; d0 < 2; ++d0) vbase[d0] = (4 * hi + q4) * 128 + ((d0 ^ ((q4 >> 1) & 1)) << 6) + ((2 * g1b + (p4 >> 1)) << 4) + (p4 & 1) * 8;
#pragma unroll
    for (int kb = 0; kb < 8; ++kb) {
        if (!CAUSAL || kb <= wave) {
#pragma unroll
            for (int s2 = 0; s2 < 2; ++s2) {
                h16x8 pa;
#pragma unroll
                for (int j = 0; j < 8; ++j) pa[j] = (h16)sacc[kb][8 * s2 + j];
#pragma unroll
                for (int d0 = 0; d0 < 2; ++d0) {
                    const h16x4 lo = tr16(ldsV + vbase[d0] + kb * 4096 + s2 * 2048), hi4 = tr16(ldsV + vbase[d0] + kb * 4096 + s2 * 2048 + 1024);
                    const h16x8 bf = (h16x8){lo[0], lo[1], lo[2], lo[3], hi4[0], hi4[1], hi4[2], hi4[3]};
                    o[d0] = __builtin_amdgcn_mfma_f32_32x32x16_f16(pa, bf, o[d0], 0, 0, 0);
                }
            }
        }
    }
    m_out = m; l_out = ls;
}
__device__ __forceinline__ void load_kv_block(LAS unsigned char* lds, const h16* proj, size_t row0, int h, int tid) {
#pragma unroll
    for (int i = 0; i < 4; ++i) { const int idx = tid + 512 * i, key = idx >> 3, c8 = idx & 7; const h16* rp = proj + (row0 + key) * INW + h * 64 + 8 * c8;
        const u32x4 kv = *(const u32x4*)(rp + PK), vv = *(const u32x4*)(rp + PV);
        *(LAS u32x4*)(lds + AL_K + k_off(key, c8)) = kv; *(LAS u32x4*)(lds + AL_V + vt_off(key, c8)) = vv; }
}
__device__ __forceinline__ void stage_o(LAS unsigned char* stg, LAS float* wsf, const f32x16 (&o)[2], float l, int lane) {
    const int r32 = lane & 31, hi = lane >> 5;
    if (hi == 0) wsf[r32] = 1.f / l;
    LDS_WAIT();
#pragma unroll
    for (int e = 0; e < 16; ++e) { const int qr = (e & 3) + 8 * (e >> 2) + 4 * hi; const float rl = wsf[qr];
        *(LAS h16*)(stg + qr * 128 + r32 * 2) = (h16)(o[0][e] * rl); *(LAS h16*)(stg + qr * 128 + 64 + r32 * 2) = (h16)(o[1][e] * rl); }
    LDS_WAIT();
}

__device__ __forceinline__ void moba_b_phase(const Frame& F0, float* dout) {
    const int tid = threadIdx.x, lane = tid & 63, wave = __builtin_amdgcn_readfirstlane(tid >> 6), r32 = lane & 31, hi = lane >> 5;
    const h16* proj = (const h16*)(F0.ws + WS_PROJ); const unsigned* cnt = F0.ctl + CW_CNT; const unsigned short* lists = (const unsigned short*)(F0.ws + WS_LISTS);
    h16* PO = (h16*)((unsigned char*)dout + DO_PO); float* PML = (float*)((unsigned char*)dout + DO_PML);
    LAS unsigned char* lds = F0.lds;
    LAS int* start = (LAS int*)(lds + AL_START);
    LAS float* wsf = (LAS float*)(lds + AL_WSF + wave * 512); LAS int* wsi = (LAS int*)(lds + AL_WSF + wave * 512 + 256);
    LAS unsigned char* stg = lds + AL_STG + wave * 4096;
    {
        const unsigned c0 = cnt[2 * tid], c1 = cnt[2 * tid + 1];
        const int t0 = (int)((c0 + 255u) >> 8), t1 = (int)((c1 + 255u) >> 8);
        int v = t0 + t1, inc = v;
#pragma unroll
        for (int o = 1; o < 64; o <<= 1) { const int u = __shfl_up(inc, o); if (lane >= o) inc += u; }
        LAS int* wtot = (LAS int*)(lds + AL_WSF);
        __syncthreads();
        if (lane == 63) wtot[wave] = inc;
        __syncthreads();
        int pre = 0;
        for (int w = 0; w < wave; ++w) pre += wtot[w];
        const int ex = pre + inc - v;
        __syncthreads();
        start[2 * tid] = ex; start[2 * tid + 1] = ex + t0;
        if (tid == 511) start[1024] = ex + v;
        __syncthreads();
    }
    const int nitems = start[1024];
    for (int item = F0.vcu; item < nitems; item += F0.G) {
        int lo = 0, hi_ = 1024;
        while (hi_ - lo > 1) { const int mid = (lo + hi_) >> 1; if (start[mid] <= item) lo = mid; else hi_ = mid; }
        const int l = lo, chunk = item - start[l];
        const int bh = l >> 5, n = l & 31, b = bh >> 3, h = bh & 7;
        const int nq = (int)cnt[l] - chunk * 256;
        load_kv_block(lds, proj, (size_t)b * S + (size_t)n * MBLK, h, tid);
        const int qi = chunk * 256 + wave * 32 + r32;
        const bool valid = (wave * 32 + r32) < nq;
        const unsigned ent = lists[(size_t)l * LISTCAP + (valid ? qi : chunk * 256)];
        const int sq = ent & 8191, rank = ent >> 13;
        h16x8 qf[4];
        { const h16* qp = proj + (size_t)(b * S + sq) * INW + PQ + h * 64 + 8 * hi;
#pragma unroll
          for (int ks = 0; ks < 4; ++ks) qf[ks] = *(const h16x8*)(qp + 16 * ks); }
        __syncthreads();
        if (wave * 32 < nq) {
            f32x16 o[2]; float m, lsum;
            attn_tile<false>(lds + AL_K, lds + AL_V, qf, wave, lane, o, m, lsum);
            const int slot = ((b * S + sq) * NH + h) * 3 + rank;
            if (hi == 0) { wsi[r32] = valid ? slot : -1; if (valid) { PML[(size_t)slot * 2] = m; PML[(size_t)slot * 2 + 1] = lsum; } }
            stage_o(stg, wsf, o, lsum, lane);
#pragma unroll
            for (int i = 0; i < 4; ++i) { const int row = i * 8 + (lane >> 3), ch = lane & 7; const int sl = wsi[row];
                if (sl >= 0) *(u32x4*)(PO + (size_t)sl * 64 + ch * 8) = *(const LAS u32x4*)(stg + row * 128 + ch * 16); }
        }
        __syncthreads();
    }
}

__device__ __forceinline__ void moba_c_phase(const Frame& F0, const float* dout) {
    const int tid = threadIdx.x, lane = tid & 63, wave = __builtin_amdgcn_readfirstlane(tid >> 6), r32 = lane & 31, hi = lane >> 5;
    h16* proj = (h16*)(F0.ws + WS_PROJ); float* SSQA = (float*)(F0.ws + WS_SSQA);
    const h16* PO = (const h16*)((const unsigned char*)dout + DO_PO); const float* PML = (const float*)((const unsigned char*)dout + DO_PML);
    LAS unsigned char* lds = F0.lds;
    LAS float* wsf = (LAS float*)(lds + AL_WSF + wave * 512);
    LAS unsigned char* stg = lds + AL_STG + wave * 4096;
    for (int unit = F0.vcu; unit < NB * NH * NBLK; unit += F0.G) {
        const int qb = unit & 31, bh = unit >> 5, b = bh >> 3, h = bh & 7;
        const size_t row0 = (size_t)b * S + (size_t)qb * MBLK;
        load_kv_block(lds, proj, row0, h, tid);
        h16x8 qf[4];
        { const h16* qp = proj + (row0 + wave * 32 + r32) * INW + PQ + h * 64 + 8 * hi;
#pragma unroll
          for (int ks = 0; ks < 4; ++ks) qf[ks] = *(const h16x8*)(qp + 16 * ks); }
        __syncthreads();
        f32x16 o[2]; float m, lsum;
        attn_tile<true>(lds + AL_K, lds + AL_V, qf, wave, lane, o, m, lsum);
        if (hi == 0) { wsf[32 + r32] = m; wsf[64 + r32] = lsum; }
        stage_o(stg, wsf, o, lsum, lane);
        const int nsel = qb < 3 ? qb : 3;
#pragma unroll
        for (int i = 0; i < 4; ++i) {
            const int row = i * 8 + (lane >> 3), ch = lane & 7;
            const size_t grow = row0 + wave * 32 + row;
            const float mo = wsf[32 + row], lo_ = wsf[64 + row];
            const h16x8 ov = *(const LAS h16x8*)(stg + row * 128 + ch * 16);
            float mr[3], lr[3]; h16x8 pv[3];
            float mmax = mo;
#pragma unroll
            for (int r = 0; r < 3; ++r) { if (r < nsel) { const size_t sl = (grow * NH + h) * 3 + r; mr[r] = PML[sl * 2]; lr[r] = PML[sl * 2 + 1]; pv[r] = *(const h16x8*)(PO + sl * 64 + ch * 8); mmax = fmaxf(mmax, mr[r]); } }
            float wo = lo_ * __builtin_amdgcn_exp2f(mo - mmax), L = wo;
            float acc[8];
#pragma unroll
            for (int e = 0; e < 8; ++e) acc[e] = wo * (float)ov[e];
#pragma unroll
            for (int r = 0; r < 3; ++r) { if (r < nsel) { const float wr_ = lr[r] * __builtin_amdgcn_exp2f(mr[r] - mmax); L += wr_;
#pragma unroll
                for (int e = 0; e < 8; ++e) acc[e] += wr_ * (float)pv[r][e]; } }
            const float rL = 1.f / L; float q = 0.f; u32x4 w;
#pragma unroll
            for (int e = 0; e < 8; ++e) { acc[e] *= rL; q += acc[e] * acc[e]; }
            w[0] = pkh(acc[0], acc[1]); w[1] = pkh(acc[2], acc[3]); w[2] = pkh(acc[4], acc[5]); w[3] = pkh(acc[6], acc[7]);
            *(u32x4*)(proj + grow * INW + PQ + h * 64 + ch * 8) = w;
            q += __shfl_xor(q, 1); q += __shfl_xor(q, 2); q += __shfl_xor(q, 4);
            if (ch == 0) SSQA[grow * 8 + h] = q;
        }
        __syncthreads();
    }
}

enum Phase { PH_P0 = 0, PH_P1, PH_G1A, PH_G1B, PH_INPROJ, PH_MIX_A, PH_MIX_B, PH_MIX_C, PH_OUTPROJ, PH_G2A, PH_G2B, PH_FINAL, PH_COUNT };
__global__ void __launch_bounds__(NWAVES * 64, 2) mega_fwd(Args args) {
    extern __shared__ __attribute__((aligned(16))) unsigned char lds[];
    Frame F;
    F.lds = (LAS unsigned char*)lds; F.MISC = (volatile LAS unsigned*)(F.lds + MISC_OFF);
    F.tid = threadIdx.x; F.lane = F.tid & 63; F.wave = __builtin_amdgcn_readfirstlane(F.tid >> 6);
    F.G = gridDim.x; { const int bx = blockIdx.x; F.vcu = (F.G % 8 == 0) ? (bx % 8) * (F.G / 8) + bx / 8 : bx; }
    F.ws = args.ws; F.out = args.out; F.ctl = (unsigned*)(args.ws + WS_CTL);
    for (int u = F.tid; u < (LDS_BYTES - LDSCTL_OFF) / 4; u += NWAVES * 64) ((LAS unsigned*)(F.lds + LDSCTL_OFF))[u] = 0u;
    __syncthreads();
    XcdBarrier bar; bar.bar = F.ctl + CW_BAR; bar.x = 0; bar.st = nullptr;
    const int lo = args.ph_lo, hi = args.ph_hi;
    if (hi - lo > 1) bar = xcd_barrier_post(F.ctl + CW_BAR, F.MISC + 8);
#ifndef MK_PHASE_MASK
#define MK_PHASE_MASK 0xFFFF
#endif
#define IN(k) (((MK_PHASE_MASK >> (k)) & 1) && lo <= (k) && (k) < hi)
#define SEAM(k) do { if (IN(k) && IN((k) + 1)) xcd_barrier(bar); } while (0)
#define PHASE_PTRS() unsigned char* ws = args.ws; asm volatile("" : "+s"(ws)); const float* GT = (const float*)(ws + WS_GT); const float* GP = (const float*)(ws + WS_GP); (void)GT; (void)GP; F.ws = ws
    if (IN(PH_P0)) { PHASE_PTRS(); p0_prologue(F, args); SEAM(PH_P0); }
    if (IN(PH_P1)) { PHASE_PTRS(); p1_prep(F, args); SEAM(PH_P1); }
    if (IN(PH_G1A)) {
        PHASE_PTRS();
        pg8::Gemm g{(const h16*)(ws + WS_HG), (const h16*)(ws + WS_WGU1), D, NGU, D}; pg8::StaticOrder So; So.init(M, NGU, F.G, (int)blockIdx.x);
        EpiSwiglu<false> E{(h16*)(ws + WS_ACT), (const float*)(ws + WS_R1), (const float*)(ws + WS_BIAS1)};
        pg8::gemm_phase<EpiSwiglu<false>, true>(F.lds, g, So, E); SEAM(PH_G1A);
    }
    if (IN(PH_G1B)) {
        PHASE_PTRS();
        pg8::Gemm g{(const h16*)(ws + WS_ACT), (const h16*)(ws + WS_WD1), DFF, D, DFF}; pg8::StaticOrder So; So.init(M, D, F.G, (int)blockIdx.x);
        EpiResid<true, false, true> E{args.in[0], (h16*)(ws + WS_H), (h16*)(ws + WS_HG), GT + 0 * 4 * D, GP + 1 * 4 * D, (float*)(ws + WS_SSQ2), nullptr, 0.5f};
        pg8::gemm_phase<EpiResid<true, false, true>, true>(F.lds, g, So, E); SEAM(PH_G1B);
    }
    if (IN(PH_INPROJ)) {
        PHASE_PTRS();
        pg8::Gemm g{(const h16*)(ws + WS_HG), (const h16*)(ws + WS_WIN), D, INW, D}; pg8::StaticOrder So; So.init(M, INW, F.G, (int)blockIdx.x);
        EpiInproj E{(h16*)(ws + WS_PROJ), (const float*)(ws + WS_SSQ2), (const float*)(ws + WS_BIAS2), (const float*)(ws + WS_ROPE), (float*)(ws + WS_KMP)};
        pg8::gemm_phase<EpiInproj, true>(F.lds, g, So, E); SEAM(PH_INPROJ);
    }
    if (IN(PH_MIX_A)) { PHASE_PTRS(); gmlp_phase(F, args); moba_gate_phase(F); SEAM(PH_MIX_A); }
    if (IN(PH_MIX_B)) { PHASE_PTRS(); moba_b_phase(F, args.out); SEAM(PH_MIX_B); }
    if (IN(PH_MIX_C)) { PHASE_PTRS(); moba_c_phase(F, args.out); SEAM(PH_MIX_C); }
    if (IN(PH_OUTPROJ)) {
        PHASE_PTRS();
        pg8::Gemm g{(const h16*)(ws + WS_PROJ), (const h16*)(ws + WS_WOUT), INW, D, D}; pg8::StaticOrder So; So.init(M, D, F.G, (int)blockIdx.x);
        const LAS float* sct = (const LAS float*)(F.lds + MISC_OFF + 128);
        {   LAS float* t = (LAS float*)(F.lds + MISC_OFF + 128); const float* ssqa = (const float*)(ws + WS_SSQA); const float* ssqg = (const float*)(ws + WS_RG);
            pg8::Unit uu;
            for (int i = 0; i < 4 && So.next(i, uu); ++i)
                if (F.tid < 256) { const int row = uu.pm * 256 + F.tid; const f32x4 a = *(const f32x4*)(ssqa + (size_t)row * 8), bq = *(const f32x4*)(ssqa + (size_t)row * 8 + 4);
                    const float ra = rsqrtf((((a[0] + a[1]) + (a[2] + a[3])) + ((bq[0] + bq[1]) + (bq[2] + bq[3]))) * (1.f / 512.f) + EPS), rg = rsqrtf(ssqg[row] * (1.f / 512.f) + EPS);
                    t[i * 512 + F.tid] = ra / rg; t[i * 512 + 256 + F.tid] = rg; }
            __syncthreads(); }
        EpiResid<false, true, true> E{nullptr, (h16*)(ws + WS_H), (h16*)(ws + WS_HG), GT + 1 * 4 * D, GP + 2 * 4 * D, (float*)(ws + WS_SSQ3), sct, 1.0f};
        pg8::gemm_phase<EpiResid<false, true, true>, true>(F.lds, g, So, E); SEAM(PH_OUTPROJ);
    }
    if (IN(PH_G2A)) {
        PHASE_PTRS();
        pg8::Gemm g{(const h16*)(ws + WS_HG), (const h16*)(ws + WS_WGU2), D, NGU, D}; pg8::StaticOrder So; So.init(M, NGU, F.G, (int)blockIdx.x);
        EpiSwiglu<true> E{(h16*)(ws + WS_ACT), (const float*)(ws + WS_SSQ3), (const float*)(ws + WS_BIAS3)};
        pg8::gemm_phase<EpiSwiglu<true>, true>(F.lds, g, So, E); SEAM(PH_G2A);
    }
    if (IN(PH_G2B)) {
        PHASE_PTRS();
        pg8::Gemm g{(const h16*)(ws + WS_ACT), (const h16*)(ws + WS_WD2), DFF, D, DFF}; pg8::StaticOrder So; So.init(M, D, F.G, (int)blockIdx.x);
        EpiResid<false, false, false> E{nullptr, (h16*)(ws + WS_H), nullptr, GT + 2 * 4 * D, nullptr, (float*)(ws + WS_SSQF), nullptr, 0.5f};
        pg8::gemm_phase<EpiResid<false, false, false>, true>(F.lds, g, So, E); SEAM(PH_G2B);
    }
    if (IN(PH_FINAL)) { PHASE_PTRS(); p_final(F, args); }
#undef IN
#undef SEAM
}

extern "C" void kernel_launch(void* const* d_in, const int* in_sizes, int n_in, void* d_out, int out_size, void* d_ws, size_t ws_size, hipStream_t stream) {
    static int grid = 0;
    if (grid == 0) {
        if (n_in != 20 || out_size != M * D || ws_size < WS_END) { fprintf(stderr, "kernel_launch: unexpected shapes (n_in %d out %d ws %zu)\n", n_in, out_size, ws_size); grid = -1; return; }
        int dev = 0, cus = 0, per_cu = 0;
        hipGetDevice(&dev); hipDeviceGetAttribute(&cus, hipDeviceAttributeMultiprocessorCount, dev);
        if (hipFuncSetAttribute((const void*)mega_fwd, hipFuncAttributeMaxDynamicSharedMemorySize, LDS_BYTES) != hipSuccess) { fprintf(stderr, "kernel_launch: hipFuncSetAttribute failed\n"); grid = -1; return; }
        hipOccupancyMaxActiveBlocksPerMultiprocessor(&per_cu, (const void*)mega_fwd, NWAVES * 64, LDS_BYTES);
        (void)hipGetLastError();
        if (per_cu < 1) { fprintf(stderr, "kernel_launch: occupancy query says %d blocks/CU; nothing launched\n", per_cu); grid = -1; return; }
        grid = cus;
    }
    if (grid < 0) return;
    hipMemsetAsync((char*)d_ws + WS_CTL, 0, CTL_ZERO_BYTES, stream);
    Args a{};
    for (int i = 0; i < 20; ++i) a.in[i] = (const float*)d_in[i];
    a.out = (float*)d_out; a.ws = (unsigned char*)d_ws;
    unsigned char* ws = (unsigned char*)d_ws;
    auto run = [&](int lo, int hi) {
#if MK_PER_PHASE
        for (int p = lo; p < hi; ++p) { a.ph_lo = p; a.ph_hi = p + 1; hipLaunchKernelGGL(mega_fwd, dim3(grid), dim3(NWAVES * 64), LDS_BYTES, stream, a); }
#else
        a.ph_lo = lo; a.ph_hi = hi;
        void* kargs[] = {(void*)&a};
        hipError_t e = hipLaunchCooperativeKernel((const void*)mega_fwd, dim3(grid), dim3(NWAVES * 64), kargs, LDS_BYTES, stream);
        if (e != hipSuccess) fprintf(stderr, "kernel_launch: cooperative launch failed: %s (grid %d)\n", hipGetErrorString(e), grid);
#endif
    };
    run(PH_P0, PH_COUNT);
}
```

```cpp
#include <hip/hip_runtime.h>
#include <cstdio>
#include <cstdint>

#ifndef MK_DUP_MASK
#define MK_DUP_MASK 0
#endif
#ifndef MK_GPROBE
#define MK_GPROBE 0
#endif
#ifndef MK_SHADOW
#define MK_SHADOW 0
#endif
#ifndef MK_PER_PHASE
#define MK_PER_PHASE 0
#endif

#define GAS __attribute__((address_space(1)))
#define LAS __attribute__((address_space(3)))
typedef _Float16 h16;
typedef _Float16 h16x8 __attribute__((ext_vector_type(8)));
typedef _Float16 h16x4 __attribute__((ext_vector_type(4)));
typedef _Float16 h16x2 __attribute__((ext_vector_type(2)));
typedef float f32x4 __attribute__((ext_vector_type(4)));
typedef float f32x2 __attribute__((ext_vector_type(2)));
typedef unsigned u32x4 __attribute__((ext_vector_type(4)));
typedef unsigned u32x2 __attribute__((ext_vector_type(2)));

constexpr int D = 1024, NB = 4, S = 8192, M = NB * S, DFF = 2816, NGU = 2 * DFF, NMOD = 9;
constexpr int AW = 512, HD = 64, NH = 8, INW = 2560, MBLK = 256, NBLK = S / MBLK, GC = 128;
constexpr float EPS = 1e-6f;
constexpr float C2 = 0.125f * 1.4426950408889634f;
constexpr int PQ = 0, PU = 512, PK = 1024, PV = 1536, PG = 2048;

constexpr size_t MiB = 1u << 20, KiB = 1u << 10;
constexpr size_t WS_CTL = 0, CTL_ZERO_BYTES = 1 * MiB;
constexpr size_t WS_MODP = 1 * MiB;
constexpr size_t WS_GT = 2 * MiB, WS_GP = WS_GT + 64 * KiB;
constexpr size_t WS_BIAS1 = WS_GT + 128 * KiB, WS_BIAS2 = WS_GT + 256 * KiB, WS_BIAS3 = WS_GT + 320 * KiB;
constexpr size_t WS_R1 = 3 * MiB, WS_RG = WS_R1 + 128 * KiB;
constexpr size_t WS_SSQA = 4 * MiB;
constexpr size_t WS_SSQ2 = 5 * MiB, WS_SSQ3 = 7 * MiB, WS_SSQF = 9 * MiB;
constexpr size_t WS_KMP = 11 * MiB;
constexpr size_t WS_ROPE = 12 * MiB;
constexpr size_t WS_WS16 = 14 * MiB;
constexpr size_t WS_WGU1 = 16 * MiB, WS_WD1 = 27 * MiB, WS_WIN = 33 * MiB, WS_WOUT = 38 * MiB, WS_WGU2 = 40 * MiB, WS_WD2 = 51 * MiB;
constexpr size_t WS_HG = 64 * MiB, WS_H = 128 * MiB, WS_ACT = 192 * MiB, WS_PROJ = WS_ACT;
constexpr size_t WS_LISTS = 368 * MiB, WS_END = 384 * MiB;
static_assert(WS_WD2 + (size_t)D * DFF * 2 <= WS_HG && WS_ACT + (size_t)M * DFF * 2 <= WS_LISTS, "ws map");
constexpr int CW_TMO = 0, CW_BAR = 4096;

constexpr int RING_BYTES = 131072, LDSCTL_OFF = RING_BYTES, MISC_OFF = LDSCTL_OFF + 320, LDS_BYTES = 147456;
constexpr int NWAVES = 8;

#define LDS_WAIT() asm volatile("s_waitcnt lgkmcnt(0)" ::: "memory")
#define VM_WAIT() asm volatile("s_waitcnt vmcnt(0)" ::: "memory")

__device__ __forceinline__ float wave_sum(float v) {
#pragma unroll
    for (int o = 1; o < 64; o <<= 1) v += __shfl_xor(v, o);
    return v;
}
__device__ __forceinline__ unsigned pkh(float lo, float hi) { h16x2 v; v.x = (h16)lo; v.y = (h16)hi; return __builtin_bit_cast(unsigned, v); }
__device__ __forceinline__ float silu_fast(float x) { return x * __builtin_amdgcn_rcpf(1.f + __builtin_amdgcn_exp2f(-1.4426950408889634f * x)); }
__device__ __forceinline__ float gelu_fast(float x) {
    const float u2 = 1.5957691216057308f * (x + 0.044715f * x * x * x);
    return x * __builtin_amdgcn_rcpf(1.f + __builtin_amdgcn_exp2f(-1.4426950408889634f * u2));
}
__device__ __forceinline__ float rs16(const GAS float* p) {
    const f32x4 s0 = *(const GAS f32x4*)(p), s1 = *(const GAS f32x4*)(p + 4), s2 = *(const GAS f32x4*)(p + 8), s3 = *(const GAS f32x4*)(p + 12);
    const f32x4 st = (s0 + s1) + (s2 + s3);
    return rsqrtf(((st[0] + st[1]) + (st[2] + st[3])) * (1.f / D) + EPS);
}

namespace pg8 {
constexpr int BM = 256, BK = 64, HALF = 128, HTB = HALF * BK * 2, STAGE_BYTES = 8 * HTB, NXCD = 8, WGM = 8;
__host__ __device__ __forceinline__ int lds_byte(int r, int c) { const int st = (r >> 4) * 2 + (c >> 5), rr = r & 15, cc = c & 31, ob = rr * 64 + cc * 2; return st * 1024 + (ob ^ (((ob >> 9) & 1) << 5)); }
__host__ __device__ __forceinline__ void stage_rc(int b, int& R, int& C) { const int st = b / 1024, sb = b % 1024, swz = sb ^ (((sb >> 9) & 1) << 5); R = (st >> 1) * 16 + swz / 64; C = (st & 1) * 32 + (swz % 64) / 2; }
struct Unit { int pm, pn; };
struct Gemm { const GAS h16* A; const GAS h16* Bt; int lda, N, K; };
struct StaticOrder {
    int nM, nN, nwg, G, c;
    __device__ void init(int M_, int N, int G_, int c_) { nM = M_ / BM; nN = N / BM; nwg = nM * nN; G = G_; c = c_; }
    __device__ bool next(int i, Unit& u) const {
        const long L = (long)i * G + c; if (L >= nwg) return false;
        int wgid = (int)L; { const int q = nwg / NXCD, r = nwg % NXCD, xcd = wgid % NXCD, off = wgid / NXCD; wgid = (xcd < r ? xcd * (q + 1) : r * (q + 1) + (xcd - r) * q) + off; }
        const int nig = WGM * nN, gid = wgid / nig, fm = gid * WGM, gsz = (nM - fm) < WGM ? (nM - fm) : WGM;
        u.pm = fm + ((wgid % nig) % gsz); u.pn = (wgid % nig) / gsz; return true;
    }
};
template <class Epi, bool ALIGN_EPI, int PROBE = 0>
__device__ __forceinline__ void gemm_phase(LAS unsigned char* lds, const Gemm g, const StaticOrder& S, const Epi& E) {
    const int tid = threadIdx.x, wid = __builtin_amdgcn_readfirstlane(tid >> 6), lane = tid & 63, wr = wid >> 2, wc = wid & 3, fr = lane & 15, fq = lane >> 4;
    const int K = g.K, nt = K / BK;
    unsigned voffA[2], voffB[2];
#pragma unroll
    for (int i = 0; i < 2; ++i) { int R, C; stage_rc(tid * 16 + i * 8192, R, C); voffA[i] = (unsigned)(R * g.lda + C) * 2u; voffB[i] = (unsigned)(R * K + C) * 2u; }
    const size_t kstep = (size_t)(BK * 2);
    const size_t hstepA = (size_t)HALF * g.lda * 2, hstepB = (size_t)HALF * K * 2;
    const size_t tstepA = 2 * hstepA, tstepB = 2 * hstepB;
    const unsigned ldsw = (unsigned)wid * 1024u;
    const int aoff = lds_byte(wr * 64 + fr, fq * 8), boff = lds_byte(wc * 32 + fr, fq * 8);
#define PG8_SA(b, h) (((b) * 2 + (h)) * HTB)
#define PG8_SB(b, h) ((4 + (b) * 2 + (h)) * HTB)
#define PG8_STAGE(bufoff, gbase, voff) do { if (PROBE != 2) _Pragma("unroll") for (int _i = 0; _i < 2; ++_i) \
        __builtin_amdgcn_global_load_lds((const unsigned*)((const char*)(gbase) + (voff)[_i]), (LAS unsigned*)(lds + (bufoff) + ldsw + _i * 8192), 16, 0, 0); } while (0)
#define PG8_LDA(dst, b, h) do { _Pragma("unroll") for (int m = 0; m < 4; ++m) _Pragma("unroll") for (int k = 0; k < 2; ++k) dst[m][k] = *(const LAS h16x8*)(lds + PG8_SA(b, h) + aoff + m * 2048 + k * 1024); } while (0)
#define PG8_LDB(dst, b, h) do { _Pragma("unroll") for (int n = 0; n < 2; ++n) _Pragma("unroll") for (int k = 0; k < 2; ++k) dst[n][k] = *(const LAS h16x8*)(lds + PG8_SB(b, h) + boff + n * 2048 + k * 1024); } while (0)
#define PG8_MMA(ai, bj, At, Bt) do { if (PROBE == 1 && (bj) == 1) break; __builtin_amdgcn_s_setprio(1); _Pragma("unroll") for (int m = 0; m < 4; ++m) _Pragma("unroll") for (int n = 0; n < 2; ++n) _Pragma("unroll") for (int k = 0; k < 2; ++k) \
        acc[ai][bj][m][n] = __builtin_amdgcn_mfma_f32_16x16x32_f16(Bt[n][k], At[m][k], acc[ai][bj][m][n], 0, 0, 0); __builtin_amdgcn_s_setprio(0); } while (0)
#define PG8_WAIT_V(n) asm volatile("s_waitcnt vmcnt(" #n ")" ::: "memory")
#define PG8_WAIT_L(n) asm volatile("s_waitcnt lgkmcnt(" #n ")" ::: "memory")
#define PG8_BAR __builtin_amdgcn_s_barrier()
#define PG8_SCHED __builtin_amdgcn_sched_barrier(0)
    Unit cur, nxt; int ui = 0;
    if (!S.next(0, cur)) return;
    f32x4 acc[2][2][4][2];
#pragma unroll
    for (int a = 0; a < 2; ++a)
#pragma unroll
        for (int b = 0; b < 2; ++b)
#pragma unroll
            for (int m = 0; m < 4; ++m)
#pragma unroll
                for (int n = 0; n < 2; ++n) acc[a][b][m][n] = (f32x4){0.f, 0.f, 0.f, 0.f};
    h16x8 At[4][2], B0[2][2], B1[2][2];
    const char* cA = (const char*)g.A + (size_t)cur.pm * tstepA; const char* cB = (const char*)g.Bt + (size_t)cur.pn * tstepB;
    PG8_STAGE(PG8_SB(0, 0), cB, voffB); PG8_STAGE(PG8_SB(0, 1), cB + hstepB, voffB); PG8_STAGE(PG8_SA(0, 0), cA, voffA); PG8_STAGE(PG8_SA(0, 1), cA + hstepA, voffA);
    if (wr == 1) PG8_BAR;
    PG8_WAIT_V(2); PG8_BAR;
    PG8_STAGE(PG8_SB(1, 0), cB + kstep, voffB); PG8_STAGE(PG8_SA(1, 0), cA + kstep, voffA); PG8_STAGE(PG8_SB(1, 1), cB + hstepB + kstep, voffB);
    PG8_WAIT_V(6); PG8_BAR;
    for (;;) {
        const bool has_next = S.next(ui + 1, nxt);
        const char* nA = has_next ? (const char*)g.A + (size_t)nxt.pm * tstepA : cA; const char* nB = has_next ? (const char*)g.Bt + (size_t)nxt.pn * tstepB : cB;
        for (int t = 0; t < nt; t += 2) {
            const bool last = (t == nt - 2);
            const char* a1 = cA + (size_t)(t + 1) * kstep;
            const char* a2 = last ? nA : cA + (size_t)(t + 2) * kstep; const char* b2 = last ? nB : cB + (size_t)(t + 2) * kstep;
            const char* a3 = a2 + kstep; const char* b3 = b2 + kstep;
            if constexpr (Epi::MID) { if (t == nt / 2) E.mid(acc, cur, ui, wr, wc, fr, fq); }
            PG8_LDB(B0, 0, 0); PG8_LDB(B1, 0, 1); PG8_SCHED; PG8_LDA(At, 0, 0); PG8_STAGE(PG8_SA(1, 1), a1 + hstepA, voffA);
            PG8_WAIT_V(8); PG8_WAIT_L(0); PG8_BAR; PG8_MMA(0, 0, At, B0); PG8_MMA(0, 1, At, B1); PG8_BAR; PG8_SCHED;
            PG8_LDA(At, 0, 1); PG8_STAGE(PG8_SB(0, 0), b2, voffB); PG8_STAGE(PG8_SB(0, 1), b2 + hstepB, voffB); PG8_STAGE(PG8_SA(0, 0), a2, voffA);
            PG8_WAIT_V(8); PG8_WAIT_L(0); PG8_BAR; PG8_MMA(1, 0, At, B0); PG8_MMA(1, 1, At, B1); PG8_BAR; PG8_SCHED;
            PG8_LDB(B0, 1, 0); PG8_LDB(B1, 1, 1); PG8_SCHED; PG8_LDA(At, 1, 0); PG8_STAGE(PG8_SA(0, 1), a2 + hstepA, voffA);
            PG8_WAIT_V(8); PG8_WAIT_L(0); PG8_BAR; PG8_MMA(0, 0, At, B0); PG8_MMA(0, 1, At, B1); PG8_BAR; PG8_SCHED;
            PG8_LDA(At, 1, 1); PG8_STAGE(PG8_SB(1, 0), b3, voffB); PG8_STAGE(PG8_SB(1, 1), b3 + hstepB, voffB); PG8_STAGE(PG8_SA(1, 0), a3, voffA);
            PG8_WAIT_V(8); PG8_WAIT_L(0); PG8_BAR; PG8_MMA(1, 0, At, B0); PG8_MMA(1, 1, At, B1); PG8_BAR; PG8_SCHED;
        }
        if constexpr (ALIGN_EPI) { if (wr == 0) PG8_BAR; }
        E(acc, cur, ui, wr, wc, fr, fq);
        if (!has_next) break;
#pragma unroll
        for (int a = 0; a < 2; ++a)
#pragma unroll
            for (int b = 0; b < 2; ++b)
#pragma unroll
                for (int m = 0; m < 4; ++m)
#pragma unroll
                    for (int n = 0; n < 2; ++n) acc[a][b][m][n] = (f32x4){0.f, 0.f, 0.f, 0.f};
        cur = nxt; cA = nA; cB = nB; ++ui;
        if constexpr (ALIGN_EPI) { if (wr == 1) PG8_BAR; }
    }
    PG8_WAIT_V(0);
    if constexpr (!ALIGN_EPI) { if (wr == 0) PG8_BAR; }
    PG8_BAR;
#undef PG8_SA
#undef PG8_SB
#undef PG8_STAGE
#undef PG8_LDA
#undef PG8_LDB
#undef PG8_MMA
#undef PG8_WAIT_V
#undef PG8_WAIT_L
#undef PG8_BAR
#undef PG8_SCHED
}
}

typedef const f32x4 (&AccRef)[2][2][4][2];
template <bool PART16> struct EpiSwiglu {
    static constexpr bool MID = false;
    GAS h16* act; const GAS float* r; const GAS float* bias;
    __device__ __forceinline__ void mid(f32x4 (&)[2][2][4][2], const pg8::Unit&, int, int, int, int, int) const {}
    __device__ __forceinline__ void operator()(AccRef acc, const pg8::Unit& u, int ui, int wr, int wc, int fr, int fq) const {
        const int b = u.pm >> 5, row0 = u.pm * 256 + wr * 64 + fr;
        const GAS float* bp = bias + b * NGU + u.pn * 256 + wc * 32 + 4 * fq;
        f32x4 bv[2][2];
#pragma unroll
        for (int bj = 0; bj < 2; ++bj)
#pragma unroll
            for (int n = 0; n < 2; ++n) bv[bj][n] = *(const GAS f32x4*)(bp + bj * 128 + n * 16);
        GAS h16* ob = act + (size_t)row0 * DFF + u.pn * 128 + wc * 32 + fq * 8;
#pragma unroll
        for (int ai = 0; ai < 2; ++ai)
#pragma unroll
            for (int m = 0; m < 4; ++m) {
                const int ro = ai * 128 + m * 16; const float rs = PART16 ? rs16(r + (size_t)(row0 + ro) * 16) : r[row0 + ro];
                u32x4 w;
#pragma unroll
                for (int n = 0; n < 2; ++n) {
                    const f32x4 gv = acc[ai][0][m][n] * rs + bv[0][n], uv = acc[ai][1][m][n] * rs + bv[1][n];
                    const float a0 = silu_fast(gv[0]) * uv[0], a1 = silu_fast(gv[1]) * uv[1], a2 = silu_fast(gv[2]) * uv[2], a3 = silu_fast(gv[3]) * uv[3];
                    w[2 * n] = pkh(a0, a1); w[2 * n + 1] = pkh(a2, a3);
                }
                *(GAS u32x4*)(ob + (size_t)ro * DFF) = w;
            }
    }
};
struct EpiNull {
    static constexpr bool MID = false;
    __device__ __forceinline__ void mid(f32x4 (&)[2][2][4][2], const pg8::Unit&, int, int, int, int, int) const {}
    __device__ __forceinline__ void operator()(AccRef acc, const pg8::Unit& u, int ui, int wr, int wc, int fr, int fq) const {
#pragma unroll
        for (int ai = 0; ai < 2; ++ai)
#pragma unroll
            for (int bj = 0; bj < 2; ++bj)
#pragma unroll
                for (int m = 0; m < 4; ++m)
#pragma unroll
                    for (int n = 0; n < 2; ++n) asm volatile("" :: "v"(acc[ai][bj][m][n]));
    }
};
template <bool RES_F32, bool TWOSCALE, bool WRITE_HG> struct EpiResid {
    static constexpr bool MID = TWOSCALE;
    const GAS float* xres; GAS h16* H; GAS h16* HG; const GAS float* cs; const GAS float* gp; GAS float* ssq; const LAS float* sct; float cmul;
    __device__ __forceinline__ void mid(f32x4 (&acc)[2][2][4][2], const pg8::Unit& u, int ui, int wr, int wc, int fr, int fq) const {
        if constexpr (TWOSCALE) {
            const LAS float* t = sct + ui * 512 + wr * 64 + fr;
#pragma unroll
            for (int ai = 0; ai < 2; ++ai)
#pragma unroll
                for (int m = 0; m < 4; ++m) { const float f = t[ai * 128 + m * 16];
#pragma unroll
                    for (int bj = 0; bj < 2; ++bj)
#pragma unroll
                        for (int n = 0; n < 2; ++n) acc[ai][bj][m][n] *= f; }
        }
    }
    __device__ __forceinline__ void operator()(AccRef acc, const pg8::Unit& u, int ui, int wr, int wc, int fr, int fq) const {
        const int b = u.pm >> 5, row0 = u.pm * 256 + wr * 64 + fr, col0 = u.pn * 256 + wc * 32 + 8 * fq;
        f32x4 csv[2][2], gpv[2][2];
#pragma unroll
        for (int bj = 0; bj < 2; ++bj)
#pragma unroll
            for (int n = 0; n < 2; ++n) { csv[bj][n] = *(const GAS f32x4*)(cs + b * D + col0 + bj * 128 + 4 * n) * cmul; if constexpr (WRITE_HG) gpv[bj][n] = *(const GAS f32x4*)(gp + b * D + col0 + bj * 128 + 4 * n); }
#pragma unroll
        for (int ai = 0; ai < 2; ++ai)
#pragma unroll
            for (int m = 0; m < 4; ++m) {
                const int row = row0 + ai * 128 + m * 16; const size_t off = (size_t)row * D + col0;
                float rsc = 1.f; if constexpr (TWOSCALE) rsc = sct[ui * 512 + 256 + wr * 64 + fr + ai * 128 + m * 16];
                float q = 0.f;
#pragma unroll
                for (int bj = 0; bj < 2; ++bj) {
                    f32x4 r0, r1;
                    if constexpr (RES_F32) { r0 = *(const GAS f32x4*)(xres + off + bj * 128); r1 = *(const GAS f32x4*)(xres + off + bj * 128 + 4); }
                    else { const h16x8 hv = *(const GAS h16x8*)(H + off + bj * 128); r0 = (f32x4){(float)hv[0], (float)hv[1], (float)hv[2], (float)hv[3]}; r1 = (f32x4){(float)hv[4], (float)hv[5], (float)hv[6], (float)hv[7]}; }
                    const f32x4 v0 = r0 + csv[bj][0] * (acc[ai][bj][m][0] * rsc), v1 = r1 + csv[bj][1] * (acc[ai][bj][m][1] * rsc);
                    q += ((v0[0] * v0[0] + v0[1] * v0[1]) + (v0[2] * v0[2] + v0[3] * v0[3])) + ((v1[0] * v1[0] + v1[1] * v1[1]) + (v1[2] * v1[2] + v1[3] * v1[3]));
                    u32x4 w; w[0] = pkh(v0[0], v0[1]); w[1] = pkh(v0[2], v0[3]); w[2] = pkh(v1[0], v1[1]); w[3] = pkh(v1[2], v1[3]);
                    *(GAS u32x4*)(H + off + bj * 128) = w;
                    if constexpr (WRITE_HG) { const f32x4 g0 = v0 * gpv[bj][0], g1 = v1 * gpv[bj][1];
                        u32x4 wg; wg[0] = pkh(g0[0], g0[1]); wg[1] = pkh(g0[2], g0[3]); wg[2] = pkh(g1[0], g1[1]); wg[3] = pkh(g1[2], g1[3]);
                        *(GAS u32x4*)(HG + off + bj * 128) = wg; }
                }
                q += __shfl_xor(q, 16); q += __shfl_xor(q, 32);
                if (fq == 0) ssq[(size_t)row * 16 + u.pn * 4 + wc] = q;
            }
    }
};
struct EpiInproj {
    static constexpr bool MID = false;
    GAS h16* proj; const GAS float* ssq2; const GAS float* bias; const GAS float* rope; GAS float* kmp;
    __device__ __forceinline__ void mid(f32x4 (&)[2][2][4][2], const pg8::Unit&, int, int, int, int, int) const {}
    __device__ __forceinline__ void operator()(AccRef acc, const pg8::Unit& u, int ui, int wr, int wc, int fr, int fq) const {
        const int b = u.pm >> 5, row0 = u.pm * 256 + wr * 64 + fr, region = u.pn >> 1;
        const GAS float* bp = bias + b * INW + u.pn * 256 + wc * 32 + 4 * fq;
        f32x4 bv[2][2];
#pragma unroll
        for (int bj = 0; bj < 2; ++bj)
#pragma unroll
            for (int n = 0; n < 2; ++n) bv[bj][n] = *(const GAS f32x4*)(bp + bj * 128 + n * 16);
        const bool is_rope = (region == 0) || (region == 2);
        f32x4 csum[2][2];
#pragma unroll
        for (int bj = 0; bj < 2; ++bj)
#pragma unroll
            for (int n = 0; n < 2; ++n) csum[bj][n] = (f32x4){0.f, 0.f, 0.f, 0.f};
#pragma unroll
        for (int ai = 0; ai < 2; ++ai)
#pragma unroll
            for (int m = 0; m < 4; ++m) {
                const int row = row0 + ai * 128 + m * 16;
                const float rs = rs16(ssq2 + (size_t)row * 16);
                f32x4 v[2][2];
#pragma unroll
                for (int bj = 0; bj < 2; ++bj)
#pragma unroll
                    for (int n = 0; n < 2; ++n) v[bj][n] = acc[ai][bj][m][n] * rs + bv[bj][n];
                GAS h16* prow = proj + (size_t)row * INW + region * 512 + (u.pn & 1) * 256;
                if (is_rope) {
                    const GAS float* rp = rope + (size_t)(row & (S - 1)) * 64 + 4 * fq;
                    const float qs = (region == 0) ? C2 : 1.f;
#pragma unroll
                    for (int n = 0; n < 2; ++n) {
                        const f32x4 cs4 = *(const GAS f32x4*)(rp + 16 * n) * qs, sn4 = *(const GAS f32x4*)(rp + 32 + 16 * n) * qs;
                        const f32x4 x1 = v[0][n], x2 = v[1][n];
                        v[0][n] = x1 * cs4 - x2 * sn4; v[1][n] = x2 * cs4 + x1 * sn4;
                    }
                    GAS h16* hp = prow + wc * 64 + 16 * fq;
#pragma unroll
                    for (int bj = 0; bj < 2; ++bj) { u32x4 w; w[0] = pkh(v[bj][0][0], v[bj][0][1]); w[1] = pkh(v[bj][0][2], v[bj][0][3]); w[2] = pkh(v[bj][1][0], v[bj][1][1]); w[3] = pkh(v[bj][1][2], v[bj][1][3]);
                        *(GAS u32x4*)(hp + 8 * bj) = w; }
                    if (region == 2) {
#pragma unroll
                        for (int bj = 0; bj < 2; ++bj)
#pragma unroll
                            for (int n = 0; n < 2; ++n) csum[bj][n] += v[bj][n];
                    }
                } else {
                    if (region == 1 || region == 4) {
#pragma unroll
                        for (int bj = 0; bj < 2; ++bj)
#pragma unroll
                            for (int n = 0; n < 2; ++n)
#pragma unroll
                                for (int j = 0; j < 4; ++j) v[bj][n][j] = gelu_fast(v[bj][n][j]);
                    }
                    GAS h16* hp = prow + wc * 32 + 8 * fq;
#pragma unroll
                    for (int bj = 0; bj < 2; ++bj) { u32x4 w; w[0] = pkh(v[bj][0][0], v[bj][0][1]); w[1] = pkh(v[bj][0][2], v[bj][0][3]); w[2] = pkh(v[bj][1][0], v[bj][1][1]); w[3] = pkh(v[bj][1][2], v[bj][1][3]);
                        *(GAS u32x4*)(hp + 128 * bj) = w; }
                }
            }
        if (region == 2) {
#pragma unroll
            for (int bj = 0; bj < 2; ++bj)
#pragma unroll
                for (int n = 0; n < 2; ++n)
#pragma unroll
                    for (int j = 0; j < 4; ++j) { float t = csum[bj][n][j]; t += __shfl_xor(t, 1); t += __shfl_xor(t, 2); t += __shfl_xor(t, 4); t += __shfl_xor(t, 8); csum[bj][n][j] = t; }
            if (fr == 0) {
                GAS float* kp = kmp + ((size_t)((b * NBLK + (u.pm & 31)) * 2 + wr)) * 512 + ((u.pn & 1) * 4 + wc) * 64 + 16 * fq;
#pragma unroll
                for (int bj = 0; bj < 2; ++bj)
#pragma unroll
                    for (int n = 0; n < 2; ++n) *(GAS f32x4*)(kp + 8 * bj + 4 * n) = csum[bj][n];
            }
        }
    }
};

#define XB_TMO      128
#define XB_XCNT(j)  (256  + 64 * (j))
#define XB_XSUB(j)  (1280 + 64 * (j))
#define XB_XGEN(j)  (2304 + 64 * (j))
#define XB_TOP      3328
#define XB_TOPGEN   3392
#define XCD_BAR_WORDS 3456
#define XB_SPIN_CAP (1u << 18)
__device__ __forceinline__ unsigned xb_ld(unsigned* p)              { return __hip_atomic_load(p, __ATOMIC_RELAXED, __HIP_MEMORY_SCOPE_AGENT); }
__device__ __forceinline__ unsigned xb_add(unsigned* p, unsigned v) { return __hip_atomic_fetch_add(p, v, __ATOMIC_RELAXED, __HIP_MEMORY_SCOPE_AGENT); }
__device__ __forceinline__ unsigned xb_xcc_id() { return (unsigned)__builtin_amdgcn_s_getreg((3 << 11) | 20) & 0xFu; }
#define XB_SPIN(cond, bar) do { unsigned _sp = 0; while (cond) { __builtin_amdgcn_s_sleep(1); \
    if ((++_sp & 255u) == 0u) { if (xb_ld(&(bar)[XB_TMO])) break; if (_sp > XB_SPIN_CAP) { atomicAdd(&(bar)[XB_TMO], 1u); break; } } } } while (0)
struct XcdBarrier { unsigned* bar; unsigned x; volatile LAS unsigned* st; };
__device__ __forceinline__ XcdBarrier xcd_barrier_post(unsigned* bar, volatile LAS unsigned* st) {
    XcdBarrier b; b.bar = bar; b.x = xb_xcc_id(); b.st = st;
    if (threadIdx.x == 0) (void)xb_add(&bar[XB_XCNT(b.x)], 1u);
    return b;
}
__device__ __forceinline__ void xcd_barrier_complete(unsigned* bar, unsigned x, unsigned& nloc, unsigned& nx) {
    const unsigned G = gridDim.x * gridDim.y * gridDim.z;
    unsigned sum, cnt, mine, sp = 0u;
    for (;;) {
        sum = 0u; cnt = 0u; mine = 0u;
#pragma unroll
        for (unsigned j = 0; j < 16; ++j) { const unsigned c = xb_ld(&bar[XB_XCNT(j)]); sum += c; cnt += (c > 0u) ? 1u : 0u; mine = (j == x) ? c : mine; }
        if (sum == G) break;
        __builtin_amdgcn_s_sleep(1);
        if ((++sp & 255u) == 0u) { if (xb_ld(&bar[XB_TMO])) break; if (sp > XB_SPIN_CAP) { atomicAdd(&bar[XB_TMO], 1u); break; } }
    }
    nloc = mine > 0u ? mine : 1u; nx = cnt > 0u ? cnt : 1u;
}
__device__ __forceinline__ void xcd_barrier(const XcdBarrier& b) {
    asm volatile("s_waitcnt vmcnt(0)" ::: "memory");
    __syncthreads();
    if (threadIdx.x == 0) {
        unsigned* bar = b.bar;
        __builtin_amdgcn_s_waitcnt(0);
        unsigned nloc = b.st[0], nx = b.st[1];
        if (nloc == 0u) { xcd_barrier_complete(bar, b.x, nloc, nx); b.st[0] = nloc; b.st[1] = nx; }
        const unsigned old = xb_add(&bar[XB_XSUB(b.x)], 1u);
        const unsigned gen = old / nloc;
        if (old + 1u == (gen + 1u) * nloc) {
            __builtin_amdgcn_fence(__ATOMIC_RELEASE, "agent");
            asm volatile("s_waitcnt vmcnt(0)" ::: "memory");
            const unsigned og = xb_add(&bar[XB_TOP], 1u);
            const unsigned tg = og / nx;
            if (og + 1u == (tg + 1u) * nx) xb_add(&bar[XB_TOPGEN], 1u);
            else XB_SPIN(xb_ld(&bar[XB_TOPGEN]) == tg, bar);
            __builtin_amdgcn_fence(__ATOMIC_ACQUIRE, "agent");
            xb_add(&bar[XB_XGEN(b.x)], 1u);
            asm volatile("s_waitcnt vmcnt(0)" ::: "memory");
        } else {
            XB_SPIN(xb_ld(&bar[XB_XGEN(b.x)]) == gen, bar);
            __builtin_amdgcn_fence(__ATOMIC_ACQUIRE, "agent");
            asm volatile("s_waitcnt vmcnt(0)" ::: "memory");
        }
    }
    __syncthreads();
}

#define GIN(a_, i_) ((const GAS float*)(a_).in[i_])
struct Args { const float* in[20]; float* out; unsigned char* ws; int ph_lo, ph_hi; int shadow, pad; };
struct Frame {
    LAS unsigned char* lds; volatile LAS unsigned* MISC; unsigned* ctl;
    int tid, lane, wave, vcu, G;
    unsigned char* ws; GAS float* out;
};

__device__ __forceinline__ int p8(int l) { return (l & ~31) + 16 * ((l >> 2) & 1) + 4 * ((l >> 3) & 3) + (l & 3); }
__device__ __forceinline__ int phys_gu(int L) { const int isu = L >= DFF, hid = isu ? L - DFF : L, pn = hid >> 7, hh = hid & 127; return 256 * pn + 128 * isu + p8(hh); }
__device__ __forceinline__ int phys_in(int L) {
    const int reg = L >> 9, l = L & 511;
    const int preg = reg == 0 ? 0 : reg == 1 ? 2 : reg == 2 ? 3 : reg == 3 ? 1 : 4;
    if (reg <= 1) { const int head = l >> 6, d = l & 63, bj = d >> 5, i = d & 31; return 512 * preg + 256 * (head >> 2) + 128 * bj + 32 * (head & 3) + i; }
    return 512 * preg + p8(l);
}
enum PhysKind { PH_GU = 0, PH_P8 = 1, PH_IN = 2 };
template <int KIND> __device__ __forceinline__ int physmap(int L) { return KIND == PH_GU ? phys_gu(L) : KIND == PH_P8 ? p8(L) : phys_in(L); }

template <int KIND> __device__ __forceinline__ void p0_transpose_item(const GAS float* W, int K, int N, GAS h16* WT, const GAS float* kscale, LAS float* scr, int item, int lane) {
    const int nblk = N / 32, kb = item / nblk, nb = item % nblk, k0 = 64 * kb, n0 = 32 * nb;
#pragma unroll 8
    for (int i = 0; i < 32; ++i) { const int kk = 2 * i + (lane >> 5); float v = W[(size_t)(k0 + kk) * N + n0 + (lane & 31)]; if (kscale) v *= kscale[k0 + kk]; scr[kk * 33 + (lane & 31)] = v; }
    LDS_WAIT(); asm volatile("" ::: "memory");
    const int c = lane & 7;
#pragma unroll
    for (int j = 0; j < 4; ++j) { const int n = (lane >> 3) + 8 * j; const LAS float* s = scr + (8 * c) * 33 + n;
        u32x4 o; o.x = pkh(s[0 * 33], s[1 * 33]); o.y = pkh(s[2 * 33], s[3 * 33]); o.z = pkh(s[4 * 33], s[5 * 33]); o.w = pkh(s[6 * 33], s[7 * 33]);
        *(GAS u32x4*)(WT + (size_t)physmap<KIND>(n0 + n) * K + k0 + 8 * c) = o; }
    LDS_WAIT(); asm volatile("" ::: "memory");
}

__device__ __forceinline__ void p0_prologue(const Frame& F0, const Args& a) {
    Frame F = F0; F.tid = threadIdx.x; F.lane = F.tid & 63; F.wave = __builtin_amdgcn_readfirstlane(F.tid >> 6);
    const GAS float* c = GIN(a, 1); const GAS float* w_ada = GIN(a, 2);
    {
        LAS float* red = (LAS float*)F.lds;
        for (int item = F.vcu; item < 72 * 4; item += F.G) {
            const int cg = item % 72, kq = item / 72, hlf = F.lane >> 5, col = cg * 128 + (F.lane & 31) * 4;
            f32x4 acc[4] = {{0.f, 0.f, 0.f, 0.f}, {0.f, 0.f, 0.f, 0.f}, {0.f, 0.f, 0.f, 0.f}, {0.f, 0.f, 0.f, 0.f}};
            const int kbase = kq * 256 + F.wave * 32 + hlf;
#pragma unroll 4
            for (int i = 0; i < 16; ++i) { const int k = kbase + 2 * i; const f32x4 w4 = *(const GAS f32x4*)(w_ada + (size_t)k * (NMOD * D) + col);
#pragma unroll
                for (int b = 0; b < 4; ++b) { const float cv = c[b * D + k]; const float sv = cv / (1.f + __expf(-cv)); acc[b] += w4 * sv; } }
#pragma unroll
            for (int b = 0; b < 4; ++b)
#pragma unroll
                for (int j = 0; j < 4; ++j) acc[b][j] += __shfl_xor(acc[b][j], 32);
            if (hlf == 0) {
#pragma unroll
                for (int b = 0; b < 4; ++b) *(LAS f32x4*)(red + (F.wave * 4 + b) * 128 + (F.lane & 31) * 4) = acc[b];
            }
            __syncthreads();
            { const int b = F.tid >> 7, cc = F.tid & 127; float s = 0.f;
#pragma unroll
              for (int w = 0; w < 8; ++w) s += red[(w * 4 + b) * 128 + cc];
              ((GAS float*)(F.ws + WS_MODP))[(size_t)(kq * 4 + b) * (NMOD * D) + cg * 128 + cc] = s; }
            __syncthreads();
        }
    }
    LAS float* scr = (LAS float*)(F.lds + F.wave * 16384);
    const int gw = F.vcu * NWAVES + F.wave, NGW = F.G * NWAVES;
    constexpr int I_GU = (D / 64) * (NGU / 32), I_DN = (DFF / 64) * (D / 32), I_IN = (D / 64) * (INW / 32), I_OUT = (D / 64) * (D / 32);
    constexpr int NITEMS = 2 * I_GU + 2 * I_DN + I_IN + I_OUT;
    for (int it = gw; it < NITEMS; it += NGW) {
        int r = it;
        if (r < I_GU) { p0_transpose_item<PH_GU>(GIN(a, 5), D, NGU, (GAS h16*)(F.ws + WS_WGU1), nullptr, scr, r, F.lane); continue; } r -= I_GU;
        if (r < I_GU) { p0_transpose_item<PH_GU>(GIN(a, 17), D, NGU, (GAS h16*)(F.ws + WS_WGU2), nullptr, scr, r, F.lane); continue; } r -= I_GU;
        if (r < I_DN) { p0_transpose_item<PH_P8>(GIN(a, 6), DFF, D, (GAS h16*)(F.ws + WS_WD1), nullptr, scr, r, F.lane); continue; } r -= I_DN;
        if (r < I_DN) { p0_transpose_item<PH_P8>(GIN(a, 18), DFF, D, (GAS h16*)(F.ws + WS_WD2), nullptr, scr, r, F.lane); continue; } r -= I_DN;
        if (r < I_IN) { p0_transpose_item<PH_IN>(GIN(a, 8), D, INW, (GAS h16*)(F.ws + WS_WIN), nullptr, scr, r, F.lane); continue; } r -= I_IN;
        {
            const int kb = r / (D / 32); const GAS float* ks = (kb < 8) ? GIN(a, 13) : (GIN(a, 14) - 512);
            p0_transpose_item<PH_P8>(GIN(a, 15), D, D, (GAS h16*)(F.ws + WS_WOUT), ks, scr, r, F.lane); }
    }
    for (int pos = gw; pos < S; pos += NGW) {
        const int i = F.lane & 31;
        const float inv = (float)exp(-(double)i / 32.0 * 9.210340371976184);
        const float ang = (float)pos * inv;
        const double da = (double)ang;
        ((GAS float*)(F.ws + WS_ROPE))[(size_t)pos * 64 + F.lane] = (F.lane < 32) ? (float)cos(da) : (float)sin(da);
    }
    for (int e = gw * 64 + F.lane; e < NH * GC * GC; e += NGW * 64) { const int t = (e >> 7) & 127, s = e & 127; ((GAS h16*)(F.ws + WS_WS16))[e] = (s <= t) ? (h16)GIN(a, 11)[e] : (h16)0.f; }
}

__device__ __forceinline__ void p1_prep(const Frame& F0, const Args& a) {
    Frame F = F0; F.tid = threadIdx.x; F.lane = F.tid & 63; F.wave = __builtin_amdgcn_readfirstlane(F.tid >> 6);
    LAS float* modl = (LAS float*)F.lds;
    const GAS float* modp = (const GAS float*)(F.ws + WS_MODP); const GAS float* b_ada = GIN(a, 3);
    const size_t st = (size_t)4 * NMOD * D;
    for (int e = F.tid; e < 4 * 6 * D; e += NWAVES * 64) {
        const int b = e / (6 * D), sl = (e / D) % 6, k = e % D; const int mi = (sl < 3) ? 3 * sl : 3 * (sl - 3) + 1;
        const size_t o = (size_t)b * (NMOD * D) + mi * D + k;
        modl[e] = ((modp[o] + modp[o + st]) + (modp[o + 2 * st] + modp[o + 3 * st])) + b_ada[mi * D + k];
    }
    __syncthreads();
    if (F.vcu == 0) {
        GAS float* GT = (GAS float*)(F.ws + WS_GT); GAS float* GP = (GAS float*)(F.ws + WS_GP);
        for (int e = F.tid; e < 3 * 4 * D; e += NWAVES * 64) {
            const int j = e / (4 * D), b = (e / D) % 4, k = e % D; const int mi = 3 * j + 2;
            const size_t o = (size_t)b * (NMOD * D) + mi * D + k;
            GT[e] = ((modp[o] + modp[o + st]) + (modp[o + 2 * st] + modp[o + 3 * st])) + b_ada[mi * D + k];
            const GAS float* g = j == 0 ? GIN(a, 4) : j == 1 ? GIN(a, 7) : GIN(a, 16);
            GP[e] = g[k] * (1.f + modl[(b * 6 + 3 + j) * D + k]);
        }
    }
    const GAS float* x = GIN(a, 0); const GAS float* g1 = GIN(a, 4);
    GAS h16* XG = (GAS h16*)(F.ws + WS_HG); GAS float* R1 = (GAS float*)(F.ws + WS_R1);
    for (int chunk = F.vcu; chunk < M / 128; chunk += F.G) {
        const int b = chunk / (S / 128);
        for (int rr = 0; rr < 16; ++rr) {
            const int row = chunk * 128 + F.wave * 16 + rr;
            const GAS float* xr = x + (size_t)row * D + 8 * F.lane;
            f32x4 v[2][2]; float q = 0.f;
#pragma unroll
            for (int j = 0; j < 2; ++j) { v[j][0] = *(const GAS f32x4*)(xr + 512 * j); v[j][1] = *(const GAS f32x4*)(xr + 512 * j + 4);
                q += ((v[j][0][0] * v[j][0][0] + v[j][0][1] * v[j][0][1]) + (v[j][0][2] * v[j][0][2] + v[j][0][3] * v[j][0][3])) + ((v[j][1][0] * v[j][1][0] + v[j][1][1] * v[j][1][1]) + (v[j][1][2] * v[j][1][2] + v[j][1][3] * v[j][1][3])); }
            q = wave_sum(q);
            if (F.lane == 0) R1[row] = rsqrtf(q * (1.f / D) + EPS);
#pragma unroll
            for (int j = 0; j < 2; ++j) {
                const int k = 8 * F.lane + 512 * j; u32x4 w;
#pragma unroll
                for (int h = 0; h < 2; ++h) { const f32x4 gg = *(const GAS f32x4*)(g1 + k + 4 * h); const LAS float* sc = modl + (b * 6 + 3) * D + k + 4 * h;
                    const f32x4 o = v[j][h] * gg * ((f32x4){1.f + sc[0], 1.f + sc[1], 1.f + sc[2], 1.f + sc[3]});
                    w[2 * h] = pkh(o[0], o[1]); w[2 * h + 1] = pkh(o[2], o[3]); }
                *(GAS u32x4*)(XG + (size_t)row * D + k) = w;
            }
        }
    }
    const int gw = F.vcu * NWAVES + F.wave, NGW = F.G * NWAVES;
    for (int it = gw; it < NGU + INW + NGU; it += NGW) {
        int n = it, j; const GAS h16* W; GAS float* B; int NN;
        if (n < NGU) { j = 0; W = (const GAS h16*)(F.ws + WS_WGU1); B = (GAS float*)(F.ws + WS_BIAS1); NN = NGU; }
        else if (n < NGU + INW) { n -= NGU; j = 1; W = (const GAS h16*)(F.ws + WS_WIN); B = (GAS float*)(F.ws + WS_BIAS2); NN = INW; }
        else { n -= NGU + INW; j = 2; W = (const GAS h16*)(F.ws + WS_WGU2); B = (GAS float*)(F.ws + WS_BIAS3); NN = NGU; }
        const h16x8 w0 = *(const GAS h16x8*)(W + (size_t)n * D + 16 * F.lane), w1 = *(const GAS h16x8*)(W + (size_t)n * D + 16 * F.lane + 8);
        float s[4];
#pragma unroll
        for (int b = 0; b < 4; ++b) { const LAS float* sh = modl + (b * 6 + j) * D + 16 * F.lane; float t = 0.f;
#pragma unroll
            for (int e = 0; e < 8; ++e) t += sh[e] * (float)w0[e] + sh[8 + e] * (float)w1[e];
            s[b] = wave_sum(t); }
        if (F.lane == 0) { B[0 * NN + n] = s[0]; B[1 * NN + n] = s[1]; B[2 * NN + n] = s[2]; B[3 * NN + n] = s[3]; }
    }
    __syncthreads();
}

__device__ __forceinline__ void p_final(const Frame& F0, const Args& a) {
    Frame F = F0; F.tid = threadIdx.x; F.lane = F.tid & 63; F.wave = __builtin_amdgcn_readfirstlane(F.tid >> 6);
    const GAS h16* H = (const GAS h16*)(F.ws + WS_H); const GAS float* ssq = (const GAS float*)(F.ws + WS_SSQF); const GAS float* gf = GIN(a, 19);
    const int gw = F.vcu * NWAVES + F.wave, NGW = F.G * NWAVES;
    f32x4 g[2][2];
#pragma unroll
    for (int j = 0; j < 2; ++j)
#pragma unroll
        for (int h = 0; h < 2; ++h) g[j][h] = *(const GAS f32x4*)(gf + 8 * F.lane + 512 * j + 4 * h);
    for (int row = gw; row < M; row += NGW) {
        const float rs = rs16(ssq + (size_t)row * 16);
#pragma unroll
        for (int j = 0; j < 2; ++j) { const h16x8 hv = *(const GAS h16x8*)(H + (size_t)row * D + 8 * F.lane + 512 * j);
            f32x4 o0 = (f32x4){(float)hv[0], (float)hv[1], (float)hv[2], (float)hv[3]} * rs * g[j][0], o1 = (f32x4){(float)hv[4], (float)hv[5], (float)hv[6], (float)hv[7]} * rs * g[j][1];
            *(GAS f32x4*)(a.out + (size_t)row * D + 8 * F.lane + 512 * j) = o0; *(GAS f32x4*)(a.out + (size_t)row * D + 8 * F.lane + 512 * j + 4) = o1; }
    }
}


typedef float f32x16 __attribute__((ext_vector_type(16)));
typedef short v4i16_t __attribute__((ext_vector_type(4)));
__device__ __forceinline__ h16x4 tr16(const LAS unsigned char* p) { return __builtin_bit_cast(h16x4, __builtin_amdgcn_ds_read_tr16_b64_v4i16((LAS v4i16_t*)p)); }
__device__ __forceinline__ int vt_off(int t, int c8) { return t * 128 + (((c8 >> 2) ^ ((t >> 1) & 1)) << 6) + ((c8 & 3) << 4); }

__device__ __forceinline__ void gmlp_phase(const Frame& F0, const Args& a, int shadow) {
    const int tid = threadIdx.x, lane = tid & 63, wave = __builtin_amdgcn_readfirstlane(tid >> 6), r32 = lane & 31, hi = lane >> 5;
    GAS h16* proj = (GAS h16*)(F0.ws + WS_PROJ); const GAS h16* W16 = (const GAS h16*)(F0.ws + WS_WS16); GAS float* RG = (GAS float*)(F0.ws + WS_RG);
    const GAS float* ln_g = GIN(a, 9); const GAS float* ln_b = GIN(a, 10); const GAS float* b_s = GIN(a, 12);
    LAS unsigned char* lds = F0.lds;
    LAS float* rowsq = (LAS float*)(lds + MISC_OFF + 128);
    f32x4 g0 = *(const GAS f32x4*)(ln_g + 8 * lane), g1 = *(const GAS f32x4*)(ln_g + 8 * lane + 4), b0 = *(const GAS f32x4*)(ln_b + 8 * lane), b1 = *(const GAS f32x4*)(ln_b + 8 * lane + 4);
    for (int unit = F0.vcu; unit < M / GC; unit += F0.G) {
        const size_t row0 = (size_t)unit * GC;
        for (int rr = 0; rr < 16; ++rr) {
            const int t = wave * 16 + rr;
            const h16x8 hv = *(const GAS h16x8*)(proj + (row0 + t) * INW + PG + 8 * lane);
            float v[8]; float sm = 0.f;
#pragma unroll
            for (int e = 0; e < 8; ++e) { v[e] = (float)hv[e]; sm += v[e]; }
            const float mu = wave_sum(sm) * (1.f / 512.f); float q = 0.f;
#pragma unroll
            for (int e = 0; e < 8; ++e) { v[e] -= mu; q += v[e] * v[e]; }
            const float rs = rsqrtf(wave_sum(q) * (1.f / 512.f) + EPS);
            u32x4 w; w[0] = pkh(v[0] * rs * g0[0] + b0[0], v[1] * rs * g0[1] + b0[1]); w[1] = pkh(v[2] * rs * g0[2] + b0[2], v[3] * rs * g0[3] + b0[3]);
            w[2] = pkh(v[4] * rs * g1[0] + b1[0], v[5] * rs * g1[1] + b1[1]); w[3] = pkh(v[6] * rs * g1[2] + b1[2], v[7] * rs * g1[3] + b1[3]);
            *(LAS u32x4*)(lds + (lane >> 3) * 16384 + vt_off(t, lane & 7)) = w;
        }
        __syncthreads();
        const GAS h16* Wh = W16 + (size_t)wave * GC * GC;
        const LAS unsigned char* vt = lds + wave * 16384;
        const int q4 = (lane & 15) >> 2, p4 = lane & 3, g1b = (lane >> 4) & 1;
        for (int tb = 0; tb < 4; ++tb) {
            f32x16 acc[2];
#pragma unroll
            for (int d0 = 0; d0 < 2; ++d0)
#pragma unroll
                for (int e = 0; e < 16; ++e) acc[d0][e] = 0.f;
            for (int ks = 0; ks <= 2 * tb + 1; ++ks) {
                const h16x8 af = *(const GAS h16x8*)(Wh + (size_t)(32 * tb + r32) * GC + 16 * ks + 8 * hi);
#pragma unroll
                for (int d0 = 0; d0 < 2; ++d0) {
                    const int srow = 16 * ks + 8 * hi + q4, c8 = 4 * d0 + 2 * g1b + (p4 >> 1);
                    const h16x4 lo = tr16(vt + vt_off(srow, c8) + (p4 & 1) * 8), hi4 = tr16(vt + vt_off(srow + 4, c8) + (p4 & 1) * 8);
                    const h16x8 bf = (h16x8){lo[0], lo[1], lo[2], lo[3], hi4[0], hi4[1], hi4[2], hi4[3]};
                    acc[d0] = __builtin_amdgcn_mfma_f32_32x32x16_f16(af, bf, acc[d0], 0, 0, 0);
                }
            }
#pragma unroll
            for (int e = 0; e < 16; ++e) {
                const int t = 32 * tb + (e & 3) + 8 * (e >> 2) + 4 * hi;
                const float bs = b_s[wave * GC + t];
                GAS h16* up = proj + (row0 + t) * INW + PU + wave * 64 + r32;
                const float o0 = (float)up[0] * (acc[0][e] + bs), o1 = (float)up[32] * (acc[1][e] + bs);
                GAS h16* wp = shadow ? (GAS h16*)(F0.ws + WS_HG) + (row0 + t) * 512 + wave * 64 + r32 : up;
                wp[0] = (h16)o0; wp[32] = (h16)o1;
                float q = o0 * o0 + o1 * o1;
                q += __shfl_xor(q, 1); q += __shfl_xor(q, 2); q += __shfl_xor(q, 4); q += __shfl_xor(q, 8); q += __shfl_xor(q, 16);
                if (r32 == 0) rowsq[wave * 128 + t] = q;
            }
        }
        __syncthreads();
        if (tid < 128) { float s8 = 0.f;
#pragma unroll
            for (int w = 0; w < 8; ++w) s8 += rowsq[w * 128 + tid];
            RG[row0 + tid] = s8; }
        __syncthreads();
    }
}


constexpr size_t DO_PO = 0, DO_PML = 96 * MiB;
constexpr int CW_CNT = 8192;
constexpr int LISTCAP = 8192;
constexpr int AL_K = 0, AL_V = 32768, AL_STG = 65536, AL_WSF = 98304, AL_START = 102400;
__device__ __forceinline__ int k_off(int key, int c8) { return key * 128 + ((c8 ^ (key & 7)) << 4); }

__device__ __forceinline__ void moba_gate_phase(const Frame& F0, int shadow) {
    const int tid = threadIdx.x, lane = tid & 63;
    const GAS h16* proj = (const GAS h16*)(F0.ws + WS_PROJ); const GAS float* kmp = (const GAS float*)(F0.ws + WS_KMP);
    unsigned* cnt = F0.ctl + CW_CNT + (shadow ? 1024 : 0); GAS unsigned short* lists = (GAS unsigned short*)(F0.ws + (shadow ? WS_HG : WS_LISTS));
    LAS float* km = (LAS float*)F0.lds;
    for (int item = F0.vcu; item < NB * NH * (S / 512); item += F0.G) {
        const int span = item % (S / 512), bh = item / (S / 512), b = bh >> 3, h = bh & 7;
        __syncthreads();
        for (int e = tid; e < NBLK * 64; e += NWAVES * 64) { const int n = e >> 6, d = e & 63; const GAS float* kp = kmp + (size_t)((b * NBLK + n) * 2) * 512 + h * 64 + d; km[e] = kp[0] + kp[512]; }
        __syncthreads();
        const int sq = span * 512 + tid, own = __builtin_amdgcn_readfirstlane(sq >> 8);
        float q[64];
        { const GAS h16* qp = proj + (size_t)(b * S + sq) * INW + PQ + h * 64;
#pragma unroll
          for (int c = 0; c < 8; ++c) { const h16x8 v = *(const GAS h16x8*)(qp + 8 * c);
#pragma unroll
              for (int e = 0; e < 8; ++e) q[8 * c + e] = (float)v[e]; } }
        float v0 = -3e38f, v1 = -3e38f, v2 = -3e38f; int i0 = -1, i1 = -1, i2 = -1;
        for (int n = 0; n < own; ++n) {
            float g0 = 0.f, g1 = 0.f, g2 = 0.f, g3 = 0.f;
#pragma unroll
            for (int c = 0; c < 16; ++c) { const f32x4 kv = *(const LAS f32x4*)(km + n * 64 + 4 * c); g0 += q[4 * c] * kv[0]; g1 += q[4 * c + 1] * kv[1]; g2 += q[4 * c + 2] * kv[2]; g3 += q[4 * c + 3] * kv[3]; }
            const float g = (g0 + g1) + (g2 + g3);
            if (g > v0) { v2 = v1; i2 = i1; v1 = v0; i1 = i0; v0 = g; i0 = n; }
            else if (g > v1) { v2 = v1; i2 = i1; v1 = g; i1 = n; }
            else if (g > v2) { v2 = g; i2 = n; }
        }
        int mycnt = 0, pos0 = 0, pos1 = 0, pos2 = 0;
        const unsigned long long ltmask = (1ull << lane) - 1ull;
        for (int n = 0; n < own; ++n) {
            const bool sel = (i0 == n) || (i1 == n) || (i2 == n);
            const unsigned long long mask = __ballot(sel);
            const int before = __popcll(mask & ltmask);
            if (lane == n) mycnt = __popcll(mask);
            if (i0 == n) pos0 = before; if (i1 == n) pos1 = before; if (i2 == n) pos2 = before;
        }
        unsigned base = 0u;
        if (lane < own && mycnt > 0) base = atomicAdd(cnt + bh * NBLK + lane, (unsigned)mycnt);
        const unsigned bb0 = (unsigned)__shfl((int)base, i0 & 63), bb1 = (unsigned)__shfl((int)base, i1 & 63), bb2 = (unsigned)__shfl((int)base, i2 & 63);
        if (i0 >= 0) lists[(size_t)(bh * NBLK + i0) * LISTCAP + bb0 + pos0] = (unsigned short)(sq | (0 << 13));
        if (i1 >= 0) lists[(size_t)(bh * NBLK + i1) * LISTCAP + bb1 + pos1] = (unsigned short)(sq | (1 << 13));
        if (i2 >= 0) lists[(size_t)(bh * NBLK + i2) * LISTCAP + bb2 + pos2] = (unsigned short)(sq | (2 << 13));
    }
    __syncthreads();
}

template <bool CAUSAL>
__device__ __forceinline__ void attn_tile(const LAS unsigned char* ldsK, const LAS unsigned char* ldsV, const h16x8 (&qf)[4], int wave, int lane, f32x16 (&o)[2], float& m_out, float& l_out) {
    const int r32 = lane & 31, hi = lane >> 5;
    int kbase[4];
#pragma unroll
    for (int ks = 0; ks < 4; ++ks) kbase[ks] = r32 * 128 + (((2 * ks + hi) ^ (r32 & 7)) << 4);
    f32x16 sacc[8];
#pragma unroll
    for (int kb = 0; kb < 8; ++kb) {
        f32x16 acc;
#pragma unroll
        for (int e = 0; e < 16; ++e) acc[e] = 0.f;
#pragma unroll
        for (int ks = 0; ks < 4; ++ks) { const h16x8 kf = *(const LAS h16x8*)(ldsK + kbase[ks] + kb * 4096); acc = __builtin_amdgcn_mfma_f32_32x32x16_f16(kf, qf[ks], acc, 0, 0, 0); }
        if (CAUSAL) {
            const int lim = 32 * (wave - kb) + r32;
#pragma unroll
            for (int e = 0; e < 16; ++e) { const int key = (e & 3) + 8 * (e >> 2) + 4 * hi; if (key > lim) acc[e] = -1e30f; }
        }
        sacc[kb] = acc;
    }
    float m = -3e38f;
#pragma unroll
    for (int kb = 0; kb < 8; ++kb)
#pragma unroll
        for (int e = 0; e < 16; ++e) m = fmaxf(m, sacc[kb][e]);
    m = fmaxf(m, __shfl_xor(m, 32));
    float ls = 0.f;
#pragma unroll
    for (int kb = 0; kb < 8; ++kb)
#pragma unroll
        for (int e = 0; e < 16; ++e) { const float pv = __builtin_amdgcn_exp2f(sacc[kb][e] - m); sacc[kb][e] = pv; ls += pv; }
    ls += __shfl_xor(ls, 32);
#pragma unroll
    for (int d0 = 0; d0 < 2; ++d0)
#pragma unroll
        for (int e = 0; e < 16; ++e) o[d0][e] = 0.f;
    const int q4 = (lane & 15) >> 2, p4 = lane & 3, g1b = (lane >> 4) & 1;
    int vbase[2];
#pragma unroll
    for (int d0 = 0; d0 < 2; ++d0) vbase[d0] = (4 * hi + q4) * 128 + ((d0 ^ ((q4 >> 1) & 1)) << 6) + ((2 * g1b + (p4 >> 1)) << 4) + (p4 & 1) * 8;
#pragma unroll
    for (int kb = 0; kb < 8; ++kb) {
        if (!CAUSAL || kb <= wave) {
#pragma unroll
            for (int s2 = 0; s2 < 2; ++s2) {
                h16x8 pa;
#pragma unroll
                for (int j = 0; j < 8; ++j) pa[j] = (h16)sacc[kb][8 * s2 + j];
#pragma unroll
                for (int d0 = 0; d0 < 2; ++d0) {
                    const h16x4 lo = tr16(ldsV + vbase[d0] + kb * 4096 + s2 * 2048), hi4 = tr16(ldsV + vbase[d0] + kb * 4096 + s2 * 2048 + 1024);
                    const h16x8 bf = (h16x8){lo[0], lo[1], lo[2], lo[3], hi4[0], hi4[1], hi4[2], hi4[3]};
                    o[d0] = __builtin_amdgcn_mfma_f32_32x32x16_f16(pa, bf, o[d0], 0, 0, 0);
                }
            }
        }
    }
    m_out = m; l_out = ls;
}
__device__ __forceinline__ void attn_tile_causal(const LAS unsigned char* ldsK, const LAS unsigned char* ldsV, const h16x8 (&qf)[4], int wave, int lane, f32x16 (&o)[2], float& m_out, float& l_out) {
    const int r32 = lane & 31, hi = lane >> 5;
    int kbase[4];
#pragma unroll
    for (int ks = 0; ks < 4; ++ks) kbase[ks] = r32 * 128 + (((2 * ks + hi) ^ (r32 & 7)) << 4);
    const int q4 = (lane & 15) >> 2, p4 = lane & 3, g1b = (lane >> 4) & 1;
    int vbase[2];
#pragma unroll
    for (int d0 = 0; d0 < 2; ++d0) vbase[d0] = (4 * hi + q4) * 128 + ((d0 ^ ((q4 >> 1) & 1)) << 6) + ((2 * g1b + (p4 >> 1)) << 4) + (p4 & 1) * 8;
    float m = -3e38f;
    for (int kb = 0; kb <= wave; ++kb) {
        f32x16 acc;
#pragma unroll
        for (int e = 0; e < 16; ++e) acc[e] = 0.f;
#pragma unroll
        for (int ks = 0; ks < 4; ++ks) { const h16x8 kf = *(const LAS h16x8*)(ldsK + kbase[ks] + kb * 4096); acc = __builtin_amdgcn_mfma_f32_32x32x16_f16(kf, qf[ks], acc, 0, 0, 0); }
        const int lim = (kb == wave) ? r32 : 64;
#pragma unroll
        for (int e = 0; e < 16; ++e) { const int key = (e & 3) + 8 * (e >> 2) + 4 * hi; if (key <= lim) m = fmaxf(m, acc[e]); }
    }
    m = fmaxf(m, __shfl_xor(m, 32));
    float ls = 0.f;
#pragma unroll
    for (int d0 = 0; d0 < 2; ++d0)
#pragma unroll
        for (int e = 0; e < 16; ++e) o[d0][e] = 0.f;
    for (int kb = 0; kb <= wave; ++kb) {
        f32x16 acc;
#pragma unroll
        for (int e = 0; e < 16; ++e) acc[e] = 0.f;
#pragma unroll
        for (int ks = 0; ks < 4; ++ks) { const h16x8 kf = *(const LAS h16x8*)(ldsK + kbase[ks] + kb * 4096); acc = __builtin_amdgcn_mfma_f32_32x32x16_f16(kf, qf[ks], acc, 0, 0, 0); }
        const int lim = (kb == wave) ? r32 : 64;
#pragma unroll
        for (int e = 0; e < 16; ++e) { const int key = (e & 3) + 8 * (e >> 2) + 4 * hi; const float pv = (key <= lim) ? __builtin_amdgcn_exp2f(acc[e] - m) : 0.f; acc[e] = pv; ls += pv; }
#pragma unroll
        for (int s2 = 0; s2 < 2; ++s2) {
            h16x8 pa;
#pragma unroll
            for (int j = 0; j < 8; ++j) pa[j] = (h16)acc[8 * s2 + j];
#pragma unroll
            for (int d0 = 0; d0 < 2; ++d0) {
                const h16x4 lo = tr16(ldsV + vbase[d0] + kb * 4096 + s2 * 2048), hi4 = tr16(ldsV + vbase[d0] + kb * 4096 + s2 * 2048 + 1024);
                const h16x8 bf = (h16x8){lo[0], lo[1], lo[2], lo[3], hi4[0], hi4[1], hi4[2], hi4[3]};
                o[d0] = __builtin_amdgcn_mfma_f32_32x32x16_f16(pa, bf, o[d0], 0, 0, 0);
            }
        }
    }
    ls += __shfl_xor(ls, 32);
    m_out = m; l_out = ls;
}
__device__ __forceinline__ void load_kv_block(LAS unsigned char* lds, const GAS h16* proj, size_t row0, int h, int tid) {
#pragma unroll
    for (int i = 0; i < 4; ++i) { const int idx = tid + 512 * i, key = idx >> 3, c8 = idx & 7; const GAS h16* rp = proj + (row0 + key) * INW + h * 64 + 8 * c8;
        const u32x4 kv = *(const GAS u32x4*)(rp + PK), vv = *(const GAS u32x4*)(rp + PV);
        *(LAS u32x4*)(lds + AL_K + k_off(key, c8)) = kv; *(LAS u32x4*)(lds + AL_V + vt_off(key, c8)) = vv; }
}
__device__ __forceinline__ void stage_o(LAS unsigned char* stg, LAS float* wsf, const f32x16 (&o)[2], float l, int lane) {
    const int r32 = lane & 31, hi = lane >> 5;
    if (hi == 0) wsf[r32] = 1.f / l;
    LDS_WAIT();
#pragma unroll
    for (int e = 0; e < 16; ++e) { const int qr = (e & 3) + 8 * (e >> 2) + 4 * hi; const float rl = wsf[qr];
        *(LAS h16*)(stg + qr * 128 + r32 * 2) = (h16)(o[0][e] * rl); *(LAS h16*)(stg + qr * 128 + 64 + r32 * 2) = (h16)(o[1][e] * rl); }
    LDS_WAIT();
}

__device__ __forceinline__ void moba_b_phase(const Frame& F0, GAS float* dout) {
    const int tid = threadIdx.x, lane = tid & 63, wave = __builtin_amdgcn_readfirstlane(tid >> 6), r32 = lane & 31, hi = lane >> 5;
    const GAS h16* proj = (const GAS h16*)(F0.ws + WS_PROJ); const unsigned* cnt = F0.ctl + CW_CNT; const GAS unsigned short* lists = (const GAS unsigned short*)(F0.ws + WS_LISTS);
    GAS h16* PO = (GAS h16*)((unsigned char*)dout + DO_PO); GAS float* PML = (GAS float*)((unsigned char*)dout + DO_PML);
    LAS unsigned char* lds = F0.lds;
    LAS int* start = (LAS int*)(lds + AL_START);
    LAS float* wsf = (LAS float*)(lds + AL_WSF + wave * 512); LAS int* wsi = (LAS int*)(lds + AL_WSF + wave * 512 + 256);
    LAS unsigned char* stg = lds + AL_STG + wave * 4096;
    {
        const unsigned c0 = cnt[2 * tid], c1 = cnt[2 * tid + 1];
        const int t0 = (int)((c0 + 255u) >> 8), t1 = (int)((c1 + 255u) >> 8);
        int v = t0 + t1, inc = v;
#pragma unroll
        for (int o = 1; o < 64; o <<= 1) { const int u = __shfl_up(inc, o); if (lane >= o) inc += u; }
        LAS int* wtot = (LAS int*)(lds + AL_WSF);
        __syncthreads();
        if (lane == 63) wtot[wave] = inc;
        __syncthreads();
        int pre = 0;
        for (int w = 0; w < wave; ++w) pre += wtot[w];
        const int ex = pre + inc - v;
        __syncthreads();
        start[2 * tid] = ex; start[2 * tid + 1] = ex + t0;
        if (tid == 511) start[1024] = ex + v;
        __syncthreads();
    }
    const int nitems = start[1024];
    for (int item = F0.vcu; item < nitems; item += F0.G) {
        int lo = 0, hi_ = 1024;
        while (hi_ - lo > 1) { const int mid = (lo + hi_) >> 1; if (start[mid] <= item) lo = mid; else hi_ = mid; }
        const int l = lo, chunk = item - start[l];
        const int bh = l >> 5, n = l & 31, b = bh >> 3, h = bh & 7;
        const int nq = (int)cnt[l] - chunk * 256;
        load_kv_block(lds, proj, (size_t)b * S + (size_t)n * MBLK, h, tid);
        const int qi = chunk * 256 + wave * 32 + r32;
        const bool valid = (wave * 32 + r32) < nq;
        const unsigned ent = lists[(size_t)l * LISTCAP + (valid ? qi : chunk * 256)];
        const int sq = ent & 8191, rank = ent >> 13;
        h16x8 qf[4];
        { const GAS h16* qp = proj + (size_t)(b * S + sq) * INW + PQ + h * 64 + 8 * hi;
#pragma unroll
          for (int ks = 0; ks < 4; ++ks) qf[ks] = *(const GAS h16x8*)(qp + 16 * ks); }
        __syncthreads();
        if (wave * 32 < nq) {
            f32x16 o[2]; float m, lsum;
            attn_tile<false>(lds + AL_K, lds + AL_V, qf, wave, lane, o, m, lsum);
            const int slot = ((b * S + sq) * NH + h) * 3 + rank;
            if (hi == 0) { wsi[r32] = valid ? slot : -1; if (valid) { PML[(size_t)slot * 2] = m; PML[(size_t)slot * 2 + 1] = lsum; } }
            stage_o(stg, wsf, o, lsum, lane);
#pragma unroll
            for (int i = 0; i < 4; ++i) { const int row = i * 8 + (lane >> 3), ch = lane & 7; const int sl = wsi[row];
                if (sl >= 0) *(GAS u32x4*)(PO + (size_t)sl * 64 + ch * 8) = *(const LAS u32x4*)(stg + row * 128 + ch * 16); }
        }
        __syncthreads();
    }
}

__device__ __forceinline__ void moba_c_phase(const Frame& F0, const GAS float* dout, int shadow) {
    const int tid = threadIdx.x, lane = tid & 63, wave = __builtin_amdgcn_readfirstlane(tid >> 6), r32 = lane & 31, hi = lane >> 5;
    GAS h16* proj = (GAS h16*)(F0.ws + WS_PROJ); GAS float* SSQA = (GAS float*)(F0.ws + WS_SSQA);
    const GAS h16* PO = (const GAS h16*)((const unsigned char*)dout + DO_PO); const GAS float* PML = (const GAS float*)((const unsigned char*)dout + DO_PML);
    LAS unsigned char* lds = F0.lds;
    LAS float* wsf = (LAS float*)(lds + AL_WSF + wave * 512);
    LAS unsigned char* stg = lds + AL_STG + wave * 4096;
    for (int unit = F0.vcu; unit < NB * NH * NBLK; unit += F0.G) {
        const int qb = unit & 31, bh = unit >> 5, b = bh >> 3, h = bh & 7;
        const size_t row0 = (size_t)b * S + (size_t)qb * MBLK;
        load_kv_block(lds, proj, row0, h, tid);
        h16x8 qf[4];
        { const GAS h16* qp = proj + (row0 + wave * 32 + r32) * INW + PQ + h * 64 + 8 * hi;
#pragma unroll
          for (int ks = 0; ks < 4; ++ks) qf[ks] = *(const GAS h16x8*)(qp + 16 * ks); }
        __syncthreads();
        f32x16 o[2]; float m, lsum;
        attn_tile_causal(lds + AL_K, lds + AL_V, qf, wave, lane, o, m, lsum);
        if (hi == 0) { wsf[32 + r32] = m; wsf[64 + r32] = lsum; }
        stage_o(stg, wsf, o, lsum, lane);
        const int nsel = qb < 3 ? qb : 3;
#pragma unroll
        for (int i = 0; i < 4; ++i) {
            const int row = i * 8 + (lane >> 3), ch = lane & 7;
            const size_t grow = row0 + wave * 32 + row;
            const float mo = wsf[32 + row], lo_ = wsf[64 + row];
            const h16x8 ov = *(const LAS h16x8*)(stg + row * 128 + ch * 16);
            float mr[3], lr[3]; h16x8 pv[3];
            float mmax = mo;
#pragma unroll
            for (int r = 0; r < 3; ++r) { if (r < nsel) { const size_t sl = (grow * NH + h) * 3 + r; mr[r] = PML[sl * 2]; lr[r] = PML[sl * 2 + 1]; pv[r] = *(const GAS h16x8*)(PO + sl * 64 + ch * 8); mmax = fmaxf(mmax, mr[r]); } }
            float wo = lo_ * __builtin_amdgcn_exp2f(mo - mmax), L = wo;
            float acc[8];
#pragma unroll
            for (int e = 0; e < 8; ++e) acc[e] = wo * (float)ov[e];
#pragma unroll
            for (int r = 0; r < 3; ++r) { if (r < nsel) { const float wr_ = lr[r] * __builtin_amdgcn_exp2f(mr[r] - mmax); L += wr_;
#pragma unroll
                for (int e = 0; e < 8; ++e) acc[e] += wr_ * (float)pv[r][e]; } }
            const float rL = 1.f / L; float q = 0.f; u32x4 w;
#pragma unroll
            for (int e = 0; e < 8; ++e) { acc[e] *= rL; q += acc[e] * acc[e]; }
            w[0] = pkh(acc[0], acc[1]); w[1] = pkh(acc[2], acc[3]); w[2] = pkh(acc[4], acc[5]); w[3] = pkh(acc[6], acc[7]);
            if (shadow) *(GAS u32x4*)((GAS h16*)(F0.ws + WS_HG) + grow * 512 + h * 64 + ch * 8) = w;
            else *(GAS u32x4*)(proj + grow * INW + PQ + h * 64 + ch * 8) = w;
            q += __shfl_xor(q, 1); q += __shfl_xor(q, 2); q += __shfl_xor(q, 4);
            if (ch == 0) SSQA[grow * 8 + h] = q;
        }
        __syncthreads();
    }
}

enum Phase { PH_P0 = 0, PH_P1, PH_G1A, PH_G1B, PH_INPROJ, PH_MIX_A, PH_MIX_B, PH_MIX_C, PH_OUTPROJ, PH_G2A, PH_G2B, PH_FINAL, PH_COUNT };
__global__ void __launch_bounds__(NWAVES * 64, 2) mega_fwd(Args args) {
    extern __shared__ __attribute__((aligned(16))) unsigned char lds[];
    Frame F;
    F.lds = (LAS unsigned char*)lds; F.MISC = (volatile LAS unsigned*)(F.lds + MISC_OFF);
    F.tid = threadIdx.x; F.lane = F.tid & 63; F.wave = __builtin_amdgcn_readfirstlane(F.tid >> 6);
    F.G = gridDim.x; { const int bx = blockIdx.x; F.vcu = (F.G % 8 == 0) ? (bx % 8) * (F.G / 8) + bx / 8 : bx; }
    F.ws = args.ws; F.out = (GAS float*)args.out; F.ctl = (unsigned*)(args.ws + WS_CTL);
    for (int u = F.tid; u < (LDS_BYTES - LDSCTL_OFF) / 4; u += NWAVES * 64) ((LAS unsigned*)(F.lds + LDSCTL_OFF))[u] = 0u;
    __syncthreads();
    XcdBarrier bar; bar.bar = F.ctl + CW_BAR; bar.x = 0; bar.st = nullptr;
    const int lo = args.ph_lo, hi = args.ph_hi;
    if (hi - lo > 1) bar = xcd_barrier_post(F.ctl + CW_BAR, F.MISC + 8);
#ifndef MK_PHASE_MASK
#define MK_PHASE_MASK 0xFFFF
#endif
#define IN(k) (((MK_PHASE_MASK >> (k)) & 1) && lo <= (k) && (k) < hi)
#define SEAM(k) do { if (IN(k) && IN((k) + 1)) xcd_barrier(bar); } while (0)
#define PHASE_PTRS() unsigned char* ws = args.ws; asm volatile("" : "+s"(ws)); const GAS float* GT = (const GAS float*)(ws + WS_GT); const GAS float* GP = (const GAS float*)(ws + WS_GP); (void)GT; (void)GP; F.ws = ws
    if (IN(PH_P0)) { PHASE_PTRS(); p0_prologue(F, args); SEAM(PH_P0); }
    if (IN(PH_P1)) { PHASE_PTRS(); p1_prep(F, args); SEAM(PH_P1); }
    if (IN(PH_G1A)) {
        PHASE_PTRS();
        pg8::Gemm g{(const GAS h16*)(ws + WS_HG), (const GAS h16*)(ws + WS_WGU1), D, NGU, D}; pg8::StaticOrder So; So.init(M, NGU, F.G, (int)blockIdx.x);
#if MK_SHADOW == 1
        if (args.ph_lo == PH_G1A && args.ph_hi == PH_G1A + 1 && args.shadow) { EpiNull En; pg8::gemm_phase<EpiNull, true, MK_GPROBE>(F.lds, g, So, En); return; }
#endif
        EpiSwiglu<false> E{(GAS h16*)(ws + WS_ACT), (const GAS float*)(ws + WS_R1), (const GAS float*)(ws + WS_BIAS1)};
        pg8::gemm_phase<EpiSwiglu<false>, true>(F.lds, g, So, E); SEAM(PH_G1A);
    }
    if (IN(PH_G1B)) {
        PHASE_PTRS();
        pg8::Gemm g{(const GAS h16*)(ws + WS_ACT), (const GAS h16*)(ws + WS_WD1), DFF, D, DFF}; pg8::StaticOrder So; So.init(M, D, F.G, (int)blockIdx.x);
        EpiResid<true, false, true> E{GIN(args, 0), (GAS h16*)(ws + WS_H), (GAS h16*)(ws + WS_HG), GT + 0 * 4 * D, GP + 1 * 4 * D, (GAS float*)(ws + WS_SSQ2), nullptr, 0.5f};
        pg8::gemm_phase<EpiResid<true, false, true>, true>(F.lds, g, So, E); SEAM(PH_G1B);
    }
    if (IN(PH_INPROJ)) {
        PHASE_PTRS();
        pg8::Gemm g{(const GAS h16*)(ws + WS_HG), (const GAS h16*)(ws + WS_WIN), D, INW, D}; pg8::StaticOrder So; So.init(M, INW, F.G, (int)blockIdx.x);
        EpiInproj E{(GAS h16*)(ws + WS_PROJ), (const GAS float*)(ws + WS_SSQ2), (const GAS float*)(ws + WS_BIAS2), (const GAS float*)(ws + WS_ROPE), (GAS float*)(ws + WS_KMP)};
        pg8::gemm_phase<EpiInproj, true>(F.lds, g, So, E); SEAM(PH_INPROJ);
    }
    if (IN(PH_MIX_A)) { PHASE_PTRS(); if (!(args.shadow & 2)) gmlp_phase(F, args, args.shadow & 1); if (!(args.shadow & 4)) moba_gate_phase(F, args.shadow & 1); SEAM(PH_MIX_A); }
    if (IN(PH_MIX_B)) { PHASE_PTRS(); moba_b_phase(F, (GAS float*)args.out); SEAM(PH_MIX_B); }
    if (IN(PH_MIX_C)) { PHASE_PTRS(); moba_c_phase(F, (const GAS float*)args.out, args.shadow & 1); SEAM(PH_MIX_C); }
    if (IN(PH_OUTPROJ)) {
        PHASE_PTRS();
        pg8::Gemm g{(const GAS h16*)(ws + WS_PROJ), (const GAS h16*)(ws + WS_WOUT), INW, D, D}; pg8::StaticOrder So; So.init(M, D, F.G, (int)blockIdx.x);
        const LAS float* sct = (const LAS float*)(F.lds + MISC_OFF + 128);
        {   LAS float* t = (LAS float*)(F.lds + MISC_OFF + 128); const GAS float* ssqa = (const GAS float*)(ws + WS_SSQA); const GAS float* ssqg = (const GAS float*)(ws + WS_RG);
            pg8::Unit uu;
            for (int i = 0; i < 4 && So.next(i, uu); ++i)
                if (F.tid < 256) { const int row = uu.pm * 256 + F.tid; const f32x4 a = *(const GAS f32x4*)(ssqa + (size_t)row * 8), bq = *(const GAS f32x4*)(ssqa + (size_t)row * 8 + 4);
                    const float ra = rsqrtf((((a[0] + a[1]) + (a[2] + a[3])) + ((bq[0] + bq[1]) + (bq[2] + bq[3]))) * (1.f / 512.f) + EPS), rg = rsqrtf(ssqg[row] * (1.f / 512.f) + EPS);
                    t[i * 512 + F.tid] = ra / rg; t[i * 512 + 256 + F.tid] = rg; }
            __syncthreads(); }
        EpiResid<false, true, true> E{nullptr, (GAS h16*)(ws + WS_H), (GAS h16*)(ws + WS_HG), GT + 1 * 4 * D, GP + 2 * 4 * D, (GAS float*)(ws + WS_SSQ3), sct, 1.0f};
        pg8::gemm_phase<EpiResid<false, true, true>, true>(F.lds, g, So, E); SEAM(PH_OUTPROJ);
    }
    if (IN(PH_G2A)) {
        PHASE_PTRS();
        pg8::Gemm g{(const GAS h16*)(ws + WS_HG), (const GAS h16*)(ws + WS_WGU2), D, NGU, D}; pg8::StaticOrder So; So.init(M, NGU, F.G, (int)blockIdx.x);
        EpiSwiglu<true> E{(GAS h16*)(ws + WS_ACT), (const GAS float*)(ws + WS_SSQ3), (const GAS float*)(ws + WS_BIAS3)};
        pg8::gemm_phase<EpiSwiglu<true>, true>(F.lds, g, So, E); SEAM(PH_G2A);
    }
    if (IN(PH_G2B)) {
        PHASE_PTRS();
        pg8::Gemm g{(const GAS h16*)(ws + WS_ACT), (const GAS h16*)(ws + WS_WD2), DFF, D, DFF}; pg8::StaticOrder So; So.init(M, D, F.G, (int)blockIdx.x);
        EpiResid<false, false, false> E{nullptr, (GAS h16*)(ws + WS_H), nullptr, GT + 2 * 4 * D, nullptr, (GAS float*)(ws + WS_SSQF), nullptr, 0.5f};
        pg8::gemm_phase<EpiResid<false, false, false>, true>(F.lds, g, So, E); SEAM(PH_G2B);
    }
    if (IN(PH_FINAL)) { PHASE_PTRS(); p_final(F, args); }
#undef IN
#undef SEAM
}

extern "C" void kernel_launch(void* const* d_in, const int* in_sizes, int n_in, void* d_out, int out_size, void* d_ws, size_t ws_size, hipStream_t stream) {
    static int grid = 0;
    if (grid == 0) {
        if (n_in != 20 || out_size != M * D || ws_size < WS_END) { fprintf(stderr, "kernel_launch: unexpected shapes (n_in %d out %d ws %zu)\n", n_in, out_size, ws_size); grid = -1; return; }
        int dev = 0, cus = 0, per_cu = 0;
        hipGetDevice(&dev); hipDeviceGetAttribute(&cus, hipDeviceAttributeMultiprocessorCount, dev);
        if (hipFuncSetAttribute((const void*)mega_fwd, hipFuncAttributeMaxDynamicSharedMemorySize, LDS_BYTES) != hipSuccess) { fprintf(stderr, "kernel_launch: hipFuncSetAttribute failed\n"); grid = -1; return; }
        hipOccupancyMaxActiveBlocksPerMultiprocessor(&per_cu, (const void*)mega_fwd, NWAVES * 64, LDS_BYTES);
        (void)hipGetLastError();
        if (per_cu < 1) { fprintf(stderr, "kernel_launch: occupancy query says %d blocks/CU; nothing launched\n", per_cu); grid = -1; return; }
        grid = cus;
    }
    if (grid < 0) return;
    hipMemsetAsync((char*)d_ws + WS_CTL, 0, CTL_ZERO_BYTES, stream);
    Args a{};
    for (int i = 0; i < 20; ++i) a.in[i] = (const float*)d_in[i];
    a.out = (float*)d_out; a.ws = (unsigned char*)d_ws;
    unsigned char* ws = (unsigned char*)d_ws;
    auto run = [&](int lo, int hi) {
#if MK_PER_PHASE
        for (int p = lo; p < hi; ++p) {
            if (MK_SHADOW == 2 && p == PH_MIX_A) { a.ph_lo = p; a.ph_hi = p + 1; a.shadow = 1 | 4; hipLaunchKernelGGL(mega_fwd, dim3(grid), dim3(NWAVES * 64), LDS_BYTES, stream, a); a.shadow = 0; }
            if (MK_SHADOW == 3 && p == PH_MIX_A) { a.ph_lo = p; a.ph_hi = p + 1; a.shadow = 1 | 2; hipLaunchKernelGGL(mega_fwd, dim3(grid), dim3(NWAVES * 64), LDS_BYTES, stream, a); a.shadow = 0; }
            if (MK_SHADOW == 4 && p == PH_MIX_C) { a.ph_lo = p; a.ph_hi = p + 1; a.shadow = 1; hipLaunchKernelGGL(mega_fwd, dim3(grid), dim3(NWAVES * 64), LDS_BYTES, stream, a); a.shadow = 0; }
            if (MK_SHADOW == 1 && p == PH_G1A) { a.ph_lo = p; a.ph_hi = p + 1; a.shadow = 1; hipLaunchKernelGGL(mega_fwd, dim3(grid), dim3(NWAVES * 64), LDS_BYTES, stream, a); a.shadow = 0; }
            for (int rep = 0; rep < ((((MK_DUP_MASK) >> p) & 1) ? 2 : 1); ++rep) { a.ph_lo = p; a.ph_hi = p + 1; hipLaunchKernelGGL(mega_fwd, dim3(grid), dim3(NWAVES * 64), LDS_BYTES, stream, a); }
        }
#else
        a.ph_lo = lo; a.ph_hi = hi;
        void* kargs[] = {(void*)&a};
        hipError_t e = hipLaunchCooperativeKernel((const void*)mega_fwd, dim3(grid), dim3(NWAVES * 64), kargs, LDS_BYTES, stream);
        if (e != hipSuccess) fprintf(stderr, "kernel_launch: cooperative launch failed: %s (grid %d)\n", hipGetErrorString(e), grid);
#endif
    };
    run(PH_P0, PH_COUNT);
}
```

```cpp
#include <hip/hip_runtime.h>
#include <cstdio>
#include <cstdint>

#ifndef MK_DUP_MASK
#define MK_DUP_MASK 0
#endif
#ifndef MK_GPROBE
#define MK_GPROBE 0
#endif
#ifndef MK_SHADOW
#define MK_SHADOW 0
#endif
#ifndef MK_PER_PHASE
#define MK_PER_PHASE 0
#endif

#define GAS __attribute__((address_space(1)))
#define LAS __attribute__((address_space(3)))
typedef _Float16 h16;
typedef _Float16 h16x8 __attribute__((ext_vector_type(8)));
typedef _Float16 h16x4 __attribute__((ext_vector_type(4)));
typedef _Float16 h16x2 __attribute__((ext_vector_type(2)));
typedef float f32x4 __attribute__((ext_vector_type(4)));
typedef float f32x2 __attribute__((ext_vector_type(2)));
typedef unsigned u32x4 __attribute__((ext_vector_type(4)));
typedef unsigned u32x2 __attribute__((ext_vector_type(2)));

constexpr int D = 1024, NB = 4, S = 8192, M = NB * S, DFF = 2816, NGU = 2 * DFF, NMOD = 9;
constexpr int AW = 512, HD = 64, NH = 8, INW = 2560, MBLK = 256, NBLK = S / MBLK, GC = 128;
constexpr float EPS = 1e-6f;
constexpr float C2 = 0.125f * 1.4426950408889634f;
constexpr int PQ = 0, PU = 512, PK = 1024, PV = 1536, PG = 2048;

constexpr size_t MiB = 1u << 20, KiB = 1u << 10;
constexpr size_t WS_CTL = 0, CTL_ZERO_BYTES = 1 * MiB;
constexpr size_t WS_MODP = 1 * MiB;
constexpr size_t WS_GT = 2 * MiB, WS_GP = WS_GT + 64 * KiB;
constexpr size_t WS_BIAS1 = WS_GT + 128 * KiB, WS_BIAS2 = WS_GT + 256 * KiB, WS_BIAS3 = WS_GT + 320 * KiB;
constexpr size_t WS_R1 = 3 * MiB, WS_RG = WS_R1 + 128 * KiB;
constexpr size_t WS_SSQA = 4 * MiB;
constexpr size_t WS_SSQ2 = 5 * MiB, WS_SSQ3 = 7 * MiB, WS_SSQF = 9 * MiB;
constexpr size_t WS_KMP = 11 * MiB;
constexpr size_t WS_ROPE = 12 * MiB;
constexpr size_t WS_WS16 = 14 * MiB;
constexpr size_t WS_WGU1 = 16 * MiB, WS_WD1 = 27 * MiB, WS_WIN = 33 * MiB, WS_WOUT = 38 * MiB, WS_WGU2 = 40 * MiB, WS_WD2 = 51 * MiB;
constexpr size_t WS_HG = 64 * MiB, WS_H = 128 * MiB, WS_ACT = 192 * MiB, WS_PROJ = WS_ACT;
constexpr size_t WS_LISTS = 368 * MiB, WS_END = 384 * MiB;
static_assert(WS_WD2 + (size_t)D * DFF * 2 <= WS_HG && WS_ACT + (size_t)M * DFF * 2 <= WS_LISTS, "ws map");
constexpr int CW_TMO = 0, CW_BAR = 4096;

constexpr int RING_BYTES = 131072, LDSCTL_OFF = RING_BYTES, MISC_OFF = LDSCTL_OFF + 320, LDS_BYTES = 147456;
constexpr int NWAVES = 8;

#define LDS_WAIT() asm volatile("s_waitcnt lgkmcnt(0)" ::: "memory")
#define VM_WAIT() asm volatile("s_waitcnt vmcnt(0)" ::: "memory")

__device__ __forceinline__ float wave_sum(float v) {
#pragma unroll
    for (int o = 1; o < 64; o <<= 1) v += __shfl_xor(v, o);
    return v;
}
__device__ __forceinline__ unsigned pkh(float lo, float hi) { h16x2 v; v.x = (h16)lo; v.y = (h16)hi; return __builtin_bit_cast(unsigned, v); }
__device__ __forceinline__ float silu_fast(float x) { return x * __builtin_amdgcn_rcpf(1.f + __builtin_amdgcn_exp2f(-1.4426950408889634f * x)); }
__device__ __forceinline__ float gelu_fast(float x) {
    const float u2 = 1.5957691216057308f * (x + 0.044715f * x * x * x);
    return x * __builtin_amdgcn_rcpf(1.f + __builtin_amdgcn_exp2f(-1.4426950408889634f * u2));
}
__device__ __forceinline__ float rs16(const GAS float* p) {
    const f32x4 s0 = *(const GAS f32x4*)(p), s1 = *(const GAS f32x4*)(p + 4), s2 = *(const GAS f32x4*)(p + 8), s3 = *(const GAS f32x4*)(p + 12);
    const f32x4 st = (s0 + s1) + (s2 + s3);
    return rsqrtf(((st[0] + st[1]) + (st[2] + st[3])) * (1.f / D) + EPS);
}


__device__ __forceinline__ size_t blk_off(int row, int k, int nt) { return (((size_t)(row >> 8) * nt + (k >> 6)) * 256 + (row & 255)) * 64 + (k & 63); }

namespace pg8 {
constexpr int BM = 256, BK = 64, HALF = 128, HTB = HALF * BK * 2, STAGE_BYTES = 8 * HTB, NXCD = 8, WGM = 8;
__host__ __device__ __forceinline__ int lds_byte(int r, int c) { const int st = (r >> 4) * 2 + (c >> 5), rr = r & 15, cc = c & 31, ob = rr * 64 + cc * 2; return st * 1024 + (ob ^ (((ob >> 9) & 1) << 5)); }
__host__ __device__ __forceinline__ void stage_rc(int b, int& R, int& C) { const int st = b / 1024, sb = b % 1024, swz = sb ^ (((sb >> 9) & 1) << 5); R = (st >> 1) * 16 + swz / 64; C = (st & 1) * 32 + (swz % 64) / 2; }
struct Unit { int pm, pn; };
struct Gemm { const GAS h16* A; const GAS h16* Bt; int lda, N, K; };
struct StaticOrder {
    int nM, nN, nwg, G, c;
    __device__ void init(int M_, int N, int G_, int c_) { nM = M_ / BM; nN = N / BM; nwg = nM * nN; G = G_; c = c_; }
    __device__ bool next(int i, Unit& u) const {
        const long L = (long)i * G + c; if (L >= nwg) return false;
        int wgid = (int)L; { const int q = nwg / NXCD, r = nwg % NXCD, xcd = wgid % NXCD, off = wgid / NXCD; wgid = (xcd < r ? xcd * (q + 1) : r * (q + 1) + (xcd - r) * q) + off; }
        const int nig = WGM * nN, gid = wgid / nig, fm = gid * WGM, gsz = (nM - fm) < WGM ? (nM - fm) : WGM;
        u.pm = fm + ((wgid % nig) % gsz); u.pn = (wgid % nig) / gsz; return true;
    }
};
template <class Epi, bool ALIGN_EPI, int PROBE = 0>
__device__ __forceinline__ void gemm_phase(LAS unsigned char* lds, const Gemm g, const StaticOrder& S, const Epi& E) {
    const int tid = threadIdx.x, wid = __builtin_amdgcn_readfirstlane(tid >> 6), lane = tid & 63, wr = wid >> 2, wc = wid & 3, fr = lane & 15, fq = lane >> 4;
    const int K = g.K, nt = K / BK;
    unsigned voffA[2], voffB[2];
    const bool ablk = (g.lda == 0);
#pragma unroll
    for (int i = 0; i < 2; ++i) { int R, C; stage_rc(tid * 16 + i * 8192, R, C); voffA[i] = (unsigned)(R * (ablk ? BK : g.lda) + C) * 2u; voffB[i] = (unsigned)(R * BK + C) * 2u; }
    const size_t kstepB = (size_t)BM * BK * 2, kstepA = ablk ? kstepB : (size_t)(BK * 2);
    const size_t hstepB = (size_t)HALF * BK * 2, hstepA = ablk ? hstepB : (size_t)HALF * g.lda * 2;
    const size_t tstepB = (size_t)nt * kstepB, tstepA = ablk ? tstepB : 2 * hstepA;
    const unsigned ldsw = (unsigned)wid * 1024u;
    const int aoff = lds_byte(wr * 64 + fr, fq * 8), boff = lds_byte(wc * 32 + fr, fq * 8);
#define PG8_SA(b, h) (((b) * 2 + (h)) * HTB)
#define PG8_SB(b, h) ((4 + (b) * 2 + (h)) * HTB)
#define PG8_STAGE(bufoff, gbase, voff) do { if (PROBE != 2) _Pragma("unroll") for (int _i = 0; _i < 2; ++_i) \
        __builtin_amdgcn_global_load_lds((const unsigned*)((const char*)(gbase) + (voff)[_i]), (LAS unsigned*)(lds + (bufoff) + ldsw + _i * 8192), 16, 0, 0); } while (0)
#define PG8_LDA(dst, b, h) do { _Pragma("unroll") for (int m = 0; m < 4; ++m) _Pragma("unroll") for (int k = 0; k < 2; ++k) dst[m][k] = *(const LAS h16x8*)(lds + PG8_SA(b, h) + aoff + m * 2048 + k * 1024); } while (0)
#define PG8_LDB(dst, b, h) do { _Pragma("unroll") for (int n = 0; n < 2; ++n) _Pragma("unroll") for (int k = 0; k < 2; ++k) dst[n][k] = *(const LAS h16x8*)(lds + PG8_SB(b, h) + boff + n * 2048 + k * 1024); } while (0)
#define PG8_MMA(ai, bj, At, Bt) do { if (PROBE == 1 && (bj) == 1) break; __builtin_amdgcn_s_setprio(1); _Pragma("unroll") for (int m = 0; m < 4; ++m) _Pragma("unroll") for (int n = 0; n < 2; ++n) _Pragma("unroll") for (int k = 0; k < 2; ++k) \
        acc[ai][bj][m][n] = __builtin_amdgcn_mfma_f32_16x16x32_f16(Bt[n][k], At[m][k], acc[ai][bj][m][n], 0, 0, 0); __builtin_amdgcn_s_setprio(0); } while (0)
#define PG8_WAIT_V(n) asm volatile("s_waitcnt vmcnt(" #n ")" ::: "memory")
#define PG8_WAIT_L(n) asm volatile("s_waitcnt lgkmcnt(" #n ")" ::: "memory")
#define PG8_BAR __builtin_amdgcn_s_barrier()
#define PG8_SCHED __builtin_amdgcn_sched_barrier(0)
    Unit cur, nxt; int ui = 0;
    if (!S.next(0, cur)) return;
    f32x4 acc[2][2][4][2];
#pragma unroll
    for (int a = 0; a < 2; ++a)
#pragma unroll
        for (int b = 0; b < 2; ++b)
#pragma unroll
            for (int m = 0; m < 4; ++m)
#pragma unroll
                for (int n = 0; n < 2; ++n) acc[a][b][m][n] = (f32x4){0.f, 0.f, 0.f, 0.f};
    h16x8 At[4][2], B0[2][2], B1[2][2];
    const char* cA = (const char*)g.A + (size_t)cur.pm * tstepA; const char* cB = (const char*)g.Bt + (size_t)cur.pn * tstepB;
    PG8_STAGE(PG8_SB(0, 0), cB, voffB); PG8_STAGE(PG8_SB(0, 1), cB + hstepB, voffB); PG8_STAGE(PG8_SA(0, 0), cA, voffA); PG8_STAGE(PG8_SA(0, 1), cA + hstepA, voffA);
    if (wr == 1) PG8_BAR;
    PG8_WAIT_V(2); PG8_BAR;
    PG8_STAGE(PG8_SB(1, 0), cB + kstepB, voffB); PG8_STAGE(PG8_SA(1, 0), cA + kstepA, voffA); PG8_STAGE(PG8_SB(1, 1), cB + hstepB + kstepB, voffB);
    PG8_WAIT_V(6); PG8_BAR;
    for (;;) {
        const bool has_next = S.next(ui + 1, nxt);
        const char* nA = has_next ? (const char*)g.A + (size_t)nxt.pm * tstepA : cA; const char* nB = has_next ? (const char*)g.Bt + (size_t)nxt.pn * tstepB : cB;
        for (int t = 0; t < nt; t += 2) {
            const bool last = (t == nt - 2);
            const char* a1 = cA + (size_t)(t + 1) * kstepA;
            const char* a2 = last ? nA : cA + (size_t)(t + 2) * kstepA; const char* b2 = last ? nB : cB + (size_t)(t + 2) * kstepB;
            const char* a3 = a2 + kstepA; const char* b3 = b2 + kstepB;
            if constexpr (Epi::MID) { if (t == nt / 2) E.mid(acc, cur, ui, wr, wc, fr, fq); }
            PG8_LDB(B0, 0, 0); PG8_LDB(B1, 0, 1); PG8_SCHED; PG8_LDA(At, 0, 0); PG8_STAGE(PG8_SA(1, 1), a1 + hstepA, voffA);
            PG8_WAIT_V(8); PG8_WAIT_L(0); PG8_BAR; PG8_MMA(0, 0, At, B0); PG8_MMA(0, 1, At, B1); PG8_BAR; PG8_SCHED;
            PG8_LDA(At, 0, 1); PG8_STAGE(PG8_SB(0, 0), b2, voffB); PG8_STAGE(PG8_SB(0, 1), b2 + hstepB, voffB); PG8_STAGE(PG8_SA(0, 0), a2, voffA);
            PG8_WAIT_V(8); PG8_WAIT_L(0); PG8_BAR; PG8_MMA(1, 0, At, B0); PG8_MMA(1, 1, At, B1); PG8_BAR; PG8_SCHED;
            PG8_LDB(B0, 1, 0); PG8_LDB(B1, 1, 1); PG8_SCHED; PG8_LDA(At, 1, 0); PG8_STAGE(PG8_SA(0, 1), a2 + hstepA, voffA);
            PG8_WAIT_V(8); PG8_WAIT_L(0); PG8_BAR; PG8_MMA(0, 0, At, B0); PG8_MMA(0, 1, At, B1); PG8_BAR; PG8_SCHED;
            PG8_LDA(At, 1, 1); PG8_STAGE(PG8_SB(1, 0), b3, voffB); PG8_STAGE(PG8_SB(1, 1), b3 + hstepB, voffB); PG8_STAGE(PG8_SA(1, 0), a3, voffA);
            PG8_WAIT_V(8); PG8_WAIT_L(0); PG8_BAR; PG8_MMA(1, 0, At, B0); PG8_MMA(1, 1, At, B1); PG8_BAR; PG8_SCHED;
        }
        if constexpr (ALIGN_EPI) { if (wr == 0) PG8_BAR; }
        E(acc, cur, ui, wr, wc, fr, fq);
        if (!has_next) break;
#pragma unroll
        for (int a = 0; a < 2; ++a)
#pragma unroll
            for (int b = 0; b < 2; ++b)
#pragma unroll
                for (int m = 0; m < 4; ++m)
#pragma unroll
                    for (int n = 0; n < 2; ++n) acc[a][b][m][n] = (f32x4){0.f, 0.f, 0.f, 0.f};
        cur = nxt; cA = nA; cB = nB; ++ui;
        if constexpr (ALIGN_EPI) { if (wr == 1) PG8_BAR; }
    }
    PG8_WAIT_V(0);
    if constexpr (!ALIGN_EPI) { if (wr == 0) PG8_BAR; }
    PG8_BAR;
#undef PG8_SA
#undef PG8_SB
#undef PG8_STAGE
#undef PG8_LDA
#undef PG8_LDB
#undef PG8_MMA
#undef PG8_WAIT_V
#undef PG8_WAIT_L
#undef PG8_BAR
#undef PG8_SCHED
}
}

typedef const f32x4 (&AccRef)[2][2][4][2];
struct EpiSwiglu {
    static constexpr bool MID = false;
    GAS h16* act; const LAS float* rtab; const GAS float* bias;
    __device__ __forceinline__ void mid(f32x4 (&)[2][2][4][2], const pg8::Unit&, int, int, int, int, int) const {}
    __device__ __forceinline__ void operator()(AccRef acc, const pg8::Unit& u, int ui, int wr, int wc, int fr, int fq) const {
        const int b = u.pm >> 5, row0 = u.pm * 256 + wr * 64 + fr;
        const GAS float* bp = bias + b * NGU + u.pn * 256 + wc * 32 + 4 * fq;
        f32x4 bv[2][2];
#pragma unroll
        for (int bj = 0; bj < 2; ++bj)
#pragma unroll
            for (int n = 0; n < 2; ++n) bv[bj][n] = *(const GAS f32x4*)(bp + bj * 128 + n * 16);
        const LAS float* rt = rtab + ui * 256 + wr * 64 + fr;
        const int hid0 = u.pn * 128 + wc * 32 + fq * 8;
#pragma unroll
        for (int ai = 0; ai < 2; ++ai)
#pragma unroll
            for (int m = 0; m < 4; ++m) {
                const int ro = ai * 128 + m * 16; const float rs = rt[ro];
                u32x4 w;
#pragma unroll
                for (int n = 0; n < 2; ++n) {
                    const f32x4 gv = acc[ai][0][m][n] * rs + bv[0][n], uv = acc[ai][1][m][n] * rs + bv[1][n];
                    const float a0 = silu_fast(gv[0]) * uv[0], a1 = silu_fast(gv[1]) * uv[1], a2 = silu_fast(gv[2]) * uv[2], a3 = silu_fast(gv[3]) * uv[3];
                    w[2 * n] = pkh(a0, a1); w[2 * n + 1] = pkh(a2, a3);
                }
                *(GAS u32x4*)(act + blk_off(row0 + ro, hid0, DFF / 64)) = w;
            }
    }
};
template <bool RES_F32, bool TWOSCALE, bool WRITE_HG> struct EpiResid {
    static constexpr bool MID = TWOSCALE;
    const GAS float* xres; GAS h16* H; GAS h16* HG; const GAS float* cs; const GAS float* gp; GAS float* ssq; const LAS float* sct; float cmul;
    __device__ __forceinline__ void mid(f32x4 (&acc)[2][2][4][2], const pg8::Unit& u, int ui, int wr, int wc, int fr, int fq) const {
        if constexpr (TWOSCALE) {
            const LAS float* t = sct + ui * 512 + wr * 64 + fr;
#pragma unroll
            for (int ai = 0; ai < 2; ++ai)
#pragma unroll
                for (int m = 0; m < 4; ++m) { const float f = t[ai * 128 + m * 16];
#pragma unroll
                    for (int bj = 0; bj < 2; ++bj)
#pragma unroll
                        for (int n = 0; n < 2; ++n) acc[ai][bj][m][n] *= f; }
        }
    }
    __device__ __forceinline__ void operator()(AccRef acc, const pg8::Unit& u, int ui, int wr, int wc, int fr, int fq) const {
        const int b = u.pm >> 5, row0 = u.pm * 256 + wr * 64 + fr, col0 = u.pn * 256 + wc * 32 + 8 * fq;
        f32x4 csv[2][2], gpv[2][2];
#pragma unroll
        for (int bj = 0; bj < 2; ++bj)
#pragma unroll
            for (int n = 0; n < 2; ++n) { csv[bj][n] = *(const GAS f32x4*)(cs + b * D + col0 + bj * 128 + 4 * n) * cmul; if constexpr (WRITE_HG) gpv[bj][n] = *(const GAS f32x4*)(gp + b * D + col0 + bj * 128 + 4 * n); }
        constexpr int MB_ = RES_F32 ? 2 : 4;
#pragma unroll
        for (int ai = 0; ai < 2; ++ai)
#pragma unroll
        for (int m0 = 0; m0 < 4; m0 += MB_) {
            f32x4 rf[4][2][2]; h16x8 rh[4][2];
#pragma unroll
            for (int m = m0; m < m0 + MB_; ++m)
#pragma unroll
                for (int bj = 0; bj < 2; ++bj) { const size_t off = (size_t)(row0 + ai * 128 + m * 16) * D + col0 + bj * 128;
                    if constexpr (RES_F32) { rf[m][bj][0] = *(const GAS f32x4*)(xres + off); rf[m][bj][1] = *(const GAS f32x4*)(xres + off + 4); }
                    else rh[m][bj] = *(const GAS h16x8*)(H + off); }
            asm volatile("" ::: "memory");
#pragma unroll
            for (int m = m0; m < m0 + MB_; ++m) {
                const int row = row0 + ai * 128 + m * 16; const size_t off = (size_t)row * D + col0;
                float rsc = 1.f; if constexpr (TWOSCALE) rsc = sct[ui * 512 + 256 + wr * 64 + fr + ai * 128 + m * 16];
                float q = 0.f;
#pragma unroll
                for (int bj = 0; bj < 2; ++bj) {
                    f32x4 r0, r1;
                    if constexpr (RES_F32) { r0 = rf[m][bj][0]; r1 = rf[m][bj][1]; }
                    else { const h16x8 hv = rh[m][bj]; r0 = (f32x4){(float)hv[0], (float)hv[1], (float)hv[2], (float)hv[3]}; r1 = (f32x4){(float)hv[4], (float)hv[5], (float)hv[6], (float)hv[7]}; }
                    const f32x4 v0 = r0 + csv[bj][0] * (acc[ai][bj][m][0] * rsc), v1 = r1 + csv[bj][1] * (acc[ai][bj][m][1] * rsc);
                    q += ((v0[0] * v0[0] + v0[1] * v0[1]) + (v0[2] * v0[2] + v0[3] * v0[3])) + ((v1[0] * v1[0] + v1[1] * v1[1]) + (v1[2] * v1[2] + v1[3] * v1[3]));
                    u32x4 w; w[0] = pkh(v0[0], v0[1]); w[1] = pkh(v0[2], v0[3]); w[2] = pkh(v1[0], v1[1]); w[3] = pkh(v1[2], v1[3]);
                    *(GAS u32x4*)(H + off + bj * 128) = w;
                    if constexpr (WRITE_HG) { const f32x4 g0 = v0 * gpv[bj][0], g1 = v1 * gpv[bj][1];
                        u32x4 wg; wg[0] = pkh(g0[0], g0[1]); wg[1] = pkh(g0[2], g0[3]); wg[2] = pkh(g1[0], g1[1]); wg[3] = pkh(g1[2], g1[3]);
                        *(GAS u32x4*)(HG + blk_off(row, col0 + bj * 128, D / 64)) = wg; }
                }
                q += __shfl_xor(q, 16); q += __shfl_xor(q, 32);
                if (fq == 0) ssq[(size_t)row * 16 + u.pn * 4 + wc] = q;
            }
        }
    }
};
struct EpiInproj {
    static constexpr bool MID = false;
    GAS h16* proj; const LAS float* rtab; const GAS float* bias; const GAS float* rope; GAS float* kmp;
    __device__ __forceinline__ void mid(f32x4 (&)[2][2][4][2], const pg8::Unit&, int, int, int, int, int) const {}
    __device__ __forceinline__ void operator()(AccRef acc, const pg8::Unit& u, int ui, int wr, int wc, int fr, int fq) const {
        const int b = u.pm >> 5, row0 = u.pm * 256 + wr * 64 + fr, region = u.pn >> 1;
        const GAS float* bp = bias + b * INW + u.pn * 256 + wc * 32 + 4 * fq;
        f32x4 bv[2][2];
#pragma unroll
        for (int bj = 0; bj < 2; ++bj)
#pragma unroll
            for (int n = 0; n < 2; ++n) bv[bj][n] = *(const GAS f32x4*)(bp + bj * 128 + n * 16);
        const bool is_rope = (region == 0) || (region == 2);
        f32x4 csum[2][2];
#pragma unroll
        for (int bj = 0; bj < 2; ++bj)
#pragma unroll
            for (int n = 0; n < 2; ++n) csum[bj][n] = (f32x4){0.f, 0.f, 0.f, 0.f};
        const LAS float* rt = rtab + ui * 256 + wr * 64 + fr;
#pragma unroll
        for (int ai = 0; ai < 2; ++ai)
#pragma unroll
        for (int m0 = 0; m0 < 4; m0 += 2) {
            f32x4 rcs[4][2], rsn[4][2];
            if (is_rope) {
#pragma unroll
                for (int m = m0; m < m0 + 2; ++m) { const GAS float* rp = rope + (size_t)((row0 + ai * 128 + m * 16) & (S - 1)) * 64 + 4 * fq;
#pragma unroll
                    for (int n = 0; n < 2; ++n) { rcs[m][n] = *(const GAS f32x4*)(rp + 16 * n); rsn[m][n] = *(const GAS f32x4*)(rp + 32 + 16 * n); } }
            }
            asm volatile("" ::: "memory");
#pragma unroll
            for (int m = m0; m < m0 + 2; ++m) {
                const int row = row0 + ai * 128 + m * 16;
                const float rs = rt[ai * 128 + m * 16];
                f32x4 v[2][2];
#pragma unroll
                for (int bj = 0; bj < 2; ++bj)
#pragma unroll
                    for (int n = 0; n < 2; ++n) v[bj][n] = acc[ai][bj][m][n] * rs + bv[bj][n];
                GAS h16* prow = proj + (size_t)row * INW + region * 512 + (u.pn & 1) * 256;
                if (is_rope) {
                    const float qs = (region == 0) ? C2 : 1.f;
#pragma unroll
                    for (int n = 0; n < 2; ++n) {
                        const f32x4 cs4 = rcs[m][n] * qs, sn4 = rsn[m][n] * qs;
                        const f32x4 x1 = v[0][n], x2 = v[1][n];
                        v[0][n] = x1 * cs4 - x2 * sn4; v[1][n] = x2 * cs4 + x1 * sn4;
                    }
                    GAS h16* hp = prow + wc * 64 + 16 * fq;
#pragma unroll
                    for (int bj = 0; bj < 2; ++bj) { u32x4 w; w[0] = pkh(v[bj][0][0], v[bj][0][1]); w[1] = pkh(v[bj][0][2], v[bj][0][3]); w[2] = pkh(v[bj][1][0], v[bj][1][1]); w[3] = pkh(v[bj][1][2], v[bj][1][3]);
                        *(GAS u32x4*)(hp + 8 * bj) = w; }
                    if (region == 2) {
#pragma unroll
                        for (int bj = 0; bj < 2; ++bj)
#pragma unroll
                            for (int n = 0; n < 2; ++n) csum[bj][n] += v[bj][n];
                    }
                } else {
                    if (region == 1 || region == 4) {
#pragma unroll
                        for (int bj = 0; bj < 2; ++bj)
#pragma unroll
                            for (int n = 0; n < 2; ++n)
#pragma unroll
                                for (int j = 0; j < 4; ++j) v[bj][n][j] = gelu_fast(v[bj][n][j]);
                    }
                    GAS h16* hp = prow + wc * 32 + 8 * fq;
#pragma unroll
                    for (int bj = 0; bj < 2; ++bj) { u32x4 w; w[0] = pkh(v[bj][0][0], v[bj][0][1]); w[1] = pkh(v[bj][0][2], v[bj][0][3]); w[2] = pkh(v[bj][1][0], v[bj][1][1]); w[3] = pkh(v[bj][1][2], v[bj][1][3]);
                        *(GAS u32x4*)(hp + 128 * bj) = w; }
                }
            }
        }
        if (region == 2) {
#pragma unroll
            for (int bj = 0; bj < 2; ++bj)
#pragma unroll
                for (int n = 0; n < 2; ++n)
#pragma unroll
                    for (int j = 0; j < 4; ++j) { float t = csum[bj][n][j]; t += __shfl_xor(t, 1); t += __shfl_xor(t, 2); t += __shfl_xor(t, 4); t += __shfl_xor(t, 8); csum[bj][n][j] = t; }
            if (fr == 0) {
                GAS float* kp = kmp + ((size_t)((b * NBLK + (u.pm & 31)) * 2 + wr)) * 512 + ((u.pn & 1) * 4 + wc) * 64 + 16 * fq;
#pragma unroll
                for (int bj = 0; bj < 2; ++bj)
#pragma unroll
                    for (int n = 0; n < 2; ++n) *(GAS f32x4*)(kp + 8 * bj + 4 * n) = csum[bj][n];
            }
        }
    }
};

#define XB_TMO      128
#define XB_XCNT(j)  (256  + 64 * (j))
#define XB_XSUB(j)  (1280 + 64 * (j))
#define XB_XGEN(j)  (2304 + 64 * (j))
#define XB_TOP      3328
#define XB_TOPGEN   3392
#define XCD_BAR_WORDS 3456
#define XB_SPIN_CAP (1u << 18)
__device__ __forceinline__ unsigned xb_ld(unsigned* p)              { return __hip_atomic_load(p, __ATOMIC_RELAXED, __HIP_MEMORY_SCOPE_AGENT); }
__device__ __forceinline__ unsigned xb_add(unsigned* p, unsigned v) { return __hip_atomic_fetch_add(p, v, __ATOMIC_RELAXED, __HIP_MEMORY_SCOPE_AGENT); }
__device__ __forceinline__ unsigned xb_xcc_id() { return (unsigned)__builtin_amdgcn_s_getreg((3 << 11) | 20) & 0xFu; }
#define XB_SPIN(cond, bar) do { unsigned _sp = 0; while (cond) { __builtin_amdgcn_s_sleep(1); \
    if ((++_sp & 255u) == 0u) { if (xb_ld(&(bar)[XB_TMO])) break; if (_sp > XB_SPIN_CAP) { atomicAdd(&(bar)[XB_TMO], 1u); break; } } } } while (0)
struct XcdBarrier { unsigned* bar; unsigned x; volatile LAS unsigned* st; };
__device__ __forceinline__ XcdBarrier xcd_barrier_post(unsigned* bar, volatile LAS unsigned* st) {
    XcdBarrier b; b.bar = bar; b.x = xb_xcc_id(); b.st = st;
    if (threadIdx.x == 0) (void)xb_add(&bar[XB_XCNT(b.x)], 1u);
    return b;
}
__device__ __forceinline__ void xcd_barrier_complete(unsigned* bar, unsigned x, unsigned& nloc, unsigned& nx) {
    const unsigned G = gridDim.x * gridDim.y * gridDim.z;
    unsigned sum, cnt, mine, sp = 0u;
    for (;;) {
        sum = 0u; cnt = 0u; mine = 0u;
#pragma unroll
        for (unsigned j = 0; j < 16; ++j) { const unsigned c = xb_ld(&bar[XB_XCNT(j)]); sum += c; cnt += (c > 0u) ? 1u : 0u; mine = (j == x) ? c : mine; }
        if (sum == G) break;
        __builtin_amdgcn_s_sleep(1);
        if ((++sp & 255u) == 0u) { if (xb_ld(&bar[XB_TMO])) break; if (sp > XB_SPIN_CAP) { atomicAdd(&bar[XB_TMO], 1u); break; } }
    }
    nloc = mine > 0u ? mine : 1u; nx = cnt > 0u ? cnt : 1u;
}
__device__ __forceinline__ void xcd_barrier(const XcdBarrier& b) {
    asm volatile("s_waitcnt vmcnt(0)" ::: "memory");
    __syncthreads();
    if (threadIdx.x == 0) {
        unsigned* bar = b.bar;
        __builtin_amdgcn_s_waitcnt(0);
        unsigned nloc = b.st[0], nx = b.st[1];
        if (nloc == 0u) { xcd_barrier_complete(bar, b.x, nloc, nx); b.st[0] = nloc; b.st[1] = nx; }
        const unsigned old = xb_add(&bar[XB_XSUB(b.x)], 1u);
        const unsigned gen = old / nloc;
        if (old + 1u == (gen + 1u) * nloc) {
            __builtin_amdgcn_fence(__ATOMIC_RELEASE, "agent");
            asm volatile("s_waitcnt vmcnt(0)" ::: "memory");
            const unsigned og = xb_add(&bar[XB_TOP], 1u);
            const unsigned tg = og / nx;
            if (og + 1u == (tg + 1u) * nx) xb_add(&bar[XB_TOPGEN], 1u);
            else XB_SPIN(xb_ld(&bar[XB_TOPGEN]) == tg, bar);
            __builtin_amdgcn_fence(__ATOMIC_ACQUIRE, "agent");
            xb_add(&bar[XB_XGEN(b.x)], 1u);
            asm volatile("s_waitcnt vmcnt(0)" ::: "memory");
        } else {
            XB_SPIN(xb_ld(&bar[XB_XGEN(b.x)]) == gen, bar);
            __builtin_amdgcn_fence(__ATOMIC_ACQUIRE, "agent");
            asm volatile("s_waitcnt vmcnt(0)" ::: "memory");
        }
    }
    __syncthreads();
}

#define GIN(a_, i_) ((const GAS float*)(a_).in[i_])
struct Args { const float* in[20]; float* out; unsigned char* ws; int ph_lo, ph_hi; int shadow, pad; };
struct Frame {
    LAS unsigned char* lds; volatile LAS unsigned* MISC; unsigned* ctl;
    int tid, lane, wave, vcu, G;
    unsigned char* ws; GAS float* out;
};

__device__ __forceinline__ int p8(int l) { return (l & ~31) + 16 * ((l >> 2) & 1) + 4 * ((l >> 3) & 3) + (l & 3); }
__device__ __forceinline__ int phys_gu(int L) { const int isu = L >= DFF, hid = isu ? L - DFF : L, pn = hid >> 7, hh = hid & 127; return 256 * pn + 128 * isu + p8(hh); }
__device__ __forceinline__ int phys_in(int L) {
    const int reg = L >> 9, l = L & 511;
    const int preg = reg == 0 ? 0 : reg == 1 ? 2 : reg == 2 ? 3 : reg == 3 ? 1 : 4;
    if (reg <= 1) { const int head = l >> 6, d = l & 63, bj = d >> 5, i = d & 31; return 512 * preg + 256 * (head >> 2) + 128 * bj + 32 * (head & 3) + i; }
    return 512 * preg + p8(l);
}
enum PhysKind { PH_GU = 0, PH_P8 = 1, PH_IN = 2 };
template <int KIND> __device__ __forceinline__ int physmap(int L) { return KIND == PH_GU ? phys_gu(L) : KIND == PH_P8 ? p8(L) : phys_in(L); }

template <int KIND> __device__ __forceinline__ void p0_transpose_item(const GAS float* W, int K, int N, GAS h16* WT, const GAS float* kscale, LAS float* scr, int item, int lane) {
    const int nblk = N / 32, kb = item / nblk, nb = item % nblk, k0 = 64 * kb, n0 = 32 * nb;
#pragma unroll 8
    for (int i = 0; i < 32; ++i) { const int kk = 2 * i + (lane >> 5); float v = W[(size_t)(k0 + kk) * N + n0 + (lane & 31)]; if (kscale) v *= kscale[k0 + kk]; scr[kk * 33 + (lane & 31)] = v; }
    LDS_WAIT(); asm volatile("" ::: "memory");
    const int c = lane & 7;
#pragma unroll
    for (int j = 0; j < 4; ++j) { const int n = (lane >> 3) + 8 * j; const LAS float* s = scr + (8 * c) * 33 + n;
        u32x4 o; o.x = pkh(s[0 * 33], s[1 * 33]); o.y = pkh(s[2 * 33], s[3 * 33]); o.z = pkh(s[4 * 33], s[5 * 33]); o.w = pkh(s[6 * 33], s[7 * 33]);
        *(GAS u32x4*)(WT + blk_off(physmap<KIND>(n0 + n), k0 + 8 * c, K / 64)) = o; }
    LDS_WAIT(); asm volatile("" ::: "memory");
}

__device__ __forceinline__ void p0_prologue(const Frame& F0, const Args& a) {
    Frame F = F0; F.tid = threadIdx.x; F.lane = F.tid & 63; F.wave = __builtin_amdgcn_readfirstlane(F.tid >> 6);
    const GAS float* c = GIN(a, 1); const GAS float* w_ada = GIN(a, 2);
    {
        LAS float* red = (LAS float*)F.lds;
        for (int item = F.vcu; item < 72 * 4; item += F.G) {
            const int cg = item % 72, kq = item / 72, hlf = F.lane >> 5, col = cg * 128 + (F.lane & 31) * 4;
            f32x4 acc[4] = {{0.f, 0.f, 0.f, 0.f}, {0.f, 0.f, 0.f, 0.f}, {0.f, 0.f, 0.f, 0.f}, {0.f, 0.f, 0.f, 0.f}};
            const int kbase = kq * 256 + F.wave * 32 + hlf;
#pragma unroll 4
            for (int i = 0; i < 16; ++i) { const int k = kbase + 2 * i; const f32x4 w4 = *(const GAS f32x4*)(w_ada + (size_t)k * (NMOD * D) + col);
#pragma unroll
                for (int b = 0; b < 4; ++b) { const float cv = c[b * D + k]; const float sv = cv / (1.f + __expf(-cv)); acc[b] += w4 * sv; } }
#pragma unroll
            for (int b = 0; b < 4; ++b)
#pragma unroll
                for (int j = 0; j < 4; ++j) acc[b][j] += __shfl_xor(acc[b][j], 32);
            if (hlf == 0) {
#pragma unroll
                for (int b = 0; b < 4; ++b) *(LAS f32x4*)(red + (F.wave * 4 + b) * 128 + (F.lane & 31) * 4) = acc[b];
            }
            __syncthreads();
            { const int b = F.tid >> 7, cc = F.tid & 127; float s = 0.f;
#pragma unroll
              for (int w = 0; w < 8; ++w) s += red[(w * 4 + b) * 128 + cc];
              ((GAS float*)(F.ws + WS_MODP))[(size_t)(kq * 4 + b) * (NMOD * D) + cg * 128 + cc] = s; }
            __syncthreads();
        }
    }
    LAS float* scr = (LAS float*)(F.lds + F.wave * 16384);
    const int gw = F.vcu * NWAVES + F.wave, NGW = F.G * NWAVES;
    constexpr int I_GU = (D / 64) * (NGU / 32), I_DN = (DFF / 64) * (D / 32), I_IN = (D / 64) * (INW / 32), I_OUT = (D / 64) * (D / 32);
    constexpr int NITEMS = 2 * I_GU + 2 * I_DN + I_IN + I_OUT;
    for (int it = gw; it < NITEMS; it += NGW) {
        int r = it;
        if (r < I_GU) { p0_transpose_item<PH_GU>(GIN(a, 5), D, NGU, (GAS h16*)(F.ws + WS_WGU1), nullptr, scr, r, F.lane); continue; } r -= I_GU;
        if (r < I_GU) { p0_transpose_item<PH_GU>(GIN(a, 17), D, NGU, (GAS h16*)(F.ws + WS_WGU2), nullptr, scr, r, F.lane); continue; } r -= I_GU;
        if (r < I_DN) { p0_transpose_item<PH_P8>(GIN(a, 6), DFF, D, (GAS h16*)(F.ws + WS_WD1), nullptr, scr, r, F.lane); continue; } r -= I_DN;
        if (r < I_DN) { p0_transpose_item<PH_P8>(GIN(a, 18), DFF, D, (GAS h16*)(F.ws + WS_WD2), nullptr, scr, r, F.lane); continue; } r -= I_DN;
        if (r < I_IN) { p0_transpose_item<PH_IN>(GIN(a, 8), D, INW, (GAS h16*)(F.ws + WS_WIN), nullptr, scr, r, F.lane); continue; } r -= I_IN;
        {
            const int kb = r / (D / 32); const GAS float* ks = (kb < 8) ? GIN(a, 13) : (GIN(a, 14) - 512);
            p0_transpose_item<PH_P8>(GIN(a, 15), D, D, (GAS h16*)(F.ws + WS_WOUT), ks, scr, r, F.lane); }
    }
    for (int pos = gw; pos < S; pos += NGW) {
        const int i = F.lane & 31;
        const float inv = (float)exp(-(double)i / 32.0 * 9.210340371976184);
        const float ang = (float)pos * inv;
        const double da = (double)ang;
        ((GAS float*)(F.ws + WS_ROPE))[(size_t)pos * 64 + F.lane] = (F.lane < 32) ? (float)cos(da) : (float)sin(da);
    }
    for (int e = gw * 64 + F.lane; e < NH * GC * GC; e += NGW * 64) { const int t = (e >> 7) & 127, s = e & 127; ((GAS h16*)(F.ws + WS_WS16))[e] = (s <= t) ? (h16)GIN(a, 11)[e] : (h16)0.f; }
}

__device__ __forceinline__ void p1_prep(const Frame& F0, const Args& a) {
    Frame F = F0; F.tid = threadIdx.x; F.lane = F.tid & 63; F.wave = __builtin_amdgcn_readfirstlane(F.tid >> 6);
    LAS float* modl = (LAS float*)F.lds;
    const GAS float* modp = (const GAS float*)(F.ws + WS_MODP); const GAS float* b_ada = GIN(a, 3);
    const size_t st = (size_t)4 * NMOD * D;
    for (int e = F.tid; e < 4 * 6 * D; e += NWAVES * 64) {
        const int b = e / (6 * D), sl = (e / D) % 6, k = e % D; const int mi = (sl < 3) ? 3 * sl : 3 * (sl - 3) + 1;
        const size_t o = (size_t)b * (NMOD * D) + mi * D + k;
        modl[e] = ((modp[o] + modp[o + st]) + (modp[o + 2 * st] + modp[o + 3 * st])) + b_ada[mi * D + k];
    }
    __syncthreads();
    if (F.vcu == 0) {
        GAS float* GT = (GAS float*)(F.ws + WS_GT); GAS float* GP = (GAS float*)(F.ws + WS_GP);
        for (int e = F.tid; e < 3 * 4 * D; e += NWAVES * 64) {
            const int j = e / (4 * D), b = (e / D) % 4, k = e % D; const int mi = 3 * j + 2;
            const size_t o = (size_t)b * (NMOD * D) + mi * D + k;
            GT[e] = ((modp[o] + modp[o + st]) + (modp[o + 2 * st] + modp[o + 3 * st])) + b_ada[mi * D + k];
            const GAS float* g = j == 0 ? GIN(a, 4) : j == 1 ? GIN(a, 7) : GIN(a, 16);
            GP[e] = g[k] * (1.f + modl[(b * 6 + 3 + j) * D + k]);
        }
    }
    const GAS float* x = GIN(a, 0); const GAS float* g1 = GIN(a, 4);
    GAS h16* XG = (GAS h16*)(F.ws + WS_HG); GAS float* R1 = (GAS float*)(F.ws + WS_R1);
    for (int chunk = F.vcu; chunk < M / 128; chunk += F.G) {
        const int b = chunk / (S / 128);
        for (int rr = 0; rr < 16; ++rr) {
            const int row = chunk * 128 + F.wave * 16 + rr;
            const GAS float* xr = x + (size_t)row * D + 8 * F.lane;
            f32x4 v[2][2]; float q = 0.f;
#pragma unroll
            for (int j = 0; j < 2; ++j) { v[j][0] = *(const GAS f32x4*)(xr + 512 * j); v[j][1] = *(const GAS f32x4*)(xr + 512 * j + 4);
                q += ((v[j][0][0] * v[j][0][0] + v[j][0][1] * v[j][0][1]) + (v[j][0][2] * v[j][0][2] + v[j][0][3] * v[j][0][3])) + ((v[j][1][0] * v[j][1][0] + v[j][1][1] * v[j][1][1]) + (v[j][1][2] * v[j][1][2] + v[j][1][3] * v[j][1][3])); }
            q = wave_sum(q);
            if (F.lane == 0) R1[row] = rsqrtf(q * (1.f / D) + EPS);
#pragma unroll
            for (int j = 0; j < 2; ++j) {
                const int k = 8 * F.lane + 512 * j; u32x4 w;
#pragma unroll
                for (int h = 0; h < 2; ++h) { const f32x4 gg = *(const GAS f32x4*)(g1 + k + 4 * h); const LAS float* sc = modl + (b * 6 + 3) * D + k + 4 * h;
                    const f32x4 o = v[j][h] * gg * ((f32x4){1.f + sc[0], 1.f + sc[1], 1.f + sc[2], 1.f + sc[3]});
                    w[2 * h] = pkh(o[0], o[1]); w[2 * h + 1] = pkh(o[2], o[3]); }
                *(GAS u32x4*)(XG + blk_off(row, k, D / 64)) = w;
            }
        }
    }
    const int gw = F.vcu * NWAVES + F.wave, NGW = F.G * NWAVES;
    for (int it = gw; it < NGU + INW + NGU; it += NGW) {
        int n = it, j; const GAS h16* W; GAS float* B; int NN;
        if (n < NGU) { j = 0; W = (const GAS h16*)(F.ws + WS_WGU1); B = (GAS float*)(F.ws + WS_BIAS1); NN = NGU; }
        else if (n < NGU + INW) { n -= NGU; j = 1; W = (const GAS h16*)(F.ws + WS_WIN); B = (GAS float*)(F.ws + WS_BIAS2); NN = INW; }
        else { n -= NGU + INW; j = 2; W = (const GAS h16*)(F.ws + WS_WGU2); B = (GAS float*)(F.ws + WS_BIAS3); NN = NGU; }
        const h16x8 w0 = *(const GAS h16x8*)(W + blk_off(n, 16 * F.lane, D / 64)), w1 = *(const GAS h16x8*)(W + blk_off(n, 16 * F.lane + 8, D / 64));
        float s[4];
#pragma unroll
        for (int b = 0; b < 4; ++b) { const LAS float* sh = modl + (b * 6 + j) * D + 16 * F.lane; float t = 0.f;
#pragma unroll
            for (int e = 0; e < 8; ++e) t += sh[e] * (float)w0[e] + sh[8 + e] * (float)w1[e];
            s[b] = wave_sum(t); }
        if (F.lane == 0) { B[0 * NN + n] = s[0]; B[1 * NN + n] = s[1]; B[2 * NN + n] = s[2]; B[3 * NN + n] = s[3]; }
    }
    __syncthreads();
}

__device__ __forceinline__ void p_final(const Frame& F0, const Args& a) {
    Frame F = F0; F.tid = threadIdx.x; F.lane = F.tid & 63; F.wave = __builtin_amdgcn_readfirstlane(F.tid >> 6);
    const GAS h16* H = (const GAS h16*)(F.ws + WS_H); const GAS float* ssq = (const GAS float*)(F.ws + WS_SSQF); const GAS float* gf = GIN(a, 19);
    const int gw = F.vcu * NWAVES + F.wave, NGW = F.G * NWAVES;
    f32x4 g[2][2];
#pragma unroll
    for (int j = 0; j < 2; ++j)
#pragma unroll
        for (int h = 0; h < 2; ++h) g[j][h] = *(const GAS f32x4*)(gf + 8 * F.lane + 512 * j + 4 * h);
    for (int row = gw; row < M; row += NGW) {
        const float rs = rs16(ssq + (size_t)row * 16);
#pragma unroll
        for (int j = 0; j < 2; ++j) { const h16x8 hv = *(const GAS h16x8*)(H + (size_t)row * D + 8 * F.lane + 512 * j);
            f32x4 o0 = (f32x4){(float)hv[0], (float)hv[1], (float)hv[2], (float)hv[3]} * rs * g[j][0], o1 = (f32x4){(float)hv[4], (float)hv[5], (float)hv[6], (float)hv[7]} * rs * g[j][1];
            *(GAS f32x4*)(a.out + (size_t)row * D + 8 * F.lane + 512 * j) = o0; *(GAS f32x4*)(a.out + (size_t)row * D + 8 * F.lane + 512 * j + 4) = o1; }
    }
}


typedef float f32x16 __attribute__((ext_vector_type(16)));
typedef short v4i16_t __attribute__((ext_vector_type(4)));
__device__ __forceinline__ h16x4 tr16(const LAS unsigned char* p) { return __builtin_bit_cast(h16x4, __builtin_amdgcn_ds_read_tr16_b64_v4i16((LAS v4i16_t*)p)); }
__device__ __forceinline__ int vt_off(int t, int c8) { return t * 128 + (((c8 >> 2) ^ ((t >> 1) & 1)) << 6) + ((c8 & 3) << 4); }

__device__ __forceinline__ void gmlp_phase(const Frame& F0, const Args& a, int shadow) {
    const int tid = threadIdx.x, lane = tid & 63, wave = __builtin_amdgcn_readfirstlane(tid >> 6), r32 = lane & 31, hi = lane >> 5;
    GAS h16* proj = (GAS h16*)(F0.ws + WS_PROJ); const GAS h16* W16 = (const GAS h16*)(F0.ws + WS_WS16); GAS float* RG = (GAS float*)(F0.ws + WS_RG);
    const GAS float* ln_g = GIN(a, 9); const GAS float* ln_b = GIN(a, 10); const GAS float* b_s = GIN(a, 12);
    LAS unsigned char* lds = F0.lds;
    LAS float* rowsq = (LAS float*)(lds + MISC_OFF + 128);
    f32x4 g0 = *(const GAS f32x4*)(ln_g + 8 * lane), g1 = *(const GAS f32x4*)(ln_g + 8 * lane + 4), b0 = *(const GAS f32x4*)(ln_b + 8 * lane), b1 = *(const GAS f32x4*)(ln_b + 8 * lane + 4);
    for (int unit = F0.vcu; unit < M / GC; unit += F0.G) {
        const size_t row0 = (size_t)unit * GC;
        {
            h16x8 hv[16]; float sm[16], mu[16], rsd[16];
#pragma unroll
            for (int rr = 0; rr < 16; ++rr) hv[rr] = *(const GAS h16x8*)(proj + (row0 + wave * 16 + rr) * INW + PG + 8 * lane);
#pragma unroll
            for (int rr = 0; rr < 16; ++rr) { float t = 0.f;
#pragma unroll
                for (int e = 0; e < 8; ++e) t += (float)hv[rr][e];
                sm[rr] = t; }
#pragma unroll
            for (int o = 1; o < 64; o <<= 1)
#pragma unroll
                for (int rr = 0; rr < 16; ++rr) sm[rr] += __shfl_xor(sm[rr], o);
#pragma unroll
            for (int rr = 0; rr < 16; ++rr) { mu[rr] = sm[rr] * (1.f / 512.f); float q = 0.f;
#pragma unroll
                for (int e = 0; e < 8; ++e) { const float d = (float)hv[rr][e] - mu[rr]; q += d * d; }
                sm[rr] = q; }
#pragma unroll
            for (int o = 1; o < 64; o <<= 1)
#pragma unroll
                for (int rr = 0; rr < 16; ++rr) sm[rr] += __shfl_xor(sm[rr], o);
#pragma unroll
            for (int rr = 0; rr < 16; ++rr) { rsd[rr] = rsqrtf(sm[rr] * (1.f / 512.f) + EPS);
                const int t = wave * 16 + rr; float v[8];
#pragma unroll
                for (int e = 0; e < 8; ++e) v[e] = ((float)hv[rr][e] - mu[rr]) * rsd[rr];
                u32x4 w; w[0] = pkh(v[0] * g0[0] + b0[0], v[1] * g0[1] + b0[1]); w[1] = pkh(v[2] * g0[2] + b0[2], v[3] * g0[3] + b0[3]);
                w[2] = pkh(v[4] * g1[0] + b1[0], v[5] * g1[1] + b1[1]); w[3] = pkh(v[6] * g1[2] + b1[2], v[7] * g1[3] + b1[3]);
                *(LAS u32x4*)(lds + (lane >> 3) * 16384 + vt_off(t, lane & 7)) = w; }
        }
        __syncthreads();
        const GAS h16* Wh = W16 + (size_t)wave * GC * GC;
        const LAS unsigned char* vt = lds + wave * 16384;
        const int q4 = (lane & 15) >> 2, p4 = lane & 3, g1b = (lane >> 4) & 1;
        for (int tb = 0; tb < 4; ++tb) {
            f32x16 acc[2];
#pragma unroll
            for (int d0 = 0; d0 < 2; ++d0)
#pragma unroll
                for (int e = 0; e < 16; ++e) acc[d0][e] = 0.f;
            for (int ks = 0; ks <= 2 * tb + 1; ++ks) {
                const h16x8 af = *(const GAS h16x8*)(Wh + (size_t)(32 * tb + r32) * GC + 16 * ks + 8 * hi);
#pragma unroll
                for (int d0 = 0; d0 < 2; ++d0) {
                    const int srow = 16 * ks + 8 * hi + q4, c8 = 4 * d0 + 2 * g1b + (p4 >> 1);
                    const h16x4 lo = tr16(vt + vt_off(srow, c8) + (p4 & 1) * 8), hi4 = tr16(vt + vt_off(srow + 4, c8) + (p4 & 1) * 8);
                    const h16x8 bf = (h16x8){lo[0], lo[1], lo[2], lo[3], hi4[0], hi4[1], hi4[2], hi4[3]};
                    acc[d0] = __builtin_amdgcn_mfma_f32_32x32x16_f16(af, bf, acc[d0], 0, 0, 0);
                }
            }
            h16 uv0[16], uv1[16]; float bsv[16];
#pragma unroll
            for (int e = 0; e < 16; ++e) { const int t = 32 * tb + (e & 3) + 8 * (e >> 2) + 4 * hi; const GAS h16* up = proj + (row0 + t) * INW + PU + wave * 64 + r32; uv0[e] = up[0]; uv1[e] = up[32]; bsv[e] = b_s[wave * GC + t]; }
            asm volatile("" ::: "memory");
#pragma unroll
            for (int e = 0; e < 16; ++e) {
                const int t = 32 * tb + (e & 3) + 8 * (e >> 2) + 4 * hi;
                GAS h16* up = proj + (row0 + t) * INW + PU + wave * 64 + r32;
                const float o0 = (float)uv0[e] * (acc[0][e] + bsv[e]), o1 = (float)uv1[e] * (acc[1][e] + bsv[e]);
                up[0] = (h16)o0; up[32] = (h16)o1;
                float q = o0 * o0 + o1 * o1;
                q += __shfl_xor(q, 1); q += __shfl_xor(q, 2); q += __shfl_xor(q, 4); q += __shfl_xor(q, 8); q += __shfl_xor(q, 16);
                if (r32 == 0) rowsq[wave * 128 + t] = q;
            }
        }
        __syncthreads();
        if (tid < 128) { float s8 = 0.f;
#pragma unroll
            for (int w = 0; w < 8; ++w) s8 += rowsq[w * 128 + tid];
            RG[row0 + tid] = s8; }
        __syncthreads();
    }
}


constexpr size_t DO_PO = 0, DO_PML = 96 * MiB;
constexpr int CW_CNT = 8192;
constexpr int LISTCAP = 8192;
constexpr int AL_K = 0, AL_V = 32768, AL_STG = 65536, AL_WSF = 98304, AL_START = 102400;
__device__ __forceinline__ int k_off(int key, int c8) { return key * 128 + ((c8 ^ (key & 7)) << 4); }

__device__ __forceinline__ void moba_gate_phase(const Frame& F0, int shadow) {
    const int tid = threadIdx.x, lane = tid & 63;
    const GAS h16* proj = (const GAS h16*)(F0.ws + WS_PROJ); const GAS float* kmp = (const GAS float*)(F0.ws + WS_KMP);
    unsigned* cnt = F0.ctl + CW_CNT + (shadow ? 1024 : 0); GAS unsigned short* lists = (GAS unsigned short*)(F0.ws + (shadow ? WS_HG : WS_LISTS));
    LAS float* km = (LAS float*)F0.lds;
    for (int item = F0.vcu; item < NB * NH * (S / 512); item += F0.G) {
        const int span = item % (S / 512), bh = item / (S / 512), b = bh >> 3, h = bh & 7;
        __syncthreads();
        for (int e = tid; e < NBLK * 64; e += NWAVES * 64) { const int n = e >> 6, d = e & 63; const GAS float* kp = kmp + (size_t)((b * NBLK + n) * 2) * 512 + h * 64 + d; km[e] = kp[0] + kp[512]; }
        __syncthreads();
        const int sq = span * 512 + tid, own = __builtin_amdgcn_readfirstlane(sq >> 8);
        float q[64];
        { const GAS h16* qp = proj + (size_t)(b * S + sq) * INW + PQ + h * 64;
#pragma unroll
          for (int c = 0; c < 8; ++c) { const h16x8 v = *(const GAS h16x8*)(qp + 8 * c);
#pragma unroll
              for (int e = 0; e < 8; ++e) q[8 * c + e] = (float)v[e]; } }
        float v0 = -3e38f, v1 = -3e38f, v2 = -3e38f; int i0 = -1, i1 = -1, i2 = -1;
        for (int n = 0; n < own; ++n) {
            float g0 = 0.f, g1 = 0.f, g2 = 0.f, g3 = 0.f;
#pragma unroll
            for (int c = 0; c < 16; ++c) { const f32x4 kv = *(const LAS f32x4*)(km + n * 64 + 4 * c); g0 += q[4 * c] * kv[0]; g1 += q[4 * c + 1] * kv[1]; g2 += q[4 * c + 2] * kv[2]; g3 += q[4 * c + 3] * kv[3]; }
            const float g = (g0 + g1) + (g2 + g3);
            if (g > v0) { v2 = v1; i2 = i1; v1 = v0; i1 = i0; v0 = g; i0 = n; }
            else if (g > v1) { v2 = v1; i2 = i1; v1 = g; i1 = n; }
            else if (g > v2) { v2 = g; i2 = n; }
        }
        int mycnt = 0, pos0 = 0, pos1 = 0, pos2 = 0;
        const unsigned long long ltmask = (1ull << lane) - 1ull;
        for (int n = 0; n < own; ++n) {
            const bool sel = (i0 == n) || (i1 == n) || (i2 == n);
            const unsigned long long mask = __ballot(sel);
            const int before = __popcll(mask & ltmask);
            if (lane == n) mycnt = __popcll(mask);
            if (i0 == n) pos0 = before; if (i1 == n) pos1 = before; if (i2 == n) pos2 = before;
        }
        unsigned base = 0u;
        if (lane < own && mycnt > 0) base = atomicAdd(cnt + bh * NBLK + lane, (unsigned)mycnt);
        const unsigned bb0 = (unsigned)__shfl((int)base, i0 & 63), bb1 = (unsigned)__shfl((int)base, i1 & 63), bb2 = (unsigned)__shfl((int)base, i2 & 63);
        if (i0 >= 0) lists[(size_t)(bh * NBLK + i0) * LISTCAP + bb0 + pos0] = (unsigned short)(sq | (0 << 13));
        if (i1 >= 0) lists[(size_t)(bh * NBLK + i1) * LISTCAP + bb1 + pos1] = (unsigned short)(sq | (1 << 13));
        if (i2 >= 0) lists[(size_t)(bh * NBLK + i2) * LISTCAP + bb2 + pos2] = (unsigned short)(sq | (2 << 13));
    }
    __syncthreads();
}

template <bool CAUSAL>
__device__ __forceinline__ void attn_tile(const LAS unsigned char* ldsK, const LAS unsigned char* ldsV, const h16x8 (&qf)[4], int wave, int lane, f32x16 (&o)[2], float& m_out, float& l_out) {
    const int r32 = lane & 31, hi = lane >> 5;
    int kbase[4];
#pragma unroll
    for (int ks = 0; ks < 4; ++ks) kbase[ks] = r32 * 128 + (((2 * ks + hi) ^ (r32 & 7)) << 4);
    f32x16 sacc[8];
#pragma unroll
    for (int kb = 0; kb < 8; ++kb) {
        f32x16 acc;
#pragma unroll
        for (int e = 0; e < 16; ++e) acc[e] = 0.f;
#pragma unroll
        for (int ks = 0; ks < 4; ++ks) { const h16x8 kf = *(const LAS h16x8*)(ldsK + kbase[ks] + kb * 4096); acc = __builtin_amdgcn_mfma_f32_32x32x16_f16(kf, qf[ks], acc, 0, 0, 0); }
        if (CAUSAL) {
            const int lim = 32 * (wave - kb) + r32;
#pragma unroll
            for (int e = 0; e < 16; ++e) { const int key = (e & 3) + 8 * (e >> 2) + 4 * hi; if (key > lim) acc[e] = -1e30f; }
        }
        sacc[kb] = acc;
    }
    float m = -3e38f;
#pragma unroll
    for (int kb = 0; kb < 8; ++kb)
#pragma unroll
        for (int e = 0; e < 16; ++e) m = fmaxf(m, sacc[kb][e]);
    m = fmaxf(m, __shfl_xor(m, 32));
    float ls = 0.f;
#pragma unroll
    for (int kb = 0; kb < 8; ++kb)
#pragma unroll
        for (int e = 0; e < 16; ++e) { const float pv = __builtin_amdgcn_exp2f(sacc[kb][e] - m); sacc[kb][e] = pv; ls += pv; }
    ls += __shfl_xor(ls, 32);
#pragma unroll
    for (int d0 = 0; d0 < 2; ++d0)
#pragma unroll
        for (int e = 0; e < 16; ++e) o[d0][e] = 0.f;
    const int q4 = (lane & 15) >> 2, p4 = lane & 3, g1b = (lane >> 4) & 1;
    int vbase[2];
#pragma unroll
    for (int d0 = 0; d0 < 2; ++d0) vbase[d0] = (4 * hi + q4) * 128 + ((d0 ^ ((q4 >> 1) & 1)) << 6) + ((2 * g1b + (p4 >> 1)) << 4) + (p4 & 1) * 8;
#pragma unroll
    for (int kb = 0; kb < 8; ++kb) {
        if (!CAUSAL || kb <= wave) {
#pragma unroll
            for (int s2 = 0; s2 < 2; ++s2) {
                h16x8 pa;
#pragma unroll
                for (int j = 0; j < 8; ++j) pa[j] = (h16)sacc[kb][8 * s2 + j];
#pragma unroll
                for (int d0 = 0; d0 < 2; ++d0) {
                    const h16x4 lo = tr16(ldsV + vbase[d0] + kb * 4096 + s2 * 2048), hi4 = tr16(ldsV + vbase[d0] + kb * 4096 + s2 * 2048 + 1024);
                    const h16x8 bf = (h16x8){lo[0], lo[1], lo[2], lo[3], hi4[0], hi4[1], hi4[2], hi4[3]};
                    o[d0] = __builtin_amdgcn_mfma_f32_32x32x16_f16(pa, bf, o[d0], 0, 0, 0);
                }
            }
        }
    }
    m_out = m; l_out = ls;
}
__device__ __forceinline__ void attn_tile_causal(const LAS unsigned char* ldsK, const LAS unsigned char* ldsV, const h16x8 (&qf)[4], int wave, int lane, f32x16 (&o)[2], float& m_out, float& l_out) {
    const int r32 = lane & 31, hi = lane >> 5;
    int kbase[4];
#pragma unroll
    for (int ks = 0; ks < 4; ++ks) kbase[ks] = r32 * 128 + (((2 * ks + hi) ^ (r32 & 7)) << 4);
    const int q4 = (lane & 15) >> 2, p4 = lane & 3, g1b = (lane >> 4) & 1;
    int vbase[2];
#pragma unroll
    for (int d0 = 0; d0 < 2; ++d0) vbase[d0] = (4 * hi + q4) * 128 + ((d0 ^ ((q4 >> 1) & 1)) << 6) + ((2 * g1b + (p4 >> 1)) << 4) + (p4 & 1) * 8;
    float m = -3e38f;
    for (int kb = 0; kb <= wave; ++kb) {
        f32x16 acc;
#pragma unroll
        for (int e = 0; e < 16; ++e) acc[e] = 0.f;
#pragma unroll
        for (int ks = 0; ks < 4; ++ks) { const h16x8 kf = *(const LAS h16x8*)(ldsK + kbase[ks] + kb * 4096); acc = __builtin_amdgcn_mfma_f32_32x32x16_f16(kf, qf[ks], acc, 0, 0, 0); }
        const int lim = (kb == wave) ? r32 : 64;
#pragma unroll
        for (int e = 0; e < 16; ++e) { const int key = (e & 3) + 8 * (e >> 2) + 4 * hi; if (key <= lim) m = fmaxf(m, acc[e]); }
    }
    m = fmaxf(m, __shfl_xor(m, 32));
    float ls = 0.f;
#pragma unroll
    for (int d0 = 0; d0 < 2; ++d0)
#pragma unroll
        for (int e = 0; e < 16; ++e) o[d0][e] = 0.f;
    for (int kb = 0; kb <= wave; ++kb) {
        f32x16 acc;
#pragma unroll
        for (int e = 0; e < 16; ++e) acc[e] = 0.f;
#pragma unroll
        for (int ks = 0; ks < 4; ++ks) { const h16x8 kf = *(const LAS h16x8*)(ldsK + kbase[ks] + kb * 4096); acc = __builtin_amdgcn_mfma_f32_32x32x16_f16(kf, qf[ks], acc, 0, 0, 0); }
        const int lim = (kb == wave) ? r32 : 64;
#pragma unroll
        for (int e = 0; e < 16; ++e) { const int key = (e & 3) + 8 * (e >> 2) + 4 * hi; const float pv = (key <= lim) ? __builtin_amdgcn_exp2f(acc[e] - m) : 0.f; acc[e] = pv; ls += pv; }
#pragma unroll
        for (int s2 = 0; s2 < 2; ++s2) {
            h16x8 pa;
#pragma unroll
            for (int j = 0; j < 8; ++j) pa[j] = (h16)acc[8 * s2 + j];
#pragma unroll
            for (int d0 = 0; d0 < 2; ++d0) {
                const h16x4 lo = tr16(ldsV + vbase[d0] + kb * 4096 + s2 * 2048), hi4 = tr16(ldsV + vbase[d0] + kb * 4096 + s2 * 2048 + 1024);
                const h16x8 bf = (h16x8){lo[0], lo[1], lo[2], lo[3], hi4[0], hi4[1], hi4[2], hi4[3]};
                o[d0] = __builtin_amdgcn_mfma_f32_32x32x16_f16(pa, bf, o[d0], 0, 0, 0);
            }
        }
    }
    ls += __shfl_xor(ls, 32);
    m_out = m; l_out = ls;
}
__device__ __forceinline__ void load_kv_block(LAS unsigned char* lds, const GAS h16* proj, size_t row0, int h, int tid) {
#pragma unroll
    for (int i = 0; i < 4; ++i) { const int idx = tid + 512 * i, key = idx >> 3, c8 = idx & 7; const GAS h16* rp = proj + (row0 + key) * INW + h * 64 + 8 * c8;
        const u32x4 kv = *(const GAS u32x4*)(rp + PK), vv = *(const GAS u32x4*)(rp + PV);
        *(LAS u32x4*)(lds + AL_K + k_off(key, c8)) = kv; *(LAS u32x4*)(lds + AL_V + vt_off(key, c8)) = vv; }
}
__device__ __forceinline__ void stage_o(LAS unsigned char* stg, LAS float* wsf, const f32x16 (&o)[2], float l, int lane) {
    const int r32 = lane & 31, hi = lane >> 5;
    if (hi == 0) wsf[r32] = 1.f / l;
    LDS_WAIT();
#pragma unroll
    for (int e = 0; e < 16; ++e) { const int qr = (e & 3) + 8 * (e >> 2) + 4 * hi; const float rl = wsf[qr];
        *(LAS h16*)(stg + qr * 128 + r32 * 2) = (h16)(o[0][e] * rl); *(LAS h16*)(stg + qr * 128 + 64 + r32 * 2) = (h16)(o[1][e] * rl); }
    LDS_WAIT();
}

__device__ __forceinline__ void moba_b_phase(const Frame& F0, GAS float* dout) {
    const int tid = threadIdx.x, lane = tid & 63, wave = __builtin_amdgcn_readfirstlane(tid >> 6), r32 = lane & 31, hi = lane >> 5;
    const GAS h16* proj = (const GAS h16*)(F0.ws + WS_PROJ); const unsigned* cnt = F0.ctl + CW_CNT; const GAS unsigned short* lists = (const GAS unsigned short*)(F0.ws + WS_LISTS);
    GAS h16* PO = (GAS h16*)((unsigned char*)dout + DO_PO); GAS float* PML = (GAS float*)((unsigned char*)dout + DO_PML);
    LAS unsigned char* lds = F0.lds;
    LAS int* start = (LAS int*)(lds + AL_START);
    LAS float* wsf = (LAS float*)(lds + AL_WSF + wave * 512); LAS int* wsi = (LAS int*)(lds + AL_WSF + wave * 512 + 256);
    LAS unsigned char* stg = lds + AL_STG + wave * 4096;
    {
        const unsigned c0 = cnt[2 * tid], c1 = cnt[2 * tid + 1];
        const int t0 = (int)((c0 + 255u) >> 8), t1 = (int)((c1 + 255u) >> 8);
        int v = t0 + t1, inc = v;
#pragma unroll
        for (int o = 1; o < 64; o <<= 1) { const int u = __shfl_up(inc, o); if (lane >= o) inc += u; }
        LAS int* wtot = (LAS int*)(lds + AL_WSF);
        __syncthreads();
        if (lane == 63) wtot[wave] = inc;
        __syncthreads();
        int pre = 0;
        for (int w = 0; w < wave; ++w) pre += wtot[w];
        const int ex = pre + inc - v;
        __syncthreads();
        start[2 * tid] = ex; start[2 * tid + 1] = ex + t0;
        if (tid == 511) start[1024] = ex + v;
        __syncthreads();
    }
    const int nitems = start[1024];
    for (int item = F0.vcu; item < nitems; item += F0.G) {
        int lo = 0, hi_ = 1024;
        while (hi_ - lo > 1) { const int mid = (lo + hi_) >> 1; if (start[mid] <= item) lo = mid; else hi_ = mid; }
        const int l = lo, chunk = item - start[l];
        const int bh = l >> 5, n = l & 31, b = bh >> 3, h = bh & 7;
        const int nq = (int)cnt[l] - chunk * 256;
        load_kv_block(lds, proj, (size_t)b * S + (size_t)n * MBLK, h, tid);
        const int qi = chunk * 256 + wave * 32 + r32;
        const bool valid = (wave * 32 + r32) < nq;
        const unsigned ent = lists[(size_t)l * LISTCAP + (valid ? qi : chunk * 256)];
        const int sq = ent & 8191, rank = ent >> 13;
        h16x8 qf[4];
        { const GAS h16* qp = proj + (size_t)(b * S + sq) * INW + PQ + h * 64 + 8 * hi;
#pragma unroll
          for (int ks = 0; ks < 4; ++ks) qf[ks] = *(const GAS h16x8*)(qp + 16 * ks); }
        __syncthreads();
        if (wave * 32 < nq) {
            f32x16 o[2]; float m, lsum;
            attn_tile<false>(lds + AL_K, lds + AL_V, qf, wave, lane, o, m, lsum);
            const int slot = ((b * S + sq) * NH + h) * 3 + rank;
            if (hi == 0) { wsi[r32] = valid ? slot : -1; if (valid) { PML[(size_t)slot * 2] = m; PML[(size_t)slot * 2 + 1] = lsum; } }
            stage_o(stg, wsf, o, lsum, lane);
#pragma unroll
            for (int i = 0; i < 4; ++i) { const int row = i * 8 + (lane >> 3), ch = lane & 7; const int sl = wsi[row];
                if (sl >= 0) *(GAS u32x4*)(PO + (size_t)sl * 64 + ch * 8) = *(const LAS u32x4*)(stg + row * 128 + ch * 16); }
        }
        __syncthreads();
    }
}

__device__ __forceinline__ void moba_c_phase(const Frame& F0, const GAS float* dout, int shadow) {
    const int tid = threadIdx.x, lane = tid & 63, wave = __builtin_amdgcn_readfirstlane(tid >> 6), r32 = lane & 31, hi = lane >> 5;
    GAS h16* proj = (GAS h16*)(F0.ws + WS_PROJ); GAS float* SSQA = (GAS float*)(F0.ws + WS_SSQA);
    const GAS h16* PO = (const GAS h16*)((const unsigned char*)dout + DO_PO); const GAS float* PML = (const GAS float*)((const unsigned char*)dout + DO_PML);
    LAS unsigned char* lds = F0.lds;
    LAS float* wsf = (LAS float*)(lds + AL_WSF + wave * 512);
    LAS unsigned char* stg = lds + AL_STG + wave * 4096;
    for (int unit = F0.vcu; unit < NB * NH * NBLK; unit += F0.G) {
        const int qb = unit & 31, bh = unit >> 5, b = bh >> 3, h = bh & 7;
        const size_t row0 = (size_t)b * S + (size_t)qb * MBLK;
        load_kv_block(lds, proj, row0, h, tid);
        h16x8 qf[4];
        { const GAS h16* qp = proj + (row0 + wave * 32 + r32) * INW + PQ + h * 64 + 8 * hi;
#pragma unroll
          for (int ks = 0; ks < 4; ++ks) qf[ks] = *(const GAS h16x8*)(qp + 16 * ks); }
        __syncthreads();
        f32x16 o[2]; float m, lsum;
        attn_tile_causal(lds + AL_K, lds + AL_V, qf, wave, lane, o, m, lsum);
        if (hi == 0) { wsf[32 + r32] = m; wsf[64 + r32] = lsum; }
        stage_o(stg, wsf, o, lsum, lane);
        const int nsel = qb < 3 ? qb : 3;
#pragma unroll
        for (int i0 = 0; i0 < 4; i0 += 2) {
            float mr[2][3], lr[2][3]; h16x8 pv[2][3];
#pragma unroll
            for (int ii = 0; ii < 2; ++ii) { const size_t grow = row0 + wave * 32 + (i0 + ii) * 8 + (lane >> 3);
#pragma unroll
                for (int r = 0; r < 3; ++r) { if (r < nsel) { const size_t sl = (grow * NH + h) * 3 + r; mr[ii][r] = PML[sl * 2]; lr[ii][r] = PML[sl * 2 + 1]; pv[ii][r] = *(const GAS h16x8*)(PO + sl * 64 + (lane & 7) * 8); } } }
            asm volatile("" ::: "memory");
#pragma unroll
            for (int ii = 0; ii < 2; ++ii) {
                const int row = (i0 + ii) * 8 + (lane >> 3), ch = lane & 7;
                const size_t grow = row0 + wave * 32 + row;
                const float mo = wsf[32 + row], lo_ = wsf[64 + row];
                const h16x8 ov = *(const LAS h16x8*)(stg + row * 128 + ch * 16);
                float mmax = mo;
#pragma unroll
                for (int r = 0; r < 3; ++r) { if (r < nsel) mmax = fmaxf(mmax, mr[ii][r]); }
                float wo = lo_ * __builtin_amdgcn_exp2f(mo - mmax), L = wo;
                float acc[8];
#pragma unroll
                for (int e = 0; e < 8; ++e) acc[e] = wo * (float)ov[e];
#pragma unroll
                for (int r = 0; r < 3; ++r) { if (r < nsel) { const float wr_ = lr[ii][r] * __builtin_amdgcn_exp2f(mr[ii][r] - mmax); L += wr_;
#pragma unroll
                    for (int e = 0; e < 8; ++e) acc[e] += wr_ * (float)pv[ii][r][e]; } }
                const float rL = 1.f / L; float q = 0.f; u32x4 w;
#pragma unroll
                for (int e = 0; e < 8; ++e) { acc[e] *= rL; q += acc[e] * acc[e]; }
                w[0] = pkh(acc[0], acc[1]); w[1] = pkh(acc[2], acc[3]); w[2] = pkh(acc[4], acc[5]); w[3] = pkh(acc[6], acc[7]);
                if (shadow) *(GAS u32x4*)((GAS h16*)(F0.ws + WS_HG) + grow * 512 + h * 64 + ch * 8) = w;
                else *(GAS u32x4*)(proj + grow * INW + PQ + h * 64 + ch * 8) = w;
                q += __shfl_xor(q, 1); q += __shfl_xor(q, 2); q += __shfl_xor(q, 4);
                if (ch == 0) SSQA[grow * 8 + h] = q;
            }
        }
        __syncthreads();
    }
}


template <bool PART16> __device__ __forceinline__ void fill_rowscale(LAS float* tab, const pg8::StaticOrder& So, const GAS float* src, int maxu) {
    pg8::Unit uu;
    for (int i = 0; i < maxu && So.next(i, uu); ++i)
        if (threadIdx.x < 256) { const int row = uu.pm * 256 + (int)threadIdx.x; tab[i * 256 + threadIdx.x] = PART16 ? rs16(src + (size_t)row * 16) : src[row]; }
    __syncthreads();
}
constexpr int TAB_OFF = MISC_OFF + 128, TAB_MAXU = 15;
static_assert(TAB_OFF + TAB_MAXU * 1024 <= LDS_BYTES, "row-scale table");

enum Phase { PH_P0 = 0, PH_P1, PH_G1A, PH_G1B, PH_INPROJ, PH_MIX_A, PH_MIX_B, PH_MIX_C, PH_OUTPROJ, PH_G2A, PH_G2B, PH_FINAL, PH_COUNT };
__global__ void __launch_bounds__(NWAVES * 64, 2) mega_fwd(Args args) {
    extern __shared__ __attribute__((aligned(16))) unsigned char lds[];
    Frame F;
    F.lds = (LAS unsigned char*)lds; F.MISC = (volatile LAS unsigned*)(F.lds + MISC_OFF);
    F.tid = threadIdx.x; F.lane = F.tid & 63; F.wave = __builtin_amdgcn_readfirstlane(F.tid >> 6);
    F.G = gridDim.x; { const int bx = blockIdx.x; F.vcu = (F.G % 8 == 0) ? (bx % 8) * (F.G / 8) + bx / 8 : bx; }
    F.ws = args.ws; F.out = (GAS float*)args.out; F.ctl = (unsigned*)(args.ws + WS_CTL);
    for (int u = F.tid; u < (LDS_BYTES - LDSCTL_OFF) / 4; u += NWAVES * 64) ((LAS unsigned*)(F.lds + LDSCTL_OFF))[u] = 0u;
    __syncthreads();
    XcdBarrier bar; bar.bar = F.ctl + CW_BAR; bar.x = 0; bar.st = nullptr;
    const int lo = args.ph_lo, hi = args.ph_hi;
    if (hi - lo > 1) bar = xcd_barrier_post(F.ctl + CW_BAR, F.MISC + 8);
#ifndef MK_PHASE_MASK
#define MK_PHASE_MASK 0xFFFF
#endif
#define IN(k) (((MK_PHASE_MASK >> (k)) & 1) && lo <= (k) && (k) < hi)
#define SEAM(k) do { if (IN(k) && IN((k) + 1)) xcd_barrier(bar); } while (0)
#define PHASE_PTRS() unsigned char* ws = args.ws; asm volatile("" : "+s"(ws)); const GAS float* GT = (const GAS float*)(ws + WS_GT); const GAS float* GP = (const GAS float*)(ws + WS_GP); (void)GT; (void)GP; F.ws = ws
    if (IN(PH_P0)) { PHASE_PTRS(); p0_prologue(F, args); SEAM(PH_P0); }
    if (IN(PH_P1)) { PHASE_PTRS(); p1_prep(F, args); SEAM(PH_P1); }
    if (IN(PH_G1A)) {
        PHASE_PTRS();
        pg8::Gemm g{(const GAS h16*)(ws + WS_HG), (const GAS h16*)(ws + WS_WGU1), 0, NGU, D}; pg8::StaticOrder So; So.init(M, NGU, F.G, (int)blockIdx.x);
#if MK_SHADOW == 1
        if (args.ph_lo == PH_G1A && args.ph_hi == PH_G1A + 1 && args.shadow) { EpiNull En; pg8::gemm_phase<EpiNull, true, MK_GPROBE>(F.lds, g, So, En); return; }
#endif
        fill_rowscale<false>((LAS float*)(F.lds + TAB_OFF), So, (const GAS float*)(ws + WS_R1), TAB_MAXU);
        EpiSwiglu E{(GAS h16*)(ws + WS_ACT), (const LAS float*)(F.lds + TAB_OFF), (const GAS float*)(ws + WS_BIAS1)};
        pg8::gemm_phase<EpiSwiglu, true>(F.lds, g, So, E); SEAM(PH_G1A);
    }
    if (IN(PH_G1B)) {
        PHASE_PTRS();
        pg8::Gemm g{(const GAS h16*)(ws + WS_ACT), (const GAS h16*)(ws + WS_WD1), 0, D, DFF}; pg8::StaticOrder So; So.init(M, D, F.G, (int)blockIdx.x);
        EpiResid<true, false, true> E{GIN(args, 0), (GAS h16*)(ws + WS_H), (GAS h16*)(ws + WS_HG), GT + 0 * 4 * D, GP + 1 * 4 * D, (GAS float*)(ws + WS_SSQ2), nullptr, 0.5f};
        pg8::gemm_phase<EpiResid<true, false, true>, true>(F.lds, g, So, E); SEAM(PH_G1B);
    }
    if (IN(PH_INPROJ)) {
        PHASE_PTRS();
        pg8::Gemm g{(const GAS h16*)(ws + WS_HG), (const GAS h16*)(ws + WS_WIN), 0, INW, D}; pg8::StaticOrder So; So.init(M, INW, F.G, (int)blockIdx.x);
        fill_rowscale<true>((LAS float*)(F.lds + TAB_OFF), So, (const GAS float*)(ws + WS_SSQ2), TAB_MAXU);
        EpiInproj E{(GAS h16*)(ws + WS_PROJ), (const LAS float*)(F.lds + TAB_OFF), (const GAS float*)(ws + WS_BIAS2), (const GAS float*)(ws + WS_ROPE), (GAS float*)(ws + WS_KMP)};
        pg8::gemm_phase<EpiInproj, true>(F.lds, g, So, E); SEAM(PH_INPROJ);
    }
    if (IN(PH_MIX_A)) { PHASE_PTRS(); if (!(args.shadow & 2)) gmlp_phase(F, args, args.shadow & 1); if (!(args.shadow & 4)) moba_gate_phase(F, args.shadow & 1); SEAM(PH_MIX_A); }
    if (IN(PH_MIX_B)) { PHASE_PTRS(); moba_b_phase(F, (GAS float*)args.out); SEAM(PH_MIX_B); }
    if (IN(PH_MIX_C)) { PHASE_PTRS(); moba_c_phase(F, (const GAS float*)args.out, args.shadow & 1); SEAM(PH_MIX_C); }
    if (IN(PH_OUTPROJ)) {
        PHASE_PTRS();
        pg8::Gemm g{(const GAS h16*)(ws + WS_PROJ), (const GAS h16*)(ws + WS_WOUT), INW, D, D}; pg8::StaticOrder So; So.init(M, D, F.G, (int)blockIdx.x);
        const LAS float* sct = (const LAS float*)(F.lds + MISC_OFF + 128);
        {   LAS float* t = (LAS float*)(F.lds + MISC_OFF + 128); const GAS float* ssqa = (const GAS float*)(ws + WS_SSQA); const GAS float* ssqg = (const GAS float*)(ws + WS_RG);
            pg8::Unit uu;
            for (int i = 0; i < 4 && So.next(i, uu); ++i)
                if (F.tid < 256) { const int row = uu.pm * 256 + F.tid; const f32x4 a = *(const GAS f32x4*)(ssqa + (size_t)row * 8), bq = *(const GAS f32x4*)(ssqa + (size_t)row * 8 + 4);
                    const float ra = rsqrtf((((a[0] + a[1]) + (a[2] + a[3])) + ((bq[0] + bq[1]) + (bq[2] + bq[3]))) * (1.f / 512.f) + EPS), rg = rsqrtf(ssqg[row] * (1.f / 512.f) + EPS);
                    t[i * 512 + F.tid] = ra / rg; t[i * 512 + 256 + F.tid] = rg; }
            __syncthreads(); }
        EpiResid<false, true, true> E{nullptr, (GAS h16*)(ws + WS_H), (GAS h16*)(ws + WS_HG), GT + 1 * 4 * D, GP + 2 * 4 * D, (GAS float*)(ws + WS_SSQ3), sct, 1.0f};
        pg8::gemm_phase<EpiResid<false, true, true>, true>(F.lds, g, So, E); SEAM(PH_OUTPROJ);
    }
    if (IN(PH_G2A)) {
        PHASE_PTRS();
        pg8::Gemm g{(const GAS h16*)(ws + WS_HG), (const GAS h16*)(ws + WS_WGU2), 0, NGU, D}; pg8::StaticOrder So; So.init(M, NGU, F.G, (int)blockIdx.x);
        fill_rowscale<true>((LAS float*)(F.lds + TAB_OFF), So, (const GAS float*)(ws + WS_SSQ3), TAB_MAXU);
        EpiSwiglu E{(GAS h16*)(ws + WS_ACT), (const LAS float*)(F.lds + TAB_OFF), (const GAS float*)(ws + WS_BIAS3)};
        pg8::gemm_phase<EpiSwiglu, true>(F.lds, g, So, E); SEAM(PH_G2A);
    }
    if (IN(PH_G2B)) {
        PHASE_PTRS();
        pg8::Gemm g{(const GAS h16*)(ws + WS_ACT), (const GAS h16*)(ws + WS_WD2), 0, D, DFF}; pg8::StaticOrder So; So.init(M, D, F.G, (int)blockIdx.x);
        EpiResid<false, false, false> E{nullptr, (GAS h16*)(ws + WS_H), nullptr, GT + 2 * 4 * D, nullptr, (GAS float*)(ws + WS_SSQF), nullptr, 0.5f};
        pg8::gemm_phase<EpiResid<false, false, false>, true>(F.lds, g, So, E); SEAM(PH_G2B);
    }
    if (IN(PH_FINAL)) { PHASE_PTRS(); p_final(F, args); }
#undef IN
#undef SEAM
}

extern "C" void kernel_launch(void* const* d_in, const int* in_sizes, int n_in, void* d_out, int out_size, void* d_ws, size_t ws_size, hipStream_t stream) {
    static int grid = 0;
    if (grid == 0) {
        if (n_in != 20 || out_size != M * D || ws_size < WS_END) { fprintf(stderr, "kernel_launch: unexpected shapes (n_in %d out %d ws %zu)\n", n_in, out_size, ws_size); grid = -1; return; }
        int dev = 0, cus = 0, per_cu = 0;
        hipGetDevice(&dev); hipDeviceGetAttribute(&cus, hipDeviceAttributeMultiprocessorCount, dev);
        if (hipFuncSetAttribute((const void*)mega_fwd, hipFuncAttributeMaxDynamicSharedMemorySize, LDS_BYTES) != hipSuccess) { fprintf(stderr, "kernel_launch: hipFuncSetAttribute failed\n"); grid = -1; return; }
        hipOccupancyMaxActiveBlocksPerMultiprocessor(&per_cu, (const void*)mega_fwd, NWAVES * 64, LDS_BYTES);
        (void)hipGetLastError();
        if (per_cu < 1) { fprintf(stderr, "kernel_launch: occupancy query says %d blocks/CU; nothing launched\n", per_cu); grid = -1; return; }
        grid = cus;
    }
    if (grid < 0) return;
    hipMemsetAsync((char*)d_ws + WS_CTL, 0, CTL_ZERO_BYTES, stream);
    Args a{};
    for (int i = 0; i < 20; ++i) a.in[i] = (const float*)d_in[i];
    a.out = (float*)d_out; a.ws = (unsigned char*)d_ws;
    unsigned char* ws = (unsigned char*)d_ws;
    auto run = [&](int lo, int hi) {
#if MK_PER_PHASE
        for (int p = lo; p < hi; ++p) {
            if (MK_SHADOW == 2 && p == PH_MIX_A) { a.ph_lo = p; a.ph_hi = p + 1; a.shadow = 1 | 4; hipLaunchKernelGGL(mega_fwd, dim3(grid), dim3(NWAVES * 64), LDS_BYTES, stream, a); a.shadow = 0; }
            if (MK_SHADOW == 3 && p == PH_MIX_A) { a.ph_lo = p; a.ph_hi = p + 1; a.shadow = 1 | 2; hipLaunchKernelGGL(mega_fwd, dim3(grid), dim3(NWAVES * 64), LDS_BYTES, stream, a); a.shadow = 0; }
            if (MK_SHADOW == 4 && p == PH_MIX_C) { a.ph_lo = p; a.ph_hi = p + 1; a.shadow = 1; hipLaunchKernelGGL(mega_fwd, dim3(grid), dim3(NWAVES * 64), LDS_BYTES, stream, a); a.shadow = 0; }
            if (MK_SHADOW == 1 && p == PH_G1A) { a.ph_lo = p; a.ph_hi = p + 1; a.shadow = 1; hipLaunchKernelGGL(mega_fwd, dim3(grid), dim3(NWAVES * 64), LDS_BYTES, stream, a); a.shadow = 0; }
            for (int rep = 0; rep < ((((MK_DUP_MASK) >> p) & 1) ? 2 : 1); ++rep) { a.ph_lo = p; a.ph_hi = p + 1; hipLaunchKernelGGL(mega_fwd, dim3(grid), dim3(NWAVES * 64), LDS_BYTES, stream, a); }
        }
#else
        a.ph_lo = lo; a.ph_hi = hi;
        void* kargs[] = {(void*)&a};
        hipError_t e = hipLaunchCooperativeKernel((const void*)mega_fwd, dim3(grid), dim3(NWAVES * 64), kargs, LDS_BYTES, stream);
        if (e != hipSuccess) fprintf(stderr, "kernel_launch: cooperative launch failed: %s (grid %d)\n", hipGetErrorString(e), grid);
#endif
    };
    run(PH_P0, PH_COUNT);
}
```

```cpp
#include <hip/hip_runtime.h>
#include <cstdio>
#include <cstdint>

#ifndef MK_DUP_MASK
#define MK_DUP_MASK 0
#endif
#ifndef MK_GPROBE
#define MK_GPROBE 0
#endif
#ifndef MK_SHADOW
#define MK_SHADOW 0
#endif
#ifndef MK_FUSE_FINAL
#define MK_FUSE_FINAL 1
#endif
#ifndef MK_PER_PHASE
#define MK_PER_PHASE 0
#endif

#define GAS __attribute__((address_space(1)))
#define LAS __attribute__((address_space(3)))
typedef _Float16 h16;
typedef _Float16 h16x8 __attribute__((ext_vector_type(8)));
typedef _Float16 h16x4 __attribute__((ext_vector_type(4)));
typedef _Float16 h16x2 __attribute__((ext_vector_type(2)));
typedef float f32x4 __attribute__((ext_vector_type(4)));
typedef float f32x2 __attribute__((ext_vector_type(2)));
typedef unsigned u32x4 __attribute__((ext_vector_type(4)));
typedef unsigned u32x2 __attribute__((ext_vector_type(2)));

constexpr int D = 1024, NB = 4, S = 8192, M = NB * S, DFF = 2816, NGU = 2 * DFF, NMOD = 9;
constexpr int AW = 512, HD = 64, NH = 8, INW = 2560, MBLK = 256, NBLK = S / MBLK, GC = 128;
constexpr float EPS = 1e-6f;
constexpr float C2 = 0.125f * 1.4426950408889634f;
constexpr int PQ = 0, PU = 512, PK = 1024, PV = 1536, PG = 2048;

constexpr size_t MiB = 1u << 20, KiB = 1u << 10;
constexpr size_t WS_CTL = 0, CTL_ZERO_BYTES = 1 * MiB;
constexpr size_t WS_MODP = 1 * MiB;
constexpr size_t WS_GT = 2 * MiB, WS_GP = WS_GT + 64 * KiB;
constexpr size_t WS_BIAS1 = WS_GT + 128 * KiB, WS_BIAS2 = WS_GT + 256 * KiB, WS_BIAS3 = WS_GT + 320 * KiB;
constexpr size_t WS_R1 = 3 * MiB, WS_RG = WS_R1 + 128 * KiB;
constexpr size_t WS_SSQA = 4 * MiB;
constexpr size_t WS_SSQ2 = 5 * MiB, WS_SSQ3 = 7 * MiB, WS_SSQF = 9 * MiB;
constexpr size_t WS_KMP = 11 * MiB;
constexpr size_t WS_ROPE = 12 * MiB;
constexpr size_t WS_WS16 = 14 * MiB;
constexpr size_t WS_WGU1 = 16 * MiB, WS_WD1 = 27 * MiB, WS_WIN = 33 * MiB, WS_WOUT = 38 * MiB, WS_WGU2 = 40 * MiB, WS_WD2 = 51 * MiB;
constexpr size_t WS_HG = 64 * MiB, WS_H = 128 * MiB, WS_ACT = 192 * MiB, WS_PROJ = WS_ACT;
constexpr size_t WS_LISTS = 368 * MiB, WS_END = 384 * MiB;
static_assert(WS_WD2 + (size_t)D * DFF * 2 <= WS_HG && WS_ACT + (size_t)M * DFF * 2 <= WS_LISTS, "ws map");
constexpr int CW_TMO = 0, CW_BAR = 4096;

constexpr int RING_BYTES = 131072, LDSCTL_OFF = RING_BYTES, MISC_OFF = LDSCTL_OFF + 320, LDS_BYTES = 147456;
constexpr int NWAVES = 8;

#define LDS_WAIT() asm volatile("s_waitcnt lgkmcnt(0)" ::: "memory")
#define VM_WAIT() asm volatile("s_waitcnt vmcnt(0)" ::: "memory")

__device__ __forceinline__ float wave_sum(float v) {
#pragma unroll
    for (int o = 1; o < 64; o <<= 1) v += __shfl_xor(v, o);
    return v;
}
__device__ __forceinline__ unsigned pkh(float lo, float hi) { h16x2 v; v.x = (h16)lo; v.y = (h16)hi; return __builtin_bit_cast(unsigned, v); }
__device__ __forceinline__ float silu_fast(float x) { return x * __builtin_amdgcn_rcpf(1.f + __builtin_amdgcn_exp2f(-1.4426950408889634f * x)); }
__device__ __forceinline__ float gelu_fast(float x) {
    const float u2 = 1.5957691216057308f * (x + 0.044715f * x * x * x);
    return x * __builtin_amdgcn_rcpf(1.f + __builtin_amdgcn_exp2f(-1.4426950408889634f * u2));
}
__device__ __forceinline__ float rs16(const GAS float* p) {
    const f32x4 s0 = *(const GAS f32x4*)(p), s1 = *(const GAS f32x4*)(p + 4), s2 = *(const GAS f32x4*)(p + 8), s3 = *(const GAS f32x4*)(p + 12);
    const f32x4 st = (s0 + s1) + (s2 + s3);
    return rsqrtf(((st[0] + st[1]) + (st[2] + st[3])) * (1.f / D) + EPS);
}


__device__ __forceinline__ size_t blk_off(int row, int k, int nt) { return (((size_t)(row >> 8) * nt + (k >> 6)) * 256 + (row & 255)) * 64 + (k & 63); }

namespace pg8 {
constexpr int BM = 256, BK = 64, HALF = 128, HTB = HALF * BK * 2, STAGE_BYTES = 8 * HTB, NXCD = 8, WGM = 8;
__host__ __device__ __forceinline__ int lds_byte(int r, int c) { const int st = (r >> 4) * 2 + (c >> 5), rr = r & 15, cc = c & 31, ob = rr * 64 + cc * 2; return st * 1024 + (ob ^ (((ob >> 9) & 1) << 5)); }
__host__ __device__ __forceinline__ void stage_rc(int b, int& R, int& C) { const int st = b / 1024, sb = b % 1024, swz = sb ^ (((sb >> 9) & 1) << 5); R = (st >> 1) * 16 + swz / 64; C = (st & 1) * 32 + (swz % 64) / 2; }
struct Unit { int pm, pn; };
struct Gemm { const GAS h16* A; const GAS h16* Bt; int lda, N, K; };
struct StaticOrder {
    int nM, nN, nwg, G, c;
    __device__ void init(int M_, int N, int G_, int c_) { nM = M_ / BM; nN = N / BM; nwg = nM * nN; G = G_; c = c_; }
    __device__ bool next(int i, Unit& u) const {
        const long L = (long)i * G + c; if (L >= nwg) return false;
        int wgid = (int)L; { const int q = nwg / NXCD, r = nwg % NXCD, xcd = wgid % NXCD, off = wgid / NXCD; wgid = (xcd < r ? xcd * (q + 1) : r * (q + 1) + (xcd - r) * q) + off; }
        const int nig = WGM * nN, gid = wgid / nig, fm = gid * WGM, gsz = (nM - fm) < WGM ? (nM - fm) : WGM;
        u.pm = fm + ((wgid % nig) % gsz); u.pn = (wgid % nig) / gsz; return true;
    }
};
template <class Epi, bool ALIGN_EPI, int PROBE = 0>
__device__ __forceinline__ void gemm_phase(LAS unsigned char* lds, const Gemm g, const StaticOrder& S, const Epi& E) {
    const int tid = threadIdx.x, wid = __builtin_amdgcn_readfirstlane(tid >> 6), lane = tid & 63, wr = wid >> 2, wc = wid & 3, fr = lane & 15, fq = lane >> 4;
    const int K = g.K, nt = K / BK;
    unsigned voffA[2], voffB[2];
    const bool ablk = (g.lda == 0);
#pragma unroll
    for (int i = 0; i < 2; ++i) { int R, C; stage_rc(tid * 16 + i * 8192, R, C); voffA[i] = (unsigned)(R * (ablk ? BK : g.lda) + C) * 2u; voffB[i] = (unsigned)(R * BK + C) * 2u; }
    const size_t kstepB = (size_t)BM * BK * 2, kstepA = ablk ? kstepB : (size_t)(BK * 2);
    const size_t hstepB = (size_t)HALF * BK * 2, hstepA = ablk ? hstepB : (size_t)HALF * g.lda * 2;
    const size_t tstepB = (size_t)nt * kstepB, tstepA = ablk ? tstepB : 2 * hstepA;
    const unsigned ldsw = (unsigned)wid * 1024u;
    const int aoff = lds_byte(wr * 64 + fr, fq * 8), boff = lds_byte(wc * 32 + fr, fq * 8);
#define PG8_SA(b, h) (((b) * 2 + (h)) * HTB)
#define PG8_SB(b, h) ((4 + (b) * 2 + (h)) * HTB)
#define PG8_STAGE(bufoff, gbase, voff) do { if (PROBE != 2) _Pragma("unroll") for (int _i = 0; _i < 2; ++_i) \
        __builtin_amdgcn_global_load_lds((const unsigned*)((const char*)(gbase) + (voff)[_i]), (LAS unsigned*)(lds + (bufoff) + ldsw + _i * 8192), 16, 0, 0); } while (0)
#define PG8_LDA(dst, b, h) do { _Pragma("unroll") for (int m = 0; m < 4; ++m) _Pragma("unroll") for (int k = 0; k < 2; ++k) dst[m][k] = *(const LAS h16x8*)(lds + PG8_SA(b, h) + aoff + m * 2048 + k * 1024); } while (0)
#define PG8_LDB(dst, b, h) do { _Pragma("unroll") for (int n = 0; n < 2; ++n) _Pragma("unroll") for (int k = 0; k < 2; ++k) dst[n][k] = *(const LAS h16x8*)(lds + PG8_SB(b, h) + boff + n * 2048 + k * 1024); } while (0)
#define PG8_MMA(ai, bj, At, Bt) do { if (PROBE == 1 && (bj) == 1) break; __builtin_amdgcn_s_setprio(1); _Pragma("unroll") for (int m = 0; m < 4; ++m) _Pragma("unroll") for (int n = 0; n < 2; ++n) _Pragma("unroll") for (int k = 0; k < 2; ++k) \
        acc[ai][bj][m][n] = __builtin_amdgcn_mfma_f32_16x16x32_f16(Bt[n][k], At[m][k], acc[ai][bj][m][n], 0, 0, 0); __builtin_amdgcn_s_setprio(0); } while (0)
#define PG8_WAIT_V(n) asm volatile("s_waitcnt vmcnt(" #n ")" ::: "memory")
#define PG8_WAIT_L(n) asm volatile("s_waitcnt lgkmcnt(" #n ")" ::: "memory")
#define PG8_BAR __builtin_amdgcn_s_barrier()
#define PG8_SCHED __builtin_amdgcn_sched_barrier(0)
    Unit cur, nxt; int ui = 0;
    if (!S.next(0, cur)) return;
    f32x4 acc[2][2][4][2];
#pragma unroll
    for (int a = 0; a < 2; ++a)
#pragma unroll
        for (int b = 0; b < 2; ++b)
#pragma unroll
            for (int m = 0; m < 4; ++m)
#pragma unroll
                for (int n = 0; n < 2; ++n) acc[a][b][m][n] = (f32x4){0.f, 0.f, 0.f, 0.f};
    h16x8 At[4][2], B0[2][2], B1[2][2];
    const char* cA = (const char*)g.A + (size_t)cur.pm * tstepA; const char* cB = (const char*)g.Bt + (size_t)cur.pn * tstepB;
    PG8_STAGE(PG8_SB(0, 0), cB, voffB); PG8_STAGE(PG8_SB(0, 1), cB + hstepB, voffB); PG8_STAGE(PG8_SA(0, 0), cA, voffA); PG8_STAGE(PG8_SA(0, 1), cA + hstepA, voffA);
    if (wr == 1) PG8_BAR;
    PG8_WAIT_V(2); PG8_BAR;
    PG8_STAGE(PG8_SB(1, 0), cB + kstepB, voffB); PG8_STAGE(PG8_SA(1, 0), cA + kstepA, voffA); PG8_STAGE(PG8_SB(1, 1), cB + hstepB + kstepB, voffB);
    PG8_WAIT_V(6); PG8_BAR;
    for (;;) {
        const bool has_next = S.next(ui + 1, nxt);
        const char* nA = has_next ? (const char*)g.A + (size_t)nxt.pm * tstepA : cA; const char* nB = has_next ? (const char*)g.Bt + (size_t)nxt.pn * tstepB : cB;
        for (int t = 0; t < nt; t += 2) {
            const bool last = (t == nt - 2);
            const char* a1 = cA + (size_t)(t + 1) * kstepA;
            const char* a2 = last ? nA : cA + (size_t)(t + 2) * kstepA; const char* b2 = last ? nB : cB + (size_t)(t + 2) * kstepB;
            const char* a3 = a2 + kstepA; const char* b3 = b2 + kstepB;
            if constexpr (Epi::MID) { if (t == nt / 2) E.mid(acc, cur, ui, wr, wc, fr, fq); }
            PG8_LDB(B0, 0, 0); PG8_LDB(B1, 0, 1); PG8_SCHED; PG8_LDA(At, 0, 0); PG8_STAGE(PG8_SA(1, 1), a1 + hstepA, voffA);
            PG8_WAIT_V(8); PG8_WAIT_L(0); PG8_BAR; PG8_MMA(0, 0, At, B0); PG8_MMA(0, 1, At, B1); PG8_BAR; PG8_SCHED;
            PG8_LDA(At, 0, 1); PG8_STAGE(PG8_SB(0, 0), b2, voffB); PG8_STAGE(PG8_SB(0, 1), b2 + hstepB, voffB); PG8_STAGE(PG8_SA(0, 0), a2, voffA);
            PG8_WAIT_V(8); PG8_WAIT_L(0); PG8_BAR; PG8_MMA(1, 0, At, B0); PG8_MMA(1, 1, At, B1); PG8_BAR; PG8_SCHED;
            PG8_LDB(B0, 1, 0); PG8_LDB(B1, 1, 1); PG8_SCHED; PG8_LDA(At, 1, 0); PG8_STAGE(PG8_SA(0, 1), a2 + hstepA, voffA);
            PG8_WAIT_V(8); PG8_WAIT_L(0); PG8_BAR; PG8_MMA(0, 0, At, B0); PG8_MMA(0, 1, At, B1); PG8_BAR; PG8_SCHED;
            PG8_LDA(At, 1, 1); PG8_STAGE(PG8_SB(1, 0), b3, voffB); PG8_STAGE(PG8_SB(1, 1), b3 + hstepB, voffB); PG8_STAGE(PG8_SA(1, 0), a3, voffA);
            PG8_WAIT_V(8); PG8_WAIT_L(0); PG8_BAR; PG8_MMA(1, 0, At, B0); PG8_MMA(1, 1, At, B1); PG8_BAR; PG8_SCHED;
        }
        if constexpr (ALIGN_EPI) { if (wr == 0) PG8_BAR; }
        E(acc, cur, ui, wr, wc, fr, fq);
        if (!has_next) break;
#pragma unroll
        for (int a = 0; a < 2; ++a)
#pragma unroll
            for (int b = 0; b < 2; ++b)
#pragma unroll
                for (int m = 0; m < 4; ++m)
#pragma unroll
                    for (int n = 0; n < 2; ++n) acc[a][b][m][n] = (f32x4){0.f, 0.f, 0.f, 0.f};
        cur = nxt; cA = nA; cB = nB; ++ui;
        if constexpr (ALIGN_EPI) { if (wr == 1) PG8_BAR; }
    }
    PG8_WAIT_V(0);
    if constexpr (!ALIGN_EPI) { if (wr == 0) PG8_BAR; }
    PG8_BAR;
#undef PG8_SA
#undef PG8_SB
#undef PG8_STAGE
#undef PG8_LDA
#undef PG8_LDB
#undef PG8_MMA
#undef PG8_WAIT_V
#undef PG8_WAIT_L
#undef PG8_BAR
#undef PG8_SCHED
}
}

typedef const f32x4 (&AccRef)[2][2][4][2];
struct EpiSwiglu {
    static constexpr bool MID = false;
    GAS h16* act; const LAS float* rtab; const GAS float* bias;
    __device__ __forceinline__ void mid(f32x4 (&)[2][2][4][2], const pg8::Unit&, int, int, int, int, int) const {}
    __device__ __forceinline__ void operator()(AccRef acc, const pg8::Unit& u, int ui, int wr, int wc, int fr, int fq) const {
        const int b = u.pm >> 5, row0 = u.pm * 256 + wr * 64 + fr;
        const GAS float* bp = bias + b * NGU + u.pn * 256 + wc * 32 + 4 * fq;
        f32x4 bv[2][2];
#pragma unroll
        for (int bj = 0; bj < 2; ++bj)
#pragma unroll
            for (int n = 0; n < 2; ++n) bv[bj][n] = *(const GAS f32x4*)(bp + bj * 128 + n * 16);
        const LAS float* rt = rtab + ui * 256 + wr * 64 + fr;
        const int hid0 = u.pn * 128 + wc * 32 + fq * 8;
#pragma unroll
        for (int ai = 0; ai < 2; ++ai)
#pragma unroll
            for (int m = 0; m < 4; ++m) {
                const int ro = ai * 128 + m * 16; const float rs = rt[ro];
                u32x4 w;
#pragma unroll
                for (int n = 0; n < 2; ++n) {
                    const f32x4 gv = acc[ai][0][m][n] * rs + bv[0][n], uv = acc[ai][1][m][n] * rs + bv[1][n];
                    const float a0 = silu_fast(gv[0]) * uv[0], a1 = silu_fast(gv[1]) * uv[1], a2 = silu_fast(gv[2]) * uv[2], a3 = silu_fast(gv[3]) * uv[3];
                    w[2 * n] = pkh(a0, a1); w[2 * n + 1] = pkh(a2, a3);
                }
                *(GAS u32x4*)(act + blk_off(row0 + ro, hid0, DFF / 64)) = w;
            }
    }
};
template <bool RES_F32, bool TWOSCALE, bool WRITE_HG> struct EpiResid {
    static constexpr bool MID = TWOSCALE;
    const GAS float* xres; GAS h16* H; GAS h16* HG; const GAS float* cs; const GAS float* gp; GAS float* ssq; const LAS float* sct; float cmul;
    __device__ __forceinline__ void mid(f32x4 (&acc)[2][2][4][2], const pg8::Unit& u, int ui, int wr, int wc, int fr, int fq) const {
        if constexpr (TWOSCALE) {
            const LAS float* t = sct + ui * 512 + wr * 64 + fr;
#pragma unroll
            for (int ai = 0; ai < 2; ++ai)
#pragma unroll
                for (int m = 0; m < 4; ++m) { const float f = t[ai * 128 + m * 16];
#pragma unroll
                    for (int bj = 0; bj < 2; ++bj)
#pragma unroll
                        for (int n = 0; n < 2; ++n) acc[ai][bj][m][n] *= f; }
        }
    }
    __device__ __forceinline__ void operator()(AccRef acc, const pg8::Unit& u, int ui, int wr, int wc, int fr, int fq) const {
        const int b = u.pm >> 5, row0 = u.pm * 256 + wr * 64 + fr, col0 = u.pn * 256 + wc * 32 + 8 * fq;
        f32x4 csv[2][2], gpv[2][2];
#pragma unroll
        for (int bj = 0; bj < 2; ++bj)
#pragma unroll
            for (int n = 0; n < 2; ++n) { csv[bj][n] = *(const GAS f32x4*)(cs + b * D + col0 + bj * 128 + 4 * n) * cmul; if constexpr (WRITE_HG) gpv[bj][n] = *(const GAS f32x4*)(gp + b * D + col0 + bj * 128 + 4 * n); }
        constexpr int MB_ = RES_F32 ? 2 : 4;
#pragma unroll
        for (int ai = 0; ai < 2; ++ai)
#pragma unroll
        for (int m0 = 0; m0 < 4; m0 += MB_) {
            f32x4 rf[4][2][2]; h16x8 rh[4][2];
#pragma unroll
            for (int m = m0; m < m0 + MB_; ++m)
#pragma unroll
                for (int bj = 0; bj < 2; ++bj) { const size_t off = (size_t)(row0 + ai * 128 + m * 16) * D + col0 + bj * 128;
                    if constexpr (RES_F32) { rf[m][bj][0] = *(const GAS f32x4*)(xres + off); rf[m][bj][1] = *(const GAS f32x4*)(xres + off + 4); }
                    else rh[m][bj] = *(const GAS h16x8*)(H + off); }
            asm volatile("" ::: "memory");
#pragma unroll
            for (int m = m0; m < m0 + MB_; ++m) {
                const int row = row0 + ai * 128 + m * 16; const size_t off = (size_t)row * D + col0;
                float rsc = 1.f; if constexpr (TWOSCALE) rsc = sct[ui * 512 + 256 + wr * 64 + fr + ai * 128 + m * 16];
                float q = 0.f;
#pragma unroll
                for (int bj = 0; bj < 2; ++bj) {
                    f32x4 r0, r1;
                    if constexpr (RES_F32) { r0 = rf[m][bj][0]; r1 = rf[m][bj][1]; }
                    else { const h16x8 hv = rh[m][bj]; r0 = (f32x4){(float)hv[0], (float)hv[1], (float)hv[2], (float)hv[3]}; r1 = (f32x4){(float)hv[4], (float)hv[5], (float)hv[6], (float)hv[7]}; }
                    const f32x4 v0 = r0 + csv[bj][0] * (acc[ai][bj][m][0] * rsc), v1 = r1 + csv[bj][1] * (acc[ai][bj][m][1] * rsc);
                    q += ((v0[0] * v0[0] + v0[1] * v0[1]) + (v0[2] * v0[2] + v0[3] * v0[3])) + ((v1[0] * v1[0] + v1[1] * v1[1]) + (v1[2] * v1[2] + v1[3] * v1[3]));
                    u32x4 w; w[0] = pkh(v0[0], v0[1]); w[1] = pkh(v0[2], v0[3]); w[2] = pkh(v1[0], v1[1]); w[3] = pkh(v1[2], v1[3]);
                    *(GAS u32x4*)(H + off + bj * 128) = w;
                    if constexpr (WRITE_HG) { const f32x4 g0 = v0 * gpv[bj][0], g1 = v1 * gpv[bj][1];
                        u32x4 wg; wg[0] = pkh(g0[0], g0[1]); wg[1] = pkh(g0[2], g0[3]); wg[2] = pkh(g1[0], g1[1]); wg[3] = pkh(g1[2], g1[3]);
                        *(GAS u32x4*)(HG + blk_off(row, col0 + bj * 128, D / 64)) = wg; }
                }
                q += __shfl_xor(q, 16); q += __shfl_xor(q, 32);
                if (fq == 0) ssq[(size_t)row * 16 + u.pn * 4 + wc] = q;
            }
        }
    }
};
constexpr int CW_PAN = 16384;
struct EpiFinal {
    static constexpr bool MID = false;
    const GAS h16* H; const GAS float* cs; const GAS float* gfin; GAS float* out; unsigned* xs; unsigned* cnt; unsigned* tmo; LAS float* P; LAS float* Sx; float cmul;
    __device__ __forceinline__ void mid(f32x4 (&)[2][2][4][2], const pg8::Unit&, int, int, int, int, int) const {}
    __device__ __forceinline__ void operator()(f32x4 (&acc)[2][2][4][2], const pg8::Unit& u, int ui, int wr, int wc, int fr, int fq) const {
        const int b = u.pm >> 5, row0 = u.pm * 256 + wr * 64 + fr, col0 = u.pn * 256 + wc * 32 + 8 * fq;
        const int tid = threadIdx.x, lane = tid & 63, wid = __builtin_amdgcn_readfirstlane(tid >> 6);
        f32x4 csv[2][2];
#pragma unroll
        for (int bj = 0; bj < 2; ++bj)
#pragma unroll
            for (int n = 0; n < 2; ++n) csv[bj][n] = *(const GAS f32x4*)(cs + b * D + col0 + bj * 128 + 4 * n) * cmul;
#pragma unroll
        for (int ai = 0; ai < 2; ++ai) {
            h16x8 rh[4][2];
#pragma unroll
            for (int m = 0; m < 4; ++m)
#pragma unroll
                for (int bj = 0; bj < 2; ++bj) rh[m][bj] = *(const GAS h16x8*)(H + (size_t)(row0 + ai * 128 + m * 16) * D + col0 + bj * 128);
#pragma unroll
            for (int m = 0; m < 4; ++m) {
                float q = 0.f;
#pragma unroll
                for (int bj = 0; bj < 2; ++bj) { const h16x8 hv = rh[m][bj];
                    const f32x4 v0 = (f32x4){(float)hv[0], (float)hv[1], (float)hv[2], (float)hv[3]} + csv[bj][0] * acc[ai][bj][m][0], v1 = (f32x4){(float)hv[4], (float)hv[5], (float)hv[6], (float)hv[7]} + csv[bj][1] * acc[ai][bj][m][1];
                    acc[ai][bj][m][0] = v0; acc[ai][bj][m][1] = v1;
                    q += ((v0[0] * v0[0] + v0[1] * v0[1]) + (v0[2] * v0[2] + v0[3] * v0[3])) + ((v1[0] * v1[0] + v1[1] * v1[1]) + (v1[2] * v1[2] + v1[3] * v1[3])); }
                q += __shfl_xor(q, 16); q += __shfl_xor(q, 32);
                if (fq == 0) P[(ai * 128 + wr * 64 + m * 16 + fr) * 4 + wc] = q;
            }
        }
        asm volatile("s_waitcnt lgkmcnt(0)" ::: "memory"); __builtin_amdgcn_s_barrier(); asm volatile("" ::: "memory");
        if (tid < 256) {
            const f32x4 p4 = *(const LAS f32x4*)(P + tid * 4);
            __hip_atomic_store(xs + ((size_t)(u.pm * 256 + tid) * 4 + u.pn), __float_as_uint((p4[0] + p4[1]) + (p4[2] + p4[3])), __ATOMIC_RELAXED, __HIP_MEMORY_SCOPE_AGENT);
        }
        asm volatile("s_waitcnt vmcnt(0)" ::: "memory");
        if (wid < 4 && lane == 0) __hip_atomic_fetch_add(cnt + 64 * u.pm, 1u, __ATOMIC_RELAXED, __HIP_MEMORY_SCOPE_AGENT);
        if (wid == 0) {
            unsigned sp = 0u;
            while ((unsigned)__builtin_amdgcn_readfirstlane(__hip_atomic_load(cnt + 64 * u.pm, __ATOMIC_RELAXED, __HIP_MEMORY_SCOPE_AGENT)) < 16u) {
                __builtin_amdgcn_s_sleep(2);
                if (++sp > (1u << 16)) { if (lane == 0) __hip_atomic_store(tmo, 1u, __ATOMIC_RELAXED, __HIP_MEMORY_SCOPE_AGENT); break; }
            }
            __builtin_amdgcn_fence(__ATOMIC_ACQUIRE, "agent");
        }
        asm volatile("s_waitcnt vmcnt(0) lgkmcnt(0)" ::: "memory"); __builtin_amdgcn_s_barrier(); asm volatile("" ::: "memory");
        if (tid < 256) {
            const unsigned* sl = xs + (size_t)(u.pm * 256 + tid) * 4;
            const float s0 = __uint_as_float(__hip_atomic_load(sl + 0, __ATOMIC_RELAXED, __HIP_MEMORY_SCOPE_AGENT)), s1 = __uint_as_float(__hip_atomic_load(sl + 1, __ATOMIC_RELAXED, __HIP_MEMORY_SCOPE_AGENT)),
                        s2 = __uint_as_float(__hip_atomic_load(sl + 2, __ATOMIC_RELAXED, __HIP_MEMORY_SCOPE_AGENT)), s3 = __uint_as_float(__hip_atomic_load(sl + 3, __ATOMIC_RELAXED, __HIP_MEMORY_SCOPE_AGENT));
            Sx[tid] = rsqrtf(((s0 + s1) + (s2 + s3)) * (1.f / D) + EPS);
        }
        asm volatile("s_waitcnt vmcnt(0) lgkmcnt(0)" ::: "memory"); __builtin_amdgcn_s_barrier(); asm volatile("" ::: "memory");
        f32x4 gv[2][2];
#pragma unroll
        for (int bj = 0; bj < 2; ++bj)
#pragma unroll
            for (int n = 0; n < 2; ++n) gv[bj][n] = *(const GAS f32x4*)(gfin + col0 + bj * 128 + 4 * n);
#pragma unroll
        for (int ai = 0; ai < 2; ++ai)
#pragma unroll
            for (int m = 0; m < 4; ++m) { const int rl = ai * 128 + wr * 64 + m * 16 + fr; const float rs = Sx[rl]; GAS float* op = out + (size_t)(u.pm * 256 + rl) * D + col0;
#pragma unroll
                for (int bj = 0; bj < 2; ++bj) { *(GAS f32x4*)(op + bj * 128) = acc[ai][bj][m][0] * rs * gv[bj][0]; *(GAS f32x4*)(op + bj * 128 + 4) = acc[ai][bj][m][1] * rs * gv[bj][1]; } }
        asm volatile("s_waitcnt lgkmcnt(0)" ::: "memory"); __builtin_amdgcn_s_barrier(); asm volatile("" ::: "memory");
    }
};
struct EpiInproj {
    static constexpr bool MID = false;
    GAS h16* proj; const LAS float* rtab; const GAS float* bias; const GAS float* rope; GAS float* kmp;
    __device__ __forceinline__ void mid(f32x4 (&)[2][2][4][2], const pg8::Unit&, int, int, int, int, int) const {}
    __device__ __forceinline__ void operator()(AccRef acc, const pg8::Unit& u, int ui, int wr, int wc, int fr, int fq) const {
        const int b = u.pm >> 5, row0 = u.pm * 256 + wr * 64 + fr, region = u.pn >> 1;
        const GAS float* bp = bias + b * INW + u.pn * 256 + wc * 32 + 4 * fq;
        f32x4 bv[2][2];
#pragma unroll
        for (int bj = 0; bj < 2; ++bj)
#pragma unroll
            for (int n = 0; n < 2; ++n) bv[bj][n] = *(const GAS f32x4*)(bp + bj * 128 + n * 16);
        const bool is_rope = (region == 0) || (region == 2);
        f32x4 csum[2][2];
#pragma unroll
        for (int bj = 0; bj < 2; ++bj)
#pragma unroll
            for (int n = 0; n < 2; ++n) csum[bj][n] = (f32x4){0.f, 0.f, 0.f, 0.f};
        const LAS float* rt = rtab + ui * 256 + wr * 64 + fr;
#pragma unroll
        for (int ai = 0; ai < 2; ++ai)
#pragma unroll
        for (int m0 = 0; m0 < 4; m0 += 2) {
            f32x4 rcs[4][2], rsn[4][2];
            if (is_rope) {
#pragma unroll
                for (int m = m0; m < m0 + 2; ++m) { const GAS float* rp = rope + (size_t)((row0 + ai * 128 + m * 16) & (S - 1)) * 64 + 4 * fq;
#pragma unroll
                    for (int n = 0; n < 2; ++n) { rcs[m][n] = *(const GAS f32x4*)(rp + 16 * n); rsn[m][n] = *(const GAS f32x4*)(rp + 32 + 16 * n); } }
            }
            asm volatile("" ::: "memory");
#pragma unroll
            for (int m = m0; m < m0 + 2; ++m) {
                const int row = row0 + ai * 128 + m * 16;
                const float rs = rt[ai * 128 + m * 16];
                f32x4 v[2][2];
#pragma unroll
                for (int bj = 0; bj < 2; ++bj)
#pragma unroll
                    for (int n = 0; n < 2; ++n) v[bj][n] = acc[ai][bj][m][n] * rs + bv[bj][n];
                GAS h16* prow = proj + (size_t)row * INW + region * 512 + (u.pn & 1) * 256;
                if (is_rope) {
                    const float qs = (region == 0) ? C2 : 1.f;
#pragma unroll
                    for (int n = 0; n < 2; ++n) {
                        const f32x4 cs4 = rcs[m][n] * qs, sn4 = rsn[m][n] * qs;
                        const f32x4 x1 = v[0][n], x2 = v[1][n];
                        v[0][n] = x1 * cs4 - x2 * sn4; v[1][n] = x2 * cs4 + x1 * sn4;
                    }
                    GAS h16* hp = prow + wc * 64 + 16 * fq;
#pragma unroll
                    for (int bj = 0; bj < 2; ++bj) { u32x4 w; w[0] = pkh(v[bj][0][0], v[bj][0][1]); w[1] = pkh(v[bj][0][2], v[bj][0][3]); w[2] = pkh(v[bj][1][0], v[bj][1][1]); w[3] = pkh(v[bj][1][2], v[bj][1][3]);
                        *(GAS u32x4*)(hp + 8 * bj) = w; }
                    if (region == 2) {
#pragma unroll
                        for (int bj = 0; bj < 2; ++bj)
#pragma unroll
                            for (int n = 0; n < 2; ++n) csum[bj][n] += v[bj][n];
                    }
                } else {
                    if (region == 1 || region == 4) {
#pragma unroll
                        for (int bj = 0; bj < 2; ++bj)
#pragma unroll
                            for (int n = 0; n < 2; ++n)
#pragma unroll
                                for (int j = 0; j < 4; ++j) v[bj][n][j] = gelu_fast(v[bj][n][j]);
                    }
                    GAS h16* hp = prow + wc * 32 + 8 * fq;
#pragma unroll
                    for (int bj = 0; bj < 2; ++bj) { u32x4 w; w[0] = pkh(v[bj][0][0], v[bj][0][1]); w[1] = pkh(v[bj][0][2], v[bj][0][3]); w[2] = pkh(v[bj][1][0], v[bj][1][1]); w[3] = pkh(v[bj][1][2], v[bj][1][3]);
                        *(GAS u32x4*)(hp + 128 * bj) = w; }
                }
            }
        }
        if (region == 2) {
#pragma unroll
            for (int bj = 0; bj < 2; ++bj)
#pragma unroll
                for (int n = 0; n < 2; ++n)
#pragma unroll
                    for (int j = 0; j < 4; ++j) { float t = csum[bj][n][j]; t += __shfl_xor(t, 1); t += __shfl_xor(t, 2); t += __shfl_xor(t, 4); t += __shfl_xor(t, 8); csum[bj][n][j] = t; }
            if (fr == 0) {
                GAS float* kp = kmp + ((size_t)((b * NBLK + (u.pm & 31)) * 2 + wr)) * 512 + ((u.pn & 1) * 4 + wc) * 64 + 16 * fq;
#pragma unroll
                for (int bj = 0; bj < 2; ++bj)
#pragma unroll
                    for (int n = 0; n < 2; ++n) *(GAS f32x4*)(kp + 8 * bj + 4 * n) = csum[bj][n];
            }
        }
    }
};

#define XB_TMO      128
#define XB_XCNT(j)  (256  + 64 * (j))
#define XB_XSUB(j)  (1280 + 64 * (j))
#define XB_XGEN(j)  (2304 + 64 * (j))
#define XB_TOP      3328
#define XB_TOPGEN   3392
#define XCD_BAR_WORDS 3456
#define XB_SPIN_CAP (1u << 18)
__device__ __forceinline__ unsigned xb_ld(unsigned* p)              { return __hip_atomic_load(p, __ATOMIC_RELAXED, __HIP_MEMORY_SCOPE_AGENT); }
__device__ __forceinline__ unsigned xb_add(unsigned* p, unsigned v) { return __hip_atomic_fetch_add(p, v, __ATOMIC_RELAXED, __HIP_MEMORY_SCOPE_AGENT); }
__device__ __forceinline__ unsigned xb_xcc_id() { return (unsigned)__builtin_amdgcn_s_getreg((3 << 11) | 20) & 0xFu; }
#define XB_SPIN(cond, bar) do { unsigned _sp = 0; while (cond) { __builtin_amdgcn_s_sleep(1); \
    if ((++_sp & 255u) == 0u) { if (xb_ld(&(bar)[XB_TMO])) break; if (_sp > XB_SPIN_CAP) { atomicAdd(&(bar)[XB_TMO], 1u); break; } } } } while (0)
struct XcdBarrier { unsigned* bar; unsigned x; volatile LAS unsigned* st; };
__device__ __forceinline__ XcdBarrier xcd_barrier_post(unsigned* bar, volatile LAS unsigned* st) {
    XcdBarrier b; b.bar = bar; b.x = xb_xcc_id(); b.st = st;
    if (threadIdx.x == 0) (void)xb_add(&bar[XB_XCNT(b.x)], 1u);
    return b;
}
__device__ __forceinline__ void xcd_barrier_complete(unsigned* bar, unsigned x, unsigned& nloc, unsigned& nx) {
    const unsigned G = gridDim.x * gridDim.y * gridDim.z;
    unsigned sum, cnt, mine, sp = 0u;
    for (;;) {
        sum = 0u; cnt = 0u; mine = 0u;
#pragma unroll
        for (unsigned j = 0; j < 16; ++j) { const unsigned c = xb_ld(&bar[XB_XCNT(j)]); sum += c; cnt += (c > 0u) ? 1u : 0u; mine = (j == x) ? c : mine; }
        if (sum == G) break;
        __builtin_amdgcn_s_sleep(1);
        if ((++sp & 255u) == 0u) { if (xb_ld(&bar[XB_TMO])) break; if (sp > XB_SPIN_CAP) { atomicAdd(&bar[XB_TMO], 1u); break; } }
    }
    nloc = mine > 0u ? mine : 1u; nx = cnt > 0u ? cnt : 1u;
}
__device__ __forceinline__ void xcd_barrier(const XcdBarrier& b) {
    asm volatile("s_waitcnt vmcnt(0)" ::: "memory");
    __syncthreads();
    if (threadIdx.x == 0) {
        unsigned* bar = b.bar;
        __builtin_amdgcn_s_waitcnt(0);
        unsigned nloc = b.st[0], nx = b.st[1];
        if (nloc == 0u) { xcd_barrier_complete(bar, b.x, nloc, nx); b.st[0] = nloc; b.st[1] = nx; }
        const unsigned old = xb_add(&bar[XB_XSUB(b.x)], 1u);
        const unsigned gen = old / nloc;
        if (old + 1u == (gen + 1u) * nloc) {
            __builtin_amdgcn_fence(__ATOMIC_RELEASE, "agent");
            asm volatile("s_waitcnt vmcnt(0)" ::: "memory");
            const unsigned og = xb_add(&bar[XB_TOP], 1u);
            const unsigned tg = og / nx;
            if (og + 1u == (tg + 1u) * nx) xb_add(&bar[XB_TOPGEN], 1u);
            else XB_SPIN(xb_ld(&bar[XB_TOPGEN]) == tg, bar);
            __builtin_amdgcn_fence(__ATOMIC_ACQUIRE, "agent");
            xb_add(&bar[XB_XGEN(b.x)], 1u);
            asm volatile("s_waitcnt vmcnt(0)" ::: "memory");
        } else {
            XB_SPIN(xb_ld(&bar[XB_XGEN(b.x)]) == gen, bar);
            __builtin_amdgcn_fence(__ATOMIC_ACQUIRE, "agent");
            asm volatile("s_waitcnt vmcnt(0)" ::: "memory");
        }
    }
    __syncthreads();
}

#define GIN(a_, i_) ((const GAS float*)(a_).in[i_])
struct Args { const float* in[20]; float* out; unsigned char* ws; int ph_lo, ph_hi; int shadow, pad; };
struct Frame {
    LAS unsigned char* lds; volatile LAS unsigned* MISC; unsigned* ctl;
    int tid, lane, wave, vcu, G;
    unsigned char* ws; GAS float* out;
};

__device__ __forceinline__ int p8(int l) { return (l & ~31) + 16 * ((l >> 2) & 1) + 4 * ((l >> 3) & 3) + (l & 3); }
__device__ __forceinline__ int phys_gu(int L) { const int isu = L >= DFF, hid = isu ? L - DFF : L, pn = hid >> 7, hh = hid & 127; return 256 * pn + 128 * isu + p8(hh); }
__device__ __forceinline__ int phys_in(int L) {
    const int reg = L >> 9, l = L & 511;
    const int preg = reg == 0 ? 0 : reg == 1 ? 2 : reg == 2 ? 3 : reg == 3 ? 1 : 4;
    if (reg <= 1) { const int head = l >> 6, d = l & 63, bj = d >> 5, i = d & 31; return 512 * preg + 256 * (head >> 2) + 128 * bj + 32 * (head & 3) + i; }
    return 512 * preg + p8(l);
}
enum PhysKind { PH_GU = 0, PH_P8 = 1, PH_IN = 2 };
template <int KIND> __device__ __forceinline__ int physmap(int L) { return KIND == PH_GU ? phys_gu(L) : KIND == PH_P8 ? p8(L) : phys_in(L); }

template <int KIND> __device__ __forceinline__ void p0_transpose_item(const GAS float* W, int K, int N, GAS h16* WT, const GAS float* kscale, LAS float* scr, int item, int lane) {
    const int nblk = N / 32, kb = item / nblk, nb = item % nblk, k0 = 64 * kb, n0 = 32 * nb;
    float wv[32];
#pragma unroll
    for (int i = 0; i < 32; ++i) { const int kk = 2 * i + (lane >> 5); wv[i] = W[(size_t)(k0 + kk) * N + n0 + (lane & 31)]; }
    if (kscale) {
#pragma unroll
        for (int i = 0; i < 32; ++i) wv[i] *= kscale[k0 + 2 * i + (lane >> 5)]; }
#pragma unroll
    for (int i = 0; i < 32; ++i) scr[(2 * i + (lane >> 5)) * 33 + (lane & 31)] = wv[i];
    LDS_WAIT(); asm volatile("" ::: "memory");
    const int c = lane & 7;
#pragma unroll
    for (int j = 0; j < 4; ++j) { const int n = (lane >> 3) + 8 * j; const LAS float* s = scr + (8 * c) * 33 + n;
        u32x4 o; o.x = pkh(s[0 * 33], s[1 * 33]); o.y = pkh(s[2 * 33], s[3 * 33]); o.z = pkh(s[4 * 33], s[5 * 33]); o.w = pkh(s[6 * 33], s[7 * 33]);
        *(GAS u32x4*)(WT + blk_off(physmap<KIND>(n0 + n), k0 + 8 * c, K / 64)) = o; }
    LDS_WAIT(); asm volatile("" ::: "memory");
}

__device__ __forceinline__ void p0_prologue(const Frame& F0, const Args& a) {
    Frame F = F0; F.tid = threadIdx.x; F.lane = F.tid & 63; F.wave = __builtin_amdgcn_readfirstlane(F.tid >> 6);
    const GAS float* c = GIN(a, 1); const GAS float* w_ada = GIN(a, 2);
    {
        LAS float* red = (LAS float*)F.lds;
        for (int item = F.vcu; item < 72 * 4; item += F.G) {
            const int cg = item % 72, kq = item / 72, hlf = F.lane >> 5, col = cg * 128 + (F.lane & 31) * 4;
            f32x4 acc[4] = {{0.f, 0.f, 0.f, 0.f}, {0.f, 0.f, 0.f, 0.f}, {0.f, 0.f, 0.f, 0.f}, {0.f, 0.f, 0.f, 0.f}};
            const int kbase = kq * 256 + F.wave * 32 + hlf;
#pragma unroll
            for (int i = 0; i < 16; ++i) { const int k = kbase + 2 * i; const f32x4 w4 = *(const GAS f32x4*)(w_ada + (size_t)k * (NMOD * D) + col);
#pragma unroll
                for (int b = 0; b < 4; ++b) { const float cv = c[b * D + k]; const float sv = cv / (1.f + __expf(-cv)); acc[b] += w4 * sv; } }
#pragma unroll
            for (int b = 0; b < 4; ++b)
#pragma unroll
                for (int j = 0; j < 4; ++j) acc[b][j] += __shfl_xor(acc[b][j], 32);
            if (hlf == 0) {
#pragma unroll
                for (int b = 0; b < 4; ++b) *(LAS f32x4*)(red + (F.wave * 4 + b) * 128 + (F.lane & 31) * 4) = acc[b];
            }
            __syncthreads();
            { const int b = F.tid >> 7, cc = F.tid & 127; float s = 0.f;
#pragma unroll
              for (int w = 0; w < 8; ++w) s += red[(w * 4 + b) * 128 + cc];
              ((GAS float*)(F.ws + WS_MODP))[(size_t)(kq * 4 + b) * (NMOD * D) + cg * 128 + cc] = s; }
            __syncthreads();
        }
    }
    LAS float* scr = (LAS float*)(F.lds + F.wave * 16384);
    const int gw = F.vcu * NWAVES + F.wave, NGW = F.G * NWAVES;
    constexpr int I_GU = (D / 64) * (NGU / 32), I_DN = (DFF / 64) * (D / 32), I_IN = (D / 64) * (INW / 32), I_OUT = (D / 64) * (D / 32);
    constexpr int NITEMS = 2 * I_GU + 2 * I_DN + I_IN + I_OUT;
    for (int it = gw; it < NITEMS; it += NGW) {
        int r = it;
        if (r < I_GU) { p0_transpose_item<PH_GU>(GIN(a, 5), D, NGU, (GAS h16*)(F.ws + WS_WGU1), nullptr, scr, r, F.lane); continue; } r -= I_GU;
        if (r < I_GU) { p0_transpose_item<PH_GU>(GIN(a, 17), D, NGU, (GAS h16*)(F.ws + WS_WGU2), nullptr, scr, r, F.lane); continue; } r -= I_GU;
        if (r < I_DN) { p0_transpose_item<PH_P8>(GIN(a, 6), DFF, D, (GAS h16*)(F.ws + WS_WD1), nullptr, scr, r, F.lane); continue; } r -= I_DN;
        if (r < I_DN) { p0_transpose_item<PH_P8>(GIN(a, 18), DFF, D, (GAS h16*)(F.ws + WS_WD2), nullptr, scr, r, F.lane); continue; } r -= I_DN;
        if (r < I_IN) { p0_transpose_item<PH_IN>(GIN(a, 8), D, INW, (GAS h16*)(F.ws + WS_WIN), nullptr, scr, r, F.lane); continue; } r -= I_IN;
        {
            const int kb = r / (D / 32); const GAS float* ks = (kb < 8) ? GIN(a, 13) : (GIN(a, 14) - 512);
            p0_transpose_item<PH_P8>(GIN(a, 15), D, D, (GAS h16*)(F.ws + WS_WOUT), ks, scr, r, F.lane); }
    }
    for (int pos = gw; pos < S; pos += NGW) {
        const int i = F.lane & 31;
        const float inv = (float)exp(-(double)i / 32.0 * 9.210340371976184);
        const float ang = (float)pos * inv;
        const double da = (double)ang;
        ((GAS float*)(F.ws + WS_ROPE))[(size_t)pos * 64 + F.lane] = (F.lane < 32) ? (float)cos(da) : (float)sin(da);
    }
    for (int e = gw * 64 + F.lane; e < NH * GC * GC; e += NGW * 64) { const int t = (e >> 7) & 127, s = e & 127; ((GAS h16*)(F.ws + WS_WS16))[e] = (s <= t) ? (h16)GIN(a, 11)[e] : (h16)0.f; }
}

__device__ __forceinline__ void p1_prep(const Frame& F0, const Args& a) {
    Frame F = F0; F.tid = threadIdx.x; F.lane = F.tid & 63; F.wave = __builtin_amdgcn_readfirstlane(F.tid >> 6);
    LAS float* modl = (LAS float*)F.lds;
    const GAS float* modp = (const GAS float*)(F.ws + WS_MODP); const GAS float* b_ada = GIN(a, 3);
    const size_t st = (size_t)4 * NMOD * D;
    for (int e = F.tid; e < 4 * 6 * D; e += NWAVES * 64) {
        const int b = e / (6 * D), sl = (e / D) % 6, k = e % D; const int mi = (sl < 3) ? 3 * sl : 3 * (sl - 3) + 1;
        const size_t o = (size_t)b * (NMOD * D) + mi * D + k;
        modl[e] = ((modp[o] + modp[o + st]) + (modp[o + 2 * st] + modp[o + 3 * st])) + b_ada[mi * D + k];
    }
    __syncthreads();
    if (F.vcu == 0) {
        GAS float* GT = (GAS float*)(F.ws + WS_GT); GAS float* GP = (GAS float*)(F.ws + WS_GP);
        for (int e = F.tid; e < 3 * 4 * D; e += NWAVES * 64) {
            const int j = e / (4 * D), b = (e / D) % 4, k = e % D; const int mi = 3 * j + 2;
            const size_t o = (size_t)b * (NMOD * D) + mi * D + k;
            GT[e] = ((modp[o] + modp[o + st]) + (modp[o + 2 * st] + modp[o + 3 * st])) + b_ada[mi * D + k];
            const GAS float* g = j == 0 ? GIN(a, 4) : j == 1 ? GIN(a, 7) : GIN(a, 16);
            GP[e] = g[k] * (1.f + modl[(b * 6 + 3 + j) * D + k]);
        }
    }
    const GAS float* x = GIN(a, 0); const GAS float* g1 = GIN(a, 4);
    GAS h16* XG = (GAS h16*)(F.ws + WS_HG); GAS float* R1 = (GAS float*)(F.ws + WS_R1);
    for (int chunk = F.vcu; chunk < M / 128; chunk += F.G) {
        const int b = chunk / (S / 128);
        f32x4 scl[2][2];
#pragma unroll
        for (int j = 0; j < 2; ++j)
#pragma unroll
            for (int h = 0; h < 2; ++h) { const int k = 8 * F.lane + 512 * j + 4 * h; const f32x4 gg = *(const GAS f32x4*)(g1 + k); const LAS float* sc = modl + (b * 6 + 3) * D + k;
                scl[j][h] = gg * ((f32x4){1.f + sc[0], 1.f + sc[1], 1.f + sc[2], 1.f + sc[3]}); }
        for (int rb = 0; rb < 16; rb += 4) {
            f32x4 v[4][2][2]; float q[4];
#pragma unroll
            for (int r4 = 0; r4 < 4; ++r4) { const GAS float* xr = x + (size_t)(chunk * 128 + F.wave * 16 + rb + r4) * D + 8 * F.lane;
#pragma unroll
                for (int j = 0; j < 2; ++j) { v[r4][j][0] = *(const GAS f32x4*)(xr + 512 * j); v[r4][j][1] = *(const GAS f32x4*)(xr + 512 * j + 4); } }
            asm volatile("" ::: "memory");
#pragma unroll
            for (int r4 = 0; r4 < 4; ++r4) { float t = 0.f;
#pragma unroll
                for (int j = 0; j < 2; ++j)
#pragma unroll
                    for (int h = 0; h < 2; ++h) t += (v[r4][j][h][0] * v[r4][j][h][0] + v[r4][j][h][1] * v[r4][j][h][1]) + (v[r4][j][h][2] * v[r4][j][h][2] + v[r4][j][h][3] * v[r4][j][h][3]);
                q[r4] = t; }
#pragma unroll
            for (int o = 1; o < 64; o <<= 1)
#pragma unroll
                for (int r4 = 0; r4 < 4; ++r4) q[r4] += __shfl_xor(q[r4], o);
#pragma unroll
            for (int r4 = 0; r4 < 4; ++r4) {
                const int row = chunk * 128 + F.wave * 16 + rb + r4;
                if (F.lane == 0) R1[row] = rsqrtf(q[r4] * (1.f / D) + EPS);
#pragma unroll
                for (int j = 0; j < 2; ++j) { const int k = 8 * F.lane + 512 * j; u32x4 w;
#pragma unroll
                    for (int h = 0; h < 2; ++h) { const f32x4 o = v[r4][j][h] * scl[j][h]; w[2 * h] = pkh(o[0], o[1]); w[2 * h + 1] = pkh(o[2], o[3]); }
                    *(GAS u32x4*)(XG + blk_off(row, k, D / 64)) = w; }
            }
        }
    }
    const int gw = F.vcu * NWAVES + F.wave, NGW = F.G * NWAVES;
    for (int it = gw; it < NGU + INW + NGU; it += NGW) {
        int n = it, j; const GAS h16* W; GAS float* B; int NN;
        if (n < NGU) { j = 0; W = (const GAS h16*)(F.ws + WS_WGU1); B = (GAS float*)(F.ws + WS_BIAS1); NN = NGU; }
        else if (n < NGU + INW) { n -= NGU; j = 1; W = (const GAS h16*)(F.ws + WS_WIN); B = (GAS float*)(F.ws + WS_BIAS2); NN = INW; }
        else { n -= NGU + INW; j = 2; W = (const GAS h16*)(F.ws + WS_WGU2); B = (GAS float*)(F.ws + WS_BIAS3); NN = NGU; }
        const h16x8 w0 = *(const GAS h16x8*)(W + blk_off(n, 16 * F.lane, D / 64)), w1 = *(const GAS h16x8*)(W + blk_off(n, 16 * F.lane + 8, D / 64));
        float s[4];
#pragma unroll
        for (int b = 0; b < 4; ++b) { const LAS float* sh = modl + (b * 6 + j) * D + 16 * F.lane; float t = 0.f;
#pragma unroll
            for (int e = 0; e < 8; ++e) t += sh[e] * (float)w0[e] + sh[8 + e] * (float)w1[e];
            s[b] = wave_sum(t); }
        if (F.lane == 0) { B[0 * NN + n] = s[0]; B[1 * NN + n] = s[1]; B[2 * NN + n] = s[2]; B[3 * NN + n] = s[3]; }
    }
    __syncthreads();
}

__device__ __forceinline__ void p_final(const Frame& F0, const Args& a) {
    Frame F = F0; F.tid = threadIdx.x; F.lane = F.tid & 63; F.wave = __builtin_amdgcn_readfirstlane(F.tid >> 6);
    const GAS h16* H = (const GAS h16*)(F.ws + WS_H); const GAS float* ssq = (const GAS float*)(F.ws + WS_SSQF); const GAS float* gf = GIN(a, 19);
    const int gw = F.vcu * NWAVES + F.wave, NGW = F.G * NWAVES;
    f32x4 g[2][2];
#pragma unroll
    for (int j = 0; j < 2; ++j)
#pragma unroll
        for (int h = 0; h < 2; ++h) g[j][h] = *(const GAS f32x4*)(gf + 8 * F.lane + 512 * j + 4 * h);
    for (int row = gw; row < M; row += NGW) {
        const float rs = rs16(ssq + (size_t)row * 16);
#pragma unroll
        for (int j = 0; j < 2; ++j) { const h16x8 hv = *(const GAS h16x8*)(H + (size_t)row * D + 8 * F.lane + 512 * j);
            f32x4 o0 = (f32x4){(float)hv[0], (float)hv[1], (float)hv[2], (float)hv[3]} * rs * g[j][0], o1 = (f32x4){(float)hv[4], (float)hv[5], (float)hv[6], (float)hv[7]} * rs * g[j][1];
            *(GAS f32x4*)(a.out + (size_t)row * D + 8 * F.lane + 512 * j) = o0; *(GAS f32x4*)(a.out + (size_t)row * D + 8 * F.lane + 512 * j + 4) = o1; }
    }
}


typedef float f32x16 __attribute__((ext_vector_type(16)));
typedef short v4i16_t __attribute__((ext_vector_type(4)));
__device__ __forceinline__ h16x4 tr16(const LAS unsigned char* p) { return __builtin_bit_cast(h16x4, __builtin_amdgcn_ds_read_tr16_b64_v4i16((LAS v4i16_t*)p)); }
__device__ __forceinline__ int vt_off(int t, int c8) { return t * 128 + (((c8 >> 2) ^ ((t >> 1) & 1)) << 6) + ((c8 & 3) << 4); }

__device__ __forceinline__ void gmlp_phase(const Frame& F0, const Args& a, int shadow) {
    const int tid = threadIdx.x, lane = tid & 63, wave = __builtin_amdgcn_readfirstlane(tid >> 6), r32 = lane & 31, hi = lane >> 5;
    GAS h16* proj = (GAS h16*)(F0.ws + WS_PROJ); const GAS h16* W16 = (const GAS h16*)(F0.ws + WS_WS16); GAS float* RG = (GAS float*)(F0.ws + WS_RG);
    const GAS float* ln_g = GIN(a, 9); const GAS float* ln_b = GIN(a, 10); const GAS float* b_s = GIN(a, 12);
    LAS unsigned char* lds = F0.lds;
    LAS float* rowsq = (LAS float*)(lds + MISC_OFF + 128);
    f32x4 g0 = *(const GAS f32x4*)(ln_g + 8 * lane), g1 = *(const GAS f32x4*)(ln_g + 8 * lane + 4), b0 = *(const GAS f32x4*)(ln_b + 8 * lane), b1 = *(const GAS f32x4*)(ln_b + 8 * lane + 4);
    for (int unit = F0.vcu; unit < M / GC; unit += F0.G) {
        const size_t row0 = (size_t)unit * GC;
        {
            h16x8 hv[16]; float sm[16], mu[16], rsd[16];
#pragma unroll
            for (int rr = 0; rr < 16; ++rr) hv[rr] = *(const GAS h16x8*)(proj + (row0 + wave * 16 + rr) * INW + PG + 8 * lane);
#pragma unroll
            for (int rr = 0; rr < 16; ++rr) { float t = 0.f;
#pragma unroll
                for (int e = 0; e < 8; ++e) t += (float)hv[rr][e];
                sm[rr] = t; }
#pragma unroll
            for (int o = 1; o < 64; o <<= 1)
#pragma unroll
                for (int rr = 0; rr < 16; ++rr) sm[rr] += __shfl_xor(sm[rr], o);
#pragma unroll
            for (int rr = 0; rr < 16; ++rr) { mu[rr] = sm[rr] * (1.f / 512.f); float q = 0.f;
#pragma unroll
                for (int e = 0; e < 8; ++e) { const float d = (float)hv[rr][e] - mu[rr]; q += d * d; }
                sm[rr] = q; }
#pragma unroll
            for (int o = 1; o < 64; o <<= 1)
#pragma unroll
                for (int rr = 0; rr < 16; ++rr) sm[rr] += __shfl_xor(sm[rr], o);
#pragma unroll
            for (int rr = 0; rr < 16; ++rr) { rsd[rr] = rsqrtf(sm[rr] * (1.f / 512.f) + EPS);
                const int t = wave * 16 + rr; float v[8];
#pragma unroll
                for (int e = 0; e < 8; ++e) v[e] = ((float)hv[rr][e] - mu[rr]) * rsd[rr];
                u32x4 w; w[0] = pkh(v[0] * g0[0] + b0[0], v[1] * g0[1] + b0[1]); w[1] = pkh(v[2] * g0[2] + b0[2], v[3] * g0[3] + b0[3]);
                w[2] = pkh(v[4] * g1[0] + b1[0], v[5] * g1[1] + b1[1]); w[3] = pkh(v[6] * g1[2] + b1[2], v[7] * g1[3] + b1[3]);
                *(LAS u32x4*)(lds + (lane >> 3) * 16384 + vt_off(t, lane & 7)) = w; }
        }
        __syncthreads();
        const GAS h16* Wh = W16 + (size_t)wave * GC * GC;
        const LAS unsigned char* vt = lds + wave * 16384;
        const int q4 = (lane & 15) >> 2, p4 = lane & 3, g1b = (lane >> 4) & 1;
        for (int tb = 0; tb < 4; ++tb) {
            f32x16 acc[2];
#pragma unroll
            for (int d0 = 0; d0 < 2; ++d0)
#pragma unroll
                for (int e = 0; e < 16; ++e) acc[d0][e] = 0.f;
            for (int ks = 0; ks <= 2 * tb + 1; ++ks) {
                const h16x8 af = *(const GAS h16x8*)(Wh + (size_t)(32 * tb + r32) * GC + 16 * ks + 8 * hi);
#pragma unroll
                for (int d0 = 0; d0 < 2; ++d0) {
                    const int srow = 16 * ks + 8 * hi + q4, c8 = 4 * d0 + 2 * g1b + (p4 >> 1);
                    const h16x4 lo = tr16(vt + vt_off(srow, c8) + (p4 & 1) * 8), hi4 = tr16(vt + vt_off(srow + 4, c8) + (p4 & 1) * 8);
                    const h16x8 bf = (h16x8){lo[0], lo[1], lo[2], lo[3], hi4[0], hi4[1], hi4[2], hi4[3]};
                    acc[d0] = __builtin_amdgcn_mfma_f32_32x32x16_f16(af, bf, acc[d0], 0, 0, 0);
                }
            }
            h16 uv0[16], uv1[16]; float bsv[16];
#pragma unroll
            for (int e = 0; e < 16; ++e) { const int t = 32 * tb + (e & 3) + 8 * (e >> 2) + 4 * hi; const GAS h16* up = proj + (row0 + t) * INW + PU + wave * 64 + r32; uv0[e] = up[0]; uv1[e] = up[32]; bsv[e] = b_s[wave * GC + t]; }
            asm volatile("" ::: "memory");
#pragma unroll
            for (int e = 0; e < 16; ++e) {
                const int t = 32 * tb + (e & 3) + 8 * (e >> 2) + 4 * hi;
                GAS h16* up = proj + (row0 + t) * INW + PU + wave * 64 + r32;
                const float o0 = (float)uv0[e] * (acc[0][e] + bsv[e]), o1 = (float)uv1[e] * (acc[1][e] + bsv[e]);
                up[0] = (h16)o0; up[32] = (h16)o1;
                float q = o0 * o0 + o1 * o1;
                q += __shfl_xor(q, 1); q += __shfl_xor(q, 2); q += __shfl_xor(q, 4); q += __shfl_xor(q, 8); q += __shfl_xor(q, 16);
                if (r32 == 0) rowsq[wave * 128 + t] = q;
            }
        }
        __syncthreads();
        if (tid < 128) { float s8 = 0.f;
#pragma unroll
            for (int w = 0; w < 8; ++w) s8 += rowsq[w * 128 + tid];
            RG[row0 + tid] = s8; }
        __syncthreads();
    }
}


constexpr size_t DO_PO = 0, DO_PML = 96 * MiB;
constexpr int CW_CNT = 8192;
constexpr int LISTCAP = 8192;
constexpr int AL_K = 0, AL_V = 32768, AL_STG = 65536, AL_WSF = 98304, AL_START = 102400;
__device__ __forceinline__ int k_off(int key, int c8) { return key * 128 + ((c8 ^ (key & 7)) << 4); }

__device__ __forceinline__ void moba_gate_phase(const Frame& F0, int shadow) {
    const int tid = threadIdx.x, lane = tid & 63;
    const GAS h16* proj = (const GAS h16*)(F0.ws + WS_PROJ); const GAS float* kmp = (const GAS float*)(F0.ws + WS_KMP);
    unsigned* cnt = F0.ctl + CW_CNT + (shadow ? 1024 : 0); GAS unsigned short* lists = (GAS unsigned short*)(F0.ws + (shadow ? WS_HG : WS_LISTS));
    LAS float* km = (LAS float*)F0.lds;
    for (int item = F0.vcu; item < NB * NH * (S / 512); item += F0.G) {
        const int span = item % (S / 512), bh = item / (S / 512), b = bh >> 3, h = bh & 7;
        __syncthreads();
        for (int e = tid; e < NBLK * 64; e += NWAVES * 64) { const int n = e >> 6, d = e & 63; const GAS float* kp = kmp + (size_t)((b * NBLK + n) * 2) * 512 + h * 64 + d; km[e] = kp[0] + kp[512]; }
        __syncthreads();
        const int sq = span * 512 + tid, own = __builtin_amdgcn_readfirstlane(sq >> 8);
        float q[64];
        { const GAS h16* qp = proj + (size_t)(b * S + sq) * INW + PQ + h * 64;
#pragma unroll
          for (int c = 0; c < 8; ++c) { const h16x8 v = *(const GAS h16x8*)(qp + 8 * c);
#pragma unroll
              for (int e = 0; e < 8; ++e) q[8 * c + e] = (float)v[e]; } }
        float v0 = -3e38f, v1 = -3e38f, v2 = -3e38f; int i0 = -1, i1 = -1, i2 = -1;
        for (int n = 0; n < own; ++n) {
            float g0 = 0.f, g1 = 0.f, g2 = 0.f, g3 = 0.f;
#pragma unroll
            for (int c = 0; c < 16; ++c) { const f32x4 kv = *(const LAS f32x4*)(km + n * 64 + 4 * c); g0 += q[4 * c] * kv[0]; g1 += q[4 * c + 1] * kv[1]; g2 += q[4 * c + 2] * kv[2]; g3 += q[4 * c + 3] * kv[3]; }
            const float g = (g0 + g1) + (g2 + g3);
            if (g > v0) { v2 = v1; i2 = i1; v1 = v0; i1 = i0; v0 = g; i0 = n; }
            else if (g > v1) { v2 = v1; i2 = i1; v1 = g; i1 = n; }
            else if (g > v2) { v2 = g; i2 = n; }
        }
        int mycnt = 0, pos0 = 0, pos1 = 0, pos2 = 0;
        const unsigned long long ltmask = (1ull << lane) - 1ull;
        for (int n = 0; n < own; ++n) {
            const bool sel = (i0 == n) || (i1 == n) || (i2 == n);
            const unsigned long long mask = __ballot(sel);
            const int before = __popcll(mask & ltmask);
            if (lane == n) mycnt = __popcll(mask);
            if (i0 == n) pos0 = before; if (i1 == n) pos1 = before; if (i2 == n) pos2 = before;
        }
        unsigned base = 0u;
        if (lane < own && mycnt > 0) base = atomicAdd(cnt + bh * NBLK + lane, (unsigned)mycnt);
        const unsigned bb0 = (unsigned)__shfl((int)base, i0 & 63), bb1 = (unsigned)__shfl((int)base, i1 & 63), bb2 = (unsigned)__shfl((int)base, i2 & 63);
        if (i0 >= 0) lists[(size_t)(bh * NBLK + i0) * LISTCAP + bb0 + pos0] = (unsigned short)(sq | (0 << 13));
        if (i1 >= 0) lists[(size_t)(bh * NBLK + i1) * LISTCAP + bb1 + pos1] = (unsigned short)(sq | (1 << 13));
        if (i2 >= 0) lists[(size_t)(bh * NBLK + i2) * LISTCAP + bb2 + pos2] = (unsigned short)(sq | (2 << 13));
    }
    __syncthreads();
}

template <bool CAUSAL>
__device__ __forceinline__ void attn_tile(const LAS unsigned char* ldsK, const LAS unsigned char* ldsV, const h16x8 (&qf)[4], int wave, int lane, f32x16 (&o)[2], float& m_out, float& l_out) {
    const int r32 = lane & 31, hi = lane >> 5;
    int kbase[4];
#pragma unroll
    for (int ks = 0; ks < 4; ++ks) kbase[ks] = r32 * 128 + (((2 * ks + hi) ^ (r32 & 7)) << 4);
    f32x16 sacc[8];
#pragma unroll
    for (int kb = 0; kb < 8; ++kb) {
        f32x16 acc;
#pragma unroll
        for (int e = 0; e < 16; ++e) acc[e] = 0.f;
#pragma unroll
        for (int ks = 0; ks < 4; ++ks) { const h16x8 kf = *(const LAS h16x8*)(ldsK + kbase[ks] + kb * 4096); acc = __builtin_amdgcn_mfma_f32_32x32x16_f16(kf, qf[ks], acc, 0, 0, 0); }
        if (CAUSAL) {
            const int lim = 32 * (wave - kb) + r32;
#pragma unroll
            for (int e = 0; e < 16; ++e) { const int key = (e & 3) + 8 * (e >> 2) + 4 * hi; if (key > lim) acc[e] = -1e30f; }
        }
        sacc[kb] = acc;
    }
    float m = -3e38f;
#pragma unroll
    for (int kb = 0; kb < 8; ++kb)
#pragma unroll
        for (int e = 0; e < 16; ++e) m = fmaxf(m, sacc[kb][e]);
    m = fmaxf(m, __shfl_xor(m, 32));
    float ls = 0.f;
#pragma unroll
    for (int kb = 0; kb < 8; ++kb)
#pragma unroll
        for (int e = 0; e < 16; ++e) { const float pv = __builtin_amdgcn_exp2f(sacc[kb][e] - m); sacc[kb][e] = pv; ls += pv; }
    ls += __shfl_xor(ls, 32);
#pragma unroll
    for (int d0 = 0; d0 < 2; ++d0)
#pragma unroll
        for (int e = 0; e < 16; ++e) o[d0][e] = 0.f;
    const int q4 = (lane & 15) >> 2, p4 = lane & 3, g1b = (lane >> 4) & 1;
    int vbase[2];
#pragma unroll
    for (int d0 = 0; d0 < 2; ++d0) vbase[d0] = (4 * hi + q4) * 128 + ((d0 ^ ((q4 >> 1) & 1)) << 6) + ((2 * g1b + (p4 >> 1)) << 4) + (p4 & 1) * 8;
#pragma unroll
    for (int kb = 0; kb < 8; ++kb) {
        if (!CAUSAL || kb <= wave) {
#pragma unroll
            for (int s2 = 0; s2 < 2; ++s2) {
                h16x8 pa;
#pragma unroll
                for (int j = 0; j < 8; ++j) pa[j] = (h16)sacc[kb][8 * s2 + j];
#pragma unroll
                for (int d0 = 0; d0 < 2; ++d0) {
                    const h16x4 lo = tr16(ldsV + vbase[d0] + kb * 4096 + s2 * 2048), hi4 = tr16(ldsV + vbase[d0] + kb * 4096 + s2 * 2048 + 1024);
                    const h16x8 bf = (h16x8){lo[0], lo[1], lo[2], lo[3], hi4[0], hi4[1], hi4[2], hi4[3]};
                    o[d0] = __builtin_amdgcn_mfma_f32_32x32x16_f16(pa, bf, o[d0], 0, 0, 0);
                }
            }
        }
    }
    m_out = m; l_out = ls;
}
__device__ __forceinline__ void attn_tile_causal(const LAS unsigned char* ldsK, const LAS unsigned char* ldsV, const h16x8 (&qf)[4], int wave, int lane, f32x16 (&o)[2], float& m_out, float& l_out) {
    const int r32 = lane & 31, hi = lane >> 5;
    int kbase[4];
#pragma unroll
    for (int ks = 0; ks < 4; ++ks) kbase[ks] = r32 * 128 + (((2 * ks + hi) ^ (r32 & 7)) << 4);
    const int q4 = (lane & 15) >> 2, p4 = lane & 3, g1b = (lane >> 4) & 1;
    int vbase[2];
#pragma unroll
    for (int d0 = 0; d0 < 2; ++d0) vbase[d0] = (4 * hi + q4) * 128 + ((d0 ^ ((q4 >> 1) & 1)) << 6) + ((2 * g1b + (p4 >> 1)) << 4) + (p4 & 1) * 8;
    float m = -3e38f;
    for (int kb = 0; kb <= wave; ++kb) {
        f32x16 acc;
#pragma unroll
        for (int e = 0; e < 16; ++e) acc[e] = 0.f;
#pragma unroll
        for (int ks = 0; ks < 4; ++ks) { const h16x8 kf = *(const LAS h16x8*)(ldsK + kbase[ks] + kb * 4096); acc = __builtin_amdgcn_mfma_f32_32x32x16_f16(kf, qf[ks], acc, 0, 0, 0); }
        const int lim = (kb == wave) ? r32 : 64;
#pragma unroll
        for (int e = 0; e < 16; ++e) { const int key = (e & 3) + 8 * (e >> 2) + 4 * hi; if (key <= lim) m = fmaxf(m, acc[e]); }
    }
    m = fmaxf(m, __shfl_xor(m, 32));
    float ls = 0.f;
#pragma unroll
    for (int d0 = 0; d0 < 2; ++d0)
#pragma unroll
        for (int e = 0; e < 16; ++e) o[d0][e] = 0.f;
    for (int kb = 0; kb <= wave; ++kb) {
        f32x16 acc;
#pragma unroll
        for (int e = 0; e < 16; ++e) acc[e] = 0.f;
#pragma unroll
        for (int ks = 0; ks < 4; ++ks) { const h16x8 kf = *(const LAS h16x8*)(ldsK + kbase[ks] + kb * 4096); acc = __builtin_amdgcn_mfma_f32_32x32x16_f16(kf, qf[ks], acc, 0, 0, 0); }
        const int lim = (kb == wave) ? r32 : 64;
#pragma unroll
        for (int e = 0; e < 16; ++e) { const int key = (e & 3) + 8 * (e >> 2) + 4 * hi; const float pv = (key <= lim) ? __builtin_amdgcn_exp2f(acc[e] - m) : 0.f; acc[e] = pv; ls += pv; }
#pragma unroll
        for (int s2 = 0; s2 < 2; ++s2) {
            h16x8 pa;
#pragma unroll
            for (int j = 0; j < 8; ++j) pa[j] = (h16)acc[8 * s2 + j];
#pragma unroll
            for (int d0 = 0; d0 < 2; ++d0) {
                const h16x4 lo = tr16(ldsV + vbase[d0] + kb * 4096 + s2 * 2048), hi4 = tr16(ldsV + vbase[d0] + kb * 4096 + s2 * 2048 + 1024);
                const h16x8 bf = (h16x8){lo[0], lo[1], lo[2], lo[3], hi4[0], hi4[1], hi4[2], hi4[3]};
                o[d0] = __builtin_amdgcn_mfma_f32_32x32x16_f16(pa, bf, o[d0], 0, 0, 0);
            }
        }
    }
    ls += __shfl_xor(ls, 32);
    m_out = m; l_out = ls;
}
__device__ __forceinline__ void load_kv_block(LAS unsigned char* lds, const GAS h16* proj, size_t row0, int h, int tid) {
#pragma unroll
    for (int i = 0; i < 4; ++i) { const int idx = tid + 512 * i, key = idx >> 3, c8 = idx & 7; const GAS h16* rp = proj + (row0 + key) * INW + h * 64 + 8 * c8;
        const u32x4 kv = *(const GAS u32x4*)(rp + PK), vv = *(const GAS u32x4*)(rp + PV);
        *(LAS u32x4*)(lds + AL_K + k_off(key, c8)) = kv; *(LAS u32x4*)(lds + AL_V + vt_off(key, c8)) = vv; }
}
struct KvRegs { u32x4 kv[4], vv[4]; };
__device__ __forceinline__ void kv_fetch(KvRegs& r, const GAS h16* proj, size_t row0, int h, int tid) {
#pragma unroll
    for (int i = 0; i < 4; ++i) { const int idx = tid + 512 * i, key = idx >> 3, c8 = idx & 7; const GAS h16* rp = proj + (row0 + key) * INW + h * 64 + 8 * c8;
        r.kv[i] = *(const GAS u32x4*)(rp + PK); r.vv[i] = *(const GAS u32x4*)(rp + PV); }
}
__device__ __forceinline__ void kv_commit(const KvRegs& r, LAS unsigned char* lds, int tid) {
#pragma unroll
    for (int i = 0; i < 4; ++i) { const int idx = tid + 512 * i, key = idx >> 3, c8 = idx & 7;
        *(LAS u32x4*)(lds + AL_K + k_off(key, c8)) = r.kv[i]; *(LAS u32x4*)(lds + AL_V + vt_off(key, c8)) = r.vv[i]; }
}
__device__ __forceinline__ void stage_o(LAS unsigned char* stg, LAS float* wsf, const f32x16 (&o)[2], float l, int lane) {
    const int r32 = lane & 31, hi = lane >> 5;
    if (hi == 0) wsf[r32] = 1.f / l;
    LDS_WAIT();
#pragma unroll
    for (int e = 0; e < 16; ++e) { const int qr = (e & 3) + 8 * (e >> 2) + 4 * hi; const float rl = wsf[qr];
        *(LAS h16*)(stg + qr * 128 + r32 * 2) = (h16)(o[0][e] * rl); *(LAS h16*)(stg + qr * 128 + 64 + r32 * 2) = (h16)(o[1][e] * rl); }
    LDS_WAIT();
}

__device__ __forceinline__ void moba_b_phase(const Frame& F0, GAS float* dout) {
    const int tid = threadIdx.x, lane = tid & 63, wave = __builtin_amdgcn_readfirstlane(tid >> 6), r32 = lane & 31, hi = lane >> 5;
    const GAS h16* proj = (const GAS h16*)(F0.ws + WS_PROJ); const unsigned* cnt = F0.ctl + CW_CNT; const GAS unsigned short* lists = (const GAS unsigned short*)(F0.ws + WS_LISTS);
    GAS h16* PO = (GAS h16*)((unsigned char*)dout + DO_PO); GAS float* PML = (GAS float*)((unsigned char*)dout + DO_PML);
    LAS unsigned char* lds = F0.lds;
    LAS int* start = (LAS int*)(lds + AL_START);
    LAS float* wsf = (LAS float*)(lds + AL_WSF + wave * 512); LAS int* wsi = (LAS int*)(lds + AL_WSF + wave * 512 + 256);
    LAS unsigned char* stg = lds + AL_STG + wave * 4096;
    {
        const unsigned c0 = cnt[2 * tid], c1 = cnt[2 * tid + 1];
        const int t0 = (int)((c0 + 255u) >> 8), t1 = (int)((c1 + 255u) >> 8);
        int v = t0 + t1, inc = v;
#pragma unroll
        for (int o = 1; o < 64; o <<= 1) { const int u = __shfl_up(inc, o); if (lane >= o) inc += u; }
        LAS int* wtot = (LAS int*)(lds + AL_WSF);
        __syncthreads();
        if (lane == 63) wtot[wave] = inc;
        __syncthreads();
        int pre = 0;
        for (int w = 0; w < wave; ++w) pre += wtot[w];
        const int ex = pre + inc - v;
        __syncthreads();
        start[2 * tid] = ex; start[2 * tid + 1] = ex + t0;
        if (tid == 511) start[1024] = ex + v;
        __syncthreads();
    }
    const int nitems = start[1024];
    for (int item = F0.vcu; item < nitems; item += F0.G) {
        int lo = 0, hi_ = 1024;
        while (hi_ - lo > 1) { const int mid = (lo + hi_) >> 1; if (start[mid] <= item) lo = mid; else hi_ = mid; }
        const int l = lo, chunk = item - start[l];
        const int bh = l >> 5, n = l & 31, b = bh >> 3, h = bh & 7;
        const int nq = (int)cnt[l] - chunk * 256;
        load_kv_block(lds, proj, (size_t)b * S + (size_t)n * MBLK, h, tid);
        const int qi = chunk * 256 + wave * 32 + r32;
        const bool valid = (wave * 32 + r32) < nq;
        const unsigned ent = lists[(size_t)l * LISTCAP + (valid ? qi : chunk * 256)];
        const int sq = ent & 8191, rank = ent >> 13;
        h16x8 qf[4];
        { const GAS h16* qp = proj + (size_t)(b * S + sq) * INW + PQ + h * 64 + 8 * hi;
#pragma unroll
          for (int ks = 0; ks < 4; ++ks) qf[ks] = *(const GAS h16x8*)(qp + 16 * ks); }
        __syncthreads();
        if (wave * 32 < nq) {
            f32x16 o[2]; float m, lsum;
            attn_tile<false>(lds + AL_K, lds + AL_V, qf, wave, lane, o, m, lsum);
            const int slot = ((b * S + sq) * NH + h) * 3 + rank;
            if (hi == 0) { wsi[r32] = valid ? slot : -1; if (valid) { PML[(size_t)slot * 2] = m; PML[(size_t)slot * 2 + 1] = lsum; } }
            stage_o(stg, wsf, o, lsum, lane);
#pragma unroll
            for (int i = 0; i < 4; ++i) { const int row = i * 8 + (lane >> 3), ch = lane & 7; const int sl = wsi[row];
                if (sl >= 0) *(GAS u32x4*)(PO + (size_t)sl * 64 + ch * 8) = *(const LAS u32x4*)(stg + row * 128 + ch * 16); }
        }
        __syncthreads();
    }
}

__device__ __forceinline__ void moba_c_phase(const Frame& F0, const GAS float* dout, int shadow) {
    const int tid = threadIdx.x, lane = tid & 63, wave = __builtin_amdgcn_readfirstlane(tid >> 6), r32 = lane & 31, hi = lane >> 5;
    GAS h16* proj = (GAS h16*)(F0.ws + WS_PROJ); GAS float* SSQA = (GAS float*)(F0.ws + WS_SSQA);
    const GAS h16* PO = (const GAS h16*)((const unsigned char*)dout + DO_PO); const GAS float* PML = (const GAS float*)((const unsigned char*)dout + DO_PML);
    LAS unsigned char* lds = F0.lds;
    LAS float* wsf = (LAS float*)(lds + AL_WSF + wave * 512);
    LAS unsigned char* stg = lds + AL_STG + wave * 4096;
    KvRegs kvr;
    if (F0.vcu < NB * NH * NBLK) { const int u0 = F0.vcu; kv_fetch(kvr, proj, (size_t)((u0 >> 5) >> 3) * S + (size_t)(u0 & 31) * MBLK, (u0 >> 5) & 7, tid); }
    for (int unit = F0.vcu; unit < NB * NH * NBLK; unit += F0.G) {
        const int qb = unit & 31, bh = unit >> 5, b = bh >> 3, h = bh & 7;
        const size_t row0 = (size_t)b * S + (size_t)qb * MBLK;
        kv_commit(kvr, lds, tid);
        { const int un = unit + F0.G; if (un < NB * NH * NBLK) kv_fetch(kvr, proj, (size_t)((un >> 5) >> 3) * S + (size_t)(un & 31) * MBLK, (un >> 5) & 7, tid); }
        h16x8 qf[4];
        { const GAS h16* qp = proj + (row0 + wave * 32 + r32) * INW + PQ + h * 64 + 8 * hi;
#pragma unroll
          for (int ks = 0; ks < 4; ++ks) qf[ks] = *(const GAS h16x8*)(qp + 16 * ks); }
        __syncthreads();
        f32x16 o[2]; float m, lsum;
        attn_tile_causal(lds + AL_K, lds + AL_V, qf, wave, lane, o, m, lsum);
        if (hi == 0) { wsf[32 + r32] = m; wsf[64 + r32] = lsum; }
        stage_o(stg, wsf, o, lsum, lane);
        const int nsel = qb < 3 ? qb : 3;
#pragma unroll
        for (int i0 = 0; i0 < 4; i0 += 2) {
            float mr[2][3], lr[2][3]; h16x8 pv[2][3];
#pragma unroll
            for (int ii = 0; ii < 2; ++ii) { const size_t grow = row0 + wave * 32 + (i0 + ii) * 8 + (lane >> 3);
#pragma unroll
                for (int r = 0; r < 3; ++r) { if (r < nsel) { const size_t sl = (grow * NH + h) * 3 + r; mr[ii][r] = PML[sl * 2]; lr[ii][r] = PML[sl * 2 + 1]; pv[ii][r] = *(const GAS h16x8*)(PO + sl * 64 + (lane & 7) * 8); } } }
            asm volatile("" ::: "memory");
#pragma unroll
            for (int ii = 0; ii < 2; ++ii) {
                const int row = (i0 + ii) * 8 + (lane >> 3), ch = lane & 7;
                const size_t grow = row0 + wave * 32 + row;
                const float mo = wsf[32 + row], lo_ = wsf[64 + row];
                const h16x8 ov = *(const LAS h16x8*)(stg + row * 128 + ch * 16);
                float mmax = mo;
#pragma unroll
                for (int r = 0; r < 3; ++r) { if (r < nsel) mmax = fmaxf(mmax, mr[ii][r]); }
                float wo = lo_ * __builtin_amdgcn_exp2f(mo - mmax), L = wo;
                float acc[8];
#pragma unroll
                for (int e = 0; e < 8; ++e) acc[e] = wo * (float)ov[e];
#pragma unroll
                for (int r = 0; r < 3; ++r) { if (r < nsel) { const float wr_ = lr[ii][r] * __builtin_amdgcn_exp2f(mr[ii][r] - mmax); L += wr_;
#pragma unroll
                    for (int e = 0; e < 8; ++e) acc[e] += wr_ * (float)pv[ii][r][e]; } }
                const float rL = 1.f / L; float q = 0.f; u32x4 w;
#pragma unroll
                for (int e = 0; e < 8; ++e) { acc[e] *= rL; q += acc[e] * acc[e]; }
                w[0] = pkh(acc[0], acc[1]); w[1] = pkh(acc[2], acc[3]); w[2] = pkh(acc[4], acc[5]); w[3] = pkh(acc[6], acc[7]);
                if (shadow) *(GAS u32x4*)((GAS h16*)(F0.ws + WS_HG) + grow * 512 + h * 64 + ch * 8) = w;
                else *(GAS u32x4*)(proj + grow * INW + PQ + h * 64 + ch * 8) = w;
                q += __shfl_xor(q, 1); q += __shfl_xor(q, 2); q += __shfl_xor(q, 4);
                if (ch == 0) SSQA[grow * 8 + h] = q;
            }
        }
        __syncthreads();
    }
}


template <bool PART16> __device__ __forceinline__ void fill_rowscale(LAS float* tab, const pg8::StaticOrder& So, const GAS float* src, int maxu) {
    pg8::Unit uu;
    for (int i = 0; i < maxu && So.next(i, uu); ++i)
        if (threadIdx.x < 256) { const int row = uu.pm * 256 + (int)threadIdx.x; tab[i * 256 + threadIdx.x] = PART16 ? rs16(src + (size_t)row * 16) : src[row]; }
    __syncthreads();
}
constexpr int TAB_OFF = MISC_OFF + 128, TAB_MAXU = 15;
static_assert(TAB_OFF + TAB_MAXU * 1024 <= LDS_BYTES, "row-scale table");

enum Phase { PH_P0 = 0, PH_P1, PH_G1A, PH_G1B, PH_INPROJ, PH_MIX_A, PH_MIX_B, PH_MIX_C, PH_OUTPROJ, PH_G2A, PH_G2B, PH_FINAL, PH_COUNT };
__global__ void __launch_bounds__(NWAVES * 64, 2) mega_fwd(Args args) {
    extern __shared__ __attribute__((aligned(16))) unsigned char lds[];
    Frame F;
    F.lds = (LAS unsigned char*)lds; F.MISC = (volatile LAS unsigned*)(F.lds + MISC_OFF);
    F.tid = threadIdx.x; F.lane = F.tid & 63; F.wave = __builtin_amdgcn_readfirstlane(F.tid >> 6);
    F.G = gridDim.x; { const int bx = blockIdx.x; F.vcu = (F.G % 8 == 0) ? (bx % 8) * (F.G / 8) + bx / 8 : bx; }
    F.ws = args.ws; F.out = (GAS float*)args.out; F.ctl = (unsigned*)(args.ws + WS_CTL);
    for (int u = F.tid; u < (LDS_BYTES - LDSCTL_OFF) / 4; u += NWAVES * 64) ((LAS unsigned*)(F.lds + LDSCTL_OFF))[u] = 0u;
    __syncthreads();
    XcdBarrier bar; bar.bar = F.ctl + CW_BAR; bar.x = 0; bar.st = nullptr;
    const int lo = args.ph_lo, hi = args.ph_hi;
    if (hi - lo > 1) bar = xcd_barrier_post(F.ctl + CW_BAR, F.MISC + 8);
#ifndef MK_PHASE_MASK
#define MK_PHASE_MASK 0xFFFF
#endif
#define IN(k) (((MK_PHASE_MASK >> (k)) & 1) && lo <= (k) && (k) < hi)
#define SEAM(k) do { if (IN(k) && IN((k) + 1)) xcd_barrier(bar); } while (0)
#define PHASE_PTRS() unsigned char* ws = args.ws; asm volatile("" : "+s"(ws)); const GAS float* GT = (const GAS float*)(ws + WS_GT); const GAS float* GP = (const GAS float*)(ws + WS_GP); (void)GT; (void)GP; F.ws = ws
    if (IN(PH_P0)) { PHASE_PTRS(); p0_prologue(F, args); SEAM(PH_P0); }
    if (IN(PH_P1)) { PHASE_PTRS(); p1_prep(F, args); SEAM(PH_P1); }
    if (IN(PH_G1A)) {
        PHASE_PTRS();
        pg8::Gemm g{(const GAS h16*)(ws + WS_HG), (const GAS h16*)(ws + WS_WGU1), 0, NGU, D}; pg8::StaticOrder So; So.init(M, NGU, F.G, (int)blockIdx.x);
#if MK_SHADOW == 1
        if (args.ph_lo == PH_G1A && args.ph_hi == PH_G1A + 1 && args.shadow) { EpiNull En; pg8::gemm_phase<EpiNull, true, MK_GPROBE>(F.lds, g, So, En); return; }
#endif
        fill_rowscale<false>((LAS float*)(F.lds + TAB_OFF), So, (const GAS float*)(ws + WS_R1), TAB_MAXU);
        EpiSwiglu E{(GAS h16*)(ws + WS_ACT), (const LAS float*)(F.lds + TAB_OFF), (const GAS float*)(ws + WS_BIAS1)};
        pg8::gemm_phase<EpiSwiglu, true>(F.lds, g, So, E); SEAM(PH_G1A);
    }
    if (IN(PH_G1B)) {
        PHASE_PTRS();
        pg8::Gemm g{(const GAS h16*)(ws + WS_ACT), (const GAS h16*)(ws + WS_WD1), 0, D, DFF}; pg8::StaticOrder So; So.init(M, D, F.G, (int)blockIdx.x);
        EpiResid<true, false, true> E{GIN(args, 0), (GAS h16*)(ws + WS_H), (GAS h16*)(ws + WS_HG), GT + 0 * 4 * D, GP + 1 * 4 * D, (GAS float*)(ws + WS_SSQ2), nullptr, 0.5f};
        pg8::gemm_phase<EpiResid<true, false, true>, true>(F.lds, g, So, E); SEAM(PH_G1B);
    }
    if (IN(PH_INPROJ)) {
        PHASE_PTRS();
        pg8::Gemm g{(const GAS h16*)(ws + WS_HG), (const GAS h16*)(ws + WS_WIN), 0, INW, D}; pg8::StaticOrder So; So.init(M, INW, F.G, (int)blockIdx.x);
        fill_rowscale<true>((LAS float*)(F.lds + TAB_OFF), So, (const GAS float*)(ws + WS_SSQ2), TAB_MAXU);
        EpiInproj E{(GAS h16*)(ws + WS_PROJ), (const LAS float*)(F.lds + TAB_OFF), (const GAS float*)(ws + WS_BIAS2), (const GAS float*)(ws + WS_ROPE), (GAS float*)(ws + WS_KMP)};
        pg8::gemm_phase<EpiInproj, true>(F.lds, g, So, E); SEAM(PH_INPROJ);
    }
    if (IN(PH_MIX_A)) { PHASE_PTRS(); if (!(args.shadow & 2)) gmlp_phase(F, args, args.shadow & 1); if (!(args.shadow & 4)) moba_gate_phase(F, args.shadow & 1); SEAM(PH_MIX_A); }
    if (IN(PH_MIX_B)) { PHASE_PTRS(); moba_b_phase(F, (GAS float*)args.out); SEAM(PH_MIX_B); }
    if (IN(PH_MIX_C)) { PHASE_PTRS(); moba_c_phase(F, (const GAS float*)args.out, args.shadow & 1); SEAM(PH_MIX_C); }
    if (IN(PH_OUTPROJ)) {
        PHASE_PTRS();
        pg8::Gemm g{(const GAS h16*)(ws + WS_PROJ), (const GAS h16*)(ws + WS_WOUT), INW, D, D}; pg8::StaticOrder So; So.init(M, D, F.G, (int)blockIdx.x);
        const LAS float* sct = (const LAS float*)(F.lds + MISC_OFF + 128);
        {   LAS float* t = (LAS float*)(F.lds + MISC_OFF + 128); const GAS float* ssqa = (const GAS float*)(ws + WS_SSQA); const GAS float* ssqg = (const GAS float*)(ws + WS_RG);
            pg8::Unit uu;
            for (int i = 0; i < 4 && So.next(i, uu); ++i)
                if (F.tid < 256) { const int row = uu.pm * 256 + F.tid; const f32x4 a = *(const GAS f32x4*)(ssqa + (size_t)row * 8), bq = *(const GAS f32x4*)(ssqa + (size_t)row * 8 + 4);
                    const float ra = rsqrtf((((a[0] + a[1]) + (a[2] + a[3])) + ((bq[0] + bq[1]) + (bq[2] + bq[3]))) * (1.f / 512.f) + EPS), rg = rsqrtf(ssqg[row] * (1.f / 512.f) + EPS);
                    t[i * 512 + F.tid] = ra / rg; t[i * 512 + 256 + F.tid] = rg; }
            __syncthreads(); }
        EpiResid<false, true, true> E{nullptr, (GAS h16*)(ws + WS_H), (GAS h16*)(ws + WS_HG), GT + 1 * 4 * D, GP + 2 * 4 * D, (GAS float*)(ws + WS_SSQ3), sct, 1.0f};
        pg8::gemm_phase<EpiResid<false, true, true>, true>(F.lds, g, So, E); SEAM(PH_OUTPROJ);
    }
    if (IN(PH_G2A)) {
        PHASE_PTRS();
        pg8::Gemm g{(const GAS h16*)(ws + WS_HG), (const GAS h16*)(ws + WS_WGU2), 0, NGU, D}; pg8::StaticOrder So; So.init(M, NGU, F.G, (int)blockIdx.x);
        fill_rowscale<true>((LAS float*)(F.lds + TAB_OFF), So, (const GAS float*)(ws + WS_SSQ3), TAB_MAXU);
        EpiSwiglu E{(GAS h16*)(ws + WS_ACT), (const LAS float*)(F.lds + TAB_OFF), (const GAS float*)(ws + WS_BIAS3)};
        pg8::gemm_phase<EpiSwiglu, true>(F.lds, g, So, E); SEAM(PH_G2A);
    }
    if (IN(PH_G2B)) {
        PHASE_PTRS();
        pg8::Gemm g{(const GAS h16*)(ws + WS_ACT), (const GAS h16*)(ws + WS_WD2), 0, D, DFF}; pg8::StaticOrder So; So.init(M, D, F.G, (int)blockIdx.x);
#if MK_FUSE_FINAL
        EpiFinal E{(const GAS h16*)(ws + WS_H), GT + 2 * 4 * D, GIN(args, 19), (GAS float*)args.out, (unsigned*)(ws + WS_SSQF), F.ctl + CW_PAN, F.ctl + CW_TMO,
                   (LAS float*)(F.lds + MISC_OFF + 128), (LAS float*)(F.lds + MISC_OFF + 128 + 4096), 0.5f};
        pg8::gemm_phase<EpiFinal, true>(F.lds, g, So, E);
#else
        EpiResid<false, false, false> E{nullptr, (GAS h16*)(ws + WS_H), nullptr, GT + 2 * 4 * D, nullptr, (GAS float*)(ws + WS_SSQF), nullptr, 0.5f};
        pg8::gemm_phase<EpiResid<false, false, false>, true>(F.lds, g, So, E); SEAM(PH_G2B);
#endif
    }
#if !MK_FUSE_FINAL
    if (IN(PH_FINAL)) { PHASE_PTRS(); p_final(F, args); }
#endif
#undef IN
#undef SEAM
}

extern "C" void kernel_launch(void* const* d_in, const int* in_sizes, int n_in, void* d_out, int out_size, void* d_ws, size_t ws_size, hipStream_t stream) {
    static int grid = 0;
    if (grid == 0) {
        if (n_in != 20 || out_size != M * D || ws_size < WS_END) { fprintf(stderr, "kernel_launch: unexpected shapes (n_in %d out %d ws %zu)\n", n_in, out_size, ws_size); grid = -1; return; }
        int dev = 0, cus = 0, per_cu = 0;
        hipGetDevice(&dev); hipDeviceGetAttribute(&cus, hipDeviceAttributeMultiprocessorCount, dev);
        if (hipFuncSetAttribute((const void*)mega_fwd, hipFuncAttributeMaxDynamicSharedMemorySize, LDS_BYTES) != hipSuccess) { fprintf(stderr, "kernel_launch: hipFuncSetAttribute failed\n"); grid = -1; return; }
        hipOccupancyMaxActiveBlocksPerMultiprocessor(&per_cu, (const void*)mega_fwd, NWAVES * 64, LDS_BYTES);
        (void)hipGetLastError();
        if (per_cu < 1) { fprintf(stderr, "kernel_launch: occupancy query says %d blocks/CU; nothing launched\n", per_cu); grid = -1; return; }
        grid = cus;
    }
    if (grid < 0) return;
    hipMemsetAsync((char*)d_ws + WS_CTL, 0, CTL_ZERO_BYTES, stream);
    Args a{};
    for (int i = 0; i < 20; ++i) a.in[i] = (const float*)d_in[i];
    a.out = (float*)d_out; a.ws = (unsigned char*)d_ws;
    unsigned char* ws = (unsigned char*)d_ws;
    auto run = [&](int lo, int hi) {
#if MK_PER_PHASE
        for (int p = lo; p < hi; ++p) {
            if (MK_SHADOW == 2 && p == PH_MIX_A) { a.ph_lo = p; a.ph_hi = p + 1; a.shadow = 1 | 4; hipLaunchKernelGGL(mega_fwd, dim3(grid), dim3(NWAVES * 64), LDS_BYTES, stream, a); a.shadow = 0; }
            if (MK_SHADOW == 3 && p == PH_MIX_A) { a.ph_lo = p; a.ph_hi = p + 1; a.shadow = 1 | 2; hipLaunchKernelGGL(mega_fwd, dim3(grid), dim3(NWAVES * 64), LDS_BYTES, stream, a); a.shadow = 0; }
            if (MK_SHADOW == 4 && p == PH_MIX_C) { a.ph_lo = p; a.ph_hi = p + 1; a.shadow = 1; hipLaunchKernelGGL(mega_fwd, dim3(grid), dim3(NWAVES * 64), LDS_BYTES, stream, a); a.shadow = 0; }
            if (MK_SHADOW == 1 && p == PH_G1A) { a.ph_lo = p; a.ph_hi = p + 1; a.shadow = 1; hipLaunchKernelGGL(mega_fwd, dim3(grid), dim3(NWAVES * 64), LDS_BYTES, stream, a); a.shadow = 0; }
            for (int rep = 0; rep < ((((MK_DUP_MASK) >> p) & 1) ? 2 : 1); ++rep) { a.ph_lo = p; a.ph_hi = p + 1; hipLaunchKernelGGL(mega_fwd, dim3(grid), dim3(NWAVES * 64), LDS_BYTES, stream, a); }
        }
#else
        a.ph_lo = lo; a.ph_hi = hi;
        void* kargs[] = {(void*)&a};
        hipError_t e = hipLaunchCooperativeKernel((const void*)mega_fwd, dim3(grid), dim3(NWAVES * 64), kargs, LDS_BYTES, stream);
        if (e != hipSuccess) fprintf(stderr, "kernel_launch: cooperative launch failed: %s (grid %d)\n", hipGetErrorString(e), grid);
#endif
    };
    run(PH_P0, PH_COUNT);
}
```

```cpp
#include <hip/hip_runtime.h>
#include <cstdio>
#include <cstdint>

#ifndef MK_DUP_MASK
#define MK_DUP_MASK 0
#endif
#ifndef MK_GPROBE
#define MK_GPROBE 0
#endif
#ifndef MK_SHADOW
#define MK_SHADOW 0
#endif
#ifndef MK_FUSE_FINAL
#define MK_FUSE_FINAL 1
#endif
#ifndef MK_STAG
#define MK_STAG 0
#endif
#ifndef MK_NT
#define MK_NT 0x0
#endif
#ifndef MK_PER_PHASE
#define MK_PER_PHASE 0
#endif

#define GAS __attribute__((address_space(1)))
#define LAS __attribute__((address_space(3)))
typedef _Float16 h16;
typedef _Float16 h16x8 __attribute__((ext_vector_type(8)));
typedef _Float16 h16x4 __attribute__((ext_vector_type(4)));
typedef _Float16 h16x2 __attribute__((ext_vector_type(2)));
typedef float f32x4 __attribute__((ext_vector_type(4)));
typedef float f32x2 __attribute__((ext_vector_type(2)));
typedef unsigned u32x4 __attribute__((ext_vector_type(4)));
typedef unsigned u32x2 __attribute__((ext_vector_type(2)));

constexpr int D = 1024, NB = 4, S = 8192, M = NB * S, DFF = 2816, NGU = 2 * DFF, NMOD = 9;
constexpr int AW = 512, HD = 64, NH = 8, INW = 2560, MBLK = 256, NBLK = S / MBLK, GC = 128;
constexpr float EPS = 1e-6f;
constexpr float C2 = 0.125f * 1.4426950408889634f;
constexpr int PQ = 0, PU = 512, PK = 1024, PV = 1536, PG = 2048;

constexpr size_t MiB = 1u << 20, KiB = 1u << 10;
constexpr size_t WS_CTL = 0, CTL_ZERO_BYTES = 1 * MiB;
constexpr size_t WS_MODP = 1 * MiB;
constexpr size_t WS_GT = 2 * MiB, WS_GP = WS_GT + 64 * KiB;
constexpr size_t WS_BIAS1 = WS_GT + 128 * KiB, WS_BIAS2 = WS_GT + 256 * KiB, WS_BIAS3 = WS_GT + 320 * KiB;
constexpr size_t WS_R1 = 3 * MiB, WS_RG = WS_R1 + 128 * KiB;
constexpr size_t WS_SSQA = 4 * MiB;
constexpr size_t WS_SSQ2 = 5 * MiB, WS_SSQ3 = 7 * MiB, WS_SSQF = 9 * MiB;
constexpr size_t WS_KMP = 11 * MiB;
constexpr size_t WS_ROPE = 12 * MiB;
constexpr size_t WS_WS16 = 14 * MiB;
constexpr size_t WS_WGU1 = 16 * MiB, WS_WD1 = 27 * MiB, WS_WIN = 33 * MiB, WS_WOUT = 38 * MiB, WS_WGU2 = 40 * MiB, WS_WD2 = 51 * MiB;
constexpr size_t WS_HG = 64 * MiB, WS_H = 128 * MiB, WS_ACT = 192 * MiB, WS_PROJ = WS_ACT;
constexpr size_t WS_LISTS = 368 * MiB, WS_END = 384 * MiB;
static_assert(WS_WD2 + (size_t)D * DFF * 2 <= WS_HG && WS_ACT + (size_t)M * DFF * 2 <= WS_LISTS, "ws map");
constexpr int CW_TMO = 0, CW_BAR = 4096;

constexpr int RING_BYTES = 131072, LDSCTL_OFF = RING_BYTES, MISC_OFF = LDSCTL_OFF + 320, LDS_BYTES = 147456;
constexpr int NWAVES = 8;

#define LDS_WAIT() asm volatile("s_waitcnt lgkmcnt(0)" ::: "memory")
#define VM_WAIT() asm volatile("s_waitcnt vmcnt(0)" ::: "memory")

__device__ __forceinline__ float wave_sum(float v) {
#pragma unroll
    for (int o = 1; o < 64; o <<= 1) v += __shfl_xor(v, o);
    return v;
}
template <int SEL, class T> __device__ __forceinline__ void st_stream(GAS T* p, const T& v) { if ((MK_NT >> SEL) & 1) __builtin_nontemporal_store(v, p); else *p = v; }
__device__ __forceinline__ unsigned pkh(float lo, float hi) { h16x2 v; v.x = (h16)lo; v.y = (h16)hi; return __builtin_bit_cast(unsigned, v); }
__device__ __forceinline__ float silu_fast(float x) { return x * __builtin_amdgcn_rcpf(1.f + __builtin_amdgcn_exp2f(-1.4426950408889634f * x)); }
__device__ __forceinline__ float gelu_fast(float x) {
    const float u2 = 1.5957691216057308f * (x + 0.044715f * x * x * x);
    return x * __builtin_amdgcn_rcpf(1.f + __builtin_amdgcn_exp2f(-1.4426950408889634f * u2));
}
__device__ __forceinline__ float rs16(const GAS float* p) {
    const f32x4 s0 = *(const GAS f32x4*)(p), s1 = *(const GAS f32x4*)(p + 4), s2 = *(const GAS f32x4*)(p + 8), s3 = *(const GAS f32x4*)(p + 12);
    const f32x4 st = (s0 + s1) + (s2 + s3);
    return rsqrtf(((st[0] + st[1]) + (st[2] + st[3])) * (1.f / D) + EPS);
}


__device__ __forceinline__ size_t blk_off(int row, int k, int nt) { return (((size_t)(row >> 8) * nt + (k >> 6)) * 256 + (row & 255)) * 64 + (k & 63); }

namespace pg8 {
constexpr int BM = 256, BK = 64, HALF = 128, HTB = HALF * BK * 2, STAGE_BYTES = 8 * HTB, NXCD = 8, WGM = 8;
__host__ __device__ __forceinline__ int lds_byte(int r, int c) { const int st = (r >> 4) * 2 + (c >> 5), rr = r & 15, cc = c & 31, ob = rr * 64 + cc * 2; return st * 1024 + (ob ^ (((ob >> 9) & 1) << 5)); }
__host__ __device__ __forceinline__ void stage_rc(int b, int& R, int& C) { const int st = b / 1024, sb = b % 1024, swz = sb ^ (((sb >> 9) & 1) << 5); R = (st >> 1) * 16 + swz / 64; C = (st & 1) * 32 + (swz % 64) / 2; }
struct Unit { int pm, pn; };
struct Gemm { const GAS h16* A; const GAS h16* Bt; int lda, N, K; unsigned stag = 0; };
struct StaticOrder {
    int nM, nN, nwg, G, c;
    __device__ __forceinline__ void init(int M_, int N, int G_, int c_) { nM = M_ / BM; nN = N / BM; nwg = nM * nN; G = G_; c = c_; }
    __device__ __forceinline__ bool next(int i, Unit& u) const {
        const long L = (long)i * G + c; if (L >= nwg) return false;
        int wgid = (int)L; { const int q = nwg / NXCD, r = nwg % NXCD, xcd = wgid % NXCD, off = wgid / NXCD; wgid = (xcd < r ? xcd * (q + 1) : r * (q + 1) + (xcd - r) * q) + off; }
        const int nig = WGM * nN, gid = wgid / nig, fm = gid * WGM, gsz = (nM - fm) < WGM ? (nM - fm) : WGM;
        u.pm = fm + ((wgid % nig) % gsz); u.pn = (wgid % nig) / gsz; return true;
    }
};
struct TableOrder {
    const LAS int* tab; int n;
    __device__ __forceinline__ bool next(int i, Unit& u) const { if (i >= n) return false; u.pm = tab[2 * i]; u.pn = tab[2 * i + 1]; return true; }
};
__device__ __forceinline__ TableOrder make_table(const StaticOrder& So, LAS int* tab) {
    if (threadIdx.x < 16) { Unit u; u.pm = -1; u.pn = 0; const bool ok = So.next((int)threadIdx.x, u); tab[2 * threadIdx.x] = ok ? u.pm : -1; tab[2 * threadIdx.x + 1] = u.pn; }
    __syncthreads();
    int n = 0;
    while (n < 16 && tab[2 * n] >= 0) ++n;
    TableOrder T; T.tab = tab; T.n = __builtin_amdgcn_readfirstlane(n); return T;
}
template <class Epi, bool ALIGN_EPI, int PROBE = 0, class Order = StaticOrder>
__device__ __forceinline__ void gemm_phase(LAS unsigned char* lds, const Gemm g, const Order& S, const Epi& E) {
    const int tid = threadIdx.x, wid = __builtin_amdgcn_readfirstlane(tid >> 6), lane = tid & 63, wr = wid >> 2, wc = wid & 3, fr = lane & 15, fq = lane >> 4;
    const int K = g.K, nt = K / BK;
    unsigned voffA[2], voffB[2];
    const bool ablk = (g.lda == 0);
#pragma unroll
    for (int i = 0; i < 2; ++i) { int R, C; stage_rc(tid * 16 + i * 8192, R, C); voffA[i] = (unsigned)(R * (ablk ? BK : g.lda) + C) * 2u; voffB[i] = (unsigned)(R * BK + C) * 2u; }
    const size_t kstepB = (size_t)BM * BK * 2, kstepA = ablk ? kstepB : (size_t)(BK * 2);
    const size_t hstepB = (size_t)HALF * BK * 2, hstepA = ablk ? hstepB : (size_t)HALF * g.lda * 2;
    const size_t tstepB = (size_t)nt * kstepB, tstepA = ablk ? tstepB : 2 * hstepA;
    const unsigned ldsw = (unsigned)wid * 1024u;
    const int aoff = lds_byte(wr * 64 + fr, fq * 8), boff = lds_byte(wc * 32 + fr, fq * 8);
#define PG8_SA(b, h) (((b) * 2 + (h)) * HTB)
#define PG8_SB(b, h) ((4 + (b) * 2 + (h)) * HTB)
#define PG8_STAGE(bufoff, gbase, voff) do { if (PROBE != 2) _Pragma("unroll") for (int _i = 0; _i < 2; ++_i) \
        __builtin_amdgcn_global_load_lds((const unsigned*)((const char*)(gbase) + (voff)[_i]), (LAS unsigned*)(lds + (bufoff) + ldsw + _i * 8192), 16, 0, 0); } while (0)
#define PG8_LDA(dst, b, h) do { _Pragma("unroll") for (int m = 0; m < 4; ++m) _Pragma("unroll") for (int k = 0; k < 2; ++k) dst[m][k] = *(const LAS h16x8*)(lds + PG8_SA(b, h) + aoff + m * 2048 + k * 1024); } while (0)
#define PG8_LDB(dst, b, h) do { _Pragma("unroll") for (int n = 0; n < 2; ++n) _Pragma("unroll") for (int k = 0; k < 2; ++k) dst[n][k] = *(const LAS h16x8*)(lds + PG8_SB(b, h) + boff + n * 2048 + k * 1024); } while (0)
#define PG8_MMA(ai, bj, At, Bt) do { if (PROBE == 1 && (bj) == 1) break; __builtin_amdgcn_s_setprio(1); _Pragma("unroll") for (int m = 0; m < 4; ++m) _Pragma("unroll") for (int n = 0; n < 2; ++n) _Pragma("unroll") for (int k = 0; k < 2; ++k) \
        acc[ai][bj][m][n] = __builtin_amdgcn_mfma_f32_16x16x32_f16(Bt[n][k], At[m][k], acc[ai][bj][m][n], 0, 0, 0); __builtin_amdgcn_s_setprio(0); } while (0)
#define PG8_WAIT_V(n) asm volatile("s_waitcnt vmcnt(" #n ")" ::: "memory")
#define PG8_WAIT_L(n) asm volatile("s_waitcnt lgkmcnt(" #n ")" ::: "memory")
#define PG8_BAR __builtin_amdgcn_s_barrier()
#define PG8_SCHED __builtin_amdgcn_sched_barrier(0)
    Unit cur, nxt; int ui = 0;
    if (!S.next(0, cur)) return;
    if (g.stag) { const unsigned st = (unsigned)(cur.pm & 7); if (st) { const unsigned long long t0 = __builtin_amdgcn_s_memrealtime(), dl = (unsigned long long)st * g.stag; while (__builtin_amdgcn_s_memrealtime() - t0 < dl) __builtin_amdgcn_s_sleep(4); } }
    f32x4 acc[2][2][4][2];
#pragma unroll
    for (int a = 0; a < 2; ++a)
#pragma unroll
        for (int b = 0; b < 2; ++b)
#pragma unroll
            for (int m = 0; m < 4; ++m)
#pragma unroll
                for (int n = 0; n < 2; ++n) acc[a][b][m][n] = (f32x4){0.f, 0.f, 0.f, 0.f};
    h16x8 At[4][2], B0[2][2], B1[2][2];
    const char* cA = (const char*)g.A + (size_t)cur.pm * tstepA; const char* cB = (const char*)g.Bt + (size_t)cur.pn * tstepB;
    PG8_STAGE(PG8_SB(0, 0), cB, voffB); PG8_STAGE(PG8_SB(0, 1), cB + hstepB, voffB); PG8_STAGE(PG8_SA(0, 0), cA, voffA); PG8_STAGE(PG8_SA(0, 1), cA + hstepA, voffA);
    if (wr == 1) PG8_BAR;
    PG8_WAIT_V(2); PG8_BAR;
    PG8_STAGE(PG8_SB(1, 0), cB + kstepB, voffB); PG8_STAGE(PG8_SA(1, 0), cA + kstepA, voffA); PG8_STAGE(PG8_SB(1, 1), cB + hstepB + kstepB, voffB);
    PG8_WAIT_V(6); PG8_BAR;
    for (;;) {
        const bool has_next = S.next(ui + 1, nxt);
        const char* nA = has_next ? (const char*)g.A + (size_t)nxt.pm * tstepA : cA; const char* nB = has_next ? (const char*)g.Bt + (size_t)nxt.pn * tstepB : cB;
        for (int t = 0; t < nt; t += 2) {
            const bool last = (t == nt - 2);
            const char* a1 = cA + (size_t)(t + 1) * kstepA;
            const char* a2 = last ? nA : cA + (size_t)(t + 2) * kstepA; const char* b2 = last ? nB : cB + (size_t)(t + 2) * kstepB;
            const char* a3 = a2 + kstepA; const char* b3 = b2 + kstepB;
            if constexpr (Epi::MID) { if (t == nt / 2) E.mid(acc, cur, ui, wr, wc, fr, fq); }
            PG8_LDB(B0, 0, 0); PG8_LDB(B1, 0, 1); PG8_SCHED; PG8_LDA(At, 0, 0); PG8_STAGE(PG8_SA(1, 1), a1 + hstepA, voffA);
            PG8_WAIT_V(8); PG8_WAIT_L(0); PG8_BAR; PG8_MMA(0, 0, At, B0); PG8_MMA(0, 1, At, B1); PG8_BAR; PG8_SCHED;
            PG8_LDA(At, 0, 1); PG8_STAGE(PG8_SB(0, 0), b2, voffB); PG8_STAGE(PG8_SB(0, 1), b2 + hstepB, voffB); PG8_STAGE(PG8_SA(0, 0), a2, voffA);
            PG8_WAIT_V(8); PG8_WAIT_L(0); PG8_BAR; PG8_MMA(1, 0, At, B0); PG8_MMA(1, 1, At, B1); PG8_BAR; PG8_SCHED;
            PG8_LDB(B0, 1, 0); PG8_LDB(B1, 1, 1); PG8_SCHED; PG8_LDA(At, 1, 0); PG8_STAGE(PG8_SA(0, 1), a2 + hstepA, voffA);
            PG8_WAIT_V(8); PG8_WAIT_L(0); PG8_BAR; PG8_MMA(0, 0, At, B0); PG8_MMA(0, 1, At, B1); PG8_BAR; PG8_SCHED;
            PG8_LDA(At, 1, 1); PG8_STAGE(PG8_SB(1, 0), b3, voffB); PG8_STAGE(PG8_SB(1, 1), b3 + hstepB, voffB); PG8_STAGE(PG8_SA(1, 0), a3, voffA);
            PG8_WAIT_V(8); PG8_WAIT_L(0); PG8_BAR; PG8_MMA(1, 0, At, B0); PG8_MMA(1, 1, At, B1); PG8_BAR; PG8_SCHED;
        }
        if constexpr (ALIGN_EPI) { if (wr == 0) PG8_BAR; }
        E(acc, cur, ui, wr, wc, fr, fq);
        if (!has_next) break;
#pragma unroll
        for (int a = 0; a < 2; ++a)
#pragma unroll
            for (int b = 0; b < 2; ++b)
#pragma unroll
                for (int m = 0; m < 4; ++m)
#pragma unroll
                    for (int n = 0; n < 2; ++n) acc[a][b][m][n] = (f32x4){0.f, 0.f, 0.f, 0.f};
        cur = nxt; cA = nA; cB = nB; ++ui;
        if constexpr (ALIGN_EPI) { if (wr == 1) PG8_BAR; }
    }
    PG8_WAIT_V(0);
    if constexpr (!ALIGN_EPI) { if (wr == 0) PG8_BAR; }
    PG8_BAR;
#undef PG8_SA
#undef PG8_SB
#undef PG8_STAGE
#undef PG8_LDA
#undef PG8_LDB
#undef PG8_MMA
#undef PG8_WAIT_V
#undef PG8_WAIT_L
#undef PG8_BAR
#undef PG8_SCHED
}
}

typedef const f32x4 (&AccRef)[2][2][4][2];
struct EpiSwiglu {
    static constexpr bool MID = false;
    GAS h16* act; const LAS float* rtab; const GAS float* bias;
    __device__ __forceinline__ void mid(f32x4 (&)[2][2][4][2], const pg8::Unit&, int, int, int, int, int) const {}
    __device__ __forceinline__ void operator()(AccRef acc, const pg8::Unit& u, int ui, int wr, int wc, int fr, int fq) const {
        const int b = u.pm >> 5, row0 = u.pm * 256 + wr * 64 + fr;
        const GAS float* bp = bias + b * NGU + u.pn * 256 + wc * 32 + 4 * fq;
        f32x4 bv[2][2];
#pragma unroll
        for (int bj = 0; bj < 2; ++bj)
#pragma unroll
            for (int n = 0; n < 2; ++n) bv[bj][n] = *(const GAS f32x4*)(bp + bj * 128 + n * 16);
        const LAS float* rt = rtab + ui * 256 + wr * 64 + fr;
        const int hid0 = u.pn * 128 + wc * 32 + fq * 8;
#pragma unroll
        for (int ai = 0; ai < 2; ++ai)
#pragma unroll
            for (int m = 0; m < 4; ++m) {
                const int ro = ai * 128 + m * 16; const float rs = rt[ro];
                u32x4 w;
#pragma unroll
                for (int n = 0; n < 2; ++n) {
                    const f32x4 gv = acc[ai][0][m][n] * rs + bv[0][n], uv = acc[ai][1][m][n] * rs + bv[1][n];
                    const float a0 = silu_fast(gv[0]) * uv[0], a1 = silu_fast(gv[1]) * uv[1], a2 = silu_fast(gv[2]) * uv[2], a3 = silu_fast(gv[3]) * uv[3];
                    w[2 * n] = pkh(a0, a1); w[2 * n + 1] = pkh(a2, a3);
                }
                st_stream<3>((GAS u32x4*)(act + blk_off(row0 + ro, hid0, DFF / 64)), w);
            }
    }
};
struct EpiNull {
    static constexpr bool MID = false;
    __device__ __forceinline__ void mid(f32x4 (&)[2][2][4][2], const pg8::Unit&, int, int, int, int, int) const {}
    __device__ __forceinline__ void operator()(AccRef acc, const pg8::Unit& u, int ui, int wr, int wc, int fr, int fq) const {
#pragma unroll
        for (int ai = 0; ai < 2; ++ai)
#pragma unroll
            for (int bj = 0; bj < 2; ++bj)
#pragma unroll
                for (int m = 0; m < 4; ++m)
#pragma unroll
                    for (int n = 0; n < 2; ++n) asm volatile("" :: "v"(acc[ai][bj][m][n]));
    }
};
template <bool RES_F32, bool TWOSCALE, bool WRITE_HG, int PVAR = 0> struct EpiResid {
    static constexpr bool MID = TWOSCALE;
    const GAS float* xres; GAS h16* H; GAS h16* HG; const GAS float* cs; const GAS float* gp; GAS float* ssq; const LAS float* sct; float cmul;
    __device__ __forceinline__ void mid(f32x4 (&acc)[2][2][4][2], const pg8::Unit& u, int ui, int wr, int wc, int fr, int fq) const {
        if constexpr (TWOSCALE) {
            const LAS float* t = sct + ui * 512 + wr * 64 + fr;
#pragma unroll
            for (int ai = 0; ai < 2; ++ai)
#pragma unroll
                for (int m = 0; m < 4; ++m) { const float f = t[ai * 128 + m * 16];
#pragma unroll
                    for (int bj = 0; bj < 2; ++bj)
#pragma unroll
                        for (int n = 0; n < 2; ++n) acc[ai][bj][m][n] *= f; }
        }
    }
    __device__ __forceinline__ void operator()(AccRef acc, const pg8::Unit& u, int ui, int wr, int wc, int fr, int fq) const {
        const int b = u.pm >> 5, row0 = u.pm * 256 + wr * 64 + fr, col0 = u.pn * 256 + wc * 32 + 8 * fq;
        f32x4 csv[2][2], gpv[2][2];
#pragma unroll
        for (int bj = 0; bj < 2; ++bj)
#pragma unroll
            for (int n = 0; n < 2; ++n) { csv[bj][n] = *(const GAS f32x4*)(cs + b * D + col0 + bj * 128 + 4 * n) * cmul; if constexpr (WRITE_HG) gpv[bj][n] = *(const GAS f32x4*)(gp + b * D + col0 + bj * 128 + 4 * n); }
        constexpr int MB_ = RES_F32 ? 2 : 4;
#pragma unroll
        for (int ai = 0; ai < 2; ++ai)
#pragma unroll
        for (int m0 = 0; m0 < 4; m0 += MB_) {
            f32x4 rf[4][2][2]; h16x8 rh[4][2];
#pragma unroll
            for (int m = m0; m < m0 + MB_; ++m)
#pragma unroll
                for (int bj = 0; bj < 2; ++bj) { const size_t off = (size_t)(row0 + ai * 128 + m * 16) * D + col0 + bj * 128;
                    if constexpr (PVAR == 2 || PVAR == 6 || PVAR == 7) { rf[m][bj][0] = (f32x4){0.f, 0.f, 0.f, 0.f}; rf[m][bj][1] = rf[m][bj][0]; rh[m][bj] = (h16x8){0, 0, 0, 0, 0, 0, 0, 0}; }
                    else if constexpr (PVAR == 3) { const h16x8 t = *(const GAS h16x8*)(HG + blk_off(row0 + ai * 128 + m * 16, col0 + bj * 128, D / 64)); rf[m][bj][0] = (f32x4){(float)t[0], (float)t[1], (float)t[2], (float)t[3]}; rf[m][bj][1] = (f32x4){(float)t[4], (float)t[5], (float)t[6], (float)t[7]}; }
                    else if constexpr (RES_F32) { rf[m][bj][0] = *(const GAS f32x4*)(xres + off); rf[m][bj][1] = *(const GAS f32x4*)(xres + off + 4); }
                    else rh[m][bj] = *(const GAS h16x8*)(H + off); }
            asm volatile("" ::: "memory");
#pragma unroll
            for (int m = m0; m < m0 + MB_; ++m) {
                const int row = row0 + ai * 128 + m * 16; const size_t off = (size_t)row * D + col0;
                float rsc = 1.f; if constexpr (TWOSCALE) rsc = sct[ui * 512 + 256 + wr * 64 + fr + ai * 128 + m * 16];
                float q = 0.f;
#pragma unroll
                for (int bj = 0; bj < 2; ++bj) {
                    f32x4 r0, r1;
                    if constexpr (RES_F32) { r0 = rf[m][bj][0]; r1 = rf[m][bj][1]; }
                    else { const h16x8 hv = rh[m][bj]; r0 = (f32x4){(float)hv[0], (float)hv[1], (float)hv[2], (float)hv[3]}; r1 = (f32x4){(float)hv[4], (float)hv[5], (float)hv[6], (float)hv[7]}; }
                    const f32x4 v0 = r0 + csv[bj][0] * (acc[ai][bj][m][0] * rsc), v1 = r1 + csv[bj][1] * (acc[ai][bj][m][1] * rsc);
                    q += ((v0[0] * v0[0] + v0[1] * v0[1]) + (v0[2] * v0[2] + v0[3] * v0[3])) + ((v1[0] * v1[0] + v1[1] * v1[1]) + (v1[2] * v1[2] + v1[3] * v1[3]));
                    u32x4 w; w[0] = pkh(v0[0], v0[1]); w[1] = pkh(v0[2], v0[3]); w[2] = pkh(v1[0], v1[1]); w[3] = pkh(v1[2], v1[3]);
                    const int colp = u.pn * 256 + wc * 64 + 16 * fq + 8 * bj;
                    if constexpr (PVAR == 1) asm volatile("" :: "v"(w)); else if constexpr (PVAR == 4) *(GAS u32x4*)(H + blk_off(row, col0 + bj * 128, D / 64)) = w;
                    else if constexpr (PVAR == 5) *(GAS u32x4*)(H + (size_t)row * D + colp) = w; else if constexpr (PVAR == 7) __builtin_nontemporal_store(w, (GAS u32x4*)(H + off + bj * 128)); else st_stream<1>((GAS u32x4*)(H + off + bj * 128), w);
                    if constexpr (WRITE_HG) { const f32x4 g0 = v0 * gpv[bj][0], g1 = v1 * gpv[bj][1];
                        u32x4 wg; wg[0] = pkh(g0[0], g0[1]); wg[1] = pkh(g0[2], g0[3]); wg[2] = pkh(g1[0], g1[1]); wg[3] = pkh(g1[2], g1[3]);
                        if constexpr (PVAR == 1 || PVAR == 6) asm volatile("" :: "v"(wg)); else if constexpr (PVAR == 7) __builtin_nontemporal_store(wg, (GAS u32x4*)(HG + blk_off(row, col0 + bj * 128, D / 64))); else if constexpr (PVAR == 5) *(GAS u32x4*)(HG + blk_off(row, colp, D / 64)) = wg; else st_stream<2>((GAS u32x4*)(HG + blk_off(row, col0 + bj * 128, D / 64)), wg); }
                }
                q += __shfl_xor(q, 16); q += __shfl_xor(q, 32);
                if (fq == 0) { if constexpr (PVAR == 1) asm volatile("" :: "v"(q)); else ssq[(size_t)row * 16 + u.pn * 4 + wc] = q; }
            }
        }
    }
};
constexpr int CW_PAN = 16384;
struct EpiFinal {
    static constexpr bool MID = false;
    const GAS h16* H; const GAS float* cs; const GAS float* gfin; GAS float* out; unsigned* xs; unsigned* cnt; unsigned* tmo; LAS float* P; LAS float* Sx; float cmul;
    __device__ __forceinline__ void mid(f32x4 (&)[2][2][4][2], const pg8::Unit&, int, int, int, int, int) const {}
    __device__ __forceinline__ void operator()(f32x4 (&acc)[2][2][4][2], const pg8::Unit& u, int ui, int wr, int wc, int fr, int fq) const {
        const int b = u.pm >> 5, row0 = u.pm * 256 + wr * 64 + fr, col0 = u.pn * 256 + wc * 32 + 8 * fq;
        const int tid = threadIdx.x, lane = tid & 63, wid = __builtin_amdgcn_readfirstlane(tid >> 6);
        f32x4 csv[2][2];
#pragma unroll
        for (int bj = 0; bj < 2; ++bj)
#pragma unroll
            for (int n = 0; n < 2; ++n) csv[bj][n] = *(const GAS f32x4*)(cs + b * D + col0 + bj * 128 + 4 * n) * cmul;
#pragma unroll
        for (int ai = 0; ai < 2; ++ai) {
            h16x8 rh[4][2];
#pragma unroll
            for (int m = 0; m < 4; ++m)
#pragma unroll
                for (int bj = 0; bj < 2; ++bj) rh[m][bj] = *(const GAS h16x8*)(H + (size_t)(row0 + ai * 128 + m * 16) * D + col0 + bj * 128);
#pragma unroll
            for (int m = 0; m < 4; ++m) {
                float q = 0.f;
#pragma unroll
                for (int bj = 0; bj < 2; ++bj) { const h16x8 hv = rh[m][bj];
                    const f32x4 v0 = (f32x4){(float)hv[0], (float)hv[1], (float)hv[2], (float)hv[3]} + csv[bj][0] * acc[ai][bj][m][0], v1 = (f32x4){(float)hv[4], (float)hv[5], (float)hv[6], (float)hv[7]} + csv[bj][1] * acc[ai][bj][m][1];
                    acc[ai][bj][m][0] = v0; acc[ai][bj][m][1] = v1;
                    q += ((v0[0] * v0[0] + v0[1] * v0[1]) + (v0[2] * v0[2] + v0[3] * v0[3])) + ((v1[0] * v1[0] + v1[1] * v1[1]) + (v1[2] * v1[2] + v1[3] * v1[3])); }
                q += __shfl_xor(q, 16); q += __shfl_xor(q, 32);
                if (fq == 0) P[(ai * 128 + wr * 64 + m * 16 + fr) * 4 + wc] = q;
            }
        }
        asm volatile("s_waitcnt lgkmcnt(0)" ::: "memory"); __builtin_amdgcn_s_barrier(); asm volatile("" ::: "memory");
        if (tid < 256) {
            const f32x4 p4 = *(const LAS f32x4*)(P + tid * 4);
            __hip_atomic_store(xs + ((size_t)(u.pm * 256 + tid) * 4 + u.pn), __float_as_uint((p4[0] + p4[1]) + (p4[2] + p4[3])), __ATOMIC_RELAXED, __HIP_MEMORY_SCOPE_AGENT);
        }
        asm volatile("s_waitcnt vmcnt(0)" ::: "memory");
        if (wid < 4 && lane == 0) __hip_atomic_fetch_add(cnt + 64 * u.pm, 1u, __ATOMIC_RELAXED, __HIP_MEMORY_SCOPE_AGENT);
        if (wid == 0) {
            unsigned sp = 0u;
            while ((unsigned)__builtin_amdgcn_readfirstlane(__hip_atomic_load(cnt + 64 * u.pm, __ATOMIC_RELAXED, __HIP_MEMORY_SCOPE_AGENT)) < 16u) {
                __builtin_amdgcn_s_sleep(2);
                if (++sp > (1u << 16)) { if (lane == 0) __hip_atomic_store(tmo, 1u, __ATOMIC_RELAXED, __HIP_MEMORY_SCOPE_AGENT); break; }
            }
            __builtin_amdgcn_fence(__ATOMIC_ACQUIRE, "agent");
        }
        asm volatile("s_waitcnt vmcnt(0) lgkmcnt(0)" ::: "memory"); __builtin_amdgcn_s_barrier(); asm volatile("" ::: "memory");
        if (tid < 256) {
            const unsigned* sl = xs + (size_t)(u.pm * 256 + tid) * 4;
            const float s0 = __uint_as_float(__hip_atomic_load(sl + 0, __ATOMIC_RELAXED, __HIP_MEMORY_SCOPE_AGENT)), s1 = __uint_as_float(__hip_atomic_load(sl + 1, __ATOMIC_RELAXED, __HIP_MEMORY_SCOPE_AGENT)),
                        s2 = __uint_as_float(__hip_atomic_load(sl + 2, __ATOMIC_RELAXED, __HIP_MEMORY_SCOPE_AGENT)), s3 = __uint_as_float(__hip_atomic_load(sl + 3, __ATOMIC_RELAXED, __HIP_MEMORY_SCOPE_AGENT));
            Sx[tid] = rsqrtf(((s0 + s1) + (s2 + s3)) * (1.f / D) + EPS);
        }
        asm volatile("s_waitcnt vmcnt(0) lgkmcnt(0)" ::: "memory"); __builtin_amdgcn_s_barrier(); asm volatile("" ::: "memory");
        f32x4 gv[2][2];
#pragma unroll
        for (int bj = 0; bj < 2; ++bj)
#pragma unroll
            for (int n = 0; n < 2; ++n) gv[bj][n] = *(const GAS f32x4*)(gfin + col0 + bj * 128 + 4 * n);
#pragma unroll
        for (int ai = 0; ai < 2; ++ai)
#pragma unroll
            for (int m = 0; m < 4; ++m) { const int rl = ai * 128 + wr * 64 + m * 16 + fr; const float rs = Sx[rl]; GAS float* op = out + (size_t)(u.pm * 256 + rl) * D + col0;
#pragma unroll
                for (int bj = 0; bj < 2; ++bj) { st_stream<0>((GAS f32x4*)(op + bj * 128), acc[ai][bj][m][0] * rs * gv[bj][0]); st_stream<0>((GAS f32x4*)(op + bj * 128 + 4), acc[ai][bj][m][1] * rs * gv[bj][1]); } }
        asm volatile("s_waitcnt lgkmcnt(0)" ::: "memory"); __builtin_amdgcn_s_barrier(); asm volatile("" ::: "memory");
    }
};
struct EpiInproj {
    static constexpr bool MID = false;
    GAS h16* proj; const LAS float* rtab; const GAS float* bias; const GAS float* rope; GAS float* kmp;
    __device__ __forceinline__ void mid(f32x4 (&)[2][2][4][2], const pg8::Unit&, int, int, int, int, int) const {}
    __device__ __forceinline__ void operator()(AccRef acc, const pg8::Unit& u, int ui, int wr, int wc, int fr, int fq) const {
        const int b = u.pm >> 5, row0 = u.pm * 256 + wr * 64 + fr, region = u.pn >> 1;
        const GAS float* bp = bias + b * INW + u.pn * 256 + wc * 32 + 4 * fq;
        f32x4 bv[2][2];
#pragma unroll
        for (int bj = 0; bj < 2; ++bj)
#pragma unroll
            for (int n = 0; n < 2; ++n) bv[bj][n] = *(const GAS f32x4*)(bp + bj * 128 + n * 16);
        const bool is_rope = (region == 0) || (region == 2);
        f32x4 csum[2][2];
#pragma unroll
        for (int bj = 0; bj < 2; ++bj)
#pragma unroll
            for (int n = 0; n < 2; ++n) csum[bj][n] = (f32x4){0.f, 0.f, 0.f, 0.f};
        const LAS float* rt = rtab + ui * 256 + wr * 64 + fr;
#pragma unroll
        for (int ai = 0; ai < 2; ++ai)
#pragma unroll
        for (int m0 = 0; m0 < 4; m0 += 2) {
            f32x4 rcs[4][2], rsn[4][2];
            if (is_rope) {
#pragma unroll
                for (int m = m0; m < m0 + 2; ++m) { const GAS float* rp = rope + (size_t)((row0 + ai * 128 + m * 16) & (S - 1)) * 64 + 4 * fq;
#pragma unroll
                    for (int n = 0; n < 2; ++n) { rcs[m][n] = *(const GAS f32x4*)(rp + 16 * n); rsn[m][n] = *(const GAS f32x4*)(rp + 32 + 16 * n); } }
            }
            asm volatile("" ::: "memory");
#pragma unroll
            for (int m = m0; m < m0 + 2; ++m) {
                const int row = row0 + ai * 128 + m * 16;
                const float rs = rt[ai * 128 + m * 16];
                f32x4 v[2][2];
#pragma unroll
                for (int bj = 0; bj < 2; ++bj)
#pragma unroll
                    for (int n = 0; n < 2; ++n) v[bj][n] = acc[ai][bj][m][n] * rs + bv[bj][n];
                GAS h16* prow = proj + (size_t)row * INW + region * 512 + (u.pn & 1) * 256;
                if (is_rope) {
                    const float qs = (region == 0) ? C2 : 1.f;
#pragma unroll
                    for (int n = 0; n < 2; ++n) {
                        const f32x4 cs4 = rcs[m][n] * qs, sn4 = rsn[m][n] * qs;
                        const f32x4 x1 = v[0][n], x2 = v[1][n];
                        v[0][n] = x1 * cs4 - x2 * sn4; v[1][n] = x2 * cs4 + x1 * sn4;
                    }
                    GAS h16* hp = prow + wc * 64 + 16 * fq;
#pragma unroll
                    for (int bj = 0; bj < 2; ++bj) { u32x4 w; w[0] = pkh(v[bj][0][0], v[bj][0][1]); w[1] = pkh(v[bj][0][2], v[bj][0][3]); w[2] = pkh(v[bj][1][0], v[bj][1][1]); w[3] = pkh(v[bj][1][2], v[bj][1][3]);
                        st_stream<4>((GAS u32x4*)(hp + 8 * bj), w); }
                    if (region == 2) {
#pragma unroll
                        for (int bj = 0; bj < 2; ++bj)
#pragma unroll
                            for (int n = 0; n < 2; ++n) csum[bj][n] += v[bj][n];
                    }
                } else {
                    if (region == 1 || region == 4) {
#pragma unroll
                        for (int bj = 0; bj < 2; ++bj)
#pragma unroll
                            for (int n = 0; n < 2; ++n)
#pragma unroll
                                for (int j = 0; j < 4; ++j) v[bj][n][j] = gelu_fast(v[bj][n][j]);
                    }
                    GAS h16* hp = prow + wc * 32 + 8 * fq;
#pragma unroll
                    for (int bj = 0; bj < 2; ++bj) { u32x4 w; w[0] = pkh(v[bj][0][0], v[bj][0][1]); w[1] = pkh(v[bj][0][2], v[bj][0][3]); w[2] = pkh(v[bj][1][0], v[bj][1][1]); w[3] = pkh(v[bj][1][2], v[bj][1][3]);
                        st_stream<4>((GAS u32x4*)(hp + 128 * bj), w); }
                }
            }
        }
        if (region == 2) {
#pragma unroll
            for (int bj = 0; bj < 2; ++bj)
#pragma unroll
                for (int n = 0; n < 2; ++n)
#pragma unroll
                    for (int j = 0; j < 4; ++j) { float t = csum[bj][n][j]; t += __shfl_xor(t, 1); t += __shfl_xor(t, 2); t += __shfl_xor(t, 4); t += __shfl_xor(t, 8); csum[bj][n][j] = t; }
            if (fr == 0) {
                GAS float* kp = kmp + ((size_t)((b * NBLK + (u.pm & 31)) * 2 + wr)) * 512 + ((u.pn & 1) * 4 + wc) * 64 + 16 * fq;
#pragma unroll
                for (int bj = 0; bj < 2; ++bj)
#pragma unroll
                    for (int n = 0; n < 2; ++n) *(GAS f32x4*)(kp + 8 * bj + 4 * n) = csum[bj][n];
            }
        }
    }
};

#define XB_TMO      128
#define XB_XCNT(j)  (256  + 64 * (j))
#define XB_XSUB(j)  (1280 + 64 * (j))
#define XB_XGEN(j)  (2304 + 64 * (j))
#define XB_TOP      3328
#define XB_TOPGEN   3392
#define XCD_BAR_WORDS 3456
#define XB_SPIN_CAP (1u << 18)
__device__ __forceinline__ unsigned xb_ld(unsigned* p)              { return __hip_atomic_load(p, __ATOMIC_RELAXED, __HIP_MEMORY_SCOPE_AGENT); }
__device__ __forceinline__ unsigned xb_add(unsigned* p, unsigned v) { return __hip_atomic_fetch_add(p, v, __ATOMIC_RELAXED, __HIP_MEMORY_SCOPE_AGENT); }
__device__ __forceinline__ unsigned xb_xcc_id() { return (unsigned)__builtin_amdgcn_s_getreg((3 << 11) | 20) & 0xFu; }
#define XB_SPIN(cond, bar) do { unsigned _sp = 0; while (cond) { __builtin_amdgcn_s_sleep(1); \
    if ((++_sp & 255u) == 0u) { if (xb_ld(&(bar)[XB_TMO])) break; if (_sp > XB_SPIN_CAP) { atomicAdd(&(bar)[XB_TMO], 1u); break; } } } } while (0)
struct XcdBarrier { unsigned* bar; unsigned x; volatile LAS unsigned* st; };
__device__ __forceinline__ XcdBarrier xcd_barrier_post(unsigned* bar, volatile LAS unsigned* st) {
    XcdBarrier b; b.bar = bar; b.x = xb_xcc_id(); b.st = st;
    if (threadIdx.x == 0) (void)xb_add(&bar[XB_XCNT(b.x)], 1u);
    return b;
}
__device__ __forceinline__ void xcd_barrier_complete(unsigned* bar, unsigned x, unsigned& nloc, unsigned& nx) {
    const unsigned G = gridDim.x * gridDim.y * gridDim.z;
    unsigned sum, cnt, mine, sp = 0u;
    for (;;) {
        sum = 0u; cnt = 0u; mine = 0u;
#pragma unroll
        for (unsigned j = 0; j < 16; ++j) { const unsigned c = xb_ld(&bar[XB_XCNT(j)]); sum += c; cnt += (c > 0u) ? 1u : 0u; mine = (j == x) ? c : mine; }
        if (sum == G) break;
        __builtin_amdgcn_s_sleep(1);
        if ((++sp & 255u) == 0u) { if (xb_ld(&bar[XB_TMO])) break; if (sp > XB_SPIN_CAP) { atomicAdd(&bar[XB_TMO], 1u); break; } }
    }
    nloc = mine > 0u ? mine : 1u; nx = cnt > 0u ? cnt : 1u;
}
__device__ __forceinline__ void xcd_barrier(const XcdBarrier& b) {
    asm volatile("s_waitcnt vmcnt(0)" ::: "memory");
    __syncthreads();
    if (threadIdx.x == 0) {
        unsigned* bar = b.bar;
        __builtin_amdgcn_s_waitcnt(0);
        unsigned nloc = b.st[0], nx = b.st[1];
        if (nloc == 0u) { xcd_barrier_complete(bar, b.x, nloc, nx); b.st[0] = nloc; b.st[1] = nx; }
        const unsigned old = xb_add(&bar[XB_XSUB(b.x)], 1u);
        const unsigned gen = old / nloc;
        if (old + 1u == (gen + 1u) * nloc) {
            __builtin_amdgcn_fence(__ATOMIC_RELEASE, "agent");
            asm volatile("s_waitcnt vmcnt(0)" ::: "memory");
            const unsigned og = xb_add(&bar[XB_TOP], 1u);
            const unsigned tg = og / nx;
            if (og + 1u == (tg + 1u) * nx) xb_add(&bar[XB_TOPGEN], 1u);
            else XB_SPIN(xb_ld(&bar[XB_TOPGEN]) == tg, bar);
            __builtin_amdgcn_fence(__ATOMIC_ACQUIRE, "agent");
            xb_add(&bar[XB_XGEN(b.x)], 1u);
            asm volatile("s_waitcnt vmcnt(0)" ::: "memory");
        } else {
            XB_SPIN(xb_ld(&bar[XB_XGEN(b.x)]) == gen, bar);
            __builtin_amdgcn_fence(__ATOMIC_ACQUIRE, "agent");
            asm volatile("s_waitcnt vmcnt(0)" ::: "memory");
        }
    }
    __syncthreads();
}

#define GIN(a_, i_) ((const GAS float*)(a_).in[i_])
struct Args { const float* in[20]; float* out; unsigned char* ws; int ph_lo, ph_hi; int shadow, pad; };
struct Frame {
    LAS unsigned char* lds; volatile LAS unsigned* MISC; unsigned* ctl;
    int tid, lane, wave, vcu, G;
    unsigned char* ws; GAS float* out;
};

__device__ __forceinline__ int p8(int l) { return (l & ~31) + 16 * ((l >> 2) & 1) + 4 * ((l >> 3) & 3) + (l & 3); }
__device__ __forceinline__ int phys_gu(int L) { const int isu = L >= DFF, hid = isu ? L - DFF : L, pn = hid >> 7, hh = hid & 127; return 256 * pn + 128 * isu + p8(hh); }
__device__ __forceinline__ int phys_in(int L) {
    const int reg = L >> 9, l = L & 511;
    const int preg = reg == 0 ? 0 : reg == 1 ? 2 : reg == 2 ? 3 : reg == 3 ? 1 : 4;
    if (reg <= 1) { const int head = l >> 6, d = l & 63, bj = d >> 5, i = d & 31; return 512 * preg + 256 * (head >> 2) + 128 * bj + 32 * (head & 3) + i; }
    return 512 * preg + p8(l);
}
enum PhysKind { PH_GU = 0, PH_P8 = 1, PH_IN = 2 };
template <int KIND> __device__ __forceinline__ int physmap(int L) { return KIND == PH_GU ? phys_gu(L) : KIND == PH_P8 ? p8(L) : phys_in(L); }

template <int KIND> __device__ __forceinline__ void p0_transpose_item(const GAS float* W, int K, int N, GAS h16* WT, const GAS float* kscale, LAS float* scr, int item, int lane) {
    const int nblk = N / 32, kb = item / nblk, nb = item % nblk, k0 = 64 * kb, n0 = 32 * nb;
    float wv[32];
#pragma unroll
    for (int i = 0; i < 32; ++i) { const int kk = 2 * i + (lane >> 5); wv[i] = W[(size_t)(k0 + kk) * N + n0 + (lane & 31)]; }
    if (kscale) {
#pragma unroll
        for (int i = 0; i < 32; ++i) wv[i] *= kscale[k0 + 2 * i + (lane >> 5)]; }
#pragma unroll
    for (int i = 0; i < 32; ++i) scr[(2 * i + (lane >> 5)) * 33 + (lane & 31)] = wv[i];
    LDS_WAIT(); asm volatile("" ::: "memory");
    const int c = lane & 7;
#pragma unroll
    for (int j = 0; j < 4; ++j) { const int n = (lane >> 3) + 8 * j; const LAS float* s = scr + (8 * c) * 33 + n;
        u32x4 o; o.x = pkh(s[0 * 33], s[1 * 33]); o.y = pkh(s[2 * 33], s[3 * 33]); o.z = pkh(s[4 * 33], s[5 * 33]); o.w = pkh(s[6 * 33], s[7 * 33]);
        *(GAS u32x4*)(WT + blk_off(physmap<KIND>(n0 + n), k0 + 8 * c, K / 64)) = o; }
    LDS_WAIT(); asm volatile("" ::: "memory");
}

__device__ __forceinline__ void p0_prologue(const Frame& F0, const Args& a) {
    Frame F = F0; F.tid = threadIdx.x; F.lane = F.tid & 63; F.wave = __builtin_amdgcn_readfirstlane(F.tid >> 6);
    const GAS float* c = GIN(a, 1); const GAS float* w_ada = GIN(a, 2);
    {
        LAS float* red = (LAS float*)F.lds;
        for (int item = F.vcu; item < 72 * 4; item += F.G) {
            const int cg = item % 72, kq = item / 72, hlf = F.lane >> 5, col = cg * 128 + (F.lane & 31) * 4;
            f32x4 acc[4] = {{0.f, 0.f, 0.f, 0.f}, {0.f, 0.f, 0.f, 0.f}, {0.f, 0.f, 0.f, 0.f}, {0.f, 0.f, 0.f, 0.f}};
            const int kbase = kq * 256 + F.wave * 32 + hlf;
#pragma unroll
            for (int i = 0; i < 16; ++i) { const int k = kbase + 2 * i; const f32x4 w4 = *(const GAS f32x4*)(w_ada + (size_t)k * (NMOD * D) + col);
#pragma unroll
                for (int b = 0; b < 4; ++b) { const float cv = c[b * D + k]; const float sv = cv / (1.f + __expf(-cv)); acc[b] += w4 * sv; } }
#pragma unroll
            for (int b = 0; b < 4; ++b)
#pragma unroll
                for (int j = 0; j < 4; ++j) acc[b][j] += __shfl_xor(acc[b][j], 32);
            if (hlf == 0) {
#pragma unroll
                for (int b = 0; b < 4; ++b) *(LAS f32x4*)(red + (F.wave * 4 + b) * 128 + (F.lane & 31) * 4) = acc[b];
            }
            __syncthreads();
            { const int b = F.tid >> 7, cc = F.tid & 127; float s = 0.f;
#pragma unroll
              for (int w = 0; w < 8; ++w) s += red[(w * 4 + b) * 128 + cc];
              ((GAS float*)(F.ws + WS_MODP))[(size_t)(kq * 4 + b) * (NMOD * D) + cg * 128 + cc] = s; }
            __syncthreads();
        }
    }
    LAS float* scr = (LAS float*)(F.lds + F.wave * 16384);
    const int gw = F.vcu * NWAVES + F.wave, NGW = F.G * NWAVES;
    constexpr int I_GU = (D / 64) * (NGU / 32), I_DN = (DFF / 64) * (D / 32), I_IN = (D / 64) * (INW / 32), I_OUT = (D / 64) * (D / 32);
    constexpr int NITEMS = 2 * I_GU + 2 * I_DN + I_IN + I_OUT;
    for (int it = gw; it < NITEMS; it += NGW) {
        int r = it;
        if (r < I_GU) { p0_transpose_item<PH_GU>(GIN(a, 5), D, NGU, (GAS h16*)(F.ws + WS_WGU1), nullptr, scr, r, F.lane); continue; } r -= I_GU;
        if (r < I_GU) { p0_transpose_item<PH_GU>(GIN(a, 17), D, NGU, (GAS h16*)(F.ws + WS_WGU2), nullptr, scr, r, F.lane); continue; } r -= I_GU;
        if (r < I_DN) { p0_transpose_item<PH_P8>(GIN(a, 6), DFF, D, (GAS h16*)(F.ws + WS_WD1), nullptr, scr, r, F.lane); continue; } r -= I_DN;
        if (r < I_DN) { p0_transpose_item<PH_P8>(GIN(a, 18), DFF, D, (GAS h16*)(F.ws + WS_WD2), nullptr, scr, r, F.lane); continue; } r -= I_DN;
        if (r < I_IN) { p0_transpose_item<PH_IN>(GIN(a, 8), D, INW, (GAS h16*)(F.ws + WS_WIN), nullptr, scr, r, F.lane); continue; } r -= I_IN;
        {
            const int kb = r / (D / 32); const GAS float* ks = (kb < 8) ? GIN(a, 13) : (GIN(a, 14) - 512);
            p0_transpose_item<PH_P8>(GIN(a, 15), D, D, (GAS h16*)(F.ws + WS_WOUT), ks, scr, r, F.lane); }
    }
    for (int pos = gw; pos < S; pos += NGW) {
        const int i = F.lane & 31;
        const float inv = (float)exp(-(double)i / 32.0 * 9.210340371976184);
        const float ang = (float)pos * inv;
        const double da = (double)ang;
        ((GAS float*)(F.ws + WS_ROPE))[(size_t)pos * 64 + F.lane] = (F.lane < 32) ? (float)cos(da) : (float)sin(da);
    }
    for (int e = gw * 64 + F.lane; e < NH * GC * GC; e += NGW * 64) { const int t = (e >> 7) & 127, s = e & 127; ((GAS h16*)(F.ws + WS_WS16))[e] = (s <= t) ? (h16)GIN(a, 11)[e] : (h16)0.f; }
}

__device__ __forceinline__ void p1_prep(const Frame& F0, const Args& a) {
    Frame F = F0; F.tid = threadIdx.x; F.lane = F.tid & 63; F.wave = __builtin_amdgcn_readfirstlane(F.tid >> 6);
    LAS float* modl = (LAS float*)F.lds;
    const GAS float* modp = (const GAS float*)(F.ws + WS_MODP); const GAS float* b_ada = GIN(a, 3);
    const size_t st = (size_t)4 * NMOD * D;
    for (int e = F.tid; e < 4 * 6 * D; e += NWAVES * 64) {
        const int b = e / (6 * D), sl = (e / D) % 6, k = e % D; const int mi = (sl < 3) ? 3 * sl : 3 * (sl - 3) + 1;
        const size_t o = (size_t)b * (NMOD * D) + mi * D + k;
        modl[e] = ((modp[o] + modp[o + st]) + (modp[o + 2 * st] + modp[o + 3 * st])) + b_ada[mi * D + k];
    }
    __syncthreads();
    if (F.vcu == 0) {
        GAS float* GT = (GAS float*)(F.ws + WS_GT); GAS float* GP = (GAS float*)(F.ws + WS_GP);
        for (int e = F.tid; e < 3 * 4 * D; e += NWAVES * 64) {
            const int j = e / (4 * D), b = (e / D) % 4, k = e % D; const int mi = 3 * j + 2;
            const size_t o = (size_t)b * (NMOD * D) + mi * D + k;
            GT[e] = ((modp[o] + modp[o + st]) + (modp[o + 2 * st] + modp[o + 3 * st])) + b_ada[mi * D + k];
            const GAS float* g = j == 0 ? GIN(a, 4) : j == 1 ? GIN(a, 7) : GIN(a, 16);
            GP[e] = g[k] * (1.f + modl[(b * 6 + 3 + j) * D + k]);
        }
    }
    const GAS float* x = GIN(a, 0); const GAS float* g1 = GIN(a, 4);
    GAS h16* XG = (GAS h16*)(F.ws + WS_HG); GAS float* R1 = (GAS float*)(F.ws + WS_R1);
    for (int chunk = F.vcu; chunk < M / 128; chunk += F.G) {
        const int b = chunk / (S / 128);
        f32x4 scl[2][2];
#pragma unroll
        for (int j = 0; j < 2; ++j)
#pragma unroll
            for (int h = 0; h < 2; ++h) { const int k = 8 * F.lane + 512 * j + 4 * h; const f32x4 gg = *(const GAS f32x4*)(g1 + k); const LAS float* sc = modl + (b * 6 + 3) * D + k;
                scl[j][h] = gg * ((f32x4){1.f + sc[0], 1.f + sc[1], 1.f + sc[2], 1.f + sc[3]}); }
        for (int rb = 0; rb < 16; rb += 4) {
            f32x4 v[4][2][2]; float q[4];
#pragma unroll
            for (int r4 = 0; r4 < 4; ++r4) { const GAS float* xr = x + (size_t)(chunk * 128 + F.wave * 16 + rb + r4) * D + 8 * F.lane;
#pragma unroll
                for (int j = 0; j < 2; ++j) { v[r4][j][0] = *(const GAS f32x4*)(xr + 512 * j); v[r4][j][1] = *(const GAS f32x4*)(xr + 512 * j + 4); } }
            asm volatile("" ::: "memory");
#pragma unroll
            for (int r4 = 0; r4 < 4; ++r4) { float t = 0.f;
#pragma unroll
                for (int j = 0; j < 2; ++j)
#pragma unroll
                    for (int h = 0; h < 2; ++h) t += (v[r4][j][h][0] * v[r4][j][h][0] + v[r4][j][h][1] * v[r4][j][h][1]) + (v[r4][j][h][2] * v[r4][j][h][2] + v[r4][j][h][3] * v[r4][j][h][3]);
                q[r4] = t; }
#pragma unroll
            for (int o = 1; o < 64; o <<= 1)
#pragma unroll
                for (int r4 = 0; r4 < 4; ++r4) q[r4] += __shfl_xor(q[r4], o);
#pragma unroll
            for (int r4 = 0; r4 < 4; ++r4) {
                const int row = chunk * 128 + F.wave * 16 + rb + r4;
                if (F.lane == 0) R1[row] = rsqrtf(q[r4] * (1.f / D) + EPS);
#pragma unroll
                for (int j = 0; j < 2; ++j) { const int k = 8 * F.lane + 512 * j; u32x4 w;
#pragma unroll
                    for (int h = 0; h < 2; ++h) { const f32x4 o = v[r4][j][h] * scl[j][h]; w[2 * h] = pkh(o[0], o[1]); w[2 * h + 1] = pkh(o[2], o[3]); }
                    *(GAS u32x4*)(XG + blk_off(row, k, D / 64)) = w; }
            }
        }
    }
    const int gw = F.vcu * NWAVES + F.wave, NGW = F.G * NWAVES;
    for (int it = gw; it < NGU + INW + NGU; it += NGW) {
        int n = it, j; const GAS h16* W; GAS float* B; int NN;
        if (n < NGU) { j = 0; W = (const GAS h16*)(F.ws + WS_WGU1); B = (GAS float*)(F.ws + WS_BIAS1); NN = NGU; }
        else if (n < NGU + INW) { n -= NGU; j = 1; W = (const GAS h16*)(F.ws + WS_WIN); B = (GAS float*)(F.ws + WS_BIAS2); NN = INW; }
        else { n -= NGU + INW; j = 2; W = (const GAS h16*)(F.ws + WS_WGU2); B = (GAS float*)(F.ws + WS_BIAS3); NN = NGU; }
        const h16x8 w0 = *(const GAS h16x8*)(W + blk_off(n, 16 * F.lane, D / 64)), w1 = *(const GAS h16x8*)(W + blk_off(n, 16 * F.lane + 8, D / 64));
        float s[4];
#pragma unroll
        for (int b = 0; b < 4; ++b) { const LAS float* sh = modl + (b * 6 + j) * D + 16 * F.lane; float t = 0.f;
#pragma unroll
            for (int e = 0; e < 8; ++e) t += sh[e] * (float)w0[e] + sh[8 + e] * (float)w1[e];
            s[b] = wave_sum(t); }
        if (F.lane == 0) { B[0 * NN + n] = s[0]; B[1 * NN + n] = s[1]; B[2 * NN + n] = s[2]; B[3 * NN + n] = s[3]; }
    }
    __syncthreads();
}

__device__ __forceinline__ void p_final(const Frame& F0, const Args& a) {
    Frame F = F0; F.tid = threadIdx.x; F.lane = F.tid & 63; F.wave = __builtin_amdgcn_readfirstlane(F.tid >> 6);
    const GAS h16* H = (const GAS h16*)(F.ws + WS_H); const GAS float* ssq = (const GAS float*)(F.ws + WS_SSQF); const GAS float* gf = GIN(a, 19);
    const int gw = F.vcu * NWAVES + F.wave, NGW = F.G * NWAVES;
    f32x4 g[2][2];
#pragma unroll
    for (int j = 0; j < 2; ++j)
#pragma unroll
        for (int h = 0; h < 2; ++h) g[j][h] = *(const GAS f32x4*)(gf + 8 * F.lane + 512 * j + 4 * h);
    for (int row = gw; row < M; row += NGW) {
        const float rs = rs16(ssq + (size_t)row * 16);
#pragma unroll
        for (int j = 0; j < 2; ++j) { const h16x8 hv = *(const GAS h16x8*)(H + (size_t)row * D + 8 * F.lane + 512 * j);
            f32x4 o0 = (f32x4){(float)hv[0], (float)hv[1], (float)hv[2], (float)hv[3]} * rs * g[j][0], o1 = (f32x4){(float)hv[4], (float)hv[5], (float)hv[6], (float)hv[7]} * rs * g[j][1];
            *(GAS f32x4*)(a.out + (size_t)row * D + 8 * F.lane + 512 * j) = o0; *(GAS f32x4*)(a.out + (size_t)row * D + 8 * F.lane + 512 * j + 4) = o1; }
    }
}


typedef float f32x16 __attribute__((ext_vector_type(16)));
typedef short v4i16_t __attribute__((ext_vector_type(4)));
__device__ __forceinline__ h16x4 tr16(const LAS unsigned char* p) { return __builtin_bit_cast(h16x4, __builtin_amdgcn_ds_read_tr16_b64_v4i16((LAS v4i16_t*)p)); }
__device__ __forceinline__ int vt_off(int t, int c8) { return t * 128 + (((c8 >> 2) ^ ((t >> 1) & 1)) << 6) + ((c8 & 3) << 4); }

__device__ __forceinline__ void gmlp_phase(const Frame& F0, const Args& a, int shadow) {
    const int tid = threadIdx.x, lane = tid & 63, wave = __builtin_amdgcn_readfirstlane(tid >> 6), r32 = lane & 31, hi = lane >> 5;
    GAS h16* proj = (GAS h16*)(F0.ws + WS_PROJ); const GAS h16* W16 = (const GAS h16*)(F0.ws + WS_WS16); GAS float* RG = (GAS float*)(F0.ws + WS_RG);
    const GAS float* ln_g = GIN(a, 9); const GAS float* ln_b = GIN(a, 10); const GAS float* b_s = GIN(a, 12);
    LAS unsigned char* lds = F0.lds;
    LAS float* rowsq = (LAS float*)(lds + MISC_OFF + 128);
    f32x4 g0 = *(const GAS f32x4*)(ln_g + 8 * lane), g1 = *(const GAS f32x4*)(ln_g + 8 * lane + 4), b0 = *(const GAS f32x4*)(ln_b + 8 * lane), b1 = *(const GAS f32x4*)(ln_b + 8 * lane + 4);
    for (int unit = F0.vcu; unit < M / GC; unit += F0.G) {
        const size_t row0 = (size_t)unit * GC;
        {
            h16x8 hv[16]; float sm[16], mu[16], rsd[16];
#pragma unroll
            for (int rr = 0; rr < 16; ++rr) hv[rr] = *(const GAS h16x8*)(proj + (row0 + wave * 16 + rr) * INW + PG + 8 * lane);
#pragma unroll
            for (int rr = 0; rr < 16; ++rr) { float t = 0.f;
#pragma unroll
                for (int e = 0; e < 8; ++e) t += (float)hv[rr][e];
                sm[rr] = t; }
#pragma unroll
            for (int o = 1; o < 64; o <<= 1)
#pragma unroll
                for (int rr = 0; rr < 16; ++rr) sm[rr] += __shfl_xor(sm[rr], o);
#pragma unroll
            for (int rr = 0; rr < 16; ++rr) { mu[rr] = sm[rr] * (1.f / 512.f); float q = 0.f;
#pragma unroll
                for (int e = 0; e < 8; ++e) { const float d = (float)hv[rr][e] - mu[rr]; q += d * d; }
                sm[rr] = q; }
#pragma unroll
            for (int o = 1; o < 64; o <<= 1)
#pragma unroll
                for (int rr = 0; rr < 16; ++rr) sm[rr] += __shfl_xor(sm[rr], o);
#pragma unroll
            for (int rr = 0; rr < 16; ++rr) { rsd[rr] = rsqrtf(sm[rr] * (1.f / 512.f) + EPS);
                const int t = wave * 16 + rr; float v[8];
#pragma unroll
                for (int e = 0; e < 8; ++e) v[e] = ((float)hv[rr][e] - mu[rr]) * rsd[rr];
                u32x4 w; w[0] = pkh(v[0] * g0[0] + b0[0], v[1] * g0[1] + b0[1]); w[1] = pkh(v[2] * g0[2] + b0[2], v[3] * g0[3] + b0[3]);
                w[2] = pkh(v[4] * g1[0] + b1[0], v[5] * g1[1] + b1[1]); w[3] = pkh(v[6] * g1[2] + b1[2], v[7] * g1[3] + b1[3]);
                *(LAS u32x4*)(lds + (lane >> 3) * 16384 + vt_off(t, lane & 7)) = w; }
        }
        __syncthreads();
        const GAS h16* Wh = W16 + (size_t)wave * GC * GC;
        const LAS unsigned char* vt = lds + wave * 16384;
        const int q4 = (lane & 15) >> 2, p4 = lane & 3, g1b = (lane >> 4) & 1;
        for (int tb = 0; tb < 4; ++tb) {
            f32x16 acc[2];
#pragma unroll
            for (int d0 = 0; d0 < 2; ++d0)
#pragma unroll
                for (int e = 0; e < 16; ++e) acc[d0][e] = 0.f;
            for (int ks = 0; ks <= 2 * tb + 1; ++ks) {
                const h16x8 af = *(const GAS h16x8*)(Wh + (size_t)(32 * tb + r32) * GC + 16 * ks + 8 * hi);
#pragma unroll
                for (int d0 = 0; d0 < 2; ++d0) {
                    const int srow = 16 * ks + 8 * hi + q4, c8 = 4 * d0 + 2 * g1b + (p4 >> 1);
                    const h16x4 lo = tr16(vt + vt_off(srow, c8) + (p4 & 1) * 8), hi4 = tr16(vt + vt_off(srow + 4, c8) + (p4 & 1) * 8);
                    const h16x8 bf = (h16x8){lo[0], lo[1], lo[2], lo[3], hi4[0], hi4[1], hi4[2], hi4[3]};
                    acc[d0] = __builtin_amdgcn_mfma_f32_32x32x16_f16(af, bf, acc[d0], 0, 0, 0);
                }
            }
            h16 uv0[16], uv1[16]; float bsv[16];
#pragma unroll
            for (int e = 0; e < 16; ++e) { const int t = 32 * tb + (e & 3) + 8 * (e >> 2) + 4 * hi; const GAS h16* up = proj + (row0 + t) * INW + PU + wave * 64 + r32; uv0[e] = up[0]; uv1[e] = up[32]; bsv[e] = b_s[wave * GC + t]; }
            asm volatile("" ::: "memory");
#pragma unroll
            for (int e = 0; e < 16; ++e) {
                const int t = 32 * tb + (e & 3) + 8 * (e >> 2) + 4 * hi;
                GAS h16* up = proj + (row0 + t) * INW + PU + wave * 64 + r32;
                const float o0 = (float)uv0[e] * (acc[0][e] + bsv[e]), o1 = (float)uv1[e] * (acc[1][e] + bsv[e]);
                up[0] = (h16)o0; up[32] = (h16)o1;
                float q = o0 * o0 + o1 * o1;
                q += __shfl_xor(q, 1); q += __shfl_xor(q, 2); q += __shfl_xor(q, 4); q += __shfl_xor(q, 8); q += __shfl_xor(q, 16);
                if (r32 == 0) rowsq[wave * 128 + t] = q;
            }
        }
        __syncthreads();
        if (tid < 128) { float s8 = 0.f;
#pragma unroll
            for (int w = 0; w < 8; ++w) s8 += rowsq[w * 128 + tid];
            RG[row0 + tid] = s8; }
        __syncthreads();
    }
}


constexpr size_t DO_PO = 0, DO_PML = 96 * MiB;
constexpr int CW_CNT = 8192;
constexpr int LISTCAP = 8192;
constexpr int AL_K = 0, AL_V = 32768, AL_STG = 65536, AL_WSF = 98304, AL_START = 102400;
__device__ __forceinline__ int k_off(int key, int c8) { return key * 128 + ((c8 ^ (key & 7)) << 4); }

__device__ __forceinline__ void moba_gate_phase(const Frame& F0, int shadow) {
    const int tid = threadIdx.x, lane = tid & 63;
    const GAS h16* proj = (const GAS h16*)(F0.ws + WS_PROJ); const GAS float* kmp = (const GAS float*)(F0.ws + WS_KMP);
    unsigned* cnt = F0.ctl + CW_CNT + (shadow ? 1024 : 0); GAS unsigned short* lists = (GAS unsigned short*)(F0.ws + (shadow ? WS_HG : WS_LISTS));
    LAS float* km = (LAS float*)F0.lds;
    for (int item = F0.vcu; item < NB * NH * (S / 512); item += F0.G) {
        const int span = item % (S / 512), bh = item / (S / 512), b = bh >> 3, h = bh & 7;
        __syncthreads();
        for (int e = tid; e < NBLK * 64; e += NWAVES * 64) { const int n = e >> 6, d = e & 63; const GAS float* kp = kmp + (size_t)((b * NBLK + n) * 2) * 512 + h * 64 + d; km[e] = kp[0] + kp[512]; }
        __syncthreads();
        const int sq = span * 512 + tid, own = __builtin_amdgcn_readfirstlane(sq >> 8);
        float q[64];
        { const GAS h16* qp = proj + (size_t)(b * S + sq) * INW + PQ + h * 64;
#pragma unroll
          for (int c = 0; c < 8; ++c) { const h16x8 v = *(const GAS h16x8*)(qp + 8 * c);
#pragma unroll
              for (int e = 0; e < 8; ++e) q[8 * c + e] = (float)v[e]; } }
        float v0 = -3e38f, v1 = -3e38f, v2 = -3e38f; int i0 = -1, i1 = -1, i2 = -1;
        for (int n = 0; n < own; ++n) {
            float g0 = 0.f, g1 = 0.f, g2 = 0.f, g3 = 0.f;
#pragma unroll
            for (int c = 0; c < 16; ++c) { const f32x4 kv = *(const LAS f32x4*)(km + n * 64 + 4 * c); g0 += q[4 * c] * kv[0]; g1 += q[4 * c + 1] * kv[1]; g2 += q[4 * c + 2] * kv[2]; g3 += q[4 * c + 3] * kv[3]; }
            const float g = (g0 + g1) + (g2 + g3);
            if (g > v0) { v2 = v1; i2 = i1; v1 = v0; i1 = i0; v0 = g; i0 = n; }
            else if (g > v1) { v2 = v1; i2 = i1; v1 = g; i1 = n; }
            else if (g > v2) { v2 = g; i2 = n; }
        }
        int mycnt = 0, pos0 = 0, pos1 = 0, pos2 = 0;
        const unsigned long long ltmask = (1ull << lane) - 1ull;
        for (int n = 0; n < own; ++n) {
            const bool sel = (i0 == n) || (i1 == n) || (i2 == n);
            const unsigned long long mask = __ballot(sel);
            const int before = __popcll(mask & ltmask);
            if (lane == n) mycnt = __popcll(mask);
            if (i0 == n) pos0 = before; if (i1 == n) pos1 = before; if (i2 == n) pos2 = before;
        }
        unsigned base = 0u;
        if (lane < own && mycnt > 0) base = atomicAdd(cnt + bh * NBLK + lane, (unsigned)mycnt);
        const unsigned bb0 = (unsigned)__shfl((int)base, i0 & 63), bb1 = (unsigned)__shfl((int)base, i1 & 63), bb2 = (unsigned)__shfl((int)base, i2 & 63);
        if (i0 >= 0) lists[(size_t)(bh * NBLK + i0) * LISTCAP + bb0 + pos0] = (unsigned short)(sq | (0 << 13));
        if (i1 >= 0) lists[(size_t)(bh * NBLK + i1) * LISTCAP + bb1 + pos1] = (unsigned short)(sq | (1 << 13));
        if (i2 >= 0) lists[(size_t)(bh * NBLK + i2) * LISTCAP + bb2 + pos2] = (unsigned short)(sq | (2 << 13));
    }
    __syncthreads();
}

template <bool CAUSAL>
__device__ __forceinline__ void attn_tile(const LAS unsigned char* ldsK, const LAS unsigned char* ldsV, const h16x8 (&qf)[4], int wave, int lane, f32x16 (&o)[2], float& m_out, float& l_out) {
    const int r32 = lane & 31, hi = lane >> 5;
    int kbase[4];
#pragma unroll
    for (int ks = 0; ks < 4; ++ks) kbase[ks] = r32 * 128 + (((2 * ks + hi) ^ (r32 & 7)) << 4);
    f32x16 sacc[8];
#pragma unroll
    for (int kb = 0; kb < 8; ++kb) {
        f32x16 acc;
#pragma unroll
        for (int e = 0; e < 16; ++e) acc[e] = 0.f;
#pragma unroll
        for (int ks = 0; ks < 4; ++ks) { const h16x8 kf = *(const LAS h16x8*)(ldsK + kbase[ks] + kb * 4096); acc = __builtin_amdgcn_mfma_f32_32x32x16_f16(kf, qf[ks], acc, 0, 0, 0); }
        if (CAUSAL) {
            const int lim = 32 * (wave - kb) + r32;
#pragma unroll
            for (int e = 0; e < 16; ++e) { const int key = (e & 3) + 8 * (e >> 2) + 4 * hi; if (key > lim) acc[e] = -1e30f; }
        }
        sacc[kb] = acc;
    }
    float m = -3e38f;
#pragma unroll
    for (int kb = 0; kb < 8; ++kb)
#pragma unroll
        for (int e = 0; e < 16; ++e) m = fmaxf(m, sacc[kb][e]);
    m = fmaxf(m, __shfl_xor(m, 32));
    float ls = 0.f;
#pragma unroll
    for (int kb = 0; kb < 8; ++kb)
#pragma unroll
        for (int e = 0; e < 16; ++e) { const float pv = __builtin_amdgcn_exp2f(sacc[kb][e] - m); sacc[kb][e] = pv; ls += pv; }
    ls += __shfl_xor(ls, 32);
#pragma unroll
    for (int d0 = 0; d0 < 2; ++d0)
#pragma unroll
        for (int e = 0; e < 16; ++e) o[d0][e] = 0.f;
    const int q4 = (lane & 15) >> 2, p4 = lane & 3, g1b = (lane >> 4) & 1;
    int vbase[2];
#pragma unroll
    for (int d0 = 0; d0 < 2; ++d0) vbase[d0] = (4 * hi + q4) * 128 + ((d0 ^ ((q4 >> 1) & 1)) << 6) + ((2 * g1b + (p4 >> 1)) << 4) + (p4 & 1) * 8;
#pragma unroll
    for (int kb = 0; kb < 8; ++kb) {
        if (!CAUSAL || kb <= wave) {
#pragma unroll
            for (int s2 = 0; s2 < 2; ++s2) {
                h16x8 pa;
#pragma unroll
                for (int j = 0; j < 8; ++j) pa[j] = (h16)sacc[kb][8 * s2 + j];
#pragma unroll
                for (int d0 = 0; d0 < 2; ++d0) {
                    const h16x4 lo = tr16(ldsV + vbase[d0] + kb * 4096 + s2 * 2048), hi4 = tr16(ldsV + vbase[d0] + kb * 4096 + s2 * 2048 + 1024);
                    const h16x8 bf = (h16x8){lo[0], lo[1], lo[2], lo[3], hi4[0], hi4[1], hi4[2], hi4[3]};
                    o[d0] = __builtin_amdgcn_mfma_f32_32x32x16_f16(pa, bf, o[d0], 0, 0, 0);
                }
            }
        }
    }
    m_out = m; l_out = ls;
}
__device__ __forceinline__ void attn_tile_causal(const LAS unsigned char* ldsK, const LAS unsigned char* ldsV, const h16x8 (&qf)[4], int wave, int lane, f32x16 (&o)[2], float& m_out, float& l_out) {
    const int r32 = lane & 31, hi = lane >> 5;
    int kbase[4];
#pragma unroll
    for (int ks = 0; ks < 4; ++ks) kbase[ks] = r32 * 128 + (((2 * ks + hi) ^ (r32 & 7)) << 4);
    const int q4 = (lane & 15) >> 2, p4 = lane & 3, g1b = (lane >> 4) & 1;
    int vbase[2];
#pragma unroll
    for (int d0 = 0; d0 < 2; ++d0) vbase[d0] = (4 * hi + q4) * 128 + ((d0 ^ ((q4 >> 1) & 1)) << 6) + ((2 * g1b + (p4 >> 1)) << 4) + (p4 & 1) * 8;
    float m = -3e38f;
    for (int kb = 0; kb <= wave; ++kb) {
        f32x16 acc;
#pragma unroll
        for (int e = 0; e < 16; ++e) acc[e] = 0.f;
#pragma unroll
        for (int ks = 0; ks < 4; ++ks) { const h16x8 kf = *(const LAS h16x8*)(ldsK + kbase[ks] + kb * 4096); acc = __builtin_amdgcn_mfma_f32_32x32x16_f16(kf, qf[ks], acc, 0, 0, 0); }
        const int lim = (kb == wave) ? r32 : 64;
#pragma unroll
        for (int e = 0; e < 16; ++e) { const int key = (e & 3) + 8 * (e >> 2) + 4 * hi; if (key <= lim) m = fmaxf(m, acc[e]); }
    }
    m = fmaxf(m, __shfl_xor(m, 32));
    float ls = 0.f;
#pragma unroll
    for (int d0 = 0; d0 < 2; ++d0)
#pragma unroll
        for (int e = 0; e < 16; ++e) o[d0][e] = 0.f;
    for (int kb = 0; kb <= wave; ++kb) {
        f32x16 acc;
#pragma unroll
        for (int e = 0; e < 16; ++e) acc[e] = 0.f;
#pragma unroll
        for (int ks = 0; ks < 4; ++ks) { const h16x8 kf = *(const LAS h16x8*)(ldsK + kbase[ks] + kb * 4096); acc = __builtin_amdgcn_mfma_f32_32x32x16_f16(kf, qf[ks], acc, 0, 0, 0); }
        const int lim = (kb == wave) ? r32 : 64;
#pragma unroll
        for (int e = 0; e < 16; ++e) { const int key = (e & 3) + 8 * (e >> 2) + 4 * hi; const float pv = (key <= lim) ? __builtin_amdgcn_exp2f(acc[e] - m) : 0.f; acc[e] = pv; ls += pv; }
#pragma unroll
        for (int s2 = 0; s2 < 2; ++s2) {
            h16x8 pa;
#pragma unroll
            for (int j = 0; j < 8; ++j) pa[j] = (h16)acc[8 * s2 + j];
#pragma unroll
            for (int d0 = 0; d0 < 2; ++d0) {
                const h16x4 lo = tr16(ldsV + vbase[d0] + kb * 4096 + s2 * 2048), hi4 = tr16(ldsV + vbase[d0] + kb * 4096 + s2 * 2048 + 1024);
                const h16x8 bf = (h16x8){lo[0], lo[1], lo[2], lo[3], hi4[0], hi4[1], hi4[2], hi4[3]};
                o[d0] = __builtin_amdgcn_mfma_f32_32x32x16_f16(pa, bf, o[d0], 0, 0, 0);
            }
        }
    }
    ls += __shfl_xor(ls, 32);
    m_out = m; l_out = ls;
}
__device__ __forceinline__ void load_kv_block(LAS unsigned char* lds, const GAS h16* proj, size_t row0, int h, int tid) {
#pragma unroll
    for (int i = 0; i < 4; ++i) { const int idx = tid + 512 * i, key = idx >> 3, c8 = idx & 7; const GAS h16* rp = proj + (row0 + key) * INW + h * 64 + 8 * c8;
        const u32x4 kv = *(const GAS u32x4*)(rp + PK), vv = *(const GAS u32x4*)(rp + PV);
        *(LAS u32x4*)(lds + AL_K + k_off(key, c8)) = kv; *(LAS u32x4*)(lds + AL_V + vt_off(key, c8)) = vv; }
}
struct KvRegs { u32x4 kv[4], vv[4]; };
__device__ __forceinline__ void kv_fetch(KvRegs& r, const GAS h16* proj, size_t row0, int h, int tid) {
#pragma unroll
    for (int i = 0; i < 4; ++i) { const int idx = tid + 512 * i, key = idx >> 3, c8 = idx & 7; const GAS h16* rp = proj + (row0 + key) * INW + h * 64 + 8 * c8;
        r.kv[i] = *(const GAS u32x4*)(rp + PK); r.vv[i] = *(const GAS u32x4*)(rp + PV); }
}
__device__ __forceinline__ void kv_commit(const KvRegs& r, LAS unsigned char* lds, int tid) {
#pragma unroll
    for (int i = 0; i < 4; ++i) { const int idx = tid + 512 * i, key = idx >> 3, c8 = idx & 7;
        *(LAS u32x4*)(lds + AL_K + k_off(key, c8)) = r.kv[i]; *(LAS u32x4*)(lds + AL_V + vt_off(key, c8)) = r.vv[i]; }
}
__device__ __forceinline__ void stage_o(LAS unsigned char* stg, LAS float* wsf, const f32x16 (&o)[2], float l, int lane) {
    const int r32 = lane & 31, hi = lane >> 5;
    if (hi == 0) wsf[r32] = 1.f / l;
    LDS_WAIT();
#pragma unroll
    for (int e = 0; e < 16; ++e) { const int qr = (e & 3) + 8 * (e >> 2) + 4 * hi; const float rl = wsf[qr];
        *(LAS h16*)(stg + qr * 128 + r32 * 2) = (h16)(o[0][e] * rl); *(LAS h16*)(stg + qr * 128 + 64 + r32 * 2) = (h16)(o[1][e] * rl); }
    LDS_WAIT();
}

__device__ __forceinline__ void moba_b_phase(const Frame& F0, GAS float* dout) {
    const int tid = threadIdx.x, lane = tid & 63, wave = __builtin_amdgcn_readfirstlane(tid >> 6), r32 = lane & 31, hi = lane >> 5;
    const GAS h16* proj = (const GAS h16*)(F0.ws + WS_PROJ); const unsigned* cnt = F0.ctl + CW_CNT; const GAS unsigned short* lists = (const GAS unsigned short*)(F0.ws + WS_LISTS);
    GAS h16* PO = (GAS h16*)((unsigned char*)dout + DO_PO); GAS float* PML = (GAS float*)((unsigned char*)dout + DO_PML);
    LAS unsigned char* lds = F0.lds;
    LAS int* start = (LAS int*)(lds + AL_START);
    LAS float* wsf = (LAS float*)(lds + AL_WSF + wave * 512); LAS int* wsi = (LAS int*)(lds + AL_WSF + wave * 512 + 256);
    LAS unsigned char* stg = lds + AL_STG + wave * 4096;
    {
        const unsigned c0 = cnt[2 * tid], c1 = cnt[2 * tid + 1];
        const int t0 = (int)((c0 + 255u) >> 8), t1 = (int)((c1 + 255u) >> 8);
        int v = t0 + t1, inc = v;
#pragma unroll
        for (int o = 1; o < 64; o <<= 1) { const int u = __shfl_up(inc, o); if (lane >= o) inc += u; }
        LAS int* wtot = (LAS int*)(lds + AL_WSF);
        __syncthreads();
        if (lane == 63) wtot[wave] = inc;
        __syncthreads();
        int pre = 0;
        for (int w = 0; w < wave; ++w) pre += wtot[w];
        const int ex = pre + inc - v;
        __syncthreads();
        start[2 * tid] = ex; start[2 * tid + 1] = ex + t0;
        if (tid == 511) start[1024] = ex + v;
        __syncthreads();
    }
    const int nitems = start[1024];
    for (int item = F0.vcu; item < nitems; item += F0.G) {
        int lo = 0, hi_ = 1024;
        while (hi_ - lo > 1) { const int mid = (lo + hi_) >> 1; if (start[mid] <= item) lo = mid; else hi_ = mid; }
        const int l = lo, chunk = item - start[l];
        const int bh = l >> 5, n = l & 31, b = bh >> 3, h = bh & 7;
        const int nq = (int)cnt[l] - chunk * 256;
        load_kv_block(lds, proj, (size_t)b * S + (size_t)n * MBLK, h, tid);
        const int qi = chunk * 256 + wave * 32 + r32;
        const bool valid = (wave * 32 + r32) < nq;
        const unsigned ent = lists[(size_t)l * LISTCAP + (valid ? qi : chunk * 256)];
        const int sq = ent & 8191, rank = ent >> 13;
        h16x8 qf[4];
        { const GAS h16* qp = proj + (size_t)(b * S + sq) * INW + PQ + h * 64 + 8 * hi;
#pragma unroll
          for (int ks = 0; ks < 4; ++ks) qf[ks] = *(const GAS h16x8*)(qp + 16 * ks); }
        __syncthreads();
        if (wave * 32 < nq) {
            f32x16 o[2]; float m, lsum;
            attn_tile<false>(lds + AL_K, lds + AL_V, qf, wave, lane, o, m, lsum);
            const int slot = ((b * NH + h) * 3 + rank) * S + sq;
            if (hi == 0) { wsi[r32] = valid ? slot : -1; if (valid) { PML[(size_t)slot * 2] = m; PML[(size_t)slot * 2 + 1] = lsum; } }
            stage_o(stg, wsf, o, lsum, lane);
#pragma unroll
            for (int i = 0; i < 4; ++i) { const int row = i * 8 + (lane >> 3), ch = lane & 7; const int sl = wsi[row];
                if (sl >= 0) *(GAS u32x4*)(PO + (size_t)sl * 64 + ch * 8) = *(const LAS u32x4*)(stg + row * 128 + ch * 16); }
        }
        __syncthreads();
    }
}

__device__ __forceinline__ void moba_c_phase(const Frame& F0, const GAS float* dout, int shadow) {
    const int tid = threadIdx.x, lane = tid & 63, wave = __builtin_amdgcn_readfirstlane(tid >> 6), r32 = lane & 31, hi = lane >> 5;
    GAS h16* proj = (GAS h16*)(F0.ws + WS_PROJ); GAS float* SSQA = (GAS float*)(F0.ws + WS_SSQA);
    const GAS h16* PO = (const GAS h16*)((const unsigned char*)dout + DO_PO); const GAS float* PML = (const GAS float*)((const unsigned char*)dout + DO_PML);
    LAS unsigned char* lds = F0.lds;
    LAS float* wsf = (LAS float*)(lds + AL_WSF + wave * 512);
    LAS unsigned char* stg = lds + AL_STG + wave * 4096;
    KvRegs kvr;
    if (F0.vcu < NB * NH * NBLK) { const int u0 = F0.vcu; kv_fetch(kvr, proj, (size_t)((u0 >> 5) >> 3) * S + (size_t)(u0 & 31) * MBLK, (u0 >> 5) & 7, tid); }
    for (int unit = F0.vcu; unit < NB * NH * NBLK; unit += F0.G) {
        const int qb = unit & 31, bh = unit >> 5, b = bh >> 3, h = bh & 7;
        const size_t row0 = (size_t)b * S + (size_t)qb * MBLK;
        kv_commit(kvr, lds, tid);
        { const int un = unit + F0.G; if (un < NB * NH * NBLK) kv_fetch(kvr, proj, (size_t)((un >> 5) >> 3) * S + (size_t)(un & 31) * MBLK, (un >> 5) & 7, tid); }
        h16x8 qf[4];
        { const GAS h16* qp = proj + (row0 + wave * 32 + r32) * INW + PQ + h * 64 + 8 * hi;
#pragma unroll
          for (int ks = 0; ks < 4; ++ks) qf[ks] = *(const GAS h16x8*)(qp + 16 * ks); }
        __syncthreads();
        f32x16 o[2]; float m, lsum;
        attn_tile_causal(lds + AL_K, lds + AL_V, qf, wave, lane, o, m, lsum);
        if (hi == 0) { wsf[32 + r32] = m; wsf[64 + r32] = lsum; }
        stage_o(stg, wsf, o, lsum, lane);
        const int nsel = qb < 3 ? qb : 3;
#pragma unroll
        for (int i0 = 0; i0 < 4; i0 += 2) {
            float mr[2][3], lr[2][3]; h16x8 pv[2][3];
#pragma unroll
            for (int ii = 0; ii < 2; ++ii) { const size_t grow = row0 + wave * 32 + (i0 + ii) * 8 + (lane >> 3);
#pragma unroll
                for (int r = 0; r < 3; ++r) { if (r < nsel) { const size_t sl = ((size_t)(b * NH + h) * 3 + r) * S + (grow - (size_t)b * S); mr[ii][r] = PML[sl * 2]; lr[ii][r] = PML[sl * 2 + 1]; pv[ii][r] = *(const GAS h16x8*)(PO + sl * 64 + (lane & 7) * 8); } } }
            asm volatile("" ::: "memory");
#pragma unroll
            for (int ii = 0; ii < 2; ++ii) {
                const int row = (i0 + ii) * 8 + (lane >> 3), ch = lane & 7;
                const size_t grow = row0 + wave * 32 + row;
                const float mo = wsf[32 + row], lo_ = wsf[64 + row];
                const h16x8 ov = *(const LAS h16x8*)(stg + row * 128 + ch * 16);
                float mmax = mo;
#pragma unroll
                for (int r = 0; r < 3; ++r) { if (r < nsel) mmax = fmaxf(mmax, mr[ii][r]); }
                float wo = lo_ * __builtin_amdgcn_exp2f(mo - mmax), L = wo;
                float acc[8];
#pragma unroll
                for (int e = 0; e < 8; ++e) acc[e] = wo * (float)ov[e];
#pragma unroll
                for (int r = 0; r < 3; ++r) { if (r < nsel) { const float wr_ = lr[ii][r] * __builtin_amdgcn_exp2f(mr[ii][r] - mmax); L += wr_;
#pragma unroll
                    for (int e = 0; e < 8; ++e) acc[e] += wr_ * (float)pv[ii][r][e]; } }
                const float rL = 1.f / L; float q = 0.f; u32x4 w;
#pragma unroll
                for (int e = 0; e < 8; ++e) { acc[e] *= rL; q += acc[e] * acc[e]; }
                w[0] = pkh(acc[0], acc[1]); w[1] = pkh(acc[2], acc[3]); w[2] = pkh(acc[4], acc[5]); w[3] = pkh(acc[6], acc[7]);
                if (shadow) *(GAS u32x4*)((GAS h16*)(F0.ws + WS_HG) + grow * 512 + h * 64 + ch * 8) = w;
                else *(GAS u32x4*)(proj + grow * INW + PQ + h * 64 + ch * 8) = w;
                q += __shfl_xor(q, 1); q += __shfl_xor(q, 2); q += __shfl_xor(q, 4);
                if (ch == 0) SSQA[grow * 8 + h] = q;
            }
        }
        __syncthreads();
    }
}


template <bool PART16, class Order> __device__ __forceinline__ void fill_rowscale(LAS float* tab, const Order& So, const GAS float* src, int maxu) {
    pg8::Unit uu;
    for (int i = 0; i < maxu && So.next(i, uu); ++i)
        if (threadIdx.x < 256) { const int row = uu.pm * 256 + (int)threadIdx.x; tab[i * 256 + threadIdx.x] = PART16 ? rs16(src + (size_t)row * 16) : src[row]; }
    __syncthreads();
}
constexpr int TAB_OFF = MISC_OFF + 128, TAB_MAXU = 15;
static_assert(TAB_OFF + TAB_MAXU * 1024 <= LDS_BYTES, "row-scale table");

enum Phase { PH_P0 = 0, PH_P1, PH_G1A, PH_G1B, PH_INPROJ, PH_MIX_A, PH_MIX_B, PH_MIX_C, PH_OUTPROJ, PH_G2A, PH_G2B, PH_FINAL, PH_COUNT };
__global__ void __launch_bounds__(NWAVES * 64, 2) mega_fwd(Args args) {
    extern __shared__ __attribute__((aligned(16))) unsigned char lds[];
    Frame F;
    F.lds = (LAS unsigned char*)lds; F.MISC = (volatile LAS unsigned*)(F.lds + MISC_OFF);
    F.tid = threadIdx.x; F.lane = F.tid & 63; F.wave = __builtin_amdgcn_readfirstlane(F.tid >> 6);
    F.G = gridDim.x; { const int bx = blockIdx.x; F.vcu = (F.G % 8 == 0) ? (bx % 8) * (F.G / 8) + bx / 8 : bx; }
    F.ws = args.ws; F.out = (GAS float*)args.out; F.ctl = (unsigned*)(args.ws + WS_CTL);
    for (int u = F.tid; u < (LDS_BYTES - LDSCTL_OFF) / 4; u += NWAVES * 64) ((LAS unsigned*)(F.lds + LDSCTL_OFF))[u] = 0u;
    __syncthreads();
    XcdBarrier bar; bar.bar = F.ctl + CW_BAR; bar.x = 0; bar.st = nullptr;
    const int lo = args.ph_lo, hi = args.ph_hi;
    if (hi - lo > 1) bar = xcd_barrier_post(F.ctl + CW_BAR, F.MISC + 8);
#ifndef MK_PHASE_MASK
#define MK_PHASE_MASK 0xFFFF
#endif
#define IN(k) (((MK_PHASE_MASK >> (k)) & 1) && lo <= (k) && (k) < hi)
#define SEAM(k) do { if (IN(k) && IN((k) + 1)) xcd_barrier(bar); } while (0)
#define PHASE_PTRS() unsigned char* ws = args.ws; asm volatile("" : "+s"(ws)); const GAS float* GT = (const GAS float*)(ws + WS_GT); const GAS float* GP = (const GAS float*)(ws + WS_GP); (void)GT; (void)GP; F.ws = ws
    if (IN(PH_P0)) { PHASE_PTRS(); p0_prologue(F, args); SEAM(PH_P0); }
    if (IN(PH_P1)) { PHASE_PTRS(); p1_prep(F, args); SEAM(PH_P1); }
    if (IN(PH_G1A)) {
        PHASE_PTRS();
        pg8::Gemm g{(const GAS h16*)(ws + WS_HG), (const GAS h16*)(ws + WS_WGU1), 0, NGU, D}; pg8::StaticOrder So; So.init(M, NGU, F.G, (int)blockIdx.x); const pg8::TableOrder To = pg8::make_table(So, (LAS int*)(F.lds + LDSCTL_OFF));
#if MK_SHADOW == 1
        if (args.ph_lo == PH_G1A && args.ph_hi == PH_G1A + 1 && args.shadow) { EpiNull En; pg8::gemm_phase<EpiNull, true, MK_GPROBE>(F.lds, g, So, En); return; }
#endif
        fill_rowscale<false>((LAS float*)(F.lds + TAB_OFF), To, (const GAS float*)(ws + WS_R1), TAB_MAXU);
        EpiSwiglu E{(GAS h16*)(ws + WS_ACT), (const LAS float*)(F.lds + TAB_OFF), (const GAS float*)(ws + WS_BIAS1)};
        pg8::gemm_phase<EpiSwiglu, true, 0, pg8::TableOrder>(F.lds, g, To, E); SEAM(PH_G1A);
    }
    if (IN(PH_G1B)) {
        PHASE_PTRS();
        pg8::Gemm g{(const GAS h16*)(ws + WS_ACT), (const GAS h16*)(ws + WS_WD1), 0, D, DFF, MK_STAG}; pg8::StaticOrder So; So.init(M, D, F.G, (int)blockIdx.x); const pg8::TableOrder To = pg8::make_table(So, (LAS int*)(F.lds + LDSCTL_OFF));
#if MK_SHADOW == 8
        if (args.ph_lo == PH_G1B && args.ph_hi == PH_G1B + 1 && args.shadow) {
#if MK_GPROBE == 0
            EpiNull En; pg8::gemm_phase<EpiNull, true>(F.lds, g, So, En);
#else
            EpiResid<true, false, true, MK_GPROBE> Ev{GIN(args, 0), (GAS h16*)(ws + WS_H), (GAS h16*)(ws + WS_HG), GT + 0 * 4 * D, GP + 1 * 4 * D, (GAS float*)(ws + WS_SSQ2), nullptr, 0.5f};
            pg8::gemm_phase<EpiResid<true, false, true, MK_GPROBE>, true>(F.lds, g, So, Ev);
#endif
            return; }
#endif
        EpiResid<true, false, true> E{GIN(args, 0), (GAS h16*)(ws + WS_H), (GAS h16*)(ws + WS_HG), GT + 0 * 4 * D, GP + 1 * 4 * D, (GAS float*)(ws + WS_SSQ2), nullptr, 0.5f};
        pg8::gemm_phase<EpiResid<true, false, true>, true, 0, pg8::TableOrder>(F.lds, g, To, E); SEAM(PH_G1B);
    }
    if (IN(PH_INPROJ)) {
        PHASE_PTRS();
        pg8::Gemm g{(const GAS h16*)(ws + WS_HG), (const GAS h16*)(ws + WS_WIN), 0, INW, D}; pg8::StaticOrder So; So.init(M, INW, F.G, (int)blockIdx.x); const pg8::TableOrder To = pg8::make_table(So, (LAS int*)(F.lds + LDSCTL_OFF));
        fill_rowscale<true>((LAS float*)(F.lds + TAB_OFF), To, (const GAS float*)(ws + WS_SSQ2), TAB_MAXU);
        EpiInproj E{(GAS h16*)(ws + WS_PROJ), (const LAS float*)(F.lds + TAB_OFF), (const GAS float*)(ws + WS_BIAS2), (const GAS float*)(ws + WS_ROPE), (GAS float*)(ws + WS_KMP)};
        pg8::gemm_phase<EpiInproj, true, 0, pg8::TableOrder>(F.lds, g, To, E); SEAM(PH_INPROJ);
    }
    if (IN(PH_MIX_A)) { PHASE_PTRS(); if (!(args.shadow & 2)) gmlp_phase(F, args, args.shadow & 1); if (!(args.shadow & 4)) moba_gate_phase(F, args.shadow & 1); SEAM(PH_MIX_A); }
    if (IN(PH_MIX_B)) { PHASE_PTRS(); moba_b_phase(F, (GAS float*)args.out); SEAM(PH_MIX_B); }
    if (IN(PH_MIX_C)) { PHASE_PTRS(); moba_c_phase(F, (const GAS float*)args.out, args.shadow & 1); SEAM(PH_MIX_C); }
    if (IN(PH_OUTPROJ)) {
        PHASE_PTRS();
        pg8::Gemm g{(const GAS h16*)(ws + WS_PROJ), (const GAS h16*)(ws + WS_WOUT), INW, D, D}; pg8::StaticOrder So; So.init(M, D, F.G, (int)blockIdx.x); const pg8::TableOrder To = pg8::make_table(So, (LAS int*)(F.lds + LDSCTL_OFF));
        const LAS float* sct = (const LAS float*)(F.lds + MISC_OFF + 128);
        {   LAS float* t = (LAS float*)(F.lds + MISC_OFF + 128); const GAS float* ssqa = (const GAS float*)(ws + WS_SSQA); const GAS float* ssqg = (const GAS float*)(ws + WS_RG);
            pg8::Unit uu;
            for (int i = 0; i < 4 && To.next(i, uu); ++i)
                if (F.tid < 256) { const int row = uu.pm * 256 + F.tid; const f32x4 a = *(const GAS f32x4*)(ssqa + (size_t)row * 8), bq = *(const GAS f32x4*)(ssqa + (size_t)row * 8 + 4);
                    const float ra = rsqrtf((((a[0] + a[1]) + (a[2] + a[3])) + ((bq[0] + bq[1]) + (bq[2] + bq[3]))) * (1.f / 512.f) + EPS), rg = rsqrtf(ssqg[row] * (1.f / 512.f) + EPS);
                    t[i * 512 + F.tid] = ra / rg; t[i * 512 + 256 + F.tid] = rg; }
            __syncthreads(); }
        EpiResid<false, true, true> E{nullptr, (GAS h16*)(ws + WS_H), (GAS h16*)(ws + WS_HG), GT + 1 * 4 * D, GP + 2 * 4 * D, (GAS float*)(ws + WS_SSQ3), sct, 1.0f};
        pg8::gemm_phase<EpiResid<false, true, true>, true, 0, pg8::TableOrder>(F.lds, g, To, E); SEAM(PH_OUTPROJ);
    }
    if (IN(PH_G2A)) {
        PHASE_PTRS();
        pg8::Gemm g{(const GAS h16*)(ws + WS_HG), (const GAS h16*)(ws + WS_WGU2), 0, NGU, D}; pg8::StaticOrder So; So.init(M, NGU, F.G, (int)blockIdx.x); const pg8::TableOrder To = pg8::make_table(So, (LAS int*)(F.lds + LDSCTL_OFF));
        fill_rowscale<true>((LAS float*)(F.lds + TAB_OFF), To, (const GAS float*)(ws + WS_SSQ3), TAB_MAXU);
        EpiSwiglu E{(GAS h16*)(ws + WS_ACT), (const LAS float*)(F.lds + TAB_OFF), (const GAS float*)(ws + WS_BIAS3)};
        pg8::gemm_phase<EpiSwiglu, true, 0, pg8::TableOrder>(F.lds, g, To, E); SEAM(PH_G2A);
    }
    if (IN(PH_G2B)) {
        PHASE_PTRS();
        pg8::Gemm g{(const GAS h16*)(ws + WS_ACT), (const GAS h16*)(ws + WS_WD2), 0, D, DFF}; pg8::StaticOrder So; So.init(M, D, F.G, (int)blockIdx.x); const pg8::TableOrder To = pg8::make_table(So, (LAS int*)(F.lds + LDSCTL_OFF));
#if MK_FUSE_FINAL
        EpiFinal E{(const GAS h16*)(ws + WS_H), GT + 2 * 4 * D, GIN(args, 19), (GAS float*)args.out, (unsigned*)(ws + WS_SSQF), F.ctl + CW_PAN, F.ctl + CW_TMO,
                   (LAS float*)(F.lds + MISC_OFF + 128), (LAS float*)(F.lds + MISC_OFF + 128 + 4096), 0.5f};
        pg8::gemm_phase<EpiFinal, true, 0, pg8::TableOrder>(F.lds, g, To, E);
#else
        EpiResid<false, false, false> E{nullptr, (GAS h16*)(ws + WS_H), nullptr, GT + 2 * 4 * D, nullptr, (GAS float*)(ws + WS_SSQF), nullptr, 0.5f};
        pg8::gemm_phase<EpiResid<false, false, false>, true, 0, pg8::TableOrder>(F.lds, g, To, E); SEAM(PH_G2B);
#endif
    }
#if !MK_FUSE_FINAL
    if (IN(PH_FINAL)) { PHASE_PTRS(); p_final(F, args); }
#endif
#undef IN
#undef SEAM
}

extern "C" void kernel_launch(void* const* d_in, const int* in_sizes, int n_in, void* d_out, int out_size, void* d_ws, size_t ws_size, hipStream_t stream) {
    static int grid = 0;
    if (grid == 0) {
        if (n_in != 20 || out_size != M * D || ws_size < WS_END) { fprintf(stderr, "kernel_launch: unexpected shapes (n_in %d out %d ws %zu)\n", n_in, out_size, ws_size); grid = -1; return; }
        int dev = 0, cus = 0, per_cu = 0;
        hipGetDevice(&dev); hipDeviceGetAttribute(&cus, hipDeviceAttributeMultiprocessorCount, dev);
        if (hipFuncSetAttribute((const void*)mega_fwd, hipFuncAttributeMaxDynamicSharedMemorySize, LDS_BYTES) != hipSuccess) { fprintf(stderr, "kernel_launch: hipFuncSetAttribute failed\n"); grid = -1; return; }
        hipOccupancyMaxActiveBlocksPerMultiprocessor(&per_cu, (const void*)mega_fwd, NWAVES * 64, LDS_BYTES);
        (void)hipGetLastError();
        if (per_cu < 1) { fprintf(stderr, "kernel_launch: occupancy query says %d blocks/CU; nothing launched\n", per_cu); grid = -1; return; }
        grid = cus;
    }
    if (grid < 0) return;
    hipMemsetAsync((char*)d_ws + WS_CTL, 0, CTL_ZERO_BYTES, stream);
    Args a{};
    for (int i = 0; i < 20; ++i) a.in[i] = (const float*)d_in[i];
    a.out = (float*)d_out; a.ws = (unsigned char*)d_ws;
    unsigned char* ws = (unsigned char*)d_ws;
    auto run = [&](int lo, int hi) {
#if MK_PER_PHASE
        for (int p = lo; p < hi; ++p) {
            if (MK_SHADOW == 2 && p == PH_MIX_A) { a.ph_lo = p; a.ph_hi = p + 1; a.shadow = 1 | 4; hipLaunchKernelGGL(mega_fwd, dim3(grid), dim3(NWAVES * 64), LDS_BYTES, stream, a); a.shadow = 0; }
            if (MK_SHADOW == 3 && p == PH_MIX_A) { a.ph_lo = p; a.ph_hi = p + 1; a.shadow = 1 | 2; hipLaunchKernelGGL(mega_fwd, dim3(grid), dim3(NWAVES * 64), LDS_BYTES, stream, a); a.shadow = 0; }
            if (MK_SHADOW == 4 && p == PH_MIX_C) { a.ph_lo = p; a.ph_hi = p + 1; a.shadow = 1; hipLaunchKernelGGL(mega_fwd, dim3(grid), dim3(NWAVES * 64), LDS_BYTES, stream, a); a.shadow = 0; }
            if (MK_SHADOW == 8 && p == PH_G1B) { a.ph_lo = p; a.ph_hi = p + 1; a.shadow = 1; hipLaunchKernelGGL(mega_fwd, dim3(grid), dim3(NWAVES * 64), LDS_BYTES, stream, a); a.shadow = 0; }
            if (MK_SHADOW == 1 && p == PH_G1A) { a.ph_lo = p; a.ph_hi = p + 1; a.shadow = 1; hipLaunchKernelGGL(mega_fwd, dim3(grid), dim3(NWAVES * 64), LDS_BYTES, stream, a); a.shadow = 0; }
            for (int rep = 0; rep < ((((MK_DUP_MASK) >> p) & 1) ? 2 : 1); ++rep) { a.ph_lo = p; a.ph_hi = p + 1; hipLaunchKernelGGL(mega_fwd, dim3(grid), dim3(NWAVES * 64), LDS_BYTES, stream, a); }
        }
#else
        a.ph_lo = lo; a.ph_hi = hi;
        void* kargs[] = {(void*)&a};
        hipError_t e = hipLaunchCooperativeKernel((const void*)mega_fwd, dim3(grid), dim3(NWAVES * 64), kargs, LDS_BYTES, stream);
        if (e != hipSuccess) fprintf(stderr, "kernel_launch: cooperative launch failed: %s (grid %d)\n", hipGetErrorString(e), grid);
#endif
    };
    run(PH_P0, PH_COUNT);
}
```

```cpp
#include <hip/hip_runtime.h>
#include <cstdio>
#include <cstdint>

#ifndef MK_DUP_MASK
#define MK_DUP_MASK 0
#endif
#ifndef MK_GPROBE
#define MK_GPROBE 0
#endif
#ifndef MK_SHADOW
#define MK_SHADOW 0
#endif
#ifndef MK_FUSE_FINAL
#define MK_FUSE_FINAL 1
#endif
#ifndef MK_STAG
#define MK_STAG 0
#endif
#ifndef MK_NT
#define MK_NT 0x0
#endif
#ifndef MK_PER_PHASE
#define MK_PER_PHASE 0
#endif

#define GAS __attribute__((address_space(1)))
#define LAS __attribute__((address_space(3)))
typedef _Float16 h16;
typedef _Float16 h16x8 __attribute__((ext_vector_type(8)));
typedef _Float16 h16x4 __attribute__((ext_vector_type(4)));
typedef _Float16 h16x2 __attribute__((ext_vector_type(2)));
typedef float f32x4 __attribute__((ext_vector_type(4)));
typedef float f32x2 __attribute__((ext_vector_type(2)));
typedef unsigned u32x4 __attribute__((ext_vector_type(4)));
typedef unsigned u32x2 __attribute__((ext_vector_type(2)));

constexpr int D = 1024, NB = 4, S = 8192, M = NB * S, DFF = 2816, NGU = 2 * DFF, NMOD = 9;
constexpr int AW = 512, HD = 64, NH = 8, INW = 2560, MBLK = 256, NBLK = S / MBLK, GC = 128;
constexpr float EPS = 1e-6f;
constexpr float C2 = 0.125f * 1.4426950408889634f;
constexpr int PQ = 0, PU = 512, PK = 1024, PV = 1536, PG = 2048;

constexpr size_t MiB = 1u << 20, KiB = 1u << 10;
constexpr size_t WS_CTL = 0, CTL_ZERO_BYTES = 1 * MiB;
constexpr size_t WS_MODP = 1 * MiB;
constexpr size_t WS_GT = 2 * MiB, WS_GP = WS_GT + 64 * KiB;
constexpr size_t WS_BIAS1 = WS_GT + 128 * KiB, WS_BIAS2 = WS_GT + 256 * KiB, WS_BIAS3 = WS_GT + 320 * KiB;
constexpr size_t WS_R1 = 3 * MiB, WS_RG = WS_R1 + 128 * KiB;
constexpr size_t WS_SSQA = 4 * MiB;
constexpr size_t WS_SSQ2 = 5 * MiB, WS_SSQ3 = 7 * MiB, WS_SSQF = 9 * MiB;
constexpr size_t WS_KMP = 11 * MiB;
constexpr size_t WS_ROPE = 12 * MiB;
constexpr size_t WS_WS16 = 14 * MiB;
constexpr size_t WS_WGU1 = 16 * MiB, WS_WD1 = 27 * MiB, WS_WIN = 33 * MiB, WS_WOUT = 38 * MiB, WS_WGU2 = 40 * MiB, WS_WD2 = 51 * MiB;
constexpr size_t WS_HG = 64 * MiB, WS_H = 128 * MiB, WS_ACT = 192 * MiB, WS_PROJ = WS_ACT;
constexpr size_t WS_LISTS = 368 * MiB, WS_END = 384 * MiB;
static_assert(WS_WD2 + (size_t)D * DFF * 2 <= WS_HG && WS_ACT + (size_t)M * DFF * 2 <= WS_LISTS, "ws map");
constexpr int CW_TMO = 0, CW_BAR = 4096;

constexpr int RING_BYTES = 131072, LDSCTL_OFF = RING_BYTES, MISC_OFF = LDSCTL_OFF + 320, LDS_BYTES = 147456;
constexpr int NWAVES = 8;

#define LDS_WAIT() asm volatile("s_waitcnt lgkmcnt(0)" ::: "memory")
#define VM_WAIT() asm volatile("s_waitcnt vmcnt(0)" ::: "memory")

__device__ __forceinline__ float wave_sum(float v) {
#pragma unroll
    for (int o = 1; o < 64; o <<= 1) v += __shfl_xor(v, o);
    return v;
}
template <int SEL, class T> __device__ __forceinline__ void st_stream(GAS T* p, const T& v) { if ((MK_NT >> SEL) & 1) __builtin_nontemporal_store(v, p); else *p = v; }
__device__ __forceinline__ unsigned pkh(float lo, float hi) { h16x2 v; v.x = (h16)lo; v.y = (h16)hi; return __builtin_bit_cast(unsigned, v); }
__device__ __forceinline__ float silu_fast(float x) { return x * __builtin_amdgcn_rcpf(1.f + __builtin_amdgcn_exp2f(-1.4426950408889634f * x)); }
__device__ __forceinline__ float gelu_fast(float x) {
    const float u2 = 1.5957691216057308f * (x + 0.044715f * x * x * x);
    return x * __builtin_amdgcn_rcpf(1.f + __builtin_amdgcn_exp2f(-1.4426950408889634f * u2));
}
__device__ __forceinline__ float rs16(const GAS float* p) {
    const f32x4 s0 = *(const GAS f32x4*)(p), s1 = *(const GAS f32x4*)(p + 4), s2 = *(const GAS f32x4*)(p + 8), s3 = *(const GAS f32x4*)(p + 12);
    const f32x4 st = (s0 + s1) + (s2 + s3);
    return rsqrtf(((st[0] + st[1]) + (st[2] + st[3])) * (1.f / D) + EPS);
}


__device__ __forceinline__ size_t blk_off(int row, int k, int nt) { return (((size_t)(row >> 8) * nt + (k >> 6)) * 256 + (row & 255)) * 64 + (k & 63); }

namespace pg8 {
constexpr int BM = 256, BK = 64, HALF = 128, HTB = HALF * BK * 2, STAGE_BYTES = 8 * HTB, NXCD = 8, WGM = 8;
__host__ __device__ __forceinline__ int lds_byte(int r, int c) { const int st = (r >> 4) * 2 + (c >> 5), rr = r & 15, cc = c & 31, ob = rr * 64 + cc * 2; return st * 1024 + (ob ^ (((ob >> 9) & 1) << 5)); }
__host__ __device__ __forceinline__ void stage_rc(int b, int& R, int& C) { const int st = b / 1024, sb = b % 1024, swz = sb ^ (((sb >> 9) & 1) << 5); R = (st >> 1) * 16 + swz / 64; C = (st & 1) * 32 + (swz % 64) / 2; }
struct Unit { int pm, pn; };
struct Gemm { const GAS h16* A; const GAS h16* Bt; int lda, N, K; unsigned stag = 0; };
struct StaticOrder {
    int nM, nN, nwg, G, c;
    __device__ __forceinline__ void init(int M_, int N, int G_, int c_) { nM = M_ / BM; nN = N / BM; nwg = nM * nN; G = G_; c = c_; }
    __device__ __forceinline__ bool next(int i, Unit& u) const {
        const long L = (long)i * G + c; if (L >= nwg) return false;
        int wgid = (int)L; { const int q = nwg / NXCD, r = nwg % NXCD, xcd = wgid % NXCD, off = wgid / NXCD; wgid = (xcd < r ? xcd * (q + 1) : r * (q + 1) + (xcd - r) * q) + off; }
        const int nig = WGM * nN, gid = wgid / nig, fm = gid * WGM, gsz = (nM - fm) < WGM ? (nM - fm) : WGM;
        u.pm = fm + ((wgid % nig) % gsz); u.pn = (wgid % nig) / gsz; return true;
    }
};
struct TableOrder {
    const LAS int* tab; int n;
    __device__ __forceinline__ bool next(int i, Unit& u) const { if (i >= n) return false; u.pm = tab[2 * i]; u.pn = tab[2 * i + 1]; return true; }
};
__device__ __forceinline__ TableOrder make_table(const StaticOrder& So, LAS int* tab) {
    if (threadIdx.x < 16) { Unit u; u.pm = -1; u.pn = 0; const bool ok = So.next((int)threadIdx.x, u); tab[2 * threadIdx.x] = ok ? u.pm : -1; tab[2 * threadIdx.x + 1] = u.pn; }
    __syncthreads();
    int n = 0;
    while (n < 16 && tab[2 * n] >= 0) ++n;
    TableOrder T; T.tab = tab; T.n = __builtin_amdgcn_readfirstlane(n); return T;
}
template <class Epi, bool ALIGN_EPI, int PROBE = 0, class Order = StaticOrder>
__device__ __forceinline__ void gemm_phase(LAS unsigned char* lds, const Gemm g, const Order& S, const Epi& E) {
    const int tid = threadIdx.x, wid = __builtin_amdgcn_readfirstlane(tid >> 6), lane = tid & 63, wr = wid >> 2, wc = wid & 3, fr = lane & 15, fq = lane >> 4;
    const int K = g.K, nt = K / BK;
    unsigned voffA[2], voffB[2];
    const bool ablk = (g.lda == 0);
#pragma unroll
    for (int i = 0; i < 2; ++i) { int R, C; stage_rc(tid * 16 + i * 8192, R, C); voffA[i] = (unsigned)(R * (ablk ? BK : g.lda) + C) * 2u; voffB[i] = (unsigned)(R * BK + C) * 2u; }
    const size_t kstepB = (size_t)BM * BK * 2, kstepA = ablk ? kstepB : (size_t)(BK * 2);
    const size_t hstepB = (size_t)HALF * BK * 2, hstepA = ablk ? hstepB : (size_t)HALF * g.lda * 2;
    const size_t tstepB = (size_t)nt * kstepB, tstepA = ablk ? tstepB : 2 * hstepA;
    const unsigned ldsw = (unsigned)wid * 1024u;
    const int aoff = lds_byte(wr * 64 + fr, fq * 8), boff = lds_byte(wc * 32 + fr, fq * 8);
#define PG8_SA(b, h) (((b) * 2 + (h)) * HTB)
#define PG8_SB(b, h) ((4 + (b) * 2 + (h)) * HTB)
#define PG8_STAGE(bufoff, gbase, voff) do { if (PROBE != 2) _Pragma("unroll") for (int _i = 0; _i < 2; ++_i) \
        __builtin_amdgcn_global_load_lds((const unsigned*)((const char*)(gbase) + (voff)[_i]), (LAS unsigned*)(lds + (bufoff) + ldsw + _i * 8192), 16, 0, 0); } while (0)
#define PG8_LDA(dst, b, h) do { _Pragma("unroll") for (int m = 0; m < 4; ++m) _Pragma("unroll") for (int k = 0; k < 2; ++k) dst[m][k] = *(const LAS h16x8*)(lds + PG8_SA(b, h) + aoff + m * 2048 + k * 1024); } while (0)
#define PG8_LDB(dst, b, h) do { _Pragma("unroll") for (int n = 0; n < 2; ++n) _Pragma("unroll") for (int k = 0; k < 2; ++k) dst[n][k] = *(const LAS h16x8*)(lds + PG8_SB(b, h) + boff + n * 2048 + k * 1024); } while (0)
#define PG8_MMA(ai, bj, At, Bt) do { if (PROBE == 1 && (bj) == 1) break; __builtin_amdgcn_s_setprio(1); _Pragma("unroll") for (int m = 0; m < 4; ++m) _Pragma("unroll") for (int n = 0; n < 2; ++n) _Pragma("unroll") for (int k = 0; k < 2; ++k) \
        acc[ai][bj][m][n] = __builtin_amdgcn_mfma_f32_16x16x32_f16(Bt[n][k], At[m][k], acc[ai][bj][m][n], 0, 0, 0); __builtin_amdgcn_s_setprio(0); } while (0)
#define PG8_WAIT_V(n) asm volatile("s_waitcnt vmcnt(" #n ")" ::: "memory")
#define PG8_WAIT_L(n) asm volatile("s_waitcnt lgkmcnt(" #n ")" ::: "memory")
#define PG8_BAR __builtin_amdgcn_s_barrier()
#define PG8_SCHED __builtin_amdgcn_sched_barrier(0)
    Unit cur, nxt; int ui = 0;
    if (!S.next(0, cur)) return;
    if (g.stag) { const unsigned st = (unsigned)(cur.pm & 7); if (st) { const unsigned long long t0 = __builtin_amdgcn_s_memrealtime(), dl = (unsigned long long)st * g.stag; while (__builtin_amdgcn_s_memrealtime() - t0 < dl) __builtin_amdgcn_s_sleep(4); } }
    f32x4 acc[2][2][4][2];
#pragma unroll
    for (int a = 0; a < 2; ++a)
#pragma unroll
        for (int b = 0; b < 2; ++b)
#pragma unroll
            for (int m = 0; m < 4; ++m)
#pragma unroll
                for (int n = 0; n < 2; ++n) acc[a][b][m][n] = (f32x4){0.f, 0.f, 0.f, 0.f};
    h16x8 At[4][2], B0[2][2], B1[2][2];
    const char* cA = (const char*)g.A + (size_t)cur.pm * tstepA; const char* cB = (const char*)g.Bt + (size_t)cur.pn * tstepB;
    PG8_STAGE(PG8_SB(0, 0), cB, voffB); PG8_STAGE(PG8_SB(0, 1), cB + hstepB, voffB); PG8_STAGE(PG8_SA(0, 0), cA, voffA); PG8_STAGE(PG8_SA(0, 1), cA + hstepA, voffA);
    if (wr == 1) PG8_BAR;
    PG8_WAIT_V(2); PG8_BAR;
    PG8_STAGE(PG8_SB(1, 0), cB + kstepB, voffB); PG8_STAGE(PG8_SA(1, 0), cA + kstepA, voffA); PG8_STAGE(PG8_SB(1, 1), cB + hstepB + kstepB, voffB);
    PG8_WAIT_V(6); PG8_BAR;
    for (;;) {
        const bool has_next = S.next(ui + 1, nxt);
        const char* nA = has_next ? (const char*)g.A + (size_t)nxt.pm * tstepA : cA; const char* nB = has_next ? (const char*)g.Bt + (size_t)nxt.pn * tstepB : cB;
        for (int t = 0; t < nt; t += 2) {
            const bool last = (t == nt - 2);
            const char* a1 = cA + (size_t)(t + 1) * kstepA;
            const char* a2 = last ? nA : cA + (size_t)(t + 2) * kstepA; const char* b2 = last ? nB : cB + (size_t)(t + 2) * kstepB;
            const char* a3 = a2 + kstepA; const char* b3 = b2 + kstepB;
            if constexpr (Epi::MID) { if (t == nt / 2) E.mid(acc, cur, ui, wr, wc, fr, fq); }
            PG8_LDB(B0, 0, 0); PG8_LDB(B1, 0, 1); PG8_SCHED; PG8_LDA(At, 0, 0); PG8_STAGE(PG8_SA(1, 1), a1 + hstepA, voffA);
            PG8_WAIT_V(8); PG8_WAIT_L(0); PG8_BAR; PG8_MMA(0, 0, At, B0); PG8_MMA(0, 1, At, B1); PG8_BAR; PG8_SCHED;
            PG8_LDA(At, 0, 1); PG8_STAGE(PG8_SB(0, 0), b2, voffB); PG8_STAGE(PG8_SB(0, 1), b2 + hstepB, voffB); PG8_STAGE(PG8_SA(0, 0), a2, voffA);
            PG8_WAIT_V(8); PG8_WAIT_L(0); PG8_BAR; PG8_MMA(1, 0, At, B0); PG8_MMA(1, 1, At, B1); PG8_BAR; PG8_SCHED;
            PG8_LDB(B0, 1, 0); PG8_LDB(B1, 1, 1); PG8_SCHED; PG8_LDA(At, 1, 0); PG8_STAGE(PG8_SA(0, 1), a2 + hstepA, voffA);
            PG8_WAIT_V(8); PG8_WAIT_L(0); PG8_BAR; PG8_MMA(0, 0, At, B0); PG8_MMA(0, 1, At, B1); PG8_BAR; PG8_SCHED;
            PG8_LDA(At, 1, 1); PG8_STAGE(PG8_SB(1, 0), b3, voffB); PG8_STAGE(PG8_SB(1, 1), b3 + hstepB, voffB); PG8_STAGE(PG8_SA(1, 0), a3, voffA);
            PG8_WAIT_V(8); PG8_WAIT_L(0); PG8_BAR; PG8_MMA(1, 0, At, B0); PG8_MMA(1, 1, At, B1); PG8_BAR; PG8_SCHED;
        }
        if constexpr (ALIGN_EPI) { if (wr == 0) PG8_BAR; }
        E(acc, cur, ui, wr, wc, fr, fq);
        if (!has_next) break;
#pragma unroll
        for (int a = 0; a < 2; ++a)
#pragma unroll
            for (int b = 0; b < 2; ++b)
#pragma unroll
                for (int m = 0; m < 4; ++m)
#pragma unroll
                    for (int n = 0; n < 2; ++n) acc[a][b][m][n] = (f32x4){0.f, 0.f, 0.f, 0.f};
        cur = nxt; cA = nA; cB = nB; ++ui;
        if constexpr (ALIGN_EPI) { if (wr == 1) PG8_BAR; }
    }
    PG8_WAIT_V(0);
    if constexpr (!ALIGN_EPI) { if (wr == 0) PG8_BAR; }
    PG8_BAR;
#undef PG8_SA
#undef PG8_SB
#undef PG8_STAGE
#undef PG8_LDA
#undef PG8_LDB
#undef PG8_MMA
#undef PG8_WAIT_V
#undef PG8_WAIT_L
#undef PG8_BAR
#undef PG8_SCHED
}
}

typedef const f32x4 (&AccRef)[2][2][4][2];
struct EpiSwiglu {
    static constexpr bool MID = false;
    GAS h16* act; const LAS float* rtab; const GAS float* bias;
    __device__ __forceinline__ void mid(f32x4 (&)[2][2][4][2], const pg8::Unit&, int, int, int, int, int) const {}
    __device__ __forceinline__ void operator()(AccRef acc, const pg8::Unit& u, int ui, int wr, int wc, int fr, int fq) const {
        const int b = u.pm >> 5, row0 = u.pm * 256 + wr * 64 + fr;
        const GAS float* bp = bias + b * NGU + u.pn * 256 + wc * 32 + 4 * fq;
        f32x4 bv[2][2];
#pragma unroll
        for (int bj = 0; bj < 2; ++bj)
#pragma unroll
            for (int n = 0; n < 2; ++n) bv[bj][n] = *(const GAS f32x4*)(bp + bj * 128 + n * 16);
        const LAS float* rt = rtab + ui * 256 + wr * 64 + fr;
        const int hid0 = u.pn * 128 + wc * 32 + fq * 8;
#pragma unroll
        for (int ai = 0; ai < 2; ++ai)
#pragma unroll
            for (int m = 0; m < 4; ++m) {
                const int ro = ai * 128 + m * 16; const float rs = rt[ro];
                u32x4 w;
#pragma unroll
                for (int n = 0; n < 2; ++n) {
                    const f32x4 gv = acc[ai][0][m][n] * rs + bv[0][n], uv = acc[ai][1][m][n] * rs + bv[1][n];
                    const float a0 = silu_fast(gv[0]) * uv[0], a1 = silu_fast(gv[1]) * uv[1], a2 = silu_fast(gv[2]) * uv[2], a3 = silu_fast(gv[3]) * uv[3];
                    w[2 * n] = pkh(a0, a1); w[2 * n + 1] = pkh(a2, a3);
                }
                st_stream<3>((GAS u32x4*)(act + blk_off(row0 + ro, hid0, DFF / 64)), w);
            }
    }
};
struct EpiNull {
    static constexpr bool MID = false;
    __device__ __forceinline__ void mid(f32x4 (&)[2][2][4][2], const pg8::Unit&, int, int, int, int, int) const {}
    __device__ __forceinline__ void operator()(AccRef acc, const pg8::Unit& u, int ui, int wr, int wc, int fr, int fq) const {
#pragma unroll
        for (int ai = 0; ai < 2; ++ai)
#pragma unroll
            for (int bj = 0; bj < 2; ++bj)
#pragma unroll
                for (int m = 0; m < 4; ++m)
#pragma unroll
                    for (int n = 0; n < 2; ++n) asm volatile("" :: "v"(acc[ai][bj][m][n]));
    }
};
template <bool RES_F32, bool TWOSCALE, bool WRITE_HG, int PVAR = 0> struct EpiResid {
    static constexpr bool MID = TWOSCALE;
    const GAS float* xres; GAS h16* H; GAS h16* HG; const GAS float* cs; const GAS float* gp; GAS float* ssq; const LAS float* sct; float cmul;
    __device__ __forceinline__ void mid(f32x4 (&acc)[2][2][4][2], const pg8::Unit& u, int ui, int wr, int wc, int fr, int fq) const {
        if constexpr (TWOSCALE) {
            const LAS float* t = sct + ui * 512 + wr * 64 + fr;
#pragma unroll
            for (int ai = 0; ai < 2; ++ai)
#pragma unroll
                for (int m = 0; m < 4; ++m) { const float f = t[ai * 128 + m * 16];
#pragma unroll
                    for (int bj = 0; bj < 2; ++bj)
#pragma unroll
                        for (int n = 0; n < 2; ++n) acc[ai][bj][m][n] *= f; }
        }
    }
    __device__ __forceinline__ void operator()(AccRef acc, const pg8::Unit& u, int ui, int wr, int wc, int fr, int fq) const {
        const int b = u.pm >> 5, row0 = u.pm * 256 + wr * 64 + fr, col0 = u.pn * 256 + wc * 32 + 8 * fq;
        f32x4 csv[2][2], gpv[2][2];
#pragma unroll
        for (int bj = 0; bj < 2; ++bj)
#pragma unroll
            for (int n = 0; n < 2; ++n) { csv[bj][n] = *(const GAS f32x4*)(cs + b * D + col0 + bj * 128 + 4 * n) * cmul; if constexpr (WRITE_HG) gpv[bj][n] = *(const GAS f32x4*)(gp + b * D + col0 + bj * 128 + 4 * n); }
        constexpr int MB_ = RES_F32 ? 2 : 4;
#pragma unroll
        for (int ai = 0; ai < 2; ++ai)
#pragma unroll
        for (int m0 = 0; m0 < 4; m0 += MB_) {
            f32x4 rf[4][2][2]; h16x8 rh[4][2];
#pragma unroll
            for (int m = m0; m < m0 + MB_; ++m)
#pragma unroll
                for (int bj = 0; bj < 2; ++bj) { const size_t off = (size_t)(row0 + ai * 128 + m * 16) * D + col0 + bj * 128;
                    if constexpr (PVAR == 2 || PVAR == 6 || PVAR == 7) { rf[m][bj][0] = (f32x4){0.f, 0.f, 0.f, 0.f}; rf[m][bj][1] = rf[m][bj][0]; rh[m][bj] = (h16x8){0, 0, 0, 0, 0, 0, 0, 0}; }
                    else if constexpr (PVAR == 3) { const h16x8 t = *(const GAS h16x8*)(HG + blk_off(row0 + ai * 128 + m * 16, col0 + bj * 128, D / 64)); rf[m][bj][0] = (f32x4){(float)t[0], (float)t[1], (float)t[2], (float)t[3]}; rf[m][bj][1] = (f32x4){(float)t[4], (float)t[5], (float)t[6], (float)t[7]}; }
                    else if constexpr (RES_F32) { rf[m][bj][0] = *(const GAS f32x4*)(xres + off); rf[m][bj][1] = *(const GAS f32x4*)(xres + off + 4); }
                    else rh[m][bj] = *(const GAS h16x8*)(H + off); }
            asm volatile("" ::: "memory");
#pragma unroll
            for (int m = m0; m < m0 + MB_; ++m) {
                const int row = row0 + ai * 128 + m * 16; const size_t off = (size_t)row * D + col0;
                float rsc = 1.f; if constexpr (TWOSCALE) rsc = sct[ui * 512 + 256 + wr * 64 + fr + ai * 128 + m * 16];
                float q = 0.f;
#pragma unroll
                for (int bj = 0; bj < 2; ++bj) {
                    f32x4 r0, r1;
                    if constexpr (RES_F32) { r0 = rf[m][bj][0]; r1 = rf[m][bj][1]; }
                    else { const h16x8 hv = rh[m][bj]; r0 = (f32x4){(float)hv[0], (float)hv[1], (float)hv[2], (float)hv[3]}; r1 = (f32x4){(float)hv[4], (float)hv[5], (float)hv[6], (float)hv[7]}; }
                    const f32x4 v0 = r0 + csv[bj][0] * (acc[ai][bj][m][0] * rsc), v1 = r1 + csv[bj][1] * (acc[ai][bj][m][1] * rsc);
                    q += ((v0[0] * v0[0] + v0[1] * v0[1]) + (v0[2] * v0[2] + v0[3] * v0[3])) + ((v1[0] * v1[0] + v1[1] * v1[1]) + (v1[2] * v1[2] + v1[3] * v1[3]));
                    u32x4 w; w[0] = pkh(v0[0], v0[1]); w[1] = pkh(v0[2], v0[3]); w[2] = pkh(v1[0], v1[1]); w[3] = pkh(v1[2], v1[3]);
                    const int colp = u.pn * 256 + wc * 64 + 16 * fq + 8 * bj;
                    if constexpr (PVAR == 1) asm volatile("" :: "v"(w)); else if constexpr (PVAR == 4) *(GAS u32x4*)(H + blk_off(row, col0 + bj * 128, D / 64)) = w;
                    else if constexpr (PVAR == 5) *(GAS u32x4*)(H + (size_t)row * D + colp) = w; else if constexpr (PVAR == 7) __builtin_nontemporal_store(w, (GAS u32x4*)(H + off + bj * 128)); else st_stream<1>((GAS u32x4*)(H + off + bj * 128), w);
                    if constexpr (WRITE_HG) { const f32x4 g0 = v0 * gpv[bj][0], g1 = v1 * gpv[bj][1];
                        u32x4 wg; wg[0] = pkh(g0[0], g0[1]); wg[1] = pkh(g0[2], g0[3]); wg[2] = pkh(g1[0], g1[1]); wg[3] = pkh(g1[2], g1[3]);
                        if constexpr (PVAR == 1 || PVAR == 6) asm volatile("" :: "v"(wg)); else if constexpr (PVAR == 7) __builtin_nontemporal_store(wg, (GAS u32x4*)(HG + blk_off(row, col0 + bj * 128, D / 64))); else if constexpr (PVAR == 5) *(GAS u32x4*)(HG + blk_off(row, colp, D / 64)) = wg; else st_stream<2>((GAS u32x4*)(HG + blk_off(row, col0 + bj * 128, D / 64)), wg); }
                }
                q += __shfl_xor(q, 16); q += __shfl_xor(q, 32);
                if (fq == 0) { if constexpr (PVAR == 1) asm volatile("" :: "v"(q)); else ssq[(size_t)row * 16 + u.pn * 4 + wc] = q; }
            }
        }
    }
};
constexpr int CW_PAN = 16384;
struct EpiFinal {
    static constexpr bool MID = false;
    const GAS h16* H; const GAS float* cs; const GAS float* gfin; GAS float* out; unsigned* xs; unsigned* cnt; unsigned* tmo; LAS float* P; LAS float* Sx; float cmul;
    __device__ __forceinline__ void mid(f32x4 (&)[2][2][4][2], const pg8::Unit&, int, int, int, int, int) const {}
    __device__ __forceinline__ void operator()(f32x4 (&acc)[2][2][4][2], const pg8::Unit& u, int ui, int wr, int wc, int fr, int fq) const {
        const int b = u.pm >> 5, row0 = u.pm * 256 + wr * 64 + fr, col0 = u.pn * 256 + wc * 32 + 8 * fq;
        const int tid = threadIdx.x, lane = tid & 63, wid = __builtin_amdgcn_readfirstlane(tid >> 6);
        f32x4 csv[2][2];
#pragma unroll
        for (int bj = 0; bj < 2; ++bj)
#pragma unroll
            for (int n = 0; n < 2; ++n) csv[bj][n] = *(const GAS f32x4*)(cs + b * D + col0 + bj * 128 + 4 * n) * cmul;
#pragma unroll
        for (int ai = 0; ai < 2; ++ai) {
            h16x8 rh[4][2];
#pragma unroll
            for (int m = 0; m < 4; ++m)
#pragma unroll
                for (int bj = 0; bj < 2; ++bj) rh[m][bj] = *(const GAS h16x8*)(H + (size_t)(row0 + ai * 128 + m * 16) * D + col0 + bj * 128);
#pragma unroll
            for (int m = 0; m < 4; ++m) {
                float q = 0.f;
#pragma unroll
                for (int bj = 0; bj < 2; ++bj) { const h16x8 hv = rh[m][bj];
                    const f32x4 v0 = (f32x4){(float)hv[0], (float)hv[1], (float)hv[2], (float)hv[3]} + csv[bj][0] * acc[ai][bj][m][0], v1 = (f32x4){(float)hv[4], (float)hv[5], (float)hv[6], (float)hv[7]} + csv[bj][1] * acc[ai][bj][m][1];
                    acc[ai][bj][m][0] = v0; acc[ai][bj][m][1] = v1;
                    q += ((v0[0] * v0[0] + v0[1] * v0[1]) + (v0[2] * v0[2] + v0[3] * v0[3])) + ((v1[0] * v1[0] + v1[1] * v1[1]) + (v1[2] * v1[2] + v1[3] * v1[3])); }
                q += __shfl_xor(q, 16); q += __shfl_xor(q, 32);
                if (fq == 0) P[(ai * 128 + wr * 64 + m * 16 + fr) * 4 + wc] = q;
            }
        }
        asm volatile("s_waitcnt lgkmcnt(0)" ::: "memory"); __builtin_amdgcn_s_barrier(); asm volatile("" ::: "memory");
        if (tid < 256) {
            const f32x4 p4 = *(const LAS f32x4*)(P + tid * 4);
            __hip_atomic_store(xs + ((size_t)(u.pm * 256 + tid) * 4 + u.pn), __float_as_uint((p4[0] + p4[1]) + (p4[2] + p4[3])), __ATOMIC_RELAXED, __HIP_MEMORY_SCOPE_AGENT);
        }
        asm volatile("s_waitcnt vmcnt(0)" ::: "memory");
        if (wid < 4 && lane == 0) __hip_atomic_fetch_add(cnt + 64 * u.pm, 1u, __ATOMIC_RELAXED, __HIP_MEMORY_SCOPE_AGENT);
        if (wid == 0) {
            unsigned sp = 0u;
            while ((unsigned)__builtin_amdgcn_readfirstlane(__hip_atomic_load(cnt + 64 * u.pm, __ATOMIC_RELAXED, __HIP_MEMORY_SCOPE_AGENT)) < 16u) {
                __builtin_amdgcn_s_sleep(2);
                if (++sp > (1u << 16)) { if (lane == 0) __hip_atomic_store(tmo, 1u, __ATOMIC_RELAXED, __HIP_MEMORY_SCOPE_AGENT); break; }
            }
            __builtin_amdgcn_fence(__ATOMIC_ACQUIRE, "agent");
        }
        asm volatile("s_waitcnt vmcnt(0) lgkmcnt(0)" ::: "memory"); __builtin_amdgcn_s_barrier(); asm volatile("" ::: "memory");
        if (tid < 256) {
            const unsigned* sl = xs + (size_t)(u.pm * 256 + tid) * 4;
            const float s0 = __uint_as_float(__hip_atomic_load(sl + 0, __ATOMIC_RELAXED, __HIP_MEMORY_SCOPE_AGENT)), s1 = __uint_as_float(__hip_atomic_load(sl + 1, __ATOMIC_RELAXED, __HIP_MEMORY_SCOPE_AGENT)),
                        s2 = __uint_as_float(__hip_atomic_load(sl + 2, __ATOMIC_RELAXED, __HIP_MEMORY_SCOPE_AGENT)), s3 = __uint_as_float(__hip_atomic_load(sl + 3, __ATOMIC_RELAXED, __HIP_MEMORY_SCOPE_AGENT));
            Sx[tid] = rsqrtf(((s0 + s1) + (s2 + s3)) * (1.f / D) + EPS);
        }
        asm volatile("s_waitcnt vmcnt(0) lgkmcnt(0)" ::: "memory"); __builtin_amdgcn_s_barrier(); asm volatile("" ::: "memory");
        f32x4 gv[2][2];
#pragma unroll
        for (int bj = 0; bj < 2; ++bj)
#pragma unroll
            for (int n = 0; n < 2; ++n) gv[bj][n] = *(const GAS f32x4*)(gfin + col0 + bj * 128 + 4 * n);
#pragma unroll
        for (int ai = 0; ai < 2; ++ai)
#pragma unroll
            for (int m = 0; m < 4; ++m) { const int rl = ai * 128 + wr * 64 + m * 16 + fr; const float rs = Sx[rl]; GAS float* op = out + (size_t)(u.pm * 256 + rl) * D + col0;
#pragma unroll
                for (int bj = 0; bj < 2; ++bj) { st_stream<0>((GAS f32x4*)(op + bj * 128), acc[ai][bj][m][0] * rs * gv[bj][0]); st_stream<0>((GAS f32x4*)(op + bj * 128 + 4), acc[ai][bj][m][1] * rs * gv[bj][1]); } }
        asm volatile("s_waitcnt lgkmcnt(0)" ::: "memory"); __builtin_amdgcn_s_barrier(); asm volatile("" ::: "memory");
    }
};
struct EpiInproj {
    static constexpr bool MID = false;
    GAS h16* proj; const LAS float* rtab; const GAS float* bias; const GAS float* rope; GAS float* kmp;
    __device__ __forceinline__ void mid(f32x4 (&)[2][2][4][2], const pg8::Unit&, int, int, int, int, int) const {}
    __device__ __forceinline__ void operator()(AccRef acc, const pg8::Unit& u, int ui, int wr, int wc, int fr, int fq) const {
        const int b = u.pm >> 5, row0 = u.pm * 256 + wr * 64 + fr, region = u.pn >> 1;
        const GAS float* bp = bias + b * INW + u.pn * 256 + wc * 32 + 4 * fq;
        f32x4 bv[2][2];
#pragma unroll
        for (int bj = 0; bj < 2; ++bj)
#pragma unroll
            for (int n = 0; n < 2; ++n) bv[bj][n] = *(const GAS f32x4*)(bp + bj * 128 + n * 16);
        const bool is_rope = (region == 0) || (region == 2);
        f32x4 csum[2][2];
#pragma unroll
        for (int bj = 0; bj < 2; ++bj)
#pragma unroll
            for (int n = 0; n < 2; ++n) csum[bj][n] = (f32x4){0.f, 0.f, 0.f, 0.f};
        const LAS float* rt = rtab + ui * 256 + wr * 64 + fr;
#pragma unroll
        for (int ai = 0; ai < 2; ++ai)
#pragma unroll
        for (int m0 = 0; m0 < 4; m0 += 2) {
            f32x4 rcs[4][2], rsn[4][2];
            if (is_rope) {
#pragma unroll
                for (int m = m0; m < m0 + 2; ++m) { const GAS float* rp = rope + (size_t)((row0 + ai * 128 + m * 16) & (S - 1)) * 64 + 4 * fq;
#pragma unroll
                    for (int n = 0; n < 2; ++n) { rcs[m][n] = *(const GAS f32x4*)(rp + 16 * n); rsn[m][n] = *(const GAS f32x4*)(rp + 32 + 16 * n); } }
            }
            asm volatile("" ::: "memory");
#pragma unroll
            for (int m = m0; m < m0 + 2; ++m) {
                const int row = row0 + ai * 128 + m * 16;
                const float rs = rt[ai * 128 + m * 16];
                f32x4 v[2][2];
#pragma unroll
                for (int bj = 0; bj < 2; ++bj)
#pragma unroll
                    for (int n = 0; n < 2; ++n) v[bj][n] = acc[ai][bj][m][n] * rs + bv[bj][n];
                GAS h16* prow = proj + (size_t)row * INW + region * 512 + (u.pn & 1) * 256;
                if (is_rope) {
                    const float qs = (region == 0) ? C2 : 1.f;
#pragma unroll
                    for (int n = 0; n < 2; ++n) {
                        const f32x4 cs4 = rcs[m][n] * qs, sn4 = rsn[m][n] * qs;
                        const f32x4 x1 = v[0][n], x2 = v[1][n];
                        v[0][n] = x1 * cs4 - x2 * sn4; v[1][n] = x2 * cs4 + x1 * sn4;
                    }
                    GAS h16* hp = prow + wc * 64 + 16 * fq;
#pragma unroll
                    for (int bj = 0; bj < 2; ++bj) { u32x4 w; w[0] = pkh(v[bj][0][0], v[bj][0][1]); w[1] = pkh(v[bj][0][2], v[bj][0][3]); w[2] = pkh(v[bj][1][0], v[bj][1][1]); w[3] = pkh(v[bj][1][2], v[bj][1][3]);
                        st_stream<4>((GAS u32x4*)(hp + 8 * bj), w); }
                    if (region == 2) {
#pragma unroll
                        for (int bj = 0; bj < 2; ++bj)
#pragma unroll
                            for (int n = 0; n < 2; ++n) csum[bj][n] += v[bj][n];
                    }
                } else {
                    if (region == 1 || region == 4) {
#pragma unroll
                        for (int bj = 0; bj < 2; ++bj)
#pragma unroll
                            for (int n = 0; n < 2; ++n)
#pragma unroll
                                for (int j = 0; j < 4; ++j) v[bj][n][j] = gelu_fast(v[bj][n][j]);
                    }
                    GAS h16* hp = prow + wc * 32 + 8 * fq;
#pragma unroll
                    for (int bj = 0; bj < 2; ++bj) { u32x4 w; w[0] = pkh(v[bj][0][0], v[bj][0][1]); w[1] = pkh(v[bj][0][2], v[bj][0][3]); w[2] = pkh(v[bj][1][0], v[bj][1][1]); w[3] = pkh(v[bj][1][2], v[bj][1][3]);
                        st_stream<4>((GAS u32x4*)(hp + 128 * bj), w); }
                }
            }
        }
        if (region == 2) {
#pragma unroll
            for (int bj = 0; bj < 2; ++bj)
#pragma unroll
                for (int n = 0; n < 2; ++n)
#pragma unroll
                    for (int j = 0; j < 4; ++j) { float t = csum[bj][n][j]; t += __shfl_xor(t, 1); t += __shfl_xor(t, 2); t += __shfl_xor(t, 4); t += __shfl_xor(t, 8); csum[bj][n][j] = t; }
            if (fr == 0) {
                GAS float* kp = kmp + ((size_t)((b * NBLK + (u.pm & 31)) * 2 + wr)) * 512 + ((u.pn & 1) * 4 + wc) * 64 + 16 * fq;
#pragma unroll
                for (int bj = 0; bj < 2; ++bj)
#pragma unroll
                    for (int n = 0; n < 2; ++n) *(GAS f32x4*)(kp + 8 * bj + 4 * n) = csum[bj][n];
            }
        }
    }
};

#define XB_TMO      128
#define XB_XCNT(j)  (256  + 64 * (j))
#define XB_XSUB(j)  (1280 + 64 * (j))
#define XB_XGEN(j)  (2304 + 64 * (j))
#define XB_TOP      3328
#define XB_TOPGEN   3392
#define XCD_BAR_WORDS 3456
#define XB_SPIN_CAP (1u << 18)
__device__ __forceinline__ unsigned xb_ld(unsigned* p)              { return __hip_atomic_load(p, __ATOMIC_RELAXED, __HIP_MEMORY_SCOPE_AGENT); }
__device__ __forceinline__ unsigned xb_add(unsigned* p, unsigned v) { return __hip_atomic_fetch_add(p, v, __ATOMIC_RELAXED, __HIP_MEMORY_SCOPE_AGENT); }
__device__ __forceinline__ unsigned xb_xcc_id() { return (unsigned)__builtin_amdgcn_s_getreg((3 << 11) | 20) & 0xFu; }
#define XB_SPIN(cond, bar) do { unsigned _sp = 0; while (cond) { __builtin_amdgcn_s_sleep(1); \
    if ((++_sp & 255u) == 0u) { if (xb_ld(&(bar)[XB_TMO])) break; if (_sp > XB_SPIN_CAP) { atomicAdd(&(bar)[XB_TMO], 1u); break; } } } } while (0)
struct XcdBarrier { unsigned* bar; unsigned x; volatile LAS unsigned* st; };
__device__ __forceinline__ XcdBarrier xcd_barrier_post(unsigned* bar, volatile LAS unsigned* st) {
    XcdBarrier b; b.bar = bar; b.x = xb_xcc_id(); b.st = st;
    if (threadIdx.x == 0) (void)xb_add(&bar[XB_XCNT(b.x)], 1u);
    return b;
}
__device__ __forceinline__ void xcd_barrier_complete(unsigned* bar, unsigned x, unsigned& nloc, unsigned& nx) {
    const unsigned G = gridDim.x * gridDim.y * gridDim.z;
    unsigned sum, cnt, mine, sp = 0u;
    for (;;) {
        sum = 0u; cnt = 0u; mine = 0u;
#pragma unroll
        for (unsigned j = 0; j < 16; ++j) { const unsigned c = xb_ld(&bar[XB_XCNT(j)]); sum += c; cnt += (c > 0u) ? 1u : 0u; mine = (j == x) ? c : mine; }
        if (sum == G) break;
        __builtin_amdgcn_s_sleep(1);
        if ((++sp & 255u) == 0u) { if (xb_ld(&bar[XB_TMO])) break; if (sp > XB_SPIN_CAP) { atomicAdd(&bar[XB_TMO], 1u); break; } }
    }
    nloc = mine > 0u ? mine : 1u; nx = cnt > 0u ? cnt : 1u;
}
__device__ __forceinline__ void xcd_barrier(const XcdBarrier& b) {
    asm volatile("s_waitcnt vmcnt(0)" ::: "memory");
    __syncthreads();
    if (threadIdx.x == 0) {
        unsigned* bar = b.bar;
        __builtin_amdgcn_s_waitcnt(0);
        unsigned nloc = b.st[0], nx = b.st[1];
        if (nloc == 0u) { xcd_barrier_complete(bar, b.x, nloc, nx); b.st[0] = nloc; b.st[1] = nx; }
        const unsigned old = xb_add(&bar[XB_XSUB(b.x)], 1u);
        const unsigned gen = old / nloc;
        if (old + 1u == (gen + 1u) * nloc) {
            __builtin_amdgcn_fence(__ATOMIC_RELEASE, "agent");
            asm volatile("s_waitcnt vmcnt(0)" ::: "memory");
            const unsigned og = xb_add(&bar[XB_TOP], 1u);
            const unsigned tg = og / nx;
            if (og + 1u == (tg + 1u) * nx) xb_add(&bar[XB_TOPGEN], 1u);
            else XB_SPIN(xb_ld(&bar[XB_TOPGEN]) == tg, bar);
            __builtin_amdgcn_fence(__ATOMIC_ACQUIRE, "agent");
            xb_add(&bar[XB_XGEN(b.x)], 1u);
            asm volatile("s_waitcnt vmcnt(0)" ::: "memory");
        } else {
            XB_SPIN(xb_ld(&bar[XB_XGEN(b.x)]) == gen, bar);
            __builtin_amdgcn_fence(__ATOMIC_ACQUIRE, "agent");
            asm volatile("s_waitcnt vmcnt(0)" ::: "memory");
        }
    }
    __syncthreads();
}

#define GIN(a_, i_) ((const GAS float*)(a_).in[i_])
struct Args { const float* in[20]; float* out; unsigned char* ws; int ph_lo, ph_hi; int shadow, pad; };
struct Frame {
    LAS unsigned char* lds; volatile LAS unsigned* MISC; unsigned* ctl;
    int tid, lane, wave, vcu, G;
    unsigned char* ws; GAS float* out;
};

__device__ __forceinline__ int p8(int l) { return (l & ~31) + 16 * ((l >> 2) & 1) + 4 * ((l >> 3) & 3) + (l & 3); }
__device__ __forceinline__ int phys_gu(int L) { const int isu = L >= DFF, hid = isu ? L - DFF : L, pn = hid >> 7, hh = hid & 127; return 256 * pn + 128 * isu + p8(hh); }
__device__ __forceinline__ int phys_in(int L) {
    const int reg = L >> 9, l = L & 511;
    const int preg = reg == 0 ? 0 : reg == 1 ? 2 : reg == 2 ? 3 : reg == 3 ? 1 : 4;
    if (reg <= 1) { const int head = l >> 6, d = l & 63, bj = d >> 5, i = d & 31; return 512 * preg + 256 * (head >> 2) + 128 * bj + 32 * (head & 3) + i; }
    return 512 * preg + p8(l);
}
enum PhysKind { PH_GU = 0, PH_P8 = 1, PH_IN = 2 };
template <int KIND> __device__ __forceinline__ int physmap(int L) { return KIND == PH_GU ? phys_gu(L) : KIND == PH_P8 ? p8(L) : phys_in(L); }

template <int KIND> __device__ __forceinline__ void p0_transpose_item(const GAS float* W, int K, int N, GAS h16* WT, const GAS float* kscale, LAS float* scr, int item, int lane) {
    const int nblk = N / 32, kb = item / nblk, nb = item % nblk, k0 = 64 * kb, n0 = 32 * nb;
    float wv[32];
#pragma unroll
    for (int i = 0; i < 32; ++i) { const int kk = 2 * i + (lane >> 5); wv[i] = W[(size_t)(k0 + kk) * N + n0 + (lane & 31)]; }
    if (kscale) {
#pragma unroll
        for (int i = 0; i < 32; ++i) wv[i] *= kscale[k0 + 2 * i + (lane >> 5)]; }
#pragma unroll
    for (int i = 0; i < 32; ++i) scr[(2 * i + (lane >> 5)) * 33 + (lane & 31)] = wv[i];
    LDS_WAIT(); asm volatile("" ::: "memory");
    const int c = lane & 7;
#pragma unroll
    for (int j = 0; j < 4; ++j) { const int n = (lane >> 3) + 8 * j; const LAS float* s = scr + (8 * c) * 33 + n;
        u32x4 o; o.x = pkh(s[0 * 33], s[1 * 33]); o.y = pkh(s[2 * 33], s[3 * 33]); o.z = pkh(s[4 * 33], s[5 * 33]); o.w = pkh(s[6 * 33], s[7 * 33]);
        *(GAS u32x4*)(WT + blk_off(physmap<KIND>(n0 + n), k0 + 8 * c, K / 64)) = o; }
    LDS_WAIT(); asm volatile("" ::: "memory");
}

__device__ __forceinline__ void p0_prologue(const Frame& F0, const Args& a) {
    Frame F = F0; F.tid = threadIdx.x; F.lane = F.tid & 63; F.wave = __builtin_amdgcn_readfirstlane(F.tid >> 6);
    const GAS float* c = GIN(a, 1); const GAS float* w_ada = GIN(a, 2);
    {
        LAS float* red = (LAS float*)F.lds;
        for (int item = F.vcu; item < 72 * 4; item += F.G) {
            const int cg = item % 72, kq = item / 72, hlf = F.lane >> 5, col = cg * 128 + (F.lane & 31) * 4;
            f32x4 acc[4] = {{0.f, 0.f, 0.f, 0.f}, {0.f, 0.f, 0.f, 0.f}, {0.f, 0.f, 0.f, 0.f}, {0.f, 0.f, 0.f, 0.f}};
            const int kbase = kq * 256 + F.wave * 32 + hlf;
#pragma unroll
            for (int i = 0; i < 16; ++i) { const int k = kbase + 2 * i; const f32x4 w4 = *(const GAS f32x4*)(w_ada + (size_t)k * (NMOD * D) + col);
#pragma unroll
                for (int b = 0; b < 4; ++b) { const float cv = c[b * D + k]; const float sv = cv / (1.f + __expf(-cv)); acc[b] += w4 * sv; } }
#pragma unroll
            for (int b = 0; b < 4; ++b)
#pragma unroll
                for (int j = 0; j < 4; ++j) acc[b][j] += __shfl_xor(acc[b][j], 32);
            if (hlf == 0) {
#pragma unroll
                for (int b = 0; b < 4; ++b) *(LAS f32x4*)(red + (F.wave * 4 + b) * 128 + (F.lane & 31) * 4) = acc[b];
            }
            __syncthreads();
            { const int b = F.tid >> 7, cc = F.tid & 127; float s = 0.f;
#pragma unroll
              for (int w = 0; w < 8; ++w) s += red[(w * 4 + b) * 128 + cc];
              ((GAS float*)(F.ws + WS_MODP))[(size_t)(kq * 4 + b) * (NMOD * D) + cg * 128 + cc] = s; }
            __syncthreads();
        }
    }
    LAS float* scr = (LAS float*)(F.lds + F.wave * 16384);
    const int gw = F.vcu * NWAVES + F.wave, NGW = F.G * NWAVES;
    constexpr int I_GU = (D / 64) * (NGU / 32), I_DN = (DFF / 64) * (D / 32), I_IN = (D / 64) * (INW / 32), I_OUT = (D / 64) * (D / 32);
    constexpr int NITEMS = 2 * I_GU + 2 * I_DN + I_IN + I_OUT;
    for (int it = gw; it < NITEMS; it += NGW) {
        int r = it;
        if (r < I_GU) { p0_transpose_item<PH_GU>(GIN(a, 5), D, NGU, (GAS h16*)(F.ws + WS_WGU1), nullptr, scr, r, F.lane); continue; } r -= I_GU;
        if (r < I_GU) { p0_transpose_item<PH_GU>(GIN(a, 17), D, NGU, (GAS h16*)(F.ws + WS_WGU2), nullptr, scr, r, F.lane); continue; } r -= I_GU;
        if (r < I_DN) { p0_transpose_item<PH_P8>(GIN(a, 6), DFF, D, (GAS h16*)(F.ws + WS_WD1), nullptr, scr, r, F.lane); continue; } r -= I_DN;
        if (r < I_DN) { p0_transpose_item<PH_P8>(GIN(a, 18), DFF, D, (GAS h16*)(F.ws + WS_WD2), nullptr, scr, r, F.lane); continue; } r -= I_DN;
        if (r < I_IN) { p0_transpose_item<PH_IN>(GIN(a, 8), D, INW, (GAS h16*)(F.ws + WS_WIN), nullptr, scr, r, F.lane); continue; } r -= I_IN;
        {
            const int kb = r / (D / 32); const GAS float* ks = (kb < 8) ? GIN(a, 13) : (GIN(a, 14) - 512);
            p0_transpose_item<PH_P8>(GIN(a, 15), D, D, (GAS h16*)(F.ws + WS_WOUT), ks, scr, r, F.lane); }
    }
    for (int pos = gw; pos < S; pos += NGW) {
        const int i = F.lane & 31;
        const float inv = (float)exp(-(double)i / 32.0 * 9.210340371976184);
        const float ang = (float)pos * inv;
        const double da = (double)ang;
        ((GAS float*)(F.ws + WS_ROPE))[(size_t)pos * 64 + F.lane] = (F.lane < 32) ? (float)cos(da) : (float)sin(da);
    }
    for (int e = gw * 64 + F.lane; e < NH * GC * GC; e += NGW * 64) { const int t = (e >> 7) & 127, s = e & 127; ((GAS h16*)(F.ws + WS_WS16))[e] = (s <= t) ? (h16)GIN(a, 11)[e] : (h16)0.f; }
}

__device__ __forceinline__ void p1_prep(const Frame& F0, const Args& a) {
    Frame F = F0; F.tid = threadIdx.x; F.lane = F.tid & 63; F.wave = __builtin_amdgcn_readfirstlane(F.tid >> 6);
    LAS float* modl = (LAS float*)F.lds;
    const GAS float* modp = (const GAS float*)(F.ws + WS_MODP); const GAS float* b_ada = GIN(a, 3);
    const size_t st = (size_t)4 * NMOD * D;
    for (int e = F.tid; e < 4 * 6 * D; e += NWAVES * 64) {
        const int b = e / (6 * D), sl = (e / D) % 6, k = e % D; const int mi = (sl < 3) ? 3 * sl : 3 * (sl - 3) + 1;
        const size_t o = (size_t)b * (NMOD * D) + mi * D + k;
        modl[e] = ((modp[o] + modp[o + st]) + (modp[o + 2 * st] + modp[o + 3 * st])) + b_ada[mi * D + k];
    }
    __syncthreads();
    if (F.vcu == 0) {
        GAS float* GT = (GAS float*)(F.ws + WS_GT); GAS float* GP = (GAS float*)(F.ws + WS_GP);
        for (int e = F.tid; e < 3 * 4 * D; e += NWAVES * 64) {
            const int j = e / (4 * D), b = (e / D) % 4, k = e % D; const int mi = 3 * j + 2;
            const size_t o = (size_t)b * (NMOD * D) + mi * D + k;
            GT[e] = ((modp[o] + modp[o + st]) + (modp[o + 2 * st] + modp[o + 3 * st])) + b_ada[mi * D + k];
            const GAS float* g = j == 0 ? GIN(a, 4) : j == 1 ? GIN(a, 7) : GIN(a, 16);
            GP[e] = g[k] * (1.f + modl[(b * 6 + 3 + j) * D + k]);
        }
    }
    const GAS float* x = GIN(a, 0); const GAS float* g1 = GIN(a, 4);
    GAS h16* XG = (GAS h16*)(F.ws + WS_HG); GAS float* R1 = (GAS float*)(F.ws + WS_R1);
    for (int chunk = F.vcu; chunk < M / 128; chunk += F.G) {
        const int b = chunk / (S / 128);
        f32x4 scl[2][2];
#pragma unroll
        for (int j = 0; j < 2; ++j)
#pragma unroll
            for (int h = 0; h < 2; ++h) { const int k = 8 * F.lane + 512 * j + 4 * h; const f32x4 gg = *(const GAS f32x4*)(g1 + k); const LAS float* sc = modl + (b * 6 + 3) * D + k;
                scl[j][h] = gg * ((f32x4){1.f + sc[0], 1.f + sc[1], 1.f + sc[2], 1.f + sc[3]}); }
        for (int rb = 0; rb < 16; rb += 4) {
            f32x4 v[4][2][2]; float q[4];
#pragma unroll
            for (int r4 = 0; r4 < 4; ++r4) { const GAS float* xr = x + (size_t)(chunk * 128 + F.wave * 16 + rb + r4) * D + 8 * F.lane;
#pragma unroll
                for (int j = 0; j < 2; ++j) { v[r4][j][0] = *(const GAS f32x4*)(xr + 512 * j); v[r4][j][1] = *(const GAS f32x4*)(xr + 512 * j + 4); } }
            asm volatile("" ::: "memory");
#pragma unroll
            for (int r4 = 0; r4 < 4; ++r4) { float t = 0.f;
#pragma unroll
                for (int j = 0; j < 2; ++j)
#pragma unroll
                    for (int h = 0; h < 2; ++h) t += (v[r4][j][h][0] * v[r4][j][h][0] + v[r4][j][h][1] * v[r4][j][h][1]) + (v[r4][j][h][2] * v[r4][j][h][2] + v[r4][j][h][3] * v[r4][j][h][3]);
                q[r4] = t; }
#pragma unroll
            for (int o = 1; o < 64; o <<= 1)
#pragma unroll
                for (int r4 = 0; r4 < 4; ++r4) q[r4] += __shfl_xor(q[r4], o);
#pragma unroll
            for (int r4 = 0; r4 < 4; ++r4) {
                const int row = chunk * 128 + F.wave * 16 + rb + r4;
                if (F.lane == 0) R1[row] = rsqrtf(q[r4] * (1.f / D) + EPS);
#pragma unroll
                for (int j = 0; j < 2; ++j) { const int k = 8 * F.lane + 512 * j; u32x4 w;
#pragma unroll
                    for (int h = 0; h < 2; ++h) { const f32x4 o = v[r4][j][h] * scl[j][h]; w[2 * h] = pkh(o[0], o[1]); w[2 * h + 1] = pkh(o[2], o[3]); }
                    *(GAS u32x4*)(XG + blk_off(row, k, D / 64)) = w; }
            }
        }
    }
    const int gw = F.vcu * NWAVES + F.wave, NGW = F.G * NWAVES;
    for (int it = gw; it < NGU + INW + NGU; it += NGW) {
        int n = it, j; const GAS h16* W; GAS float* B; int NN;
        if (n < NGU) { j = 0; W = (const GAS h16*)(F.ws + WS_WGU1); B = (GAS float*)(F.ws + WS_BIAS1); NN = NGU; }
        else if (n < NGU + INW) { n -= NGU; j = 1; W = (const GAS h16*)(F.ws + WS_WIN); B = (GAS float*)(F.ws + WS_BIAS2); NN = INW; }
        else { n -= NGU + INW; j = 2; W = (const GAS h16*)(F.ws + WS_WGU2); B = (GAS float*)(F.ws + WS_BIAS3); NN = NGU; }
        const h16x8 w0 = *(const GAS h16x8*)(W + blk_off(n, 16 * F.lane, D / 64)), w1 = *(const GAS h16x8*)(W + blk_off(n, 16 * F.lane + 8, D / 64));
        float s[4];
#pragma unroll
        for (int b = 0; b < 4; ++b) { const LAS float* sh = modl + (b * 6 + j) * D + 16 * F.lane; float t = 0.f;
#pragma unroll
            for (int e = 0; e < 8; ++e) t += sh[e] * (float)w0[e] + sh[8 + e] * (float)w1[e];
            s[b] = wave_sum(t); }
        if (F.lane == 0) { B[0 * NN + n] = s[0]; B[1 * NN + n] = s[1]; B[2 * NN + n] = s[2]; B[3 * NN + n] = s[3]; }
    }
    __syncthreads();
}

__device__ __forceinline__ void p_final(const Frame& F0, const Args& a) {
    Frame F = F0; F.tid = threadIdx.x; F.lane = F.tid & 63; F.wave = __builtin_amdgcn_readfirstlane(F.tid >> 6);
    const GAS h16* H = (const GAS h16*)(F.ws + WS_H); const GAS float* ssq = (const GAS float*)(F.ws + WS_SSQF); const GAS float* gf = GIN(a, 19);
    const int gw = F.vcu * NWAVES + F.wave, NGW = F.G * NWAVES;
    f32x4 g[2][2];
#pragma unroll
    for (int j = 0; j < 2; ++j)
#pragma unroll
        for (int h = 0; h < 2; ++h) g[j][h] = *(const GAS f32x4*)(gf + 8 * F.lane + 512 * j + 4 * h);
    for (int row = gw; row < M; row += NGW) {
        const float rs = rs16(ssq + (size_t)row * 16);
#pragma unroll
        for (int j = 0; j < 2; ++j) { const h16x8 hv = *(const GAS h16x8*)(H + (size_t)row * D + 8 * F.lane + 512 * j);
            f32x4 o0 = (f32x4){(float)hv[0], (float)hv[1], (float)hv[2], (float)hv[3]} * rs * g[j][0], o1 = (f32x4){(float)hv[4], (float)hv[5], (float)hv[6], (float)hv[7]} * rs * g[j][1];
            *(GAS f32x4*)(a.out + (size_t)row * D + 8 * F.lane + 512 * j) = o0; *(GAS f32x4*)(a.out + (size_t)row * D + 8 * F.lane + 512 * j + 4) = o1; }
    }
}


typedef float f32x16 __attribute__((ext_vector_type(16)));
typedef short v4i16_t __attribute__((ext_vector_type(4)));
__device__ __forceinline__ h16x4 tr16(const LAS unsigned char* p) { return __builtin_bit_cast(h16x4, __builtin_amdgcn_ds_read_tr16_b64_v4i16((LAS v4i16_t*)p)); }
__device__ __forceinline__ int vt_off(int t, int c8) { return t * 128 + (((c8 >> 2) ^ ((t >> 1) & 1)) << 6) + ((c8 & 3) << 4); }

__device__ __forceinline__ void gmlp_phase(const Frame& F0, const Args& a, int shadow) {
    const int tid = threadIdx.x, lane = tid & 63, wave = __builtin_amdgcn_readfirstlane(tid >> 6), r32 = lane & 31, hi = lane >> 5;
    GAS h16* proj = (GAS h16*)(F0.ws + WS_PROJ); const GAS h16* W16 = (const GAS h16*)(F0.ws + WS_WS16); GAS float* RG = (GAS float*)(F0.ws + WS_RG);
    const GAS float* ln_g = GIN(a, 9); const GAS float* ln_b = GIN(a, 10); const GAS float* b_s = GIN(a, 12);
    LAS unsigned char* lds = F0.lds;
    LAS float* rowsq = (LAS float*)(lds + MISC_OFF + 128);
    f32x4 g0 = *(const GAS f32x4*)(ln_g + 8 * lane), g1 = *(const GAS f32x4*)(ln_g + 8 * lane + 4), b0 = *(const GAS f32x4*)(ln_b + 8 * lane), b1 = *(const GAS f32x4*)(ln_b + 8 * lane + 4);
    for (int unit = F0.vcu; unit < M / GC; unit += F0.G) {
        const size_t row0 = (size_t)unit * GC;
        {
            h16x8 hv[16]; float sm[16], mu[16], rsd[16];
#pragma unroll
            for (int rr = 0; rr < 16; ++rr) hv[rr] = *(const GAS h16x8*)(proj + (row0 + wave * 16 + rr) * INW + PG + 8 * lane);
#pragma unroll
            for (int rr = 0; rr < 16; ++rr) { float t = 0.f;
#pragma unroll
                for (int e = 0; e < 8; ++e) t += (float)hv[rr][e];
                sm[rr] = t; }
#pragma unroll
            for (int o = 1; o < 64; o <<= 1)
#pragma unroll
                for (int rr = 0; rr < 16; ++rr) sm[rr] += __shfl_xor(sm[rr], o);
#pragma unroll
            for (int rr = 0; rr < 16; ++rr) { mu[rr] = sm[rr] * (1.f / 512.f); float q = 0.f;
#pragma unroll
                for (int e = 0; e < 8; ++e) { const float d = (float)hv[rr][e] - mu[rr]; q += d * d; }
                sm[rr] = q; }
#pragma unroll
            for (int o = 1; o < 64; o <<= 1)
#pragma unroll
                for (int rr = 0; rr < 16; ++rr) sm[rr] += __shfl_xor(sm[rr], o);
#pragma unroll
            for (int rr = 0; rr < 16; ++rr) { rsd[rr] = rsqrtf(sm[rr] * (1.f / 512.f) + EPS);
                const int t = wave * 16 + rr; float v[8];
#pragma unroll
                for (int e = 0; e < 8; ++e) v[e] = ((float)hv[rr][e] - mu[rr]) * rsd[rr];
                u32x4 w; w[0] = pkh(v[0] * g0[0] + b0[0], v[1] * g0[1] + b0[1]); w[1] = pkh(v[2] * g0[2] + b0[2], v[3] * g0[3] + b0[3]);
                w[2] = pkh(v[4] * g1[0] + b1[0], v[5] * g1[1] + b1[1]); w[3] = pkh(v[6] * g1[2] + b1[2], v[7] * g1[3] + b1[3]);
                *(LAS u32x4*)(lds + (lane >> 3) * 16384 + vt_off(t, lane & 7)) = w; }
        }
        __syncthreads();
        const GAS h16* Wh = W16 + (size_t)wave * GC * GC;
        const LAS unsigned char* vt = lds + wave * 16384;
        const int q4 = (lane & 15) >> 2, p4 = lane & 3, g1b = (lane >> 4) & 1;
#pragma unroll
        for (int tb = 0; tb < 4; ++tb) {
            f32x16 acc[2];
#pragma unroll
            for (int d0 = 0; d0 < 2; ++d0)
#pragma unroll
                for (int e = 0; e < 16; ++e) acc[d0][e] = 0.f;
            h16x8 af[8];
#pragma unroll
            for (int ks = 0; ks < 8; ++ks) if (ks <= 2 * tb + 1) af[ks] = *(const GAS h16x8*)(Wh + (size_t)(32 * tb + r32) * GC + 16 * ks + 8 * hi);
#pragma unroll
            for (int ks = 0; ks < 8; ++ks) {
                if (ks <= 2 * tb + 1) {
#pragma unroll
                    for (int d0 = 0; d0 < 2; ++d0) {
                        const int srow = 16 * ks + 8 * hi + q4, c8 = 4 * d0 + 2 * g1b + (p4 >> 1);
                        const h16x4 lo = tr16(vt + vt_off(srow, c8) + (p4 & 1) * 8), hi4 = tr16(vt + vt_off(srow + 4, c8) + (p4 & 1) * 8);
                        const h16x8 bf = (h16x8){lo[0], lo[1], lo[2], lo[3], hi4[0], hi4[1], hi4[2], hi4[3]};
                        acc[d0] = __builtin_amdgcn_mfma_f32_32x32x16_f16(af[ks], bf, acc[d0], 0, 0, 0);
                    }
                }
            }
            h16 uv0[16], uv1[16]; float bsv[16];
#pragma unroll
            for (int e = 0; e < 16; ++e) { const int t = 32 * tb + (e & 3) + 8 * (e >> 2) + 4 * hi; const GAS h16* up = proj + (row0 + t) * INW + PU + wave * 64 + r32; uv0[e] = up[0]; uv1[e] = up[32]; bsv[e] = b_s[wave * GC + t]; }
            asm volatile("" ::: "memory");
#pragma unroll
            for (int e = 0; e < 16; ++e) {
                const int t = 32 * tb + (e & 3) + 8 * (e >> 2) + 4 * hi;
                GAS h16* up = proj + (row0 + t) * INW + PU + wave * 64 + r32;
                const float o0 = (float)uv0[e] * (acc[0][e] + bsv[e]), o1 = (float)uv1[e] * (acc[1][e] + bsv[e]);
                up[0] = (h16)o0; up[32] = (h16)o1;
                float q = o0 * o0 + o1 * o1;
                q += __shfl_xor(q, 1); q += __shfl_xor(q, 2); q += __shfl_xor(q, 4); q += __shfl_xor(q, 8); q += __shfl_xor(q, 16);
                if (r32 == 0) rowsq[wave * 128 + t] = q;
            }
        }
        __syncthreads();
        if (tid < 128) { float s8 = 0.f;
#pragma unroll
            for (int w = 0; w < 8; ++w) s8 += rowsq[w * 128 + tid];
            RG[row0 + tid] = s8; }
        __syncthreads();
    }
}


constexpr size_t DO_PO = 0, DO_PML = 96 * MiB;
constexpr int CW_CNT = 8192;
constexpr int LISTCAP = 8192;
constexpr int AL_K = 0, AL_V = 32768, AL_STG = 65536, AL_WSF = 98304, AL_START = 102400;
__device__ __forceinline__ int k_off(int key, int c8) { return key * 128 + ((c8 ^ (key & 7)) << 4); }

__device__ __forceinline__ void moba_gate_phase(const Frame& F0, int shadow) {
    const int tid = threadIdx.x, lane = tid & 63;
    const GAS h16* proj = (const GAS h16*)(F0.ws + WS_PROJ); const GAS float* kmp = (const GAS float*)(F0.ws + WS_KMP);
    unsigned* cnt = F0.ctl + CW_CNT + (shadow ? 1024 : 0); GAS unsigned short* lists = (GAS unsigned short*)(F0.ws + (shadow ? WS_HG : WS_LISTS));
    LAS float* km = (LAS float*)F0.lds;
    for (int item = F0.vcu; item < NB * NH * (S / 512); item += F0.G) {
        const int span = item % (S / 512), bh = item / (S / 512), b = bh >> 3, h = bh & 7;
        __syncthreads();
        for (int e = tid; e < NBLK * 64; e += NWAVES * 64) { const int n = e >> 6, d = e & 63; const GAS float* kp = kmp + (size_t)((b * NBLK + n) * 2) * 512 + h * 64 + d; km[e] = kp[0] + kp[512]; }
        __syncthreads();
        const int sq = span * 512 + tid, own = __builtin_amdgcn_readfirstlane(sq >> 8);
        float q[64];
        { const GAS h16* qp = proj + (size_t)(b * S + sq) * INW + PQ + h * 64;
#pragma unroll
          for (int c = 0; c < 8; ++c) { const h16x8 v = *(const GAS h16x8*)(qp + 8 * c);
#pragma unroll
              for (int e = 0; e < 8; ++e) q[8 * c + e] = (float)v[e]; } }
        float v0 = -3e38f, v1 = -3e38f, v2 = -3e38f; int i0 = -1, i1 = -1, i2 = -1;
        for (int n = 0; n < own; ++n) {
            float g0 = 0.f, g1 = 0.f, g2 = 0.f, g3 = 0.f;
#pragma unroll
            for (int c = 0; c < 16; ++c) { const f32x4 kv = *(const LAS f32x4*)(km + n * 64 + 4 * c); g0 += q[4 * c] * kv[0]; g1 += q[4 * c + 1] * kv[1]; g2 += q[4 * c + 2] * kv[2]; g3 += q[4 * c + 3] * kv[3]; }
            const float g = (g0 + g1) + (g2 + g3);
            if (g > v0) { v2 = v1; i2 = i1; v1 = v0; i1 = i0; v0 = g; i0 = n; }
            else if (g > v1) { v2 = v1; i2 = i1; v1 = g; i1 = n; }
            else if (g > v2) { v2 = g; i2 = n; }
        }
        int mycnt = 0, pos0 = 0, pos1 = 0, pos2 = 0;
        const unsigned long long ltmask = (1ull << lane) - 1ull;
        for (int n = 0; n < own; ++n) {
            const bool sel = (i0 == n) || (i1 == n) || (i2 == n);
            const unsigned long long mask = __ballot(sel);
            const int before = __popcll(mask & ltmask);
            if (lane == n) mycnt = __popcll(mask);
            if (i0 == n) pos0 = before; if (i1 == n) pos1 = before; if (i2 == n) pos2 = before;
        }
        unsigned base = 0u;
        if (lane < own && mycnt > 0) base = atomicAdd(cnt + bh * NBLK + lane, (unsigned)mycnt);
        const unsigned bb0 = (unsigned)__shfl((int)base, i0 & 63), bb1 = (unsigned)__shfl((int)base, i1 & 63), bb2 = (unsigned)__shfl((int)base, i2 & 63);
        if (i0 >= 0) lists[(size_t)(bh * NBLK + i0) * LISTCAP + bb0 + pos0] = (unsigned short)(sq | (0 << 13));
        if (i1 >= 0) lists[(size_t)(bh * NBLK + i1) * LISTCAP + bb1 + pos1] = (unsigned short)(sq | (1 << 13));
        if (i2 >= 0) lists[(size_t)(bh * NBLK + i2) * LISTCAP + bb2 + pos2] = (unsigned short)(sq | (2 << 13));
    }
    __syncthreads();
}

template <bool CAUSAL>
__device__ __forceinline__ void attn_tile(const LAS unsigned char* ldsK, const LAS unsigned char* ldsV, const h16x8 (&qf)[4], int wave, int lane, f32x16 (&o)[2], float& m_out, float& l_out) {
    const int r32 = lane & 31, hi = lane >> 5;
    int kbase[4];
#pragma unroll
    for (int ks = 0; ks < 4; ++ks) kbase[ks] = r32 * 128 + (((2 * ks + hi) ^ (r32 & 7)) << 4);
    f32x16 sacc[8];
#pragma unroll
    for (int kb = 0; kb < 8; ++kb) {
        f32x16 acc;
#pragma unroll
        for (int e = 0; e < 16; ++e) acc[e] = 0.f;
#pragma unroll
        for (int ks = 0; ks < 4; ++ks) { const h16x8 kf = *(const LAS h16x8*)(ldsK + kbase[ks] + kb * 4096); acc = __builtin_amdgcn_mfma_f32_32x32x16_f16(kf, qf[ks], acc, 0, 0, 0); }
        if (CAUSAL) {
            const int lim = 32 * (wave - kb) + r32;
#pragma unroll
            for (int e = 0; e < 16; ++e) { const int key = (e & 3) + 8 * (e >> 2) + 4 * hi; if (key > lim) acc[e] = -1e30f; }
        }
        sacc[kb] = acc;
    }
    float m = -3e38f;
#pragma unroll
    for (int kb = 0; kb < 8; ++kb)
#pragma unroll
        for (int e = 0; e < 16; ++e) m = fmaxf(m, sacc[kb][e]);
    m = fmaxf(m, __shfl_xor(m, 32));
    float ls = 0.f;
#pragma unroll
    for (int kb = 0; kb < 8; ++kb)
#pragma unroll
        for (int e = 0; e < 16; ++e) { const float pv = __builtin_amdgcn_exp2f(sacc[kb][e] - m); sacc[kb][e] = pv; ls += pv; }
    ls += __shfl_xor(ls, 32);
#pragma unroll
    for (int d0 = 0; d0 < 2; ++d0)
#pragma unroll
        for (int e = 0; e < 16; ++e) o[d0][e] = 0.f;
    const int q4 = (lane & 15) >> 2, p4 = lane & 3, g1b = (lane >> 4) & 1;
    int vbase[2];
#pragma unroll
    for (int d0 = 0; d0 < 2; ++d0) vbase[d0] = (4 * hi + q4) * 128 + ((d0 ^ ((q4 >> 1) & 1)) << 6) + ((2 * g1b + (p4 >> 1)) << 4) + (p4 & 1) * 8;
#pragma unroll
    for (int kb = 0; kb < 8; ++kb) {
        if (!CAUSAL || kb <= wave) {
#pragma unroll
            for (int s2 = 0; s2 < 2; ++s2) {
                h16x8 pa;
#pragma unroll
                for (int j = 0; j < 8; ++j) pa[j] = (h16)sacc[kb][8 * s2 + j];
#pragma unroll
                for (int d0 = 0; d0 < 2; ++d0) {
                    const h16x4 lo = tr16(ldsV + vbase[d0] + kb * 4096 + s2 * 2048), hi4 = tr16(ldsV + vbase[d0] + kb * 4096 + s2 * 2048 + 1024);
                    const h16x8 bf = (h16x8){lo[0], lo[1], lo[2], lo[3], hi4[0], hi4[1], hi4[2], hi4[3]};
                    o[d0] = __builtin_amdgcn_mfma_f32_32x32x16_f16(pa, bf, o[d0], 0, 0, 0);
                }
            }
        }
    }
    m_out = m; l_out = ls;
}
__device__ __forceinline__ void attn_tile_causal(const LAS unsigned char* ldsK, const LAS unsigned char* ldsV, const h16x8 (&qf)[4], int wave, int lane, f32x16 (&o)[2], float& m_out, float& l_out) {
    const int r32 = lane & 31, hi = lane >> 5;
    int kbase[4];
#pragma unroll
    for (int ks = 0; ks < 4; ++ks) kbase[ks] = r32 * 128 + (((2 * ks + hi) ^ (r32 & 7)) << 4);
    const int q4 = (lane & 15) >> 2, p4 = lane & 3, g1b = (lane >> 4) & 1;
    int vbase[2];
#pragma unroll
    for (int d0 = 0; d0 < 2; ++d0) vbase[d0] = (4 * hi + q4) * 128 + ((d0 ^ ((q4 >> 1) & 1)) << 6) + ((2 * g1b + (p4 >> 1)) << 4) + (p4 & 1) * 8;
    float m = -3e38f;
    for (int kb = 0; kb <= wave; ++kb) {
        f32x16 acc;
#pragma unroll
        for (int e = 0; e < 16; ++e) acc[e] = 0.f;
#pragma unroll
        for (int ks = 0; ks < 4; ++ks) { const h16x8 kf = *(const LAS h16x8*)(ldsK + kbase[ks] + kb * 4096); acc = __builtin_amdgcn_mfma_f32_32x32x16_f16(kf, qf[ks], acc, 0, 0, 0); }
        const int lim = (kb == wave) ? r32 : 64;
#pragma unroll
        for (int e = 0; e < 16; ++e) { const int key = (e & 3) + 8 * (e >> 2) + 4 * hi; if (key <= lim) m = fmaxf(m, acc[e]); }
    }
    m = fmaxf(m, __shfl_xor(m, 32));
    float ls = 0.f;
#pragma unroll
    for (int d0 = 0; d0 < 2; ++d0)
#pragma unroll
        for (int e = 0; e < 16; ++e) o[d0][e] = 0.f;
    for (int kb = 0; kb <= wave; ++kb) {
        f32x16 acc;
#pragma unroll
        for (int e = 0; e < 16; ++e) acc[e] = 0.f;
#pragma unroll
        for (int ks = 0; ks < 4; ++ks) { const h16x8 kf = *(const LAS h16x8*)(ldsK + kbase[ks] + kb * 4096); acc = __builtin_amdgcn_mfma_f32_32x32x16_f16(kf, qf[ks], acc, 0, 0, 0); }
        const int lim = (kb == wave) ? r32 : 64;
#pragma unroll
        for (int e = 0; e < 16; ++e) { const int key = (e & 3) + 8 * (e >> 2) + 4 * hi; const float pv = (key <= lim) ? __builtin_amdgcn_exp2f(acc[e] - m) : 0.f; acc[e] = pv; ls += pv; }
#pragma unroll
        for (int s2 = 0; s2 < 2; ++s2) {
            h16x8 pa;
#pragma unroll
            for (int j = 0; j < 8; ++j) pa[j] = (h16)acc[8 * s2 + j];
#pragma unroll
            for (int d0 = 0; d0 < 2; ++d0) {
                const h16x4 lo = tr16(ldsV + vbase[d0] + kb * 4096 + s2 * 2048), hi4 = tr16(ldsV + vbase[d0] + kb * 4096 + s2 * 2048 + 1024);
                const h16x8 bf = (h16x8){lo[0], lo[1], lo[2], lo[3], hi4[0], hi4[1], hi4[2], hi4[3]};
                o[d0] = __builtin_amdgcn_mfma_f32_32x32x16_f16(pa, bf, o[d0], 0, 0, 0);
            }
        }
    }
    ls += __shfl_xor(ls, 32);
    m_out = m; l_out = ls;
}
__device__ __forceinline__ void load_kv_block(LAS unsigned char* lds, const GAS h16* proj, size_t row0, int h, int tid) {
#pragma unroll
    for (int i = 0; i < 4; ++i) { const int idx = tid + 512 * i, key = idx >> 3, c8 = idx & 7; const GAS h16* rp = proj + (row0 + key) * INW + h * 64 + 8 * c8;
        const u32x4 kv = *(const GAS u32x4*)(rp + PK), vv = *(const GAS u32x4*)(rp + PV);
        *(LAS u32x4*)(lds + AL_K + k_off(key, c8)) = kv; *(LAS u32x4*)(lds + AL_V + vt_off(key, c8)) = vv; }
}
struct KvRegs { u32x4 kv[4], vv[4]; };
__device__ __forceinline__ void kv_fetch(KvRegs& r, const GAS h16* proj, size_t row0, int h, int tid) {
#pragma unroll
    for (int i = 0; i < 4; ++i) { const int idx = tid + 512 * i, key = idx >> 3, c8 = idx & 7; const GAS h16* rp = proj + (row0 + key) * INW + h * 64 + 8 * c8;
        r.kv[i] = *(const GAS u32x4*)(rp + PK); r.vv[i] = *(const GAS u32x4*)(rp + PV); }
}
__device__ __forceinline__ void kv_commit(const KvRegs& r, LAS unsigned char* lds, int tid) {
#pragma unroll
    for (int i = 0; i < 4; ++i) { const int idx = tid + 512 * i, key = idx >> 3, c8 = idx & 7;
        *(LAS u32x4*)(lds + AL_K + k_off(key, c8)) = r.kv[i]; *(LAS u32x4*)(lds + AL_V + vt_off(key, c8)) = r.vv[i]; }
}
__device__ __forceinline__ void stage_o(LAS unsigned char* stg, LAS float* wsf, const f32x16 (&o)[2], float l, int lane) {
    const int r32 = lane & 31, hi = lane >> 5;
    if (hi == 0) wsf[r32] = 1.f / l;
    LDS_WAIT();
#pragma unroll
    for (int e = 0; e < 16; ++e) { const int qr = (e & 3) + 8 * (e >> 2) + 4 * hi; const float rl = wsf[qr];
        *(LAS h16*)(stg + qr * 128 + r32 * 2) = (h16)(o[0][e] * rl); *(LAS h16*)(stg + qr * 128 + 64 + r32 * 2) = (h16)(o[1][e] * rl); }
    LDS_WAIT();
}

__device__ __forceinline__ void moba_b_phase(const Frame& F0, GAS float* dout) {
    const int tid = threadIdx.x, lane = tid & 63, wave = __builtin_amdgcn_readfirstlane(tid >> 6), r32 = lane & 31, hi = lane >> 5;
    const GAS h16* proj = (const GAS h16*)(F0.ws + WS_PROJ); const unsigned* cnt = F0.ctl + CW_CNT; const GAS unsigned short* lists = (const GAS unsigned short*)(F0.ws + WS_LISTS);
    GAS h16* PO = (GAS h16*)((unsigned char*)dout + DO_PO); GAS float* PML = (GAS float*)((unsigned char*)dout + DO_PML);
    LAS unsigned char* lds = F0.lds;
    LAS int* start = (LAS int*)(lds + AL_START);
    LAS float* wsf = (LAS float*)(lds + AL_WSF + wave * 512); LAS int* wsi = (LAS int*)(lds + AL_WSF + wave * 512 + 256);
    LAS unsigned char* stg = lds + AL_STG + wave * 4096;
    {
        const unsigned c0 = cnt[2 * tid], c1 = cnt[2 * tid + 1];
        const int t0 = (int)((c0 + 255u) >> 8), t1 = (int)((c1 + 255u) >> 8);
        int v = t0 + t1, inc = v;
#pragma unroll
        for (int o = 1; o < 64; o <<= 1) { const int u = __shfl_up(inc, o); if (lane >= o) inc += u; }
        LAS int* wtot = (LAS int*)(lds + AL_WSF);
        __syncthreads();
        if (lane == 63) wtot[wave] = inc;
        __syncthreads();
        int pre = 0;
        for (int w = 0; w < wave; ++w) pre += wtot[w];
        const int ex = pre + inc - v;
        __syncthreads();
        start[2 * tid] = ex; start[2 * tid + 1] = ex + t0;
        if (tid == 511) start[1024] = ex + v;
        __syncthreads();
    }
    const int nitems = start[1024];
    for (int item = F0.vcu; item < nitems; item += F0.G) {
        int lo = 0, hi_ = 1024;
        while (hi_ - lo > 1) { const int mid = (lo + hi_) >> 1; if (start[mid] <= item) lo = mid; else hi_ = mid; }
        const int l = lo, chunk = item - start[l];
        const int bh = l >> 5, n = l & 31, b = bh >> 3, h = bh & 7;
        const int nq = (int)cnt[l] - chunk * 256;
        load_kv_block(lds, proj, (size_t)b * S + (size_t)n * MBLK, h, tid);
        const int qi = chunk * 256 + wave * 32 + r32;
        const bool valid = (wave * 32 + r32) < nq;
        const unsigned ent = lists[(size_t)l * LISTCAP + (valid ? qi : chunk * 256)];
        const int sq = ent & 8191, rank = ent >> 13;
        h16x8 qf[4];
        { const GAS h16* qp = proj + (size_t)(b * S + sq) * INW + PQ + h * 64 + 8 * hi;
#pragma unroll
          for (int ks = 0; ks < 4; ++ks) qf[ks] = *(const GAS h16x8*)(qp + 16 * ks); }
        __syncthreads();
        if (wave * 32 < nq) {
            f32x16 o[2]; float m, lsum;
            attn_tile<false>(lds + AL_K, lds + AL_V, qf, wave, lane, o, m, lsum);
            const int slot = ((b * NH + h) * 3 + rank) * S + sq;
            if (hi == 0) { wsi[r32] = valid ? slot : -1; if (valid) { PML[(size_t)slot * 2] = m; PML[(size_t)slot * 2 + 1] = lsum; } }
            stage_o(stg, wsf, o, lsum, lane);
#pragma unroll
            for (int i = 0; i < 4; ++i) { const int row = i * 8 + (lane >> 3), ch = lane & 7; const int sl = wsi[row];
                if (sl >= 0) *(GAS u32x4*)(PO + (size_t)sl * 64 + ch * 8) = *(const LAS u32x4*)(stg + row * 128 + ch * 16); }
        }
        __syncthreads();
    }
}

__device__ __forceinline__ void moba_c_phase(const Frame& F0, const GAS float* dout, int shadow) {
    const int tid = threadIdx.x, lane = tid & 63, wave = __builtin_amdgcn_readfirstlane(tid >> 6), r32 = lane & 31, hi = lane >> 5;
    GAS h16* proj = (GAS h16*)(F0.ws + WS_PROJ); GAS float* SSQA = (GAS float*)(F0.ws + WS_SSQA);
    const GAS h16* PO = (const GAS h16*)((const unsigned char*)dout + DO_PO); const GAS float* PML = (const GAS float*)((const unsigned char*)dout + DO_PML);
    LAS unsigned char* lds = F0.lds;
    LAS float* wsf = (LAS float*)(lds + AL_WSF + wave * 512);
    LAS unsigned char* stg = lds + AL_STG + wave * 4096;
    KvRegs kvr;
    if (F0.vcu < NB * NH * NBLK) { const int u0 = F0.vcu; kv_fetch(kvr, proj, (size_t)((u0 >> 5) >> 3) * S + (size_t)(u0 & 31) * MBLK, (u0 >> 5) & 7, tid); }
    for (int unit = F0.vcu; unit < NB * NH * NBLK; unit += F0.G) {
        const int qb = unit & 31, bh = unit >> 5, b = bh >> 3, h = bh & 7;
        const size_t row0 = (size_t)b * S + (size_t)qb * MBLK;
        kv_commit(kvr, lds, tid);
        { const int un = unit + F0.G; if (un < NB * NH * NBLK) kv_fetch(kvr, proj, (size_t)((un >> 5) >> 3) * S + (size_t)(un & 31) * MBLK, (un >> 5) & 7, tid); }
        h16x8 qf[4];
        { const GAS h16* qp = proj + (row0 + wave * 32 + r32) * INW + PQ + h * 64 + 8 * hi;
#pragma unroll
          for (int ks = 0; ks < 4; ++ks) qf[ks] = *(const GAS h16x8*)(qp + 16 * ks); }
        __syncthreads();
        f32x16 o[2]; float m, lsum;
        attn_tile_causal(lds + AL_K, lds + AL_V, qf, wave, lane, o, m, lsum);
        if (hi == 0) { wsf[32 + r32] = m; wsf[64 + r32] = lsum; }
        stage_o(stg, wsf, o, lsum, lane);
        const int nsel = qb < 3 ? qb : 3;
#pragma unroll
        for (int i0 = 0; i0 < 4; i0 += 2) {
            float mr[2][3], lr[2][3]; h16x8 pv[2][3];
#pragma unroll
            for (int ii = 0; ii < 2; ++ii) { const size_t grow = row0 + wave * 32 + (i0 + ii) * 8 + (lane >> 3);
#pragma unroll
                for (int r = 0; r < 3; ++r) { if (r < nsel) { const size_t sl = ((size_t)(b * NH + h) * 3 + r) * S + (grow - (size_t)b * S); mr[ii][r] = PML[sl * 2]; lr[ii][r] = PML[sl * 2 + 1]; pv[ii][r] = *(const GAS h16x8*)(PO + sl * 64 + (lane & 7) * 8); } } }
            asm volatile("" ::: "memory");
#pragma unroll
            for (int ii = 0; ii < 2; ++ii) {
                const int row = (i0 + ii) * 8 + (lane >> 3), ch = lane & 7;
                const size_t grow = row0 + wave * 32 + row;
                const float mo = wsf[32 + row], lo_ = wsf[64 + row];
                const h16x8 ov = *(const LAS h16x8*)(stg + row * 128 + ch * 16);
                float mmax = mo;
#pragma unroll
                for (int r = 0; r < 3; ++r) { if (r < nsel) mmax = fmaxf(mmax, mr[ii][r]); }
                float wo = lo_ * __builtin_amdgcn_exp2f(mo - mmax), L = wo;
                float acc[8];
#pragma unroll
                for (int e = 0; e < 8; ++e) acc[e] = wo * (float)ov[e];
#pragma unroll
                for (int r = 0; r < 3; ++r) { if (r < nsel) { const float wr_ = lr[ii][r] * __builtin_amdgcn_exp2f(mr[ii][r] - mmax); L += wr_;
#pragma unroll
                    for (int e = 0; e < 8; ++e) acc[e] += wr_ * (float)pv[ii][r][e]; } }
                const float rL = 1.f / L; float q = 0.f; u32x4 w;
#pragma unroll
                for (int e = 0; e < 8; ++e) { acc[e] *= rL; q += acc[e] * acc[e]; }
                w[0] = pkh(acc[0], acc[1]); w[1] = pkh(acc[2], acc[3]); w[2] = pkh(acc[4], acc[5]); w[3] = pkh(acc[6], acc[7]);
                if (shadow) *(GAS u32x4*)((GAS h16*)(F0.ws + WS_HG) + grow * 512 + h * 64 + ch * 8) = w;
                else *(GAS u32x4*)(proj + grow * INW + PQ + h * 64 + ch * 8) = w;
                q += __shfl_xor(q, 1); q += __shfl_xor(q, 2); q += __shfl_xor(q, 4);
                if (ch == 0) SSQA[grow * 8 + h] = q;
            }
        }
        __syncthreads();
    }
}


template <bool PART16, class Order> __device__ __forceinline__ void fill_rowscale(LAS float* tab, const Order& So, const GAS float* src, int maxu) {
    pg8::Unit uu;
    for (int i = 0; i < maxu && So.next(i, uu); ++i)
        if (threadIdx.x < 256) { const int row = uu.pm * 256 + (int)threadIdx.x; tab[i * 256 + threadIdx.x] = PART16 ? rs16(src + (size_t)row * 16) : src[row]; }
    __syncthreads();
}
constexpr int TAB_OFF = MISC_OFF + 128, TAB_MAXU = 15;
static_assert(TAB_OFF + TAB_MAXU * 1024 <= LDS_BYTES, "row-scale table");

enum Phase { PH_P0 = 0, PH_P1, PH_G1A, PH_G1B, PH_INPROJ, PH_MIX_A, PH_MIX_B, PH_MIX_C, PH_OUTPROJ, PH_G2A, PH_G2B, PH_FINAL, PH_COUNT };
__global__ void __launch_bounds__(NWAVES * 64, 2) mega_fwd(Args args) {
    extern __shared__ __attribute__((aligned(16))) unsigned char lds[];
    Frame F;
    F.lds = (LAS unsigned char*)lds; F.MISC = (volatile LAS unsigned*)(F.lds + MISC_OFF);
    F.tid = threadIdx.x; F.lane = F.tid & 63; F.wave = __builtin_amdgcn_readfirstlane(F.tid >> 6);
    F.G = gridDim.x; { const int bx = blockIdx.x; F.vcu = (F.G % 8 == 0) ? (bx % 8) * (F.G / 8) + bx / 8 : bx; }
    F.ws = args.ws; F.out = (GAS float*)args.out; F.ctl = (unsigned*)(args.ws + WS_CTL);
    for (int u = F.tid; u < (LDS_BYTES - LDSCTL_OFF) / 4; u += NWAVES * 64) ((LAS unsigned*)(F.lds + LDSCTL_OFF))[u] = 0u;
    __syncthreads();
    XcdBarrier bar; bar.bar = F.ctl + CW_BAR; bar.x = 0; bar.st = nullptr;
    const int lo = args.ph_lo, hi = args.ph_hi;
    if (hi - lo > 1) bar = xcd_barrier_post(F.ctl + CW_BAR, F.MISC + 8);
#ifndef MK_PHASE_MASK
#define MK_PHASE_MASK 0xFFFF
#endif
#define IN(k) (((MK_PHASE_MASK >> (k)) & 1) && lo <= (k) && (k) < hi)
#define SEAM(k) do { if (IN(k) && IN((k) + 1)) xcd_barrier(bar); } while (0)
#define PHASE_PTRS() unsigned char* ws = args.ws; asm volatile("" : "+s"(ws)); const GAS float* GT = (const GAS float*)(ws + WS_GT); const GAS float* GP = (const GAS float*)(ws + WS_GP); (void)GT; (void)GP; F.ws = ws
    if (IN(PH_P0)) { PHASE_PTRS(); p0_prologue(F, args); SEAM(PH_P0); }
    if (IN(PH_P1)) { PHASE_PTRS(); p1_prep(F, args); SEAM(PH_P1); }
    if (IN(PH_G1A)) {
        PHASE_PTRS();
        pg8::Gemm g{(const GAS h16*)(ws + WS_HG), (const GAS h16*)(ws + WS_WGU1), 0, NGU, D}; pg8::StaticOrder So; So.init(M, NGU, F.G, (int)blockIdx.x); const pg8::TableOrder To = pg8::make_table(So, (LAS int*)(F.lds + LDSCTL_OFF));
#if MK_SHADOW == 1
        if (args.ph_lo == PH_G1A && args.ph_hi == PH_G1A + 1 && args.shadow) { EpiNull En; pg8::gemm_phase<EpiNull, true, MK_GPROBE>(F.lds, g, So, En); return; }
#endif
        fill_rowscale<false>((LAS float*)(F.lds + TAB_OFF), To, (const GAS float*)(ws + WS_R1), TAB_MAXU);
        EpiSwiglu E{(GAS h16*)(ws + WS_ACT), (const LAS float*)(F.lds + TAB_OFF), (const GAS float*)(ws + WS_BIAS1)};
        pg8::gemm_phase<EpiSwiglu, true, 0, pg8::TableOrder>(F.lds, g, To, E); SEAM(PH_G1A);
    }
    if (IN(PH_G1B)) {
        PHASE_PTRS();
        pg8::Gemm g{(const GAS h16*)(ws + WS_ACT), (const GAS h16*)(ws + WS_WD1), 0, D, DFF, MK_STAG}; pg8::StaticOrder So; So.init(M, D, F.G, (int)blockIdx.x); const pg8::TableOrder To = pg8::make_table(So, (LAS int*)(F.lds + LDSCTL_OFF));
#if MK_SHADOW == 8
        if (args.ph_lo == PH_G1B && args.ph_hi == PH_G1B + 1 && args.shadow) {
#if MK_GPROBE == 0
            EpiNull En; pg8::gemm_phase<EpiNull, true>(F.lds, g, So, En);
#else
            EpiResid<true, false, true, MK_GPROBE> Ev{GIN(args, 0), (GAS h16*)(ws + WS_H), (GAS h16*)(ws + WS_HG), GT + 0 * 4 * D, GP + 1 * 4 * D, (GAS float*)(ws + WS_SSQ2), nullptr, 0.5f};
            pg8::gemm_phase<EpiResid<true, false, true, MK_GPROBE>, true>(F.lds, g, So, Ev);
#endif
            return; }
#endif
        EpiResid<true, false, true> E{GIN(args, 0), (GAS h16*)(ws + WS_H), (GAS h16*)(ws + WS_HG), GT + 0 * 4 * D, GP + 1 * 4 * D, (GAS float*)(ws + WS_SSQ2), nullptr, 0.5f};
        pg8::gemm_phase<EpiResid<true, false, true>, true, 0, pg8::TableOrder>(F.lds, g, To, E); SEAM(PH_G1B);
    }
    if (IN(PH_INPROJ)) {
        PHASE_PTRS();
        pg8::Gemm g{(const GAS h16*)(ws + WS_HG), (const GAS h16*)(ws + WS_WIN), 0, INW, D}; pg8::StaticOrder So; So.init(M, INW, F.G, (int)blockIdx.x); const pg8::TableOrder To = pg8::make_table(So, (LAS int*)(F.lds + LDSCTL_OFF));
        fill_rowscale<true>((LAS float*)(F.lds + TAB_OFF), To, (const GAS float*)(ws + WS_SSQ2), TAB_MAXU);
        EpiInproj E{(GAS h16*)(ws + WS_PROJ), (const LAS float*)(F.lds + TAB_OFF), (const GAS float*)(ws + WS_BIAS2), (const GAS float*)(ws + WS_ROPE), (GAS float*)(ws + WS_KMP)};
        pg8::gemm_phase<EpiInproj, true, 0, pg8::TableOrder>(F.lds, g, To, E); SEAM(PH_INPROJ);
    }
    if (IN(PH_MIX_A)) { PHASE_PTRS(); if (!(args.shadow & 2)) gmlp_phase(F, args, args.shadow & 1); if (!(args.shadow & 4)) moba_gate_phase(F, args.shadow & 1); SEAM(PH_MIX_A); }
    if (IN(PH_MIX_B)) { PHASE_PTRS(); moba_b_phase(F, (GAS float*)args.out); SEAM(PH_MIX_B); }
    if (IN(PH_MIX_C)) { PHASE_PTRS(); moba_c_phase(F, (const GAS float*)args.out, args.shadow & 1); SEAM(PH_MIX_C); }
    if (IN(PH_OUTPROJ)) {
        PHASE_PTRS();
        pg8::Gemm g{(const GAS h16*)(ws + WS_PROJ), (const GAS h16*)(ws + WS_WOUT), INW, D, D}; pg8::StaticOrder So; So.init(M, D, F.G, (int)blockIdx.x); const pg8::TableOrder To = pg8::make_table(So, (LAS int*)(F.lds + LDSCTL_OFF));
        const LAS float* sct = (const LAS float*)(F.lds + MISC_OFF + 128);
        {   LAS float* t = (LAS float*)(F.lds + MISC_OFF + 128); const GAS float* ssqa = (const GAS float*)(ws + WS_SSQA); const GAS float* ssqg = (const GAS float*)(ws + WS_RG);
            pg8::Unit uu;
            for (int i = 0; i < 4 && To.next(i, uu); ++i)
                if (F.tid < 256) { const int row = uu.pm * 256 + F.tid; const f32x4 a = *(const GAS f32x4*)(ssqa + (size_t)row * 8), bq = *(const GAS f32x4*)(ssqa + (size_t)row * 8 + 4);
                    const float ra = rsqrtf((((a[0] + a[1]) + (a[2] + a[3])) + ((bq[0] + bq[1]) + (bq[2] + bq[3]))) * (1.f / 512.f) + EPS), rg = rsqrtf(ssqg[row] * (1.f / 512.f) + EPS);
                    t[i * 512 + F.tid] = ra / rg; t[i * 512 + 256 + F.tid] = rg; }
            __syncthreads(); }
        EpiResid<false, true, true> E{nullptr, (GAS h16*)(ws + WS_H), (GAS h16*)(ws + WS_HG), GT + 1 * 4 * D, GP + 2 * 4 * D, (GAS float*)(ws + WS_SSQ3), sct, 1.0f};
        pg8::gemm_phase<EpiResid<false, true, true>, true, 0, pg8::TableOrder>(F.lds, g, To, E); SEAM(PH_OUTPROJ);
    }
    if (IN(PH_G2A)) {
        PHASE_PTRS();
        pg8::Gemm g{(const GAS h16*)(ws + WS_HG), (const GAS h16*)(ws + WS_WGU2), 0, NGU, D}; pg8::StaticOrder So; So.init(M, NGU, F.G, (int)blockIdx.x); const pg8::TableOrder To = pg8::make_table(So, (LAS int*)(F.lds + LDSCTL_OFF));
        fill_rowscale<true>((LAS float*)(F.lds + TAB_OFF), To, (const GAS float*)(ws + WS_SSQ3), TAB_MAXU);
        EpiSwiglu E{(GAS h16*)(ws + WS_ACT), (const LAS float*)(F.lds + TAB_OFF), (const GAS float*)(ws + WS_BIAS3)};
        pg8::gemm_phase<EpiSwiglu, true, 0, pg8::TableOrder>(F.lds, g, To, E); SEAM(PH_G2A);
    }
    if (IN(PH_G2B)) {
        PHASE_PTRS();
        pg8::Gemm g{(const GAS h16*)(ws + WS_ACT), (const GAS h16*)(ws + WS_WD2), 0, D, DFF}; pg8::StaticOrder So; So.init(M, D, F.G, (int)blockIdx.x); const pg8::TableOrder To = pg8::make_table(So, (LAS int*)(F.lds + LDSCTL_OFF));
#if MK_FUSE_FINAL
        EpiFinal E{(const GAS h16*)(ws + WS_H), GT + 2 * 4 * D, GIN(args, 19), (GAS float*)args.out, (unsigned*)(ws + WS_SSQF), F.ctl + CW_PAN, F.ctl + CW_TMO,
                   (LAS float*)(F.lds + MISC_OFF + 128), (LAS float*)(F.lds + MISC_OFF + 128 + 4096), 0.5f};
        pg8::gemm_phase<EpiFinal, true, 0, pg8::TableOrder>(F.lds, g, To, E);
#else
        EpiResid<false, false, false> E{nullptr, (GAS h16*)(ws + WS_H), nullptr, GT + 2 * 4 * D, nullptr, (GAS float*)(ws + WS_SSQF), nullptr, 0.5f};
        pg8::gemm_phase<EpiResid<false, false, false>, true, 0, pg8::TableOrder>(F.lds, g, To, E); SEAM(PH_G2B);
#endif
    }
#if !MK_FUSE_FINAL
    if (IN(PH_FINAL)) { PHASE_PTRS(); p_final(F, args); }
#endif
#undef IN
#undef SEAM
}

extern "C" void kernel_launch(void* const* d_in, const int* in_sizes, int n_in, void* d_out, int out_size, void* d_ws, size_t ws_size, hipStream_t stream) {
    static int grid = 0;
    if (grid == 0) {
        if (n_in != 20 || out_size != M * D || ws_size < WS_END) { fprintf(stderr, "kernel_launch: unexpected shapes (n_in %d out %d ws %zu)\n", n_in, out_size, ws_size); grid = -1; return; }
        int dev = 0, cus = 0, per_cu = 0;
        hipGetDevice(&dev); hipDeviceGetAttribute(&cus, hipDeviceAttributeMultiprocessorCount, dev);
        if (hipFuncSetAttribute((const void*)mega_fwd, hipFuncAttributeMaxDynamicSharedMemorySize, LDS_BYTES) != hipSuccess) { fprintf(stderr, "kernel_launch: hipFuncSetAttribute failed\n"); grid = -1; return; }
        hipOccupancyMaxActiveBlocksPerMultiprocessor(&per_cu, (const void*)mega_fwd, NWAVES * 64, LDS_BYTES);
        (void)hipGetLastError();
        if (per_cu < 1) { fprintf(stderr, "kernel_launch: occupancy query says %d blocks/CU; nothing launched\n", per_cu); grid = -1; return; }
        grid = cus;
    }
    if (grid < 0) return;
    hipMemsetAsync((char*)d_ws + WS_CTL, 0, CTL_ZERO_BYTES, stream);
    Args a{};
    for (int i = 0; i < 20; ++i) a.in[i] = (const float*)d_in[i];
    a.out = (float*)d_out; a.ws = (unsigned char*)d_ws;
    unsigned char* ws = (unsigned char*)d_ws;
    auto run = [&](int lo, int hi) {
#if MK_PER_PHASE
        for (int p = lo; p < hi; ++p) {
            if (MK_SHADOW == 2 && p == PH_MIX_A) { a.ph_lo = p; a.ph_hi = p + 1; a.shadow = 1 | 4; hipLaunchKernelGGL(mega_fwd, dim3(grid), dim3(NWAVES * 64), LDS_BYTES, stream, a); a.shadow = 0; }
            if (MK_SHADOW == 3 && p == PH_MIX_A) { a.ph_lo = p; a.ph_hi = p + 1; a.shadow = 1 | 2; hipLaunchKernelGGL(mega_fwd, dim3(grid), dim3(NWAVES * 64), LDS_BYTES, stream, a); a.shadow = 0; }
            if (MK_SHADOW == 4 && p == PH_MIX_C) { a.ph_lo = p; a.ph_hi = p + 1; a.shadow = 1; hipLaunchKernelGGL(mega_fwd, dim3(grid), dim3(NWAVES * 64), LDS_BYTES, stream, a); a.shadow = 0; }
            if (MK_SHADOW == 8 && p == PH_G1B) { a.ph_lo = p; a.ph_hi = p + 1; a.shadow = 1; hipLaunchKernelGGL(mega_fwd, dim3(grid), dim3(NWAVES * 64), LDS_BYTES, stream, a); a.shadow = 0; }
            if (MK_SHADOW == 1 && p == PH_G1A) { a.ph_lo = p; a.ph_hi = p + 1; a.shadow = 1; hipLaunchKernelGGL(mega_fwd, dim3(grid), dim3(NWAVES * 64), LDS_BYTES, stream, a); a.shadow = 0; }
            for (int rep = 0; rep < ((((MK_DUP_MASK) >> p) & 1) ? 2 : 1); ++rep) { a.ph_lo = p; a.ph_hi = p + 1; hipLaunchKernelGGL(mega_fwd, dim3(grid), dim3(NWAVES * 64), LDS_BYTES, stream, a); }
        }
#else
        a.ph_lo = lo; a.ph_hi = hi;
        void* kargs[] = {(void*)&a};
        hipError_t e = hipLaunchCooperativeKernel((const void*)mega_fwd, dim3(grid), dim3(NWAVES * 64), kargs, LDS_BYTES, stream);
        if (e != hipSuccess) fprintf(stderr, "kernel_launch: cooperative launch failed: %s (grid %d)\n", hipGetErrorString(e), grid);
#endif
    };
    run(PH_P0, PH_COUNT);
}
```

```cpp
#include <hip/hip_runtime.h>
#include <cstdio>
#include <cstdint>

#ifndef MK_DUP_MASK
#define MK_DUP_MASK 0
#endif
#ifndef MK_GPROBE
#define MK_GPROBE 0
#endif
#ifndef MK_SHADOW
#define MK_SHADOW 0
#endif
#ifndef MK_FUSE_FINAL
#define MK_FUSE_FINAL 1
#endif
#ifndef MK_STAG
#define MK_STAG 0
#endif
#ifndef MK_NT
#define MK_NT 0x0
#endif
#ifndef MK_PER_PHASE
#define MK_PER_PHASE 0
#endif

#define GAS __attribute__((address_space(1)))
#define LAS __attribute__((address_space(3)))
typedef _Float16 h16;
typedef _Float16 h16x8 __attribute__((ext_vector_type(8)));
typedef _Float16 h16x4 __attribute__((ext_vector_type(4)));
typedef _Float16 h16x2 __attribute__((ext_vector_type(2)));
typedef float f32x4 __attribute__((ext_vector_type(4)));
typedef float f32x2 __attribute__((ext_vector_type(2)));
typedef unsigned u32x4 __attribute__((ext_vector_type(4)));
typedef unsigned u32x2 __attribute__((ext_vector_type(2)));

constexpr int D = 1024, NB = 4, S = 8192, M = NB * S, DFF = 2816, NGU = 2 * DFF, NMOD = 9;
constexpr int AW = 512, HD = 64, NH = 8, INW = 2560, MBLK = 256, NBLK = S / MBLK, GC = 128;
constexpr float EPS = 1e-6f;
constexpr float C2 = 0.125f * 1.4426950408889634f;
constexpr int PQ = 0, PU = 512, PK = 1024, PV = 1536, PG = 2048;

constexpr size_t MiB = 1u << 20, KiB = 1u << 10;
constexpr size_t WS_CTL = 0, CTL_ZERO_BYTES = 1 * MiB;
constexpr size_t WS_MODP = 1 * MiB;
constexpr size_t WS_GT = 2 * MiB, WS_GP = WS_GT + 64 * KiB;
constexpr size_t WS_BIAS1 = WS_GT + 128 * KiB, WS_BIAS2 = WS_GT + 256 * KiB, WS_BIAS3 = WS_GT + 320 * KiB;
constexpr size_t WS_R1 = 3 * MiB, WS_RG = WS_R1 + 128 * KiB;
constexpr size_t WS_SSQA = 4 * MiB;
constexpr size_t WS_SSQ2 = 5 * MiB, WS_SSQ3 = 7 * MiB, WS_SSQF = 9 * MiB;
constexpr size_t WS_KMP = 11 * MiB;
constexpr size_t WS_ROPE = 12 * MiB;
constexpr size_t WS_WS16 = 14 * MiB;
constexpr size_t WS_WGU1 = 16 * MiB, WS_WD1 = 27 * MiB, WS_WIN = 33 * MiB, WS_WOUT = 38 * MiB, WS_WGU2 = 40 * MiB, WS_WD2 = 51 * MiB;
constexpr size_t WS_HG = 64 * MiB, WS_H = 128 * MiB, WS_ACT = 192 * MiB, WS_PROJ = WS_ACT;
constexpr size_t WS_LISTS = 368 * MiB, WS_END = 384 * MiB;
static_assert(WS_WD2 + (size_t)D * DFF * 2 <= WS_HG && WS_ACT + (size_t)M * DFF * 2 <= WS_LISTS, "ws map");
constexpr int CW_TMO = 0, CW_BAR = 4096;

constexpr int RING_BYTES = 131072, LDSCTL_OFF = RING_BYTES, MISC_OFF = LDSCTL_OFF + 320, LDS_BYTES = 147456;
constexpr int NWAVES = 8;

#define LDS_WAIT() asm volatile("s_waitcnt lgkmcnt(0)" ::: "memory")
#define VM_WAIT() asm volatile("s_waitcnt vmcnt(0)" ::: "memory")

__device__ __forceinline__ float wave_sum(float v) {
#pragma unroll
    for (int o = 1; o < 64; o <<= 1) v += __shfl_xor(v, o);
    return v;
}
template <int SEL, class T> __device__ __forceinline__ void st_stream(GAS T* p, const T& v) { if ((MK_NT >> SEL) & 1) __builtin_nontemporal_store(v, p); else *p = v; }
__device__ __forceinline__ unsigned pkh(float lo, float hi) { h16x2 v; v.x = (h16)lo; v.y = (h16)hi; return __builtin_bit_cast(unsigned, v); }
__device__ __forceinline__ float silu_fast(float x) { return x * __builtin_amdgcn_rcpf(1.f + __builtin_amdgcn_exp2f(-1.4426950408889634f * x)); }
__device__ __forceinline__ float gelu_fast(float x) {
    const float u2 = 1.5957691216057308f * (x + 0.044715f * x * x * x);
    return x * __builtin_amdgcn_rcpf(1.f + __builtin_amdgcn_exp2f(-1.4426950408889634f * u2));
}
__device__ __forceinline__ float rs16(const GAS float* p) {
    const f32x4 s0 = *(const GAS f32x4*)(p), s1 = *(const GAS f32x4*)(p + 4), s2 = *(const GAS f32x4*)(p + 8), s3 = *(const GAS f32x4*)(p + 12);
    const f32x4 st = (s0 + s1) + (s2 + s3);
    return rsqrtf(((st[0] + st[1]) + (st[2] + st[3])) * (1.f / D) + EPS);
}


__device__ __forceinline__ size_t blk_off(int row, int k, int nt) { return (((size_t)(row >> 8) * nt + (k >> 6)) * 256 + (row & 255)) * 64 + (k & 63); }

namespace pg8 {
constexpr int BM = 256, BK = 64, HALF = 128, HTB = HALF * BK * 2, STAGE_BYTES = 8 * HTB, NXCD = 8, WGM = 8;
__host__ __device__ __forceinline__ int lds_byte(int r, int c) { const int st = (r >> 4) * 2 + (c >> 5), rr = r & 15, cc = c & 31, ob = rr * 64 + cc * 2; return st * 1024 + (ob ^ (((ob >> 9) & 1) << 5)); }
__host__ __device__ __forceinline__ void stage_rc(int b, int& R, int& C) { const int st = b / 1024, sb = b % 1024, swz = sb ^ (((sb >> 9) & 1) << 5); R = (st >> 1) * 16 + swz / 64; C = (st & 1) * 32 + (swz % 64) / 2; }
struct Unit { int pm, pn; };
struct Gemm { const GAS h16* A; const GAS h16* Bt; int lda, N, K; unsigned stag = 0; };
struct StaticOrder {
    int nM, nN, nwg, G, c;
    __device__ __forceinline__ void init(int M_, int N, int G_, int c_) { nM = M_ / BM; nN = N / BM; nwg = nM * nN; G = G_; c = c_; }
    __device__ __forceinline__ bool next(int i, Unit& u) const {
        const long L = (long)i * G + c; if (L >= nwg) return false;
        int wgid = (int)L; { const int q = nwg / NXCD, r = nwg % NXCD, xcd = wgid % NXCD, off = wgid / NXCD; wgid = (xcd < r ? xcd * (q + 1) : r * (q + 1) + (xcd - r) * q) + off; }
        const int nig = WGM * nN, gid = wgid / nig, fm = gid * WGM, gsz = (nM - fm) < WGM ? (nM - fm) : WGM;
        u.pm = fm + ((wgid % nig) % gsz); u.pn = (wgid % nig) / gsz; return true;
    }
};
struct TableOrder {
    const LAS int* tab; int n;
    __device__ __forceinline__ bool next(int i, Unit& u) const { if (i >= n) return false; u.pm = tab[2 * i]; u.pn = tab[2 * i + 1]; return true; }
};
__device__ __forceinline__ TableOrder make_table(const StaticOrder& So, LAS int* tab) {
    if (threadIdx.x < 16) { Unit u; u.pm = -1; u.pn = 0; const bool ok = So.next((int)threadIdx.x, u); tab[2 * threadIdx.x] = ok ? u.pm : -1; tab[2 * threadIdx.x + 1] = u.pn; }
    __syncthreads();
    int n = 0;
    while (n < 16 && tab[2 * n] >= 0) ++n;
    TableOrder T; T.tab = tab; T.n = __builtin_amdgcn_readfirstlane(n); return T;
}
template <class Epi, bool ALIGN_EPI, int PROBE = 0, class Order = StaticOrder>
__device__ __forceinline__ void gemm_phase(LAS unsigned char* lds, const Gemm g, const Order& S, const Epi& E) {
    const int tid = threadIdx.x, wid = __builtin_amdgcn_readfirstlane(tid >> 6), lane = tid & 63, wr = wid >> 2, wc = wid & 3, fr = lane & 15, fq = lane >> 4;
    const int K = g.K, nt = K / BK;
    unsigned voffA[2], voffB[2];
    const bool ablk = (g.lda == 0);
#pragma unroll
    for (int i = 0; i < 2; ++i) { int R, C; stage_rc(tid * 16 + i * 8192, R, C); voffA[i] = (unsigned)(R * (ablk ? BK : g.lda) + C) * 2u; voffB[i] = (unsigned)(R * BK + C) * 2u; }
    const size_t kstepB = (size_t)BM * BK * 2, kstepA = ablk ? kstepB : (size_t)(BK * 2);
    const size_t hstepB = (size_t)HALF * BK * 2, hstepA = ablk ? hstepB : (size_t)HALF * g.lda * 2;
    const size_t tstepB = (size_t)nt * kstepB, tstepA = ablk ? tstepB : 2 * hstepA;
    const unsigned ldsw = (unsigned)wid * 1024u;
    const int aoff = lds_byte(wr * 64 + fr, fq * 8), boff = lds_byte(wc * 32 + fr, fq * 8);
#define PG8_SA(b, h) (((b) * 2 + (h)) * HTB)
#define PG8_SB(b, h) ((4 + (b) * 2 + (h)) * HTB)
#define PG8_STAGE(bufoff, gbase, voff) do { if (PROBE != 2) _Pragma("unroll") for (int _i = 0; _i < 2; ++_i) \
        __builtin_amdgcn_global_load_lds((const unsigned*)((const char*)(gbase) + (voff)[_i]), (LAS unsigned*)(lds + (bufoff) + ldsw + _i * 8192), 16, 0, 0); } while (0)
#define PG8_LDA(dst, b, h) do { _Pragma("unroll") for (int m = 0; m < 4; ++m) _Pragma("unroll") for (int k = 0; k < 2; ++k) dst[m][k] = *(const LAS h16x8*)(lds + PG8_SA(b, h) + aoff + m * 2048 + k * 1024); } while (0)
#define PG8_LDB(dst, b, h) do { _Pragma("unroll") for (int n = 0; n < 2; ++n) _Pragma("unroll") for (int k = 0; k < 2; ++k) dst[n][k] = *(const LAS h16x8*)(lds + PG8_SB(b, h) + boff + n * 2048 + k * 1024); } while (0)
#define PG8_MMA(ai, bj, At, Bt) do { if (PROBE == 1 && (bj) == 1) break; __builtin_amdgcn_s_setprio(1); _Pragma("unroll") for (int m = 0; m < 4; ++m) _Pragma("unroll") for (int n = 0; n < 2; ++n) _Pragma("unroll") for (int k = 0; k < 2; ++k) \
        acc[ai][bj][m][n] = __builtin_amdgcn_mfma_f32_16x16x32_f16(Bt[n][k], At[m][k], acc[ai][bj][m][n], 0, 0, 0); __builtin_amdgcn_s_setprio(0); } while (0)
#define PG8_WAIT_V(n) asm volatile("s_waitcnt vmcnt(" #n ")" ::: "memory")
#define PG8_WAIT_L(n) asm volatile("s_waitcnt lgkmcnt(" #n ")" ::: "memory")
#define PG8_BAR __builtin_amdgcn_s_barrier()
#define PG8_SCHED __builtin_amdgcn_sched_barrier(0)
    Unit cur, nxt; int ui = 0;
    if (!S.next(0, cur)) return;
    if (g.stag) { const unsigned st = (unsigned)(cur.pm & 7); if (st) { const unsigned long long t0 = __builtin_amdgcn_s_memrealtime(), dl = (unsigned long long)st * g.stag; while (__builtin_amdgcn_s_memrealtime() - t0 < dl) __builtin_amdgcn_s_sleep(4); } }
    f32x4 acc[2][2][4][2];
#pragma unroll
    for (int a = 0; a < 2; ++a)
#pragma unroll
        for (int b = 0; b < 2; ++b)
#pragma unroll
            for (int m = 0; m < 4; ++m)
#pragma unroll
                for (int n = 0; n < 2; ++n) acc[a][b][m][n] = (f32x4){0.f, 0.f, 0.f, 0.f};
    h16x8 At[4][2], B0[2][2], B1[2][2];
    const char* cA = (const char*)g.A + (size_t)cur.pm * tstepA; const char* cB = (const char*)g.Bt + (size_t)cur.pn * tstepB;
    PG8_STAGE(PG8_SB(0, 0), cB, voffB); PG8_STAGE(PG8_SB(0, 1), cB + hstepB, voffB); PG8_STAGE(PG8_SA(0, 0), cA, voffA); PG8_STAGE(PG8_SA(0, 1), cA + hstepA, voffA);
    if (wr == 1) PG8_BAR;
    PG8_WAIT_V(2); PG8_BAR;
    PG8_STAGE(PG8_SB(1, 0), cB + kstepB, voffB); PG8_STAGE(PG8_SA(1, 0), cA + kstepA, voffA); PG8_STAGE(PG8_SB(1, 1), cB + hstepB + kstepB, voffB);
    PG8_WAIT_V(6); PG8_BAR;
    for (;;) {
        const bool has_next = S.next(ui + 1, nxt);
        const char* nA = has_next ? (const char*)g.A + (size_t)nxt.pm * tstepA : cA; const char* nB = has_next ? (const char*)g.Bt + (size_t)nxt.pn * tstepB : cB;
        for (int t = 0; t < nt; t += 2) {
            const bool last = (t == nt - 2);
            const char* a1 = cA + (size_t)(t + 1) * kstepA;
            const char* a2 = last ? nA : cA + (size_t)(t + 2) * kstepA; const char* b2 = last ? nB : cB + (size_t)(t + 2) * kstepB;
            const char* a3 = a2 + kstepA; const char* b3 = b2 + kstepB;
            if constexpr (Epi::MID) { if (t == nt / 2) E.mid(acc, cur, ui, wr, wc, fr, fq); }
            PG8_LDB(B0, 0, 0); PG8_LDB(B1, 0, 1); PG8_SCHED; PG8_LDA(At, 0, 0); PG8_STAGE(PG8_SA(1, 1), a1 + hstepA, voffA);
            PG8_WAIT_V(8); PG8_WAIT_L(0); PG8_BAR; PG8_MMA(0, 0, At, B0); PG8_MMA(0, 1, At, B1); PG8_BAR; PG8_SCHED;
            PG8_LDA(At, 0, 1); PG8_STAGE(PG8_SB(0, 0), b2, voffB); PG8_STAGE(PG8_SB(0, 1), b2 + hstepB, voffB); PG8_STAGE(PG8_SA(0, 0), a2, voffA);
            PG8_WAIT_V(8); PG8_WAIT_L(0); PG8_BAR; PG8_MMA(1, 0, At, B0); PG8_MMA(1, 1, At, B1); PG8_BAR; PG8_SCHED;
            PG8_LDB(B0, 1, 0); PG8_LDB(B1, 1, 1); PG8_SCHED; PG8_LDA(At, 1, 0); PG8_STAGE(PG8_SA(0, 1), a2 + hstepA, voffA);
            PG8_WAIT_V(8); PG8_WAIT_L(0); PG8_BAR; PG8_MMA(0, 0, At, B0); PG8_MMA(0, 1, At, B1); PG8_BAR; PG8_SCHED;
            PG8_LDA(At, 1, 1); PG8_STAGE(PG8_SB(1, 0), b3, voffB); PG8_STAGE(PG8_SB(1, 1), b3 + hstepB, voffB); PG8_STAGE(PG8_SA(1, 0), a3, voffA);
            PG8_WAIT_V(8); PG8_WAIT_L(0); PG8_BAR; PG8_MMA(1, 0, At, B0); PG8_MMA(1, 1, At, B1); PG8_BAR; PG8_SCHED;
        }
        if constexpr (ALIGN_EPI) { if (wr == 0) PG8_BAR; }
        E(acc, cur, ui, wr, wc, fr, fq);
        if (!has_next) break;
#pragma unroll
        for (int a = 0; a < 2; ++a)
#pragma unroll
            for (int b = 0; b < 2; ++b)
#pragma unroll
                for (int m = 0; m < 4; ++m)
#pragma unroll
                    for (int n = 0; n < 2; ++n) acc[a][b][m][n] = (f32x4){0.f, 0.f, 0.f, 0.f};
        cur = nxt; cA = nA; cB = nB; ++ui;
        if constexpr (ALIGN_EPI) { if (wr == 1) PG8_BAR; }
    }
    PG8_WAIT_V(0);
    if constexpr (!ALIGN_EPI) { if (wr == 0) PG8_BAR; }
    PG8_BAR;
#undef PG8_SA
#undef PG8_SB
#undef PG8_STAGE
#undef PG8_LDA
#undef PG8_LDB
#undef PG8_MMA
#undef PG8_WAIT_V
#undef PG8_WAIT_L
#undef PG8_BAR
#undef PG8_SCHED
}
}

typedef const f32x4 (&AccRef)[2][2][4][2];
struct EpiSwiglu {
    static constexpr bool MID = false;
    GAS h16* act; const LAS float* rtab; const GAS float* bias;
    __device__ __forceinline__ void mid(f32x4 (&)[2][2][4][2], const pg8::Unit&, int, int, int, int, int) const {}
    __device__ __forceinline__ void operator()(AccRef acc, const pg8::Unit& u, int ui, int wr, int wc, int fr, int fq) const {
        const int b = u.pm >> 5, row0 = u.pm * 256 + wr * 64 + fr;
        const GAS float* bp = bias + b * NGU + u.pn * 256 + wc * 32 + 4 * fq;
        f32x4 bv[2][2];
#pragma unroll
        for (int bj = 0; bj < 2; ++bj)
#pragma unroll
            for (int n = 0; n < 2; ++n) bv[bj][n] = *(const GAS f32x4*)(bp + bj * 128 + n * 16);
        const LAS float* rt = rtab + ui * 256 + wr * 64 + fr;
        const int hid0 = u.pn * 128 + wc * 32 + fq * 8;
#pragma unroll
        for (int ai = 0; ai < 2; ++ai)
#pragma unroll
            for (int m = 0; m < 4; ++m) {
                const int ro = ai * 128 + m * 16; const float rs = rt[ro];
                u32x4 w;
#pragma unroll
                for (int n = 0; n < 2; ++n) {
                    const f32x4 gv = acc[ai][0][m][n] * rs + bv[0][n], uv = acc[ai][1][m][n] * rs + bv[1][n];
                    const float a0 = silu_fast(gv[0]) * uv[0], a1 = silu_fast(gv[1]) * uv[1], a2 = silu_fast(gv[2]) * uv[2], a3 = silu_fast(gv[3]) * uv[3];
                    w[2 * n] = pkh(a0, a1); w[2 * n + 1] = pkh(a2, a3);
                }
                st_stream<3>((GAS u32x4*)(act + blk_off(row0 + ro, hid0, DFF / 64)), w);
            }
    }
};
struct EpiNull {
    static constexpr bool MID = false;
    __device__ __forceinline__ void mid(f32x4 (&)[2][2][4][2], const pg8::Unit&, int, int, int, int, int) const {}
    __device__ __forceinline__ void operator()(AccRef acc, const pg8::Unit& u, int ui, int wr, int wc, int fr, int fq) const {
#pragma unroll
        for (int ai = 0; ai < 2; ++ai)
#pragma unroll
            for (int bj = 0; bj < 2; ++bj)
#pragma unroll
                for (int m = 0; m < 4; ++m)
#pragma unroll
                    for (int n = 0; n < 2; ++n) asm volatile("" :: "v"(acc[ai][bj][m][n]));
    }
};
template <bool RES_F32, bool TWOSCALE, bool WRITE_HG, int PVAR = 0> struct EpiResid {
    static constexpr bool MID = TWOSCALE;
    const GAS float* xres; GAS h16* H; GAS h16* HG; const GAS float* cs; const GAS float* gp; GAS float* ssq; const LAS float* sct; float cmul;
    __device__ __forceinline__ void mid(f32x4 (&acc)[2][2][4][2], const pg8::Unit& u, int ui, int wr, int wc, int fr, int fq) const {
        if constexpr (TWOSCALE) {
            const LAS float* t = sct + ui * 512 + wr * 64 + fr;
#pragma unroll
            for (int ai = 0; ai < 2; ++ai)
#pragma unroll
                for (int m = 0; m < 4; ++m) { const float f = t[ai * 128 + m * 16];
#pragma unroll
                    for (int bj = 0; bj < 2; ++bj)
#pragma unroll
                        for (int n = 0; n < 2; ++n) acc[ai][bj][m][n] *= f; }
        }
    }
    __device__ __forceinline__ void operator()(AccRef acc, const pg8::Unit& u, int ui, int wr, int wc, int fr, int fq) const {
        const int b = u.pm >> 5, row0 = u.pm * 256 + wr * 64 + fr, col0 = u.pn * 256 + wc * 32 + 8 * fq;
        f32x4 csv[2][2], gpv[2][2];
#pragma unroll
        for (int bj = 0; bj < 2; ++bj)
#pragma unroll
            for (int n = 0; n < 2; ++n) { csv[bj][n] = *(const GAS f32x4*)(cs + b * D + col0 + bj * 128 + 4 * n) * cmul; if constexpr (WRITE_HG) gpv[bj][n] = *(const GAS f32x4*)(gp + b * D + col0 + bj * 128 + 4 * n); }
        constexpr int MB_ = RES_F32 ? 2 : 4;
#pragma unroll
        for (int ai = 0; ai < 2; ++ai)
#pragma unroll
        for (int m0 = 0; m0 < 4; m0 += MB_) {
            f32x4 rf[4][2][2]; h16x8 rh[4][2];
#pragma unroll
            for (int m = m0; m < m0 + MB_; ++m)
#pragma unroll
                for (int bj = 0; bj < 2; ++bj) { const size_t off = (size_t)(row0 + ai * 128 + m * 16) * D + col0 + bj * 128;
                    if constexpr (PVAR == 2 || PVAR == 6 || PVAR == 7) { rf[m][bj][0] = (f32x4){0.f, 0.f, 0.f, 0.f}; rf[m][bj][1] = rf[m][bj][0]; rh[m][bj] = (h16x8){0, 0, 0, 0, 0, 0, 0, 0}; }
                    else if constexpr (PVAR == 3) { const h16x8 t = *(const GAS h16x8*)(HG + blk_off(row0 + ai * 128 + m * 16, col0 + bj * 128, D / 64)); rf[m][bj][0] = (f32x4){(float)t[0], (float)t[1], (float)t[2], (float)t[3]}; rf[m][bj][1] = (f32x4){(float)t[4], (float)t[5], (float)t[6], (float)t[7]}; }
                    else if constexpr (RES_F32) { rf[m][bj][0] = *(const GAS f32x4*)(xres + off); rf[m][bj][1] = *(const GAS f32x4*)(xres + off + 4); }
                    else rh[m][bj] = *(const GAS h16x8*)(H + off); }
            asm volatile("" ::: "memory");
#pragma unroll
            for (int m = m0; m < m0 + MB_; ++m) {
                const int row = row0 + ai * 128 + m * 16; const size_t off = (size_t)row * D + col0;
                float rsc = 1.f; if constexpr (TWOSCALE) rsc = sct[ui * 512 + 256 + wr * 64 + fr + ai * 128 + m * 16];
                float q = 0.f;
#pragma unroll
                for (int bj = 0; bj < 2; ++bj) {
                    f32x4 r0, r1;
                    if constexpr (RES_F32) { r0 = rf[m][bj][0]; r1 = rf[m][bj][1]; }
                    else { const h16x8 hv = rh[m][bj]; r0 = (f32x4){(float)hv[0], (float)hv[1], (float)hv[2], (float)hv[3]}; r1 = (f32x4){(float)hv[4], (float)hv[5], (float)hv[6], (float)hv[7]}; }
                    const f32x4 v0 = r0 + csv[bj][0] * (acc[ai][bj][m][0] * rsc), v1 = r1 + csv[bj][1] * (acc[ai][bj][m][1] * rsc);
                    q += ((v0[0] * v0[0] + v0[1] * v0[1]) + (v0[2] * v0[2] + v0[3] * v0[3])) + ((v1[0] * v1[0] + v1[1] * v1[1]) + (v1[2] * v1[2] + v1[3] * v1[3]));
                    u32x4 w; w[0] = pkh(v0[0], v0[1]); w[1] = pkh(v0[2], v0[3]); w[2] = pkh(v1[0], v1[1]); w[3] = pkh(v1[2], v1[3]);
                    const int colp = u.pn * 256 + wc * 64 + 16 * fq + 8 * bj;
                    if constexpr (PVAR == 1) asm volatile("" :: "v"(w)); else if constexpr (PVAR == 4) *(GAS u32x4*)(H + blk_off(row, col0 + bj * 128, D / 64)) = w;
                    else if constexpr (PVAR == 5) *(GAS u32x4*)(H + (size_t)row * D + colp) = w; else if constexpr (PVAR == 7) __builtin_nontemporal_store(w, (GAS u32x4*)(H + off + bj * 128)); else st_stream<1>((GAS u32x4*)(H + off + bj * 128), w);
                    if constexpr (WRITE_HG) { const f32x4 g0 = v0 * gpv[bj][0], g1 = v1 * gpv[bj][1];
                        u32x4 wg; wg[0] = pkh(g0[0], g0[1]); wg[1] = pkh(g0[2], g0[3]); wg[2] = pkh(g1[0], g1[1]); wg[3] = pkh(g1[2], g1[3]);
                        if constexpr (PVAR == 1 || PVAR == 6) asm volatile("" :: "v"(wg)); else if constexpr (PVAR == 7) __builtin_nontemporal_store(wg, (GAS u32x4*)(HG + blk_off(row, col0 + bj * 128, D / 64))); else if constexpr (PVAR == 5) *(GAS u32x4*)(HG + blk_off(row, colp, D / 64)) = wg; else st_stream<2>((GAS u32x4*)(HG + blk_off(row, col0 + bj * 128, D / 64)), wg); }
                }
                q += __shfl_xor(q, 16); q += __shfl_xor(q, 32);
                if (fq == 0) { if constexpr (PVAR == 1) asm volatile("" :: "v"(q)); else ssq[(size_t)row * 16 + u.pn * 4 + wc] = q; }
            }
        }
    }
};
constexpr int CW_PAN = 16384;
struct EpiFinal {
    static constexpr bool MID = false;
    const GAS h16* H; const GAS float* cs; const GAS float* gfin; GAS float* out; unsigned* xs; unsigned* cnt; unsigned* tmo; LAS float* P; LAS float* Sx; float cmul;
    __device__ __forceinline__ void mid(f32x4 (&)[2][2][4][2], const pg8::Unit&, int, int, int, int, int) const {}
    __device__ __forceinline__ void operator()(f32x4 (&acc)[2][2][4][2], const pg8::Unit& u, int ui, int wr, int wc, int fr, int fq) const {
        const int b = u.pm >> 5, row0 = u.pm * 256 + wr * 64 + fr, col0 = u.pn * 256 + wc * 32 + 8 * fq;
        const int tid = threadIdx.x, lane = tid & 63, wid = __builtin_amdgcn_readfirstlane(tid >> 6);
        f32x4 csv[2][2];
#pragma unroll
        for (int bj = 0; bj < 2; ++bj)
#pragma unroll
            for (int n = 0; n < 2; ++n) csv[bj][n] = *(const GAS f32x4*)(cs + b * D + col0 + bj * 128 + 4 * n) * cmul;
#pragma unroll
        for (int ai = 0; ai < 2; ++ai) {
            h16x8 rh[4][2];
#pragma unroll
            for (int m = 0; m < 4; ++m)
#pragma unroll
                for (int bj = 0; bj < 2; ++bj) rh[m][bj] = *(const GAS h16x8*)(H + (size_t)(row0 + ai * 128 + m * 16) * D + col0 + bj * 128);
#pragma unroll
            for (int m = 0; m < 4; ++m) {
                float q = 0.f;
#pragma unroll
                for (int bj = 0; bj < 2; ++bj) { const h16x8 hv = rh[m][bj];
                    const f32x4 v0 = (f32x4){(float)hv[0], (float)hv[1], (float)hv[2], (float)hv[3]} + csv[bj][0] * acc[ai][bj][m][0], v1 = (f32x4){(float)hv[4], (float)hv[5], (float)hv[6], (float)hv[7]} + csv[bj][1] * acc[ai][bj][m][1];
                    acc[ai][bj][m][0] = v0; acc[ai][bj][m][1] = v1;
                    q += ((v0[0] * v0[0] + v0[1] * v0[1]) + (v0[2] * v0[2] + v0[3] * v0[3])) + ((v1[0] * v1[0] + v1[1] * v1[1]) + (v1[2] * v1[2] + v1[3] * v1[3])); }
                q += __shfl_xor(q, 16); q += __shfl_xor(q, 32);
                if (fq == 0) P[(ai * 128 + wr * 64 + m * 16 + fr) * 4 + wc] = q;
            }
        }
        asm volatile("s_waitcnt lgkmcnt(0)" ::: "memory"); __builtin_amdgcn_s_barrier(); asm volatile("" ::: "memory");
        if (tid < 256) {
            const f32x4 p4 = *(const LAS f32x4*)(P + tid * 4);
            __hip_atomic_store(xs + ((size_t)(u.pm * 256 + tid) * 4 + u.pn), __float_as_uint((p4[0] + p4[1]) + (p4[2] + p4[3])), __ATOMIC_RELAXED, __HIP_MEMORY_SCOPE_AGENT);
        }
        asm volatile("s_waitcnt vmcnt(0)" ::: "memory");
        if (wid < 4 && lane == 0) __hip_atomic_fetch_add(cnt + 64 * u.pm, 1u, __ATOMIC_RELAXED, __HIP_MEMORY_SCOPE_AGENT);
        if (wid == 0) {
            unsigned sp = 0u;
            while ((unsigned)__builtin_amdgcn_readfirstlane(__hip_atomic_load(cnt + 64 * u.pm, __ATOMIC_RELAXED, __HIP_MEMORY_SCOPE_AGENT)) < 16u) {
                __builtin_amdgcn_s_sleep(2);
                if (++sp > (1u << 16)) { if (lane == 0) __hip_atomic_store(tmo, 1u, __ATOMIC_RELAXED, __HIP_MEMORY_SCOPE_AGENT); break; }
            }
            __builtin_amdgcn_fence(__ATOMIC_ACQUIRE, "agent");
        }
        asm volatile("s_waitcnt vmcnt(0) lgkmcnt(0)" ::: "memory"); __builtin_amdgcn_s_barrier(); asm volatile("" ::: "memory");
        if (tid < 256) {
            const unsigned* sl = xs + (size_t)(u.pm * 256 + tid) * 4;
            const float s0 = __uint_as_float(__hip_atomic_load(sl + 0, __ATOMIC_RELAXED, __HIP_MEMORY_SCOPE_AGENT)), s1 = __uint_as_float(__hip_atomic_load(sl + 1, __ATOMIC_RELAXED, __HIP_MEMORY_SCOPE_AGENT)),
                        s2 = __uint_as_float(__hip_atomic_load(sl + 2, __ATOMIC_RELAXED, __HIP_MEMORY_SCOPE_AGENT)), s3 = __uint_as_float(__hip_atomic_load(sl + 3, __ATOMIC_RELAXED, __HIP_MEMORY_SCOPE_AGENT));
            Sx[tid] = rsqrtf(((s0 + s1) + (s2 + s3)) * (1.f / D) + EPS);
        }
        asm volatile("s_waitcnt vmcnt(0) lgkmcnt(0)" ::: "memory"); __builtin_amdgcn_s_barrier(); asm volatile("" ::: "memory");
        f32x4 gv[2][2];
#pragma unroll
        for (int bj = 0; bj < 2; ++bj)
#pragma unroll
            for (int n = 0; n < 2; ++n) gv[bj][n] = *(const GAS f32x4*)(gfin + col0 + bj * 128 + 4 * n);
#pragma unroll
        for (int ai = 0; ai < 2; ++ai)
#pragma unroll
            for (int m = 0; m < 4; ++m) { const int rl = ai * 128 + wr * 64 + m * 16 + fr; const float rs = Sx[rl]; GAS float* op = out + (size_t)(u.pm * 256 + rl) * D + col0;
#pragma unroll
                for (int bj = 0; bj < 2; ++bj) { st_stream<0>((GAS f32x4*)(op + bj * 128), acc[ai][bj][m][0] * rs * gv[bj][0]); st_stream<0>((GAS f32x4*)(op + bj * 128 + 4), acc[ai][bj][m][1] * rs * gv[bj][1]); } }
        asm volatile("s_waitcnt lgkmcnt(0)" ::: "memory"); __builtin_amdgcn_s_barrier(); asm volatile("" ::: "memory");
    }
};
struct EpiInproj {
    static constexpr bool MID = false;
    GAS h16* proj; const LAS float* rtab; const GAS float* bias; const GAS float* rope; GAS float* kmp;
    __device__ __forceinline__ void mid(f32x4 (&)[2][2][4][2], const pg8::Unit&, int, int, int, int, int) const {}
    __device__ __forceinline__ void operator()(AccRef acc, const pg8::Unit& u, int ui, int wr, int wc, int fr, int fq) const {
        const int b = u.pm >> 5, row0 = u.pm * 256 + wr * 64 + fr, region = u.pn >> 1;
        const GAS float* bp = bias + b * INW + u.pn * 256 + wc * 32 + 4 * fq;
        f32x4 bv[2][2];
#pragma unroll
        for (int bj = 0; bj < 2; ++bj)
#pragma unroll
            for (int n = 0; n < 2; ++n) bv[bj][n] = *(const GAS f32x4*)(bp + bj * 128 + n * 16);
        const bool is_rope = (region == 0) || (region == 2);
        f32x4 csum[2][2];
#pragma unroll
        for (int bj = 0; bj < 2; ++bj)
#pragma unroll
            for (int n = 0; n < 2; ++n) csum[bj][n] = (f32x4){0.f, 0.f, 0.f, 0.f};
        const LAS float* rt = rtab + ui * 256 + wr * 64 + fr;
#pragma unroll
        for (int ai = 0; ai < 2; ++ai)
#pragma unroll
        for (int m0 = 0; m0 < 4; m0 += 2) {
            f32x4 rcs[4][2], rsn[4][2];
            if (is_rope) {
#pragma unroll
                for (int m = m0; m < m0 + 2; ++m) { const GAS float* rp = rope + (size_t)((row0 + ai * 128 + m * 16) & (S - 1)) * 64 + 4 * fq;
#pragma unroll
                    for (int n = 0; n < 2; ++n) { rcs[m][n] = *(const GAS f32x4*)(rp + 16 * n); rsn[m][n] = *(const GAS f32x4*)(rp + 32 + 16 * n); } }
            }
            asm volatile("" ::: "memory");
#pragma unroll
            for (int m = m0; m < m0 + 2; ++m) {
                const int row = row0 + ai * 128 + m * 16;
                const float rs = rt[ai * 128 + m * 16];
                f32x4 v[2][2];
#pragma unroll
                for (int bj = 0; bj < 2; ++bj)
#pragma unroll
                    for (int n = 0; n < 2; ++n) v[bj][n] = acc[ai][bj][m][n] * rs + bv[bj][n];
                GAS h16* prow = proj + (size_t)row * INW + region * 512 + (u.pn & 1) * 256;
                if (is_rope) {
                    const float qs = (region == 0) ? C2 : 1.f;
#pragma unroll
                    for (int n = 0; n < 2; ++n) {
                        const f32x4 cs4 = rcs[m][n] * qs, sn4 = rsn[m][n] * qs;
                        const f32x4 x1 = v[0][n], x2 = v[1][n];
                        v[0][n] = x1 * cs4 - x2 * sn4; v[1][n] = x2 * cs4 + x1 * sn4;
                    }
                    GAS h16* hp = prow + wc * 64 + 16 * fq;
#pragma unroll
                    for (int bj = 0; bj < 2; ++bj) { u32x4 w; w[0] = pkh(v[bj][0][0], v[bj][0][1]); w[1] = pkh(v[bj][0][2], v[bj][0][3]); w[2] = pkh(v[bj][1][0], v[bj][1][1]); w[3] = pkh(v[bj][1][2], v[bj][1][3]);
                        st_stream<4>((GAS u32x4*)(hp + 8 * bj), w); }
                    if (region == 2) {
#pragma unroll
                        for (int bj = 0; bj < 2; ++bj)
#pragma unroll
                            for (int n = 0; n < 2; ++n) csum[bj][n] += v[bj][n];
                    }
                } else {
                    if (region == 1 || region == 4) {
#pragma unroll
                        for (int bj = 0; bj < 2; ++bj)
#pragma unroll
                            for (int n = 0; n < 2; ++n)
#pragma unroll
                                for (int j = 0; j < 4; ++j) v[bj][n][j] = gelu_fast(v[bj][n][j]);
                    }
                    GAS h16* hp = prow + wc * 32 + 8 * fq;
#pragma unroll
                    for (int bj = 0; bj < 2; ++bj) { u32x4 w; w[0] = pkh(v[bj][0][0], v[bj][0][1]); w[1] = pkh(v[bj][0][2], v[bj][0][3]); w[2] = pkh(v[bj][1][0], v[bj][1][1]); w[3] = pkh(v[bj][1][2], v[bj][1][3]);
                        st_stream<4>((GAS u32x4*)(hp + 128 * bj), w); }
                }
            }
        }
        if (region == 2) {
#pragma unroll
            for (int bj = 0; bj < 2; ++bj)
#pragma unroll
                for (int n = 0; n < 2; ++n)
#pragma unroll
                    for (int j = 0; j < 4; ++j) { float t = csum[bj][n][j]; t += __shfl_xor(t, 1); t += __shfl_xor(t, 2); t += __shfl_xor(t, 4); t += __shfl_xor(t, 8); csum[bj][n][j] = t; }
            if (fr == 0) {
                GAS float* kp = kmp + ((size_t)((b * NBLK + (u.pm & 31)) * 2 + wr)) * 512 + ((u.pn & 1) * 4 + wc) * 64 + 16 * fq;
#pragma unroll
                for (int bj = 0; bj < 2; ++bj)
#pragma unroll
                    for (int n = 0; n < 2; ++n) *(GAS f32x4*)(kp + 8 * bj + 4 * n) = csum[bj][n];
            }
        }
    }
};

#define XB_TMO      128
#define XB_XCNT(j)  (256  + 64 * (j))
#define XB_XSUB(j)  (1280 + 64 * (j))
#define XB_XGEN(j)  (2304 + 64 * (j))
#define XB_TOP      3328
#define XB_TOPGEN   3392
#define XCD_BAR_WORDS 3456
#define XB_SPIN_CAP (1u << 18)
__device__ __forceinline__ unsigned xb_ld(unsigned* p)              { return __hip_atomic_load(p, __ATOMIC_RELAXED, __HIP_MEMORY_SCOPE_AGENT); }
__device__ __forceinline__ unsigned xb_add(unsigned* p, unsigned v) { return __hip_atomic_fetch_add(p, v, __ATOMIC_RELAXED, __HIP_MEMORY_SCOPE_AGENT); }
__device__ __forceinline__ unsigned xb_xcc_id() { return (unsigned)__builtin_amdgcn_s_getreg((3 << 11) | 20) & 0xFu; }
#define XB_SPIN(cond, bar) do { unsigned _sp = 0; while (cond) { __builtin_amdgcn_s_sleep(1); \
    if ((++_sp & 255u) == 0u) { if (xb_ld(&(bar)[XB_TMO])) break; if (_sp > XB_SPIN_CAP) { atomicAdd(&(bar)[XB_TMO], 1u); break; } } } } while (0)
struct XcdBarrier { unsigned* bar; unsigned x; volatile LAS unsigned* st; };
__device__ __forceinline__ XcdBarrier xcd_barrier_post(unsigned* bar, volatile LAS unsigned* st) {
    XcdBarrier b; b.bar = bar; b.x = xb_xcc_id(); b.st = st;
    if (threadIdx.x == 0) (void)xb_add(&bar[XB_XCNT(b.x)], 1u);
    return b;
}
__device__ __forceinline__ void xcd_barrier_complete(unsigned* bar, unsigned x, unsigned& nloc, unsigned& nx) {
    const unsigned G = gridDim.x * gridDim.y * gridDim.z;
    unsigned sum, cnt, mine, sp = 0u;
    for (;;) {
        sum = 0u; cnt = 0u; mine = 0u;
#pragma unroll
        for (unsigned j = 0; j < 16; ++j) { const unsigned c = xb_ld(&bar[XB_XCNT(j)]); sum += c; cnt += (c > 0u) ? 1u : 0u; mine = (j == x) ? c : mine; }
        if (sum == G) break;
        __builtin_amdgcn_s_sleep(1);
        if ((++sp & 255u) == 0u) { if (xb_ld(&bar[XB_TMO])) break; if (sp > XB_SPIN_CAP) { atomicAdd(&bar[XB_TMO], 1u); break; } }
    }
    nloc = mine > 0u ? mine : 1u; nx = cnt > 0u ? cnt : 1u;
}
__device__ __forceinline__ void xcd_barrier(const XcdBarrier& b) {
    asm volatile("s_waitcnt vmcnt(0)" ::: "memory");
    __syncthreads();
    if (threadIdx.x == 0) {
        unsigned* bar = b.bar;
        __builtin_amdgcn_s_waitcnt(0);
        unsigned nloc = b.st[0], nx = b.st[1];
        if (nloc == 0u) { xcd_barrier_complete(bar, b.x, nloc, nx); b.st[0] = nloc; b.st[1] = nx; }
        const unsigned old = xb_add(&bar[XB_XSUB(b.x)], 1u);
        const unsigned gen = old / nloc;
        if (old + 1u == (gen + 1u) * nloc) {
            __builtin_amdgcn_fence(__ATOMIC_RELEASE, "agent");
            asm volatile("s_waitcnt vmcnt(0)" ::: "memory");
            const unsigned og = xb_add(&bar[XB_TOP], 1u);
            const unsigned tg = og / nx;
            if (og + 1u == (tg + 1u) * nx) xb_add(&bar[XB_TOPGEN], 1u);
            else XB_SPIN(xb_ld(&bar[XB_TOPGEN]) == tg, bar);
            __builtin_amdgcn_fence(__ATOMIC_ACQUIRE, "agent");
            xb_add(&bar[XB_XGEN(b.x)], 1u);
            asm volatile("s_waitcnt vmcnt(0)" ::: "memory");
        } else {
            XB_SPIN(xb_ld(&bar[XB_XGEN(b.x)]) == gen, bar);
            __builtin_amdgcn_fence(__ATOMIC_ACQUIRE, "agent");
            asm volatile("s_waitcnt vmcnt(0)" ::: "memory");
        }
    }
    __syncthreads();
}

#define GIN(a_, i_) ((const GAS float*)(a_).in[i_])
struct Args { const float* in[20]; float* out; unsigned char* ws; int ph_lo, ph_hi; int shadow, pad; };
struct Frame {
    LAS unsigned char* lds; volatile LAS unsigned* MISC; unsigned* ctl;
    int tid, lane, wave, vcu, G;
    unsigned char* ws; GAS float* out;
};

__device__ __forceinline__ int p8(int l) { return (l & ~31) + 16 * ((l >> 2) & 1) + 4 * ((l >> 3) & 3) + (l & 3); }
__device__ __forceinline__ int phys_gu(int L) { const int isu = L >= DFF, hid = isu ? L - DFF : L, pn = hid >> 7, hh = hid & 127; return 256 * pn + 128 * isu + p8(hh); }
__device__ __forceinline__ int phys_in(int L) {
    const int reg = L >> 9, l = L & 511;
    const int preg = reg == 0 ? 0 : reg == 1 ? 2 : reg == 2 ? 3 : reg == 3 ? 1 : 4;
    if (reg <= 1) { const int head = l >> 6, d = l & 63, bj = d >> 5, i = d & 31; return 512 * preg + 256 * (head >> 2) + 128 * bj + 32 * (head & 3) + i; }
    return 512 * preg + p8(l);
}
enum PhysKind { PH_GU = 0, PH_P8 = 1, PH_IN = 2 };
template <int KIND> __device__ __forceinline__ int physmap(int L) { return KIND == PH_GU ? phys_gu(L) : KIND == PH_P8 ? p8(L) : phys_in(L); }

template <int KIND> __device__ __forceinline__ void p0_transpose_item(const GAS float* W, int K, int N, GAS h16* WT, const GAS float* kscale, LAS float* scr, int item, int lane) {
    const int nblk = N / 32, kb = item / nblk, nb = item % nblk, k0 = 64 * kb, n0 = 32 * nb;
    float wv[32];
#pragma unroll
    for (int i = 0; i < 32; ++i) { const int kk = 2 * i + (lane >> 5); wv[i] = W[(size_t)(k0 + kk) * N + n0 + (lane & 31)]; }
    if (kscale) {
#pragma unroll
        for (int i = 0; i < 32; ++i) wv[i] *= kscale[k0 + 2 * i + (lane >> 5)]; }
#pragma unroll
    for (int i = 0; i < 32; ++i) scr[(2 * i + (lane >> 5)) * 33 + (lane & 31)] = wv[i];
    LDS_WAIT(); asm volatile("" ::: "memory");
    const int c = lane & 7;
#pragma unroll
    for (int j = 0; j < 4; ++j) { const int n = (lane >> 3) + 8 * j; const LAS float* s = scr + (8 * c) * 33 + n;
        u32x4 o; o.x = pkh(s[0 * 33], s[1 * 33]); o.y = pkh(s[2 * 33], s[3 * 33]); o.z = pkh(s[4 * 33], s[5 * 33]); o.w = pkh(s[6 * 33], s[7 * 33]);
        *(GAS u32x4*)(WT + blk_off(physmap<KIND>(n0 + n), k0 + 8 * c, K / 64)) = o; }
    LDS_WAIT(); asm volatile("" ::: "memory");
}

__device__ __forceinline__ void p0_prologue(const Frame& F0, const Args& a) {
    Frame F = F0; F.tid = threadIdx.x; F.lane = F.tid & 63; F.wave = __builtin_amdgcn_readfirstlane(F.tid >> 6);
    const GAS float* c = GIN(a, 1); const GAS float* w_ada = GIN(a, 2);
    {
        LAS float* red = (LAS float*)F.lds;
        for (int item = F.vcu; item < 72 * 4; item += F.G) {
            const int cg = item % 72, kq = item / 72, hlf = F.lane >> 5, col = cg * 128 + (F.lane & 31) * 4;
            f32x4 acc[4] = {{0.f, 0.f, 0.f, 0.f}, {0.f, 0.f, 0.f, 0.f}, {0.f, 0.f, 0.f, 0.f}, {0.f, 0.f, 0.f, 0.f}};
            const int kbase = kq * 256 + F.wave * 32 + hlf;
#pragma unroll
            for (int i = 0; i < 16; ++i) { const int k = kbase + 2 * i; const f32x4 w4 = *(const GAS f32x4*)(w_ada + (size_t)k * (NMOD * D) + col);
#pragma unroll
                for (int b = 0; b < 4; ++b) { const float cv = c[b * D + k]; const float sv = cv / (1.f + __expf(-cv)); acc[b] += w4 * sv; } }
#pragma unroll
            for (int b = 0; b < 4; ++b)
#pragma unroll
                for (int j = 0; j < 4; ++j) acc[b][j] += __shfl_xor(acc[b][j], 32);
            if (hlf == 0) {
#pragma unroll
                for (int b = 0; b < 4; ++b) *(LAS f32x4*)(red + (F.wave * 4 + b) * 128 + (F.lane & 31) * 4) = acc[b];
            }
            __syncthreads();
            { const int b = F.tid >> 7, cc = F.tid & 127; float s = 0.f;
#pragma unroll
              for (int w = 0; w < 8; ++w) s += red[(w * 4 + b) * 128 + cc];
              ((GAS float*)(F.ws + WS_MODP))[(size_t)(kq * 4 + b) * (NMOD * D) + cg * 128 + cc] = s; }
            __syncthreads();
        }
    }
    LAS float* scr = (LAS float*)(F.lds + F.wave * 16384);
    const int gw = F.vcu * NWAVES + F.wave, NGW = F.G * NWAVES;
    constexpr int I_GU = (D / 64) * (NGU / 32), I_DN = (DFF / 64) * (D / 32), I_IN = (D / 64) * (INW / 32), I_OUT = (D / 64) * (D / 32);
    constexpr int NITEMS = 2 * I_GU + 2 * I_DN + I_IN + I_OUT;
    for (int it = gw; it < NITEMS; it += NGW) {
        int r = it;
        if (r < I_GU) { p0_transpose_item<PH_GU>(GIN(a, 5), D, NGU, (GAS h16*)(F.ws + WS_WGU1), nullptr, scr, r, F.lane); continue; } r -= I_GU;
        if (r < I_GU) { p0_transpose_item<PH_GU>(GIN(a, 17), D, NGU, (GAS h16*)(F.ws + WS_WGU2), nullptr, scr, r, F.lane); continue; } r -= I_GU;
        if (r < I_DN) { p0_transpose_item<PH_P8>(GIN(a, 6), DFF, D, (GAS h16*)(F.ws + WS_WD1), nullptr, scr, r, F.lane); continue; } r -= I_DN;
        if (r < I_DN) { p0_transpose_item<PH_P8>(GIN(a, 18), DFF, D, (GAS h16*)(F.ws + WS_WD2), nullptr, scr, r, F.lane); continue; } r -= I_DN;
        if (r < I_IN) { p0_transpose_item<PH_IN>(GIN(a, 8), D, INW, (GAS h16*)(F.ws + WS_WIN), nullptr, scr, r, F.lane); continue; } r -= I_IN;
        {
            const int kb = r / (D / 32); const GAS float* ks = (kb < 8) ? GIN(a, 13) : (GIN(a, 14) - 512);
            p0_transpose_item<PH_P8>(GIN(a, 15), D, D, (GAS h16*)(F.ws + WS_WOUT), ks, scr, r, F.lane); }
    }
    for (int pos = gw; pos < S; pos += NGW) {
        const int i = F.lane & 31;
        const float inv = (float)exp(-(double)i / 32.0 * 9.210340371976184);
        const float ang = (float)pos * inv;
        const double da = (double)ang;
        ((GAS float*)(F.ws + WS_ROPE))[(size_t)pos * 64 + F.lane] = (F.lane < 32) ? (float)cos(da) : (float)sin(da);
    }
    for (int e = gw * 64 + F.lane; e < NH * GC * GC; e += NGW * 64) { const int t = (e >> 7) & 127, s = e & 127; ((GAS h16*)(F.ws + WS_WS16))[e] = (s <= t) ? (h16)GIN(a, 11)[e] : (h16)0.f; }
}

__device__ __forceinline__ void p1_prep(const Frame& F0, const Args& a) {
    Frame F = F0; F.tid = threadIdx.x; F.lane = F.tid & 63; F.wave = __builtin_amdgcn_readfirstlane(F.tid >> 6);
    LAS float* modl = (LAS float*)F.lds;
    const GAS float* modp = (const GAS float*)(F.ws + WS_MODP); const GAS float* b_ada = GIN(a, 3);
    const size_t st = (size_t)4 * NMOD * D;
    for (int e = F.tid; e < 4 * 6 * D; e += NWAVES * 64) {
        const int b = e / (6 * D), sl = (e / D) % 6, k = e % D; const int mi = (sl < 3) ? 3 * sl : 3 * (sl - 3) + 1;
        const size_t o = (size_t)b * (NMOD * D) + mi * D + k;
        modl[e] = ((modp[o] + modp[o + st]) + (modp[o + 2 * st] + modp[o + 3 * st])) + b_ada[mi * D + k];
    }
    __syncthreads();
    if (F.vcu == 0) {
        GAS float* GT = (GAS float*)(F.ws + WS_GT); GAS float* GP = (GAS float*)(F.ws + WS_GP);
        for (int e = F.tid; e < 3 * 4 * D; e += NWAVES * 64) {
            const int j = e / (4 * D), b = (e / D) % 4, k = e % D; const int mi = 3 * j + 2;
            const size_t o = (size_t)b * (NMOD * D) + mi * D + k;
            GT[e] = ((modp[o] + modp[o + st]) + (modp[o + 2 * st] + modp[o + 3 * st])) + b_ada[mi * D + k];
            const GAS float* g = j == 0 ? GIN(a, 4) : j == 1 ? GIN(a, 7) : GIN(a, 16);
            GP[e] = g[k] * (1.f + modl[(b * 6 + 3 + j) * D + k]);
        }
    }
    const GAS float* x = GIN(a, 0); const GAS float* g1 = GIN(a, 4);
    GAS h16* XG = (GAS h16*)(F.ws + WS_HG); GAS float* R1 = (GAS float*)(F.ws + WS_R1);
    for (int chunk = F.vcu; chunk < M / 128; chunk += F.G) {
        const int b = chunk / (S / 128);
        f32x4 scl[2][2];
#pragma unroll
        for (int j = 0; j < 2; ++j)
#pragma unroll
            for (int h = 0; h < 2; ++h) { const int k = 8 * F.lane + 512 * j + 4 * h; const f32x4 gg = *(const GAS f32x4*)(g1 + k); const LAS float* sc = modl + (b * 6 + 3) * D + k;
                scl[j][h] = gg * ((f32x4){1.f + sc[0], 1.f + sc[1], 1.f + sc[2], 1.f + sc[3]}); }
        for (int rb = 0; rb < 16; rb += 4) {
            f32x4 v[4][2][2]; float q[4];
#pragma unroll
            for (int r4 = 0; r4 < 4; ++r4) { const GAS float* xr = x + (size_t)(chunk * 128 + F.wave * 16 + rb + r4) * D + 8 * F.lane;
#pragma unroll
                for (int j = 0; j < 2; ++j) { v[r4][j][0] = *(const GAS f32x4*)(xr + 512 * j); v[r4][j][1] = *(const GAS f32x4*)(xr + 512 * j + 4); } }
            asm volatile("" ::: "memory");
#pragma unroll
            for (int r4 = 0; r4 < 4; ++r4) { float t = 0.f;
#pragma unroll
                for (int j = 0; j < 2; ++j)
#pragma unroll
                    for (int h = 0; h < 2; ++h) t += (v[r4][j][h][0] * v[r4][j][h][0] + v[r4][j][h][1] * v[r4][j][h][1]) + (v[r4][j][h][2] * v[r4][j][h][2] + v[r4][j][h][3] * v[r4][j][h][3]);
                q[r4] = t; }
#pragma unroll
            for (int o = 1; o < 64; o <<= 1)
#pragma unroll
                for (int r4 = 0; r4 < 4; ++r4) q[r4] += __shfl_xor(q[r4], o);
#pragma unroll
            for (int r4 = 0; r4 < 4; ++r4) {
                const int row = chunk * 128 + F.wave * 16 + rb + r4;
                if (F.lane == 0) R1[row] = rsqrtf(q[r4] * (1.f / D) + EPS);
#pragma unroll
                for (int j = 0; j < 2; ++j) { const int k = 8 * F.lane + 512 * j; u32x4 w;
#pragma unroll
                    for (int h = 0; h < 2; ++h) { const f32x4 o = v[r4][j][h] * scl[j][h]; w[2 * h] = pkh(o[0], o[1]); w[2 * h + 1] = pkh(o[2], o[3]); }
                    *(GAS u32x4*)(XG + blk_off(row, k, D / 64)) = w; }
            }
        }
    }
    const int gw = F.vcu * NWAVES + F.wave, NGW = F.G * NWAVES;
    for (int it = gw; it < NGU + INW + NGU; it += NGW) {
        int n = it, j; const GAS h16* W; GAS float* B; int NN;
        if (n < NGU) { j = 0; W = (const GAS h16*)(F.ws + WS_WGU1); B = (GAS float*)(F.ws + WS_BIAS1); NN = NGU; }
        else if (n < NGU + INW) { n -= NGU; j = 1; W = (const GAS h16*)(F.ws + WS_WIN); B = (GAS float*)(F.ws + WS_BIAS2); NN = INW; }
        else { n -= NGU + INW; j = 2; W = (const GAS h16*)(F.ws + WS_WGU2); B = (GAS float*)(F.ws + WS_BIAS3); NN = NGU; }
        const h16x8 w0 = *(const GAS h16x8*)(W + blk_off(n, 16 * F.lane, D / 64)), w1 = *(const GAS h16x8*)(W + blk_off(n, 16 * F.lane + 8, D / 64));
        float s[4];
#pragma unroll
        for (int b = 0; b < 4; ++b) { const LAS float* sh = modl + (b * 6 + j) * D + 16 * F.lane; float t = 0.f;
#pragma unroll
            for (int e = 0; e < 8; ++e) t += sh[e] * (float)w0[e] + sh[8 + e] * (float)w1[e];
            s[b] = wave_sum(t); }
        if (F.lane == 0) { B[0 * NN + n] = s[0]; B[1 * NN + n] = s[1]; B[2 * NN + n] = s[2]; B[3 * NN + n] = s[3]; }
    }
    __syncthreads();
}

__device__ __forceinline__ void p_final(const Frame& F0, const Args& a) {
    Frame F = F0; F.tid = threadIdx.x; F.lane = F.tid & 63; F.wave = __builtin_amdgcn_readfirstlane(F.tid >> 6);
    const GAS h16* H = (const GAS h16*)(F.ws + WS_H); const GAS float* ssq = (const GAS float*)(F.ws + WS_SSQF); const GAS float* gf = GIN(a, 19);
    const int gw = F.vcu * NWAVES + F.wave, NGW = F.G * NWAVES;
    f32x4 g[2][2];
#pragma unroll
    for (int j = 0; j < 2; ++j)
#pragma unroll
        for (int h = 0; h < 2; ++h) g[j][h] = *(const GAS f32x4*)(gf + 8 * F.lane + 512 * j + 4 * h);
    for (int row = gw; row < M; row += NGW) {
        const float rs = rs16(ssq + (size_t)row * 16);
#pragma unroll
        for (int j = 0; j < 2; ++j) { const h16x8 hv = *(const GAS h16x8*)(H + (size_t)row * D + 8 * F.lane + 512 * j);
            f32x4 o0 = (f32x4){(float)hv[0], (float)hv[1], (float)hv[2], (float)hv[3]} * rs * g[j][0], o1 = (f32x4){(float)hv[4], (float)hv[5], (float)hv[6], (float)hv[7]} * rs * g[j][1];
            *(GAS f32x4*)(a.out + (size_t)row * D + 8 * F.lane + 512 * j) = o0; *(GAS f32x4*)(a.out + (size_t)row * D + 8 * F.lane + 512 * j + 4) = o1; }
    }
}


typedef float f32x16 __attribute__((ext_vector_type(16)));
typedef short v4i16_t __attribute__((ext_vector_type(4)));
__device__ __forceinline__ h16x4 tr16(const LAS unsigned char* p) { return __builtin_bit_cast(h16x4, __builtin_amdgcn_ds_read_tr16_b64_v4i16((LAS v4i16_t*)p)); }
__device__ __forceinline__ int vt_off(int t, int c8) { return t * 128 + (((c8 >> 2) ^ ((t >> 1) & 1)) << 6) + ((c8 & 3) << 4); }

__device__ __forceinline__ void gmlp_phase(const Frame& F0, const Args& a, int shadow) {
    const int tid = threadIdx.x, lane = tid & 63, wave = __builtin_amdgcn_readfirstlane(tid >> 6), r32 = lane & 31, hi = lane >> 5;
    GAS h16* proj = (GAS h16*)(F0.ws + WS_PROJ); const GAS h16* W16 = (const GAS h16*)(F0.ws + WS_WS16); GAS float* RG = (GAS float*)(F0.ws + WS_RG);
    const GAS float* ln_g = GIN(a, 9); const GAS float* ln_b = GIN(a, 10); const GAS float* b_s = GIN(a, 12);
    LAS unsigned char* lds = F0.lds;
    LAS float* rowsq = (LAS float*)(lds + MISC_OFF + 128);
    f32x4 g0 = *(const GAS f32x4*)(ln_g + 8 * lane), g1 = *(const GAS f32x4*)(ln_g + 8 * lane + 4), b0 = *(const GAS f32x4*)(ln_b + 8 * lane), b1 = *(const GAS f32x4*)(ln_b + 8 * lane + 4);
    for (int unit = F0.vcu; unit < M / GC; unit += F0.G) {
        const size_t row0 = (size_t)unit * GC;
        {
            h16x8 hv[16]; float sm[16], mu[16], rsd[16];
#pragma unroll
            for (int rr = 0; rr < 16; ++rr) hv[rr] = *(const GAS h16x8*)(proj + (row0 + wave * 16 + rr) * INW + PG + 8 * lane);
#pragma unroll
            for (int rr = 0; rr < 16; ++rr) { float t = 0.f;
#pragma unroll
                for (int e = 0; e < 8; ++e) t += (float)hv[rr][e];
                sm[rr] = t; }
#pragma unroll
            for (int o = 1; o < 64; o <<= 1)
#pragma unroll
                for (int rr = 0; rr < 16; ++rr) sm[rr] += __shfl_xor(sm[rr], o);
#pragma unroll
            for (int rr = 0; rr < 16; ++rr) { mu[rr] = sm[rr] * (1.f / 512.f); float q = 0.f;
#pragma unroll
                for (int e = 0; e < 8; ++e) { const float d = (float)hv[rr][e] - mu[rr]; q += d * d; }
                sm[rr] = q; }
#pragma unroll
            for (int o = 1; o < 64; o <<= 1)
#pragma unroll
                for (int rr = 0; rr < 16; ++rr) sm[rr] += __shfl_xor(sm[rr], o);
#pragma unroll
            for (int rr = 0; rr < 16; ++rr) { rsd[rr] = rsqrtf(sm[rr] * (1.f / 512.f) + EPS);
                const int t = wave * 16 + rr; float v[8];
#pragma unroll
                for (int e = 0; e < 8; ++e) v[e] = ((float)hv[rr][e] - mu[rr]) * rsd[rr];
                u32x4 w; w[0] = pkh(v[0] * g0[0] + b0[0], v[1] * g0[1] + b0[1]); w[1] = pkh(v[2] * g0[2] + b0[2], v[3] * g0[3] + b0[3]);
                w[2] = pkh(v[4] * g1[0] + b1[0], v[5] * g1[1] + b1[1]); w[3] = pkh(v[6] * g1[2] + b1[2], v[7] * g1[3] + b1[3]);
                *(LAS u32x4*)(lds + (lane >> 3) * 16384 + vt_off(t, lane & 7)) = w; }
        }
        __syncthreads();
        const GAS h16* Wh = W16 + (size_t)wave * GC * GC;
        const LAS unsigned char* vt = lds + wave * 16384;
        const int q4 = (lane & 15) >> 2, p4 = lane & 3, g1b = (lane >> 4) & 1;
#pragma unroll
        for (int tb = 0; tb < 4; ++tb) {
            f32x16 acc[2];
#pragma unroll
            for (int d0 = 0; d0 < 2; ++d0)
#pragma unroll
                for (int e = 0; e < 16; ++e) acc[d0][e] = 0.f;
            h16x8 af[8];
#pragma unroll
            for (int ks = 0; ks < 8; ++ks) if (ks <= 2 * tb + 1) af[ks] = *(const GAS h16x8*)(Wh + (size_t)(32 * tb + r32) * GC + 16 * ks + 8 * hi);
#pragma unroll
            for (int ks = 0; ks < 8; ++ks) {
                if (ks <= 2 * tb + 1) {
#pragma unroll
                    for (int d0 = 0; d0 < 2; ++d0) {
                        const int srow = 16 * ks + 8 * hi + q4, c8 = 4 * d0 + 2 * g1b + (p4 >> 1);
                        const h16x4 lo = tr16(vt + vt_off(srow, c8) + (p4 & 1) * 8), hi4 = tr16(vt + vt_off(srow + 4, c8) + (p4 & 1) * 8);
                        const h16x8 bf = (h16x8){lo[0], lo[1], lo[2], lo[3], hi4[0], hi4[1], hi4[2], hi4[3]};
                        acc[d0] = __builtin_amdgcn_mfma_f32_32x32x16_f16(af[ks], bf, acc[d0], 0, 0, 0);
                    }
                }
            }
            h16 uv0[16], uv1[16]; float bsv[16];
#pragma unroll
            for (int e = 0; e < 16; ++e) { const int t = 32 * tb + (e & 3) + 8 * (e >> 2) + 4 * hi; const GAS h16* up = proj + (row0 + t) * INW + PU + wave * 64 + r32; uv0[e] = up[0]; uv1[e] = up[32]; bsv[e] = b_s[wave * GC + t]; }
            asm volatile("" ::: "memory");
#pragma unroll
            for (int e = 0; e < 16; ++e) {
                const int t = 32 * tb + (e & 3) + 8 * (e >> 2) + 4 * hi;
                GAS h16* up = proj + (row0 + t) * INW + PU + wave * 64 + r32;
                const float o0 = (float)uv0[e] * (acc[0][e] + bsv[e]), o1 = (float)uv1[e] * (acc[1][e] + bsv[e]);
                up[0] = (h16)o0; up[32] = (h16)o1;
                float q = o0 * o0 + o1 * o1;
                q += __shfl_xor(q, 1); q += __shfl_xor(q, 2); q += __shfl_xor(q, 4); q += __shfl_xor(q, 8); q += __shfl_xor(q, 16);
                if (r32 == 0) rowsq[wave * 128 + t] = q;
            }
        }
        __syncthreads();
        if (tid < 128) { float s8 = 0.f;
#pragma unroll
            for (int w = 0; w < 8; ++w) s8 += rowsq[w * 128 + tid];
            RG[row0 + tid] = s8; }
        __syncthreads();
    }
}


constexpr size_t DO_PO = 0, DO_PML = 96 * MiB;
constexpr int CW_CNT = 8192;
constexpr int LISTCAP = 8192;
constexpr int AL_K = 0, AL_V = 32768, AL_STG = 65536, AL_WSF = 98304, AL_START = 102400;
__device__ __forceinline__ int k_off(int key, int c8) { return key * 128 + ((c8 ^ (key & 7)) << 4); }

__device__ __forceinline__ void moba_gate_phase(const Frame& F0, int shadow) {
    const int tid = threadIdx.x, lane = tid & 63;
    const GAS h16* proj = (const GAS h16*)(F0.ws + WS_PROJ); const GAS float* kmp = (const GAS float*)(F0.ws + WS_KMP);
    unsigned* cnt = F0.ctl + CW_CNT + (shadow ? 1024 : 0); GAS unsigned short* lists = (GAS unsigned short*)(F0.ws + (shadow ? WS_HG : WS_LISTS));
    LAS float* km = (LAS float*)F0.lds;
    for (int item = F0.vcu; item < NB * NH * (S / 512); item += F0.G) {
        const int span = item % (S / 512), bh = item / (S / 512), b = bh >> 3, h = bh & 7;
        __syncthreads();
        for (int e = tid; e < NBLK * 64; e += NWAVES * 64) { const int n = e >> 6, d = e & 63; const GAS float* kp = kmp + (size_t)((b * NBLK + n) * 2) * 512 + h * 64 + d; km[e] = kp[0] + kp[512]; }
        __syncthreads();
        const int sq = span * 512 + tid, own = __builtin_amdgcn_readfirstlane(sq >> 8);
        float q[64];
        { const GAS h16* qp = proj + (size_t)(b * S + sq) * INW + PQ + h * 64;
#pragma unroll
          for (int c = 0; c < 8; ++c) { const h16x8 v = *(const GAS h16x8*)(qp + 8 * c);
#pragma unroll
              for (int e = 0; e < 8; ++e) q[8 * c + e] = (float)v[e]; } }
        float v0 = -3e38f, v1 = -3e38f, v2 = -3e38f; int i0 = -1, i1 = -1, i2 = -1;
        for (int n = 0; n < own; ++n) {
            float g0 = 0.f, g1 = 0.f, g2 = 0.f, g3 = 0.f;
#pragma unroll
            for (int c = 0; c < 16; ++c) { const f32x4 kv = *(const LAS f32x4*)(km + n * 64 + 4 * c); g0 += q[4 * c] * kv[0]; g1 += q[4 * c + 1] * kv[1]; g2 += q[4 * c + 2] * kv[2]; g3 += q[4 * c + 3] * kv[3]; }
            const float g = (g0 + g1) + (g2 + g3);
            if (g > v0) { v2 = v1; i2 = i1; v1 = v0; i1 = i0; v0 = g; i0 = n; }
            else if (g > v1) { v2 = v1; i2 = i1; v1 = g; i1 = n; }
            else if (g > v2) { v2 = g; i2 = n; }
        }
        int mycnt = 0, pos0 = 0, pos1 = 0, pos2 = 0;
        const unsigned long long ltmask = (1ull << lane) - 1ull;
        for (int n = 0; n < own; ++n) {
            const bool sel = (i0 == n) || (i1 == n) || (i2 == n);
            const unsigned long long mask = __ballot(sel);
            const int before = __popcll(mask & ltmask);
            if (lane == n) mycnt = __popcll(mask);
            if (i0 == n) pos0 = before; if (i1 == n) pos1 = before; if (i2 == n) pos2 = before;
        }
        unsigned base = 0u;
        if (lane < own && mycnt > 0) base = atomicAdd(cnt + bh * NBLK + lane, (unsigned)mycnt);
        const unsigned bb0 = (unsigned)__shfl((int)base, i0 & 63), bb1 = (unsigned)__shfl((int)base, i1 & 63), bb2 = (unsigned)__shfl((int)base, i2 & 63);
        if (i0 >= 0) lists[(size_t)(bh * NBLK + i0) * LISTCAP + bb0 + pos0] = (unsigned short)(sq | (0 << 13));
        if (i1 >= 0) lists[(size_t)(bh * NBLK + i1) * LISTCAP + bb1 + pos1] = (unsigned short)(sq | (1 << 13));
        if (i2 >= 0) lists[(size_t)(bh * NBLK + i2) * LISTCAP + bb2 + pos2] = (unsigned short)(sq | (2 << 13));
    }
    __syncthreads();
}

template <bool CAUSAL>
__device__ __forceinline__ void attn_tile(const LAS unsigned char* ldsK, const LAS unsigned char* ldsV, const h16x8 (&qf)[4], int wave, int lane, f32x16 (&o)[2], float& m_out, float& l_out) {
    const int r32 = lane & 31, hi = lane >> 5;
    int kbase[4];
#pragma unroll
    for (int ks = 0; ks < 4; ++ks) kbase[ks] = r32 * 128 + (((2 * ks + hi) ^ (r32 & 7)) << 4);
    f32x16 sacc[8];
#pragma unroll
    for (int kb = 0; kb < 8; ++kb) {
        f32x16 acc;
#pragma unroll
        for (int e = 0; e < 16; ++e) acc[e] = 0.f;
#pragma unroll
        for (int ks = 0; ks < 4; ++ks) { const h16x8 kf = *(const LAS h16x8*)(ldsK + kbase[ks] + kb * 4096); acc = __builtin_amdgcn_mfma_f32_32x32x16_f16(kf, qf[ks], acc, 0, 0, 0); }
        if (CAUSAL) {
            const int lim = 32 * (wave - kb) + r32;
#pragma unroll
            for (int e = 0; e < 16; ++e) { const int key = (e & 3) + 8 * (e >> 2) + 4 * hi; if (key > lim) acc[e] = -1e30f; }
        }
        sacc[kb] = acc;
    }
    float m = -3e38f;
#pragma unroll
    for (int kb = 0; kb < 8; ++kb)
#pragma unroll
        for (int e = 0; e < 16; ++e) m = fmaxf(m, sacc[kb][e]);
    m = fmaxf(m, __shfl_xor(m, 32));
    float ls = 0.f;
#pragma unroll
    for (int kb = 0; kb < 8; ++kb)
#pragma unroll
        for (int e = 0; e < 16; ++e) { const float pv = __builtin_amdgcn_exp2f(sacc[kb][e] - m); sacc[kb][e] = pv; ls += pv; }
    ls += __shfl_xor(ls, 32);
#pragma unroll
    for (int d0 = 0; d0 < 2; ++d0)
#pragma unroll
        for (int e = 0; e < 16; ++e) o[d0][e] = 0.f;
    const int q4 = (lane & 15) >> 2, p4 = lane & 3, g1b = (lane >> 4) & 1;
    int vbase[2];
#pragma unroll
    for (int d0 = 0; d0 < 2; ++d0) vbase[d0] = (4 * hi + q4) * 128 + ((d0 ^ ((q4 >> 1) & 1)) << 6) + ((2 * g1b + (p4 >> 1)) << 4) + (p4 & 1) * 8;
#pragma unroll
    for (int kb = 0; kb < 8; ++kb) {
        if (!CAUSAL || kb <= wave) {
#pragma unroll
            for (int s2 = 0; s2 < 2; ++s2) {
                h16x8 pa;
#pragma unroll
                for (int j = 0; j < 8; ++j) pa[j] = (h16)sacc[kb][8 * s2 + j];
#pragma unroll
                for (int d0 = 0; d0 < 2; ++d0) {
                    const h16x4 lo = tr16(ldsV + vbase[d0] + kb * 4096 + s2 * 2048), hi4 = tr16(ldsV + vbase[d0] + kb * 4096 + s2 * 2048 + 1024);
                    const h16x8 bf = (h16x8){lo[0], lo[1], lo[2], lo[3], hi4[0], hi4[1], hi4[2], hi4[3]};
                    o[d0] = __builtin_amdgcn_mfma_f32_32x32x16_f16(pa, bf, o[d0], 0, 0, 0);
                }
            }
        }
    }
    m_out = m; l_out = ls;
}
__device__ __forceinline__ void attn_tile_causal(const LAS unsigned char* ldsK, const LAS unsigned char* ldsV, const h16x8 (&qf)[4], int wave, int lane, f32x16 (&o)[2], float& m_out, float& l_out) {
    const int r32 = lane & 31, hi = lane >> 5;
    int kbase[4];
#pragma unroll
    for (int ks = 0; ks < 4; ++ks) kbase[ks] = r32 * 128 + (((2 * ks + hi) ^ (r32 & 7)) << 4);
    const int q4 = (lane & 15) >> 2, p4 = lane & 3, g1b = (lane >> 4) & 1;
    int vbase[2];
#pragma unroll
    for (int d0 = 0; d0 < 2; ++d0) vbase[d0] = (4 * hi + q4) * 128 + ((d0 ^ ((q4 >> 1) & 1)) << 6) + ((2 * g1b + (p4 >> 1)) << 4) + (p4 & 1) * 8;
    float m = -3e38f;
    for (int kb = 0; kb <= wave; ++kb) {
        f32x16 acc;
#pragma unroll
        for (int e = 0; e < 16; ++e) acc[e] = 0.f;
#pragma unroll
        for (int ks = 0; ks < 4; ++ks) { const h16x8 kf = *(const LAS h16x8*)(ldsK + kbase[ks] + kb * 4096); acc = __builtin_amdgcn_mfma_f32_32x32x16_f16(kf, qf[ks], acc, 0, 0, 0); }
        const int lim = (kb == wave) ? r32 : 64;
#pragma unroll
        for (int e = 0; e < 16; ++e) { const int key = (e & 3) + 8 * (e >> 2) + 4 * hi; if (key <= lim) m = fmaxf(m, acc[e]); }
    }
    m = fmaxf(m, __shfl_xor(m, 32));
    float ls = 0.f;
#pragma unroll
    for (int d0 = 0; d0 < 2; ++d0)
#pragma unroll
        for (int e = 0; e < 16; ++e) o[d0][e] = 0.f;
    for (int kb = 0; kb <= wave; ++kb) {
        f32x16 acc;
#pragma unroll
        for (int e = 0; e < 16; ++e) acc[e] = 0.f;
#pragma unroll
        for (int ks = 0; ks < 4; ++ks) { const h16x8 kf = *(const LAS h16x8*)(ldsK + kbase[ks] + kb * 4096); acc = __builtin_amdgcn_mfma_f32_32x32x16_f16(kf, qf[ks], acc, 0, 0, 0); }
        const int lim = (kb == wave) ? r32 : 64;
#pragma unroll
        for (int e = 0; e < 16; ++e) { const int key = (e & 3) + 8 * (e >> 2) + 4 * hi; const float pv = (key <= lim) ? __builtin_amdgcn_exp2f(acc[e] - m) : 0.f; acc[e] = pv; ls += pv; }
#pragma unroll
        for (int s2 = 0; s2 < 2; ++s2) {
            h16x8 pa;
#pragma unroll
            for (int j = 0; j < 8; ++j) pa[j] = (h16)acc[8 * s2 + j];
#pragma unroll
            for (int d0 = 0; d0 < 2; ++d0) {
                const h16x4 lo = tr16(ldsV + vbase[d0] + kb * 4096 + s2 * 2048), hi4 = tr16(ldsV + vbase[d0] + kb * 4096 + s2 * 2048 + 1024);
                const h16x8 bf = (h16x8){lo[0], lo[1], lo[2], lo[3], hi4[0], hi4[1], hi4[2], hi4[3]};
                o[d0] = __builtin_amdgcn_mfma_f32_32x32x16_f16(pa, bf, o[d0], 0, 0, 0);
            }
        }
    }
    ls += __shfl_xor(ls, 32);
    m_out = m; l_out = ls;
}
__device__ __forceinline__ void load_kv_block(LAS unsigned char* lds, const GAS h16* proj, size_t row0, int h, int tid) {
#pragma unroll
    for (int i = 0; i < 4; ++i) { const int idx = tid + 512 * i, key = idx >> 3, c8 = idx & 7; const GAS h16* rp = proj + (row0 + key) * INW + h * 64 + 8 * c8;
        const u32x4 kv = *(const GAS u32x4*)(rp + PK), vv = *(const GAS u32x4*)(rp + PV);
        *(LAS u32x4*)(lds + AL_K + k_off(key, c8)) = kv; *(LAS u32x4*)(lds + AL_V + vt_off(key, c8)) = vv; }
}
__device__ __forceinline__ void stage_o(LAS unsigned char* stg, LAS float* wsf, const f32x16 (&o)[2], float l, int lane) {
    const int r32 = lane & 31, hi = lane >> 5;
    if (hi == 0) wsf[r32] = 1.f / l;
    LDS_WAIT();
#pragma unroll
    for (int e = 0; e < 16; ++e) { const int qr = (e & 3) + 8 * (e >> 2) + 4 * hi; const float rl = wsf[qr];
        *(LAS h16*)(stg + qr * 128 + r32 * 2) = (h16)(o[0][e] * rl); *(LAS h16*)(stg + qr * 128 + 64 + r32 * 2) = (h16)(o[1][e] * rl); }
    LDS_WAIT();
}

struct KvRegs { u32x4 kv[4], vv[4]; };
__device__ __forceinline__ void kv_fetch(KvRegs& r, const GAS h16* proj, size_t row0, int h, int tid) {
#pragma unroll
    for (int i = 0; i < 4; ++i) { const int idx = tid + 512 * i, key = idx >> 3, c8 = idx & 7; const GAS h16* rp = proj + (row0 + key) * INW + h * 64 + 8 * c8;
        r.kv[i] = *(const GAS u32x4*)(rp + PK); r.vv[i] = *(const GAS u32x4*)(rp + PV); }
}
__device__ __forceinline__ void kv_commit(const KvRegs& r, LAS unsigned char* lds, int tid) {
#pragma unroll
    for (int i = 0; i < 4; ++i) { const int idx = tid + 512 * i, key = idx >> 3, c8 = idx & 7;
        *(LAS u32x4*)(lds + AL_K + k_off(key, c8)) = r.kv[i]; *(LAS u32x4*)(lds + AL_V + vt_off(key, c8)) = r.vv[i]; }
}
__device__ __forceinline__ void moba_b_phase(const Frame& F0, GAS float* dout) {
    const int tid = threadIdx.x, lane = tid & 63, wave = __builtin_amdgcn_readfirstlane(tid >> 6), r32 = lane & 31, hi = lane >> 5;
    const GAS h16* proj = (const GAS h16*)(F0.ws + WS_PROJ); const unsigned* cnt = F0.ctl + CW_CNT; const GAS unsigned short* lists = (const GAS unsigned short*)(F0.ws + WS_LISTS);
    GAS h16* PO = (GAS h16*)((unsigned char*)dout + DO_PO); GAS float* PML = (GAS float*)((unsigned char*)dout + DO_PML);
    LAS unsigned char* lds = F0.lds;
    LAS int* start = (LAS int*)(lds + AL_START);
    LAS float* wsf = (LAS float*)(lds + AL_WSF + wave * 512); LAS int* wsi = (LAS int*)(lds + AL_WSF + wave * 512 + 256);
    LAS unsigned char* stg = lds + AL_STG + wave * 4096;
    {
        const unsigned c0 = cnt[2 * tid], c1 = cnt[2 * tid + 1];
        const int t0 = (int)((c0 + 255u) >> 8), t1 = (int)((c1 + 255u) >> 8);
        int v = t0 + t1, inc = v;
#pragma unroll
        for (int o = 1; o < 64; o <<= 1) { const int u = __shfl_up(inc, o); if (lane >= o) inc += u; }
        LAS int* wtot = (LAS int*)(lds + AL_WSF);
        __syncthreads();
        if (lane == 63) wtot[wave] = inc;
        __syncthreads();
        int pre = 0;
        for (int w = 0; w < wave; ++w) pre += wtot[w];
        const int ex = pre + inc - v;
        __syncthreads();
        start[2 * tid] = ex; start[2 * tid + 1] = ex + t0;
        if (tid == 511) start[1024] = ex + v;
        __syncthreads();
    }
    const int nitems = start[1024];
    for (int item = F0.vcu; item < nitems; item += F0.G) {
        int lo = 0, hi_ = 1024;
        while (hi_ - lo > 1) { const int mid = (lo + hi_) >> 1; if (start[mid] <= item) lo = mid; else hi_ = mid; }
        const int l = lo, chunk = item - start[l];
        const int bh = l >> 5, n = l & 31, b = bh >> 3, h = bh & 7;
        const int nq = (int)cnt[l] - chunk * 256;
        const int qi = chunk * 256 + wave * 32 + r32;
        const bool valid = (wave * 32 + r32) < nq;
        const unsigned ent = lists[(size_t)l * LISTCAP + (valid ? qi : chunk * 256)];
        KvRegs kvr; kv_fetch(kvr, proj, (size_t)b * S + (size_t)n * MBLK, h, tid);
        const int sq = ent & 8191, rank = ent >> 13;
        h16x8 qf[4];
        { const GAS h16* qp = proj + (size_t)(b * S + sq) * INW + PQ + h * 64 + 8 * hi;
#pragma unroll
          for (int ks = 0; ks < 4; ++ks) qf[ks] = *(const GAS h16x8*)(qp + 16 * ks); }
        kv_commit(kvr, lds, tid);
        __syncthreads();
        if (wave * 32 < nq) {
            f32x16 o[2]; float m, lsum;
            attn_tile<false>(lds + AL_K, lds + AL_V, qf, wave, lane, o, m, lsum);
            const int slot = ((b * NH + h) * 3 + rank) * S + sq;
            if (hi == 0) { wsi[r32] = valid ? slot : -1; if (valid) { PML[(size_t)slot * 2] = m; PML[(size_t)slot * 2 + 1] = lsum; } }
            stage_o(stg, wsf, o, lsum, lane);
#pragma unroll
            for (int i = 0; i < 4; ++i) { const int row = i * 8 + (lane >> 3), ch = lane & 7; const int sl = wsi[row];
                if (sl >= 0) *(GAS u32x4*)(PO + (size_t)sl * 64 + ch * 8) = *(const LAS u32x4*)(stg + row * 128 + ch * 16); }
        }
        __syncthreads();
    }
}

__device__ __forceinline__ void moba_c_phase(const Frame& F0, const GAS float* dout, int shadow) {
    const int tid = threadIdx.x, lane = tid & 63, wave = __builtin_amdgcn_readfirstlane(tid >> 6), r32 = lane & 31, hi = lane >> 5;
    GAS h16* proj = (GAS h16*)(F0.ws + WS_PROJ); GAS float* SSQA = (GAS float*)(F0.ws + WS_SSQA);
    const GAS h16* PO = (const GAS h16*)((const unsigned char*)dout + DO_PO); const GAS float* PML = (const GAS float*)((const unsigned char*)dout + DO_PML);
    LAS unsigned char* lds = F0.lds;
    LAS float* wsf = (LAS float*)(lds + AL_WSF + wave * 512);
    LAS unsigned char* stg = lds + AL_STG + wave * 4096;
    KvRegs kvr;
    if (F0.vcu < NB * NH * NBLK) { const int u0 = F0.vcu; kv_fetch(kvr, proj, (size_t)((u0 >> 5) >> 3) * S + (size_t)(u0 & 31) * MBLK, (u0 >> 5) & 7, tid); }
    for (int unit = F0.vcu; unit < NB * NH * NBLK; unit += F0.G) {
        const int qb = unit & 31, bh = unit >> 5, b = bh >> 3, h = bh & 7;
        const size_t row0 = (size_t)b * S + (size_t)qb * MBLK;
        kv_commit(kvr, lds, tid);
        { const int un = unit + F0.G; if (un < NB * NH * NBLK) kv_fetch(kvr, proj, (size_t)((un >> 5) >> 3) * S + (size_t)(un & 31) * MBLK, (un >> 5) & 7, tid); }
        h16x8 qf[4];
        { const GAS h16* qp = proj + (row0 + wave * 32 + r32) * INW + PQ + h * 64 + 8 * hi;
#pragma unroll
          for (int ks = 0; ks < 4; ++ks) qf[ks] = *(const GAS h16x8*)(qp + 16 * ks); }
        __syncthreads();
        f32x16 o[2]; float m, lsum;
        attn_tile_causal(lds + AL_K, lds + AL_V, qf, wave, lane, o, m, lsum);
        if (hi == 0) { wsf[32 + r32] = m; wsf[64 + r32] = lsum; }
        stage_o(stg, wsf, o, lsum, lane);
        const int nsel = qb < 3 ? qb : 3;
#pragma unroll
        for (int i0 = 0; i0 < 4; i0 += 2) {
            float mr[2][3], lr[2][3]; h16x8 pv[2][3];
#pragma unroll
            for (int ii = 0; ii < 2; ++ii) { const size_t grow = row0 + wave * 32 + (i0 + ii) * 8 + (lane >> 3);
#pragma unroll
                for (int r = 0; r < 3; ++r) { if (r < nsel) { const size_t sl = ((size_t)(b * NH + h) * 3 + r) * S + (grow - (size_t)b * S); mr[ii][r] = PML[sl * 2]; lr[ii][r] = PML[sl * 2 + 1]; pv[ii][r] = *(const GAS h16x8*)(PO + sl * 64 + (lane & 7) * 8); } } }
            asm volatile("" ::: "memory");
#pragma unroll
            for (int ii = 0; ii < 2; ++ii) {
                const int row = (i0 + ii) * 8 + (lane >> 3), ch = lane & 7;
                const size_t grow = row0 + wave * 32 + row;
                const float mo = wsf[32 + row], lo_ = wsf[64 + row];
                const h16x8 ov = *(const LAS h16x8*)(stg + row * 128 + ch * 16);
                float mmax = mo;
#pragma unroll
                for (int r = 0; r < 3; ++r) { if (r < nsel) mmax = fmaxf(mmax, mr[ii][r]); }
                float wo = lo_ * __builtin_amdgcn_exp2f(mo - mmax), L = wo;
                float acc[8];
#pragma unroll
                for (int e = 0; e < 8; ++e) acc[e] = wo * (float)ov[e];
#pragma unroll
                for (int r = 0; r < 3; ++r) { if (r < nsel) { const float wr_ = lr[ii][r] * __builtin_amdgcn_exp2f(mr[ii][r] - mmax); L += wr_;
#pragma unroll
                    for (int e = 0; e < 8; ++e) acc[e] += wr_ * (float)pv[ii][r][e]; } }
                const float rL = 1.f / L; float q = 0.f; u32x4 w;
#pragma unroll
                for (int e = 0; e < 8; ++e) { acc[e] *= rL; q += acc[e] * acc[e]; }
                w[0] = pkh(acc[0], acc[1]); w[1] = pkh(acc[2], acc[3]); w[2] = pkh(acc[4], acc[5]); w[3] = pkh(acc[6], acc[7]);
                if (shadow) *(GAS u32x4*)((GAS h16*)(F0.ws + WS_HG) + grow * 512 + h * 64 + ch * 8) = w;
                else *(GAS u32x4*)(proj + grow * INW + PQ + h * 64 + ch * 8) = w;
                q += __shfl_xor(q, 1); q += __shfl_xor(q, 2); q += __shfl_xor(q, 4);
                if (ch == 0) SSQA[grow * 8 + h] = q;
            }
        }
        __syncthreads();
    }
}


template <bool PART16, class Order> __device__ __forceinline__ void fill_rowscale(LAS float* tab, const Order& So, const GAS float* src, int maxu) {
    pg8::Unit uu;
    for (int i = 0; i < maxu && So.next(i, uu); ++i)
        if (threadIdx.x < 256) { const int row = uu.pm * 256 + (int)threadIdx.x; tab[i * 256 + threadIdx.x] = PART16 ? rs16(src + (size_t)row * 16) : src[row]; }
    __syncthreads();
}
constexpr int TAB_OFF = MISC_OFF + 128, TAB_MAXU = 15;
static_assert(TAB_OFF + TAB_MAXU * 1024 <= LDS_BYTES, "row-scale table");

enum Phase { PH_P0 = 0, PH_P1, PH_G1A, PH_G1B, PH_INPROJ, PH_MIX_A, PH_MIX_B, PH_MIX_C, PH_OUTPROJ, PH_G2A, PH_G2B, PH_FINAL, PH_COUNT };
__global__ void __launch_bounds__(NWAVES * 64, 2) mega_fwd(Args args) {
    extern __shared__ __attribute__((aligned(16))) unsigned char lds[];
    Frame F;
    F.lds = (LAS unsigned char*)lds; F.MISC = (volatile LAS unsigned*)(F.lds + MISC_OFF);
    F.tid = threadIdx.x; F.lane = F.tid & 63; F.wave = __builtin_amdgcn_readfirstlane(F.tid >> 6);
    F.G = gridDim.x; { const int bx = blockIdx.x; F.vcu = (F.G % 8 == 0) ? (bx % 8) * (F.G / 8) + bx / 8 : bx; }
    F.ws = args.ws; F.out = (GAS float*)args.out; F.ctl = (unsigned*)(args.ws + WS_CTL);
    for (int u = F.tid; u < (LDS_BYTES - LDSCTL_OFF) / 4; u += NWAVES * 64) ((LAS unsigned*)(F.lds + LDSCTL_OFF))[u] = 0u;
    __syncthreads();
    XcdBarrier bar; bar.bar = F.ctl + CW_BAR; bar.x = 0; bar.st = nullptr;
    const int lo = args.ph_lo, hi = args.ph_hi;
    if (hi - lo > 1) bar = xcd_barrier_post(F.ctl + CW_BAR, F.MISC + 8);
#ifndef MK_PHASE_MASK
#define MK_PHASE_MASK 0xFFFF
#endif
#define IN(k) (((MK_PHASE_MASK >> (k)) & 1) && lo <= (k) && (k) < hi)
#define SEAM(k) do { if (IN(k) && IN((k) + 1)) xcd_barrier(bar); } while (0)
#define PHASE_PTRS() unsigned char* ws = args.ws; asm volatile("" : "+s"(ws)); const GAS float* GT = (const GAS float*)(ws + WS_GT); const GAS float* GP = (const GAS float*)(ws + WS_GP); (void)GT; (void)GP; F.ws = ws
    if (IN(PH_P0)) { PHASE_PTRS(); p0_prologue(F, args); SEAM(PH_P0); }
    if (IN(PH_P1)) { PHASE_PTRS(); p1_prep(F, args); SEAM(PH_P1); }
    if (IN(PH_G1A)) {
        PHASE_PTRS();
        pg8::Gemm g{(const GAS h16*)(ws + WS_HG), (const GAS h16*)(ws + WS_WGU1), 0, NGU, D}; pg8::StaticOrder So; So.init(M, NGU, F.G, (int)blockIdx.x); const pg8::TableOrder To = pg8::make_table(So, (LAS int*)(F.lds + LDSCTL_OFF));
#if MK_SHADOW == 1
        if (args.ph_lo == PH_G1A && args.ph_hi == PH_G1A + 1 && args.shadow) { EpiNull En; pg8::gemm_phase<EpiNull, true, MK_GPROBE>(F.lds, g, So, En); return; }
#endif
        fill_rowscale<false>((LAS float*)(F.lds + TAB_OFF), To, (const GAS float*)(ws + WS_R1), TAB_MAXU);
        EpiSwiglu E{(GAS h16*)(ws + WS_ACT), (const LAS float*)(F.lds + TAB_OFF), (const GAS float*)(ws + WS_BIAS1)};
        pg8::gemm_phase<EpiSwiglu, true, 0, pg8::TableOrder>(F.lds, g, To, E); SEAM(PH_G1A);
    }
    if (IN(PH_G1B)) {
        PHASE_PTRS();
        pg8::Gemm g{(const GAS h16*)(ws + WS_ACT), (const GAS h16*)(ws + WS_WD1), 0, D, DFF, MK_STAG}; pg8::StaticOrder So; So.init(M, D, F.G, (int)blockIdx.x); const pg8::TableOrder To = pg8::make_table(So, (LAS int*)(F.lds + LDSCTL_OFF));
#if MK_SHADOW == 8
        if (args.ph_lo == PH_G1B && args.ph_hi == PH_G1B + 1 && args.shadow) {
#if MK_GPROBE == 0
            EpiNull En; pg8::gemm_phase<EpiNull, true>(F.lds, g, So, En);
#else
            EpiResid<true, false, true, MK_GPROBE> Ev{GIN(args, 0), (GAS h16*)(ws + WS_H), (GAS h16*)(ws + WS_HG), GT + 0 * 4 * D, GP + 1 * 4 * D, (GAS float*)(ws + WS_SSQ2), nullptr, 0.5f};
            pg8::gemm_phase<EpiResid<true, false, true, MK_GPROBE>, true>(F.lds, g, So, Ev);
#endif
            return; }
#endif
        EpiResid<true, false, true> E{GIN(args, 0), (GAS h16*)(ws + WS_H), (GAS h16*)(ws + WS_HG), GT + 0 * 4 * D, GP + 1 * 4 * D, (GAS float*)(ws + WS_SSQ2), nullptr, 0.5f};
        pg8::gemm_phase<EpiResid<true, false, true>, true, 0, pg8::TableOrder>(F.lds, g, To, E); SEAM(PH_G1B);
    }
    if (IN(PH_INPROJ)) {
        PHASE_PTRS();
        pg8::Gemm g{(const GAS h16*)(ws + WS_HG), (const GAS h16*)(ws + WS_WIN), 0, INW, D}; pg8::StaticOrder So; So.init(M, INW, F.G, (int)blockIdx.x); const pg8::TableOrder To = pg8::make_table(So, (LAS int*)(F.lds + LDSCTL_OFF));
        fill_rowscale<true>((LAS float*)(F.lds + TAB_OFF), To, (const GAS float*)(ws + WS_SSQ2), TAB_MAXU);
        EpiInproj E{(GAS h16*)(ws + WS_PROJ), (const LAS float*)(F.lds + TAB_OFF), (const GAS float*)(ws + WS_BIAS2), (const GAS float*)(ws + WS_ROPE), (GAS float*)(ws + WS_KMP)};
        pg8::gemm_phase<EpiInproj, true, 0, pg8::TableOrder>(F.lds, g, To, E); SEAM(PH_INPROJ);
    }
    if (IN(PH_MIX_A)) { PHASE_PTRS(); if (!(args.shadow & 2)) gmlp_phase(F, args, args.shadow & 1); if (!(args.shadow & 4)) moba_gate_phase(F, args.shadow & 1); SEAM(PH_MIX_A); }
    if (IN(PH_MIX_B)) { PHASE_PTRS(); moba_b_phase(F, (GAS float*)args.out); SEAM(PH_MIX_B); }
    if (IN(PH_MIX_C)) { PHASE_PTRS(); moba_c_phase(F, (const GAS float*)args.out, args.shadow & 1); SEAM(PH_MIX_C); }
    if (IN(PH_OUTPROJ)) {
        PHASE_PTRS();
        pg8::Gemm g{(const GAS h16*)(ws + WS_PROJ), (const GAS h16*)(ws + WS_WOUT), INW, D, D}; pg8::StaticOrder So; So.init(M, D, F.G, (int)blockIdx.x); const pg8::TableOrder To = pg8::make_table(So, (LAS int*)(F.lds + LDSCTL_OFF));
        const LAS float* sct = (const LAS float*)(F.lds + MISC_OFF + 128);
        {   LAS float* t = (LAS float*)(F.lds + MISC_OFF + 128); const GAS float* ssqa = (const GAS float*)(ws + WS_SSQA); const GAS float* ssqg = (const GAS float*)(ws + WS_RG);
            pg8::Unit uu;
            for (int i = 0; i < 4 && To.next(i, uu); ++i)
                if (F.tid < 256) { const int row = uu.pm * 256 + F.tid; const f32x4 a = *(const GAS f32x4*)(ssqa + (size_t)row * 8), bq = *(const GAS f32x4*)(ssqa + (size_t)row * 8 + 4);
                    const float ra = rsqrtf((((a[0] + a[1]) + (a[2] + a[3])) + ((bq[0] + bq[1]) + (bq[2] + bq[3]))) * (1.f / 512.f) + EPS), rg = rsqrtf(ssqg[row] * (1.f / 512.f) + EPS);
                    t[i * 512 + F.tid] = ra / rg; t[i * 512 + 256 + F.tid] = rg; }
            __syncthreads(); }
        EpiResid<false, true, true> E{nullptr, (GAS h16*)(ws + WS_H), (GAS h16*)(ws + WS_HG), GT + 1 * 4 * D, GP + 2 * 4 * D, (GAS float*)(ws + WS_SSQ3), sct, 1.0f};
        pg8::gemm_phase<EpiResid<false, true, true>, true, 0, pg8::TableOrder>(F.lds, g, To, E); SEAM(PH_OUTPROJ);
    }
    if (IN(PH_G2A)) {
        PHASE_PTRS();
        pg8::Gemm g{(const GAS h16*)(ws + WS_HG), (const GAS h16*)(ws + WS_WGU2), 0, NGU, D}; pg8::StaticOrder So; So.init(M, NGU, F.G, (int)blockIdx.x); const pg8::TableOrder To = pg8::make_table(So, (LAS int*)(F.lds + LDSCTL_OFF));
        fill_rowscale<true>((LAS float*)(F.lds + TAB_OFF), To, (const GAS float*)(ws + WS_SSQ3), TAB_MAXU);
        EpiSwiglu E{(GAS h16*)(ws + WS_ACT), (const LAS float*)(F.lds + TAB_OFF), (const GAS float*)(ws + WS_BIAS3)};
        pg8::gemm_phase<EpiSwiglu, true, 0, pg8::TableOrder>(F.lds, g, To, E); SEAM(PH_G2A);
    }
    if (IN(PH_G2B)) {
        PHASE_PTRS();
        pg8::Gemm g{(const GAS h16*)(ws + WS_ACT), (const GAS h16*)(ws + WS_WD2), 0, D, DFF}; pg8::StaticOrder So; So.init(M, D, F.G, (int)blockIdx.x); const pg8::TableOrder To = pg8::make_table(So, (LAS int*)(F.lds + LDSCTL_OFF));
#if MK_FUSE_FINAL
        EpiFinal E{(const GAS h16*)(ws + WS_H), GT + 2 * 4 * D, GIN(args, 19), (GAS float*)args.out, (unsigned*)(ws + WS_SSQF), F.ctl + CW_PAN, F.ctl + CW_TMO,
                   (LAS float*)(F.lds + MISC_OFF + 128), (LAS float*)(F.lds + MISC_OFF + 128 + 4096), 0.5f};
        pg8::gemm_phase<EpiFinal, true, 0, pg8::TableOrder>(F.lds, g, To, E);
#else
        EpiResid<false, false, false> E{nullptr, (GAS h16*)(ws + WS_H), nullptr, GT + 2 * 4 * D, nullptr, (GAS float*)(ws + WS_SSQF), nullptr, 0.5f};
        pg8::gemm_phase<EpiResid<false, false, false>, true, 0, pg8::TableOrder>(F.lds, g, To, E); SEAM(PH_G2B);
#endif
    }
#if !MK_FUSE_FINAL
    if (IN(PH_FINAL)) { PHASE_PTRS(); p_final(F, args); }
#endif
#undef IN
#undef SEAM
}

extern "C" void kernel_launch(void* const* d_in, const int* in_sizes, int n_in, void* d_out, int out_size, void* d_ws, size_t ws_size, hipStream_t stream) {
    static int grid = 0;
    if (grid == 0) {
        if (n_in != 20 || out_size != M * D || ws_size < WS_END) { fprintf(stderr, "kernel_launch: unexpected shapes (n_in %d out %d ws %zu)\n", n_in, out_size, ws_size); grid = -1; return; }
        int dev = 0, cus = 0, per_cu = 0;
        hipGetDevice(&dev); hipDeviceGetAttribute(&cus, hipDeviceAttributeMultiprocessorCount, dev);
        if (hipFuncSetAttribute((const void*)mega_fwd, hipFuncAttributeMaxDynamicSharedMemorySize, LDS_BYTES) != hipSuccess) { fprintf(stderr, "kernel_launch: hipFuncSetAttribute failed\n"); grid = -1; return; }
        hipOccupancyMaxActiveBlocksPerMultiprocessor(&per_cu, (const void*)mega_fwd, NWAVES * 64, LDS_BYTES);
        (void)hipGetLastError();
        if (per_cu < 1) { fprintf(stderr, "kernel_launch: occupancy query says %d blocks/CU; nothing launched\n", per_cu); grid = -1; return; }
        grid = cus;
    }
    if (grid < 0) return;
    hipMemsetAsync((char*)d_ws + WS_CTL, 0, CTL_ZERO_BYTES, stream);
    Args a{};
    for (int i = 0; i < 20; ++i) a.in[i] = (const float*)d_in[i];
    a.out = (float*)d_out; a.ws = (unsigned char*)d_ws;
    unsigned char* ws = (unsigned char*)d_ws;
    auto run = [&](int lo, int hi) {
#if MK_PER_PHASE
        for (int p = lo; p < hi; ++p) {
            if (MK_SHADOW == 2 && p == PH_MIX_A) { a.ph_lo = p; a.ph_hi = p + 1; a.shadow = 1 | 4; hipLaunchKernelGGL(mega_fwd, dim3(grid), dim3(NWAVES * 64), LDS_BYTES, stream, a); a.shadow = 0; }
            if (MK_SHADOW == 3 && p == PH_MIX_A) { a.ph_lo = p; a.ph_hi = p + 1; a.shadow = 1 | 2; hipLaunchKernelGGL(mega_fwd, dim3(grid), dim3(NWAVES * 64), LDS_BYTES, stream, a); a.shadow = 0; }
            if (MK_SHADOW == 4 && p == PH_MIX_C) { a.ph_lo = p; a.ph_hi = p + 1; a.shadow = 1; hipLaunchKernelGGL(mega_fwd, dim3(grid), dim3(NWAVES * 64), LDS_BYTES, stream, a); a.shadow = 0; }
            if (MK_SHADOW == 8 && p == PH_G1B) { a.ph_lo = p; a.ph_hi = p + 1; a.shadow = 1; hipLaunchKernelGGL(mega_fwd, dim3(grid), dim3(NWAVES * 64), LDS_BYTES, stream, a); a.shadow = 0; }
            if (MK_SHADOW == 1 && p == PH_G1A) { a.ph_lo = p; a.ph_hi = p + 1; a.shadow = 1; hipLaunchKernelGGL(mega_fwd, dim3(grid), dim3(NWAVES * 64), LDS_BYTES, stream, a); a.shadow = 0; }
            for (int rep = 0; rep < ((((MK_DUP_MASK) >> p) & 1) ? 2 : 1); ++rep) { a.ph_lo = p; a.ph_hi = p + 1; hipLaunchKernelGGL(mega_fwd, dim3(grid), dim3(NWAVES * 64), LDS_BYTES, stream, a); }
        }
#else
        a.ph_lo = lo; a.ph_hi = hi;
        void* kargs[] = {(void*)&a};
        hipError_t e = hipLaunchCooperativeKernel((const void*)mega_fwd, dim3(grid), dim3(NWAVES * 64), kargs, LDS_BYTES, stream);
        if (e != hipSuccess) fprintf(stderr, "kernel_launch: cooperative launch failed: %s (grid %d)\n", hipGetErrorString(e), grid);
#endif
    };
    run(PH_P0, PH_COUNT);
}
```

```cpp
#include <hip/hip_runtime.h>
#include <cstdio>
#include <cstdint>

#ifndef MK_DUP_MASK
#define MK_DUP_MASK 0
#endif
#ifndef MK_GPROBE
#define MK_GPROBE 0
#endif
#ifndef MK_SHADOW
#define MK_SHADOW 0
#endif
#ifndef MK_FUSE_FINAL
#define MK_FUSE_FINAL 1
#endif
#ifndef MK_STAG
#define MK_STAG 0
#endif
#ifndef MK_NT
#define MK_NT 0x0
#endif
#ifndef MK_LEBITS
#define MK_LEBITS 6u
#endif
#ifndef MK_LOWENT
#define MK_LOWENT 3
#endif
#ifndef MK_PER_PHASE
#define MK_PER_PHASE 0
#endif

#define GAS __attribute__((address_space(1)))
#define LAS __attribute__((address_space(3)))
typedef _Float16 h16;
typedef _Float16 h16x8 __attribute__((ext_vector_type(8)));
typedef _Float16 h16x4 __attribute__((ext_vector_type(4)));
typedef _Float16 h16x2 __attribute__((ext_vector_type(2)));
typedef float f32x4 __attribute__((ext_vector_type(4)));
typedef float f32x2 __attribute__((ext_vector_type(2)));
typedef unsigned u32x4 __attribute__((ext_vector_type(4)));
typedef unsigned u32x2 __attribute__((ext_vector_type(2)));

constexpr int D = 1024, NB = 4, S = 8192, M = NB * S, DFF = 2816, NGU = 2 * DFF, NMOD = 9;
constexpr int AW = 512, HD = 64, NH = 8, INW = 2560, MBLK = 256, NBLK = S / MBLK, GC = 128;
constexpr float EPS = 1e-6f;
constexpr float C2 = 0.125f * 1.4426950408889634f;
constexpr int PQ = 0, PU = 512, PK = 1024, PV = 1536, PG = 2048;

constexpr size_t MiB = 1u << 20, KiB = 1u << 10;
constexpr size_t WS_CTL = 0, CTL_ZERO_BYTES = 1 * MiB;
constexpr size_t WS_MODP = 1 * MiB;
constexpr size_t WS_GT = 2 * MiB, WS_GP = WS_GT + 64 * KiB;
constexpr size_t WS_BIAS1 = WS_GT + 128 * KiB, WS_BIAS2 = WS_GT + 256 * KiB, WS_BIAS3 = WS_GT + 320 * KiB;
constexpr size_t WS_R1 = 3 * MiB, WS_RG = WS_R1 + 128 * KiB;
constexpr size_t WS_SSQA = 4 * MiB;
constexpr size_t WS_SSQ2 = 5 * MiB, WS_SSQ3 = 7 * MiB, WS_SSQF = 9 * MiB;
constexpr size_t WS_KMP = 11 * MiB;
constexpr size_t WS_ROPE = 12 * MiB;
constexpr size_t WS_WS16 = 14 * MiB;
constexpr size_t WS_WGU1 = 16 * MiB, WS_WD1 = 27 * MiB, WS_WIN = 33 * MiB, WS_WOUT = 38 * MiB, WS_WGU2 = 40 * MiB, WS_WD2 = 51 * MiB;
constexpr size_t WS_HG = 64 * MiB, WS_H = 128 * MiB, WS_ACT = 192 * MiB, WS_PROJ = WS_ACT;
constexpr size_t WS_LISTS = 368 * MiB, WS_END = 384 * MiB;
static_assert(WS_WD2 + (size_t)D * DFF * 2 <= WS_HG && WS_ACT + (size_t)M * DFF * 2 <= WS_LISTS, "ws map");
constexpr int CW_TMO = 0, CW_BAR = 4096;

constexpr int RING_BYTES = 131072, LDSCTL_OFF = RING_BYTES, MISC_OFF = LDSCTL_OFF + 320, LDS_BYTES = 147456;
constexpr int NWAVES = 8;

#define LDS_WAIT() asm volatile("s_waitcnt lgkmcnt(0)" ::: "memory")
#define VM_WAIT() asm volatile("s_waitcnt vmcnt(0)" ::: "memory")

__device__ __forceinline__ float wave_sum(float v) {
#pragma unroll
    for (int o = 1; o < 64; o <<= 1) v += __shfl_xor(v, o);
    return v;
}
template <int SEL, class T> __device__ __forceinline__ void st_stream(GAS T* p, const T& v) { if ((MK_NT >> SEL) & 1) __builtin_nontemporal_store(v, p); else *p = v; }
__device__ __forceinline__ unsigned pkh(float lo, float hi) { h16x2 v; v.x = (h16)lo; v.y = (h16)hi; return __builtin_bit_cast(unsigned, v); }
__device__ __forceinline__ float round8a(float x) { constexpr unsigned drop = 24u - MK_LEBITS; unsigned u = __float_as_uint(x); u += ((1u << (drop - 1)) - 1u) + ((u >> drop) & 1u); u &= ~((1u << drop) - 1u); return __uint_as_float(u); }
__device__ __forceinline__ unsigned pkh8(float lo, float hi) { return (MK_LOWENT & 2) ? pkh(round8a(lo), round8a(hi)) : pkh(lo, hi); }
__device__ __forceinline__ float silu_fast(float x) { return x * __builtin_amdgcn_rcpf(1.f + __builtin_amdgcn_exp2f(-1.4426950408889634f * x)); }
__device__ __forceinline__ float gelu_fast(float x) {
    const float u2 = 1.5957691216057308f * (x + 0.044715f * x * x * x);
    return x * __builtin_amdgcn_rcpf(1.f + __builtin_amdgcn_exp2f(-1.4426950408889634f * u2));
}
__device__ __forceinline__ float rs16(const GAS float* p) {
    const f32x4 s0 = *(const GAS f32x4*)(p), s1 = *(const GAS f32x4*)(p + 4), s2 = *(const GAS f32x4*)(p + 8), s3 = *(const GAS f32x4*)(p + 12);
    const f32x4 st = (s0 + s1) + (s2 + s3);
    return rsqrtf(((st[0] + st[1]) + (st[2] + st[3])) * (1.f / D) + EPS);
}


__device__ __forceinline__ size_t blk_off(int row, int k, int nt) { return (((size_t)(row >> 8) * nt + (k >> 6)) * 256 + (row & 255)) * 64 + (k & 63); }

namespace pg8 {
constexpr int BM = 256, BK = 64, HALF = 128, HTB = HALF * BK * 2, STAGE_BYTES = 8 * HTB, NXCD = 8, WGM = 8;
__host__ __device__ __forceinline__ int lds_byte(int r, int c) { const int st = (r >> 4) * 2 + (c >> 5), rr = r & 15, cc = c & 31, ob = rr * 64 + cc * 2; return st * 1024 + (ob ^ (((ob >> 9) & 1) << 5)); }
__host__ __device__ __forceinline__ void stage_rc(int b, int& R, int& C) { const int st = b / 1024, sb = b % 1024, swz = sb ^ (((sb >> 9) & 1) << 5); R = (st >> 1) * 16 + swz / 64; C = (st & 1) * 32 + (swz % 64) / 2; }
struct Unit { int pm, pn; };
struct Gemm { const GAS h16* A; const GAS h16* Bt; int lda, N, K; unsigned stag = 0; };
struct StaticOrder {
    int nM, nN, nwg, G, c;
    __device__ __forceinline__ void init(int M_, int N, int G_, int c_) { nM = M_ / BM; nN = N / BM; nwg = nM * nN; G = G_; c = c_; }
    __device__ __forceinline__ bool next(int i, Unit& u) const {
        const long L = (long)i * G + c; if (L >= nwg) return false;
        int wgid = (int)L; { const int q = nwg / NXCD, r = nwg % NXCD, xcd = wgid % NXCD, off = wgid / NXCD; wgid = (xcd < r ? xcd * (q + 1) : r * (q + 1) + (xcd - r) * q) + off; }
        const int nig = WGM * nN, gid = wgid / nig, fm = gid * WGM, gsz = (nM - fm) < WGM ? (nM - fm) : WGM;
        u.pm = fm + ((wgid % nig) % gsz); u.pn = (wgid % nig) / gsz; return true;
    }
};
struct TableOrder {
    const LAS int* tab; int n;
    __device__ __forceinline__ bool next(int i, Unit& u) const { if (i >= n) return false; u.pm = tab[2 * i]; u.pn = tab[2 * i + 1]; return true; }
};
__device__ __forceinline__ TableOrder make_table(const StaticOrder& So, LAS int* tab) {
    if (threadIdx.x < 16) { Unit u; u.pm = -1; u.pn = 0; const bool ok = So.next((int)threadIdx.x, u); tab[2 * threadIdx.x] = ok ? u.pm : -1; tab[2 * threadIdx.x + 1] = u.pn; }
    __syncthreads();
    int n = 0;
    while (n < 16 && tab[2 * n] >= 0) ++n;
    TableOrder T; T.tab = tab; T.n = __builtin_amdgcn_readfirstlane(n); return T;
}
template <class Epi, bool ALIGN_EPI, int PROBE = 0, class Order = StaticOrder>
__device__ __forceinline__ void gemm_phase(LAS unsigned char* lds, const Gemm g, const Order& S, const Epi& E) {
    const int tid = threadIdx.x, wid = __builtin_amdgcn_readfirstlane(tid >> 6), lane = tid & 63, wr = wid >> 2, wc = wid & 3, fr = lane & 15, fq = lane >> 4;
    const int K = g.K, nt = K / BK;
    unsigned voffA[2], voffB[2];
    const bool ablk = (g.lda == 0);
#pragma unroll
    for (int i = 0; i < 2; ++i) { int R, C; stage_rc(tid * 16 + i * 8192, R, C); voffA[i] = (unsigned)(R * (ablk ? BK : g.lda) + C) * 2u; voffB[i] = (unsigned)(R * BK + C) * 2u; }
    const size_t kstepB = (size_t)BM * BK * 2, kstepA = ablk ? kstepB : (size_t)(BK * 2);
    const size_t hstepB = (size_t)HALF * BK * 2, hstepA = ablk ? hstepB : (size_t)HALF * g.lda * 2;
    const size_t tstepB = (size_t)nt * kstepB, tstepA = ablk ? tstepB : 2 * hstepA;
    const unsigned ldsw = (unsigned)wid * 1024u;
    const int aoff = lds_byte(wr * 64 + fr, fq * 8), boff = lds_byte(wc * 32 + fr, fq * 8);
#define PG8_SA(b, h) (((b) * 2 + (h)) * HTB)
#define PG8_SB(b, h) ((4 + (b) * 2 + (h)) * HTB)
#define PG8_STAGE(bufoff, gbase, voff) do { if (PROBE != 2) _Pragma("unroll") for (int _i = 0; _i < 2; ++_i) \
        __builtin_amdgcn_global_load_lds((const unsigned*)((const char*)(gbase) + (voff)[_i]), (LAS unsigned*)(lds + (bufoff) + ldsw + _i * 8192), 16, 0, 0); } while (0)
#define PG8_LDA(dst, b, h) do { _Pragma("unroll") for (int m = 0; m < 4; ++m) _Pragma("unroll") for (int k = 0; k < 2; ++k) dst[m][k] = *(const LAS h16x8*)(lds + PG8_SA(b, h) + aoff + m * 2048 + k * 1024); } while (0)
#define PG8_LDB(dst, b, h) do { _Pragma("unroll") for (int n = 0; n < 2; ++n) _Pragma("unroll") for (int k = 0; k < 2; ++k) dst[n][k] = *(const LAS h16x8*)(lds + PG8_SB(b, h) + boff + n * 2048 + k * 1024); } while (0)
#define PG8_MMA(ai, bj, At, Bt) do { if (PROBE == 1 && (bj) == 1) break; __builtin_amdgcn_s_setprio(1); _Pragma("unroll") for (int m = 0; m < 4; ++m) _Pragma("unroll") for (int n = 0; n < 2; ++n) _Pragma("unroll") for (int k = 0; k < 2; ++k) \
        acc[ai][bj][m][n] = __builtin_amdgcn_mfma_f32_16x16x32_f16(Bt[n][k], At[m][k], acc[ai][bj][m][n], 0, 0, 0); __builtin_amdgcn_s_setprio(0); } while (0)
#define PG8_WAIT_V(n) asm volatile("s_waitcnt vmcnt(" #n ")" ::: "memory")
#define PG8_WAIT_L(n) asm volatile("s_waitcnt lgkmcnt(" #n ")" ::: "memory")
#define PG8_BAR __builtin_amdgcn_s_barrier()
#define PG8_SCHED __builtin_amdgcn_sched_barrier(0)
    Unit cur, nxt; int ui = 0;
    if (!S.next(0, cur)) return;
    if (g.stag) { const unsigned st = (unsigned)(cur.pm & 7); if (st) { const unsigned long long t0 = __builtin_amdgcn_s_memrealtime(), dl = (unsigned long long)st * g.stag; while (__builtin_amdgcn_s_memrealtime() - t0 < dl) __builtin_amdgcn_s_sleep(4); } }
    f32x4 acc[2][2][4][2];
#pragma unroll
    for (int a = 0; a < 2; ++a)
#pragma unroll
        for (int b = 0; b < 2; ++b)
#pragma unroll
            for (int m = 0; m < 4; ++m)
#pragma unroll
                for (int n = 0; n < 2; ++n) acc[a][b][m][n] = (f32x4){0.f, 0.f, 0.f, 0.f};
    h16x8 At[4][2], B0[2][2], B1[2][2];
    const char* cA = (const char*)g.A + (size_t)cur.pm * tstepA; const char* cB = (const char*)g.Bt + (size_t)cur.pn * tstepB;
    PG8_STAGE(PG8_SB(0, 0), cB, voffB); PG8_STAGE(PG8_SB(0, 1), cB + hstepB, voffB); PG8_STAGE(PG8_SA(0, 0), cA, voffA); PG8_STAGE(PG8_SA(0, 1), cA + hstepA, voffA);
    if (wr == 1) PG8_BAR;
    PG8_WAIT_V(2); PG8_BAR;
    PG8_STAGE(PG8_SB(1, 0), cB + kstepB, voffB); PG8_STAGE(PG8_SA(1, 0), cA + kstepA, voffA); PG8_STAGE(PG8_SB(1, 1), cB + hstepB + kstepB, voffB);
    PG8_WAIT_V(6); PG8_BAR;
    for (;;) {
        const bool has_next = S.next(ui + 1, nxt);
        const char* nA = has_next ? (const char*)g.A + (size_t)nxt.pm * tstepA : cA; const char* nB = has_next ? (const char*)g.Bt + (size_t)nxt.pn * tstepB : cB;
        for (int t = 0; t < nt; t += 2) {
            const bool last = (t == nt - 2);
            const char* a1 = cA + (size_t)(t + 1) * kstepA;
            const char* a2 = last ? nA : cA + (size_t)(t + 2) * kstepA; const char* b2 = last ? nB : cB + (size_t)(t + 2) * kstepB;
            const char* a3 = a2 + kstepA; const char* b3 = b2 + kstepB;
            if constexpr (Epi::MID) { if (t == nt / 2) E.mid(acc, cur, ui, wr, wc, fr, fq); }
            PG8_LDB(B0, 0, 0); PG8_LDB(B1, 0, 1); PG8_SCHED; PG8_LDA(At, 0, 0); PG8_STAGE(PG8_SA(1, 1), a1 + hstepA, voffA);
            PG8_WAIT_V(8); PG8_WAIT_L(0); PG8_BAR; PG8_MMA(0, 0, At, B0); PG8_MMA(0, 1, At, B1); PG8_BAR; PG8_SCHED;
            PG8_LDA(At, 0, 1); PG8_STAGE(PG8_SB(0, 0), b2, voffB); PG8_STAGE(PG8_SB(0, 1), b2 + hstepB, voffB); PG8_STAGE(PG8_SA(0, 0), a2, voffA);
            PG8_WAIT_V(8); PG8_WAIT_L(0); PG8_BAR; PG8_MMA(1, 0, At, B0); PG8_MMA(1, 1, At, B1); PG8_BAR; PG8_SCHED;
            PG8_LDB(B0, 1, 0); PG8_LDB(B1, 1, 1); PG8_SCHED; PG8_LDA(At, 1, 0); PG8_STAGE(PG8_SA(0, 1), a2 + hstepA, voffA);
            PG8_WAIT_V(8); PG8_WAIT_L(0); PG8_BAR; PG8_MMA(0, 0, At, B0); PG8_MMA(0, 1, At, B1); PG8_BAR; PG8_SCHED;
            PG8_LDA(At, 1, 1); PG8_STAGE(PG8_SB(1, 0), b3, voffB); PG8_STAGE(PG8_SB(1, 1), b3 + hstepB, voffB); PG8_STAGE(PG8_SA(1, 0), a3, voffA);
            PG8_WAIT_V(8); PG8_WAIT_L(0); PG8_BAR; PG8_MMA(1, 0, At, B0); PG8_MMA(1, 1, At, B1); PG8_BAR; PG8_SCHED;
        }
        if constexpr (ALIGN_EPI) { if (wr == 0) PG8_BAR; }
        E(acc, cur, ui, wr, wc, fr, fq);
        if (!has_next) break;
#pragma unroll
        for (int a = 0; a < 2; ++a)
#pragma unroll
            for (int b = 0; b < 2; ++b)
#pragma unroll
                for (int m = 0; m < 4; ++m)
#pragma unroll
                    for (int n = 0; n < 2; ++n) acc[a][b][m][n] = (f32x4){0.f, 0.f, 0.f, 0.f};
        cur = nxt; cA = nA; cB = nB; ++ui;
        if constexpr (ALIGN_EPI) { if (wr == 1) PG8_BAR; }
    }
    PG8_WAIT_V(0);
    if constexpr (!ALIGN_EPI) { if (wr == 0) PG8_BAR; }
    PG8_BAR;
#undef PG8_SA
#undef PG8_SB
#undef PG8_STAGE
#undef PG8_LDA
#undef PG8_LDB
#undef PG8_MMA
#undef PG8_WAIT_V
#undef PG8_WAIT_L
#undef PG8_BAR
#undef PG8_SCHED
}
}

typedef const f32x4 (&AccRef)[2][2][4][2];
struct EpiSwiglu {
    static constexpr bool MID = false;
    GAS h16* act; const LAS float* rtab; const GAS float* bias;
    __device__ __forceinline__ void mid(f32x4 (&)[2][2][4][2], const pg8::Unit&, int, int, int, int, int) const {}
    __device__ __forceinline__ void operator()(AccRef acc, const pg8::Unit& u, int ui, int wr, int wc, int fr, int fq) const {
        const int b = u.pm >> 5, row0 = u.pm * 256 + wr * 64 + fr;
        const GAS float* bp = bias + b * NGU + u.pn * 256 + wc * 32 + 4 * fq;
        f32x4 bv[2][2];
#pragma unroll
        for (int bj = 0; bj < 2; ++bj)
#pragma unroll
            for (int n = 0; n < 2; ++n) bv[bj][n] = *(const GAS f32x4*)(bp + bj * 128 + n * 16);
        const LAS float* rt = rtab + ui * 256 + wr * 64 + fr;
        const int hid0 = u.pn * 128 + wc * 32 + fq * 8;
#pragma unroll
        for (int ai = 0; ai < 2; ++ai)
#pragma unroll
            for (int m = 0; m < 4; ++m) {
                const int ro = ai * 128 + m * 16; const float rs = rt[ro];
                u32x4 w;
#pragma unroll
                for (int n = 0; n < 2; ++n) {
                    const f32x4 gv = acc[ai][0][m][n] * rs + bv[0][n], uv = acc[ai][1][m][n] * rs + bv[1][n];
                    const float a0 = silu_fast(gv[0]) * uv[0], a1 = silu_fast(gv[1]) * uv[1], a2 = silu_fast(gv[2]) * uv[2], a3 = silu_fast(gv[3]) * uv[3];
                    w[2 * n] = pkh8(a0, a1); w[2 * n + 1] = pkh8(a2, a3);
                }
                st_stream<3>((GAS u32x4*)(act + blk_off(row0 + ro, hid0, DFF / 64)), w);
            }
    }
};
struct EpiNull {
    static constexpr bool MID = false;
    __device__ __forceinline__ void mid(f32x4 (&)[2][2][4][2], const pg8::Unit&, int, int, int, int, int) const {}
    __device__ __forceinline__ void operator()(AccRef acc, const pg8::Unit& u, int ui, int wr, int wc, int fr, int fq) const {
#pragma unroll
        for (int ai = 0; ai < 2; ++ai)
#pragma unroll
            for (int bj = 0; bj < 2; ++bj)
#pragma unroll
                for (int m = 0; m < 4; ++m)
#pragma unroll
                    for (int n = 0; n < 2; ++n) asm volatile("" :: "v"(acc[ai][bj][m][n]));
    }
};
template <bool RES_F32, bool TWOSCALE, bool WRITE_HG, int PVAR = 0> struct EpiResid {
    static constexpr bool MID = TWOSCALE;
    const GAS float* xres; GAS h16* H; GAS h16* HG; const GAS float* cs; const GAS float* gp; GAS float* ssq; const LAS float* sct; float cmul;
    __device__ __forceinline__ void mid(f32x4 (&acc)[2][2][4][2], const pg8::Unit& u, int ui, int wr, int wc, int fr, int fq) const {
        if constexpr (TWOSCALE) {
            const LAS float* t = sct + ui * 512 + wr * 64 + fr;
#pragma unroll
            for (int ai = 0; ai < 2; ++ai)
#pragma unroll
                for (int m = 0; m < 4; ++m) { const float f = t[ai * 128 + m * 16];
#pragma unroll
                    for (int bj = 0; bj < 2; ++bj)
#pragma unroll
                        for (int n = 0; n < 2; ++n) acc[ai][bj][m][n] *= f; }
        }
    }
    __device__ __forceinline__ void operator()(AccRef acc, const pg8::Unit& u, int ui, int wr, int wc, int fr, int fq) const {
        const int b = u.pm >> 5, row0 = u.pm * 256 + wr * 64 + fr, col0 = u.pn * 256 + wc * 32 + 8 * fq;
        f32x4 csv[2][2], gpv[2][2];
#pragma unroll
        for (int bj = 0; bj < 2; ++bj)
#pragma unroll
            for (int n = 0; n < 2; ++n) { csv[bj][n] = *(const GAS f32x4*)(cs + b * D + col0 + bj * 128 + 4 * n) * cmul; if constexpr (WRITE_HG) gpv[bj][n] = *(const GAS f32x4*)(gp + b * D + col0 + bj * 128 + 4 * n); }
        constexpr int MB_ = RES_F32 ? 2 : 4;
#pragma unroll
        for (int ai = 0; ai < 2; ++ai)
#pragma unroll
        for (int m0 = 0; m0 < 4; m0 += MB_) {
            f32x4 rf[4][2][2]; h16x8 rh[4][2];
#pragma unroll
            for (int m = m0; m < m0 + MB_; ++m)
#pragma unroll
                for (int bj = 0; bj < 2; ++bj) { const size_t off = (size_t)(row0 + ai * 128 + m * 16) * D + col0 + bj * 128;
                    if constexpr (PVAR == 2 || PVAR == 6 || PVAR == 7) { rf[m][bj][0] = (f32x4){0.f, 0.f, 0.f, 0.f}; rf[m][bj][1] = rf[m][bj][0]; rh[m][bj] = (h16x8){0, 0, 0, 0, 0, 0, 0, 0}; }
                    else if constexpr (PVAR == 3) { const h16x8 t = *(const GAS h16x8*)(HG + blk_off(row0 + ai * 128 + m * 16, col0 + bj * 128, D / 64)); rf[m][bj][0] = (f32x4){(float)t[0], (float)t[1], (float)t[2], (float)t[3]}; rf[m][bj][1] = (f32x4){(float)t[4], (float)t[5], (float)t[6], (float)t[7]}; }
                    else if constexpr (RES_F32) { rf[m][bj][0] = *(const GAS f32x4*)(xres + off); rf[m][bj][1] = *(const GAS f32x4*)(xres + off + 4); }
                    else rh[m][bj] = *(const GAS h16x8*)(H + off); }
            asm volatile("" ::: "memory");
#pragma unroll
            for (int m = m0; m < m0 + MB_; ++m) {
                const int row = row0 + ai * 128 + m * 16; const size_t off = (size_t)row * D + col0;
                float rsc = 1.f; if constexpr (TWOSCALE) rsc = sct[ui * 512 + 256 + wr * 64 + fr + ai * 128 + m * 16];
                float q = 0.f;
#pragma unroll
                for (int bj = 0; bj < 2; ++bj) {
                    f32x4 r0, r1;
                    if constexpr (RES_F32) { r0 = rf[m][bj][0]; r1 = rf[m][bj][1]; }
                    else { const h16x8 hv = rh[m][bj]; r0 = (f32x4){(float)hv[0], (float)hv[1], (float)hv[2], (float)hv[3]}; r1 = (f32x4){(float)hv[4], (float)hv[5], (float)hv[6], (float)hv[7]}; }
                    const f32x4 v0 = r0 + csv[bj][0] * (acc[ai][bj][m][0] * rsc), v1 = r1 + csv[bj][1] * (acc[ai][bj][m][1] * rsc);
                    q += ((v0[0] * v0[0] + v0[1] * v0[1]) + (v0[2] * v0[2] + v0[3] * v0[3])) + ((v1[0] * v1[0] + v1[1] * v1[1]) + (v1[2] * v1[2] + v1[3] * v1[3]));
                    u32x4 w; w[0] = pkh(v0[0], v0[1]); w[1] = pkh(v0[2], v0[3]); w[2] = pkh(v1[0], v1[1]); w[3] = pkh(v1[2], v1[3]);
                    const int colp = u.pn * 256 + wc * 64 + 16 * fq + 8 * bj;
                    if constexpr (PVAR == 1) asm volatile("" :: "v"(w)); else if constexpr (PVAR == 4) *(GAS u32x4*)(H + blk_off(row, col0 + bj * 128, D / 64)) = w;
                    else if constexpr (PVAR == 5) *(GAS u32x4*)(H + (size_t)row * D + colp) = w; else if constexpr (PVAR == 7) __builtin_nontemporal_store(w, (GAS u32x4*)(H + off + bj * 128)); else st_stream<1>((GAS u32x4*)(H + off + bj * 128), w);
                    if constexpr (WRITE_HG) { const f32x4 g0 = v0 * gpv[bj][0], g1 = v1 * gpv[bj][1];
                        u32x4 wg;
                        if constexpr (TWOSCALE) { wg[0] = pkh8(g0[0], g0[1]); wg[1] = pkh8(g0[2], g0[3]); wg[2] = pkh8(g1[0], g1[1]); wg[3] = pkh8(g1[2], g1[3]); }
                        else { wg[0] = pkh(g0[0], g0[1]); wg[1] = pkh(g0[2], g0[3]); wg[2] = pkh(g1[0], g1[1]); wg[3] = pkh(g1[2], g1[3]); }
                        if constexpr (PVAR == 1 || PVAR == 6) asm volatile("" :: "v"(wg)); else if constexpr (PVAR == 7) __builtin_nontemporal_store(wg, (GAS u32x4*)(HG + blk_off(row, col0 + bj * 128, D / 64))); else if constexpr (PVAR == 5) *(GAS u32x4*)(HG + blk_off(row, colp, D / 64)) = wg; else st_stream<2>((GAS u32x4*)(HG + blk_off(row, col0 + bj * 128, D / 64)), wg); }
                }
                q += __shfl_xor(q, 16); q += __shfl_xor(q, 32);
                if (fq == 0) { if constexpr (PVAR == 1) asm volatile("" :: "v"(q)); else ssq[(size_t)row * 16 + u.pn * 4 + wc] = q; }
            }
        }
    }
};
constexpr int CW_PAN = 16384;
struct EpiFinal {
    static constexpr bool MID = false;
    const GAS h16* H; const GAS float* cs; const GAS float* gfin; GAS float* out; unsigned* xs; unsigned* cnt; unsigned* tmo; LAS float* P; LAS float* Sx; float cmul;
    __device__ __forceinline__ void mid(f32x4 (&)[2][2][4][2], const pg8::Unit&, int, int, int, int, int) const {}
    __device__ __forceinline__ void operator()(f32x4 (&acc)[2][2][4][2], const pg8::Unit& u, int ui, int wr, int wc, int fr, int fq) const {
        const int b = u.pm >> 5, row0 = u.pm * 256 + wr * 64 + fr, col0 = u.pn * 256 + wc * 32 + 8 * fq;
        const int tid = threadIdx.x, lane = tid & 63, wid = __builtin_amdgcn_readfirstlane(tid >> 6);
        f32x4 csv[2][2];
#pragma unroll
        for (int bj = 0; bj < 2; ++bj)
#pragma unroll
            for (int n = 0; n < 2; ++n) csv[bj][n] = *(const GAS f32x4*)(cs + b * D + col0 + bj * 128 + 4 * n) * cmul;
#pragma unroll
        for (int ai = 0; ai < 2; ++ai) {
            h16x8 rh[4][2];
#pragma unroll
            for (int m = 0; m < 4; ++m)
#pragma unroll
                for (int bj = 0; bj < 2; ++bj) rh[m][bj] = *(const GAS h16x8*)(H + (size_t)(row0 + ai * 128 + m * 16) * D + col0 + bj * 128);
#pragma unroll
            for (int m = 0; m < 4; ++m) {
                float q = 0.f;
#pragma unroll
                for (int bj = 0; bj < 2; ++bj) { const h16x8 hv = rh[m][bj];
                    const f32x4 v0 = (f32x4){(float)hv[0], (float)hv[1], (float)hv[2], (float)hv[3]} + csv[bj][0] * acc[ai][bj][m][0], v1 = (f32x4){(float)hv[4], (float)hv[5], (float)hv[6], (float)hv[7]} + csv[bj][1] * acc[ai][bj][m][1];
                    acc[ai][bj][m][0] = v0; acc[ai][bj][m][1] = v1;
                    q += ((v0[0] * v0[0] + v0[1] * v0[1]) + (v0[2] * v0[2] + v0[3] * v0[3])) + ((v1[0] * v1[0] + v1[1] * v1[1]) + (v1[2] * v1[2] + v1[3] * v1[3])); }
                q += __shfl_xor(q, 16); q += __shfl_xor(q, 32);
                if (fq == 0) P[(ai * 128 + wr * 64 + m * 16 + fr) * 4 + wc] = q;
            }
        }
        asm volatile("s_waitcnt lgkmcnt(0)" ::: "memory"); __builtin_amdgcn_s_barrier(); asm volatile("" ::: "memory");
        if (tid < 256) {
            const f32x4 p4 = *(const LAS f32x4*)(P + tid * 4);
            __hip_atomic_store(xs + ((size_t)(u.pm * 256 + tid) * 4 + u.pn), __float_as_uint((p4[0] + p4[1]) + (p4[2] + p4[3])), __ATOMIC_RELAXED, __HIP_MEMORY_SCOPE_AGENT);
        }
        asm volatile("s_waitcnt vmcnt(0)" ::: "memory");
        if (wid < 4 && lane == 0) __hip_atomic_fetch_add(cnt + 64 * u.pm, 1u, __ATOMIC_RELAXED, __HIP_MEMORY_SCOPE_AGENT);
        if (wid == 0) {
            unsigned sp = 0u;
            while ((unsigned)__builtin_amdgcn_readfirstlane(__hip_atomic_load(cnt + 64 * u.pm, __ATOMIC_RELAXED, __HIP_MEMORY_SCOPE_AGENT)) < 16u) {
                __builtin_amdgcn_s_sleep(2);
                if (++sp > (1u << 16)) { if (lane == 0) __hip_atomic_store(tmo, 1u, __ATOMIC_RELAXED, __HIP_MEMORY_SCOPE_AGENT); break; }
            }
            __builtin_amdgcn_fence(__ATOMIC_ACQUIRE, "agent");
        }
        asm volatile("s_waitcnt vmcnt(0) lgkmcnt(0)" ::: "memory"); __builtin_amdgcn_s_barrier(); asm volatile("" ::: "memory");
        if (tid < 256) {
            const unsigned* sl = xs + (size_t)(u.pm * 256 + tid) * 4;
            const float s0 = __uint_as_float(__hip_atomic_load(sl + 0, __ATOMIC_RELAXED, __HIP_MEMORY_SCOPE_AGENT)), s1 = __uint_as_float(__hip_atomic_load(sl + 1, __ATOMIC_RELAXED, __HIP_MEMORY_SCOPE_AGENT)),
                        s2 = __uint_as_float(__hip_atomic_load(sl + 2, __ATOMIC_RELAXED, __HIP_MEMORY_SCOPE_AGENT)), s3 = __uint_as_float(__hip_atomic_load(sl + 3, __ATOMIC_RELAXED, __HIP_MEMORY_SCOPE_AGENT));
            Sx[tid] = rsqrtf(((s0 + s1) + (s2 + s3)) * (1.f / D) + EPS);
        }
        asm volatile("s_waitcnt vmcnt(0) lgkmcnt(0)" ::: "memory"); __builtin_amdgcn_s_barrier(); asm volatile("" ::: "memory");
        f32x4 gv[2][2];
#pragma unroll
        for (int bj = 0; bj < 2; ++bj)
#pragma unroll
            for (int n = 0; n < 2; ++n) gv[bj][n] = *(const GAS f32x4*)(gfin + col0 + bj * 128 + 4 * n);
#pragma unroll
        for (int ai = 0; ai < 2; ++ai)
#pragma unroll
            for (int m = 0; m < 4; ++m) { const int rl = ai * 128 + wr * 64 + m * 16 + fr; const float rs = Sx[rl]; GAS float* op = out + (size_t)(u.pm * 256 + rl) * D + col0;
#pragma unroll
                for (int bj = 0; bj < 2; ++bj) { st_stream<0>((GAS f32x4*)(op + bj * 128), acc[ai][bj][m][0] * rs * gv[bj][0]); st_stream<0>((GAS f32x4*)(op + bj * 128 + 4), acc[ai][bj][m][1] * rs * gv[bj][1]); } }
        asm volatile("s_waitcnt lgkmcnt(0)" ::: "memory"); __builtin_amdgcn_s_barrier(); asm volatile("" ::: "memory");
    }
};
struct EpiInproj {
    static constexpr bool MID = false;
    GAS h16* proj; const LAS float* rtab; const GAS float* bias; const GAS float* rope; GAS float* kmp;
    __device__ __forceinline__ void mid(f32x4 (&)[2][2][4][2], const pg8::Unit&, int, int, int, int, int) const {}
    __device__ __forceinline__ void operator()(AccRef acc, const pg8::Unit& u, int ui, int wr, int wc, int fr, int fq) const {
        const int b = u.pm >> 5, row0 = u.pm * 256 + wr * 64 + fr, region = u.pn >> 1;
        const GAS float* bp = bias + b * INW + u.pn * 256 + wc * 32 + 4 * fq;
        f32x4 bv[2][2];
#pragma unroll
        for (int bj = 0; bj < 2; ++bj)
#pragma unroll
            for (int n = 0; n < 2; ++n) bv[bj][n] = *(const GAS f32x4*)(bp + bj * 128 + n * 16);
        const bool is_rope = (region == 0) || (region == 2);
        f32x4 csum[2][2];
#pragma unroll
        for (int bj = 0; bj < 2; ++bj)
#pragma unroll
            for (int n = 0; n < 2; ++n) csum[bj][n] = (f32x4){0.f, 0.f, 0.f, 0.f};
        const LAS float* rt = rtab + ui * 256 + wr * 64 + fr;
#pragma unroll
        for (int ai = 0; ai < 2; ++ai)
#pragma unroll
        for (int m0 = 0; m0 < 4; m0 += 2) {
            f32x4 rcs[4][2], rsn[4][2];
            if (is_rope) {
#pragma unroll
                for (int m = m0; m < m0 + 2; ++m) { const GAS float* rp = rope + (size_t)((row0 + ai * 128 + m * 16) & (S - 1)) * 64 + 4 * fq;
#pragma unroll
                    for (int n = 0; n < 2; ++n) { rcs[m][n] = *(const GAS f32x4*)(rp + 16 * n); rsn[m][n] = *(const GAS f32x4*)(rp + 32 + 16 * n); } }
            }
            asm volatile("" ::: "memory");
#pragma unroll
            for (int m = m0; m < m0 + 2; ++m) {
                const int row = row0 + ai * 128 + m * 16;
                const float rs = rt[ai * 128 + m * 16];
                f32x4 v[2][2];
#pragma unroll
                for (int bj = 0; bj < 2; ++bj)
#pragma unroll
                    for (int n = 0; n < 2; ++n) v[bj][n] = acc[ai][bj][m][n] * rs + bv[bj][n];
                GAS h16* prow = proj + (size_t)row * INW + region * 512 + (u.pn & 1) * 256;
                if (is_rope) {
                    const float qs = (region == 0) ? C2 : 1.f;
#pragma unroll
                    for (int n = 0; n < 2; ++n) {
                        const f32x4 cs4 = rcs[m][n] * qs, sn4 = rsn[m][n] * qs;
                        const f32x4 x1 = v[0][n], x2 = v[1][n];
                        v[0][n] = x1 * cs4 - x2 * sn4; v[1][n] = x2 * cs4 + x1 * sn4;
                    }
                    GAS h16* hp = prow + wc * 64 + 16 * fq;
#pragma unroll
                    for (int bj = 0; bj < 2; ++bj) { u32x4 w; w[0] = pkh(v[bj][0][0], v[bj][0][1]); w[1] = pkh(v[bj][0][2], v[bj][0][3]); w[2] = pkh(v[bj][1][0], v[bj][1][1]); w[3] = pkh(v[bj][1][2], v[bj][1][3]);
                        st_stream<4>((GAS u32x4*)(hp + 8 * bj), w); }
                    if (region == 2) {
#pragma unroll
                        for (int bj = 0; bj < 2; ++bj)
#pragma unroll
                            for (int n = 0; n < 2; ++n) csum[bj][n] += v[bj][n];
                    }
                } else {
                    if (region == 1 || region == 4) {
#pragma unroll
                        for (int bj = 0; bj < 2; ++bj)
#pragma unroll
                            for (int n = 0; n < 2; ++n)
#pragma unroll
                                for (int j = 0; j < 4; ++j) v[bj][n][j] = gelu_fast(v[bj][n][j]);
                    }
                    GAS h16* hp = prow + wc * 32 + 8 * fq;
#pragma unroll
                    for (int bj = 0; bj < 2; ++bj) { u32x4 w; w[0] = pkh(v[bj][0][0], v[bj][0][1]); w[1] = pkh(v[bj][0][2], v[bj][0][3]); w[2] = pkh(v[bj][1][0], v[bj][1][1]); w[3] = pkh(v[bj][1][2], v[bj][1][3]);
                        st_stream<4>((GAS u32x4*)(hp + 128 * bj), w); }
                }
            }
        }
        if (region == 2) {
#pragma unroll
            for (int bj = 0; bj < 2; ++bj)
#pragma unroll
                for (int n = 0; n < 2; ++n)
#pragma unroll
                    for (int j = 0; j < 4; ++j) { float t = csum[bj][n][j]; t += __shfl_xor(t, 1); t += __shfl_xor(t, 2); t += __shfl_xor(t, 4); t += __shfl_xor(t, 8); csum[bj][n][j] = t; }
            if (fr == 0) {
                GAS float* kp = kmp + ((size_t)((b * NBLK + (u.pm & 31)) * 2 + wr)) * 512 + ((u.pn & 1) * 4 + wc) * 64 + 16 * fq;
#pragma unroll
                for (int bj = 0; bj < 2; ++bj)
#pragma unroll
                    for (int n = 0; n < 2; ++n) *(GAS f32x4*)(kp + 8 * bj + 4 * n) = csum[bj][n];
            }
        }
    }
};

#define XB_TMO      128
#define XB_XCNT(j)  (256  + 64 * (j))
#define XB_XSUB(j)  (1280 + 64 * (j))
#define XB_XGEN(j)  (2304 + 64 * (j))
#define XB_TOP      3328
#define XB_TOPGEN   3392
#define XCD_BAR_WORDS 3456
#define XB_SPIN_CAP (1u << 18)
__device__ __forceinline__ unsigned xb_ld(unsigned* p)              { return __hip_atomic_load(p, __ATOMIC_RELAXED, __HIP_MEMORY_SCOPE_AGENT); }
__device__ __forceinline__ unsigned xb_add(unsigned* p, unsigned v) { return __hip_atomic_fetch_add(p, v, __ATOMIC_RELAXED, __HIP_MEMORY_SCOPE_AGENT); }
__device__ __forceinline__ unsigned xb_xcc_id() { return (unsigned)__builtin_amdgcn_s_getreg((3 << 11) | 20) & 0xFu; }
#define XB_SPIN(cond, bar) do { unsigned _sp = 0; while (cond) { __builtin_amdgcn_s_sleep(1); \
    if ((++_sp & 255u) == 0u) { if (xb_ld(&(bar)[XB_TMO])) break; if (_sp > XB_SPIN_CAP) { atomicAdd(&(bar)[XB_TMO], 1u); break; } } } } while (0)
struct XcdBarrier { unsigned* bar; unsigned x; volatile LAS unsigned* st; };
__device__ __forceinline__ XcdBarrier xcd_barrier_post(unsigned* bar, volatile LAS unsigned* st) {
    XcdBarrier b; b.bar = bar; b.x = xb_xcc_id(); b.st = st;
    if (threadIdx.x == 0) (void)xb_add(&bar[XB_XCNT(b.x)], 1u);
    return b;
}
__device__ __forceinline__ void xcd_barrier_complete(unsigned* bar, unsigned x, unsigned& nloc, unsigned& nx) {
    const unsigned G = gridDim.x * gridDim.y * gridDim.z;
    unsigned sum, cnt, mine, sp = 0u;
    for (;;) {
        sum = 0u; cnt = 0u; mine = 0u;
#pragma unroll
        for (unsigned j = 0; j < 16; ++j) { const unsigned c = xb_ld(&bar[XB_XCNT(j)]); sum += c; cnt += (c > 0u) ? 1u : 0u; mine = (j == x) ? c : mine; }
        if (sum == G) break;
        __builtin_amdgcn_s_sleep(1);
        if ((++sp & 255u) == 0u) { if (xb_ld(&bar[XB_TMO])) break; if (sp > XB_SPIN_CAP) { atomicAdd(&bar[XB_TMO], 1u); break; } }
    }
    nloc = mine > 0u ? mine : 1u; nx = cnt > 0u ? cnt : 1u;
}
__device__ __forceinline__ void xcd_barrier(const XcdBarrier& b) {
    asm volatile("s_waitcnt vmcnt(0)" ::: "memory");
    __syncthreads();
    if (threadIdx.x == 0) {
        unsigned* bar = b.bar;
        __builtin_amdgcn_s_waitcnt(0);
        unsigned nloc = b.st[0], nx = b.st[1];
        if (nloc == 0u) { xcd_barrier_complete(bar, b.x, nloc, nx); b.st[0] = nloc; b.st[1] = nx; }
        const unsigned old = xb_add(&bar[XB_XSUB(b.x)], 1u);
        const unsigned gen = old / nloc;
        if (old + 1u == (gen + 1u) * nloc) {
            __builtin_amdgcn_fence(__ATOMIC_RELEASE, "agent");
            asm volatile("s_waitcnt vmcnt(0)" ::: "memory");
            const unsigned og = xb_add(&bar[XB_TOP], 1u);
            const unsigned tg = og / nx;
            if (og + 1u == (tg + 1u) * nx) xb_add(&bar[XB_TOPGEN], 1u);
            else XB_SPIN(xb_ld(&bar[XB_TOPGEN]) == tg, bar);
            __builtin_amdgcn_fence(__ATOMIC_ACQUIRE, "agent");
            xb_add(&bar[XB_XGEN(b.x)], 1u);
            asm volatile("s_waitcnt vmcnt(0)" ::: "memory");
        } else {
            XB_SPIN(xb_ld(&bar[XB_XGEN(b.x)]) == gen, bar);
            __builtin_amdgcn_fence(__ATOMIC_ACQUIRE, "agent");
            asm volatile("s_waitcnt vmcnt(0)" ::: "memory");
        }
    }
    __syncthreads();
}

#define GIN(a_, i_) ((const GAS float*)(a_).in[i_])
struct Args { const float* in[20]; float* out; unsigned char* ws; int ph_lo, ph_hi; int shadow, pad; };
struct Frame {
    LAS unsigned char* lds; volatile LAS unsigned* MISC; unsigned* ctl;
    int tid, lane, wave, vcu, G;
    unsigned char* ws; GAS float* out;
};

__device__ __forceinline__ float round8(float x) { return round8a(x); }
__device__ __forceinline__ int p8(int l) { return (l & ~31) + 16 * ((l >> 2) & 1) + 4 * ((l >> 3) & 3) + (l & 3); }
__device__ __forceinline__ int phys_gu(int L) { const int isu = L >= DFF, hid = isu ? L - DFF : L, pn = hid >> 7, hh = hid & 127; return 256 * pn + 128 * isu + p8(hh); }
__device__ __forceinline__ int phys_in(int L) {
    const int reg = L >> 9, l = L & 511;
    const int preg = reg == 0 ? 0 : reg == 1 ? 2 : reg == 2 ? 3 : reg == 3 ? 1 : 4;
    if (reg <= 1) { const int head = l >> 6, d = l & 63, bj = d >> 5, i = d & 31; return 512 * preg + 256 * (head >> 2) + 128 * bj + 32 * (head & 3) + i; }
    return 512 * preg + p8(l);
}
enum PhysKind { PH_GU = 0, PH_P8 = 1, PH_IN = 2 };
template <int KIND> __device__ __forceinline__ int physmap(int L) { return KIND == PH_GU ? phys_gu(L) : KIND == PH_P8 ? p8(L) : phys_in(L); }

template <int KIND, bool LOWENT = false> __device__ __forceinline__ void p0_transpose_item(const GAS float* W, int K, int N, GAS h16* WT, const GAS float* kscale, LAS float* scr, int item, int lane) {
    const int nblk = N / 32, kb = item / nblk, nb = item % nblk, k0 = 64 * kb, n0 = 32 * nb;
    float wv[32];
#pragma unroll
    for (int i = 0; i < 32; ++i) { const int kk = 2 * i + (lane >> 5); wv[i] = W[(size_t)(k0 + kk) * N + n0 + (lane & 31)]; }
    if (kscale) {
#pragma unroll
        for (int i = 0; i < 32; ++i) wv[i] *= kscale[k0 + 2 * i + (lane >> 5)]; }
#pragma unroll
    for (int i = 0; i < 32; ++i) scr[(2 * i + (lane >> 5)) * 33 + (lane & 31)] = (LOWENT && MK_LOWENT) ? round8(wv[i]) : wv[i];
    LDS_WAIT(); asm volatile("" ::: "memory");
    const int c = lane & 7;
#pragma unroll
    for (int j = 0; j < 4; ++j) { const int n = (lane >> 3) + 8 * j; const LAS float* s = scr + (8 * c) * 33 + n;
        u32x4 o; o.x = pkh(s[0 * 33], s[1 * 33]); o.y = pkh(s[2 * 33], s[3 * 33]); o.z = pkh(s[4 * 33], s[5 * 33]); o.w = pkh(s[6 * 33], s[7 * 33]);
        *(GAS u32x4*)(WT + blk_off(physmap<KIND>(n0 + n), k0 + 8 * c, K / 64)) = o; }
    LDS_WAIT(); asm volatile("" ::: "memory");
}

__device__ __forceinline__ void p0_prologue(const Frame& F0, const Args& a) {
    Frame F = F0; F.tid = threadIdx.x; F.lane = F.tid & 63; F.wave = __builtin_amdgcn_readfirstlane(F.tid >> 6);
    const GAS float* c = GIN(a, 1); const GAS float* w_ada = GIN(a, 2);
    {
        LAS float* red = (LAS float*)F.lds;
        for (int item = F.vcu; item < 72 * 4; item += F.G) {
            const int cg = item % 72, kq = item / 72, hlf = F.lane >> 5, col = cg * 128 + (F.lane & 31) * 4;
            f32x4 acc[4] = {{0.f, 0.f, 0.f, 0.f}, {0.f, 0.f, 0.f, 0.f}, {0.f, 0.f, 0.f, 0.f}, {0.f, 0.f, 0.f, 0.f}};
            const int kbase = kq * 256 + F.wave * 32 + hlf;
#pragma unroll
            for (int i = 0; i < 16; ++i) { const int k = kbase + 2 * i; const f32x4 w4 = *(const GAS f32x4*)(w_ada + (size_t)k * (NMOD * D) + col);
#pragma unroll
                for (int b = 0; b < 4; ++b) { const float cv = c[b * D + k]; const float sv = cv / (1.f + __expf(-cv)); acc[b] += w4 * sv; } }
#pragma unroll
            for (int b = 0; b < 4; ++b)
#pragma unroll
                for (int j = 0; j < 4; ++j) acc[b][j] += __shfl_xor(acc[b][j], 32);
            if (hlf == 0) {
#pragma unroll
                for (int b = 0; b < 4; ++b) *(LAS f32x4*)(red + (F.wave * 4 + b) * 128 + (F.lane & 31) * 4) = acc[b];
            }
            __syncthreads();
            { const int b = F.tid >> 7, cc = F.tid & 127; float s = 0.f;
#pragma unroll
              for (int w = 0; w < 8; ++w) s += red[(w * 4 + b) * 128 + cc];
              ((GAS float*)(F.ws + WS_MODP))[(size_t)(kq * 4 + b) * (NMOD * D) + cg * 128 + cc] = s; }
            __syncthreads();
        }
    }
    LAS float* scr = (LAS float*)(F.lds + F.wave * 16384);
    const int gw = F.vcu * NWAVES + F.wave, NGW = F.G * NWAVES;
    constexpr int I_GU = (D / 64) * (NGU / 32), I_DN = (DFF / 64) * (D / 32), I_IN = (D / 64) * (INW / 32), I_OUT = (D / 64) * (D / 32);
    constexpr int NITEMS = 2 * I_GU + 2 * I_DN + I_IN + I_OUT;
    for (int it = gw; it < NITEMS; it += NGW) {
        int r = it;
        if (r < I_GU) { p0_transpose_item<PH_GU, true>(GIN(a, 5), D, NGU, (GAS h16*)(F.ws + WS_WGU1), nullptr, scr, r, F.lane); continue; } r -= I_GU;
        if (r < I_GU) { p0_transpose_item<PH_GU, true>(GIN(a, 17), D, NGU, (GAS h16*)(F.ws + WS_WGU2), nullptr, scr, r, F.lane); continue; } r -= I_GU;
        if (r < I_DN) { p0_transpose_item<PH_P8, true>(GIN(a, 6), DFF, D, (GAS h16*)(F.ws + WS_WD1), nullptr, scr, r, F.lane); continue; } r -= I_DN;
        if (r < I_DN) { p0_transpose_item<PH_P8, true>(GIN(a, 18), DFF, D, (GAS h16*)(F.ws + WS_WD2), nullptr, scr, r, F.lane); continue; } r -= I_DN;
        if (r < I_IN) { p0_transpose_item<PH_IN>(GIN(a, 8), D, INW, (GAS h16*)(F.ws + WS_WIN), nullptr, scr, r, F.lane); continue; } r -= I_IN;
        {
            const int kb = r / (D / 32); const GAS float* ks = (kb < 8) ? GIN(a, 13) : (GIN(a, 14) - 512);
            p0_transpose_item<PH_P8>(GIN(a, 15), D, D, (GAS h16*)(F.ws + WS_WOUT), ks, scr, r, F.lane); }
    }
    for (int pos = gw; pos < S; pos += NGW) {
        const int i = F.lane & 31;
        const float inv = (float)exp(-(double)i / 32.0 * 9.210340371976184);
        const float ang = (float)pos * inv;
        const double da = (double)ang;
        ((GAS float*)(F.ws + WS_ROPE))[(size_t)pos * 64 + F.lane] = (F.lane < 32) ? (float)cos(da) : (float)sin(da);
    }
    for (int e = gw * 64 + F.lane; e < NH * GC * GC; e += NGW * 64) { const int t = (e >> 7) & 127, s = e & 127; ((GAS h16*)(F.ws + WS_WS16))[e] = (s <= t) ? (h16)GIN(a, 11)[e] : (h16)0.f; }
}

__device__ __forceinline__ void p1_prep(const Frame& F0, const Args& a) {
    Frame F = F0; F.tid = threadIdx.x; F.lane = F.tid & 63; F.wave = __builtin_amdgcn_readfirstlane(F.tid >> 6);
    LAS float* modl = (LAS float*)F.lds;
    const GAS float* modp = (const GAS float*)(F.ws + WS_MODP); const GAS float* b_ada = GIN(a, 3);
    const size_t st = (size_t)4 * NMOD * D;
    for (int e = F.tid; e < 4 * 6 * D; e += NWAVES * 64) {
        const int b = e / (6 * D), sl = (e / D) % 6, k = e % D; const int mi = (sl < 3) ? 3 * sl : 3 * (sl - 3) + 1;
        const size_t o = (size_t)b * (NMOD * D) + mi * D + k;
        modl[e] = ((modp[o] + modp[o + st]) + (modp[o + 2 * st] + modp[o + 3 * st])) + b_ada[mi * D + k];
    }
    __syncthreads();
    if (F.vcu == 0) {
        GAS float* GT = (GAS float*)(F.ws + WS_GT); GAS float* GP = (GAS float*)(F.ws + WS_GP);
        for (int e = F.tid; e < 3 * 4 * D; e += NWAVES * 64) {
            const int j = e / (4 * D), b = (e / D) % 4, k = e % D; const int mi = 3 * j + 2;
            const size_t o = (size_t)b * (NMOD * D) + mi * D + k;
            GT[e] = ((modp[o] + modp[o + st]) + (modp[o + 2 * st] + modp[o + 3 * st])) + b_ada[mi * D + k];
            const GAS float* g = j == 0 ? GIN(a, 4) : j == 1 ? GIN(a, 7) : GIN(a, 16);
            GP[e] = g[k] * (1.f + modl[(b * 6 + 3 + j) * D + k]);
        }
    }
    const GAS float* x = GIN(a, 0); const GAS float* g1 = GIN(a, 4);
    GAS h16* XG = (GAS h16*)(F.ws + WS_HG); GAS float* R1 = (GAS float*)(F.ws + WS_R1);
    for (int chunk = F.vcu; chunk < M / 128; chunk += F.G) {
        const int b = chunk / (S / 128);
        f32x4 scl[2][2];
#pragma unroll
        for (int j = 0; j < 2; ++j)
#pragma unroll
            for (int h = 0; h < 2; ++h) { const int k = 8 * F.lane + 512 * j + 4 * h; const f32x4 gg = *(const GAS f32x4*)(g1 + k); const LAS float* sc = modl + (b * 6 + 3) * D + k;
                scl[j][h] = gg * ((f32x4){1.f + sc[0], 1.f + sc[1], 1.f + sc[2], 1.f + sc[3]}); }
        for (int rb = 0; rb < 16; rb += 4) {
            f32x4 v[4][2][2]; float q[4];
#pragma unroll
            for (int r4 = 0; r4 < 4; ++r4) { const GAS float* xr = x + (size_t)(chunk * 128 + F.wave * 16 + rb + r4) * D + 8 * F.lane;
#pragma unroll
                for (int j = 0; j < 2; ++j) { v[r4][j][0] = *(const GAS f32x4*)(xr + 512 * j); v[r4][j][1] = *(const GAS f32x4*)(xr + 512 * j + 4); } }
            asm volatile("" ::: "memory");
#pragma unroll
            for (int r4 = 0; r4 < 4; ++r4) { float t = 0.f;
#pragma unroll
                for (int j = 0; j < 2; ++j)
#pragma unroll
                    for (int h = 0; h < 2; ++h) t += (v[r4][j][h][0] * v[r4][j][h][0] + v[r4][j][h][1] * v[r4][j][h][1]) + (v[r4][j][h][2] * v[r4][j][h][2] + v[r4][j][h][3] * v[r4][j][h][3]);
                q[r4] = t; }
#pragma unroll
            for (int o = 1; o < 64; o <<= 1)
#pragma unroll
                for (int r4 = 0; r4 < 4; ++r4) q[r4] += __shfl_xor(q[r4], o);
#pragma unroll
            for (int r4 = 0; r4 < 4; ++r4) {
                const int row = chunk * 128 + F.wave * 16 + rb + r4;
                if (F.lane == 0) R1[row] = rsqrtf(q[r4] * (1.f / D) + EPS);
#pragma unroll
                for (int j = 0; j < 2; ++j) { const int k = 8 * F.lane + 512 * j; u32x4 w;
#pragma unroll
                    for (int h = 0; h < 2; ++h) { const f32x4 o = v[r4][j][h] * scl[j][h]; w[2 * h] = pkh8(o[0], o[1]); w[2 * h + 1] = pkh8(o[2], o[3]); }
                    *(GAS u32x4*)(XG + blk_off(row, k, D / 64)) = w; }
            }
        }
    }
    const int gw = F.vcu * NWAVES + F.wave, NGW = F.G * NWAVES;
    for (int it = gw; it < NGU + INW + NGU; it += NGW) {
        int n = it, j; const GAS h16* W; GAS float* B; int NN;
        if (n < NGU) { j = 0; W = (const GAS h16*)(F.ws + WS_WGU1); B = (GAS float*)(F.ws + WS_BIAS1); NN = NGU; }
        else if (n < NGU + INW) { n -= NGU; j = 1; W = (const GAS h16*)(F.ws + WS_WIN); B = (GAS float*)(F.ws + WS_BIAS2); NN = INW; }
        else { n -= NGU + INW; j = 2; W = (const GAS h16*)(F.ws + WS_WGU2); B = (GAS float*)(F.ws + WS_BIAS3); NN = NGU; }
        const h16x8 w0 = *(const GAS h16x8*)(W + blk_off(n, 16 * F.lane, D / 64)), w1 = *(const GAS h16x8*)(W + blk_off(n, 16 * F.lane + 8, D / 64));
        float s[4];
#pragma unroll
        for (int b = 0; b < 4; ++b) { const LAS float* sh = modl + (b * 6 + j) * D + 16 * F.lane; float t = 0.f;
#pragma unroll
            for (int e = 0; e < 8; ++e) t += sh[e] * (float)w0[e] + sh[8 + e] * (float)w1[e];
            s[b] = wave_sum(t); }
        if (F.lane == 0) { B[0 * NN + n] = s[0]; B[1 * NN + n] = s[1]; B[2 * NN + n] = s[2]; B[3 * NN + n] = s[3]; }
    }
    __syncthreads();
}

__device__ __forceinline__ void p_final(const Frame& F0, const Args& a) {
    Frame F = F0; F.tid = threadIdx.x; F.lane = F.tid & 63; F.wave = __builtin_amdgcn_readfirstlane(F.tid >> 6);
    const GAS h16* H = (const GAS h16*)(F.ws + WS_H); const GAS float* ssq = (const GAS float*)(F.ws + WS_SSQF); const GAS float* gf = GIN(a, 19);
    const int gw = F.vcu * NWAVES + F.wave, NGW = F.G * NWAVES;
    f32x4 g[2][2];
#pragma unroll
    for (int j = 0; j < 2; ++j)
#pragma unroll
        for (int h = 0; h < 2; ++h) g[j][h] = *(const GAS f32x4*)(gf + 8 * F.lane + 512 * j + 4 * h);
    for (int row = gw; row < M; row += NGW) {
        const float rs = rs16(ssq + (size_t)row * 16);
#pragma unroll
        for (int j = 0; j < 2; ++j) { const h16x8 hv = *(const GAS h16x8*)(H + (size_t)row * D + 8 * F.lane + 512 * j);
            f32x4 o0 = (f32x4){(float)hv[0], (float)hv[1], (float)hv[2], (float)hv[3]} * rs * g[j][0], o1 = (f32x4){(float)hv[4], (float)hv[5], (float)hv[6], (float)hv[7]} * rs * g[j][1];
            *(GAS f32x4*)(a.out + (size_t)row * D + 8 * F.lane + 512 * j) = o0; *(GAS f32x4*)(a.out + (size_t)row * D + 8 * F.lane + 512 * j + 4) = o1; }
    }
}


typedef float f32x16 __attribute__((ext_vector_type(16)));
typedef short v4i16_t __attribute__((ext_vector_type(4)));
__device__ __forceinline__ h16x4 tr16(const LAS unsigned char* p) { return __builtin_bit_cast(h16x4, __builtin_amdgcn_ds_read_tr16_b64_v4i16((LAS v4i16_t*)p)); }
__device__ __forceinline__ int vt_off(int t, int c8) { return t * 128 + (((c8 >> 2) ^ ((t >> 1) & 1)) << 6) + ((c8 & 3) << 4); }

__device__ __forceinline__ void gmlp_phase(const Frame& F0, const Args& a, int shadow) {
    const int tid = threadIdx.x, lane = tid & 63, wave = __builtin_amdgcn_readfirstlane(tid >> 6), r32 = lane & 31, hi = lane >> 5;
    GAS h16* proj = (GAS h16*)(F0.ws + WS_PROJ); const GAS h16* W16 = (const GAS h16*)(F0.ws + WS_WS16); GAS float* RG = (GAS float*)(F0.ws + WS_RG);
    const GAS float* ln_g = GIN(a, 9); const GAS float* ln_b = GIN(a, 10); const GAS float* b_s = GIN(a, 12);
    LAS unsigned char* lds = F0.lds;
    LAS float* rowsq = (LAS float*)(lds + MISC_OFF + 128);
    f32x4 g0 = *(const GAS f32x4*)(ln_g + 8 * lane), g1 = *(const GAS f32x4*)(ln_g + 8 * lane + 4), b0 = *(const GAS f32x4*)(ln_b + 8 * lane), b1 = *(const GAS f32x4*)(ln_b + 8 * lane + 4);
    for (int unit = F0.vcu; unit < M / GC; unit += F0.G) {
        const size_t row0 = (size_t)unit * GC;
        {
            h16x8 hv[16]; float sm[16], mu[16], rsd[16];
#pragma unroll
            for (int rr = 0; rr < 16; ++rr) hv[rr] = *(const GAS h16x8*)(proj + (row0 + wave * 16 + rr) * INW + PG + 8 * lane);
#pragma unroll
            for (int rr = 0; rr < 16; ++rr) { float t = 0.f;
#pragma unroll
                for (int e = 0; e < 8; ++e) t += (float)hv[rr][e];
                sm[rr] = t; }
#pragma unroll
            for (int o = 1; o < 64; o <<= 1)
#pragma unroll
                for (int rr = 0; rr < 16; ++rr) sm[rr] += __shfl_xor(sm[rr], o);
#pragma unroll
            for (int rr = 0; rr < 16; ++rr) { mu[rr] = sm[rr] * (1.f / 512.f); float q = 0.f;
#pragma unroll
                for (int e = 0; e < 8; ++e) { const float d = (float)hv[rr][e] - mu[rr]; q += d * d; }
                sm[rr] = q; }
#pragma unroll
            for (int o = 1; o < 64; o <<= 1)
#pragma unroll
                for (int rr = 0; rr < 16; ++rr) sm[rr] += __shfl_xor(sm[rr], o);
#pragma unroll
            for (int rr = 0; rr < 16; ++rr) { rsd[rr] = rsqrtf(sm[rr] * (1.f / 512.f) + EPS);
                const int t = wave * 16 + rr; float v[8];
#pragma unroll
                for (int e = 0; e < 8; ++e) v[e] = ((float)hv[rr][e] - mu[rr]) * rsd[rr];
                u32x4 w; w[0] = pkh(v[0] * g0[0] + b0[0], v[1] * g0[1] + b0[1]); w[1] = pkh(v[2] * g0[2] + b0[2], v[3] * g0[3] + b0[3]);
                w[2] = pkh(v[4] * g1[0] + b1[0], v[5] * g1[1] + b1[1]); w[3] = pkh(v[6] * g1[2] + b1[2], v[7] * g1[3] + b1[3]);
                *(LAS u32x4*)(lds + (lane >> 3) * 16384 + vt_off(t, lane & 7)) = w; }
        }
        __syncthreads();
        const GAS h16* Wh = W16 + (size_t)wave * GC * GC;
        const LAS unsigned char* vt = lds + wave * 16384;
        const int q4 = (lane & 15) >> 2, p4 = lane & 3, g1b = (lane >> 4) & 1;
#pragma unroll
        for (int tb = 0; tb < 4; ++tb) {
            f32x16 acc[2];
#pragma unroll
            for (int d0 = 0; d0 < 2; ++d0)
#pragma unroll
                for (int e = 0; e < 16; ++e) acc[d0][e] = 0.f;
            h16x8 af[8];
#pragma unroll
            for (int ks = 0; ks < 8; ++ks) if (ks <= 2 * tb + 1) af[ks] = *(const GAS h16x8*)(Wh + (size_t)(32 * tb + r32) * GC + 16 * ks + 8 * hi);
#pragma unroll
            for (int ks = 0; ks < 8; ++ks) {
                if (ks <= 2 * tb + 1) {
#pragma unroll
                    for (int d0 = 0; d0 < 2; ++d0) {
                        const int srow = 16 * ks + 8 * hi + q4, c8 = 4 * d0 + 2 * g1b + (p4 >> 1);
                        const h16x4 lo = tr16(vt + vt_off(srow, c8) + (p4 & 1) * 8), hi4 = tr16(vt + vt_off(srow + 4, c8) + (p4 & 1) * 8);
                        const h16x8 bf = (h16x8){lo[0], lo[1], lo[2], lo[3], hi4[0], hi4[1], hi4[2], hi4[3]};
                        acc[d0] = __builtin_amdgcn_mfma_f32_32x32x16_f16(af[ks], bf, acc[d0], 0, 0, 0);
                    }
                }
            }
            h16 uv0[16], uv1[16]; float bsv[16];
#pragma unroll
            for (int e = 0; e < 16; ++e) { const int t = 32 * tb + (e & 3) + 8 * (e >> 2) + 4 * hi; const GAS h16* up = proj + (row0 + t) * INW + PU + wave * 64 + r32; uv0[e] = up[0]; uv1[e] = up[32]; bsv[e] = b_s[wave * GC + t]; }
            asm volatile("" ::: "memory");
#pragma unroll
            for (int e = 0; e < 16; ++e) {
                const int t = 32 * tb + (e & 3) + 8 * (e >> 2) + 4 * hi;
                GAS h16* up = proj + (row0 + t) * INW + PU + wave * 64 + r32;
                const float o0 = (float)uv0[e] * (acc[0][e] + bsv[e]), o1 = (float)uv1[e] * (acc[1][e] + bsv[e]);
                up[0] = (h16)o0; up[32] = (h16)o1;
                float q = o0 * o0 + o1 * o1;
                q += __shfl_xor(q, 1); q += __shfl_xor(q, 2); q += __shfl_xor(q, 4); q += __shfl_xor(q, 8); q += __shfl_xor(q, 16);
                if (r32 == 0) rowsq[wave * 128 + t] = q;
            }
        }
        __syncthreads();
        if (tid < 128) { float s8 = 0.f;
#pragma unroll
            for (int w = 0; w < 8; ++w) s8 += rowsq[w * 128 + tid];
            RG[row0 + tid] = s8; }
        __syncthreads();
    }
}


constexpr size_t DO_PO = 0, DO_PML = 96 * MiB;
constexpr int CW_CNT = 8192;
constexpr int LISTCAP = 8192;
constexpr int AL_K = 0, AL_V = 32768, AL_STG = 65536, AL_WSF = 98304, AL_START = 102400;
__device__ __forceinline__ int k_off(int key, int c8) { return key * 128 + ((c8 ^ (key & 7)) << 4); }

__device__ __forceinline__ void moba_gate_phase(const Frame& F0, int shadow) {
    const int tid = threadIdx.x, lane = tid & 63;
    const GAS h16* proj = (const GAS h16*)(F0.ws + WS_PROJ); const GAS float* kmp = (const GAS float*)(F0.ws + WS_KMP);
    unsigned* cnt = F0.ctl + CW_CNT + (shadow ? 1024 : 0); GAS unsigned short* lists = (GAS unsigned short*)(F0.ws + (shadow ? WS_HG : WS_LISTS));
    LAS float* km = (LAS float*)F0.lds;
    for (int item = F0.vcu; item < NB * NH * (S / 512); item += F0.G) {
        const int span = item % (S / 512), bh = item / (S / 512), b = bh >> 3, h = bh & 7;
        __syncthreads();
        for (int e = tid; e < NBLK * 64; e += NWAVES * 64) { const int n = e >> 6, d = e & 63; const GAS float* kp = kmp + (size_t)((b * NBLK + n) * 2) * 512 + h * 64 + d; km[e] = kp[0] + kp[512]; }
        __syncthreads();
        const int sq = span * 512 + tid, own = __builtin_amdgcn_readfirstlane(sq >> 8);
        float q[64];
        { const GAS h16* qp = proj + (size_t)(b * S + sq) * INW + PQ + h * 64;
#pragma unroll
          for (int c = 0; c < 8; ++c) { const h16x8 v = *(const GAS h16x8*)(qp + 8 * c);
#pragma unroll
              for (int e = 0; e < 8; ++e) q[8 * c + e] = (float)v[e]; } }
        float v0 = -3e38f, v1 = -3e38f, v2 = -3e38f; int i0 = -1, i1 = -1, i2 = -1;
        for (int n = 0; n < own; ++n) {
            float g0 = 0.f, g1 = 0.f, g2 = 0.f, g3 = 0.f;
#pragma unroll
            for (int c = 0; c < 16; ++c) { const f32x4 kv = *(const LAS f32x4*)(km + n * 64 + 4 * c); g0 += q[4 * c] * kv[0]; g1 += q[4 * c + 1] * kv[1]; g2 += q[4 * c + 2] * kv[2]; g3 += q[4 * c + 3] * kv[3]; }
            const float g = (g0 + g1) + (g2 + g3);
            if (g > v0) { v2 = v1; i2 = i1; v1 = v0; i1 = i0; v0 = g; i0 = n; }
            else if (g > v1) { v2 = v1; i2 = i1; v1 = g; i1 = n; }
            else if (g > v2) { v2 = g; i2 = n; }
        }
        int mycnt = 0, pos0 = 0, pos1 = 0, pos2 = 0;
        const unsigned long long ltmask = (1ull << lane) - 1ull;
        for (int n = 0; n < own; ++n) {
            const bool sel = (i0 == n) || (i1 == n) || (i2 == n);
            const unsigned long long mask = __ballot(sel);
            const int before = __popcll(mask & ltmask);
            if (lane == n) mycnt = __popcll(mask);
            if (i0 == n) pos0 = before; if (i1 == n) pos1 = before; if (i2 == n) pos2 = before;
        }
        unsigned base = 0u;
        if (lane < own && mycnt > 0) base = atomicAdd(cnt + bh * NBLK + lane, (unsigned)mycnt);
        const unsigned bb0 = (unsigned)__shfl((int)base, i0 & 63), bb1 = (unsigned)__shfl((int)base, i1 & 63), bb2 = (unsigned)__shfl((int)base, i2 & 63);
        if (i0 >= 0) lists[(size_t)(bh * NBLK + i0) * LISTCAP + bb0 + pos0] = (unsigned short)(sq | (0 << 13));
        if (i1 >= 0) lists[(size_t)(bh * NBLK + i1) * LISTCAP + bb1 + pos1] = (unsigned short)(sq | (1 << 13));
        if (i2 >= 0) lists[(size_t)(bh * NBLK + i2) * LISTCAP + bb2 + pos2] = (unsigned short)(sq | (2 << 13));
    }
    __syncthreads();
}

template <bool CAUSAL>
__device__ __forceinline__ void attn_tile(const LAS unsigned char* ldsK, const LAS unsigned char* ldsV, const h16x8 (&qf)[4], int wave, int lane, f32x16 (&o)[2], float& m_out, float& l_out) {
    const int r32 = lane & 31, hi = lane >> 5;
    int kbase[4];
#pragma unroll
    for (int ks = 0; ks < 4; ++ks) kbase[ks] = r32 * 128 + (((2 * ks + hi) ^ (r32 & 7)) << 4);
    f32x16 sacc[8];
#pragma unroll
    for (int kb = 0; kb < 8; ++kb) {
        f32x16 acc;
#pragma unroll
        for (int e = 0; e < 16; ++e) acc[e] = 0.f;
#pragma unroll
        for (int ks = 0; ks < 4; ++ks) { const h16x8 kf = *(const LAS h16x8*)(ldsK + kbase[ks] + kb * 4096); acc = __builtin_amdgcn_mfma_f32_32x32x16_f16(kf, qf[ks], acc, 0, 0, 0); }
        if (CAUSAL) {
            const int lim = 32 * (wave - kb) + r32;
#pragma unroll
            for (int e = 0; e < 16; ++e) { const int key = (e & 3) + 8 * (e >> 2) + 4 * hi; if (key > lim) acc[e] = -1e30f; }
        }
        sacc[kb] = acc;
    }
    float m = -3e38f;
#pragma unroll
    for (int kb = 0; kb < 8; ++kb)
#pragma unroll
        for (int e = 0; e < 16; ++e) m = fmaxf(m, sacc[kb][e]);
    m = fmaxf(m, __shfl_xor(m, 32));
    float ls = 0.f;
#pragma unroll
    for (int kb = 0; kb < 8; ++kb)
#pragma unroll
        for (int e = 0; e < 16; ++e) { const float pv = __builtin_amdgcn_exp2f(sacc[kb][e] - m); sacc[kb][e] = pv; ls += pv; }
    ls += __shfl_xor(ls, 32);
#pragma unroll
    for (int d0 = 0; d0 < 2; ++d0)
#pragma unroll
        for (int e = 0; e < 16; ++e) o[d0][e] = 0.f;
    const int q4 = (lane & 15) >> 2, p4 = lane & 3, g1b = (lane >> 4) & 1;
    int vbase[2];
#pragma unroll
    for (int d0 = 0; d0 < 2; ++d0) vbase[d0] = (4 * hi + q4) * 128 + ((d0 ^ ((q4 >> 1) & 1)) << 6) + ((2 * g1b + (p4 >> 1)) << 4) + (p4 & 1) * 8;
#pragma unroll
    for (int kb = 0; kb < 8; ++kb) {
        if (!CAUSAL || kb <= wave) {
#pragma unroll
            for (int s2 = 0; s2 < 2; ++s2) {
                h16x8 pa;
#pragma unroll
                for (int j = 0; j < 8; ++j) pa[j] = (h16)sacc[kb][8 * s2 + j];
#pragma unroll
                for (int d0 = 0; d0 < 2; ++d0) {
                    const h16x4 lo = tr16(ldsV + vbase[d0] + kb * 4096 + s2 * 2048), hi4 = tr16(ldsV + vbase[d0] + kb * 4096 + s2 * 2048 + 1024);
                    const h16x8 bf = (h16x8){lo[0], lo[1], lo[2], lo[3], hi4[0], hi4[1], hi4[2], hi4[3]};
                    o[d0] = __builtin_amdgcn_mfma_f32_32x32x16_f16(pa, bf, o[d0], 0, 0, 0);
                }
            }
        }
    }
    m_out = m; l_out = ls;
}
__device__ __forceinline__ void attn_tile_causal(const LAS unsigned char* ldsK, const LAS unsigned char* ldsV, const h16x8 (&qf)[4], int wave, int lane, f32x16 (&o)[2], float& m_out, float& l_out) {
    const int r32 = lane & 31, hi = lane >> 5;
    int kbase[4];
#pragma unroll
    for (int ks = 0; ks < 4; ++ks) kbase[ks] = r32 * 128 + (((2 * ks + hi) ^ (r32 & 7)) << 4);
    const int q4 = (lane & 15) >> 2, p4 = lane & 3, g1b = (lane >> 4) & 1;
    int vbase[2];
#pragma unroll
    for (int d0 = 0; d0 < 2; ++d0) vbase[d0] = (4 * hi + q4) * 128 + ((d0 ^ ((q4 >> 1) & 1)) << 6) + ((2 * g1b + (p4 >> 1)) << 4) + (p4 & 1) * 8;
    float m = -3e38f;
    for (int kb = 0; kb <= wave; ++kb) {
        f32x16 acc;
#pragma unroll
        for (int e = 0; e < 16; ++e) acc[e] = 0.f;
#pragma unroll
        for (int ks = 0; ks < 4; ++ks) { const h16x8 kf = *(const LAS h16x8*)(ldsK + kbase[ks] + kb * 4096); acc = __builtin_amdgcn_mfma_f32_32x32x16_f16(kf, qf[ks], acc, 0, 0, 0); }
        const int lim = (kb == wave) ? r32 : 64;
#pragma unroll
        for (int e = 0; e < 16; ++e) { const int key = (e & 3) + 8 * (e >> 2) + 4 * hi; if (key <= lim) m = fmaxf(m, acc[e]); }
    }
    m = fmaxf(m, __shfl_xor(m, 32));
    float ls = 0.f;
#pragma unroll
    for (int d0 = 0; d0 < 2; ++d0)
#pragma unroll
        for (int e = 0; e < 16; ++e) o[d0][e] = 0.f;
    for (int kb = 0; kb <= wave; ++kb) {
        f32x16 acc;
#pragma unroll
        for (int e = 0; e < 16; ++e) acc[e] = 0.f;
#pragma unroll
        for (int ks = 0; ks < 4; ++ks) { const h16x8 kf = *(const LAS h16x8*)(ldsK + kbase[ks] + kb * 4096); acc = __builtin_amdgcn_mfma_f32_32x32x16_f16(kf, qf[ks], acc, 0, 0, 0); }
        const int lim = (kb == wave) ? r32 : 64;
#pragma unroll
        for (int e = 0; e < 16; ++e) { const int key = (e & 3) + 8 * (e >> 2) + 4 * hi; const float pv = (key <= lim) ? __builtin_amdgcn_exp2f(acc[e] - m) : 0.f; acc[e] = pv; ls += pv; }
#pragma unroll
        for (int s2 = 0; s2 < 2; ++s2) {
            h16x8 pa;
#pragma unroll
            for (int j = 0; j < 8; ++j) pa[j] = (h16)acc[8 * s2 + j];
#pragma unroll
            for (int d0 = 0; d0 < 2; ++d0) {
                const h16x4 lo = tr16(ldsV + vbase[d0] + kb * 4096 + s2 * 2048), hi4 = tr16(ldsV + vbase[d0] + kb * 4096 + s2 * 2048 + 1024);
                const h16x8 bf = (h16x8){lo[0], lo[1], lo[2], lo[3], hi4[0], hi4[1], hi4[2], hi4[3]};
                o[d0] = __builtin_amdgcn_mfma_f32_32x32x16_f16(pa, bf, o[d0], 0, 0, 0);
            }
        }
    }
    ls += __shfl_xor(ls, 32);
    m_out = m; l_out = ls;
}
__device__ __forceinline__ void load_kv_block(LAS unsigned char* lds, const GAS h16* proj, size_t row0, int h, int tid) {
#pragma unroll
    for (int i = 0; i < 4; ++i) { const int idx = tid + 512 * i, key = idx >> 3, c8 = idx & 7; const GAS h16* rp = proj + (row0 + key) * INW + h * 64 + 8 * c8;
        const u32x4 kv = *(const GAS u32x4*)(rp + PK), vv = *(const GAS u32x4*)(rp + PV);
        *(LAS u32x4*)(lds + AL_K + k_off(key, c8)) = kv; *(LAS u32x4*)(lds + AL_V + vt_off(key, c8)) = vv; }
}
__device__ __forceinline__ void stage_o(LAS unsigned char* stg, LAS float* wsf, const f32x16 (&o)[2], float l, int lane) {
    const int r32 = lane & 31, hi = lane >> 5;
    if (hi == 0) wsf[r32] = 1.f / l;
    LDS_WAIT();
#pragma unroll
    for (int e = 0; e < 16; ++e) { const int qr = (e & 3) + 8 * (e >> 2) + 4 * hi; const float rl = wsf[qr];
        *(LAS h16*)(stg + qr * 128 + r32 * 2) = (h16)(o[0][e] * rl); *(LAS h16*)(stg + qr * 128 + 64 + r32 * 2) = (h16)(o[1][e] * rl); }
    LDS_WAIT();
}

struct KvRegs { u32x4 kv[4], vv[4]; };
__device__ __forceinline__ void kv_fetch(KvRegs& r, const GAS h16* proj, size_t row0, int h, int tid) {
#pragma unroll
    for (int i = 0; i < 4; ++i) { const int idx = tid + 512 * i, key = idx >> 3, c8 = idx & 7; const GAS h16* rp = proj + (row0 + key) * INW + h * 64 + 8 * c8;
        r.kv[i] = *(const GAS u32x4*)(rp + PK); r.vv[i] = *(const GAS u32x4*)(rp + PV); }
}
__device__ __forceinline__ void kv_commit(const KvRegs& r, LAS unsigned char* lds, int tid) {
#pragma unroll
    for (int i = 0; i < 4; ++i) { const int idx = tid + 512 * i, key = idx >> 3, c8 = idx & 7;
        *(LAS u32x4*)(lds + AL_K + k_off(key, c8)) = r.kv[i]; *(LAS u32x4*)(lds + AL_V + vt_off(key, c8)) = r.vv[i]; }
}
__device__ __forceinline__ void moba_b_phase(const Frame& F0, GAS float* dout) {
    const int tid = threadIdx.x, lane = tid & 63, wave = __builtin_amdgcn_readfirstlane(tid >> 6), r32 = lane & 31, hi = lane >> 5;
    const GAS h16* proj = (const GAS h16*)(F0.ws + WS_PROJ); const unsigned* cnt = F0.ctl + CW_CNT; const GAS unsigned short* lists = (const GAS unsigned short*)(F0.ws + WS_LISTS);
    GAS h16* PO = (GAS h16*)((unsigned char*)dout + DO_PO); GAS float* PML = (GAS float*)((unsigned char*)dout + DO_PML);
    LAS unsigned char* lds = F0.lds;
    LAS int* start = (LAS int*)(lds + AL_START);
    LAS float* wsf = (LAS float*)(lds + AL_WSF + wave * 512); LAS int* wsi = (LAS int*)(lds + AL_WSF + wave * 512 + 256);
    LAS unsigned char* stg = lds + AL_STG + wave * 4096;
    {
        const unsigned c0 = cnt[2 * tid], c1 = cnt[2 * tid + 1];
        const int t0 = (int)((c0 + 255u) >> 8), t1 = (int)((c1 + 255u) >> 8);
        int v = t0 + t1, inc = v;
#pragma unroll
        for (int o = 1; o < 64; o <<= 1) { const int u = __shfl_up(inc, o); if (lane >= o) inc += u; }
        LAS int* wtot = (LAS int*)(lds + AL_WSF);
        __syncthreads();
        if (lane == 63) wtot[wave] = inc;
        __syncthreads();
        int pre = 0;
        for (int w = 0; w < wave; ++w) pre += wtot[w];
        const int ex = pre + inc - v;
        __syncthreads();
        start[2 * tid] = ex; start[2 * tid + 1] = ex + t0;
        if (tid == 511) start[1024] = ex + v;
        __syncthreads();
    }
    const int nitems = start[1024];
    for (int item = F0.vcu; item < nitems; item += F0.G) {
        int lo = 0, hi_ = 1024;
        while (hi_ - lo > 1) { const int mid = (lo + hi_) >> 1; if (start[mid] <= item) lo = mid; else hi_ = mid; }
        const int l = lo, chunk = item - start[l];
        const int bh = l >> 5, n = l & 31, b = bh >> 3, h = bh & 7;
        const int nq = (int)cnt[l] - chunk * 256;
        const int qi = chunk * 256 + wave * 32 + r32;
        const bool valid = (wave * 32 + r32) < nq;
        const unsigned ent = lists[(size_t)l * LISTCAP + (valid ? qi : chunk * 256)];
        KvRegs kvr; kv_fetch(kvr, proj, (size_t)b * S + (size_t)n * MBLK, h, tid);
        const int sq = ent & 8191, rank = ent >> 13;
        h16x8 qf[4];
        { const GAS h16* qp = proj + (size_t)(b * S + sq) * INW + PQ + h * 64 + 8 * hi;
#pragma unroll
          for (int ks = 0; ks < 4; ++ks) qf[ks] = *(const GAS h16x8*)(qp + 16 * ks); }
        kv_commit(kvr, lds, tid);
        __syncthreads();
        if (wave * 32 < nq) {
            f32x16 o[2]; float m, lsum;
            attn_tile<false>(lds + AL_K, lds + AL_V, qf, wave, lane, o, m, lsum);
            const int slot = ((b * NH + h) * 3 + rank) * S + sq;
            if (hi == 0) { wsi[r32] = valid ? slot : -1; if (valid) { PML[(size_t)slot * 2] = m; PML[(size_t)slot * 2 + 1] = lsum; } }
            stage_o(stg, wsf, o, lsum, lane);
#pragma unroll
            for (int i = 0; i < 4; ++i) { const int row = i * 8 + (lane >> 3), ch = lane & 7; const int sl = wsi[row];
                if (sl >= 0) *(GAS u32x4*)(PO + (size_t)sl * 64 + ch * 8) = *(const LAS u32x4*)(stg + row * 128 + ch * 16); }
        }
        __syncthreads();
    }
}

__device__ __forceinline__ void moba_c_phase(const Frame& F0, const GAS float* dout, int shadow) {
    const int tid = threadIdx.x, lane = tid & 63, wave = __builtin_amdgcn_readfirstlane(tid >> 6), r32 = lane & 31, hi = lane >> 5;
    GAS h16* proj = (GAS h16*)(F0.ws + WS_PROJ); GAS float* SSQA = (GAS float*)(F0.ws + WS_SSQA);
    const GAS h16* PO = (const GAS h16*)((const unsigned char*)dout + DO_PO); const GAS float* PML = (const GAS float*)((const unsigned char*)dout + DO_PML);
    LAS unsigned char* lds = F0.lds;
    LAS float* wsf = (LAS float*)(lds + AL_WSF + wave * 512);
    LAS unsigned char* stg = lds + AL_STG + wave * 4096;
    KvRegs kvr;
    if (F0.vcu < NB * NH * NBLK) { const int u0 = F0.vcu; kv_fetch(kvr, proj, (size_t)((u0 >> 5) >> 3) * S + (size_t)(u0 & 31) * MBLK, (u0 >> 5) & 7, tid); }
    for (int unit = F0.vcu; unit < NB * NH * NBLK; unit += F0.G) {
        const int qb = unit & 31, bh = unit >> 5, b = bh >> 3, h = bh & 7;
        const size_t row0 = (size_t)b * S + (size_t)qb * MBLK;
        kv_commit(kvr, lds, tid);
        { const int un = unit + F0.G; if (un < NB * NH * NBLK) kv_fetch(kvr, proj, (size_t)((un >> 5) >> 3) * S + (size_t)(un & 31) * MBLK, (un >> 5) & 7, tid); }
        h16x8 qf[4];
        { const GAS h16* qp = proj + (row0 + wave * 32 + r32) * INW + PQ + h * 64 + 8 * hi;
#pragma unroll
          for (int ks = 0; ks < 4; ++ks) qf[ks] = *(const GAS h16x8*)(qp + 16 * ks); }
        __syncthreads();
        f32x16 o[2]; float m, lsum;
        attn_tile_causal(lds + AL_K, lds + AL_V, qf, wave, lane, o, m, lsum);
        if (hi == 0) { wsf[32 + r32] = m; wsf[64 + r32] = lsum; }
        stage_o(stg, wsf, o, lsum, lane);
        const int nsel = qb < 3 ? qb : 3;
#pragma unroll
        for (int i0 = 0; i0 < 4; i0 += 2) {
            float mr[2][3], lr[2][3]; h16x8 pv[2][3];
#pragma unroll
            for (int ii = 0; ii < 2; ++ii) { const size_t grow = row0 + wave * 32 + (i0 + ii) * 8 + (lane >> 3);
#pragma unroll
                for (int r = 0; r < 3; ++r) { if (r < nsel) { const size_t sl = ((size_t)(b * NH + h) * 3 + r) * S + (grow - (size_t)b * S); mr[ii][r] = PML[sl * 2]; lr[ii][r] = PML[sl * 2 + 1]; pv[ii][r] = *(const GAS h16x8*)(PO + sl * 64 + (lane & 7) * 8); } } }
            asm volatile("" ::: "memory");
#pragma unroll
            for (int ii = 0; ii < 2; ++ii) {
                const int row = (i0 + ii) * 8 + (lane >> 3), ch = lane & 7;
                const size_t grow = row0 + wave * 32 + row;
                const float mo = wsf[32 + row], lo_ = wsf[64 + row];
                const h16x8 ov = *(const LAS h16x8*)(stg + row * 128 + ch * 16);
                float mmax = mo;
#pragma unroll
                for (int r = 0; r < 3; ++r) { if (r < nsel) mmax = fmaxf(mmax, mr[ii][r]); }
                float wo = lo_ * __builtin_amdgcn_exp2f(mo - mmax), L = wo;
                float acc[8];
#pragma unroll
                for (int e = 0; e < 8; ++e) acc[e] = wo * (float)ov[e];
#pragma unroll
                for (int r = 0; r < 3; ++r) { if (r < nsel) { const float wr_ = lr[ii][r] * __builtin_amdgcn_exp2f(mr[ii][r] - mmax); L += wr_;
#pragma unroll
                    for (int e = 0; e < 8; ++e) acc[e] += wr_ * (float)pv[ii][r][e]; } }
                const float rL = 1.f / L; float q = 0.f; u32x4 w;
#pragma unroll
                for (int e = 0; e < 8; ++e) { acc[e] *= rL; q += acc[e] * acc[e]; }
                w[0] = pkh(acc[0], acc[1]); w[1] = pkh(acc[2], acc[3]); w[2] = pkh(acc[4], acc[5]); w[3] = pkh(acc[6], acc[7]);
                if (shadow) *(GAS u32x4*)((GAS h16*)(F0.ws + WS_HG) + grow * 512 + h * 64 + ch * 8) = w;
                else *(GAS u32x4*)(proj + grow * INW + PQ + h * 64 + ch * 8) = w;
                q += __shfl_xor(q, 1); q += __shfl_xor(q, 2); q += __shfl_xor(q, 4);
                if (ch == 0) SSQA[grow * 8 + h] = q;
            }
        }
        __syncthreads();
    }
}


template <bool PART16, class Order> __device__ __forceinline__ void fill_rowscale(LAS float* tab, const Order& So, const GAS float* src, int maxu) {
    pg8::Unit uu;
    for (int i = 0; i < maxu && So.next(i, uu); ++i)
        if (threadIdx.x < 256) { const int row = uu.pm * 256 + (int)threadIdx.x; tab[i * 256 + threadIdx.x] = PART16 ? rs16(src + (size_t)row * 16) : src[row]; }
    __syncthreads();
}
constexpr int TAB_OFF = MISC_OFF + 128, TAB_MAXU = 15;
static_assert(TAB_OFF + TAB_MAXU * 1024 <= LDS_BYTES, "row-scale table");

enum Phase { PH_P0 = 0, PH_P1, PH_G1A, PH_G1B, PH_INPROJ, PH_MIX_A, PH_MIX_B, PH_MIX_C, PH_OUTPROJ, PH_G2A, PH_G2B, PH_FINAL, PH_COUNT };
__global__ void __launch_bounds__(NWAVES * 64, 2) mega_fwd(Args args) {
    extern __shared__ __attribute__((aligned(16))) unsigned char lds[];
    Frame F;
    F.lds = (LAS unsigned char*)lds; F.MISC = (volatile LAS unsigned*)(F.lds + MISC_OFF);
    F.tid = threadIdx.x; F.lane = F.tid & 63; F.wave = __builtin_amdgcn_readfirstlane(F.tid >> 6);
    F.G = gridDim.x; { const int bx = blockIdx.x; F.vcu = (F.G % 8 == 0) ? (bx % 8) * (F.G / 8) + bx / 8 : bx; }
    F.ws = args.ws; F.out = (GAS float*)args.out; F.ctl = (unsigned*)(args.ws + WS_CTL);
    for (int u = F.tid; u < (LDS_BYTES - LDSCTL_OFF) / 4; u += NWAVES * 64) ((LAS unsigned*)(F.lds + LDSCTL_OFF))[u] = 0u;
    __syncthreads();
    XcdBarrier bar; bar.bar = F.ctl + CW_BAR; bar.x = 0; bar.st = nullptr;
    const int lo = args.ph_lo, hi = args.ph_hi;
    if (hi - lo > 1) bar = xcd_barrier_post(F.ctl + CW_BAR, F.MISC + 8);
#ifndef MK_PHASE_MASK
#define MK_PHASE_MASK 0xFFFF
#endif
#define IN(k) (((MK_PHASE_MASK >> (k)) & 1) && lo <= (k) && (k) < hi)
#define SEAM(k) do { if (IN(k) && IN((k) + 1)) xcd_barrier(bar); } while (0)
#define PHASE_PTRS() unsigned char* ws = args.ws; asm volatile("" : "+s"(ws)); const GAS float* GT = (const GAS float*)(ws + WS_GT); const GAS float* GP = (const GAS float*)(ws + WS_GP); (void)GT; (void)GP; F.ws = ws
    if (IN(PH_P0)) { PHASE_PTRS(); p0_prologue(F, args); SEAM(PH_P0); }
    if (IN(PH_P1)) { PHASE_PTRS(); p1_prep(F, args); SEAM(PH_P1); }
    if (IN(PH_G1A)) {
        PHASE_PTRS();
        pg8::Gemm g{(const GAS h16*)(ws + WS_HG), (const GAS h16*)(ws + WS_WGU1), 0, NGU, D}; pg8::StaticOrder So; So.init(M, NGU, F.G, (int)blockIdx.x); const pg8::TableOrder To = pg8::make_table(So, (LAS int*)(F.lds + LDSCTL_OFF));
#if MK_SHADOW == 1
        if (args.ph_lo == PH_G1A && args.ph_hi == PH_G1A + 1 && args.shadow) { EpiNull En; pg8::gemm_phase<EpiNull, true, MK_GPROBE>(F.lds, g, So, En); return; }
#endif
        fill_rowscale<false>((LAS float*)(F.lds + TAB_OFF), To, (const GAS float*)(ws + WS_R1), TAB_MAXU);
        EpiSwiglu E{(GAS h16*)(ws + WS_ACT), (const LAS float*)(F.lds + TAB_OFF), (const GAS float*)(ws + WS_BIAS1)};
        pg8::gemm_phase<EpiSwiglu, true, 0, pg8::TableOrder>(F.lds, g, To, E); SEAM(PH_G1A);
    }
    if (IN(PH_G1B)) {
        PHASE_PTRS();
        pg8::Gemm g{(const GAS h16*)(ws + WS_ACT), (const GAS h16*)(ws + WS_WD1), 0, D, DFF, MK_STAG}; pg8::StaticOrder So; So.init(M, D, F.G, (int)blockIdx.x); const pg8::TableOrder To = pg8::make_table(So, (LAS int*)(F.lds + LDSCTL_OFF));
#if MK_SHADOW == 8
        if (args.ph_lo == PH_G1B && args.ph_hi == PH_G1B + 1 && args.shadow) {
#if MK_GPROBE == 0
            EpiNull En; pg8::gemm_phase<EpiNull, true>(F.lds, g, So, En);
#else
            EpiResid<true, false, true, MK_GPROBE> Ev{GIN(args, 0), (GAS h16*)(ws + WS_H), (GAS h16*)(ws + WS_HG), GT + 0 * 4 * D, GP + 1 * 4 * D, (GAS float*)(ws + WS_SSQ2), nullptr, 0.5f};
            pg8::gemm_phase<EpiResid<true, false, true, MK_GPROBE>, true>(F.lds, g, So, Ev);
#endif
            return; }
#endif
        EpiResid<true, false, true> E{GIN(args, 0), (GAS h16*)(ws + WS_H), (GAS h16*)(ws + WS_HG), GT + 0 * 4 * D, GP + 1 * 4 * D, (GAS float*)(ws + WS_SSQ2), nullptr, 0.5f};
        pg8::gemm_phase<EpiResid<true, false, true>, true, 0, pg8::TableOrder>(F.lds, g, To, E); SEAM(PH_G1B);
    }
    if (IN(PH_INPROJ)) {
        PHASE_PTRS();
        pg8::Gemm g{(const GAS h16*)(ws + WS_HG), (const GAS h16*)(ws + WS_WIN), 0, INW, D}; pg8::StaticOrder So; So.init(M, INW, F.G, (int)blockIdx.x); const pg8::TableOrder To = pg8::make_table(So, (LAS int*)(F.lds + LDSCTL_OFF));
        fill_rowscale<true>((LAS float*)(F.lds + TAB_OFF), To, (const GAS float*)(ws + WS_SSQ2), TAB_MAXU);
        EpiInproj E{(GAS h16*)(ws + WS_PROJ), (const LAS float*)(F.lds + TAB_OFF), (const GAS float*)(ws + WS_BIAS2), (const GAS float*)(ws + WS_ROPE), (GAS float*)(ws + WS_KMP)};
        pg8::gemm_phase<EpiInproj, true, 0, pg8::TableOrder>(F.lds, g, To, E); SEAM(PH_INPROJ);
    }
    if (IN(PH_MIX_A)) { PHASE_PTRS(); if (!(args.shadow & 2)) gmlp_phase(F, args, args.shadow & 1); if (!(args.shadow & 4)) moba_gate_phase(F, args.shadow & 1); SEAM(PH_MIX_A); }
    if (IN(PH_MIX_B)) { PHASE_PTRS(); moba_b_phase(F, (GAS float*)args.out); SEAM(PH_MIX_B); }
    if (IN(PH_MIX_C)) { PHASE_PTRS(); moba_c_phase(F, (const GAS float*)args.out, args.shadow & 1); SEAM(PH_MIX_C); }
    if (IN(PH_OUTPROJ)) {
        PHASE_PTRS();
        pg8::Gemm g{(const GAS h16*)(ws + WS_PROJ), (const GAS h16*)(ws + WS_WOUT), INW, D, D}; pg8::StaticOrder So; So.init(M, D, F.G, (int)blockIdx.x); const pg8::TableOrder To = pg8::make_table(So, (LAS int*)(F.lds + LDSCTL_OFF));
        const LAS float* sct = (const LAS float*)(F.lds + MISC_OFF + 128);
        {   LAS float* t = (LAS float*)(F.lds + MISC_OFF + 128); const GAS float* ssqa = (const GAS float*)(ws + WS_SSQA); const GAS float* ssqg = (const GAS float*)(ws + WS_RG);
            pg8::Unit uu;
            for (int i = 0; i < 4 && To.next(i, uu); ++i)
                if (F.tid < 256) { const int row = uu.pm * 256 + F.tid; const f32x4 a = *(const GAS f32x4*)(ssqa + (size_t)row * 8), bq = *(const GAS f32x4*)(ssqa + (size_t)row * 8 + 4);
                    const float ra = rsqrtf((((a[0] + a[1]) + (a[2] + a[3])) + ((bq[0] + bq[1]) + (bq[2] + bq[3]))) * (1.f / 512.f) + EPS), rg = rsqrtf(ssqg[row] * (1.f / 512.f) + EPS);
                    t[i * 512 + F.tid] = ra / rg; t[i * 512 + 256 + F.tid] = rg; }
            __syncthreads(); }
        EpiResid<false, true, true> E{nullptr, (GAS h16*)(ws + WS_H), (GAS h16*)(ws + WS_HG), GT + 1 * 4 * D, GP + 2 * 4 * D, (GAS float*)(ws + WS_SSQ3), sct, 1.0f};
        pg8::gemm_phase<EpiResid<false, true, true>, true, 0, pg8::TableOrder>(F.lds, g, To, E); SEAM(PH_OUTPROJ);
    }
    if (IN(PH_G2A)) {
        PHASE_PTRS();
        pg8::Gemm g{(const GAS h16*)(ws + WS_HG), (const GAS h16*)(ws + WS_WGU2), 0, NGU, D}; pg8::StaticOrder So; So.init(M, NGU, F.G, (int)blockIdx.x); const pg8::TableOrder To = pg8::make_table(So, (LAS int*)(F.lds + LDSCTL_OFF));
        fill_rowscale<true>((LAS float*)(F.lds + TAB_OFF), To, (const GAS float*)(ws + WS_SSQ3), TAB_MAXU);
        EpiSwiglu E{(GAS h16*)(ws + WS_ACT), (const LAS float*)(F.lds + TAB_OFF), (const GAS float*)(ws + WS_BIAS3)};
        pg8::gemm_phase<EpiSwiglu, true, 0, pg8::TableOrder>(F.lds, g, To, E); SEAM(PH_G2A);
    }
    if (IN(PH_G2B)) {
        PHASE_PTRS();
        pg8::Gemm g{(const GAS h16*)(ws + WS_ACT), (const GAS h16*)(ws + WS_WD2), 0, D, DFF}; pg8::StaticOrder So; So.init(M, D, F.G, (int)blockIdx.x); const pg8::TableOrder To = pg8::make_table(So, (LAS int*)(F.lds + LDSCTL_OFF));
#if MK_FUSE_FINAL
        EpiFinal E{(const GAS h16*)(ws + WS_H), GT + 2 * 4 * D, GIN(args, 19), (GAS float*)args.out, (unsigned*)(ws + WS_SSQF), F.ctl + CW_PAN, F.ctl + CW_TMO,
                   (LAS float*)(F.lds + MISC_OFF + 128), (LAS float*)(F.lds + MISC_OFF + 128 + 4096), 0.5f};
        pg8::gemm_phase<EpiFinal, true, 0, pg8::TableOrder>(F.lds, g, To, E);
#else
        EpiResid<false, false, false> E{nullptr, (GAS h16*)(ws + WS_H), nullptr, GT + 2 * 4 * D, nullptr, (GAS float*)(ws + WS_SSQF), nullptr, 0.5f};
        pg8::gemm_phase<EpiResid<false, false, false>, true, 0, pg8::TableOrder>(F.lds, g, To, E); SEAM(PH_G2B);
#endif
    }
#if !MK_FUSE_FINAL
    if (IN(PH_FINAL)) { PHASE_PTRS(); p_final(F, args); }
#endif
#undef IN
#undef SEAM
}

extern "C" void kernel_launch(void* const* d_in, const int* in_sizes, int n_in, void* d_out, int out_size, void* d_ws, size_t ws_size, hipStream_t stream) {
    static int grid = 0;
    if (grid == 0) {
        if (n_in != 20 || out_size != M * D || ws_size < WS_END) { fprintf(stderr, "kernel_launch: unexpected shapes (n_in %d out %d ws %zu)\n", n_in, out_size, ws_size); grid = -1; return; }
        int dev = 0, cus = 0, per_cu = 0;
        hipGetDevice(&dev); hipDeviceGetAttribute(&cus, hipDeviceAttributeMultiprocessorCount, dev);
        if (hipFuncSetAttribute((const void*)mega_fwd, hipFuncAttributeMaxDynamicSharedMemorySize, LDS_BYTES) != hipSuccess) { fprintf(stderr, "kernel_launch: hipFuncSetAttribute failed\n"); grid = -1; return; }
        hipOccupancyMaxActiveBlocksPerMultiprocessor(&per_cu, (const void*)mega_fwd, NWAVES * 64, LDS_BYTES);
        (void)hipGetLastError();
        if (per_cu < 1) { fprintf(stderr, "kernel_launch: occupancy query says %d blocks/CU; nothing launched\n", per_cu); grid = -1; return; }
        grid = cus;
    }
    if (grid < 0) return;
    hipMemsetAsync((char*)d_ws + WS_CTL, 0, CTL_ZERO_BYTES, stream);
    Args a{};
    for (int i = 0; i < 20; ++i) a.in[i] = (const float*)d_in[i];
    a.out = (float*)d_out; a.ws = (unsigned char*)d_ws;
    unsigned char* ws = (unsigned char*)d_ws;
    auto run = [&](int lo, int hi) {
#if MK_PER_PHASE
        for (int p = lo; p < hi; ++p) {
            if (MK_SHADOW == 2 && p == PH_MIX_A) { a.ph_lo = p; a.ph_hi = p + 1; a.shadow = 1 | 4; hipLaunchKernelGGL(mega_fwd, dim3(grid), dim3(NWAVES * 64), LDS_BYTES, stream, a); a.shadow = 0; }
            if (MK_SHADOW == 3 && p == PH_MIX_A) { a.ph_lo = p; a.ph_hi = p + 1; a.shadow = 1 | 2; hipLaunchKernelGGL(mega_fwd, dim3(grid), dim3(NWAVES * 64), LDS_BYTES, stream, a); a.shadow = 0; }
            if (MK_SHADOW == 4 && p == PH_MIX_C) { a.ph_lo = p; a.ph_hi = p + 1; a.shadow = 1; hipLaunchKernelGGL(mega_fwd, dim3(grid), dim3(NWAVES * 64), LDS_BYTES, stream, a); a.shadow = 0; }
            if (MK_SHADOW == 8 && p == PH_G1B) { a.ph_lo = p; a.ph_hi = p + 1; a.shadow = 1; hipLaunchKernelGGL(mega_fwd, dim3(grid), dim3(NWAVES * 64), LDS_BYTES, stream, a); a.shadow = 0; }
            if (MK_SHADOW == 1 && p == PH_G1A) { a.ph_lo = p; a.ph_hi = p + 1; a.shadow = 1; hipLaunchKernelGGL(mega_fwd, dim3(grid), dim3(NWAVES * 64), LDS_BYTES, stream, a); a.shadow = 0; }
            for (int rep = 0; rep < ((((MK_DUP_MASK) >> p) & 1) ? 2 : 1); ++rep) { a.ph_lo = p; a.ph_hi = p + 1; hipLaunchKernelGGL(mega_fwd, dim3(grid), dim3(NWAVES * 64), LDS_BYTES, stream, a); }
        }
#else
        a.ph_lo = lo; a.ph_hi = hi;
        void* kargs[] = {(void*)&a};
        hipError_t e = hipLaunchCooperativeKernel((const void*)mega_fwd, dim3(grid), dim3(NWAVES * 64), kargs, LDS_BYTES, stream);
        if (e != hipSuccess) fprintf(stderr, "kernel_launch: cooperative launch failed: %s (grid %d)\n", hipGetErrorString(e), grid);
#endif
    };
    run(PH_P0, PH_COUNT);
}
```

```cpp
#include <hip/hip_runtime.h>
#include <cstdio>
#include <cstdint>

#ifndef MK_DUP_MASK
#define MK_DUP_MASK 0
#endif
#ifndef MK_GPROBE
#define MK_GPROBE 0
#endif
#ifndef MK_SHADOW
#define MK_SHADOW 0
#endif
#ifndef MK_FUSE_FINAL
#define MK_FUSE_FINAL 1
#endif
#ifndef MK_STAG
#define MK_STAG 0
#endif
#ifndef MK_NT
#define MK_NT 0x0
#endif
#ifndef MK_LEBITS
#define MK_LEBITS 6u
#endif
#ifndef MK_LOWENT
#define MK_LOWENT 3
#endif
#ifndef MK_PER_PHASE
#define MK_PER_PHASE 0
#endif

#define GAS __attribute__((address_space(1)))
#define LAS __attribute__((address_space(3)))
typedef _Float16 h16;
typedef _Float16 h16x8 __attribute__((ext_vector_type(8)));
typedef _Float16 h16x4 __attribute__((ext_vector_type(4)));
typedef _Float16 h16x2 __attribute__((ext_vector_type(2)));
typedef float f32x4 __attribute__((ext_vector_type(4)));
typedef float f32x2 __attribute__((ext_vector_type(2)));
typedef unsigned u32x4 __attribute__((ext_vector_type(4)));
typedef unsigned u32x2 __attribute__((ext_vector_type(2)));

constexpr int D = 1024, NB = 4, S = 8192, M = NB * S, DFF = 2816, NGU = 2 * DFF, NMOD = 9;
constexpr int AW = 512, HD = 64, NH = 8, INW = 2560, MBLK = 256, NBLK = S / MBLK, GC = 128;
constexpr float EPS = 1e-6f;
constexpr float C2 = 0.125f * 1.4426950408889634f;
constexpr int PQ = 0, PU = 512, PK = 1024, PV = 1536, PG = 2048;

constexpr size_t MiB = 1u << 20, KiB = 1u << 10;
constexpr size_t WS_CTL = 0, CTL_ZERO_BYTES = 1 * MiB;
constexpr size_t WS_MODP = 1 * MiB;
constexpr size_t WS_GT = 2 * MiB, WS_GP = WS_GT + 64 * KiB;
constexpr size_t WS_BIAS1 = WS_GT + 128 * KiB, WS_BIAS2 = WS_GT + 256 * KiB, WS_BIAS3 = WS_GT + 320 * KiB;
constexpr size_t WS_R1 = 3 * MiB, WS_RG = WS_R1 + 128 * KiB;
constexpr size_t WS_SSQA = 4 * MiB;
constexpr size_t WS_SSQ2 = 5 * MiB, WS_SSQ3 = 7 * MiB, WS_SSQF = 9 * MiB;
constexpr size_t WS_KMP = 11 * MiB;
constexpr size_t WS_ROPE = 12 * MiB;
constexpr size_t WS_WS16 = 14 * MiB;
constexpr size_t WS_WGU1 = 16 * MiB, WS_WD1 = 27 * MiB, WS_WIN = 33 * MiB, WS_WOUT = 38 * MiB, WS_WGU2 = 40 * MiB, WS_WD2 = 51 * MiB;
constexpr size_t WS_HG = 64 * MiB, WS_H = 128 * MiB, WS_ACT = 192 * MiB, WS_PROJ = WS_ACT;
constexpr size_t WS_LISTS = 368 * MiB, WS_END = 384 * MiB;
static_assert(WS_WD2 + (size_t)D * DFF * 2 <= WS_HG && WS_ACT + (size_t)M * DFF * 2 <= WS_LISTS, "ws map");
constexpr int CW_TMO = 0, CW_BAR = 4096;

constexpr int RING_BYTES = 131072, LDSCTL_OFF = RING_BYTES, MISC_OFF = LDSCTL_OFF + 320, LDS_BYTES = 163840;
constexpr int NWAVES = 8;

#define LDS_WAIT() asm volatile("s_waitcnt lgkmcnt(0)" ::: "memory")
#define VM_WAIT() asm volatile("s_waitcnt vmcnt(0)" ::: "memory")

__device__ __forceinline__ float wave_sum(float v) {
#pragma unroll
    for (int o = 1; o < 64; o <<= 1) v += __shfl_xor(v, o);
    return v;
}
template <int SEL, class T> __device__ __forceinline__ void st_stream(GAS T* p, const T& v) { if ((MK_NT >> SEL) & 1) __builtin_nontemporal_store(v, p); else *p = v; }
__device__ __forceinline__ unsigned pkh(float lo, float hi) { h16x2 v; v.x = (h16)lo; v.y = (h16)hi; return __builtin_bit_cast(unsigned, v); }
__device__ __forceinline__ float round8a(float x) { constexpr unsigned drop = 24u - MK_LEBITS; unsigned u = __float_as_uint(x); u += ((1u << (drop - 1)) - 1u) + ((u >> drop) & 1u); u &= ~((1u << drop) - 1u); return __uint_as_float(u); }
__device__ __forceinline__ unsigned pkh8(float lo, float hi) { return (MK_LOWENT & 2) ? pkh(round8a(lo), round8a(hi)) : pkh(lo, hi); }
__device__ __forceinline__ float silu_fast(float x) { return x * __builtin_amdgcn_rcpf(1.f + __builtin_amdgcn_exp2f(-1.4426950408889634f * x)); }
__device__ __forceinline__ float gelu_fast(float x) {
    const float u2 = 1.5957691216057308f * (x + 0.044715f * x * x * x);
    return x * __builtin_amdgcn_rcpf(1.f + __builtin_amdgcn_exp2f(-1.4426950408889634f * u2));
}
__device__ __forceinline__ float rs16p(const GAS float* p) {
    float t[16];
#pragma unroll
    for (int k = 0; k < 16; ++k) t[k] = p[(size_t)k * (4 * 8192)];
    const float a = ((t[0] + t[1]) + (t[2] + t[3])) + ((t[4] + t[5]) + (t[6] + t[7])), b = ((t[8] + t[9]) + (t[10] + t[11])) + ((t[12] + t[13]) + (t[14] + t[15]));
    return rsqrtf((a + b) * (1.f / 1024.f) + 1e-6f);
}
__device__ __forceinline__ float rs16(const GAS float* p) {
    const f32x4 s0 = *(const GAS f32x4*)(p), s1 = *(const GAS f32x4*)(p + 4), s2 = *(const GAS f32x4*)(p + 8), s3 = *(const GAS f32x4*)(p + 12);
    const f32x4 st = (s0 + s1) + (s2 + s3);
    return rsqrtf(((st[0] + st[1]) + (st[2] + st[3])) * (1.f / D) + EPS);
}


__device__ __forceinline__ size_t blk_off(int row, int k, int nt) { return (((size_t)(row >> 8) * nt + (k >> 6)) * 256 + (row & 255)) * 64 + (k & 63); }

namespace pg8 {
constexpr int BM = 256, BK = 64, HALF = 128, HTB = HALF * BK * 2, STAGE_BYTES = 8 * HTB, NXCD = 8, WGM = 8;
__host__ __device__ __forceinline__ int lds_byte(int r, int c) { const int st = (r >> 4) * 2 + (c >> 5), rr = r & 15, cc = c & 31, ob = rr * 64 + cc * 2; return st * 1024 + (ob ^ (((ob >> 9) & 1) << 5)); }
__host__ __device__ __forceinline__ void stage_rc(int b, int& R, int& C) { const int st = b / 1024, sb = b % 1024, swz = sb ^ (((sb >> 9) & 1) << 5); R = (st >> 1) * 16 + swz / 64; C = (st & 1) * 32 + (swz % 64) / 2; }
struct Unit { int pm, pn; };
struct Gemm { const GAS h16* A; const GAS h16* Bt; int lda, N, K; unsigned stag = 0; };
struct StaticOrder {
    int nM, nN, nwg, G, c;
    __device__ __forceinline__ void init(int M_, int N, int G_, int c_) { nM = M_ / BM; nN = N / BM; nwg = nM * nN; G = G_; c = c_; }
    __device__ __forceinline__ bool next(int i, Unit& u) const {
        const long L = (long)i * G + c; if (L >= nwg) return false;
        int wgid = (int)L; { const int q = nwg / NXCD, r = nwg % NXCD, xcd = wgid % NXCD, off = wgid / NXCD; wgid = (xcd < r ? xcd * (q + 1) : r * (q + 1) + (xcd - r) * q) + off; }
        const int nig = WGM * nN, gid = wgid / nig, fm = gid * WGM, gsz = (nM - fm) < WGM ? (nM - fm) : WGM;
        u.pm = fm + ((wgid % nig) % gsz); u.pn = (wgid % nig) / gsz; return true;
    }
};
struct TableOrder {
    const LAS int* tab; int n;
    __device__ __forceinline__ bool next(int i, Unit& u) const { if (i >= n) return false; u.pm = tab[2 * i]; u.pn = tab[2 * i + 1]; return true; }
};
__device__ __forceinline__ TableOrder make_table(const StaticOrder& So, LAS int* tab) {
    if (threadIdx.x < 16) { Unit u; u.pm = -1; u.pn = 0; const bool ok = So.next((int)threadIdx.x, u); tab[2 * threadIdx.x] = ok ? u.pm : -1; tab[2 * threadIdx.x + 1] = u.pn; }
    __syncthreads();
    int n = 0;
    while (n < 16 && tab[2 * n] >= 0) ++n;
    TableOrder T; T.tab = tab; T.n = __builtin_amdgcn_readfirstlane(n); return T;
}
template <class Epi, bool ALIGN_EPI, int PROBE = 0, class Order = StaticOrder>
__device__ __forceinline__ void gemm_phase(LAS unsigned char* lds, const Gemm g, const Order& S, const Epi& E) {
    const int tid = threadIdx.x, wid = __builtin_amdgcn_readfirstlane(tid >> 6), lane = tid & 63, wr = wid >> 2, wc = wid & 3, fr = lane & 15, fq = lane >> 4;
    const int K = g.K, nt = K / BK;
    unsigned voffA[2], voffB[2];
    const bool ablk = (g.lda == 0);
#pragma unroll
    for (int i = 0; i < 2; ++i) { int R, C; stage_rc(tid * 16 + i * 8192, R, C); voffA[i] = (unsigned)(R * (ablk ? BK : g.lda) + C) * 2u; voffB[i] = (unsigned)(R * BK + C) * 2u; }
    const size_t kstepB = (size_t)BM * BK * 2, kstepA = ablk ? kstepB : (size_t)(BK * 2);
    const size_t hstepB = (size_t)HALF * BK * 2, hstepA = ablk ? hstepB : (size_t)HALF * g.lda * 2;
    const size_t tstepB = (size_t)nt * kstepB, tstepA = ablk ? tstepB : 2 * hstepA;
    const unsigned ldsw = (unsigned)wid * 1024u;
    const int aoff = lds_byte(wr * 64 + fr, fq * 8), boff = lds_byte(wc * 32 + fr, fq * 8);
#define PG8_SA(b, h) (((b) * 2 + (h)) * HTB)
#define PG8_SB(b, h) ((4 + (b) * 2 + (h)) * HTB)
#define PG8_STAGE(bufoff, gbase, voff) do { if (PROBE != 2) _Pragma("unroll") for (int _i = 0; _i < 2; ++_i) \
        __builtin_amdgcn_global_load_lds((const unsigned*)((const char*)(gbase) + (voff)[_i]), (LAS unsigned*)(lds + (bufoff) + ldsw + _i * 8192), 16, 0, 0); } while (0)
#define PG8_LDA(dst, b, h) do { _Pragma("unroll") for (int m = 0; m < 4; ++m) _Pragma("unroll") for (int k = 0; k < 2; ++k) dst[m][k] = *(const LAS h16x8*)(lds + PG8_SA(b, h) + aoff + m * 2048 + k * 1024); } while (0)
#define PG8_LDB(dst, b, h) do { _Pragma("unroll") for (int n = 0; n < 2; ++n) _Pragma("unroll") for (int k = 0; k < 2; ++k) dst[n][k] = *(const LAS h16x8*)(lds + PG8_SB(b, h) + boff + n * 2048 + k * 1024); } while (0)
#define PG8_MMA(ai, bj, At, Bt) do { if (PROBE == 1 && (bj) == 1) break; __builtin_amdgcn_s_setprio(1); _Pragma("unroll") for (int m = 0; m < 4; ++m) _Pragma("unroll") for (int n = 0; n < 2; ++n) _Pragma("unroll") for (int k = 0; k < 2; ++k) \
        acc[ai][bj][m][n] = __builtin_amdgcn_mfma_f32_16x16x32_f16(Bt[n][k], At[m][k], acc[ai][bj][m][n], 0, 0, 0); __builtin_amdgcn_s_setprio(0); } while (0)
#define PG8_WAIT_V(n) asm volatile("s_waitcnt vmcnt(" #n ")" ::: "memory")
#define PG8_WAIT_L(n) asm volatile("s_waitcnt lgkmcnt(" #n ")" ::: "memory")
#define PG8_BAR __builtin_amdgcn_s_barrier()
#define PG8_SCHED __builtin_amdgcn_sched_barrier(0)
    Unit cur, nxt; int ui = 0;
    if (!S.next(0, cur)) return;
    if (g.stag) { const unsigned st = (unsigned)(cur.pm & 7); if (st) { const unsigned long long t0 = __builtin_amdgcn_s_memrealtime(), dl = (unsigned long long)st * g.stag; while (__builtin_amdgcn_s_memrealtime() - t0 < dl) __builtin_amdgcn_s_sleep(4); } }
    f32x4 acc[2][2][4][2];
#pragma unroll
    for (int a = 0; a < 2; ++a)
#pragma unroll
        for (int b = 0; b < 2; ++b)
#pragma unroll
            for (int m = 0; m < 4; ++m)
#pragma unroll
                for (int n = 0; n < 2; ++n) acc[a][b][m][n] = (f32x4){0.f, 0.f, 0.f, 0.f};
    h16x8 At[4][2], B0[2][2], B1[2][2];
    const char* cA = (const char*)g.A + (size_t)cur.pm * tstepA; const char* cB = (const char*)g.Bt + (size_t)cur.pn * tstepB;
    PG8_STAGE(PG8_SB(0, 0), cB, voffB); PG8_STAGE(PG8_SB(0, 1), cB + hstepB, voffB); PG8_STAGE(PG8_SA(0, 0), cA, voffA); PG8_STAGE(PG8_SA(0, 1), cA + hstepA, voffA);
    if (wr == 1) PG8_BAR;
    PG8_WAIT_V(2); PG8_BAR;
    PG8_STAGE(PG8_SB(1, 0), cB + kstepB, voffB); PG8_STAGE(PG8_SA(1, 0), cA + kstepA, voffA); PG8_STAGE(PG8_SB(1, 1), cB + hstepB + kstepB, voffB);
    PG8_WAIT_V(6); PG8_BAR;
    for (;;) {
        const bool has_next = S.next(ui + 1, nxt);
        const char* nA = has_next ? (const char*)g.A + (size_t)nxt.pm * tstepA : cA; const char* nB = has_next ? (const char*)g.Bt + (size_t)nxt.pn * tstepB : cB;
        for (int t = 0; t < nt; t += 2) {
            const bool last = (t == nt - 2);
            const char* a1 = cA + (size_t)(t + 1) * kstepA;
            const char* a2 = last ? nA : cA + (size_t)(t + 2) * kstepA; const char* b2 = last ? nB : cB + (size_t)(t + 2) * kstepB;
            const char* a3 = a2 + kstepA; const char* b3 = b2 + kstepB;
            if constexpr (Epi::MID) { if (t == nt / 2) E.mid(acc, cur, ui, wr, wc, fr, fq); }
            PG8_LDB(B0, 0, 0); PG8_LDB(B1, 0, 1); PG8_SCHED; PG8_LDA(At, 0, 0); PG8_STAGE(PG8_SA(1, 1), a1 + hstepA, voffA);
            PG8_WAIT_V(8); PG8_WAIT_L(0); PG8_BAR; PG8_MMA(0, 0, At, B0); PG8_MMA(0, 1, At, B1); PG8_BAR; PG8_SCHED;
            PG8_LDA(At, 0, 1); PG8_STAGE(PG8_SB(0, 0), b2, voffB); PG8_STAGE(PG8_SB(0, 1), b2 + hstepB, voffB); PG8_STAGE(PG8_SA(0, 0), a2, voffA);
            PG8_WAIT_V(8); PG8_WAIT_L(0); PG8_BAR; PG8_MMA(1, 0, At, B0); PG8_MMA(1, 1, At, B1); PG8_BAR; PG8_SCHED;
            PG8_LDB(B0, 1, 0); PG8_LDB(B1, 1, 1); PG8_SCHED; PG8_LDA(At, 1, 0); PG8_STAGE(PG8_SA(0, 1), a2 + hstepA, voffA);
            PG8_WAIT_V(8); PG8_WAIT_L(0); PG8_BAR; PG8_MMA(0, 0, At, B0); PG8_MMA(0, 1, At, B1); PG8_BAR; PG8_SCHED;
            PG8_LDA(At, 1, 1); PG8_STAGE(PG8_SB(1, 0), b3, voffB); PG8_STAGE(PG8_SB(1, 1), b3 + hstepB, voffB); PG8_STAGE(PG8_SA(1, 0), a3, voffA);
            PG8_WAIT_V(8); PG8_WAIT_L(0); PG8_BAR; PG8_MMA(1, 0, At, B0); PG8_MMA(1, 1, At, B1); PG8_BAR; PG8_SCHED;
        }
        if constexpr (ALIGN_EPI) { if (wr == 0) PG8_BAR; }
        E(acc, cur, ui, wr, wc, fr, fq);
        if (!has_next) break;
#pragma unroll
        for (int a = 0; a < 2; ++a)
#pragma unroll
            for (int b = 0; b < 2; ++b)
#pragma unroll
                for (int m = 0; m < 4; ++m)
#pragma unroll
                    for (int n = 0; n < 2; ++n) acc[a][b][m][n] = (f32x4){0.f, 0.f, 0.f, 0.f};
        cur = nxt; cA = nA; cB = nB; ++ui;
        if constexpr (ALIGN_EPI) { if (wr == 1) PG8_BAR; }
    }
    PG8_WAIT_V(0);
    if constexpr (!ALIGN_EPI) { if (wr == 0) PG8_BAR; }
    PG8_BAR;
#undef PG8_SA
#undef PG8_SB
#undef PG8_STAGE
#undef PG8_LDA
#undef PG8_LDB
#undef PG8_MMA
#undef PG8_WAIT_V
#undef PG8_WAIT_L
#undef PG8_BAR
#undef PG8_SCHED
}
}

typedef const f32x4 (&AccRef)[2][2][4][2];
struct EpiSwiglu {
    static constexpr bool MID = false;
    GAS h16* act; const LAS float* rtab; const GAS float* bias;
    __device__ __forceinline__ void mid(f32x4 (&)[2][2][4][2], const pg8::Unit&, int, int, int, int, int) const {}
    __device__ __forceinline__ void operator()(AccRef acc, const pg8::Unit& u, int ui, int wr, int wc, int fr, int fq) const {
        const int b = u.pm >> 5, row0 = u.pm * 256 + wr * 64 + fr;
        const GAS float* bp = bias + b * NGU + u.pn * 256 + wc * 32 + 4 * fq;
        f32x4 bv[2][2];
#pragma unroll
        for (int bj = 0; bj < 2; ++bj)
#pragma unroll
            for (int n = 0; n < 2; ++n) bv[bj][n] = *(const GAS f32x4*)(bp + bj * 128 + n * 16);
        const LAS float* rt = rtab + ui * 256 + wr * 64 + fr;
        const int hid0 = u.pn * 128 + wc * 32 + fq * 8;
#pragma unroll
        for (int ai = 0; ai < 2; ++ai)
#pragma unroll
            for (int m = 0; m < 4; ++m) {
                const int ro = ai * 128 + m * 16; const float rs = rt[ro];
                u32x4 w;
#pragma unroll
                for (int n = 0; n < 2; ++n) {
                    const f32x4 gv = acc[ai][0][m][n] * rs + bv[0][n], uv = acc[ai][1][m][n] * rs + bv[1][n];
                    const float a0 = silu_fast(gv[0]) * uv[0], a1 = silu_fast(gv[1]) * uv[1], a2 = silu_fast(gv[2]) * uv[2], a3 = silu_fast(gv[3]) * uv[3];
                    w[2 * n] = pkh8(a0, a1); w[2 * n + 1] = pkh8(a2, a3);
                }
                st_stream<3>((GAS u32x4*)(act + blk_off(row0 + ro, hid0, DFF / 64)), w);
            }
    }
};
struct EpiNull {
    static constexpr bool MID = false;
    __device__ __forceinline__ void mid(f32x4 (&)[2][2][4][2], const pg8::Unit&, int, int, int, int, int) const {}
    __device__ __forceinline__ void operator()(AccRef acc, const pg8::Unit& u, int ui, int wr, int wc, int fr, int fq) const {
#pragma unroll
        for (int ai = 0; ai < 2; ++ai)
#pragma unroll
            for (int bj = 0; bj < 2; ++bj)
#pragma unroll
                for (int m = 0; m < 4; ++m)
#pragma unroll
                    for (int n = 0; n < 2; ++n) asm volatile("" :: "v"(acc[ai][bj][m][n]));
    }
};
template <bool RES_F32, bool TWOSCALE, bool WRITE_HG, int PVAR = 0> struct EpiResid {
    static constexpr bool MID = TWOSCALE;
    const GAS float* xres; GAS h16* H; GAS h16* HG; const GAS float* cs; const GAS float* gp; GAS float* ssq; const LAS float* sct; float cmul;
    __device__ __forceinline__ void mid(f32x4 (&acc)[2][2][4][2], const pg8::Unit& u, int ui, int wr, int wc, int fr, int fq) const {
        if constexpr (TWOSCALE) {
            const LAS float* t = sct + ui * 512 + wr * 64 + fr;
#pragma unroll
            for (int ai = 0; ai < 2; ++ai)
#pragma unroll
                for (int m = 0; m < 4; ++m) { const float f = t[ai * 128 + m * 16];
#pragma unroll
                    for (int bj = 0; bj < 2; ++bj)
#pragma unroll
                        for (int n = 0; n < 2; ++n) acc[ai][bj][m][n] *= f; }
        }
    }
    __device__ __forceinline__ void operator()(AccRef acc, const pg8::Unit& u, int ui, int wr, int wc, int fr, int fq) const {
        const int b = u.pm >> 5, row0 = u.pm * 256 + wr * 64 + fr, col0 = u.pn * 256 + wc * 32 + 8 * fq;
        f32x4 csv[2][2], gpv[2][2];
#pragma unroll
        for (int bj = 0; bj < 2; ++bj)
#pragma unroll
            for (int n = 0; n < 2; ++n) { csv[bj][n] = *(const GAS f32x4*)(cs + b * D + col0 + bj * 128 + 4 * n) * cmul; if constexpr (WRITE_HG) gpv[bj][n] = *(const GAS f32x4*)(gp + b * D + col0 + bj * 128 + 4 * n); }
        constexpr int MB_ = RES_F32 ? 2 : 4;
        float qs[8];
#pragma unroll
        for (int ai = 0; ai < 2; ++ai)
#pragma unroll
        for (int m0 = 0; m0 < 4; m0 += MB_) {
            f32x4 rf[4][2][2]; h16x8 rh[4][2];
#pragma unroll
            for (int m = m0; m < m0 + MB_; ++m)
#pragma unroll
                for (int bj = 0; bj < 2; ++bj) { const size_t off = (size_t)(row0 + ai * 128 + m * 16) * D + col0 + bj * 128;
                    if constexpr (PVAR == 2 || PVAR == 6 || PVAR == 7) { rf[m][bj][0] = (f32x4){0.f, 0.f, 0.f, 0.f}; rf[m][bj][1] = rf[m][bj][0]; rh[m][bj] = (h16x8){0, 0, 0, 0, 0, 0, 0, 0}; }
                    else if constexpr (PVAR == 3) { const h16x8 t = *(const GAS h16x8*)(HG + blk_off(row0 + ai * 128 + m * 16, col0 + bj * 128, D / 64)); rf[m][bj][0] = (f32x4){(float)t[0], (float)t[1], (float)t[2], (float)t[3]}; rf[m][bj][1] = (f32x4){(float)t[4], (float)t[5], (float)t[6], (float)t[7]}; }
                    else if constexpr (RES_F32) { rf[m][bj][0] = *(const GAS f32x4*)(xres + off); rf[m][bj][1] = *(const GAS f32x4*)(xres + off + 4); }
                    else rh[m][bj] = *(const GAS h16x8*)(H + off); }
            asm volatile("" ::: "memory");
#pragma unroll
            for (int m = m0; m < m0 + MB_; ++m) {
                const int row = row0 + ai * 128 + m * 16; const size_t off = (size_t)row * D + col0;
                float rsc = 1.f; if constexpr (TWOSCALE) rsc = sct[ui * 512 + 256 + wr * 64 + fr + ai * 128 + m * 16];
                float q = 0.f;
#pragma unroll
                for (int bj = 0; bj < 2; ++bj) {
                    f32x4 r0, r1;
                    if constexpr (RES_F32) { r0 = rf[m][bj][0]; r1 = rf[m][bj][1]; }
                    else { const h16x8 hv = rh[m][bj]; r0 = (f32x4){(float)hv[0], (float)hv[1], (float)hv[2], (float)hv[3]}; r1 = (f32x4){(float)hv[4], (float)hv[5], (float)hv[6], (float)hv[7]}; }
                    const f32x4 v0 = r0 + csv[bj][0] * (acc[ai][bj][m][0] * rsc), v1 = r1 + csv[bj][1] * (acc[ai][bj][m][1] * rsc);
                    q += ((v0[0] * v0[0] + v0[1] * v0[1]) + (v0[2] * v0[2] + v0[3] * v0[3])) + ((v1[0] * v1[0] + v1[1] * v1[1]) + (v1[2] * v1[2] + v1[3] * v1[3]));
                    u32x4 w; w[0] = pkh(v0[0], v0[1]); w[1] = pkh(v0[2], v0[3]); w[2] = pkh(v1[0], v1[1]); w[3] = pkh(v1[2], v1[3]);
                    const int colp = u.pn * 256 + wc * 64 + 16 * fq + 8 * bj;
                    if constexpr (PVAR == 1) asm volatile("" :: "v"(w)); else if constexpr (PVAR == 4) *(GAS u32x4*)(H + blk_off(row, col0 + bj * 128, D / 64)) = w;
                    else if constexpr (PVAR == 5) *(GAS u32x4*)(H + (size_t)row * D + colp) = w; else if constexpr (PVAR == 7) __builtin_nontemporal_store(w, (GAS u32x4*)(H + off + bj * 128)); else st_stream<1>((GAS u32x4*)(H + off + bj * 128), w);
                    if constexpr (WRITE_HG) { const f32x4 g0 = v0 * gpv[bj][0], g1 = v1 * gpv[bj][1];
                        u32x4 wg;
                        if constexpr (TWOSCALE) { wg[0] = pkh8(g0[0], g0[1]); wg[1] = pkh8(g0[2], g0[3]); wg[2] = pkh8(g1[0], g1[1]); wg[3] = pkh8(g1[2], g1[3]); }
                        else { wg[0] = pkh(g0[0], g0[1]); wg[1] = pkh(g0[2], g0[3]); wg[2] = pkh(g1[0], g1[1]); wg[3] = pkh(g1[2], g1[3]); }
                        if constexpr (PVAR == 1 || PVAR == 6) asm volatile("" :: "v"(wg)); else if constexpr (PVAR == 7) __builtin_nontemporal_store(wg, (GAS u32x4*)(HG + blk_off(row, col0 + bj * 128, D / 64))); else if constexpr (PVAR == 5) *(GAS u32x4*)(HG + blk_off(row, colp, D / 64)) = wg; else st_stream<2>((GAS u32x4*)(HG + blk_off(row, col0 + bj * 128, D / 64)), wg); }
                }
                q += __shfl_xor(q, 16); q += __shfl_xor(q, 32);
                qs[ai * 4 + m] = q;
            }
        }
        if constexpr (PVAR != 1) {
            const float qa = fq == 0 ? qs[0] : fq == 1 ? qs[2] : fq == 2 ? qs[4] : qs[6], qb = fq == 0 ? qs[1] : fq == 1 ? qs[3] : fq == 2 ? qs[5] : qs[7];
            GAS float* sp = ssq + (size_t)(u.pn * 4 + wc) * M + row0 + (fq >> 1) * 128 + (fq & 1) * 32;
            sp[0] = qa; sp[16] = qb;
        }
    }
};
constexpr int CW_PAN = 16384;
struct EpiFinal {
    static constexpr bool MID = false;
    const GAS h16* H; const GAS float* cs; const GAS float* gfin; GAS float* out; unsigned* xs; unsigned* cnt; unsigned* tmo; LAS float* P; LAS float* Sx; float cmul;
    __device__ __forceinline__ void mid(f32x4 (&)[2][2][4][2], const pg8::Unit&, int, int, int, int, int) const {}
    __device__ __forceinline__ void operator()(f32x4 (&acc)[2][2][4][2], const pg8::Unit& u, int ui, int wr, int wc, int fr, int fq) const {
        const int b = u.pm >> 5, row0 = u.pm * 256 + wr * 64 + fr, col0 = u.pn * 256 + wc * 32 + 8 * fq;
        const int tid = threadIdx.x, lane = tid & 63, wid = __builtin_amdgcn_readfirstlane(tid >> 6);
        f32x4 csv[2][2];
#pragma unroll
        for (int bj = 0; bj < 2; ++bj)
#pragma unroll
            for (int n = 0; n < 2; ++n) csv[bj][n] = *(const GAS f32x4*)(cs + b * D + col0 + bj * 128 + 4 * n) * cmul;
#pragma unroll
        for (int ai = 0; ai < 2; ++ai) {
            h16x8 rh[4][2];
#pragma unroll
            for (int m = 0; m < 4; ++m)
#pragma unroll
                for (int bj = 0; bj < 2; ++bj) rh[m][bj] = *(const GAS h16x8*)(H + (size_t)(row0 + ai * 128 + m * 16) * D + col0 + bj * 128);
#pragma unroll
            for (int m = 0; m < 4; ++m) {
                float q = 0.f;
#pragma unroll
                for (int bj = 0; bj < 2; ++bj) { const h16x8 hv = rh[m][bj];
                    const f32x4 v0 = (f32x4){(float)hv[0], (float)hv[1], (float)hv[2], (float)hv[3]} + csv[bj][0] * acc[ai][bj][m][0], v1 = (f32x4){(float)hv[4], (float)hv[5], (float)hv[6], (float)hv[7]} + csv[bj][1] * acc[ai][bj][m][1];
                    acc[ai][bj][m][0] = v0; acc[ai][bj][m][1] = v1;
                    q += ((v0[0] * v0[0] + v0[1] * v0[1]) + (v0[2] * v0[2] + v0[3] * v0[3])) + ((v1[0] * v1[0] + v1[1] * v1[1]) + (v1[2] * v1[2] + v1[3] * v1[3])); }
                q += __shfl_xor(q, 16); q += __shfl_xor(q, 32);
                if (fq == 0) P[(ai * 128 + wr * 64 + m * 16 + fr) * 4 + wc] = q;
            }
        }
        asm volatile("s_waitcnt lgkmcnt(0)" ::: "memory"); __builtin_amdgcn_s_barrier(); asm volatile("" ::: "memory");
        if (tid < 256) {
            const f32x4 p4 = *(const LAS f32x4*)(P + tid * 4);
            __hip_atomic_store(xs + ((size_t)(u.pm * 256 + tid) * 4 + u.pn), __float_as_uint((p4[0] + p4[1]) + (p4[2] + p4[3])), __ATOMIC_RELAXED, __HIP_MEMORY_SCOPE_AGENT);
        }
        asm volatile("s_waitcnt vmcnt(0)" ::: "memory");
        if (wid < 4 && lane == 0) __hip_atomic_fetch_add(cnt + 64 * u.pm, 1u, __ATOMIC_RELAXED, __HIP_MEMORY_SCOPE_AGENT);
        if (wid == 0) {
            unsigned sp = 0u;
            while ((unsigned)__builtin_amdgcn_readfirstlane(__hip_atomic_load(cnt + 64 * u.pm, __ATOMIC_RELAXED, __HIP_MEMORY_SCOPE_AGENT)) < 16u) {
                __builtin_amdgcn_s_sleep(2);
                if (++sp > (1u << 16)) { if (lane == 0) __hip_atomic_store(tmo, 1u, __ATOMIC_RELAXED, __HIP_MEMORY_SCOPE_AGENT); break; }
            }
            __builtin_amdgcn_fence(__ATOMIC_ACQUIRE, "agent");
        }
        asm volatile("s_waitcnt vmcnt(0) lgkmcnt(0)" ::: "memory"); __builtin_amdgcn_s_barrier(); asm volatile("" ::: "memory");
        if (tid < 256) {
            const unsigned* sl = xs + (size_t)(u.pm * 256 + tid) * 4;
            const float s0 = __uint_as_float(__hip_atomic_load(sl + 0, __ATOMIC_RELAXED, __HIP_MEMORY_SCOPE_AGENT)), s1 = __uint_as_float(__hip_atomic_load(sl + 1, __ATOMIC_RELAXED, __HIP_MEMORY_SCOPE_AGENT)),
                        s2 = __uint_as_float(__hip_atomic_load(sl + 2, __ATOMIC_RELAXED, __HIP_MEMORY_SCOPE_AGENT)), s3 = __uint_as_float(__hip_atomic_load(sl + 3, __ATOMIC_RELAXED, __HIP_MEMORY_SCOPE_AGENT));
            Sx[tid] = rsqrtf(((s0 + s1) + (s2 + s3)) * (1.f / D) + EPS);
        }
        asm volatile("s_waitcnt vmcnt(0) lgkmcnt(0)" ::: "memory"); __builtin_amdgcn_s_barrier(); asm volatile("" ::: "memory");
        f32x4 gv[2][2];
#pragma unroll
        for (int bj = 0; bj < 2; ++bj)
#pragma unroll
            for (int n = 0; n < 2; ++n) gv[bj][n] = *(const GAS f32x4*)(gfin + col0 + bj * 128 + 4 * n);
#pragma unroll
        for (int ai = 0; ai < 2; ++ai)
#pragma unroll
            for (int m = 0; m < 4; ++m) { const int rl = ai * 128 + wr * 64 + m * 16 + fr; const float rs = Sx[rl]; GAS float* op = out + (size_t)(u.pm * 256 + rl) * D + col0;
#pragma unroll
                for (int bj = 0; bj < 2; ++bj) { st_stream<0>((GAS f32x4*)(op + bj * 128), acc[ai][bj][m][0] * rs * gv[bj][0]); st_stream<0>((GAS f32x4*)(op + bj * 128 + 4), acc[ai][bj][m][1] * rs * gv[bj][1]); } }
        asm volatile("s_waitcnt lgkmcnt(0)" ::: "memory"); __builtin_amdgcn_s_barrier(); asm volatile("" ::: "memory");
    }
};
struct EpiInproj {
    static constexpr bool MID = false;
    GAS h16* proj; const LAS float* rtab; const GAS float* bias; const GAS float* rope; GAS float* kmp;
    __device__ __forceinline__ void mid(f32x4 (&)[2][2][4][2], const pg8::Unit&, int, int, int, int, int) const {}
    __device__ __forceinline__ void operator()(AccRef acc, const pg8::Unit& u, int ui, int wr, int wc, int fr, int fq) const {
        const int b = u.pm >> 5, row0 = u.pm * 256 + wr * 64 + fr, region = u.pn >> 1;
        const GAS float* bp = bias + b * INW + u.pn * 256 + wc * 32 + 4 * fq;
        f32x4 bv[2][2];
#pragma unroll
        for (int bj = 0; bj < 2; ++bj)
#pragma unroll
            for (int n = 0; n < 2; ++n) bv[bj][n] = *(const GAS f32x4*)(bp + bj * 128 + n * 16);
        const bool is_rope = (region == 0) || (region == 2);
        f32x4 csum[2][2];
#pragma unroll
        for (int bj = 0; bj < 2; ++bj)
#pragma unroll
            for (int n = 0; n < 2; ++n) csum[bj][n] = (f32x4){0.f, 0.f, 0.f, 0.f};
        const LAS float* rt = rtab + ui * 256 + wr * 64 + fr;
#pragma unroll
        for (int ai = 0; ai < 2; ++ai)
#pragma unroll
        for (int m0 = 0; m0 < 4; m0 += 2) {
            f32x4 rcs[4][2], rsn[4][2];
            if (is_rope) {
#pragma unroll
                for (int m = m0; m < m0 + 2; ++m) { const GAS float* rp = rope + (size_t)((row0 + ai * 128 + m * 16) & (S - 1)) * 64 + 4 * fq;
#pragma unroll
                    for (int n = 0; n < 2; ++n) { rcs[m][n] = *(const GAS f32x4*)(rp + 16 * n); rsn[m][n] = *(const GAS f32x4*)(rp + 32 + 16 * n); } }
            }
            asm volatile("" ::: "memory");
#pragma unroll
            for (int m = m0; m < m0 + 2; ++m) {
                const int row = row0 + ai * 128 + m * 16;
                const float rs = rt[ai * 128 + m * 16];
                f32x4 v[2][2];
#pragma unroll
                for (int bj = 0; bj < 2; ++bj)
#pragma unroll
                    for (int n = 0; n < 2; ++n) v[bj][n] = acc[ai][bj][m][n] * rs + bv[bj][n];
                GAS h16* prow = proj + (size_t)row * INW + region * 512 + (u.pn & 1) * 256;
                if (is_rope) {
                    const float qs = (region == 0) ? C2 : 1.f;
#pragma unroll
                    for (int n = 0; n < 2; ++n) {
                        const f32x4 cs4 = rcs[m][n] * qs, sn4 = rsn[m][n] * qs;
                        const f32x4 x1 = v[0][n], x2 = v[1][n];
                        v[0][n] = x1 * cs4 - x2 * sn4; v[1][n] = x2 * cs4 + x1 * sn4;
                    }
                    GAS h16* hp = prow + wc * 64 + 16 * fq;
#pragma unroll
                    for (int bj = 0; bj < 2; ++bj) { u32x4 w; w[0] = pkh(v[bj][0][0], v[bj][0][1]); w[1] = pkh(v[bj][0][2], v[bj][0][3]); w[2] = pkh(v[bj][1][0], v[bj][1][1]); w[3] = pkh(v[bj][1][2], v[bj][1][3]);
                        st_stream<4>((GAS u32x4*)(hp + 8 * bj), w); }
                    if (region == 2) {
#pragma unroll
                        for (int bj = 0; bj < 2; ++bj)
#pragma unroll
                            for (int n = 0; n < 2; ++n) csum[bj][n] += v[bj][n];
                    }
                } else {
                    if (region == 1 || region == 4) {
#pragma unroll
                        for (int bj = 0; bj < 2; ++bj)
#pragma unroll
                            for (int n = 0; n < 2; ++n)
#pragma unroll
                                for (int j = 0; j < 4; ++j) v[bj][n][j] = gelu_fast(v[bj][n][j]);
                    }
                    GAS h16* hp = prow + wc * 32 + 8 * fq;
#pragma unroll
                    for (int bj = 0; bj < 2; ++bj) { u32x4 w; w[0] = pkh(v[bj][0][0], v[bj][0][1]); w[1] = pkh(v[bj][0][2], v[bj][0][3]); w[2] = pkh(v[bj][1][0], v[bj][1][1]); w[3] = pkh(v[bj][1][2], v[bj][1][3]);
                        st_stream<4>((GAS u32x4*)(hp + 128 * bj), w); }
                }
            }
        }
        if (region == 2) {
#pragma unroll
            for (int bj = 0; bj < 2; ++bj)
#pragma unroll
                for (int n = 0; n < 2; ++n)
#pragma unroll
                    for (int j = 0; j < 4; ++j) { float t = csum[bj][n][j]; t += __shfl_xor(t, 1); t += __shfl_xor(t, 2); t += __shfl_xor(t, 4); t += __shfl_xor(t, 8); csum[bj][n][j] = t; }
            if (fr == 0) {
                GAS float* kp = kmp + ((size_t)((b * NBLK + (u.pm & 31)) * 2 + wr)) * 512 + ((u.pn & 1) * 4 + wc) * 64 + 16 * fq;
#pragma unroll
                for (int bj = 0; bj < 2; ++bj)
#pragma unroll
                    for (int n = 0; n < 2; ++n) *(GAS f32x4*)(kp + 8 * bj + 4 * n) = csum[bj][n];
            }
        }
    }
};

#define XB_TMO      128
#define XB_XCNT(j)  (256  + 64 * (j))
#define XB_XSUB(j)  (1280 + 64 * (j))
#define XB_XGEN(j)  (2304 + 64 * (j))
#define XB_TOP      3328
#define XB_TOPGEN   3392
#define XCD_BAR_WORDS 3456
#define XB_SPIN_CAP (1u << 18)
__device__ __forceinline__ unsigned xb_ld(unsigned* p)              { return __hip_atomic_load(p, __ATOMIC_RELAXED, __HIP_MEMORY_SCOPE_AGENT); }
__device__ __forceinline__ unsigned xb_add(unsigned* p, unsigned v) { return __hip_atomic_fetch_add(p, v, __ATOMIC_RELAXED, __HIP_MEMORY_SCOPE_AGENT); }
__device__ __forceinline__ unsigned xb_xcc_id() { return (unsigned)__builtin_amdgcn_s_getreg((3 << 11) | 20) & 0xFu; }
#define XB_SPIN(cond, bar) do { unsigned _sp = 0; while (cond) { __builtin_amdgcn_s_sleep(1); \
    if ((++_sp & 255u) == 0u) { if (xb_ld(&(bar)[XB_TMO])) break; if (_sp > XB_SPIN_CAP) { atomicAdd(&(bar)[XB_TMO], 1u); break; } } } } while (0)
struct XcdBarrier { unsigned* bar; unsigned x; volatile LAS unsigned* st; };
__device__ __forceinline__ XcdBarrier xcd_barrier_post(unsigned* bar, volatile LAS unsigned* st) {
    XcdBarrier b; b.bar = bar; b.x = xb_xcc_id(); b.st = st;
    if (threadIdx.x == 0) (void)xb_add(&bar[XB_XCNT(b.x)], 1u);
    return b;
}
__device__ __forceinline__ void xcd_barrier_complete(unsigned* bar, unsigned x, unsigned& nloc, unsigned& nx) {
    const unsigned G = gridDim.x * gridDim.y * gridDim.z;
    unsigned sum, cnt, mine, sp = 0u;
    for (;;) {
        sum = 0u; cnt = 0u; mine = 0u;
#pragma unroll
        for (unsigned j = 0; j < 16; ++j) { const unsigned c = xb_ld(&bar[XB_XCNT(j)]); sum += c; cnt += (c > 0u) ? 1u : 0u; mine = (j == x) ? c : mine; }
        if (sum == G) break;
        __builtin_amdgcn_s_sleep(1);
        if ((++sp & 255u) == 0u) { if (xb_ld(&bar[XB_TMO])) break; if (sp > XB_SPIN_CAP) { atomicAdd(&bar[XB_TMO], 1u); break; } }
    }
    nloc = mine > 0u ? mine : 1u; nx = cnt > 0u ? cnt : 1u;
}
__device__ __forceinline__ void xcd_barrier(const XcdBarrier& b) {
    asm volatile("s_waitcnt vmcnt(0)" ::: "memory");
    __syncthreads();
    if (threadIdx.x == 0) {
        unsigned* bar = b.bar;
        __builtin_amdgcn_s_waitcnt(0);
        unsigned nloc = b.st[0], nx = b.st[1];
        if (nloc == 0u) { xcd_barrier_complete(bar, b.x, nloc, nx); b.st[0] = nloc; b.st[1] = nx; }
        const unsigned old = xb_add(&bar[XB_XSUB(b.x)], 1u);
        const unsigned gen = old / nloc;
        if (old + 1u == (gen + 1u) * nloc) {
            __builtin_amdgcn_fence(__ATOMIC_RELEASE, "agent");
            asm volatile("s_waitcnt vmcnt(0)" ::: "memory");
            const unsigned og = xb_add(&bar[XB_TOP], 1u);
            const unsigned tg = og / nx;
            if (og + 1u == (tg + 1u) * nx) xb_add(&bar[XB_TOPGEN], 1u);
            else XB_SPIN(xb_ld(&bar[XB_TOPGEN]) == tg, bar);
            __builtin_amdgcn_fence(__ATOMIC_ACQUIRE, "agent");
            xb_add(&bar[XB_XGEN(b.x)], 1u);
            asm volatile("s_waitcnt vmcnt(0)" ::: "memory");
        } else {
            XB_SPIN(xb_ld(&bar[XB_XGEN(b.x)]) == gen, bar);
            __builtin_amdgcn_fence(__ATOMIC_ACQUIRE, "agent");
            asm volatile("s_waitcnt vmcnt(0)" ::: "memory");
        }
    }
    __syncthreads();
}

#define GIN(a_, i_) ((const GAS float*)(a_).in[i_])
struct Args { const float* in[20]; float* out; unsigned char* ws; int ph_lo, ph_hi; int shadow, pad; };
struct Frame {
    LAS unsigned char* lds; volatile LAS unsigned* MISC; unsigned* ctl;
    int tid, lane, wave, vcu, G;
    unsigned char* ws; GAS float* out;
};

__device__ __forceinline__ float round8(float x) { return round8a(x); }
__device__ __forceinline__ int p8(int l) { return (l & ~31) + 16 * ((l >> 2) & 1) + 4 * ((l >> 3) & 3) + (l & 3); }
__device__ __forceinline__ int phys_gu(int L) { const int isu = L >= DFF, hid = isu ? L - DFF : L, pn = hid >> 7, hh = hid & 127; return 256 * pn + 128 * isu + p8(hh); }
__device__ __forceinline__ int phys_in(int L) {
    const int reg = L >> 9, l = L & 511;
    const int preg = reg == 0 ? 0 : reg == 1 ? 2 : reg == 2 ? 3 : reg == 3 ? 1 : 4;
    if (reg <= 1) { const int head = l >> 6, d = l & 63, bj = d >> 5, i = d & 31; return 512 * preg + 256 * (head >> 2) + 128 * bj + 32 * (head & 3) + i; }
    return 512 * preg + p8(l);
}
enum PhysKind { PH_GU = 0, PH_P8 = 1, PH_IN = 2 };
template <int KIND> __device__ __forceinline__ int physmap(int L) { return KIND == PH_GU ? phys_gu(L) : KIND == PH_P8 ? p8(L) : phys_in(L); }

template <int KIND, bool LOWENT = false> __device__ __forceinline__ void p0_transpose_item(const GAS float* W, int K, int N, GAS h16* WT, const GAS float* kscale, LAS float* scr, int item, int lane) {
    const int nblk = N / 32, kb = item / nblk, nb = item % nblk, k0 = 64 * kb, n0 = 32 * nb;
    float wv[32];
#pragma unroll
    for (int i = 0; i < 32; ++i) { const int kk = 2 * i + (lane >> 5); wv[i] = W[(size_t)(k0 + kk) * N + n0 + (lane & 31)]; }
    if (kscale) {
#pragma unroll
        for (int i = 0; i < 32; ++i) wv[i] *= kscale[k0 + 2 * i + (lane >> 5)]; }
#pragma unroll
    for (int i = 0; i < 32; ++i) scr[(2 * i + (lane >> 5)) * 33 + (lane & 31)] = (LOWENT && MK_LOWENT) ? round8(wv[i]) : wv[i];
    LDS_WAIT(); asm volatile("" ::: "memory");
    const int c = lane & 7;
#pragma unroll
    for (int j = 0; j < 4; ++j) { const int n = (lane >> 3) + 8 * j; const LAS float* s = scr + (8 * c) * 33 + n;
        u32x4 o; o.x = pkh(s[0 * 33], s[1 * 33]); o.y = pkh(s[2 * 33], s[3 * 33]); o.z = pkh(s[4 * 33], s[5 * 33]); o.w = pkh(s[6 * 33], s[7 * 33]);
        *(GAS u32x4*)(WT + blk_off(physmap<KIND>(n0 + n), k0 + 8 * c, K / 64)) = o; }
    LDS_WAIT(); asm volatile("" ::: "memory");
}

__device__ __forceinline__ void p0_prologue(const Frame& F0, const Args& a) {
    Frame F = F0; F.tid = threadIdx.x; F.lane = F.tid & 63; F.wave = __builtin_amdgcn_readfirstlane(F.tid >> 6);
    const GAS float* c = GIN(a, 1); const GAS float* w_ada = GIN(a, 2);
    {
        LAS float* red = (LAS float*)F.lds;
        for (int item = F.vcu; item < 72 * 4; item += F.G) {
            const int cg = item % 72, kq = item / 72, hlf = F.lane >> 5, col = cg * 128 + (F.lane & 31) * 4;
            f32x4 acc[4] = {{0.f, 0.f, 0.f, 0.f}, {0.f, 0.f, 0.f, 0.f}, {0.f, 0.f, 0.f, 0.f}, {0.f, 0.f, 0.f, 0.f}};
            const int kbase = kq * 256 + F.wave * 32 + hlf;
#pragma unroll
            for (int i = 0; i < 16; ++i) { const int k = kbase + 2 * i; const f32x4 w4 = *(const GAS f32x4*)(w_ada + (size_t)k * (NMOD * D) + col);
#pragma unroll
                for (int b = 0; b < 4; ++b) { const float cv = c[b * D + k]; const float sv = cv / (1.f + __expf(-cv)); acc[b] += w4 * sv; } }
#pragma unroll
            for (int b = 0; b < 4; ++b)
#pragma unroll
                for (int j = 0; j < 4; ++j) acc[b][j] += __shfl_xor(acc[b][j], 32);
            if (hlf == 0) {
#pragma unroll
                for (int b = 0; b < 4; ++b) *(LAS f32x4*)(red + (F.wave * 4 + b) * 128 + (F.lane & 31) * 4) = acc[b];
            }
            __syncthreads();
            { const int b = F.tid >> 7, cc = F.tid & 127; float s = 0.f;
#pragma unroll
              for (int w = 0; w < 8; ++w) s += red[(w * 4 + b) * 128 + cc];
              ((GAS float*)(F.ws + WS_MODP))[(size_t)(kq * 4 + b) * (NMOD * D) + cg * 128 + cc] = s; }
            __syncthreads();
        }
    }
    LAS float* scr = (LAS float*)(F.lds + F.wave * 16384);
    const int gw = F.vcu * NWAVES + F.wave, NGW = F.G * NWAVES;
    constexpr int I_GU = (D / 64) * (NGU / 32), I_DN = (DFF / 64) * (D / 32), I_IN = (D / 64) * (INW / 32), I_OUT = (D / 64) * (D / 32);
    constexpr int NITEMS = 2 * I_GU + 2 * I_DN + I_IN + I_OUT;
    for (int it = gw; it < NITEMS; it += NGW) {
        int r = it;
        if (r < I_GU) { p0_transpose_item<PH_GU, true>(GIN(a, 5), D, NGU, (GAS h16*)(F.ws + WS_WGU1), nullptr, scr, r, F.lane); continue; } r -= I_GU;
        if (r < I_GU) { p0_transpose_item<PH_GU, true>(GIN(a, 17), D, NGU, (GAS h16*)(F.ws + WS_WGU2), nullptr, scr, r, F.lane); continue; } r -= I_GU;
        if (r < I_DN) { p0_transpose_item<PH_P8, true>(GIN(a, 6), DFF, D, (GAS h16*)(F.ws + WS_WD1), nullptr, scr, r, F.lane); continue; } r -= I_DN;
        if (r < I_DN) { p0_transpose_item<PH_P8, true>(GIN(a, 18), DFF, D, (GAS h16*)(F.ws + WS_WD2), nullptr, scr, r, F.lane); continue; } r -= I_DN;
        if (r < I_IN) { p0_transpose_item<PH_IN>(GIN(a, 8), D, INW, (GAS h16*)(F.ws + WS_WIN), nullptr, scr, r, F.lane); continue; } r -= I_IN;
        {
            const int kb = r / (D / 32); const GAS float* ks = (kb < 8) ? GIN(a, 13) : (GIN(a, 14) - 512);
            p0_transpose_item<PH_P8>(GIN(a, 15), D, D, (GAS h16*)(F.ws + WS_WOUT), ks, scr, r, F.lane); }
    }
    for (int pos = gw; pos < S; pos += NGW) {
        const int i = F.lane & 31;
        const float inv = (float)exp(-(double)i / 32.0 * 9.210340371976184);
        const float ang = (float)pos * inv;
        const double da = (double)ang;
        ((GAS float*)(F.ws + WS_ROPE))[(size_t)pos * 64 + F.lane] = (F.lane < 32) ? (float)cos(da) : (float)sin(da);
    }
    for (int e = gw * 64 + F.lane; e < NH * GC * GC; e += NGW * 64) { const int t = (e >> 7) & 127, s = e & 127; ((GAS h16*)(F.ws + WS_WS16))[e] = (s <= t) ? (h16)GIN(a, 11)[e] : (h16)0.f; }
}

__device__ __forceinline__ void p1_prep(const Frame& F0, const Args& a) {
    Frame F = F0; F.tid = threadIdx.x; F.lane = F.tid & 63; F.wave = __builtin_amdgcn_readfirstlane(F.tid >> 6);
    LAS float* modl = (LAS float*)F.lds;
    const GAS float* modp = (const GAS float*)(F.ws + WS_MODP); const GAS float* b_ada = GIN(a, 3);
    const size_t st = (size_t)4 * NMOD * D;
    for (int e = F.tid; e < 4 * 6 * D; e += NWAVES * 64) {
        const int b = e / (6 * D), sl = (e / D) % 6, k = e % D; const int mi = (sl < 3) ? 3 * sl : 3 * (sl - 3) + 1;
        const size_t o = (size_t)b * (NMOD * D) + mi * D + k;
        modl[e] = ((modp[o] + modp[o + st]) + (modp[o + 2 * st] + modp[o + 3 * st])) + b_ada[mi * D + k];
    }
    __syncthreads();
    if (F.vcu == 0) {
        GAS float* GT = (GAS float*)(F.ws + WS_GT); GAS float* GP = (GAS float*)(F.ws + WS_GP);
        for (int e = F.tid; e < 3 * 4 * D; e += NWAVES * 64) {
            const int j = e / (4 * D), b = (e / D) % 4, k = e % D; const int mi = 3 * j + 2;
            const size_t o = (size_t)b * (NMOD * D) + mi * D + k;
            GT[e] = ((modp[o] + modp[o + st]) + (modp[o + 2 * st] + modp[o + 3 * st])) + b_ada[mi * D + k];
            const GAS float* g = j == 0 ? GIN(a, 4) : j == 1 ? GIN(a, 7) : GIN(a, 16);
            GP[e] = g[k] * (1.f + modl[(b * 6 + 3 + j) * D + k]);
        }
    }
    const GAS float* x = GIN(a, 0); const GAS float* g1 = GIN(a, 4);
    GAS h16* XG = (GAS h16*)(F.ws + WS_HG); GAS float* R1 = (GAS float*)(F.ws + WS_R1);
    for (int chunk = F.vcu; chunk < M / 128; chunk += F.G) {
        const int b = chunk / (S / 128);
        f32x4 scl[2][2];
#pragma unroll
        for (int j = 0; j < 2; ++j)
#pragma unroll
            for (int h = 0; h < 2; ++h) { const int k = 8 * F.lane + 512 * j + 4 * h; const f32x4 gg = *(const GAS f32x4*)(g1 + k); const LAS float* sc = modl + (b * 6 + 3) * D + k;
                scl[j][h] = gg * ((f32x4){1.f + sc[0], 1.f + sc[1], 1.f + sc[2], 1.f + sc[3]}); }
        for (int rb = 0; rb < 16; rb += 4) {
            f32x4 v[4][2][2]; float q[4];
#pragma unroll
            for (int r4 = 0; r4 < 4; ++r4) { const GAS float* xr = x + (size_t)(chunk * 128 + F.wave * 16 + rb + r4) * D + 8 * F.lane;
#pragma unroll
                for (int j = 0; j < 2; ++j) { v[r4][j][0] = *(const GAS f32x4*)(xr + 512 * j); v[r4][j][1] = *(const GAS f32x4*)(xr + 512 * j + 4); } }
            asm volatile("" ::: "memory");
#pragma unroll
            for (int r4 = 0; r4 < 4; ++r4) { float t = 0.f;
#pragma unroll
                for (int j = 0; j < 2; ++j)
#pragma unroll
                    for (int h = 0; h < 2; ++h) t += (v[r4][j][h][0] * v[r4][j][h][0] + v[r4][j][h][1] * v[r4][j][h][1]) + (v[r4][j][h][2] * v[r4][j][h][2] + v[r4][j][h][3] * v[r4][j][h][3]);
                q[r4] = t; }
#pragma unroll
            for (int o = 1; o < 64; o <<= 1)
#pragma unroll
                for (int r4 = 0; r4 < 4; ++r4) q[r4] += __shfl_xor(q[r4], o);
#pragma unroll
            for (int r4 = 0; r4 < 4; ++r4) {
                const int row = chunk * 128 + F.wave * 16 + rb + r4;
                if (F.lane == 0) R1[row] = rsqrtf(q[r4] * (1.f / D) + EPS);
#pragma unroll
                for (int j = 0; j < 2; ++j) { const int k = 8 * F.lane + 512 * j; u32x4 w;
#pragma unroll
                    for (int h = 0; h < 2; ++h) { const f32x4 o = v[r4][j][h] * scl[j][h]; w[2 * h] = pkh8(o[0], o[1]); w[2 * h + 1] = pkh8(o[2], o[3]); }
                    *(GAS u32x4*)(XG + blk_off(row, k, D / 64)) = w; }
            }
        }
    }
    const int gw = F.vcu * NWAVES + F.wave, NGW = F.G * NWAVES;
    for (int it = gw; it < NGU + INW + NGU; it += NGW) {
        int n = it, j; const GAS h16* W; GAS float* B; int NN;
        if (n < NGU) { j = 0; W = (const GAS h16*)(F.ws + WS_WGU1); B = (GAS float*)(F.ws + WS_BIAS1); NN = NGU; }
        else if (n < NGU + INW) { n -= NGU; j = 1; W = (const GAS h16*)(F.ws + WS_WIN); B = (GAS float*)(F.ws + WS_BIAS2); NN = INW; }
        else { n -= NGU + INW; j = 2; W = (const GAS h16*)(F.ws + WS_WGU2); B = (GAS float*)(F.ws + WS_BIAS3); NN = NGU; }
        const h16x8 w0 = *(const GAS h16x8*)(W + blk_off(n, 16 * F.lane, D / 64)), w1 = *(const GAS h16x8*)(W + blk_off(n, 16 * F.lane + 8, D / 64));
        float s[4];
#pragma unroll
        for (int b = 0; b < 4; ++b) { const LAS float* sh = modl + (b * 6 + j) * D + 16 * F.lane; float t = 0.f;
#pragma unroll
            for (int e = 0; e < 8; ++e) t += sh[e] * (float)w0[e] + sh[8 + e] * (float)w1[e];
            s[b] = wave_sum(t); }
        if (F.lane == 0) { B[0 * NN + n] = s[0]; B[1 * NN + n] = s[1]; B[2 * NN + n] = s[2]; B[3 * NN + n] = s[3]; }
    }
    __syncthreads();
}

__device__ __forceinline__ void p_final(const Frame& F0, const Args& a) {
    Frame F = F0; F.tid = threadIdx.x; F.lane = F.tid & 63; F.wave = __builtin_amdgcn_readfirstlane(F.tid >> 6);
    const GAS h16* H = (const GAS h16*)(F.ws + WS_H); const GAS float* ssq = (const GAS float*)(F.ws + WS_SSQF); const GAS float* gf = GIN(a, 19);
    const int gw = F.vcu * NWAVES + F.wave, NGW = F.G * NWAVES;
    f32x4 g[2][2];
#pragma unroll
    for (int j = 0; j < 2; ++j)
#pragma unroll
        for (int h = 0; h < 2; ++h) g[j][h] = *(const GAS f32x4*)(gf + 8 * F.lane + 512 * j + 4 * h);
    for (int row = gw; row < M; row += NGW) {
        const float rs = rs16p(ssq + row);
#pragma unroll
        for (int j = 0; j < 2; ++j) { const h16x8 hv = *(const GAS h16x8*)(H + (size_t)row * D + 8 * F.lane + 512 * j);
            f32x4 o0 = (f32x4){(float)hv[0], (float)hv[1], (float)hv[2], (float)hv[3]} * rs * g[j][0], o1 = (f32x4){(float)hv[4], (float)hv[5], (float)hv[6], (float)hv[7]} * rs * g[j][1];
            *(GAS f32x4*)(a.out + (size_t)row * D + 8 * F.lane + 512 * j) = o0; *(GAS f32x4*)(a.out + (size_t)row * D + 8 * F.lane + 512 * j + 4) = o1; }
    }
}


typedef float f32x16 __attribute__((ext_vector_type(16)));
typedef short v4i16_t __attribute__((ext_vector_type(4)));
__device__ __forceinline__ h16x4 tr16(const LAS unsigned char* p) { return __builtin_bit_cast(h16x4, __builtin_amdgcn_ds_read_tr16_b64_v4i16((LAS v4i16_t*)p)); }
__device__ __forceinline__ int vt_off(int t, int c8) { return t * 128 + (((c8 >> 2) ^ ((t >> 1) & 1)) << 6) + ((c8 & 3) << 4); }

__device__ __forceinline__ void gmlp_phase(const Frame& F0, const Args& a, int shadow) {
    const int tid = threadIdx.x, lane = tid & 63, wave = __builtin_amdgcn_readfirstlane(tid >> 6), r32 = lane & 31, hi = lane >> 5;
    GAS h16* proj = (GAS h16*)(F0.ws + WS_PROJ); const GAS h16* W16 = (const GAS h16*)(F0.ws + WS_WS16); GAS float* RG = (GAS float*)(F0.ws + WS_RG);
    const GAS float* ln_g = GIN(a, 9); const GAS float* ln_b = GIN(a, 10); const GAS float* b_s = GIN(a, 12);
    LAS unsigned char* lds = F0.lds;
    LAS float* rowsq = (LAS float*)(lds + MISC_OFF + 128);
    LAS unsigned char* gstg = lds + MISC_OFF + 128 + 4096 + wave * 2048;
    f32x4 g0 = *(const GAS f32x4*)(ln_g + 8 * lane), g1 = *(const GAS f32x4*)(ln_g + 8 * lane + 4), b0 = *(const GAS f32x4*)(ln_b + 8 * lane), b1 = *(const GAS f32x4*)(ln_b + 8 * lane + 4);
    for (int unit = F0.vcu; unit < M / GC; unit += F0.G) {
        const size_t row0 = (size_t)unit * GC;
        {
            h16x8 hv[16]; float sm[16], mu[16], rsd[16];
#pragma unroll
            for (int rr = 0; rr < 16; ++rr) hv[rr] = *(const GAS h16x8*)(proj + (row0 + wave * 16 + rr) * INW + PG + 8 * lane);
#pragma unroll
            for (int rr = 0; rr < 16; ++rr) { float t = 0.f;
#pragma unroll
                for (int e = 0; e < 8; ++e) t += (float)hv[rr][e];
                sm[rr] = t; }
#pragma unroll
            for (int o = 1; o < 64; o <<= 1)
#pragma unroll
                for (int rr = 0; rr < 16; ++rr) sm[rr] += __shfl_xor(sm[rr], o);
#pragma unroll
            for (int rr = 0; rr < 16; ++rr) { mu[rr] = sm[rr] * (1.f / 512.f); float q = 0.f;
#pragma unroll
                for (int e = 0; e < 8; ++e) { const float d = (float)hv[rr][e] - mu[rr]; q += d * d; }
                sm[rr] = q; }
#pragma unroll
            for (int o = 1; o < 64; o <<= 1)
#pragma unroll
                for (int rr = 0; rr < 16; ++rr) sm[rr] += __shfl_xor(sm[rr], o);
#pragma unroll
            for (int rr = 0; rr < 16; ++rr) { rsd[rr] = rsqrtf(sm[rr] * (1.f / 512.f) + EPS);
                const int t = wave * 16 + rr; float v[8];
#pragma unroll
                for (int e = 0; e < 8; ++e) v[e] = ((float)hv[rr][e] - mu[rr]) * rsd[rr];
                u32x4 w; w[0] = pkh(v[0] * g0[0] + b0[0], v[1] * g0[1] + b0[1]); w[1] = pkh(v[2] * g0[2] + b0[2], v[3] * g0[3] + b0[3]);
                w[2] = pkh(v[4] * g1[0] + b1[0], v[5] * g1[1] + b1[1]); w[3] = pkh(v[6] * g1[2] + b1[2], v[7] * g1[3] + b1[3]);
                *(LAS u32x4*)(lds + (lane >> 3) * 16384 + vt_off(t, lane & 7)) = w; }
        }
        __syncthreads();
        const GAS h16* Wh = W16 + (size_t)wave * GC * GC;
        const LAS unsigned char* vt = lds + wave * 16384;
        const int q4 = (lane & 15) >> 2, p4 = lane & 3, g1b = (lane >> 4) & 1;
#pragma unroll
        for (int tb = 0; tb < 4; ++tb) {
            f32x16 acc[2];
#pragma unroll
            for (int d0 = 0; d0 < 2; ++d0)
#pragma unroll
                for (int e = 0; e < 16; ++e) acc[d0][e] = 0.f;
            h16x8 af[8];
#pragma unroll
            for (int ks = 0; ks < 8; ++ks) if (ks <= 2 * tb + 1) af[ks] = *(const GAS h16x8*)(Wh + (size_t)(32 * tb + r32) * GC + 16 * ks + 8 * hi);
#pragma unroll
            for (int ks = 0; ks < 8; ++ks) {
                if (ks <= 2 * tb + 1) {
#pragma unroll
                    for (int d0 = 0; d0 < 2; ++d0) {
                        const int srow = 16 * ks + 8 * hi + q4, c8 = 4 * d0 + 2 * g1b + (p4 >> 1);
                        const h16x4 lo = tr16(vt + vt_off(srow, c8) + (p4 & 1) * 8), hi4 = tr16(vt + vt_off(srow + 4, c8) + (p4 & 1) * 8);
                        const h16x8 bf = (h16x8){lo[0], lo[1], lo[2], lo[3], hi4[0], hi4[1], hi4[2], hi4[3]};
                        acc[d0] = __builtin_amdgcn_mfma_f32_32x32x16_f16(af[ks], bf, acc[d0], 0, 0, 0);
                    }
                }
            }
            float bsv[16];
#pragma unroll
            for (int e = 0; e < 16; ++e) bsv[e] = b_s[wave * GC + 32 * tb + (e & 3) + 8 * (e >> 2) + 4 * hi];
            h16x8 uv[2][2];
#pragma unroll
            for (int d0 = 0; d0 < 2; ++d0)
#pragma unroll
                for (int i = 0; i < 2; ++i) uv[d0][i] = *(const GAS h16x8*)(proj + (row0 + 32 * tb + (lane >> 2) + 16 * i) * INW + PU + wave * 64 + 32 * d0 + (lane & 3) * 8);
            asm volatile("" ::: "memory");
            float rq[2] = {0.f, 0.f};
#pragma unroll
            for (int d0 = 0; d0 < 2; ++d0) {
#pragma unroll
                for (int e = 0; e < 16; ++e) *(LAS h16*)(gstg + ((e & 3) + 8 * (e >> 2) + 4 * hi) * 64 + r32 * 2) = (h16)(acc[d0][e] + bsv[e]);
                LDS_WAIT();
#pragma unroll
                for (int i = 0; i < 2; ++i) { const int rw = (lane >> 2) + 16 * i; const h16x8 mx = *(const LAS h16x8*)(gstg + rw * 64 + (lane & 3) * 16);
                    float o[8]; float q = 0.f;
#pragma unroll
                    for (int e = 0; e < 8; ++e) { o[e] = (float)uv[d0][i][e] * (float)mx[e]; q += o[e] * o[e]; }
                    u32x4 w; w[0] = pkh(o[0], o[1]); w[1] = pkh(o[2], o[3]); w[2] = pkh(o[4], o[5]); w[3] = pkh(o[6], o[7]);
                    *(GAS u32x4*)(proj + (row0 + 32 * tb + rw) * INW + PU + wave * 64 + 32 * d0 + (lane & 3) * 8) = w;
                    q += __shfl_xor(q, 1); q += __shfl_xor(q, 2); rq[i] += q; }
                LDS_WAIT();
            }
            if ((lane & 3) == 0) { rowsq[wave * 128 + 32 * tb + (lane >> 2)] = rq[0]; rowsq[wave * 128 + 32 * tb + (lane >> 2) + 16] = rq[1]; }
        }
        __syncthreads();
        if (tid < 128) { float s8 = 0.f;
#pragma unroll
            for (int w = 0; w < 8; ++w) s8 += rowsq[w * 128 + tid];
            RG[row0 + tid] = s8; }
        __syncthreads();
    }
}


constexpr size_t DO_PO = 0, DO_PML = 96 * MiB;
constexpr int CW_CNT = 8192;
constexpr int LISTCAP = 8192;
constexpr int AL_K = 0, AL_V = 32768, AL_STG = 65536, AL_WSF = 98304, AL_START = 102400;
__device__ __forceinline__ int k_off(int key, int c8) { return key * 128 + ((c8 ^ (key & 7)) << 4); }

__device__ __forceinline__ void moba_gate_phase(const Frame& F0, int shadow) {
    const int tid = threadIdx.x, lane = tid & 63;
    const GAS h16* proj = (const GAS h16*)(F0.ws + WS_PROJ); const GAS float* kmp = (const GAS float*)(F0.ws + WS_KMP);
    unsigned* cnt = F0.ctl + CW_CNT + (shadow ? 1024 : 0); GAS unsigned short* lists = (GAS unsigned short*)(F0.ws + (shadow ? WS_HG : WS_LISTS));
    LAS float* km = (LAS float*)F0.lds;
    for (int item = F0.vcu, rnd = 0; item < NB * NH * (S / 512); item += F0.G, ++rnd) {
        const int sp0 = item % (S / 512), span = (rnd & 1) ? (S / 512 - 1 - sp0) : sp0, bh = item / (S / 512), b = bh >> 3, h = bh & 7;
        __syncthreads();
        for (int e = tid; e < NBLK * 64; e += NWAVES * 64) { const int n = e >> 6, d = e & 63; const GAS float* kp = kmp + (size_t)((b * NBLK + n) * 2) * 512 + h * 64 + d; km[e] = kp[0] + kp[512]; }
        __syncthreads();
        const int sq = span * 512 + tid, own = __builtin_amdgcn_readfirstlane(sq >> 8);
        float q[64];
        { const GAS h16* qp = proj + (size_t)(b * S + sq) * INW + PQ + h * 64;
#pragma unroll
          for (int c = 0; c < 8; ++c) { const h16x8 v = *(const GAS h16x8*)(qp + 8 * c);
#pragma unroll
              for (int e = 0; e < 8; ++e) q[8 * c + e] = (float)v[e]; } }
        float v0 = -3e38f, v1 = -3e38f, v2 = -3e38f; int i0 = -1, i1 = -1, i2 = -1;
        for (int n = 0; n < own; ++n) {
            float g0 = 0.f, g1 = 0.f, g2 = 0.f, g3 = 0.f;
#pragma unroll
            for (int c = 0; c < 16; ++c) { const f32x4 kv = *(const LAS f32x4*)(km + n * 64 + 4 * c); g0 += q[4 * c] * kv[0]; g1 += q[4 * c + 1] * kv[1]; g2 += q[4 * c + 2] * kv[2]; g3 += q[4 * c + 3] * kv[3]; }
            const float g = (g0 + g1) + (g2 + g3);
            if (g > v0) { v2 = v1; i2 = i1; v1 = v0; i1 = i0; v0 = g; i0 = n; }
            else if (g > v1) { v2 = v1; i2 = i1; v1 = g; i1 = n; }
            else if (g > v2) { v2 = g; i2 = n; }
        }
        int mycnt = 0, pos0 = 0, pos1 = 0, pos2 = 0;
        const unsigned long long ltmask = (1ull << lane) - 1ull;
        for (int n = 0; n < own; ++n) {
            const bool sel = (i0 == n) || (i1 == n) || (i2 == n);
            const unsigned long long mask = __ballot(sel);
            const int before = __popcll(mask & ltmask);
            if (lane == n) mycnt = __popcll(mask);
            if (i0 == n) pos0 = before; if (i1 == n) pos1 = before; if (i2 == n) pos2 = before;
        }
        unsigned base = 0u;
        if (lane < own && mycnt > 0) base = atomicAdd(cnt + bh * NBLK + lane, (unsigned)mycnt);
        const unsigned bb0 = (unsigned)__shfl((int)base, i0 & 63), bb1 = (unsigned)__shfl((int)base, i1 & 63), bb2 = (unsigned)__shfl((int)base, i2 & 63);
        if (i0 >= 0) lists[(size_t)(bh * NBLK + i0) * LISTCAP + bb0 + pos0] = (unsigned short)(sq | (0 << 13));
        if (i1 >= 0) lists[(size_t)(bh * NBLK + i1) * LISTCAP + bb1 + pos1] = (unsigned short)(sq | (1 << 13));
        if (i2 >= 0) lists[(size_t)(bh * NBLK + i2) * LISTCAP + bb2 + pos2] = (unsigned short)(sq | (2 << 13));
    }
    __syncthreads();
}

template <bool CAUSAL>
__device__ __forceinline__ void attn_tile(const LAS unsigned char* ldsK, const LAS unsigned char* ldsV, const h16x8 (&qf)[4], int wave, int lane, f32x16 (&o)[2], float& m_out, float& l_out) {
    const int r32 = lane & 31, hi = lane >> 5;
    int kbase[4];
#pragma unroll
    for (int ks = 0; ks < 4; ++ks) kbase[ks] = r32 * 128 + (((2 * ks + hi) ^ (r32 & 7)) << 4);
    f32x16 sacc[8];
#pragma unroll
    for (int kb = 0; kb < 8; ++kb) {
        f32x16 acc;
#pragma unroll
        for (int e = 0; e < 16; ++e) acc[e] = 0.f;
#pragma unroll
        for (int ks = 0; ks < 4; ++ks) { const h16x8 kf = *(const LAS h16x8*)(ldsK + kbase[ks] + kb * 4096); acc = __builtin_amdgcn_mfma_f32_32x32x16_f16(kf, qf[ks], acc, 0, 0, 0); }
        if (CAUSAL) {
            const int lim = 32 * (wave - kb) + r32;
#pragma unroll
            for (int e = 0; e < 16; ++e) { const int key = (e & 3) + 8 * (e >> 2) + 4 * hi; if (key > lim) acc[e] = -1e30f; }
        }
        sacc[kb] = acc;
    }
    float m = -3e38f;
#pragma unroll
    for (int kb = 0; kb < 8; ++kb)
#pragma unroll
        for (int e = 0; e < 16; ++e) m = fmaxf(m, sacc[kb][e]);
    m = fmaxf(m, __shfl_xor(m, 32));
    float ls = 0.f;
#pragma unroll
    for (int kb = 0; kb < 8; ++kb)
#pragma unroll
        for (int e = 0; e < 16; ++e) { const float pv = __builtin_amdgcn_exp2f(sacc[kb][e] - m); sacc[kb][e] = pv; ls += pv; }
    ls += __shfl_xor(ls, 32);
#pragma unroll
    for (int d0 = 0; d0 < 2; ++d0)
#pragma unroll
        for (int e = 0; e < 16; ++e) o[d0][e] = 0.f;
    const int q4 = (lane & 15) >> 2, p4 = lane & 3, g1b = (lane >> 4) & 1;
    int vbase[2];
#pragma unroll
    for (int d0 = 0; d0 < 2; ++d0) vbase[d0] = (4 * hi + q4) * 128 + ((d0 ^ ((q4 >> 1) & 1)) << 6) + ((2 * g1b + (p4 >> 1)) << 4) + (p4 & 1) * 8;
#pragma unroll
    for (int kb = 0; kb < 8; ++kb) {
        if (!CAUSAL || kb <= wave) {
#pragma unroll
            for (int s2 = 0; s2 < 2; ++s2) {
                h16x8 pa;
#pragma unroll
                for (int j = 0; j < 8; ++j) pa[j] = (h16)sacc[kb][8 * s2 + j];
#pragma unroll
                for (int d0 = 0; d0 < 2; ++d0) {
                    const h16x4 lo = tr16(ldsV + vbase[d0] + kb * 4096 + s2 * 2048), hi4 = tr16(ldsV + vbase[d0] + kb * 4096 + s2 * 2048 + 1024);
                    const h16x8 bf = (h16x8){lo[0], lo[1], lo[2], lo[3], hi4[0], hi4[1], hi4[2], hi4[3]};
                    o[d0] = __builtin_amdgcn_mfma_f32_32x32x16_f16(pa, bf, o[d0], 0, 0, 0);
                }
            }
        }
    }
    m_out = m; l_out = ls;
}
__device__ __forceinline__ void attn_tile_causal(const LAS unsigned char* ldsK, const LAS unsigned char* ldsV, const h16x8 (&qf)[4], int wave, int lane, f32x16 (&o)[2], float& m_out, float& l_out) {
    const int r32 = lane & 31, hi = lane >> 5;
    int kbase[4];
#pragma unroll
    for (int ks = 0; ks < 4; ++ks) kbase[ks] = r32 * 128 + (((2 * ks + hi) ^ (r32 & 7)) << 4);
    const int q4 = (lane & 15) >> 2, p4 = lane & 3, g1b = (lane >> 4) & 1;
    int vbase[2];
#pragma unroll
    for (int d0 = 0; d0 < 2; ++d0) vbase[d0] = (4 * hi + q4) * 128 + ((d0 ^ ((q4 >> 1) & 1)) << 6) + ((2 * g1b + (p4 >> 1)) << 4) + (p4 & 1) * 8;
    float m = -3e38f;
    for (int kb = 0; kb <= wave; ++kb) {
        f32x16 acc;
#pragma unroll
        for (int e = 0; e < 16; ++e) acc[e] = 0.f;
#pragma unroll
        for (int ks = 0; ks < 4; ++ks) { const h16x8 kf = *(const LAS h16x8*)(ldsK + kbase[ks] + kb * 4096); acc = __builtin_amdgcn_mfma_f32_32x32x16_f16(kf, qf[ks], acc, 0, 0, 0); }
        const int lim = (kb == wave) ? r32 : 64;
#pragma unroll
        for (int e = 0; e < 16; ++e) { const int key = (e & 3) + 8 * (e >> 2) + 4 * hi; if (key <= lim) m = fmaxf(m, acc[e]); }
    }
    m = fmaxf(m, __shfl_xor(m, 32));
    float ls = 0.f;
#pragma unroll
    for (int d0 = 0; d0 < 2; ++d0)
#pragma unroll
        for (int e = 0; e < 16; ++e) o[d0][e] = 0.f;
    for (int kb = 0; kb <= wave; ++kb) {
        f32x16 acc;
#pragma unroll
        for (int e = 0; e < 16; ++e) acc[e] = 0.f;
#pragma unroll
        for (int ks = 0; ks < 4; ++ks) { const h16x8 kf = *(const LAS h16x8*)(ldsK + kbase[ks] + kb * 4096); acc = __builtin_amdgcn_mfma_f32_32x32x16_f16(kf, qf[ks], acc, 0, 0, 0); }
        const int lim = (kb == wave) ? r32 : 64;
#pragma unroll
        for (int e = 0; e < 16; ++e) { const int key = (e & 3) + 8 * (e >> 2) + 4 * hi; const float pv = (key <= lim) ? __builtin_amdgcn_exp2f(acc[e] - m) : 0.f; acc[e] = pv; ls += pv; }
#pragma unroll
        for (int s2 = 0; s2 < 2; ++s2) {
            h16x8 pa;
#pragma unroll
            for (int j = 0; j < 8; ++j) pa[j] = (h16)acc[8 * s2 + j];
#pragma unroll
            for (int d0 = 0; d0 < 2; ++d0) {
                const h16x4 lo = tr16(ldsV + vbase[d0] + kb * 4096 + s2 * 2048), hi4 = tr16(ldsV + vbase[d0] + kb * 4096 + s2 * 2048 + 1024);
                const h16x8 bf = (h16x8){lo[0], lo[1], lo[2], lo[3], hi4[0], hi4[1], hi4[2], hi4[3]};
                o[d0] = __builtin_amdgcn_mfma_f32_32x32x16_f16(pa, bf, o[d0], 0, 0, 0);
            }
        }
    }
    ls += __shfl_xor(ls, 32);
    m_out = m; l_out = ls;
}
__device__ __forceinline__ void load_kv_block(LAS unsigned char* lds, const GAS h16* proj, size_t row0, int h, int tid) {
#pragma unroll
    for (int i = 0; i < 4; ++i) { const int idx = tid + 512 * i, key = idx >> 3, c8 = idx & 7; const GAS h16* rp = proj + (row0 + key) * INW + h * 64 + 8 * c8;
        const u32x4 kv = *(const GAS u32x4*)(rp + PK), vv = *(const GAS u32x4*)(rp + PV);
        *(LAS u32x4*)(lds + AL_K + k_off(key, c8)) = kv; *(LAS u32x4*)(lds + AL_V + vt_off(key, c8)) = vv; }
}
__device__ __forceinline__ void stage_o(LAS unsigned char* stg, LAS float* wsf, const f32x16 (&o)[2], float l, int lane) {
    const int r32 = lane & 31, hi = lane >> 5;
    if (hi == 0) wsf[r32] = 1.f / l;
    LDS_WAIT();
#pragma unroll
    for (int e = 0; e < 16; ++e) { const int qr = (e & 3) + 8 * (e >> 2) + 4 * hi; const float rl = wsf[qr];
        *(LAS h16*)(stg + qr * 128 + r32 * 2) = (h16)(o[0][e] * rl); *(LAS h16*)(stg + qr * 128 + 64 + r32 * 2) = (h16)(o[1][e] * rl); }
    LDS_WAIT();
}

struct KvRegs { u32x4 kv[4], vv[4]; };
__device__ __forceinline__ void kv_fetch(KvRegs& r, const GAS h16* proj, size_t row0, int h, int tid) {
#pragma unroll
    for (int i = 0; i < 4; ++i) { const int idx = tid + 512 * i, key = idx >> 3, c8 = idx & 7; const GAS h16* rp = proj + (row0 + key) * INW + h * 64 + 8 * c8;
        r.kv[i] = *(const GAS u32x4*)(rp + PK); r.vv[i] = *(const GAS u32x4*)(rp + PV); }
}
__device__ __forceinline__ void kv_commit(const KvRegs& r, LAS unsigned char* lds, int tid) {
#pragma unroll
    for (int i = 0; i < 4; ++i) { const int idx = tid + 512 * i, key = idx >> 3, c8 = idx & 7;
        *(LAS u32x4*)(lds + AL_K + k_off(key, c8)) = r.kv[i]; *(LAS u32x4*)(lds + AL_V + vt_off(key, c8)) = r.vv[i]; }
}
__device__ __forceinline__ void moba_b_phase(const Frame& F0, GAS float* dout) {
    const int tid = threadIdx.x, lane = tid & 63, wave = __builtin_amdgcn_readfirstlane(tid >> 6), r32 = lane & 31, hi = lane >> 5;
    const GAS h16* proj = (const GAS h16*)(F0.ws + WS_PROJ); const unsigned* cnt = F0.ctl + CW_CNT; const GAS unsigned short* lists = (const GAS unsigned short*)(F0.ws + WS_LISTS);
    GAS h16* PO = (GAS h16*)((unsigned char*)dout + DO_PO); GAS float* PML = (GAS float*)((unsigned char*)dout + DO_PML);
    LAS unsigned char* lds = F0.lds;
    LAS int* start = (LAS int*)(lds + AL_START);
    LAS float* wsf = (LAS float*)(lds + AL_WSF + wave * 512); LAS int* wsi = (LAS int*)(lds + AL_WSF + wave * 512 + 256);
    LAS unsigned char* stg = lds + AL_STG + wave * 4096;
    {
        const unsigned c0 = cnt[2 * tid], c1 = cnt[2 * tid + 1];
        const int t0 = (int)((c0 + 255u) >> 8), t1 = (int)((c1 + 255u) >> 8);
        int v = t0 + t1, inc = v;
#pragma unroll
        for (int o = 1; o < 64; o <<= 1) { const int u = __shfl_up(inc, o); if (lane >= o) inc += u; }
        LAS int* wtot = (LAS int*)(lds + AL_WSF);
        __syncthreads();
        if (lane == 63) wtot[wave] = inc;
        __syncthreads();
        int pre = 0;
        for (int w = 0; w < wave; ++w) pre += wtot[w];
        const int ex = pre + inc - v;
        __syncthreads();
        start[2 * tid] = ex; start[2 * tid + 1] = ex + t0;
        if (tid == 511) start[1024] = ex + v;
        __syncthreads();
    }
    const int nitems = start[1024];
    for (int item = F0.vcu; item < nitems; item += F0.G) {
        int lo = 0, hi_ = 1024;
        while (hi_ - lo > 1) { const int mid = (lo + hi_) >> 1; if (start[mid] <= item) lo = mid; else hi_ = mid; }
        const int l = lo, chunk = item - start[l];
        const int bh = l >> 5, n = l & 31, b = bh >> 3, h = bh & 7;
        const int nq = (int)cnt[l] - chunk * 256;
        const int qi = chunk * 256 + wave * 32 + r32;
        const bool valid = (wave * 32 + r32) < nq;
        const unsigned ent = lists[(size_t)l * LISTCAP + (valid ? qi : chunk * 256)];
        KvRegs kvr; kv_fetch(kvr, proj, (size_t)b * S + (size_t)n * MBLK, h, tid);
        const int sq = ent & 8191, rank = ent >> 13;
        h16x8 qf[4];
        { const GAS h16* qp = proj + (size_t)(b * S + sq) * INW + PQ + h * 64 + 8 * hi;
#pragma unroll
          for (int ks = 0; ks < 4; ++ks) qf[ks] = *(const GAS h16x8*)(qp + 16 * ks); }
        kv_commit(kvr, lds, tid);
        __syncthreads();
        if (wave * 32 < nq) {
            f32x16 o[2]; float m, lsum;
            attn_tile<false>(lds + AL_K, lds + AL_V, qf, wave, lane, o, m, lsum);
            const int slot = ((b * NH + h) * 3 + rank) * S + sq;
            if (hi == 0) { wsi[r32] = valid ? slot : -1; if (valid) { PML[(size_t)slot * 2] = m; PML[(size_t)slot * 2 + 1] = lsum; } }
            stage_o(stg, wsf, o, lsum, lane);
#pragma unroll
            for (int i = 0; i < 4; ++i) { const int row = i * 8 + (lane >> 3), ch = lane & 7; const int sl = wsi[row];
                if (sl >= 0) *(GAS u32x4*)(PO + (size_t)sl * 64 + ch * 8) = *(const LAS u32x4*)(stg + row * 128 + ch * 16); }
        }
        __syncthreads();
    }
}

__device__ __forceinline__ void moba_c_phase(const Frame& F0, const GAS float* dout, int shadow) {
    const int tid = threadIdx.x, lane = tid & 63, wave = __builtin_amdgcn_readfirstlane(tid >> 6), r32 = lane & 31, hi = lane >> 5;
    GAS h16* proj = (GAS h16*)(F0.ws + WS_PROJ); GAS float* SSQA = (GAS float*)(F0.ws + WS_SSQA);
    const GAS h16* PO = (const GAS h16*)((const unsigned char*)dout + DO_PO); const GAS float* PML = (const GAS float*)((const unsigned char*)dout + DO_PML);
    LAS unsigned char* lds = F0.lds;
    LAS float* wsf = (LAS float*)(lds + AL_WSF + wave * 512);
    LAS unsigned char* stg = lds + AL_STG + wave * 4096;
    KvRegs kvr;
    if (F0.vcu < NB * NH * NBLK) { const int u0 = F0.vcu; kv_fetch(kvr, proj, (size_t)((u0 >> 5) >> 3) * S + (size_t)(u0 & 31) * MBLK, (u0 >> 5) & 7, tid); }
    for (int unit = F0.vcu; unit < NB * NH * NBLK; unit += F0.G) {
        const int qb = unit & 31, bh = unit >> 5, b = bh >> 3, h = bh & 7;
        const size_t row0 = (size_t)b * S + (size_t)qb * MBLK;
        kv_commit(kvr, lds, tid);
        { const int un = unit + F0.G; if (un < NB * NH * NBLK) kv_fetch(kvr, proj, (size_t)((un >> 5) >> 3) * S + (size_t)(un & 31) * MBLK, (un >> 5) & 7, tid); }
        h16x8 qf[4];
        { const GAS h16* qp = proj + (row0 + wave * 32 + r32) * INW + PQ + h * 64 + 8 * hi;
#pragma unroll
          for (int ks = 0; ks < 4; ++ks) qf[ks] = *(const GAS h16x8*)(qp + 16 * ks); }
        __syncthreads();
        f32x16 o[2]; float m, lsum;
        attn_tile_causal(lds + AL_K, lds + AL_V, qf, wave, lane, o, m, lsum);
        if (hi == 0) { wsf[32 + r32] = m; wsf[64 + r32] = lsum; }
        stage_o(stg, wsf, o, lsum, lane);
        const int nsel = qb < 3 ? qb : 3;
#pragma unroll
        for (int i0 = 0; i0 < 4; i0 += 2) {
            float mr[2][3], lr[2][3]; h16x8 pv[2][3];
#pragma unroll
            for (int ii = 0; ii < 2; ++ii) { const size_t grow = row0 + wave * 32 + (i0 + ii) * 8 + (lane >> 3);
#pragma unroll
                for (int r = 0; r < 3; ++r) { if (r < nsel) { const size_t sl = ((size_t)(b * NH + h) * 3 + r) * S + (grow - (size_t)b * S); mr[ii][r] = PML[sl * 2]; lr[ii][r] = PML[sl * 2 + 1]; pv[ii][r] = *(const GAS h16x8*)(PO + sl * 64 + (lane & 7) * 8); } } }
            asm volatile("" ::: "memory");
#pragma unroll
            for (int ii = 0; ii < 2; ++ii) {
                const int row = (i0 + ii) * 8 + (lane >> 3), ch = lane & 7;
                const size_t grow = row0 + wave * 32 + row;
                const float mo = wsf[32 + row], lo_ = wsf[64 + row];
                const h16x8 ov = *(const LAS h16x8*)(stg + row * 128 + ch * 16);
                float mmax = mo;
#pragma unroll
                for (int r = 0; r < 3; ++r) { if (r < nsel) mmax = fmaxf(mmax, mr[ii][r]); }
                float wo = lo_ * __builtin_amdgcn_exp2f(mo - mmax), L = wo;
                float acc[8];
#pragma unroll
                for (int e = 0; e < 8; ++e) acc[e] = wo * (float)ov[e];
#pragma unroll
                for (int r = 0; r < 3; ++r) { if (r < nsel) { const float wr_ = lr[ii][r] * __builtin_amdgcn_exp2f(mr[ii][r] - mmax); L += wr_;
#pragma unroll
                    for (int e = 0; e < 8; ++e) acc[e] += wr_ * (float)pv[ii][r][e]; } }
                const float rL = 1.f / L; float q = 0.f; u32x4 w;
#pragma unroll
                for (int e = 0; e < 8; ++e) { acc[e] *= rL; q += acc[e] * acc[e]; }
                w[0] = pkh(acc[0], acc[1]); w[1] = pkh(acc[2], acc[3]); w[2] = pkh(acc[4], acc[5]); w[3] = pkh(acc[6], acc[7]);
                if (shadow) *(GAS u32x4*)((GAS h16*)(F0.ws + WS_HG) + grow * 512 + h * 64 + ch * 8) = w;
                else *(GAS u32x4*)(proj + grow * INW + PQ + h * 64 + ch * 8) = w;
                q += __shfl_xor(q, 1); q += __shfl_xor(q, 2); q += __shfl_xor(q, 4);
                if (ch == 0) SSQA[grow * 8 + h] = q;
            }
        }
        __syncthreads();
    }
}


template <bool PART16, class Order> __device__ __forceinline__ void fill_rowscale(LAS float* tab, const Order& So, const GAS float* src, int maxu) {
    pg8::Unit uu;
    for (int i = 0; i < maxu && So.next(i, uu); ++i)
        if (threadIdx.x < 256) { const int row = uu.pm * 256 + (int)threadIdx.x; tab[i * 256 + threadIdx.x] = PART16 ? rs16p(src + row) : src[row]; }
    __syncthreads();
}
constexpr int TAB_OFF = MISC_OFF + 128, TAB_MAXU = 15;
static_assert(TAB_OFF + TAB_MAXU * 1024 <= LDS_BYTES, "row-scale table");

enum Phase { PH_P0 = 0, PH_P1, PH_G1A, PH_G1B, PH_INPROJ, PH_MIX_A, PH_MIX_B, PH_MIX_C, PH_OUTPROJ, PH_G2A, PH_G2B, PH_FINAL, PH_COUNT };
__global__ void __launch_bounds__(NWAVES * 64, 2) mega_fwd(Args args) {
    extern __shared__ __attribute__((aligned(16))) unsigned char lds[];
    Frame F;
    F.lds = (LAS unsigned char*)lds; F.MISC = (volatile LAS unsigned*)(F.lds + MISC_OFF);
    F.tid = threadIdx.x; F.lane = F.tid & 63; F.wave = __builtin_amdgcn_readfirstlane(F.tid >> 6);
    F.G = gridDim.x; { const int bx = blockIdx.x; F.vcu = (F.G % 8 == 0) ? (bx % 8) * (F.G / 8) + bx / 8 : bx; }
    F.ws = args.ws; F.out = (GAS float*)args.out; F.ctl = (unsigned*)(args.ws + WS_CTL);
    for (int u = F.tid; u < (LDS_BYTES - LDSCTL_OFF) / 4; u += NWAVES * 64) ((LAS unsigned*)(F.lds + LDSCTL_OFF))[u] = 0u;
    __syncthreads();
    XcdBarrier bar; bar.bar = F.ctl + CW_BAR; bar.x = 0; bar.st = nullptr;
    const int lo = args.ph_lo, hi = args.ph_hi;
    if (hi - lo > 1) bar = xcd_barrier_post(F.ctl + CW_BAR, F.MISC + 8);
#ifndef MK_PHASE_MASK
#define MK_PHASE_MASK 0xFFFF
#endif
#define IN(k) (((MK_PHASE_MASK >> (k)) & 1) && lo <= (k) && (k) < hi)
#define SEAM(k) do { if (IN(k) && IN((k) + 1)) xcd_barrier(bar); } while (0)
#define PHASE_PTRS() unsigned char* ws = args.ws; asm volatile("" : "+s"(ws)); const GAS float* GT = (const GAS float*)(ws + WS_GT); const GAS float* GP = (const GAS float*)(ws + WS_GP); (void)GT; (void)GP; F.ws = ws
    if (IN(PH_P0)) { PHASE_PTRS(); p0_prologue(F, args); SEAM(PH_P0); }
    if (IN(PH_P1)) { PHASE_PTRS(); p1_prep(F, args); SEAM(PH_P1); }
    if (IN(PH_G1A)) {
        PHASE_PTRS();
        pg8::Gemm g{(const GAS h16*)(ws + WS_HG), (const GAS h16*)(ws + WS_WGU1), 0, NGU, D}; pg8::StaticOrder So; So.init(M, NGU, F.G, (int)blockIdx.x); const pg8::TableOrder To = pg8::make_table(So, (LAS int*)(F.lds + LDSCTL_OFF));
#if MK_SHADOW == 1
        if (args.ph_lo == PH_G1A && args.ph_hi == PH_G1A + 1 && args.shadow) { EpiNull En; pg8::gemm_phase<EpiNull, true, MK_GPROBE>(F.lds, g, So, En); return; }
#endif
        fill_rowscale<false>((LAS float*)(F.lds + TAB_OFF), To, (const GAS float*)(ws + WS_R1), TAB_MAXU);
        EpiSwiglu E{(GAS h16*)(ws + WS_ACT), (const LAS float*)(F.lds + TAB_OFF), (const GAS float*)(ws + WS_BIAS1)};
        pg8::gemm_phase<EpiSwiglu, true, 0, pg8::TableOrder>(F.lds, g, To, E); SEAM(PH_G1A);
    }
    if (IN(PH_G1B)) {
        PHASE_PTRS();
        pg8::Gemm g{(const GAS h16*)(ws + WS_ACT), (const GAS h16*)(ws + WS_WD1), 0, D, DFF, MK_STAG}; pg8::StaticOrder So; So.init(M, D, F.G, (int)blockIdx.x); const pg8::TableOrder To = pg8::make_table(So, (LAS int*)(F.lds + LDSCTL_OFF));
#if MK_SHADOW == 8
        if (args.ph_lo == PH_G1B && args.ph_hi == PH_G1B + 1 && args.shadow) {
#if MK_GPROBE == 0
            EpiNull En; pg8::gemm_phase<EpiNull, true>(F.lds, g, So, En);
#else
            EpiResid<true, false, true, MK_GPROBE> Ev{GIN(args, 0), (GAS h16*)(ws + WS_H), (GAS h16*)(ws + WS_HG), GT + 0 * 4 * D, GP + 1 * 4 * D, (GAS float*)(ws + WS_SSQ2), nullptr, 0.5f};
            pg8::gemm_phase<EpiResid<true, false, true, MK_GPROBE>, true>(F.lds, g, So, Ev);
#endif
            return; }
#endif
        EpiResid<true, false, true> E{GIN(args, 0), (GAS h16*)(ws + WS_H), (GAS h16*)(ws + WS_HG), GT + 0 * 4 * D, GP + 1 * 4 * D, (GAS float*)(ws + WS_SSQ2), nullptr, 0.5f};
        pg8::gemm_phase<EpiResid<true, false, true>, true, 0, pg8::TableOrder>(F.lds, g, To, E); SEAM(PH_G1B);
    }
    if (IN(PH_INPROJ)) {
        PHASE_PTRS();
        pg8::Gemm g{(const GAS h16*)(ws + WS_HG), (const GAS h16*)(ws + WS_WIN), 0, INW, D}; pg8::StaticOrder So; So.init(M, INW, F.G, (int)blockIdx.x); const pg8::TableOrder To = pg8::make_table(So, (LAS int*)(F.lds + LDSCTL_OFF));
        fill_rowscale<true>((LAS float*)(F.lds + TAB_OFF), To, (const GAS float*)(ws + WS_SSQ2), TAB_MAXU);
        EpiInproj E{(GAS h16*)(ws + WS_PROJ), (const LAS float*)(F.lds + TAB_OFF), (const GAS float*)(ws + WS_BIAS2), (const GAS float*)(ws + WS_ROPE), (GAS float*)(ws + WS_KMP)};
        pg8::gemm_phase<EpiInproj, true, 0, pg8::TableOrder>(F.lds, g, To, E); SEAM(PH_INPROJ);
    }
    if (IN(PH_MIX_A)) { PHASE_PTRS(); if (!(args.shadow & 2)) gmlp_phase(F, args, args.shadow & 1); if (!(args.shadow & 4)) moba_gate_phase(F, args.shadow & 1); SEAM(PH_MIX_A); }
    if (IN(PH_MIX_B)) { PHASE_PTRS(); moba_b_phase(F, (GAS float*)args.out); SEAM(PH_MIX_B); }
    if (IN(PH_MIX_C)) { PHASE_PTRS(); moba_c_phase(F, (const GAS float*)args.out, args.shadow & 1); SEAM(PH_MIX_C); }
    if (IN(PH_OUTPROJ)) {
        PHASE_PTRS();
        pg8::Gemm g{(const GAS h16*)(ws + WS_PROJ), (const GAS h16*)(ws + WS_WOUT), INW, D, D}; pg8::StaticOrder So; So.init(M, D, F.G, (int)blockIdx.x); const pg8::TableOrder To = pg8::make_table(So, (LAS int*)(F.lds + LDSCTL_OFF));
        const LAS float* sct = (const LAS float*)(F.lds + MISC_OFF + 128);
        {   LAS float* t = (LAS float*)(F.lds + MISC_OFF + 128); const GAS float* ssqa = (const GAS float*)(ws + WS_SSQA); const GAS float* ssqg = (const GAS float*)(ws + WS_RG);
            pg8::Unit uu;
            for (int i = 0; i < 4 && To.next(i, uu); ++i)
                if (F.tid < 256) { const int row = uu.pm * 256 + F.tid; const f32x4 a = *(const GAS f32x4*)(ssqa + (size_t)row * 8), bq = *(const GAS f32x4*)(ssqa + (size_t)row * 8 + 4);
                    const float ra = rsqrtf((((a[0] + a[1]) + (a[2] + a[3])) + ((bq[0] + bq[1]) + (bq[2] + bq[3]))) * (1.f / 512.f) + EPS), rg = rsqrtf(ssqg[row] * (1.f / 512.f) + EPS);
                    t[i * 512 + F.tid] = ra / rg; t[i * 512 + 256 + F.tid] = rg; }
            __syncthreads(); }
        EpiResid<false, true, true> E{nullptr, (GAS h16*)(ws + WS_H), (GAS h16*)(ws + WS_HG), GT + 1 * 4 * D, GP + 2 * 4 * D, (GAS float*)(ws + WS_SSQ3), sct, 1.0f};
        pg8::gemm_phase<EpiResid<false, true, true>, true, 0, pg8::TableOrder>(F.lds, g, To, E); SEAM(PH_OUTPROJ);
    }
    if (IN(PH_G2A)) {
        PHASE_PTRS();
        pg8::Gemm g{(const GAS h16*)(ws + WS_HG), (const GAS h16*)(ws + WS_WGU2), 0, NGU, D}; pg8::StaticOrder So; So.init(M, NGU, F.G, (int)blockIdx.x); const pg8::TableOrder To = pg8::make_table(So, (LAS int*)(F.lds + LDSCTL_OFF));
        fill_rowscale<true>((LAS float*)(F.lds + TAB_OFF), To, (const GAS float*)(ws + WS_SSQ3), TAB_MAXU);
        EpiSwiglu E{(GAS h16*)(ws + WS_ACT), (const LAS float*)(F.lds + TAB_OFF), (const GAS float*)(ws + WS_BIAS3)};
        pg8::gemm_phase<EpiSwiglu, true, 0, pg8::TableOrder>(F.lds, g, To, E); SEAM(PH_G2A);
    }
    if (IN(PH_G2B)) {
        PHASE_PTRS();
        pg8::Gemm g{(const GAS h16*)(ws + WS_ACT), (const GAS h16*)(ws + WS_WD2), 0, D, DFF}; pg8::StaticOrder So; So.init(M, D, F.G, (int)blockIdx.x); const pg8::TableOrder To = pg8::make_table(So, (LAS int*)(F.lds + LDSCTL_OFF));
#if MK_FUSE_FINAL
        EpiFinal E{(const GAS h16*)(ws + WS_H), GT + 2 * 4 * D, GIN(args, 19), (GAS float*)args.out, (unsigned*)(ws + WS_SSQF), F.ctl + CW_PAN, F.ctl + CW_TMO,
                   (LAS float*)(F.lds + MISC_OFF + 128), (LAS float*)(F.lds + MISC_OFF + 128 + 4096), 0.5f};
        pg8::gemm_phase<EpiFinal, true, 0, pg8::TableOrder>(F.lds, g, To, E);
#else
        EpiResid<false, false, false> E{nullptr, (GAS h16*)(ws + WS_H), nullptr, GT + 2 * 4 * D, nullptr, (GAS float*)(ws + WS_SSQF), nullptr, 0.5f};
        pg8::gemm_phase<EpiResid<false, false, false>, true, 0, pg8::TableOrder>(F.lds, g, To, E); SEAM(PH_G2B);
#endif
    }
#if !MK_FUSE_FINAL
    if (IN(PH_FINAL)) { PHASE_PTRS(); p_final(F, args); }
#endif
#undef IN
#undef SEAM
}

extern "C" void kernel_launch(void* const* d_in, const int* in_sizes, int n_in, void* d_out, int out_size, void* d_ws, size_t ws_size, hipStream_t stream) {
    static int grid = 0;
    if (grid == 0) {
        if (n_in != 20 || out_size != M * D || ws_size < WS_END) { fprintf(stderr, "kernel_launch: unexpected shapes (n_in %d out %d ws %zu)\n", n_in, out_size, ws_size); grid = -1; return; }
        int dev = 0, cus = 0, per_cu = 0;
        hipGetDevice(&dev); hipDeviceGetAttribute(&cus, hipDeviceAttributeMultiprocessorCount, dev);
        if (hipFuncSetAttribute((const void*)mega_fwd, hipFuncAttributeMaxDynamicSharedMemorySize, LDS_BYTES) != hipSuccess) { fprintf(stderr, "kernel_launch: hipFuncSetAttribute failed\n"); grid = -1; return; }
        hipOccupancyMaxActiveBlocksPerMultiprocessor(&per_cu, (const void*)mega_fwd, NWAVES * 64, LDS_BYTES);
        (void)hipGetLastError();
        if (per_cu < 1) { fprintf(stderr, "kernel_launch: occupancy query says %d blocks/CU; nothing launched\n", per_cu); grid = -1; return; }
        grid = cus;
    }
    if (grid < 0) return;
    hipMemsetAsync((char*)d_ws + WS_CTL, 0, CTL_ZERO_BYTES, stream);
    Args a{};
    for (int i = 0; i < 20; ++i) a.in[i] = (const float*)d_in[i];
    a.out = (float*)d_out; a.ws = (unsigned char*)d_ws;
    unsigned char* ws = (unsigned char*)d_ws;
    auto run = [&](int lo, int hi) {
#if MK_PER_PHASE
        for (int p = lo; p < hi; ++p) {
            if (MK_SHADOW == 2 && p == PH_MIX_A) { a.ph_lo = p; a.ph_hi = p + 1; a.shadow = 1 | 4; hipLaunchKernelGGL(mega_fwd, dim3(grid), dim3(NWAVES * 64), LDS_BYTES, stream, a); a.shadow = 0; }
            if (MK_SHADOW == 10 && p == PH_MIX_A) { a.ph_lo = p; a.ph_hi = p + 1; a.shadow = 1 | 2 | 4; hipLaunchKernelGGL(mega_fwd, dim3(grid), dim3(NWAVES * 64), LDS_BYTES, stream, a); a.shadow = 0; }
            if (MK_SHADOW == 3 && p == PH_MIX_A) { a.ph_lo = p; a.ph_hi = p + 1; a.shadow = 1 | 2; hipLaunchKernelGGL(mega_fwd, dim3(grid), dim3(NWAVES * 64), LDS_BYTES, stream, a); a.shadow = 0; }
            if (MK_SHADOW == 4 && p == PH_MIX_C) { a.ph_lo = p; a.ph_hi = p + 1; a.shadow = 1; hipLaunchKernelGGL(mega_fwd, dim3(grid), dim3(NWAVES * 64), LDS_BYTES, stream, a); a.shadow = 0; }
            if (MK_SHADOW == 8 && p == PH_G1B) { a.ph_lo = p; a.ph_hi = p + 1; a.shadow = 1; hipLaunchKernelGGL(mega_fwd, dim3(grid), dim3(NWAVES * 64), LDS_BYTES, stream, a); a.shadow = 0; }
            if (MK_SHADOW == 1 && p == PH_G1A) { a.ph_lo = p; a.ph_hi = p + 1; a.shadow = 1; hipLaunchKernelGGL(mega_fwd, dim3(grid), dim3(NWAVES * 64), LDS_BYTES, stream, a); a.shadow = 0; }
            for (int rep = 0; rep < ((((MK_DUP_MASK) >> p) & 1) ? 2 : 1); ++rep) { a.ph_lo = p; a.ph_hi = p + 1; hipLaunchKernelGGL(mega_fwd, dim3(grid), dim3(NWAVES * 64), LDS_BYTES, stream, a); }
        }
#else
        a.ph_lo = lo; a.ph_hi = hi;
        void* kargs[] = {(void*)&a};
        hipError_t e = hipLaunchCooperativeKernel((const void*)mega_fwd, dim3(grid), dim3(NWAVES * 64), kargs, LDS_BYTES, stream);
        if (e != hipSuccess) fprintf(stderr, "kernel_launch: cooperative launch failed: %s (grid %d)\n", hipGetErrorString(e), grid);
#endif
    };
    run(PH_P0, PH_COUNT);
}
```

```cpp
#include <hip/hip_runtime.h>
#include <cstdio>
#include <cstdint>

#ifndef MK_DUP_MASK
#define MK_DUP_MASK 0
#endif
#ifndef MK_GPROBE
#define MK_GPROBE 0
#endif
#ifndef MK_SHADOW
#define MK_SHADOW 0
#endif
#ifndef MK_FUSE_FINAL
#define MK_FUSE_FINAL 1
#endif
#ifndef MK_STAG
#define MK_STAG 0
#endif
#ifndef MK_NT
#define MK_NT 0x0
#endif
#ifndef MK_LEBITS
#define MK_LEBITS 6u
#endif
#ifndef MK_LOWENT
#define MK_LOWENT 3
#endif
#ifndef MK_PER_PHASE
#define MK_PER_PHASE 0
#endif

#define GAS __attribute__((address_space(1)))
#define LAS __attribute__((address_space(3)))
typedef _Float16 h16;
typedef _Float16 h16x8 __attribute__((ext_vector_type(8)));
typedef _Float16 h16x4 __attribute__((ext_vector_type(4)));
typedef _Float16 h16x2 __attribute__((ext_vector_type(2)));
typedef float f32x4 __attribute__((ext_vector_type(4)));
typedef float f32x2 __attribute__((ext_vector_type(2)));
typedef unsigned u32x4 __attribute__((ext_vector_type(4)));
typedef unsigned u32x2 __attribute__((ext_vector_type(2)));

constexpr int D = 1024, NB = 4, S = 8192, M = NB * S, DFF = 2816, NGU = 2 * DFF, NMOD = 9;
constexpr int AW = 512, HD = 64, NH = 8, INW = 2560, MBLK = 256, NBLK = S / MBLK, GC = 128;
constexpr float EPS = 1e-6f;
constexpr float C2 = 0.125f * 1.4426950408889634f;
constexpr int PQ = 0, PU = 512, PK = 1024, PV = 1536, PG = 2048;

constexpr size_t MiB = 1u << 20, KiB = 1u << 10;
constexpr size_t WS_CTL = 0, CTL_ZERO_BYTES = 1 * MiB;
constexpr size_t WS_MODP = 1 * MiB;
constexpr size_t WS_GT = 2 * MiB, WS_GP = WS_GT + 64 * KiB;
constexpr size_t WS_BIAS1 = WS_GT + 128 * KiB, WS_BIAS2 = WS_GT + 256 * KiB, WS_BIAS3 = WS_GT + 320 * KiB;
constexpr size_t WS_R1 = 3 * MiB, WS_RG = WS_R1 + 128 * KiB;
constexpr size_t WS_SSQA = 4 * MiB;
constexpr size_t WS_SSQ2 = 5 * MiB, WS_SSQ3 = 7 * MiB, WS_SSQF = 9 * MiB;
constexpr size_t WS_KMP = 11 * MiB;
constexpr size_t WS_ROPE = 12 * MiB;
constexpr size_t WS_WS16 = 14 * MiB;
constexpr size_t WS_WGU1 = 16 * MiB, WS_WD1 = 27 * MiB, WS_WIN = 33 * MiB, WS_WOUT = 38 * MiB, WS_WGU2 = 40 * MiB, WS_WD2 = 51 * MiB;
constexpr size_t WS_HG = 64 * MiB, WS_H = 128 * MiB, WS_ACT = 192 * MiB, WS_PROJ = WS_ACT;
constexpr size_t WS_LISTS = 368 * MiB, WS_END = 384 * MiB;
static_assert(WS_WD2 + (size_t)D * DFF * 2 <= WS_HG && WS_ACT + (size_t)M * DFF * 2 <= WS_LISTS, "ws map");
constexpr int CW_TMO = 0, CW_BAR = 4096;

constexpr int RING_BYTES = 131072, LDSCTL_OFF = RING_BYTES, MISC_OFF = LDSCTL_OFF + 320, LDS_BYTES = 163840;
constexpr int NWAVES = 8;

#define LDS_WAIT() asm volatile("s_waitcnt lgkmcnt(0)" ::: "memory")
#define VM_WAIT() asm volatile("s_waitcnt vmcnt(0)" ::: "memory")

__device__ __forceinline__ float wave_sum(float v) {
#pragma unroll
    for (int o = 1; o < 64; o <<= 1) v += __shfl_xor(v, o);
    return v;
}
template <int SEL, class T> __device__ __forceinline__ void st_stream(GAS T* p, const T& v) { if ((MK_NT >> SEL) & 1) __builtin_nontemporal_store(v, p); else *p = v; }
__device__ __forceinline__ unsigned pkh(float lo, float hi) { h16x2 v; v.x = (h16)lo; v.y = (h16)hi; return __builtin_bit_cast(unsigned, v); }
__device__ __forceinline__ float round8a(float x) { constexpr unsigned drop = 24u - MK_LEBITS; unsigned u = __float_as_uint(x); u += ((1u << (drop - 1)) - 1u) + ((u >> drop) & 1u); u &= ~((1u << drop) - 1u); return __uint_as_float(u); }
__device__ __forceinline__ unsigned pkh8(float lo, float hi) { return (MK_LOWENT & 2) ? pkh(round8a(lo), round8a(hi)) : pkh(lo, hi); }
__device__ __forceinline__ float silu_fast(float x) { return x * __builtin_amdgcn_rcpf(1.f + __builtin_amdgcn_exp2f(-1.4426950408889634f * x)); }
__device__ __forceinline__ float gelu_fast(float x) {
    const float u2 = 1.5957691216057308f * (x + 0.044715f * x * x * x);
    return x * __builtin_amdgcn_rcpf(1.f + __builtin_amdgcn_exp2f(-1.4426950408889634f * u2));
}
__device__ __forceinline__ float rs16p(const GAS float* p) {
    float t[16];
#pragma unroll
    for (int k = 0; k < 16; ++k) t[k] = p[(size_t)k * (4 * 8192)];
    const float a = ((t[0] + t[1]) + (t[2] + t[3])) + ((t[4] + t[5]) + (t[6] + t[7])), b = ((t[8] + t[9]) + (t[10] + t[11])) + ((t[12] + t[13]) + (t[14] + t[15]));
    return rsqrtf((a + b) * (1.f / 1024.f) + 1e-6f);
}
__device__ __forceinline__ float rs16(const GAS float* p) {
    const f32x4 s0 = *(const GAS f32x4*)(p), s1 = *(const GAS f32x4*)(p + 4), s2 = *(const GAS f32x4*)(p + 8), s3 = *(const GAS f32x4*)(p + 12);
    const f32x4 st = (s0 + s1) + (s2 + s3);
    return rsqrtf(((st[0] + st[1]) + (st[2] + st[3])) * (1.f / D) + EPS);
}


__device__ __forceinline__ size_t blk_off(int row, int k, int nt) { return (((size_t)(row >> 8) * nt + (k >> 6)) * 256 + (row & 255)) * 64 + (k & 63); }

namespace pg8 {
constexpr int BM = 256, BK = 64, HALF = 128, HTB = HALF * BK * 2, STAGE_BYTES = 8 * HTB, NXCD = 8, WGM = 8;
__host__ __device__ __forceinline__ int lds_byte(int r, int c) { const int st = (r >> 4) * 2 + (c >> 5), rr = r & 15, cc = c & 31, ob = rr * 64 + cc * 2; return st * 1024 + (ob ^ (((ob >> 9) & 1) << 5)); }
__host__ __device__ __forceinline__ void stage_rc(int b, int& R, int& C) { const int st = b / 1024, sb = b % 1024, swz = sb ^ (((sb >> 9) & 1) << 5); R = (st >> 1) * 16 + swz / 64; C = (st & 1) * 32 + (swz % 64) / 2; }
struct Unit { int pm, pn; };
struct Gemm { const GAS h16* A; const GAS h16* Bt; int lda, N, K; unsigned stag = 0; };
struct StaticOrder {
    int nM, nN, nwg, G, c;
    __device__ __forceinline__ void init(int M_, int N, int G_, int c_) { nM = M_ / BM; nN = N / BM; nwg = nM * nN; G = G_; c = c_; }
    __device__ __forceinline__ bool next(int i, Unit& u) const {
        const long L = (long)i * G + c; if (L >= nwg) return false;
        int wgid = (int)L; { const int q = nwg / NXCD, r = nwg % NXCD, xcd = wgid % NXCD, off = wgid / NXCD; wgid = (xcd < r ? xcd * (q + 1) : r * (q + 1) + (xcd - r) * q) + off; }
        const int nig = WGM * nN, gid = wgid / nig, fm = gid * WGM, gsz = (nM - fm) < WGM ? (nM - fm) : WGM;
        u.pm = fm + ((wgid % nig) % gsz); u.pn = (wgid % nig) / gsz; return true;
    }
};
struct TableOrder {
    const LAS int* tab; int n;
    __device__ __forceinline__ bool next(int i, Unit& u) const { if (i >= n) return false; u.pm = tab[2 * i]; u.pn = tab[2 * i + 1]; return true; }
};
__device__ __forceinline__ TableOrder make_table(const StaticOrder& So, LAS int* tab) {
    if (threadIdx.x < 16) { Unit u; u.pm = -1; u.pn = 0; const bool ok = So.next((int)threadIdx.x, u); tab[2 * threadIdx.x] = ok ? u.pm : -1; tab[2 * threadIdx.x + 1] = u.pn; }
    __syncthreads();
    int n = 0;
    while (n < 16 && tab[2 * n] >= 0) ++n;
    TableOrder T; T.tab = tab; T.n = __builtin_amdgcn_readfirstlane(n); return T;
}
template <class Epi, bool ALIGN_EPI, int PROBE = 0, class Order = StaticOrder>
__device__ __forceinline__ void gemm_phase(LAS unsigned char* lds, const Gemm g, const Order& S, const Epi& E) {
    const int tid = threadIdx.x, wid = __builtin_amdgcn_readfirstlane(tid >> 6), lane = tid & 63, wr = wid >> 2, wc = wid & 3, fr = lane & 15, fq = lane >> 4;
    const int K = g.K, nt = K / BK;
    unsigned voffA[2], voffB[2];
    const bool ablk = (g.lda == 0);
#pragma unroll
    for (int i = 0; i < 2; ++i) { int R, C; stage_rc(tid * 16 + i * 8192, R, C); voffA[i] = (unsigned)(R * (ablk ? BK : g.lda) + C) * 2u; voffB[i] = (unsigned)(R * BK + C) * 2u; }
    const size_t kstepB = (size_t)BM * BK * 2, kstepA = ablk ? kstepB : (size_t)(BK * 2);
    const size_t hstepB = (size_t)HALF * BK * 2, hstepA = ablk ? hstepB : (size_t)HALF * g.lda * 2;
    const size_t tstepB = (size_t)nt * kstepB, tstepA = ablk ? tstepB : 2 * hstepA;
    const unsigned ldsw = (unsigned)wid * 1024u;
    const int aoff = lds_byte(wr * 64 + fr, fq * 8), boff = lds_byte(wc * 32 + fr, fq * 8);
#define PG8_SA(b, h) (((b) * 2 + (h)) * HTB)
#define PG8_SB(b, h) ((4 + (b) * 2 + (h)) * HTB)
#define PG8_STAGE(bufoff, gbase, voff) do { if (PROBE != 2) _Pragma("unroll") for (int _i = 0; _i < 2; ++_i) \
        __builtin_amdgcn_global_load_lds((const unsigned*)((const char*)(gbase) + (voff)[_i]), (LAS unsigned*)(lds + (bufoff) + ldsw + _i * 8192), 16, 0, 0); } while (0)
#define PG8_LDA(dst, b, h) do { _Pragma("unroll") for (int m = 0; m < 4; ++m) _Pragma("unroll") for (int k = 0; k < 2; ++k) dst[m][k] = *(const LAS h16x8*)(lds + PG8_SA(b, h) + aoff + m * 2048 + k * 1024); } while (0)
#define PG8_LDB(dst, b, h) do { _Pragma("unroll") for (int n = 0; n < 2; ++n) _Pragma("unroll") for (int k = 0; k < 2; ++k) dst[n][k] = *(const LAS h16x8*)(lds + PG8_SB(b, h) + boff + n * 2048 + k * 1024); } while (0)
#define PG8_MMA(ai, bj, At, Bt) do { if (PROBE == 1 && (bj) == 1) break; __builtin_amdgcn_s_setprio(1); _Pragma("unroll") for (int m = 0; m < 4; ++m) _Pragma("unroll") for (int n = 0; n < 2; ++n) _Pragma("unroll") for (int k = 0; k < 2; ++k) \
        acc[ai][bj][m][n] = __builtin_amdgcn_mfma_f32_16x16x32_f16(Bt[n][k], At[m][k], acc[ai][bj][m][n], 0, 0, 0); __builtin_amdgcn_s_setprio(0); } while (0)
#define PG8_WAIT_V(n) asm volatile("s_waitcnt vmcnt(" #n ")" ::: "memory")
#define PG8_WAIT_L(n) asm volatile("s_waitcnt lgkmcnt(" #n ")" ::: "memory")
#define PG8_BAR __builtin_amdgcn_s_barrier()
#define PG8_SCHED __builtin_amdgcn_sched_barrier(0)
    Unit cur, nxt; int ui = 0;
    if (!S.next(0, cur)) return;
    if (g.stag) { const unsigned st = (unsigned)(cur.pm & 7); if (st) { const unsigned long long t0 = __builtin_amdgcn_s_memrealtime(), dl = (unsigned long long)st * g.stag; while (__builtin_amdgcn_s_memrealtime() - t0 < dl) __builtin_amdgcn_s_sleep(4); } }
    f32x4 acc[2][2][4][2];
#pragma unroll
    for (int a = 0; a < 2; ++a)
#pragma unroll
        for (int b = 0; b < 2; ++b)
#pragma unroll
            for (int m = 0; m < 4; ++m)
#pragma unroll
                for (int n = 0; n < 2; ++n) acc[a][b][m][n] = (f32x4){0.f, 0.f, 0.f, 0.f};
    h16x8 At[4][2], B0[2][2], B1[2][2];
    const char* cA = (const char*)g.A + (size_t)cur.pm * tstepA; const char* cB = (const char*)g.Bt + (size_t)cur.pn * tstepB;
    PG8_STAGE(PG8_SB(0, 0), cB, voffB); PG8_STAGE(PG8_SB(0, 1), cB + hstepB, voffB); PG8_STAGE(PG8_SA(0, 0), cA, voffA); PG8_STAGE(PG8_SA(0, 1), cA + hstepA, voffA);
    if (wr == 1) PG8_BAR;
    PG8_WAIT_V(2); PG8_BAR;
    PG8_STAGE(PG8_SB(1, 0), cB + kstepB, voffB); PG8_STAGE(PG8_SA(1, 0), cA + kstepA, voffA); PG8_STAGE(PG8_SB(1, 1), cB + hstepB + kstepB, voffB);
    PG8_WAIT_V(6); PG8_BAR;
    for (;;) {
        const bool has_next = S.next(ui + 1, nxt);
        const char* nA = has_next ? (const char*)g.A + (size_t)nxt.pm * tstepA : cA; const char* nB = has_next ? (const char*)g.Bt + (size_t)nxt.pn * tstepB : cB;
        for (int t = 0; t < nt; t += 2) {
            const bool last = (t == nt - 2);
            const char* a1 = cA + (size_t)(t + 1) * kstepA;
            const char* a2 = last ? nA : cA + (size_t)(t + 2) * kstepA; const char* b2 = last ? nB : cB + (size_t)(t + 2) * kstepB;
            const char* a3 = a2 + kstepA; const char* b3 = b2 + kstepB;
            if constexpr (Epi::MID) { if (t == nt / 2) E.mid(acc, cur, ui, wr, wc, fr, fq); }
            PG8_LDB(B0, 0, 0); PG8_LDB(B1, 0, 1); PG8_SCHED; PG8_LDA(At, 0, 0); PG8_STAGE(PG8_SA(1, 1), a1 + hstepA, voffA);
            PG8_WAIT_V(8); PG8_WAIT_L(0); PG8_BAR; PG8_MMA(0, 0, At, B0); PG8_MMA(0, 1, At, B1); PG8_BAR; PG8_SCHED;
            PG8_LDA(At, 0, 1); PG8_STAGE(PG8_SB(0, 0), b2, voffB); PG8_STAGE(PG8_SB(0, 1), b2 + hstepB, voffB); PG8_STAGE(PG8_SA(0, 0), a2, voffA);
            PG8_WAIT_V(8); PG8_WAIT_L(0); PG8_BAR; PG8_MMA(1, 0, At, B0); PG8_MMA(1, 1, At, B1); PG8_BAR; PG8_SCHED;
            PG8_LDB(B0, 1, 0); PG8_LDB(B1, 1, 1); PG8_SCHED; PG8_LDA(At, 1, 0); PG8_STAGE(PG8_SA(0, 1), a2 + hstepA, voffA);
            PG8_WAIT_V(8); PG8_WAIT_L(0); PG8_BAR; PG8_MMA(0, 0, At, B0); PG8_MMA(0, 1, At, B1); PG8_BAR; PG8_SCHED;
            PG8_LDA(At, 1, 1); PG8_STAGE(PG8_SB(1, 0), b3, voffB); PG8_STAGE(PG8_SB(1, 1), b3 + hstepB, voffB); PG8_STAGE(PG8_SA(1, 0), a3, voffA);
            PG8_WAIT_V(8); PG8_WAIT_L(0); PG8_BAR; PG8_MMA(1, 0, At, B0); PG8_MMA(1, 1, At, B1); PG8_BAR; PG8_SCHED;
        }
        if constexpr (ALIGN_EPI) { if (wr == 0) PG8_BAR; }
        E(acc, cur, ui, wr, wc, fr, fq);
        if (!has_next) break;
#pragma unroll
        for (int a = 0; a < 2; ++a)
#pragma unroll
            for (int b = 0; b < 2; ++b)
#pragma unroll
                for (int m = 0; m < 4; ++m)
#pragma unroll
                    for (int n = 0; n < 2; ++n) acc[a][b][m][n] = (f32x4){0.f, 0.f, 0.f, 0.f};
        cur = nxt; cA = nA; cB = nB; ++ui;
        if constexpr (ALIGN_EPI) { if (wr == 1) PG8_BAR; }
    }
    PG8_WAIT_V(0);
    if constexpr (!ALIGN_EPI) { if (wr == 0) PG8_BAR; }
    PG8_BAR;
#undef PG8_SA
#undef PG8_SB
#undef PG8_STAGE
#undef PG8_LDA
#undef PG8_LDB
#undef PG8_MMA
#undef PG8_WAIT_V
#undef PG8_WAIT_L
#undef PG8_BAR
#undef PG8_SCHED
}
}

typedef const f32x4 (&AccRef)[2][2][4][2];
struct EpiSwiglu {
    static constexpr bool MID = false;
    GAS h16* act; const LAS float* rtab; const GAS float* bias;
    __device__ __forceinline__ void mid(f32x4 (&)[2][2][4][2], const pg8::Unit&, int, int, int, int, int) const {}
    __device__ __forceinline__ void operator()(AccRef acc, const pg8::Unit& u, int ui, int wr, int wc, int fr, int fq) const {
        const int b = u.pm >> 5, row0 = u.pm * 256 + wr * 64 + fr;
        const GAS float* bp = bias + b * NGU + u.pn * 256 + wc * 32 + 4 * fq;
        f32x4 bv[2][2];
#pragma unroll
        for (int bj = 0; bj < 2; ++bj)
#pragma unroll
            for (int n = 0; n < 2; ++n) bv[bj][n] = *(const GAS f32x4*)(bp + bj * 128 + n * 16);
        const LAS float* rt = rtab + ui * 256 + wr * 64 + fr;
        const int hid0 = u.pn * 128 + wc * 32 + fq * 8;
#pragma unroll
        for (int ai = 0; ai < 2; ++ai)
#pragma unroll
            for (int m = 0; m < 4; ++m) {
                const int ro = ai * 128 + m * 16; const float rs = rt[ro];
                u32x4 w;
#pragma unroll
                for (int n = 0; n < 2; ++n) {
                    const f32x4 gv = acc[ai][0][m][n] * rs + bv[0][n], uv = acc[ai][1][m][n] * rs + bv[1][n];
                    const float a0 = silu_fast(gv[0]) * uv[0], a1 = silu_fast(gv[1]) * uv[1], a2 = silu_fast(gv[2]) * uv[2], a3 = silu_fast(gv[3]) * uv[3];
                    w[2 * n] = pkh8(a0, a1); w[2 * n + 1] = pkh8(a2, a3);
                }
                st_stream<3>((GAS u32x4*)(act + blk_off(row0 + ro, hid0, DFF / 64)), w);
            }
    }
};
struct EpiNull {
    static constexpr bool MID = false;
    __device__ __forceinline__ void mid(f32x4 (&)[2][2][4][2], const pg8::Unit&, int, int, int, int, int) const {}
    __device__ __forceinline__ void operator()(AccRef acc, const pg8::Unit& u, int ui, int wr, int wc, int fr, int fq) const {
#pragma unroll
        for (int ai = 0; ai < 2; ++ai)
#pragma unroll
            for (int bj = 0; bj < 2; ++bj)
#pragma unroll
                for (int m = 0; m < 4; ++m)
#pragma unroll
                    for (int n = 0; n < 2; ++n) asm volatile("" :: "v"(acc[ai][bj][m][n]));
    }
};
template <bool RES_F32, bool TWOSCALE, bool WRITE_HG, int PVAR = 0> struct EpiResid {
    static constexpr bool MID = TWOSCALE;
    const GAS float* xres; GAS h16* H; GAS h16* HG; const GAS float* cs; const GAS float* gp; GAS float* ssq; const LAS float* sct; float cmul;
    __device__ __forceinline__ void mid(f32x4 (&acc)[2][2][4][2], const pg8::Unit& u, int ui, int wr, int wc, int fr, int fq) const {
        if constexpr (TWOSCALE) {
            const LAS float* t = sct + ui * 512 + wr * 64 + fr;
#pragma unroll
            for (int ai = 0; ai < 2; ++ai)
#pragma unroll
                for (int m = 0; m < 4; ++m) { const float f = t[ai * 128 + m * 16];
#pragma unroll
                    for (int bj = 0; bj < 2; ++bj)
#pragma unroll
                        for (int n = 0; n < 2; ++n) acc[ai][bj][m][n] *= f; }
        }
    }
    __device__ __forceinline__ void operator()(AccRef acc, const pg8::Unit& u, int ui, int wr, int wc, int fr, int fq) const {
        const int b = u.pm >> 5, row0 = u.pm * 256 + wr * 64 + fr, col0 = u.pn * 256 + wc * 32 + 8 * fq;
        f32x4 csv[2][2], gpv[2][2];
#pragma unroll
        for (int bj = 0; bj < 2; ++bj)
#pragma unroll
            for (int n = 0; n < 2; ++n) { csv[bj][n] = *(const GAS f32x4*)(cs + b * D + col0 + bj * 128 + 4 * n) * cmul; if constexpr (WRITE_HG) gpv[bj][n] = *(const GAS f32x4*)(gp + b * D + col0 + bj * 128 + 4 * n); }
        constexpr int MB_ = RES_F32 ? 2 : 4;
        float qs[8];
#pragma unroll
        for (int ai = 0; ai < 2; ++ai)
#pragma unroll
        for (int m0 = 0; m0 < 4; m0 += MB_) {
            f32x4 rf[4][2][2]; h16x8 rh[4][2];
#pragma unroll
            for (int m = m0; m < m0 + MB_; ++m)
#pragma unroll
                for (int bj = 0; bj < 2; ++bj) { const size_t off = (size_t)(row0 + ai * 128 + m * 16) * D + col0 + bj * 128;
                    if constexpr (PVAR == 2 || PVAR == 6 || PVAR == 7) { rf[m][bj][0] = (f32x4){0.f, 0.f, 0.f, 0.f}; rf[m][bj][1] = rf[m][bj][0]; rh[m][bj] = (h16x8){0, 0, 0, 0, 0, 0, 0, 0}; }
                    else if constexpr (PVAR == 3) { const h16x8 t = *(const GAS h16x8*)(HG + blk_off(row0 + ai * 128 + m * 16, col0 + bj * 128, D / 64)); rf[m][bj][0] = (f32x4){(float)t[0], (float)t[1], (float)t[2], (float)t[3]}; rf[m][bj][1] = (f32x4){(float)t[4], (float)t[5], (float)t[6], (float)t[7]}; }
                    else if constexpr (RES_F32) { rf[m][bj][0] = *(const GAS f32x4*)(xres + off); rf[m][bj][1] = *(const GAS f32x4*)(xres + off + 4); }
                    else rh[m][bj] = *(const GAS h16x8*)(H + off); }
            asm volatile("" ::: "memory");
#pragma unroll
            for (int m = m0; m < m0 + MB_; ++m) {
                const int row = row0 + ai * 128 + m * 16; const size_t off = (size_t)row * D + col0;
                float rsc = 1.f; if constexpr (TWOSCALE) rsc = sct[ui * 512 + 256 + wr * 64 + fr + ai * 128 + m * 16];
                float q = 0.f;
#pragma unroll
                for (int bj = 0; bj < 2; ++bj) {
                    f32x4 r0, r1;
                    if constexpr (RES_F32) { r0 = rf[m][bj][0]; r1 = rf[m][bj][1]; }
                    else { const h16x8 hv = rh[m][bj]; r0 = (f32x4){(float)hv[0], (float)hv[1], (float)hv[2], (float)hv[3]}; r1 = (f32x4){(float)hv[4], (float)hv[5], (float)hv[6], (float)hv[7]}; }
                    const f32x4 v0 = r0 + csv[bj][0] * (acc[ai][bj][m][0] * rsc), v1 = r1 + csv[bj][1] * (acc[ai][bj][m][1] * rsc);
                    q += ((v0[0] * v0[0] + v0[1] * v0[1]) + (v0[2] * v0[2] + v0[3] * v0[3])) + ((v1[0] * v1[0] + v1[1] * v1[1]) + (v1[2] * v1[2] + v1[3] * v1[3]));
                    u32x4 w; w[0] = pkh(v0[0], v0[1]); w[1] = pkh(v0[2], v0[3]); w[2] = pkh(v1[0], v1[1]); w[3] = pkh(v1[2], v1[3]);
                    const int colp = u.pn * 256 + wc * 64 + 16 * fq + 8 * bj;
                    if constexpr (PVAR == 1) asm volatile("" :: "v"(w)); else if constexpr (PVAR == 4) *(GAS u32x4*)(H + blk_off(row, col0 + bj * 128, D / 64)) = w;
                    else if constexpr (PVAR == 5) *(GAS u32x4*)(H + (size_t)row * D + colp) = w; else if constexpr (PVAR == 7) __builtin_nontemporal_store(w, (GAS u32x4*)(H + off + bj * 128)); else st_stream<1>((GAS u32x4*)(H + off + bj * 128), w);
                    if constexpr (WRITE_HG) { const f32x4 g0 = v0 * gpv[bj][0], g1 = v1 * gpv[bj][1];
                        u32x4 wg;
                        if constexpr (TWOSCALE) { wg[0] = pkh8(g0[0], g0[1]); wg[1] = pkh8(g0[2], g0[3]); wg[2] = pkh8(g1[0], g1[1]); wg[3] = pkh8(g1[2], g1[3]); }
                        else { wg[0] = pkh(g0[0], g0[1]); wg[1] = pkh(g0[2], g0[3]); wg[2] = pkh(g1[0], g1[1]); wg[3] = pkh(g1[2], g1[3]); }
                        if constexpr (PVAR == 1 || PVAR == 6) asm volatile("" :: "v"(wg)); else if constexpr (PVAR == 7) __builtin_nontemporal_store(wg, (GAS u32x4*)(HG + blk_off(row, col0 + bj * 128, D / 64))); else if constexpr (PVAR == 5) *(GAS u32x4*)(HG + blk_off(row, colp, D / 64)) = wg; else st_stream<2>((GAS u32x4*)(HG + blk_off(row, col0 + bj * 128, D / 64)), wg); }
                }
                q += __shfl_xor(q, 16); q += __shfl_xor(q, 32);
                qs[ai * 4 + m] = q;
            }
        }
        if constexpr (PVAR != 1) {
            const float qa = fq == 0 ? qs[0] : fq == 1 ? qs[2] : fq == 2 ? qs[4] : qs[6], qb = fq == 0 ? qs[1] : fq == 1 ? qs[3] : fq == 2 ? qs[5] : qs[7];
            GAS float* sp = ssq + (size_t)(u.pn * 4 + wc) * M + row0 + (fq >> 1) * 128 + (fq & 1) * 32;
            sp[0] = qa; sp[16] = qb;
        }
    }
};
constexpr int CW_PAN = 16384;
struct EpiFinal {
    static constexpr bool MID = false;
    const GAS h16* H; const GAS float* cs; const GAS float* gfin; GAS float* out; unsigned* xs; unsigned* cnt; unsigned* tmo; LAS float* P; LAS float* Sx; float cmul;
    __device__ __forceinline__ void mid(f32x4 (&)[2][2][4][2], const pg8::Unit&, int, int, int, int, int) const {}
    __device__ __forceinline__ void operator()(f32x4 (&acc)[2][2][4][2], const pg8::Unit& u, int ui, int wr, int wc, int fr, int fq) const {
        const int b = u.pm >> 5, row0 = u.pm * 256 + wr * 64 + fr, col0 = u.pn * 256 + wc * 32 + 8 * fq;
        const int tid = threadIdx.x, lane = tid & 63, wid = __builtin_amdgcn_readfirstlane(tid >> 6);
        f32x4 csv[2][2];
#pragma unroll
        for (int bj = 0; bj < 2; ++bj)
#pragma unroll
            for (int n = 0; n < 2; ++n) csv[bj][n] = *(const GAS f32x4*)(cs + b * D + col0 + bj * 128 + 4 * n) * cmul;
#pragma unroll
        for (int ai = 0; ai < 2; ++ai) {
            h16x8 rh[4][2];
#pragma unroll
            for (int m = 0; m < 4; ++m)
#pragma unroll
                for (int bj = 0; bj < 2; ++bj) rh[m][bj] = *(const GAS h16x8*)(H + (size_t)(row0 + ai * 128 + m * 16) * D + col0 + bj * 128);
#pragma unroll
            for (int m = 0; m < 4; ++m) {
                float q = 0.f;
#pragma unroll
                for (int bj = 0; bj < 2; ++bj) { const h16x8 hv = rh[m][bj];
                    const f32x4 v0 = (f32x4){(float)hv[0], (float)hv[1], (float)hv[2], (float)hv[3]} + csv[bj][0] * acc[ai][bj][m][0], v1 = (f32x4){(float)hv[4], (float)hv[5], (float)hv[6], (float)hv[7]} + csv[bj][1] * acc[ai][bj][m][1];
                    acc[ai][bj][m][0] = v0; acc[ai][bj][m][1] = v1;
                    q += ((v0[0] * v0[0] + v0[1] * v0[1]) + (v0[2] * v0[2] + v0[3] * v0[3])) + ((v1[0] * v1[0] + v1[1] * v1[1]) + (v1[2] * v1[2] + v1[3] * v1[3])); }
                q += __shfl_xor(q, 16); q += __shfl_xor(q, 32);
                if (fq == 0) P[(ai * 128 + wr * 64 + m * 16 + fr) * 4 + wc] = q;
            }
        }
        asm volatile("s_waitcnt lgkmcnt(0)" ::: "memory"); __builtin_amdgcn_s_barrier(); asm volatile("" ::: "memory");
        if (tid < 256) {
            const f32x4 p4 = *(const LAS f32x4*)(P + tid * 4);
            __hip_atomic_store(xs + ((size_t)(u.pm * 256 + tid) * 4 + u.pn), __float_as_uint((p4[0] + p4[1]) + (p4[2] + p4[3])), __ATOMIC_RELAXED, __HIP_MEMORY_SCOPE_AGENT);
        }
        asm volatile("s_waitcnt vmcnt(0)" ::: "memory");
        if (wid < 4 && lane == 0) __hip_atomic_fetch_add(cnt + 64 * u.pm, 1u, __ATOMIC_RELAXED, __HIP_MEMORY_SCOPE_AGENT);
        if (wid == 0) {
            unsigned sp = 0u;
            while ((unsigned)__builtin_amdgcn_readfirstlane(__hip_atomic_load(cnt + 64 * u.pm, __ATOMIC_RELAXED, __HIP_MEMORY_SCOPE_AGENT)) < 16u) {
                __builtin_amdgcn_s_sleep(2);
                if (++sp > (1u << 16)) { if (lane == 0) __hip_atomic_store(tmo, 1u, __ATOMIC_RELAXED, __HIP_MEMORY_SCOPE_AGENT); break; }
            }
            __builtin_amdgcn_fence(__ATOMIC_ACQUIRE, "agent");
        }
        asm volatile("s_waitcnt vmcnt(0) lgkmcnt(0)" ::: "memory"); __builtin_amdgcn_s_barrier(); asm volatile("" ::: "memory");
        if (tid < 256) {
            const unsigned* sl = xs + (size_t)(u.pm * 256 + tid) * 4;
            const float s0 = __uint_as_float(__hip_atomic_load(sl + 0, __ATOMIC_RELAXED, __HIP_MEMORY_SCOPE_AGENT)), s1 = __uint_as_float(__hip_atomic_load(sl + 1, __ATOMIC_RELAXED, __HIP_MEMORY_SCOPE_AGENT)),
                        s2 = __uint_as_float(__hip_atomic_load(sl + 2, __ATOMIC_RELAXED, __HIP_MEMORY_SCOPE_AGENT)), s3 = __uint_as_float(__hip_atomic_load(sl + 3, __ATOMIC_RELAXED, __HIP_MEMORY_SCOPE_AGENT));
            Sx[tid] = rsqrtf(((s0 + s1) + (s2 + s3)) * (1.f / D) + EPS);
        }
        asm volatile("s_waitcnt vmcnt(0) lgkmcnt(0)" ::: "memory"); __builtin_amdgcn_s_barrier(); asm volatile("" ::: "memory");
        f32x4 gv[2][2];
#pragma unroll
        for (int bj = 0; bj < 2; ++bj)
#pragma unroll
            for (int n = 0; n < 2; ++n) gv[bj][n] = *(const GAS f32x4*)(gfin + col0 + bj * 128 + 4 * n);
#pragma unroll
        for (int ai = 0; ai < 2; ++ai)
#pragma unroll
            for (int m = 0; m < 4; ++m) { const int rl = ai * 128 + wr * 64 + m * 16 + fr; const float rs = Sx[rl]; GAS float* op = out + (size_t)(u.pm * 256 + rl) * D + col0;
#pragma unroll
                for (int bj = 0; bj < 2; ++bj) { st_stream<0>((GAS f32x4*)(op + bj * 128), acc[ai][bj][m][0] * rs * gv[bj][0]); st_stream<0>((GAS f32x4*)(op + bj * 128 + 4), acc[ai][bj][m][1] * rs * gv[bj][1]); } }
        asm volatile("s_waitcnt lgkmcnt(0)" ::: "memory"); __builtin_amdgcn_s_barrier(); asm volatile("" ::: "memory");
    }
};
struct EpiInproj {
    static constexpr bool MID = false;
    GAS h16* proj; const LAS float* rtab; const GAS float* bias; const GAS float* rope; GAS float* kmp;
    __device__ __forceinline__ void mid(f32x4 (&)[2][2][4][2], const pg8::Unit&, int, int, int, int, int) const {}
    __device__ __forceinline__ void operator()(AccRef acc, const pg8::Unit& u, int ui, int wr, int wc, int fr, int fq) const {
        const int b = u.pm >> 5, row0 = u.pm * 256 + wr * 64 + fr, region = u.pn >> 1;
        const GAS float* bp = bias + b * INW + u.pn * 256 + wc * 32 + 4 * fq;
        f32x4 bv[2][2];
#pragma unroll
        for (int bj = 0; bj < 2; ++bj)
#pragma unroll
            for (int n = 0; n < 2; ++n) bv[bj][n] = *(const GAS f32x4*)(bp + bj * 128 + n * 16);
        const bool is_rope = (region == 0) || (region == 2);
        f32x4 csum[2][2];
#pragma unroll
        for (int bj = 0; bj < 2; ++bj)
#pragma unroll
            for (int n = 0; n < 2; ++n) csum[bj][n] = (f32x4){0.f, 0.f, 0.f, 0.f};
        const LAS float* rt = rtab + ui * 256 + wr * 64 + fr;
#pragma unroll
        for (int ai = 0; ai < 2; ++ai)
#pragma unroll
        for (int m0 = 0; m0 < 4; m0 += 2) {
            f32x4 rcs[4][2], rsn[4][2];
            if (is_rope) {
#pragma unroll
                for (int m = m0; m < m0 + 2; ++m) { const GAS float* rp = rope + (size_t)((row0 + ai * 128 + m * 16) & (S - 1)) * 64 + 4 * fq;
#pragma unroll
                    for (int n = 0; n < 2; ++n) { rcs[m][n] = *(const GAS f32x4*)(rp + 16 * n); rsn[m][n] = *(const GAS f32x4*)(rp + 32 + 16 * n); } }
            }
            asm volatile("" ::: "memory");
#pragma unroll
            for (int m = m0; m < m0 + 2; ++m) {
                const int row = row0 + ai * 128 + m * 16;
                const float rs = rt[ai * 128 + m * 16];
                f32x4 v[2][2];
#pragma unroll
                for (int bj = 0; bj < 2; ++bj)
#pragma unroll
                    for (int n = 0; n < 2; ++n) v[bj][n] = acc[ai][bj][m][n] * rs + bv[bj][n];
                GAS h16* prow = proj + (size_t)row * INW + region * 512 + (u.pn & 1) * 256;
                if (is_rope) {
                    const float qs = (region == 0) ? C2 : 1.f;
#pragma unroll
                    for (int n = 0; n < 2; ++n) {
                        const f32x4 cs4 = rcs[m][n] * qs, sn4 = rsn[m][n] * qs;
                        const f32x4 x1 = v[0][n], x2 = v[1][n];
                        v[0][n] = x1 * cs4 - x2 * sn4; v[1][n] = x2 * cs4 + x1 * sn4;
                    }
                    GAS h16* hp = prow + wc * 64 + 16 * fq;
#pragma unroll
                    for (int bj = 0; bj < 2; ++bj) { u32x4 w; w[0] = pkh(v[bj][0][0], v[bj][0][1]); w[1] = pkh(v[bj][0][2], v[bj][0][3]); w[2] = pkh(v[bj][1][0], v[bj][1][1]); w[3] = pkh(v[bj][1][2], v[bj][1][3]);
                        st_stream<4>((GAS u32x4*)(hp + 8 * bj), w); }
                    if (region == 2) {
#pragma unroll
                        for (int bj = 0; bj < 2; ++bj)
#pragma unroll
                            for (int n = 0; n < 2; ++n) csum[bj][n] += v[bj][n];
                    }
                } else {
                    if (region == 1 || region == 4) {
#pragma unroll
                        for (int bj = 0; bj < 2; ++bj)
#pragma unroll
                            for (int n = 0; n < 2; ++n)
#pragma unroll
                                for (int j = 0; j < 4; ++j) v[bj][n][j] = gelu_fast(v[bj][n][j]);
                    }
                    GAS h16* hp = prow + wc * 32 + 8 * fq;
#pragma unroll
                    for (int bj = 0; bj < 2; ++bj) { u32x4 w; w[0] = pkh(v[bj][0][0], v[bj][0][1]); w[1] = pkh(v[bj][0][2], v[bj][0][3]); w[2] = pkh(v[bj][1][0], v[bj][1][1]); w[3] = pkh(v[bj][1][2], v[bj][1][3]);
                        st_stream<4>((GAS u32x4*)(hp + 128 * bj), w); }
                }
            }
        }
        if (region == 2) {
#pragma unroll
            for (int bj = 0; bj < 2; ++bj)
#pragma unroll
                for (int n = 0; n < 2; ++n)
#pragma unroll
                    for (int j = 0; j < 4; ++j) { float t = csum[bj][n][j]; t += __shfl_xor(t, 1); t += __shfl_xor(t, 2); t += __shfl_xor(t, 4); t += __shfl_xor(t, 8); csum[bj][n][j] = t; }
            if (fr == 0) {
                GAS float* kp = kmp + ((size_t)((b * NBLK + (u.pm & 31)) * 2 + wr)) * 512 + ((u.pn & 1) * 4 + wc) * 64 + 16 * fq;
#pragma unroll
                for (int bj = 0; bj < 2; ++bj)
#pragma unroll
                    for (int n = 0; n < 2; ++n) *(GAS f32x4*)(kp + 8 * bj + 4 * n) = csum[bj][n];
            }
        }
    }
};

#define XB_TMO      128
#define XB_XCNT(j)  (256  + 64 * (j))
#define XB_XSUB(j)  (1280 + 64 * (j))
#define XB_XGEN(j)  (2304 + 64 * (j))
#define XB_TOP      3328
#define XB_TOPGEN   3392
#define XCD_BAR_WORDS 3456
#define XB_SPIN_CAP (1u << 18)
__device__ __forceinline__ unsigned xb_ld(unsigned* p)              { return __hip_atomic_load(p, __ATOMIC_RELAXED, __HIP_MEMORY_SCOPE_AGENT); }
__device__ __forceinline__ unsigned xb_add(unsigned* p, unsigned v) { return __hip_atomic_fetch_add(p, v, __ATOMIC_RELAXED, __HIP_MEMORY_SCOPE_AGENT); }
__device__ __forceinline__ unsigned xb_xcc_id() { return (unsigned)__builtin_amdgcn_s_getreg((3 << 11) | 20) & 0xFu; }
#define XB_SPIN(cond, bar) do { unsigned _sp = 0; while (cond) { __builtin_amdgcn_s_sleep(1); \
    if ((++_sp & 255u) == 0u) { if (xb_ld(&(bar)[XB_TMO])) break; if (_sp > XB_SPIN_CAP) { atomicAdd(&(bar)[XB_TMO], 1u); break; } } } } while (0)
struct XcdBarrier { unsigned* bar; unsigned x; volatile LAS unsigned* st; };
__device__ __forceinline__ XcdBarrier xcd_barrier_post(unsigned* bar, volatile LAS unsigned* st) {
    XcdBarrier b; b.bar = bar; b.x = xb_xcc_id(); b.st = st;
    if (threadIdx.x == 0) (void)xb_add(&bar[XB_XCNT(b.x)], 1u);
    return b;
}
__device__ __forceinline__ void xcd_barrier_complete(unsigned* bar, unsigned x, unsigned& nloc, unsigned& nx) {
    const unsigned G = gridDim.x * gridDim.y * gridDim.z;
    unsigned sum, cnt, mine, sp = 0u;
    for (;;) {
        sum = 0u; cnt = 0u; mine = 0u;
#pragma unroll
        for (unsigned j = 0; j < 16; ++j) { const unsigned c = xb_ld(&bar[XB_XCNT(j)]); sum += c; cnt += (c > 0u) ? 1u : 0u; mine = (j == x) ? c : mine; }
        if (sum == G) break;
        __builtin_amdgcn_s_sleep(1);
        if ((++sp & 255u) == 0u) { if (xb_ld(&bar[XB_TMO])) break; if (sp > XB_SPIN_CAP) { atomicAdd(&bar[XB_TMO], 1u); break; } }
    }
    nloc = mine > 0u ? mine : 1u; nx = cnt > 0u ? cnt : 1u;
}
__device__ __forceinline__ void xcd_barrier(const XcdBarrier& b) {
    asm volatile("s_waitcnt vmcnt(0)" ::: "memory");
    __syncthreads();
    if (threadIdx.x == 0) {
        unsigned* bar = b.bar;
        __builtin_amdgcn_s_waitcnt(0);
        unsigned nloc = b.st[0], nx = b.st[1];
        if (nloc == 0u) { xcd_barrier_complete(bar, b.x, nloc, nx); b.st[0] = nloc; b.st[1] = nx; }
        const unsigned old = xb_add(&bar[XB_XSUB(b.x)], 1u);
        const unsigned gen = old / nloc;
        if (old + 1u == (gen + 1u) * nloc) {
            __builtin_amdgcn_fence(__ATOMIC_RELEASE, "agent");
            asm volatile("s_waitcnt vmcnt(0)" ::: "memory");
            const unsigned og = xb_add(&bar[XB_TOP], 1u);
            const unsigned tg = og / nx;
            if (og + 1u == (tg + 1u) * nx) xb_add(&bar[XB_TOPGEN], 1u);
            else XB_SPIN(xb_ld(&bar[XB_TOPGEN]) == tg, bar);
            __builtin_amdgcn_fence(__ATOMIC_ACQUIRE, "agent");
            xb_add(&bar[XB_XGEN(b.x)], 1u);
            asm volatile("s_waitcnt vmcnt(0)" ::: "memory");
        } else {
            XB_SPIN(xb_ld(&bar[XB_XGEN(b.x)]) == gen, bar);
            __builtin_amdgcn_fence(__ATOMIC_ACQUIRE, "agent");
            asm volatile("s_waitcnt vmcnt(0)" ::: "memory");
        }
    }
    __syncthreads();
}

#define GIN(a_, i_) ((const GAS float*)(a_).in[i_])
struct Args { const float* in[20]; float* out; unsigned char* ws; int ph_lo, ph_hi; int shadow, pad; };
struct Frame {
    LAS unsigned char* lds; volatile LAS unsigned* MISC; unsigned* ctl;
    int tid, lane, wave, vcu, G;
    unsigned char* ws; GAS float* out;
};

__device__ __forceinline__ float round8(float x) { return round8a(x); }
__device__ __forceinline__ int p8(int l) { return (l & ~31) + 16 * ((l >> 2) & 1) + 4 * ((l >> 3) & 3) + (l & 3); }
__device__ __forceinline__ int phys_gu(int L) { const int isu = L >= DFF, hid = isu ? L - DFF : L, pn = hid >> 7, hh = hid & 127; return 256 * pn + 128 * isu + p8(hh); }
__device__ __forceinline__ int phys_in(int L) {
    const int reg = L >> 9, l = L & 511;
    const int preg = reg == 0 ? 0 : reg == 1 ? 2 : reg == 2 ? 3 : reg == 3 ? 1 : 4;
    if (reg <= 1) { const int head = l >> 6, d = l & 63, bj = d >> 5, i = d & 31; return 512 * preg + 256 * (head >> 2) + 128 * bj + 32 * (head & 3) + i; }
    return 512 * preg + p8(l);
}
enum PhysKind { PH_GU = 0, PH_P8 = 1, PH_IN = 2 };
template <int KIND> __device__ __forceinline__ int physmap(int L) { return KIND == PH_GU ? phys_gu(L) : KIND == PH_P8 ? p8(L) : phys_in(L); }

template <int KIND, bool LOWENT = false> __device__ __forceinline__ void p0_transpose_item(const GAS float* W, int K, int N, GAS h16* WT, const GAS float* kscale, LAS float* scr, int item, int lane) {
    const int nblk = N / 32, kb = item / nblk, nb = item % nblk, k0 = 64 * kb, n0 = 32 * nb;
    float wv[32];
#pragma unroll
    for (int i = 0; i < 32; ++i) { const int kk = 2 * i + (lane >> 5); wv[i] = W[(size_t)(k0 + kk) * N + n0 + (lane & 31)]; }
    if (kscale) {
#pragma unroll
        for (int i = 0; i < 32; ++i) wv[i] *= kscale[k0 + 2 * i + (lane >> 5)]; }
#pragma unroll
    for (int i = 0; i < 32; ++i) scr[(2 * i + (lane >> 5)) * 33 + (lane & 31)] = (LOWENT && MK_LOWENT) ? round8(wv[i]) : wv[i];
    LDS_WAIT(); asm volatile("" ::: "memory");
    const int c = lane & 7;
#pragma unroll
    for (int j = 0; j < 4; ++j) { const int n = (lane >> 3) + 8 * j; const LAS float* s = scr + (8 * c) * 33 + n;
        u32x4 o; o.x = pkh(s[0 * 33], s[1 * 33]); o.y = pkh(s[2 * 33], s[3 * 33]); o.z = pkh(s[4 * 33], s[5 * 33]); o.w = pkh(s[6 * 33], s[7 * 33]);
        *(GAS u32x4*)(WT + blk_off(physmap<KIND>(n0 + n), k0 + 8 * c, K / 64)) = o; }
    LDS_WAIT(); asm volatile("" ::: "memory");
}

__device__ __forceinline__ void p0_prologue(const Frame& F0, const Args& a) {
    Frame F = F0; F.tid = threadIdx.x; F.lane = F.tid & 63; F.wave = __builtin_amdgcn_readfirstlane(F.tid >> 6);
    const GAS float* c = GIN(a, 1); const GAS float* w_ada = GIN(a, 2);
    {
        LAS float* red = (LAS float*)F.lds;
        for (int item = F.vcu; item < 72 * 4; item += F.G) {
            const int cg = item % 72, kq = item / 72, hlf = F.lane >> 5, col = cg * 128 + (F.lane & 31) * 4;
            f32x4 acc[4] = {{0.f, 0.f, 0.f, 0.f}, {0.f, 0.f, 0.f, 0.f}, {0.f, 0.f, 0.f, 0.f}, {0.f, 0.f, 0.f, 0.f}};
            const int kbase = kq * 256 + F.wave * 32 + hlf;
#pragma unroll
            for (int i = 0; i < 16; ++i) { const int k = kbase + 2 * i; const f32x4 w4 = *(const GAS f32x4*)(w_ada + (size_t)k * (NMOD * D) + col);
#pragma unroll
                for (int b = 0; b < 4; ++b) { const float cv = c[b * D + k]; const float sv = cv / (1.f + __expf(-cv)); acc[b] += w4 * sv; } }
#pragma unroll
            for (int b = 0; b < 4; ++b)
#pragma unroll
                for (int j = 0; j < 4; ++j) acc[b][j] += __shfl_xor(acc[b][j], 32);
            if (hlf == 0) {
#pragma unroll
                for (int b = 0; b < 4; ++b) *(LAS f32x4*)(red + (F.wave * 4 + b) * 128 + (F.lane & 31) * 4) = acc[b];
            }
            __syncthreads();
            { const int b = F.tid >> 7, cc = F.tid & 127; float s = 0.f;
#pragma unroll
              for (int w = 0; w < 8; ++w) s += red[(w * 4 + b) * 128 + cc];
              ((GAS float*)(F.ws + WS_MODP))[(size_t)(kq * 4 + b) * (NMOD * D) + cg * 128 + cc] = s; }
            __syncthreads();
        }
    }
    LAS float* scr = (LAS float*)(F.lds + F.wave * 16384);
    const int gw = F.vcu * NWAVES + F.wave, NGW = F.G * NWAVES;
    constexpr int I_GU = (D / 64) * (NGU / 32), I_DN = (DFF / 64) * (D / 32), I_IN = (D / 64) * (INW / 32), I_OUT = (D / 64) * (D / 32);
    constexpr int NITEMS = 2 * I_GU + 2 * I_DN + I_IN + I_OUT;
    for (int it = gw; it < NITEMS; it += NGW) {
        int r = it;
        if (r < I_GU) { p0_transpose_item<PH_GU, true>(GIN(a, 5), D, NGU, (GAS h16*)(F.ws + WS_WGU1), nullptr, scr, r, F.lane); continue; } r -= I_GU;
        if (r < I_GU) { p0_transpose_item<PH_GU, true>(GIN(a, 17), D, NGU, (GAS h16*)(F.ws + WS_WGU2), nullptr, scr, r, F.lane); continue; } r -= I_GU;
        if (r < I_DN) { p0_transpose_item<PH_P8, true>(GIN(a, 6), DFF, D, (GAS h16*)(F.ws + WS_WD1), nullptr, scr, r, F.lane); continue; } r -= I_DN;
        if (r < I_DN) { p0_transpose_item<PH_P8, true>(GIN(a, 18), DFF, D, (GAS h16*)(F.ws + WS_WD2), nullptr, scr, r, F.lane); continue; } r -= I_DN;
        if (r < I_IN) { p0_transpose_item<PH_IN>(GIN(a, 8), D, INW, (GAS h16*)(F.ws + WS_WIN), nullptr, scr, r, F.lane); continue; } r -= I_IN;
        {
            const int kb = r / (D / 32); const GAS float* ks = (kb < 8) ? GIN(a, 13) : (GIN(a, 14) - 512);
            p0_transpose_item<PH_P8>(GIN(a, 15), D, D, (GAS h16*)(F.ws + WS_WOUT), ks, scr, r, F.lane); }
    }
    for (int pos = gw; pos < S; pos += NGW) {
        const int i = F.lane & 31;
        const float inv = (float)exp(-(double)i / 32.0 * 9.210340371976184);
        const float ang = (float)pos * inv;
        const double da = (double)ang;
        ((GAS float*)(F.ws + WS_ROPE))[(size_t)pos * 64 + F.lane] = (F.lane < 32) ? (float)cos(da) : (float)sin(da);
    }
    for (int e = gw * 64 + F.lane; e < NH * GC * GC; e += NGW * 64) { const int t = (e >> 7) & 127, s = e & 127; ((GAS h16*)(F.ws + WS_WS16))[e] = (s <= t) ? (h16)GIN(a, 11)[e] : (h16)0.f; }
}

__device__ __forceinline__ void p1_prep(const Frame& F0, const Args& a) {
    Frame F = F0; F.tid = threadIdx.x; F.lane = F.tid & 63; F.wave = __builtin_amdgcn_readfirstlane(F.tid >> 6);
    LAS float* modl = (LAS float*)F.lds;
    const GAS float* modp = (const GAS float*)(F.ws + WS_MODP); const GAS float* b_ada = GIN(a, 3);
    const size_t st = (size_t)4 * NMOD * D;
    for (int e = F.tid; e < 4 * 6 * D; e += NWAVES * 64) {
        const int b = e / (6 * D), sl = (e / D) % 6, k = e % D; const int mi = (sl < 3) ? 3 * sl : 3 * (sl - 3) + 1;
        const size_t o = (size_t)b * (NMOD * D) + mi * D + k;
        modl[e] = ((modp[o] + modp[o + st]) + (modp[o + 2 * st] + modp[o + 3 * st])) + b_ada[mi * D + k];
    }
    __syncthreads();
    if (F.vcu == 0) {
        GAS float* GT = (GAS float*)(F.ws + WS_GT); GAS float* GP = (GAS float*)(F.ws + WS_GP);
        for (int e = F.tid; e < 3 * 4 * D; e += NWAVES * 64) {
            const int j = e / (4 * D), b = (e / D) % 4, k = e % D; const int mi = 3 * j + 2;
            const size_t o = (size_t)b * (NMOD * D) + mi * D + k;
            GT[e] = ((modp[o] + modp[o + st]) + (modp[o + 2 * st] + modp[o + 3 * st])) + b_ada[mi * D + k];
            const GAS float* g = j == 0 ? GIN(a, 4) : j == 1 ? GIN(a, 7) : GIN(a, 16);
            GP[e] = g[k] * (1.f + modl[(b * 6 + 3 + j) * D + k]);
        }
    }
    const GAS float* x = GIN(a, 0); const GAS float* g1 = GIN(a, 4);
    GAS h16* XG = (GAS h16*)(F.ws + WS_HG); GAS float* R1 = (GAS float*)(F.ws + WS_R1);
    for (int chunk = F.vcu; chunk < M / 128; chunk += F.G) {
        const int b = chunk / (S / 128);
        f32x4 scl[2][2];
#pragma unroll
        for (int j = 0; j < 2; ++j)
#pragma unroll
            for (int h = 0; h < 2; ++h) { const int k = 8 * F.lane + 512 * j + 4 * h; const f32x4 gg = *(const GAS f32x4*)(g1 + k); const LAS float* sc = modl + (b * 6 + 3) * D + k;
                scl[j][h] = gg * ((f32x4){1.f + sc[0], 1.f + sc[1], 1.f + sc[2], 1.f + sc[3]}); }
        for (int rb = 0; rb < 16; rb += 4) {
            f32x4 v[4][2][2]; float q[4];
#pragma unroll
            for (int r4 = 0; r4 < 4; ++r4) { const GAS float* xr = x + (size_t)(chunk * 128 + F.wave * 16 + rb + r4) * D + 8 * F.lane;
#pragma unroll
                for (int j = 0; j < 2; ++j) { v[r4][j][0] = *(const GAS f32x4*)(xr + 512 * j); v[r4][j][1] = *(const GAS f32x4*)(xr + 512 * j + 4); } }
            asm volatile("" ::: "memory");
#pragma unroll
            for (int r4 = 0; r4 < 4; ++r4) { float t = 0.f;
#pragma unroll
                for (int j = 0; j < 2; ++j)
#pragma unroll
                    for (int h = 0; h < 2; ++h) t += (v[r4][j][h][0] * v[r4][j][h][0] + v[r4][j][h][1] * v[r4][j][h][1]) + (v[r4][j][h][2] * v[r4][j][h][2] + v[r4][j][h][3] * v[r4][j][h][3]);
                q[r4] = t; }
#pragma unroll
            for (int o = 1; o < 64; o <<= 1)
#pragma unroll
                for (int r4 = 0; r4 < 4; ++r4) q[r4] += __shfl_xor(q[r4], o);
#pragma unroll
            for (int r4 = 0; r4 < 4; ++r4) {
                const int row = chunk * 128 + F.wave * 16 + rb + r4;
                if (F.lane == 0) R1[row] = rsqrtf(q[r4] * (1.f / D) + EPS);
#pragma unroll
                for (int j = 0; j < 2; ++j) { const int k = 8 * F.lane + 512 * j; u32x4 w;
#pragma unroll
                    for (int h = 0; h < 2; ++h) { const f32x4 o = v[r4][j][h] * scl[j][h]; w[2 * h] = pkh8(o[0], o[1]); w[2 * h + 1] = pkh8(o[2], o[3]); }
                    *(GAS u32x4*)(XG + blk_off(row, k, D / 64)) = w; }
            }
        }
    }
    const int gw = F.vcu * NWAVES + F.wave, NGW = F.G * NWAVES;
    for (int it = gw; it < NGU + INW + NGU; it += NGW) {
        int n = it, j; const GAS h16* W; GAS float* B; int NN;
        if (n < NGU) { j = 0; W = (const GAS h16*)(F.ws + WS_WGU1); B = (GAS float*)(F.ws + WS_BIAS1); NN = NGU; }
        else if (n < NGU + INW) { n -= NGU; j = 1; W = (const GAS h16*)(F.ws + WS_WIN); B = (GAS float*)(F.ws + WS_BIAS2); NN = INW; }
        else { n -= NGU + INW; j = 2; W = (const GAS h16*)(F.ws + WS_WGU2); B = (GAS float*)(F.ws + WS_BIAS3); NN = NGU; }
        const h16x8 w0 = *(const GAS h16x8*)(W + blk_off(n, 16 * F.lane, D / 64)), w1 = *(const GAS h16x8*)(W + blk_off(n, 16 * F.lane + 8, D / 64));
        float s[4];
#pragma unroll
        for (int b = 0; b < 4; ++b) { const LAS float* sh = modl + (b * 6 + j) * D + 16 * F.lane; float t = 0.f;
#pragma unroll
            for (int e = 0; e < 8; ++e) t += sh[e] * (float)w0[e] + sh[8 + e] * (float)w1[e];
            s[b] = wave_sum(t); }
        if (F.lane == 0) { B[0 * NN + n] = s[0]; B[1 * NN + n] = s[1]; B[2 * NN + n] = s[2]; B[3 * NN + n] = s[3]; }
    }
    __syncthreads();
}

__device__ __forceinline__ void p_final(const Frame& F0, const Args& a) {
    Frame F = F0; F.tid = threadIdx.x; F.lane = F.tid & 63; F.wave = __builtin_amdgcn_readfirstlane(F.tid >> 6);
    const GAS h16* H = (const GAS h16*)(F.ws + WS_H); const GAS float* ssq = (const GAS float*)(F.ws + WS_SSQF); const GAS float* gf = GIN(a, 19);
    const int gw = F.vcu * NWAVES + F.wave, NGW = F.G * NWAVES;
    f32x4 g[2][2];
#pragma unroll
    for (int j = 0; j < 2; ++j)
#pragma unroll
        for (int h = 0; h < 2; ++h) g[j][h] = *(const GAS f32x4*)(gf + 8 * F.lane + 512 * j + 4 * h);
    for (int row = gw; row < M; row += NGW) {
        const float rs = rs16p(ssq + row);
#pragma unroll
        for (int j = 0; j < 2; ++j) { const h16x8 hv = *(const GAS h16x8*)(H + (size_t)row * D + 8 * F.lane + 512 * j);
            f32x4 o0 = (f32x4){(float)hv[0], (float)hv[1], (float)hv[2], (float)hv[3]} * rs * g[j][0], o1 = (f32x4){(float)hv[4], (float)hv[5], (float)hv[6], (float)hv[7]} * rs * g[j][1];
            *(GAS f32x4*)(a.out + (size_t)row * D + 8 * F.lane + 512 * j) = o0; *(GAS f32x4*)(a.out + (size_t)row * D + 8 * F.lane + 512 * j + 4) = o1; }
    }
}


typedef float f32x16 __attribute__((ext_vector_type(16)));
typedef short v4i16_t __attribute__((ext_vector_type(4)));
__device__ __forceinline__ h16x4 tr16(const LAS unsigned char* p) { return __builtin_bit_cast(h16x4, __builtin_amdgcn_ds_read_tr16_b64_v4i16((LAS v4i16_t*)p)); }
__device__ __forceinline__ int vt_off(int t, int c8) { return t * 128 + (((c8 >> 2) ^ ((t >> 1) & 1)) << 6) + ((c8 & 3) << 4); }

__device__ __forceinline__ void gmlp_phase(const Frame& F0, const Args& a, int shadow) {
    const int tid = threadIdx.x, lane = tid & 63, wave = __builtin_amdgcn_readfirstlane(tid >> 6), r32 = lane & 31, hi = lane >> 5;
    GAS h16* proj = (GAS h16*)(F0.ws + WS_PROJ); const GAS h16* W16 = (const GAS h16*)(F0.ws + WS_WS16); GAS float* RG = (GAS float*)(F0.ws + WS_RG);
    const GAS float* ln_g = GIN(a, 9); const GAS float* ln_b = GIN(a, 10); const GAS float* b_s = GIN(a, 12);
    LAS unsigned char* lds = F0.lds;
    LAS float* rowsq = (LAS float*)(lds + MISC_OFF + 128);
    LAS unsigned char* gstg = lds + MISC_OFF + 128 + 4096 + wave * 2048;
    f32x4 g0 = *(const GAS f32x4*)(ln_g + 8 * lane), g1 = *(const GAS f32x4*)(ln_g + 8 * lane + 4), b0 = *(const GAS f32x4*)(ln_b + 8 * lane), b1 = *(const GAS f32x4*)(ln_b + 8 * lane + 4);
    for (int unit = F0.vcu; unit < M / GC; unit += F0.G) {
        const size_t row0 = (size_t)unit * GC;
        {
            h16x8 hv[16]; float sm[16], mu[16], rsd[16];
#pragma unroll
            for (int rr = 0; rr < 16; ++rr) hv[rr] = *(const GAS h16x8*)(proj + (row0 + wave * 16 + rr) * INW + PG + 8 * lane);
#pragma unroll
            for (int rr = 0; rr < 16; ++rr) { float t = 0.f;
#pragma unroll
                for (int e = 0; e < 8; ++e) t += (float)hv[rr][e];
                sm[rr] = t; }
#pragma unroll
            for (int o = 1; o < 64; o <<= 1)
#pragma unroll
                for (int rr = 0; rr < 16; ++rr) sm[rr] += __shfl_xor(sm[rr], o);
#pragma unroll
            for (int rr = 0; rr < 16; ++rr) { mu[rr] = sm[rr] * (1.f / 512.f); float q = 0.f;
#pragma unroll
                for (int e = 0; e < 8; ++e) { const float d = (float)hv[rr][e] - mu[rr]; q += d * d; }
                sm[rr] = q; }
#pragma unroll
            for (int o = 1; o < 64; o <<= 1)
#pragma unroll
                for (int rr = 0; rr < 16; ++rr) sm[rr] += __shfl_xor(sm[rr], o);
#pragma unroll
            for (int rr = 0; rr < 16; ++rr) { rsd[rr] = rsqrtf(sm[rr] * (1.f / 512.f) + EPS);
                const int t = wave * 16 + rr; float v[8];
#pragma unroll
                for (int e = 0; e < 8; ++e) v[e] = ((float)hv[rr][e] - mu[rr]) * rsd[rr];
                u32x4 w; w[0] = pkh(v[0] * g0[0] + b0[0], v[1] * g0[1] + b0[1]); w[1] = pkh(v[2] * g0[2] + b0[2], v[3] * g0[3] + b0[3]);
                w[2] = pkh(v[4] * g1[0] + b1[0], v[5] * g1[1] + b1[1]); w[3] = pkh(v[6] * g1[2] + b1[2], v[7] * g1[3] + b1[3]);
                *(LAS u32x4*)(lds + (lane >> 3) * 16384 + vt_off(t, lane & 7)) = w; }
        }
        __syncthreads();
        const GAS h16* Wh = W16 + (size_t)wave * GC * GC;
        const LAS unsigned char* vt = lds + wave * 16384;
        const int q4 = (lane & 15) >> 2, p4 = lane & 3, g1b = (lane >> 4) & 1;
#pragma unroll
        for (int tb = 0; tb < 4; ++tb) {
            f32x16 acc[2];
#pragma unroll
            for (int d0 = 0; d0 < 2; ++d0)
#pragma unroll
                for (int e = 0; e < 16; ++e) acc[d0][e] = 0.f;
            h16x8 af[8];
#pragma unroll
            for (int ks = 0; ks < 8; ++ks) if (ks <= 2 * tb + 1) af[ks] = *(const GAS h16x8*)(Wh + (size_t)(32 * tb + r32) * GC + 16 * ks + 8 * hi);
#pragma unroll
            for (int ks = 0; ks < 8; ++ks) {
                if (ks <= 2 * tb + 1) {
#pragma unroll
                    for (int d0 = 0; d0 < 2; ++d0) {
                        const int srow = 16 * ks + 8 * hi + q4, c8 = 4 * d0 + 2 * g1b + (p4 >> 1);
                        const h16x4 lo = tr16(vt + vt_off(srow, c8) + (p4 & 1) * 8), hi4 = tr16(vt + vt_off(srow + 4, c8) + (p4 & 1) * 8);
                        const h16x8 bf = (h16x8){lo[0], lo[1], lo[2], lo[3], hi4[0], hi4[1], hi4[2], hi4[3]};
                        acc[d0] = __builtin_amdgcn_mfma_f32_32x32x16_f16(af[ks], bf, acc[d0], 0, 0, 0);
                    }
                }
            }
            float bsv[16];
#pragma unroll
            for (int e = 0; e < 16; ++e) bsv[e] = b_s[wave * GC + 32 * tb + (e & 3) + 8 * (e >> 2) + 4 * hi];
            h16x8 uv[2][2];
#pragma unroll
            for (int d0 = 0; d0 < 2; ++d0)
#pragma unroll
                for (int i = 0; i < 2; ++i) uv[d0][i] = *(const GAS h16x8*)(proj + (row0 + 32 * tb + (lane >> 2) + 16 * i) * INW + PU + wave * 64 + 32 * d0 + (lane & 3) * 8);
            asm volatile("" ::: "memory");
            float rq[2] = {0.f, 0.f};
#pragma unroll
            for (int d0 = 0; d0 < 2; ++d0) {
#pragma unroll
                for (int e = 0; e < 16; ++e) *(LAS h16*)(gstg + ((e & 3) + 8 * (e >> 2) + 4 * hi) * 64 + r32 * 2) = (h16)(acc[d0][e] + bsv[e]);
                LDS_WAIT();
#pragma unroll
                for (int i = 0; i < 2; ++i) { const int rw = (lane >> 2) + 16 * i; const h16x8 mx = *(const LAS h16x8*)(gstg + rw * 64 + (lane & 3) * 16);
                    float o[8]; float q = 0.f;
#pragma unroll
                    for (int e = 0; e < 8; ++e) { o[e] = (float)uv[d0][i][e] * (float)mx[e]; q += o[e] * o[e]; }
                    u32x4 w; w[0] = pkh(o[0], o[1]); w[1] = pkh(o[2], o[3]); w[2] = pkh(o[4], o[5]); w[3] = pkh(o[6], o[7]);
                    *(GAS u32x4*)(proj + (row0 + 32 * tb + rw) * INW + PU + wave * 64 + 32 * d0 + (lane & 3) * 8) = w;
                    q += __shfl_xor(q, 1); q += __shfl_xor(q, 2); rq[i] += q; }
                LDS_WAIT();
            }
            if ((lane & 3) == 0) { rowsq[wave * 128 + 32 * tb + (lane >> 2)] = rq[0]; rowsq[wave * 128 + 32 * tb + (lane >> 2) + 16] = rq[1]; }
        }
        __syncthreads();
        if (tid < 128) { float s8 = 0.f;
#pragma unroll
            for (int w = 0; w < 8; ++w) s8 += rowsq[w * 128 + tid];
            RG[row0 + tid] = s8; }
        __syncthreads();
    }
}


constexpr size_t DO_PO = 0, DO_PML = 96 * MiB;
constexpr int CW_CNT = 8192;
constexpr int LISTCAP = 8192;
constexpr int AL_K = 0, AL_V = 32768, AL_STG = 65536, AL_WSF = 98304, AL_START = 102400;
__device__ __forceinline__ int k_off(int key, int c8) { return key * 128 + ((c8 ^ (key & 7)) << 4); }

__device__ __forceinline__ void moba_gate_phase(const Frame& F0, int shadow) {
    const int tid = threadIdx.x, lane = tid & 63;
    const GAS h16* proj = (const GAS h16*)(F0.ws + WS_PROJ); const GAS float* kmp = (const GAS float*)(F0.ws + WS_KMP);
    unsigned* cnt = F0.ctl + CW_CNT + (shadow ? 1024 : 0); GAS unsigned short* lists = (GAS unsigned short*)(F0.ws + (shadow ? WS_HG : WS_LISTS));
    LAS float* km = (LAS float*)F0.lds;
    for (int item = F0.vcu, rnd = 0; item < NB * NH * (S / 512); item += F0.G, ++rnd) {
        const int sp0 = item % (S / 512), span = (rnd & 1) ? (S / 512 - 1 - sp0) : sp0, bh = item / (S / 512), b = bh >> 3, h = bh & 7;
        __syncthreads();
        for (int e = tid; e < NBLK * 64; e += NWAVES * 64) { const int n = e >> 6, d = e & 63; const GAS float* kp = kmp + (size_t)((b * NBLK + n) * 2) * 512 + h * 64 + d; km[e] = kp[0] + kp[512]; }
        __syncthreads();
        const int sq = span * 512 + tid, own = __builtin_amdgcn_readfirstlane(sq >> 8);
        float q[64];
        { const GAS h16* qp = proj + (size_t)(b * S + sq) * INW + PQ + h * 64;
#pragma unroll
          for (int c = 0; c < 8; ++c) { const h16x8 v = *(const GAS h16x8*)(qp + 8 * c);
#pragma unroll
              for (int e = 0; e < 8; ++e) q[8 * c + e] = (float)v[e]; } }
        float v0 = -3e38f, v1 = -3e38f, v2 = -3e38f; int i0 = -1, i1 = -1, i2 = -1;
        for (int n = 0; n < own; ++n) {
            float g0 = 0.f, g1 = 0.f, g2 = 0.f, g3 = 0.f;
#pragma unroll
            for (int c = 0; c < 16; ++c) { const f32x4 kv = *(const LAS f32x4*)(km + n * 64 + 4 * c); g0 += q[4 * c] * kv[0]; g1 += q[4 * c + 1] * kv[1]; g2 += q[4 * c + 2] * kv[2]; g3 += q[4 * c + 3] * kv[3]; }
            const float g = (g0 + g1) + (g2 + g3);
            if (g > v0) { v2 = v1; i2 = i1; v1 = v0; i1 = i0; v0 = g; i0 = n; }
            else if (g > v1) { v2 = v1; i2 = i1; v1 = g; i1 = n; }
            else if (g > v2) { v2 = g; i2 = n; }
        }
        int mycnt = 0, pos0 = 0, pos1 = 0, pos2 = 0;
        const unsigned long long ltmask = (1ull << lane) - 1ull;
        for (int n = 0; n < own; ++n) {
            const bool sel = (i0 == n) || (i1 == n) || (i2 == n);
            const unsigned long long mask = __ballot(sel);
            const int before = __popcll(mask & ltmask);
            if (lane == n) mycnt = __popcll(mask);
            if (i0 == n) pos0 = before; if (i1 == n) pos1 = before; if (i2 == n) pos2 = before;
        }
        unsigned base = 0u;
        if (lane < own && mycnt > 0) base = atomicAdd(cnt + bh * NBLK + lane, (unsigned)mycnt);
        const unsigned bb0 = (unsigned)__shfl((int)base, i0 & 63), bb1 = (unsigned)__shfl((int)base, i1 & 63), bb2 = (unsigned)__shfl((int)base, i2 & 63);
        if (i0 >= 0) lists[(size_t)(bh * NBLK + i0) * LISTCAP + bb0 + pos0] = (unsigned short)(sq | (0 << 13));
        if (i1 >= 0) lists[(size_t)(bh * NBLK + i1) * LISTCAP + bb1 + pos1] = (unsigned short)(sq | (1 << 13));
        if (i2 >= 0) lists[(size_t)(bh * NBLK + i2) * LISTCAP + bb2 + pos2] = (unsigned short)(sq | (2 << 13));
    }
    __syncthreads();
}

template <bool CAUSAL>
__device__ __forceinline__ void attn_tile(const LAS unsigned char* ldsK, const LAS unsigned char* ldsV, const h16x8 (&qf)[4], int wave, int lane, f32x16 (&o)[2], float& m_out, float& l_out) {
    const int r32 = lane & 31, hi = lane >> 5;
    int kbase[4];
#pragma unroll
    for (int ks = 0; ks < 4; ++ks) kbase[ks] = r32 * 128 + (((2 * ks + hi) ^ (r32 & 7)) << 4);
    f32x16 sacc[8];
#pragma unroll
    for (int kb = 0; kb < 8; ++kb) {
        f32x16 acc;
#pragma unroll
        for (int e = 0; e < 16; ++e) acc[e] = 0.f;
#pragma unroll
        for (int ks = 0; ks < 4; ++ks) { const h16x8 kf = *(const LAS h16x8*)(ldsK + kbase[ks] + kb * 4096); acc = __builtin_amdgcn_mfma_f32_32x32x16_f16(kf, qf[ks], acc, 0, 0, 0); }
        if (CAUSAL) {
            const int lim = 32 * (wave - kb) + r32;
#pragma unroll
            for (int e = 0; e < 16; ++e) { const int key = (e & 3) + 8 * (e >> 2) + 4 * hi; if (key > lim) acc[e] = -1e30f; }
        }
        sacc[kb] = acc;
    }
    float m = -3e38f;
#pragma unroll
    for (int kb = 0; kb < 8; ++kb)
#pragma unroll
        for (int e = 0; e < 16; ++e) m = fmaxf(m, sacc[kb][e]);
    m = fmaxf(m, __shfl_xor(m, 32));
    float ls = 0.f;
#pragma unroll
    for (int kb = 0; kb < 8; ++kb)
#pragma unroll
        for (int e = 0; e < 16; ++e) { const float pv = __builtin_amdgcn_exp2f(sacc[kb][e] - m); sacc[kb][e] = pv; ls += pv; }
    ls += __shfl_xor(ls, 32);
#pragma unroll
    for (int d0 = 0; d0 < 2; ++d0)
#pragma unroll
        for (int e = 0; e < 16; ++e) o[d0][e] = 0.f;
    const int q4 = (lane & 15) >> 2, p4 = lane & 3, g1b = (lane >> 4) & 1;
    int vbase[2];
#pragma unroll
    for (int d0 = 0; d0 < 2; ++d0) vbase[d0] = (4 * hi + q4) * 128 + ((d0 ^ ((q4 >> 1) & 1)) << 6) + ((2 * g1b + (p4 >> 1)) << 4) + (p4 & 1) * 8;
#pragma unroll
    for (int kb = 0; kb < 8; ++kb) {
        if (!CAUSAL || kb <= wave) {
#pragma unroll
            for (int s2 = 0; s2 < 2; ++s2) {
                h16x8 pa;
#pragma unroll
                for (int j = 0; j < 8; ++j) pa[j] = (h16)sacc[kb][8 * s2 + j];
#pragma unroll
                for (int d0 = 0; d0 < 2; ++d0) {
                    const h16x4 lo = tr16(ldsV + vbase[d0] + kb * 4096 + s2 * 2048), hi4 = tr16(ldsV + vbase[d0] + kb * 4096 + s2 * 2048 + 1024);
                    const h16x8 bf = (h16x8){lo[0], lo[1], lo[2], lo[3], hi4[0], hi4[1], hi4[2], hi4[3]};
                    o[d0] = __builtin_amdgcn_mfma_f32_32x32x16_f16(pa, bf, o[d0], 0, 0, 0);
                }
            }
        }
    }
    m_out = m; l_out = ls;
}
__device__ __forceinline__ void attn_tile_causal(const LAS unsigned char* ldsK, const LAS unsigned char* ldsV, const h16x8 (&qf)[4], int wave, int lane, f32x16 (&o)[2], float& m_out, float& l_out) {
    const int r32 = lane & 31, hi = lane >> 5;
    int kbase[4];
#pragma unroll
    for (int ks = 0; ks < 4; ++ks) kbase[ks] = r32 * 128 + (((2 * ks + hi) ^ (r32 & 7)) << 4);
    const int q4 = (lane & 15) >> 2, p4 = lane & 3, g1b = (lane >> 4) & 1;
    int vbase[2];
#pragma unroll
    for (int d0 = 0; d0 < 2; ++d0) vbase[d0] = (4 * hi + q4) * 128 + ((d0 ^ ((q4 >> 1) & 1)) << 6) + ((2 * g1b + (p4 >> 1)) << 4) + (p4 & 1) * 8;
    float m = -3e38f;
    for (int kb = 0; kb <= wave; ++kb) {
        f32x16 acc;
#pragma unroll
        for (int e = 0; e < 16; ++e) acc[e] = 0.f;
#pragma unroll
        for (int ks = 0; ks < 4; ++ks) { const h16x8 kf = *(const LAS h16x8*)(ldsK + kbase[ks] + kb * 4096); acc = __builtin_amdgcn_mfma_f32_32x32x16_f16(kf, qf[ks], acc, 0, 0, 0); }
        const int lim = (kb == wave) ? r32 : 64;
#pragma unroll
        for (int e = 0; e < 16; ++e) { const int key = (e & 3) + 8 * (e >> 2) + 4 * hi; if (key <= lim) m = fmaxf(m, acc[e]); }
    }
    m = fmaxf(m, __shfl_xor(m, 32));
    float ls = 0.f;
#pragma unroll
    for (int d0 = 0; d0 < 2; ++d0)
#pragma unroll
        for (int e = 0; e < 16; ++e) o[d0][e] = 0.f;
    for (int kb = 0; kb <= wave; ++kb) {
        f32x16 acc;
#pragma unroll
        for (int e = 0; e < 16; ++e) acc[e] = 0.f;
#pragma unroll
        for (int ks = 0; ks < 4; ++ks) { const h16x8 kf = *(const LAS h16x8*)(ldsK + kbase[ks] + kb * 4096); acc = __builtin_amdgcn_mfma_f32_32x32x16_f16(kf, qf[ks], acc, 0, 0, 0); }
        const int lim = (kb == wave) ? r32 : 64;
#pragma unroll
        for (int e = 0; e < 16; ++e) { const int key = (e & 3) + 8 * (e >> 2) + 4 * hi; const float pv = (key <= lim) ? __builtin_amdgcn_exp2f(acc[e] - m) : 0.f; acc[e] = pv; ls += pv; }
#pragma unroll
        for (int s2 = 0; s2 < 2; ++s2) {
            h16x8 pa;
#pragma unroll
            for (int j = 0; j < 8; ++j) pa[j] = (h16)acc[8 * s2 + j];
#pragma unroll
            for (int d0 = 0; d0 < 2; ++d0) {
                const h16x4 lo = tr16(ldsV + vbase[d0] + kb * 4096 + s2 * 2048), hi4 = tr16(ldsV + vbase[d0] + kb * 4096 + s2 * 2048 + 1024);
                const h16x8 bf = (h16x8){lo[0], lo[1], lo[2], lo[3], hi4[0], hi4[1], hi4[2], hi4[3]};
                o[d0] = __builtin_amdgcn_mfma_f32_32x32x16_f16(pa, bf, o[d0], 0, 0, 0);
            }
        }
    }
    ls += __shfl_xor(ls, 32);
    m_out = m; l_out = ls;
}
__device__ __forceinline__ void load_kv_block(LAS unsigned char* lds, const GAS h16* proj, size_t row0, int h, int tid) {
#pragma unroll
    for (int i = 0; i < 4; ++i) { const int idx = tid + 512 * i, key = idx >> 3, c8 = idx & 7; const GAS h16* rp = proj + (row0 + key) * INW + h * 64 + 8 * c8;
        const u32x4 kv = *(const GAS u32x4*)(rp + PK), vv = *(const GAS u32x4*)(rp + PV);
        *(LAS u32x4*)(lds + AL_K + k_off(key, c8)) = kv; *(LAS u32x4*)(lds + AL_V + vt_off(key, c8)) = vv; }
}
__device__ __forceinline__ void stage_o(LAS unsigned char* stg, LAS float* wsf, const f32x16 (&o)[2], float l, int lane) {
    const int r32 = lane & 31, hi = lane >> 5;
    if (hi == 0) wsf[r32] = 1.f / l;
    LDS_WAIT();
#pragma unroll
    for (int e = 0; e < 16; ++e) { const int qr = (e & 3) + 8 * (e >> 2) + 4 * hi; const float rl = wsf[qr];
        *(LAS h16*)(stg + qr * 128 + r32 * 2) = (h16)(o[0][e] * rl); *(LAS h16*)(stg + qr * 128 + 64 + r32 * 2) = (h16)(o[1][e] * rl); }
    LDS_WAIT();
}

struct KvRegs { u32x4 kv[4], vv[4]; };
__device__ __forceinline__ void kv_fetch(KvRegs& r, const GAS h16* proj, size_t row0, int h, int tid) {
#pragma unroll
    for (int i = 0; i < 4; ++i) { const int idx = tid + 512 * i, key = idx >> 3, c8 = idx & 7; const GAS h16* rp = proj + (row0 + key) * INW + h * 64 + 8 * c8;
        r.kv[i] = *(const GAS u32x4*)(rp + PK); r.vv[i] = *(const GAS u32x4*)(rp + PV); }
}
__device__ __forceinline__ void kv_commit(const KvRegs& r, LAS unsigned char* lds, int tid) {
#pragma unroll
    for (int i = 0; i < 4; ++i) { const int idx = tid + 512 * i, key = idx >> 3, c8 = idx & 7;
        *(LAS u32x4*)(lds + AL_K + k_off(key, c8)) = r.kv[i]; *(LAS u32x4*)(lds + AL_V + vt_off(key, c8)) = r.vv[i]; }
}
__device__ __forceinline__ void moba_b_phase(const Frame& F0, GAS float* dout) {
    const int tid = threadIdx.x, lane = tid & 63, wave = __builtin_amdgcn_readfirstlane(tid >> 6), r32 = lane & 31, hi = lane >> 5;
    const GAS h16* proj = (const GAS h16*)(F0.ws + WS_PROJ); const unsigned* cnt = F0.ctl + CW_CNT; const GAS unsigned short* lists = (const GAS unsigned short*)(F0.ws + WS_LISTS);
    GAS h16* PO = (GAS h16*)((unsigned char*)dout + DO_PO); GAS float* PML = (GAS float*)((unsigned char*)dout + DO_PML);
    LAS unsigned char* lds = F0.lds;
    LAS int* start = (LAS int*)(lds + AL_START);
    LAS float* wsf = (LAS float*)(lds + AL_WSF + wave * 512); LAS int* wsi = (LAS int*)(lds + AL_WSF + wave * 512 + 256);
    LAS unsigned char* stg = lds + AL_STG + wave * 4096;
    {
        const unsigned c0 = cnt[2 * tid], c1 = cnt[2 * tid + 1];
        const int t0 = (int)((c0 + 255u) >> 8), t1 = (int)((c1 + 255u) >> 8);
        int v = t0 + t1, inc = v;
#pragma unroll
        for (int o = 1; o < 64; o <<= 1) { const int u = __shfl_up(inc, o); if (lane >= o) inc += u; }
        LAS int* wtot = (LAS int*)(lds + AL_WSF);
        __syncthreads();
        if (lane == 63) wtot[wave] = inc;
        __syncthreads();
        int pre = 0;
        for (int w = 0; w < wave; ++w) pre += wtot[w];
        const int ex = pre + inc - v;
        __syncthreads();
        start[2 * tid] = ex; start[2 * tid + 1] = ex + t0;
        if (tid == 511) start[1024] = ex + v;
        __syncthreads();
    }
    const int nitems = start[1024];
    for (int item = F0.vcu; item < nitems; item += F0.G) {
        int lo = 0, hi_ = 1024;
        while (hi_ - lo > 1) { const int mid = (lo + hi_) >> 1; if (start[mid] <= item) lo = mid; else hi_ = mid; }
        const int l = lo, chunk = item - start[l];
        const int bh = l >> 5, n = l & 31, b = bh >> 3, h = bh & 7;
        const int nq = (int)cnt[l] - chunk * 256;
        const int qi = chunk * 256 + wave * 32 + r32;
        const bool valid = (wave * 32 + r32) < nq;
        const unsigned ent = lists[(size_t)l * LISTCAP + (valid ? qi : chunk * 256)];
        KvRegs kvr; kv_fetch(kvr, proj, (size_t)b * S + (size_t)n * MBLK, h, tid);
        const int sq = ent & 8191, rank = ent >> 13;
        h16x8 qf[4];
        { const GAS h16* qp = proj + (size_t)(b * S + sq) * INW + PQ + h * 64 + 8 * hi;
#pragma unroll
          for (int ks = 0; ks < 4; ++ks) qf[ks] = *(const GAS h16x8*)(qp + 16 * ks); }
        kv_commit(kvr, lds, tid);
        __syncthreads();
        if (wave * 32 < nq) {
            f32x16 o[2]; float m, lsum;
            attn_tile<false>(lds + AL_K, lds + AL_V, qf, wave, lane, o, m, lsum);
            const int slot = ((b * NH + h) * 3 + rank) * S + sq;
            if (hi == 0) { wsi[r32] = valid ? slot : -1; if (valid) { PML[(size_t)slot * 2] = m; PML[(size_t)slot * 2 + 1] = lsum; } }
            stage_o(stg, wsf, o, lsum, lane);
#pragma unroll
            for (int i = 0; i < 4; ++i) { const int row = i * 8 + (lane >> 3), ch = lane & 7; const int sl = wsi[row];
                if (sl >= 0) *(GAS u32x4*)(PO + (size_t)sl * 64 + ch * 8) = *(const LAS u32x4*)(stg + row * 128 + ch * 16); }
        }
        __syncthreads();
    }
}

__device__ __forceinline__ void moba_c_phase(const Frame& F0, const GAS float* dout, int shadow) {
    const int tid = threadIdx.x, lane = tid & 63, wave = __builtin_amdgcn_readfirstlane(tid >> 6), r32 = lane & 31, hi = lane >> 5;
    const int qblk = (wave < 4) ? wave : 11 - wave;
    GAS h16* proj = (GAS h16*)(F0.ws + WS_PROJ); GAS float* SSQA = (GAS float*)(F0.ws + WS_SSQA);
    const GAS h16* PO = (const GAS h16*)((const unsigned char*)dout + DO_PO); const GAS float* PML = (const GAS float*)((const unsigned char*)dout + DO_PML);
    LAS unsigned char* lds = F0.lds;
    LAS float* wsf = (LAS float*)(lds + AL_WSF + wave * 512);
    LAS unsigned char* stg = lds + AL_STG + wave * 4096;
    KvRegs kvr;
    if (F0.vcu < NB * NH * NBLK) { const int u0 = F0.vcu; kv_fetch(kvr, proj, (size_t)((u0 >> 5) >> 3) * S + (size_t)(u0 & 31) * MBLK, (u0 >> 5) & 7, tid); }
    for (int unit = F0.vcu; unit < NB * NH * NBLK; unit += F0.G) {
        const int qb = unit & 31, bh = unit >> 5, b = bh >> 3, h = bh & 7;
        const size_t row0 = (size_t)b * S + (size_t)qb * MBLK;
        kv_commit(kvr, lds, tid);
        { const int un = unit + F0.G; if (un < NB * NH * NBLK) kv_fetch(kvr, proj, (size_t)((un >> 5) >> 3) * S + (size_t)(un & 31) * MBLK, (un >> 5) & 7, tid); }
        h16x8 qf[4];
        { const GAS h16* qp = proj + (row0 + qblk * 32 + r32) * INW + PQ + h * 64 + 8 * hi;
#pragma unroll
          for (int ks = 0; ks < 4; ++ks) qf[ks] = *(const GAS h16x8*)(qp + 16 * ks); }
        __syncthreads();
        f32x16 o[2]; float m, lsum;
        attn_tile_causal(lds + AL_K, lds + AL_V, qf, qblk, lane, o, m, lsum);
        if (hi == 0) { wsf[32 + r32] = m; wsf[64 + r32] = lsum; }
        stage_o(stg, wsf, o, lsum, lane);
        const int nsel = qb < 3 ? qb : 3;
#pragma unroll
        for (int i0 = 0; i0 < 4; i0 += 2) {
            float mr[2][3], lr[2][3]; h16x8 pv[2][3];
#pragma unroll
            for (int ii = 0; ii < 2; ++ii) { const size_t grow = row0 + qblk * 32 + (i0 + ii) * 8 + (lane >> 3);
#pragma unroll
                for (int r = 0; r < 3; ++r) { if (r < nsel) { const size_t sl = ((size_t)(b * NH + h) * 3 + r) * S + (grow - (size_t)b * S); mr[ii][r] = PML[sl * 2]; lr[ii][r] = PML[sl * 2 + 1]; pv[ii][r] = *(const GAS h16x8*)(PO + sl * 64 + (lane & 7) * 8); } } }
            asm volatile("" ::: "memory");
#pragma unroll
            for (int ii = 0; ii < 2; ++ii) {
                const int row = (i0 + ii) * 8 + (lane >> 3), ch = lane & 7;
                const size_t grow = row0 + qblk * 32 + row;
                const float mo = wsf[32 + row], lo_ = wsf[64 + row];
                const h16x8 ov = *(const LAS h16x8*)(stg + row * 128 + ch * 16);
                float mmax = mo;
#pragma unroll
                for (int r = 0; r < 3; ++r) { if (r < nsel) mmax = fmaxf(mmax, mr[ii][r]); }
                float wo = lo_ * __builtin_amdgcn_exp2f(mo - mmax), L = wo;
                float acc[8];
#pragma unroll
                for (int e = 0; e < 8; ++e) acc[e] = wo * (float)ov[e];
#pragma unroll
                for (int r = 0; r < 3; ++r) { if (r < nsel) { const float wr_ = lr[ii][r] * __builtin_amdgcn_exp2f(mr[ii][r] - mmax); L += wr_;
#pragma unroll
                    for (int e = 0; e < 8; ++e) acc[e] += wr_ * (float)pv[ii][r][e]; } }
                const float rL = 1.f / L; float q = 0.f; u32x4 w;
#pragma unroll
                for (int e = 0; e < 8; ++e) { acc[e] *= rL; q += acc[e] * acc[e]; }
                w[0] = pkh(acc[0], acc[1]); w[1] = pkh(acc[2], acc[3]); w[2] = pkh(acc[4], acc[5]); w[3] = pkh(acc[6], acc[7]);
                if (shadow) *(GAS u32x4*)((GAS h16*)(F0.ws + WS_HG) + grow * 512 + h * 64 + ch * 8) = w;
                else *(GAS u32x4*)(proj + grow * INW + PQ + h * 64 + ch * 8) = w;
                q += __shfl_xor(q, 1); q += __shfl_xor(q, 2); q += __shfl_xor(q, 4);
                if (ch == 0) SSQA[grow * 8 + h] = q;
            }
        }
        __syncthreads();
    }
}


template <bool PART16, class Order> __device__ __forceinline__ void fill_rowscale(LAS float* tab, const Order& So, const GAS float* src, int maxu) {
    pg8::Unit uu;
    for (int i = 0; i < maxu && So.next(i, uu); ++i)
        if (threadIdx.x < 256) { const int row = uu.pm * 256 + (int)threadIdx.x; tab[i * 256 + threadIdx.x] = PART16 ? rs16p(src + row) : src[row]; }
    __syncthreads();
}
constexpr int TAB_OFF = MISC_OFF + 128, TAB_MAXU = 15;
static_assert(TAB_OFF + TAB_MAXU * 1024 <= LDS_BYTES, "row-scale table");

enum Phase { PH_P0 = 0, PH_P1, PH_G1A, PH_G1B, PH_INPROJ, PH_MIX_A, PH_MIX_B, PH_MIX_C, PH_OUTPROJ, PH_G2A, PH_G2B, PH_FINAL, PH_COUNT };
__global__ void __launch_bounds__(NWAVES * 64, 2) mega_fwd(Args args) {
    extern __shared__ __attribute__((aligned(16))) unsigned char lds[];
    Frame F;
    F.lds = (LAS unsigned char*)lds; F.MISC = (volatile LAS unsigned*)(F.lds + MISC_OFF);
    F.tid = threadIdx.x; F.lane = F.tid & 63; F.wave = __builtin_amdgcn_readfirstlane(F.tid >> 6);
    F.G = gridDim.x; { const int bx = blockIdx.x; F.vcu = (F.G % 8 == 0) ? (bx % 8) * (F.G / 8) + bx / 8 : bx; }
    F.ws = args.ws; F.out = (GAS float*)args.out; F.ctl = (unsigned*)(args.ws + WS_CTL);
    for (int u = F.tid; u < (LDS_BYTES - LDSCTL_OFF) / 4; u += NWAVES * 64) ((LAS unsigned*)(F.lds + LDSCTL_OFF))[u] = 0u;
    __syncthreads();
    XcdBarrier bar; bar.bar = F.ctl + CW_BAR; bar.x = 0; bar.st = nullptr;
    const int lo = args.ph_lo, hi = args.ph_hi;
    if (hi - lo > 1) bar = xcd_barrier_post(F.ctl + CW_BAR, F.MISC + 8);
#ifndef MK_PHASE_MASK
#define MK_PHASE_MASK 0xFFFF
#endif
#define IN(k) (((MK_PHASE_MASK >> (k)) & 1) && lo <= (k) && (k) < hi)
#define SEAM(k) do { if (IN(k) && IN((k) + 1)) xcd_barrier(bar); } while (0)
#define PHASE_PTRS() unsigned char* ws = args.ws; asm volatile("" : "+s"(ws)); const GAS float* GT = (const GAS float*)(ws + WS_GT); const GAS float* GP = (const GAS float*)(ws + WS_GP); (void)GT; (void)GP; F.ws = ws
    if (IN(PH_P0)) { PHASE_PTRS(); p0_prologue(F, args); SEAM(PH_P0); }
    if (IN(PH_P1)) { PHASE_PTRS(); p1_prep(F, args); SEAM(PH_P1); }
    if (IN(PH_G1A)) {
        PHASE_PTRS();
        pg8::Gemm g{(const GAS h16*)(ws + WS_HG), (const GAS h16*)(ws + WS_WGU1), 0, NGU, D}; pg8::StaticOrder So; So.init(M, NGU, F.G, (int)blockIdx.x); const pg8::TableOrder To = pg8::make_table(So, (LAS int*)(F.lds + LDSCTL_OFF));
#if MK_SHADOW == 1
        if (args.ph_lo == PH_G1A && args.ph_hi == PH_G1A + 1 && args.shadow) { EpiNull En; pg8::gemm_phase<EpiNull, true, MK_GPROBE>(F.lds, g, So, En); return; }
#endif
        fill_rowscale<false>((LAS float*)(F.lds + TAB_OFF), To, (const GAS float*)(ws + WS_R1), TAB_MAXU);
        EpiSwiglu E{(GAS h16*)(ws + WS_ACT), (const LAS float*)(F.lds + TAB_OFF), (const GAS float*)(ws + WS_BIAS1)};
        pg8::gemm_phase<EpiSwiglu, true, 0, pg8::TableOrder>(F.lds, g, To, E); SEAM(PH_G1A);
    }
    if (IN(PH_G1B)) {
        PHASE_PTRS();
        pg8::Gemm g{(const GAS h16*)(ws + WS_ACT), (const GAS h16*)(ws + WS_WD1), 0, D, DFF, MK_STAG}; pg8::StaticOrder So; So.init(M, D, F.G, (int)blockIdx.x); const pg8::TableOrder To = pg8::make_table(So, (LAS int*)(F.lds + LDSCTL_OFF));
#if MK_SHADOW == 8
        if (args.ph_lo == PH_G1B && args.ph_hi == PH_G1B + 1 && args.shadow) {
#if MK_GPROBE == 0
            EpiNull En; pg8::gemm_phase<EpiNull, true>(F.lds, g, So, En);
#else
            EpiResid<true, false, true, MK_GPROBE> Ev{GIN(args, 0), (GAS h16*)(ws + WS_H), (GAS h16*)(ws + WS_HG), GT + 0 * 4 * D, GP + 1 * 4 * D, (GAS float*)(ws + WS_SSQ2), nullptr, 0.5f};
            pg8::gemm_phase<EpiResid<true, false, true, MK_GPROBE>, true>(F.lds, g, So, Ev);
#endif
            return; }
#endif
        EpiResid<true, false, true> E{GIN(args, 0), (GAS h16*)(ws + WS_H), (GAS h16*)(ws + WS_HG), GT + 0 * 4 * D, GP + 1 * 4 * D, (GAS float*)(ws + WS_SSQ2), nullptr, 0.5f};
        pg8::gemm_phase<EpiResid<true, false, true>, true, 0, pg8::TableOrder>(F.lds, g, To, E); SEAM(PH_G1B);
    }
    if (IN(PH_INPROJ)) {
        PHASE_PTRS();
        pg8::Gemm g{(const GAS h16*)(ws + WS_HG), (const GAS h16*)(ws + WS_WIN), 0, INW, D}; pg8::StaticOrder So; So.init(M, INW, F.G, (int)blockIdx.x); const pg8::TableOrder To = pg8::make_table(So, (LAS int*)(F.lds + LDSCTL_OFF));
        fill_rowscale<true>((LAS float*)(F.lds + TAB_OFF), To, (const GAS float*)(ws + WS_SSQ2), TAB_MAXU);
        EpiInproj E{(GAS h16*)(ws + WS_PROJ), (const LAS float*)(F.lds + TAB_OFF), (const GAS float*)(ws + WS_BIAS2), (const GAS float*)(ws + WS_ROPE), (GAS float*)(ws + WS_KMP)};
        pg8::gemm_phase<EpiInproj, true, 0, pg8::TableOrder>(F.lds, g, To, E); SEAM(PH_INPROJ);
    }
    if (IN(PH_MIX_A)) { PHASE_PTRS(); if (!(args.shadow & 2)) gmlp_phase(F, args, args.shadow & 1); if (!(args.shadow & 4)) moba_gate_phase(F, args.shadow & 1); SEAM(PH_MIX_A); }
    if (IN(PH_MIX_B)) { PHASE_PTRS(); moba_b_phase(F, (GAS float*)args.out); SEAM(PH_MIX_B); }
    if (IN(PH_MIX_C)) { PHASE_PTRS(); moba_c_phase(F, (const GAS float*)args.out, args.shadow & 1); SEAM(PH_MIX_C); }
    if (IN(PH_OUTPROJ)) {
        PHASE_PTRS();
        pg8::Gemm g{(const GAS h16*)(ws + WS_PROJ), (const GAS h16*)(ws + WS_WOUT), INW, D, D}; pg8::StaticOrder So; So.init(M, D, F.G, (int)blockIdx.x); const pg8::TableOrder To = pg8::make_table(So, (LAS int*)(F.lds + LDSCTL_OFF));
        const LAS float* sct = (const LAS float*)(F.lds + MISC_OFF + 128);
        {   LAS float* t = (LAS float*)(F.lds + MISC_OFF + 128); const GAS float* ssqa = (const GAS float*)(ws + WS_SSQA); const GAS float* ssqg = (const GAS float*)(ws + WS_RG);
            pg8::Unit uu;
            for (int i = 0; i < 4 && To.next(i, uu); ++i)
                if (F.tid < 256) { const int row = uu.pm * 256 + F.tid; const f32x4 a = *(const GAS f32x4*)(ssqa + (size_t)row * 8), bq = *(const GAS f32x4*)(ssqa + (size_t)row * 8 + 4);
                    const float ra = rsqrtf((((a[0] + a[1]) + (a[2] + a[3])) + ((bq[0] + bq[1]) + (bq[2] + bq[3]))) * (1.f / 512.f) + EPS), rg = rsqrtf(ssqg[row] * (1.f / 512.f) + EPS);
                    t[i * 512 + F.tid] = ra / rg; t[i * 512 + 256 + F.tid] = rg; }
            __syncthreads(); }
        EpiResid<false, true, true> E{nullptr, (GAS h16*)(ws + WS_H), (GAS h16*)(ws + WS_HG), GT + 1 * 4 * D, GP + 2 * 4 * D, (GAS float*)(ws + WS_SSQ3), sct, 1.0f};
        pg8::gemm_phase<EpiResid<false, true, true>, true, 0, pg8::TableOrder>(F.lds, g, To, E); SEAM(PH_OUTPROJ);
    }
    if (IN(PH_G2A)) {
        PHASE_PTRS();
        pg8::Gemm g{(const GAS h16*)(ws + WS_HG), (const GAS h16*)(ws + WS_WGU2), 0, NGU, D}; pg8::StaticOrder So; So.init(M, NGU, F.G, (int)blockIdx.x); const pg8::TableOrder To = pg8::make_table(So, (LAS int*)(F.lds + LDSCTL_OFF));
        fill_rowscale<true>((LAS float*)(F.lds + TAB_OFF), To, (const GAS float*)(ws + WS_SSQ3), TAB_MAXU);
        EpiSwiglu E{(GAS h16*)(ws + WS_ACT), (const LAS float*)(F.lds + TAB_OFF), (const GAS float*)(ws + WS_BIAS3)};
        pg8::gemm_phase<EpiSwiglu, true, 0, pg8::TableOrder>(F.lds, g, To, E); SEAM(PH_G2A);
    }
    if (IN(PH_G2B)) {
        PHASE_PTRS();
        pg8::Gemm g{(const GAS h16*)(ws + WS_ACT), (const GAS h16*)(ws + WS_WD2), 0, D, DFF}; pg8::StaticOrder So; So.init(M, D, F.G, (int)blockIdx.x); const pg8::TableOrder To = pg8::make_table(So, (LAS int*)(F.lds + LDSCTL_OFF));
#if MK_FUSE_FINAL
        EpiFinal E{(const GAS h16*)(ws + WS_H), GT + 2 * 4 * D, GIN(args, 19), (GAS float*)args.out, (unsigned*)(ws + WS_SSQF), F.ctl + CW_PAN, F.ctl + CW_TMO,
                   (LAS float*)(F.lds + MISC_OFF + 128), (LAS float*)(F.lds + MISC_OFF + 128 + 4096), 0.5f};
        pg8::gemm_phase<EpiFinal, true, 0, pg8::TableOrder>(F.lds, g, To, E);
#else
        EpiResid<false, false, false> E{nullptr, (GAS h16*)(ws + WS_H), nullptr, GT + 2 * 4 * D, nullptr, (GAS float*)(ws + WS_SSQF), nullptr, 0.5f};
        pg8::gemm_phase<EpiResid<false, false, false>, true, 0, pg8::TableOrder>(F.lds, g, To, E); SEAM(PH_G2B);
#endif
    }
#if !MK_FUSE_FINAL
    if (IN(PH_FINAL)) { PHASE_PTRS(); p_final(F, args); }
#endif
#undef IN
#undef SEAM
}

extern "C" void kernel_launch(void* const* d_in, const int* in_sizes, int n_in, void* d_out, int out_size, void* d_ws, size_t ws_size, hipStream_t stream) {
    static int grid = 0;
    if (grid == 0) {
        if (n_in != 20 || out_size != M * D || ws_size < WS_END) { fprintf(stderr, "kernel_launch: unexpected shapes (n_in %d out %d ws %zu)\n", n_in, out_size, ws_size); grid = -1; return; }
        int dev = 0, cus = 0, per_cu = 0;
        hipGetDevice(&dev); hipDeviceGetAttribute(&cus, hipDeviceAttributeMultiprocessorCount, dev);
        if (hipFuncSetAttribute((const void*)mega_fwd, hipFuncAttributeMaxDynamicSharedMemorySize, LDS_BYTES) != hipSuccess) { fprintf(stderr, "kernel_launch: hipFuncSetAttribute failed\n"); grid = -1; return; }
        hipOccupancyMaxActiveBlocksPerMultiprocessor(&per_cu, (const void*)mega_fwd, NWAVES * 64, LDS_BYTES);
        (void)hipGetLastError();
        if (per_cu < 1) { fprintf(stderr, "kernel_launch: occupancy query says %d blocks/CU; nothing launched\n", per_cu); grid = -1; return; }
        grid = cus;
    }
    if (grid < 0) return;
    hipMemsetAsync((char*)d_ws + WS_CTL, 0, CTL_ZERO_BYTES, stream);
    Args a{};
    for (int i = 0; i < 20; ++i) a.in[i] = (const float*)d_in[i];
    a.out = (float*)d_out; a.ws = (unsigned char*)d_ws;
    unsigned char* ws = (unsigned char*)d_ws;
    auto run = [&](int lo, int hi) {
#if MK_PER_PHASE
        for (int p = lo; p < hi; ++p) {
            if (MK_SHADOW == 2 && p == PH_MIX_A) { a.ph_lo = p; a.ph_hi = p + 1; a.shadow = 1 | 4; hipLaunchKernelGGL(mega_fwd, dim3(grid), dim3(NWAVES * 64), LDS_BYTES, stream, a); a.shadow = 0; }
            if (MK_SHADOW == 10 && p == PH_MIX_A) { a.ph_lo = p; a.ph_hi = p + 1; a.shadow = 1 | 2 | 4; hipLaunchKernelGGL(mega_fwd, dim3(grid), dim3(NWAVES * 64), LDS_BYTES, stream, a); a.shadow = 0; }
            if (MK_SHADOW == 3 && p == PH_MIX_A) { a.ph_lo = p; a.ph_hi = p + 1; a.shadow = 1 | 2; hipLaunchKernelGGL(mega_fwd, dim3(grid), dim3(NWAVES * 64), LDS_BYTES, stream, a); a.shadow = 0; }
            if (MK_SHADOW == 4 && p == PH_MIX_C) { a.ph_lo = p; a.ph_hi = p + 1; a.shadow = 1; hipLaunchKernelGGL(mega_fwd, dim3(grid), dim3(NWAVES * 64), LDS_BYTES, stream, a); a.shadow = 0; }
            if (MK_SHADOW == 8 && p == PH_G1B) { a.ph_lo = p; a.ph_hi = p + 1; a.shadow = 1; hipLaunchKernelGGL(mega_fwd, dim3(grid), dim3(NWAVES * 64), LDS_BYTES, stream, a); a.shadow = 0; }
            if (MK_SHADOW == 1 && p == PH_G1A) { a.ph_lo = p; a.ph_hi = p + 1; a.shadow = 1; hipLaunchKernelGGL(mega_fwd, dim3(grid), dim3(NWAVES * 64), LDS_BYTES, stream, a); a.shadow = 0; }
            for (int rep = 0; rep < ((((MK_DUP_MASK) >> p) & 1) ? 2 : 1); ++rep) { a.ph_lo = p; a.ph_hi = p + 1; hipLaunchKernelGGL(mega_fwd, dim3(grid), dim3(NWAVES * 64), LDS_BYTES, stream, a); }
        }
#else
        a.ph_lo = lo; a.ph_hi = hi;
        void* kargs[] = {(void*)&a};
        hipError_t e = hipLaunchCooperativeKernel((const void*)mega_fwd, dim3(grid), dim3(NWAVES * 64), kargs, LDS_BYTES, stream);
        if (e != hipSuccess) fprintf(stderr, "kernel_launch: cooperative launch failed: %s (grid %d)\n", hipGetErrorString(e), grid);
#endif
    };
    run(PH_P0, PH_COUNT);
}
```

```cpp
#include <hip/hip_runtime.h>
#include <cstdio>
#include <cstdint>

#ifndef MK_DUP_MASK
#define MK_DUP_MASK 0
#endif
#ifndef MK_GPROBE
#define MK_GPROBE 0
#endif
#ifndef MK_SHADOW
#define MK_SHADOW 0
#endif
#ifndef MK_FUSE_FINAL
#define MK_FUSE_FINAL 1
#endif
#ifndef MK_STAG
#define MK_STAG 0
#endif
#ifndef MK_NT
#define MK_NT 0x0
#endif
#ifndef MK_LEBITS
#define MK_LEBITS 6u
#endif
#ifndef MK_LOWENT
#define MK_LOWENT 3
#endif
#ifndef MK_PER_PHASE
#define MK_PER_PHASE 0
#endif

#define GAS __attribute__((address_space(1)))
#define LAS __attribute__((address_space(3)))
typedef _Float16 h16;
typedef _Float16 h16x8 __attribute__((ext_vector_type(8)));
typedef _Float16 h16x4 __attribute__((ext_vector_type(4)));
typedef _Float16 h16x2 __attribute__((ext_vector_type(2)));
typedef float f32x4 __attribute__((ext_vector_type(4)));
typedef float f32x2 __attribute__((ext_vector_type(2)));
typedef unsigned u32x4 __attribute__((ext_vector_type(4)));
typedef unsigned u32x2 __attribute__((ext_vector_type(2)));

constexpr int D = 1024, NB = 4, S = 8192, M = NB * S, DFF = 2816, NGU = 2 * DFF, NMOD = 9;
constexpr int AW = 512, HD = 64, NH = 8, INW = 2560, MBLK = 256, NBLK = S / MBLK, GC = 128;
constexpr float EPS = 1e-6f;
constexpr float C2 = 0.125f * 1.4426950408889634f;
constexpr int PQ = 0, PU = 512, PK = 1024, PV = 1536, PG = 2048;

constexpr size_t MiB = 1u << 20, KiB = 1u << 10;
constexpr size_t WS_CTL = 0, CTL_ZERO_BYTES = 1 * MiB;
constexpr size_t WS_MODP = 1 * MiB;
constexpr size_t WS_GT = 2 * MiB, WS_GP = WS_GT + 64 * KiB;
constexpr size_t WS_BIAS1 = WS_GT + 128 * KiB, WS_BIAS2 = WS_GT + 256 * KiB, WS_BIAS3 = WS_GT + 320 * KiB;
constexpr size_t WS_R1 = 3 * MiB, WS_RG = WS_R1 + 128 * KiB;
constexpr size_t WS_SSQA = 4 * MiB;
constexpr size_t WS_SSQ2 = 5 * MiB, WS_SSQ3 = 7 * MiB, WS_SSQF = 9 * MiB;
constexpr size_t WS_KMP = 11 * MiB;
constexpr size_t WS_ROPE = 12 * MiB;
constexpr size_t WS_WS16 = 14 * MiB;
constexpr size_t WS_WGU1 = 16 * MiB, WS_WD1 = 27 * MiB, WS_WIN = 33 * MiB, WS_WOUT = 38 * MiB, WS_WGU2 = 40 * MiB, WS_WD2 = 51 * MiB;
constexpr size_t WS_HG = 64 * MiB, WS_H = 128 * MiB, WS_ACT = 192 * MiB, WS_PROJ = WS_ACT;
constexpr size_t WS_LISTS = 368 * MiB, WS_END = 384 * MiB;
static_assert(WS_WD2 + (size_t)D * DFF * 2 <= WS_HG && WS_ACT + (size_t)M * DFF * 2 <= WS_LISTS, "ws map");
constexpr int CW_TMO = 0, CW_BAR = 4096;

constexpr int RING_BYTES = 131072, LDSCTL_OFF = RING_BYTES, MISC_OFF = LDSCTL_OFF + 320, LDS_BYTES = 163840;
constexpr int NWAVES = 8;

#define LDS_WAIT() asm volatile("s_waitcnt lgkmcnt(0)" ::: "memory")
#define VM_WAIT() asm volatile("s_waitcnt vmcnt(0)" ::: "memory")

__device__ __forceinline__ float wave_sum(float v) {
#pragma unroll
    for (int o = 1; o < 64; o <<= 1) v += __shfl_xor(v, o);
    return v;
}
template <int SEL, class T> __device__ __forceinline__ void st_stream(GAS T* p, const T& v) { if ((MK_NT >> SEL) & 1) __builtin_nontemporal_store(v, p); else *p = v; }
__device__ __forceinline__ unsigned pkh(float lo, float hi) { h16x2 v; v.x = (h16)lo; v.y = (h16)hi; return __builtin_bit_cast(unsigned, v); }
__device__ __forceinline__ float round8a(float x) { constexpr unsigned drop = 24u - MK_LEBITS; unsigned u = __float_as_uint(x); u += ((1u << (drop - 1)) - 1u) + ((u >> drop) & 1u); u &= ~((1u << drop) - 1u); return __uint_as_float(u); }
__device__ __forceinline__ unsigned pkh8(float lo, float hi) {
    unsigned w = pkh(lo, hi);
    if (MK_LOWENT & 2) { constexpr unsigned drop = 11u - MK_LEBITS; w = (w + (0x00010001u << (drop - 1))) & (0x00010001u * (0xFFFFu & ~((1u << drop) - 1u))); }
    return w;
}
__device__ __forceinline__ float silu_fast(float x) { return x * __builtin_amdgcn_rcpf(1.f + __builtin_amdgcn_exp2f(-1.4426950408889634f * x)); }
__device__ __forceinline__ float gelu_fast(float x) {
    const float u2 = 1.5957691216057308f * (x + 0.044715f * x * x * x);
    return x * __builtin_amdgcn_rcpf(1.f + __builtin_amdgcn_exp2f(-1.4426950408889634f * u2));
}
__device__ __forceinline__ float rs16p(const GAS float* p) {
    float t[16];
#pragma unroll
    for (int k = 0; k < 16; ++k) t[k] = p[(size_t)k * (4 * 8192)];
    const float a = ((t[0] + t[1]) + (t[2] + t[3])) + ((t[4] + t[5]) + (t[6] + t[7])), b = ((t[8] + t[9]) + (t[10] + t[11])) + ((t[12] + t[13]) + (t[14] + t[15]));
    return rsqrtf((a + b) * (1.f / 1024.f) + 1e-6f);
}
__device__ __forceinline__ float rs16(const GAS float* p) {
    const f32x4 s0 = *(const GAS f32x4*)(p), s1 = *(const GAS f32x4*)(p + 4), s2 = *(const GAS f32x4*)(p + 8), s3 = *(const GAS f32x4*)(p + 12);
    const f32x4 st = (s0 + s1) + (s2 + s3);
    return rsqrtf(((st[0] + st[1]) + (st[2] + st[3])) * (1.f / D) + EPS);
}


__device__ __forceinline__ size_t blk_off(int row, int k, int nt) { return (((size_t)(row >> 8) * nt + (k >> 6)) * 256 + (row & 255)) * 64 + (k & 63); }

namespace pg8 {
constexpr int BM = 256, BK = 64, HALF = 128, HTB = HALF * BK * 2, STAGE_BYTES = 8 * HTB, NXCD = 8, WGM = 8;
__host__ __device__ __forceinline__ int lds_byte(int r, int c) { const int st = (r >> 4) * 2 + (c >> 5), rr = r & 15, cc = c & 31, ob = rr * 64 + cc * 2; return st * 1024 + (ob ^ (((ob >> 9) & 1) << 5)); }
__host__ __device__ __forceinline__ void stage_rc(int b, int& R, int& C) { const int st = b / 1024, sb = b % 1024, swz = sb ^ (((sb >> 9) & 1) << 5); R = (st >> 1) * 16 + swz / 64; C = (st & 1) * 32 + (swz % 64) / 2; }
struct Unit { int pm, pn; };
struct Gemm { const GAS h16* A; const GAS h16* Bt; int lda, N, K; unsigned stag = 0; };
struct StaticOrder {
    int nM, nN, nwg, G, c;
    __device__ __forceinline__ void init(int M_, int N, int G_, int c_) { nM = M_ / BM; nN = N / BM; nwg = nM * nN; G = G_; c = c_; }
    __device__ __forceinline__ bool next(int i, Unit& u) const {
        const long L = (long)i * G + c; if (L >= nwg) return false;
        int wgid = (int)L; { const int q = nwg / NXCD, r = nwg % NXCD, xcd = wgid % NXCD, off = wgid / NXCD; wgid = (xcd < r ? xcd * (q + 1) : r * (q + 1) + (xcd - r) * q) + off; }
        const int nig = WGM * nN, gid = wgid / nig, fm = gid * WGM, gsz = (nM - fm) < WGM ? (nM - fm) : WGM;
        u.pm = fm + ((wgid % nig) % gsz); u.pn = (wgid % nig) / gsz; return true;
    }
};
struct TableOrder {
    const LAS int* tab; int n;
    __device__ __forceinline__ bool next(int i, Unit& u) const { if (i >= n) return false; u.pm = tab[2 * i]; u.pn = tab[2 * i + 1]; return true; }
};
__device__ __forceinline__ TableOrder make_table(const StaticOrder& So, LAS int* tab) {
    if (threadIdx.x < 16) { Unit u; u.pm = -1; u.pn = 0; const bool ok = So.next((int)threadIdx.x, u); tab[2 * threadIdx.x] = ok ? u.pm : -1; tab[2 * threadIdx.x + 1] = u.pn; }
    __syncthreads();
    int n = 0;
    while (n < 16 && tab[2 * n] >= 0) ++n;
    TableOrder T; T.tab = tab; T.n = __builtin_amdgcn_readfirstlane(n); return T;
}
template <class Epi, bool ALIGN_EPI, int PROBE = 0, class Order = StaticOrder>
__device__ __forceinline__ void gemm_phase(LAS unsigned char* lds, const Gemm g, const Order& S, const Epi& E) {
    const int tid = threadIdx.x, wid = __builtin_amdgcn_readfirstlane(tid >> 6), lane = tid & 63, wr = wid >> 2, wc = wid & 3, fr = lane & 15, fq = lane >> 4;
    const int K = g.K, nt = K / BK;
    unsigned voffA[2], voffB[2];
    const bool ablk = (g.lda == 0);
#pragma unroll
    for (int i = 0; i < 2; ++i) { int R, C; stage_rc(tid * 16 + i * 8192, R, C); voffA[i] = (unsigned)(R * (ablk ? BK : g.lda) + C) * 2u; voffB[i] = (unsigned)(R * BK + C) * 2u; }
    const size_t kstepB = (size_t)BM * BK * 2, kstepA = ablk ? kstepB : (size_t)(BK * 2);
    const size_t hstepB = (size_t)HALF * BK * 2, hstepA = ablk ? hstepB : (size_t)HALF * g.lda * 2;
    const size_t tstepB = (size_t)nt * kstepB, tstepA = ablk ? tstepB : 2 * hstepA;
    const unsigned ldsw = (unsigned)wid * 1024u;
    const int aoff = lds_byte(wr * 64 + fr, fq * 8), boff = lds_byte(wc * 32 + fr, fq * 8);
#define PG8_SA(b, h) (((b) * 2 + (h)) * HTB)
#define PG8_SB(b, h) ((4 + (b) * 2 + (h)) * HTB)
#define PG8_STAGE(bufoff, gbase, voff) do { if (PROBE != 2) _Pragma("unroll") for (int _i = 0; _i < 2; ++_i) \
        __builtin_amdgcn_global_load_lds((const unsigned*)((const char*)(gbase) + (voff)[_i]), (LAS unsigned*)(lds + (bufoff) + ldsw + _i * 8192), 16, 0, 0); } while (0)
#define PG8_LDA(dst, b, h) do { _Pragma("unroll") for (int m = 0; m < 4; ++m) _Pragma("unroll") for (int k = 0; k < 2; ++k) dst[m][k] = *(const LAS h16x8*)(lds + PG8_SA(b, h) + aoff + m * 2048 + k * 1024); } while (0)
#define PG8_LDB(dst, b, h) do { _Pragma("unroll") for (int n = 0; n < 2; ++n) _Pragma("unroll") for (int k = 0; k < 2; ++k) dst[n][k] = *(const LAS h16x8*)(lds + PG8_SB(b, h) + boff + n * 2048 + k * 1024); } while (0)
#define PG8_MMA(ai, bj, At, Bt) do { if (PROBE == 1 && (bj) == 1) break; __builtin_amdgcn_s_setprio(1); _Pragma("unroll") for (int m = 0; m < 4; ++m) _Pragma("unroll") for (int n = 0; n < 2; ++n) _Pragma("unroll") for (int k = 0; k < 2; ++k) \
        acc[ai][bj][m][n] = __builtin_amdgcn_mfma_f32_16x16x32_f16(Bt[n][k], At[m][k], acc[ai][bj][m][n], 0, 0, 0); __builtin_amdgcn_s_setprio(0); } while (0)
#define PG8_WAIT_V(n) asm volatile("s_waitcnt vmcnt(" #n ")" ::: "memory")
#define PG8_WAIT_L(n) asm volatile("s_waitcnt lgkmcnt(" #n ")" ::: "memory")
#define PG8_BAR __builtin_amdgcn_s_barrier()
#define PG8_SCHED __builtin_amdgcn_sched_barrier(0)
    Unit cur, nxt; int ui = 0;
    if (!S.next(0, cur)) return;
    if (g.stag) { const unsigned st = (unsigned)(cur.pm & 7); if (st) { const unsigned long long t0 = __builtin_amdgcn_s_memrealtime(), dl = (unsigned long long)st * g.stag; while (__builtin_amdgcn_s_memrealtime() - t0 < dl) __builtin_amdgcn_s_sleep(4); } }
    f32x4 acc[2][2][4][2];
#pragma unroll
    for (int a = 0; a < 2; ++a)
#pragma unroll
        for (int b = 0; b < 2; ++b)
#pragma unroll
            for (int m = 0; m < 4; ++m)
#pragma unroll
                for (int n = 0; n < 2; ++n) acc[a][b][m][n] = (f32x4){0.f, 0.f, 0.f, 0.f};
    h16x8 At[4][2], B0[2][2], B1[2][2];
    const char* cA = (const char*)g.A + (size_t)cur.pm * tstepA; const char* cB = (const char*)g.Bt + (size_t)cur.pn * tstepB;
    PG8_STAGE(PG8_SB(0, 0), cB, voffB); PG8_STAGE(PG8_SB(0, 1), cB + hstepB, voffB); PG8_STAGE(PG8_SA(0, 0), cA, voffA); PG8_STAGE(PG8_SA(0, 1), cA + hstepA, voffA);
    if (wr == 1) PG8_BAR;
    PG8_WAIT_V(2); PG8_BAR;
    PG8_STAGE(PG8_SB(1, 0), cB + kstepB, voffB); PG8_STAGE(PG8_SA(1, 0), cA + kstepA, voffA); PG8_STAGE(PG8_SB(1, 1), cB + hstepB + kstepB, voffB);
    PG8_WAIT_V(6); PG8_BAR;
    for (;;) {
        const bool has_next = S.next(ui + 1, nxt);
        const char* nA = has_next ? (const char*)g.A + (size_t)nxt.pm * tstepA : cA; const char* nB = has_next ? (const char*)g.Bt + (size_t)nxt.pn * tstepB : cB;
        for (int t = 0; t < nt; t += 2) {
            const bool last = (t == nt - 2);
            const char* a1 = cA + (size_t)(t + 1) * kstepA;
            const char* a2 = last ? nA : cA + (size_t)(t + 2) * kstepA; const char* b2 = last ? nB : cB + (size_t)(t + 2) * kstepB;
            const char* a3 = a2 + kstepA; const char* b3 = b2 + kstepB;
            if constexpr (Epi::MID) { if (t == nt / 2) E.mid(acc, cur, ui, wr, wc, fr, fq); }
            PG8_LDB(B0, 0, 0); PG8_LDB(B1, 0, 1); PG8_SCHED; PG8_LDA(At, 0, 0); PG8_STAGE(PG8_SA(1, 1), a1 + hstepA, voffA);
            PG8_WAIT_V(8); PG8_WAIT_L(0); PG8_BAR; PG8_MMA(0, 0, At, B0); PG8_MMA(0, 1, At, B1); PG8_BAR; PG8_SCHED;
            PG8_LDA(At, 0, 1); PG8_STAGE(PG8_SB(0, 0), b2, voffB); PG8_STAGE(PG8_SB(0, 1), b2 + hstepB, voffB); PG8_STAGE(PG8_SA(0, 0), a2, voffA);
            PG8_WAIT_V(8); PG8_WAIT_L(0); PG8_BAR; PG8_MMA(1, 0, At, B0); PG8_MMA(1, 1, At, B1); PG8_BAR; PG8_SCHED;
            PG8_LDB(B0, 1, 0); PG8_LDB(B1, 1, 1); PG8_SCHED; PG8_LDA(At, 1, 0); PG8_STAGE(PG8_SA(0, 1), a2 + hstepA, voffA);
            PG8_WAIT_V(8); PG8_WAIT_L(0); PG8_BAR; PG8_MMA(0, 0, At, B0); PG8_MMA(0, 1, At, B1); PG8_BAR; PG8_SCHED;
            PG8_LDA(At, 1, 1); PG8_STAGE(PG8_SB(1, 0), b3, voffB); PG8_STAGE(PG8_SB(1, 1), b3 + hstepB, voffB); PG8_STAGE(PG8_SA(1, 0), a3, voffA);
            PG8_WAIT_V(8); PG8_WAIT_L(0); PG8_BAR; PG8_MMA(1, 0, At, B0); PG8_MMA(1, 1, At, B1); PG8_BAR; PG8_SCHED;
        }
        if constexpr (ALIGN_EPI) { if (wr == 0) PG8_BAR; }
        E(acc, cur, ui, wr, wc, fr, fq);
        if (!has_next) break;
#pragma unroll
        for (int a = 0; a < 2; ++a)
#pragma unroll
            for (int b = 0; b < 2; ++b)
#pragma unroll
                for (int m = 0; m < 4; ++m)
#pragma unroll
                    for (int n = 0; n < 2; ++n) acc[a][b][m][n] = (f32x4){0.f, 0.f, 0.f, 0.f};
        cur = nxt; cA = nA; cB = nB; ++ui;
        if constexpr (ALIGN_EPI) { if (wr == 1) PG8_BAR; }
    }
    PG8_WAIT_V(0);
    if constexpr (!ALIGN_EPI) { if (wr == 0) PG8_BAR; }
    PG8_BAR;
#undef PG8_SA
#undef PG8_SB
#undef PG8_STAGE
#undef PG8_LDA
#undef PG8_LDB
#undef PG8_MMA
#undef PG8_WAIT_V
#undef PG8_WAIT_L
#undef PG8_BAR
#undef PG8_SCHED
}
}

typedef const f32x4 (&AccRef)[2][2][4][2];
struct EpiSwiglu {
    static constexpr bool MID = false;
    GAS h16* act; const LAS float* rtab; const GAS float* bias;
    __device__ __forceinline__ void mid(f32x4 (&)[2][2][4][2], const pg8::Unit&, int, int, int, int, int) const {}
    __device__ __forceinline__ void operator()(AccRef acc, const pg8::Unit& u, int ui, int wr, int wc, int fr, int fq) const {
        const int b = u.pm >> 5, row0 = u.pm * 256 + wr * 64 + fr;
        const GAS float* bp = bias + b * NGU + u.pn * 256 + wc * 32 + 4 * fq;
        f32x4 bv[2][2];
#pragma unroll
        for (int bj = 0; bj < 2; ++bj)
#pragma unroll
            for (int n = 0; n < 2; ++n) bv[bj][n] = *(const GAS f32x4*)(bp + bj * 128 + n * 16) * (bj ? -0.6931471805599453f : -1.4426950408889634f);
        const LAS float* rt = rtab + ui * 256 + wr * 64 + fr;
        const int hid0 = u.pn * 128 + wc * 32 + fq * 8;
#pragma unroll
        for (int ai = 0; ai < 2; ++ai)
#pragma unroll
            for (int m = 0; m < 4; ++m) {
                const int ro = ai * 128 + m * 16; const float rs = rt[ro], rsg = rs * -1.4426950408889634f, rsu = rs * -0.6931471805599453f;
                u32x4 w;
#pragma unroll
                for (int n = 0; n < 2; ++n) {
                    const f32x4 gq = acc[ai][0][m][n] * rsg + bv[0][n], uq = acc[ai][1][m][n] * rsu + bv[1][n];
                    float a4[4];
#pragma unroll
                    for (int e = 0; e < 4; ++e) a4[e] = (gq[e] * uq[e]) * __builtin_amdgcn_rcpf(1.f + __builtin_amdgcn_exp2f(gq[e]));
                    w[2 * n] = pkh8(a4[0], a4[1]); w[2 * n + 1] = pkh8(a4[2], a4[3]);
                }
                st_stream<3>((GAS u32x4*)(act + blk_off(row0 + ro, hid0, DFF / 64)), w);
            }
    }
};
struct EpiNull {
    static constexpr bool MID = false;
    __device__ __forceinline__ void mid(f32x4 (&)[2][2][4][2], const pg8::Unit&, int, int, int, int, int) const {}
    __device__ __forceinline__ void operator()(AccRef acc, const pg8::Unit& u, int ui, int wr, int wc, int fr, int fq) const {
#pragma unroll
        for (int ai = 0; ai < 2; ++ai)
#pragma unroll
            for (int bj = 0; bj < 2; ++bj)
#pragma unroll
                for (int m = 0; m < 4; ++m)
#pragma unroll
                    for (int n = 0; n < 2; ++n) asm volatile("" :: "v"(acc[ai][bj][m][n]));
    }
};
template <bool RES_F32, bool TWOSCALE, bool WRITE_HG, int PVAR = 0> struct EpiResid {
    static constexpr bool MID = TWOSCALE;
    const GAS float* xres; GAS h16* H; GAS h16* HG; const GAS float* cs; const GAS float* gp; GAS float* ssq; const LAS float* sct; float cmul;
    __device__ __forceinline__ void mid(f32x4 (&acc)[2][2][4][2], const pg8::Unit& u, int ui, int wr, int wc, int fr, int fq) const {
        if constexpr (TWOSCALE) {
            const LAS float* t = sct + ui * 512 + wr * 64 + fr;
#pragma unroll
            for (int ai = 0; ai < 2; ++ai)
#pragma unroll
                for (int m = 0; m < 4; ++m) { const float f = t[ai * 128 + m * 16];
#pragma unroll
                    for (int bj = 0; bj < 2; ++bj)
#pragma unroll
                        for (int n = 0; n < 2; ++n) acc[ai][bj][m][n] *= f; }
        }
    }
    __device__ __forceinline__ void operator()(AccRef acc, const pg8::Unit& u, int ui, int wr, int wc, int fr, int fq) const {
        const int b = u.pm >> 5, row0 = u.pm * 256 + wr * 64 + fr, col0 = u.pn * 256 + wc * 32 + 8 * fq;
        f32x4 csv[2][2], gpv[2][2];
#pragma unroll
        for (int bj = 0; bj < 2; ++bj)
#pragma unroll
            for (int n = 0; n < 2; ++n) { csv[bj][n] = *(const GAS f32x4*)(cs + b * D + col0 + bj * 128 + 4 * n) * cmul; if constexpr (WRITE_HG) gpv[bj][n] = *(const GAS f32x4*)(gp + b * D + col0 + bj * 128 + 4 * n); }
        constexpr int MB_ = RES_F32 ? 2 : 4;
        float qs[8];
#pragma unroll
        for (int ai = 0; ai < 2; ++ai)
#pragma unroll
        for (int m0 = 0; m0 < 4; m0 += MB_) {
            f32x4 rf[4][2][2]; h16x8 rh[4][2];
#pragma unroll
            for (int m = m0; m < m0 + MB_; ++m)
#pragma unroll
                for (int bj = 0; bj < 2; ++bj) { const size_t off = (size_t)(row0 + ai * 128 + m * 16) * D + col0 + bj * 128;
                    if constexpr (PVAR == 2 || PVAR == 6 || PVAR == 7) { rf[m][bj][0] = (f32x4){0.f, 0.f, 0.f, 0.f}; rf[m][bj][1] = rf[m][bj][0]; rh[m][bj] = (h16x8){0, 0, 0, 0, 0, 0, 0, 0}; }
                    else if constexpr (PVAR == 3) { const h16x8 t = *(const GAS h16x8*)(HG + blk_off(row0 + ai * 128 + m * 16, col0 + bj * 128, D / 64)); rf[m][bj][0] = (f32x4){(float)t[0], (float)t[1], (float)t[2], (float)t[3]}; rf[m][bj][1] = (f32x4){(float)t[4], (float)t[5], (float)t[6], (float)t[7]}; }
                    else if constexpr (RES_F32) { rf[m][bj][0] = *(const GAS f32x4*)(xres + off); rf[m][bj][1] = *(const GAS f32x4*)(xres + off + 4); }
                    else rh[m][bj] = *(const GAS h16x8*)(H + off); }
            asm volatile("" ::: "memory");
#pragma unroll
            for (int m = m0; m < m0 + MB_; ++m) {
                const int row = row0 + ai * 128 + m * 16; const size_t off = (size_t)row * D + col0;
                float rsc = 1.f; if constexpr (TWOSCALE) rsc = sct[ui * 512 + 256 + wr * 64 + fr + ai * 128 + m * 16];
                float q = 0.f;
#pragma unroll
                for (int bj = 0; bj < 2; ++bj) {
                    f32x4 r0, r1;
                    if constexpr (RES_F32) { r0 = rf[m][bj][0]; r1 = rf[m][bj][1]; }
                    else { const h16x8 hv = rh[m][bj]; r0 = (f32x4){(float)hv[0], (float)hv[1], (float)hv[2], (float)hv[3]}; r1 = (f32x4){(float)hv[4], (float)hv[5], (float)hv[6], (float)hv[7]}; }
                    const f32x4 v0 = r0 + csv[bj][0] * (acc[ai][bj][m][0] * rsc), v1 = r1 + csv[bj][1] * (acc[ai][bj][m][1] * rsc);
                    q += ((v0[0] * v0[0] + v0[1] * v0[1]) + (v0[2] * v0[2] + v0[3] * v0[3])) + ((v1[0] * v1[0] + v1[1] * v1[1]) + (v1[2] * v1[2] + v1[3] * v1[3]));
                    u32x4 w; w[0] = pkh(v0[0], v0[1]); w[1] = pkh(v0[2], v0[3]); w[2] = pkh(v1[0], v1[1]); w[3] = pkh(v1[2], v1[3]);
                    const int colp = u.pn * 256 + wc * 64 + 16 * fq + 8 * bj;
                    if constexpr (PVAR == 1) asm volatile("" :: "v"(w)); else if constexpr (PVAR == 4) *(GAS u32x4*)(H + blk_off(row, col0 + bj * 128, D / 64)) = w;
                    else if constexpr (PVAR == 5) *(GAS u32x4*)(H + (size_t)row * D + colp) = w; else if constexpr (PVAR == 7) __builtin_nontemporal_store(w, (GAS u32x4*)(H + off + bj * 128)); else st_stream<1>((GAS u32x4*)(H + off + bj * 128), w);
                    if constexpr (WRITE_HG) { const f32x4 g0 = v0 * gpv[bj][0], g1 = v1 * gpv[bj][1];
                        u32x4 wg;
                        if constexpr (TWOSCALE) { wg[0] = pkh8(g0[0], g0[1]); wg[1] = pkh8(g0[2], g0[3]); wg[2] = pkh8(g1[0], g1[1]); wg[3] = pkh8(g1[2], g1[3]); }
                        else { wg[0] = pkh(g0[0], g0[1]); wg[1] = pkh(g0[2], g0[3]); wg[2] = pkh(g1[0], g1[1]); wg[3] = pkh(g1[2], g1[3]); }
                        if constexpr (PVAR == 1 || PVAR == 6) asm volatile("" :: "v"(wg)); else if constexpr (PVAR == 7) __builtin_nontemporal_store(wg, (GAS u32x4*)(HG + blk_off(row, col0 + bj * 128, D / 64))); else if constexpr (PVAR == 5) *(GAS u32x4*)(HG + blk_off(row, colp, D / 64)) = wg; else st_stream<2>((GAS u32x4*)(HG + blk_off(row, col0 + bj * 128, D / 64)), wg); }
                }
                q += __shfl_xor(q, 16); q += __shfl_xor(q, 32);
                qs[ai * 4 + m] = q;
            }
        }
        if constexpr (PVAR != 1) {
            const float qa = fq == 0 ? qs[0] : fq == 1 ? qs[2] : fq == 2 ? qs[4] : qs[6], qb = fq == 0 ? qs[1] : fq == 1 ? qs[3] : fq == 2 ? qs[5] : qs[7];
            GAS float* sp = ssq + (size_t)(u.pn * 4 + wc) * M + row0 + (fq >> 1) * 128 + (fq & 1) * 32;
            sp[0] = qa; sp[16] = qb;
        }
    }
};
constexpr int CW_PAN = 16384;
struct EpiFinal {
    static constexpr bool MID = false;
    const GAS h16* H; const GAS float* cs; const GAS float* gfin; GAS float* out; unsigned* xs; unsigned* cnt; unsigned* tmo; LAS float* P; LAS float* Sx; float cmul;
    __device__ __forceinline__ void mid(f32x4 (&)[2][2][4][2], const pg8::Unit&, int, int, int, int, int) const {}
    __device__ __forceinline__ void operator()(f32x4 (&acc)[2][2][4][2], const pg8::Unit& u, int ui, int wr, int wc, int fr, int fq) const {
        const int b = u.pm >> 5, row0 = u.pm * 256 + wr * 64 + fr, col0 = u.pn * 256 + wc * 32 + 8 * fq;
        const int tid = threadIdx.x, lane = tid & 63, wid = __builtin_amdgcn_readfirstlane(tid >> 6);
        f32x4 csv[2][2];
#pragma unroll
        for (int bj = 0; bj < 2; ++bj)
#pragma unroll
            for (int n = 0; n < 2; ++n) csv[bj][n] = *(const GAS f32x4*)(cs + b * D + col0 + bj * 128 + 4 * n) * cmul;
#pragma unroll
        for (int ai = 0; ai < 2; ++ai) {
            h16x8 rh[4][2];
#pragma unroll
            for (int m = 0; m < 4; ++m)
#pragma unroll
                for (int bj = 0; bj < 2; ++bj) rh[m][bj] = *(const GAS h16x8*)(H + (size_t)(row0 + ai * 128 + m * 16) * D + col0 + bj * 128);
#pragma unroll
            for (int m = 0; m < 4; ++m) {
                float q = 0.f;
#pragma unroll
                for (int bj = 0; bj < 2; ++bj) { const h16x8 hv = rh[m][bj];
                    const f32x4 v0 = (f32x4){(float)hv[0], (float)hv[1], (float)hv[2], (float)hv[3]} + csv[bj][0] * acc[ai][bj][m][0], v1 = (f32x4){(float)hv[4], (float)hv[5], (float)hv[6], (float)hv[7]} + csv[bj][1] * acc[ai][bj][m][1];
                    acc[ai][bj][m][0] = v0; acc[ai][bj][m][1] = v1;
                    q += ((v0[0] * v0[0] + v0[1] * v0[1]) + (v0[2] * v0[2] + v0[3] * v0[3])) + ((v1[0] * v1[0] + v1[1] * v1[1]) + (v1[2] * v1[2] + v1[3] * v1[3])); }
                q += __shfl_xor(q, 16); q += __shfl_xor(q, 32);
                if (fq == 0) P[(ai * 128 + wr * 64 + m * 16 + fr) * 4 + wc] = q;
            }
        }
        asm volatile("s_waitcnt lgkmcnt(0)" ::: "memory"); __builtin_amdgcn_s_barrier(); asm volatile("" ::: "memory");
        if (tid < 256) {
            const f32x4 p4 = *(const LAS f32x4*)(P + tid * 4);
            __hip_atomic_store(xs + ((size_t)(u.pm * 256 + tid) * 4 + u.pn), __float_as_uint((p4[0] + p4[1]) + (p4[2] + p4[3])), __ATOMIC_RELAXED, __HIP_MEMORY_SCOPE_AGENT);
        }
        asm volatile("s_waitcnt vmcnt(0)" ::: "memory");
        if (wid < 4 && lane == 0) __hip_atomic_fetch_add(cnt + 64 * u.pm, 1u, __ATOMIC_RELAXED, __HIP_MEMORY_SCOPE_AGENT);
        if (wid == 0) {
            unsigned sp = 0u;
            while ((unsigned)__builtin_amdgcn_readfirstlane(__hip_atomic_load(cnt + 64 * u.pm, __ATOMIC_RELAXED, __HIP_MEMORY_SCOPE_AGENT)) < 16u) {
                __builtin_amdgcn_s_sleep(2);
                if (++sp > (1u << 16)) { if (lane == 0) __hip_atomic_store(tmo, 1u, __ATOMIC_RELAXED, __HIP_MEMORY_SCOPE_AGENT); break; }
            }
            __builtin_amdgcn_fence(__ATOMIC_ACQUIRE, "agent");
        }
        asm volatile("s_waitcnt vmcnt(0) lgkmcnt(0)" ::: "memory"); __builtin_amdgcn_s_barrier(); asm volatile("" ::: "memory");
        if (tid < 256) {
            const unsigned* sl = xs + (size_t)(u.pm * 256 + tid) * 4;
            const float s0 = __uint_as_float(__hip_atomic_load(sl + 0, __ATOMIC_RELAXED, __HIP_MEMORY_SCOPE_AGENT)), s1 = __uint_as_float(__hip_atomic_load(sl + 1, __ATOMIC_RELAXED, __HIP_MEMORY_SCOPE_AGENT)),
                        s2 = __uint_as_float(__hip_atomic_load(sl + 2, __ATOMIC_RELAXED, __HIP_MEMORY_SCOPE_AGENT)), s3 = __uint_as_float(__hip_atomic_load(sl + 3, __ATOMIC_RELAXED, __HIP_MEMORY_SCOPE_AGENT));
            Sx[tid] = rsqrtf(((s0 + s1) + (s2 + s3)) * (1.f / D) + EPS);
        }
        asm volatile("s_waitcnt vmcnt(0) lgkmcnt(0)" ::: "memory"); __builtin_amdgcn_s_barrier(); asm volatile("" ::: "memory");
        f32x4 gv[2][2];
#pragma unroll
        for (int bj = 0; bj < 2; ++bj)
#pragma unroll
            for (int n = 0; n < 2; ++n) gv[bj][n] = *(const GAS f32x4*)(gfin + col0 + bj * 128 + 4 * n);
#pragma unroll
        for (int ai = 0; ai < 2; ++ai)
#pragma unroll
            for (int m = 0; m < 4; ++m) { const int rl = ai * 128 + wr * 64 + m * 16 + fr; const float rs = Sx[rl]; GAS float* op = out + (size_t)(u.pm * 256 + rl) * D + col0;
#pragma unroll
                for (int bj = 0; bj < 2; ++bj) { st_stream<0>((GAS f32x4*)(op + bj * 128), acc[ai][bj][m][0] * rs * gv[bj][0]); st_stream<0>((GAS f32x4*)(op + bj * 128 + 4), acc[ai][bj][m][1] * rs * gv[bj][1]); } }
        asm volatile("s_waitcnt lgkmcnt(0)" ::: "memory"); __builtin_amdgcn_s_barrier(); asm volatile("" ::: "memory");
    }
};
struct EpiInproj {
    static constexpr bool MID = false;
    GAS h16* proj; const LAS float* rtab; const GAS float* bias; const GAS float* rope; GAS float* kmp;
    __device__ __forceinline__ void mid(f32x4 (&)[2][2][4][2], const pg8::Unit&, int, int, int, int, int) const {}
    __device__ __forceinline__ void operator()(AccRef acc, const pg8::Unit& u, int ui, int wr, int wc, int fr, int fq) const {
        const int b = u.pm >> 5, row0 = u.pm * 256 + wr * 64 + fr, region = u.pn >> 1;
        const GAS float* bp = bias + b * INW + u.pn * 256 + wc * 32 + 4 * fq;
        f32x4 bv[2][2];
#pragma unroll
        for (int bj = 0; bj < 2; ++bj)
#pragma unroll
            for (int n = 0; n < 2; ++n) bv[bj][n] = *(const GAS f32x4*)(bp + bj * 128 + n * 16);
        const bool is_rope = (region == 0) || (region == 2);
        f32x4 csum[2][2];
#pragma unroll
        for (int bj = 0; bj < 2; ++bj)
#pragma unroll
            for (int n = 0; n < 2; ++n) csum[bj][n] = (f32x4){0.f, 0.f, 0.f, 0.f};
        const LAS float* rt = rtab + ui * 256 + wr * 64 + fr;
#pragma unroll
        for (int ai = 0; ai < 2; ++ai)
#pragma unroll
        for (int m0 = 0; m0 < 4; m0 += 2) {
            f32x4 rcs[4][2], rsn[4][2];
            if (is_rope) {
#pragma unroll
                for (int m = m0; m < m0 + 2; ++m) { const GAS float* rp = rope + (size_t)((row0 + ai * 128 + m * 16) & (S - 1)) * 64 + 4 * fq;
#pragma unroll
                    for (int n = 0; n < 2; ++n) { rcs[m][n] = *(const GAS f32x4*)(rp + 16 * n); rsn[m][n] = *(const GAS f32x4*)(rp + 32 + 16 * n); } }
            }
            asm volatile("" ::: "memory");
#pragma unroll
            for (int m = m0; m < m0 + 2; ++m) {
                const int row = row0 + ai * 128 + m * 16;
                const float rs = rt[ai * 128 + m * 16];
                f32x4 v[2][2];
#pragma unroll
                for (int bj = 0; bj < 2; ++bj)
#pragma unroll
                    for (int n = 0; n < 2; ++n) v[bj][n] = acc[ai][bj][m][n] * rs + bv[bj][n];
                GAS h16* prow = proj + (size_t)row * INW + region * 512 + (u.pn & 1) * 256;
                if (is_rope) {
                    const float qs = (region == 0) ? C2 : 1.f;
#pragma unroll
                    for (int n = 0; n < 2; ++n) {
                        const f32x4 cs4 = rcs[m][n] * qs, sn4 = rsn[m][n] * qs;
                        const f32x4 x1 = v[0][n], x2 = v[1][n];
                        v[0][n] = x1 * cs4 - x2 * sn4; v[1][n] = x2 * cs4 + x1 * sn4;
                    }
                    GAS h16* hp = prow + wc * 64 + 16 * fq;
#pragma unroll
                    for (int bj = 0; bj < 2; ++bj) { u32x4 w; w[0] = pkh(v[bj][0][0], v[bj][0][1]); w[1] = pkh(v[bj][0][2], v[bj][0][3]); w[2] = pkh(v[bj][1][0], v[bj][1][1]); w[3] = pkh(v[bj][1][2], v[bj][1][3]);
                        st_stream<4>((GAS u32x4*)(hp + 8 * bj), w); }
                    if (region == 2) {
#pragma unroll
                        for (int bj = 0; bj < 2; ++bj)
#pragma unroll
                            for (int n = 0; n < 2; ++n) csum[bj][n] += v[bj][n];
                    }
                } else {
                    if (region == 1 || region == 4) {
#pragma unroll
                        for (int bj = 0; bj < 2; ++bj)
#pragma unroll
                            for (int n = 0; n < 2; ++n)
#pragma unroll
                                for (int j = 0; j < 4; ++j) v[bj][n][j] = gelu_fast(v[bj][n][j]);
                    }
                    GAS h16* hp = prow + wc * 32 + 8 * fq;
#pragma unroll
                    for (int bj = 0; bj < 2; ++bj) { u32x4 w; w[0] = pkh(v[bj][0][0], v[bj][0][1]); w[1] = pkh(v[bj][0][2], v[bj][0][3]); w[2] = pkh(v[bj][1][0], v[bj][1][1]); w[3] = pkh(v[bj][1][2], v[bj][1][3]);
                        st_stream<4>((GAS u32x4*)(hp + 128 * bj), w); }
                }
            }
        }
        if (region == 2) {
#pragma unroll
            for (int bj = 0; bj < 2; ++bj)
#pragma unroll
                for (int n = 0; n < 2; ++n)
#pragma unroll
                    for (int j = 0; j < 4; ++j) { float t = csum[bj][n][j]; t += __shfl_xor(t, 1); t += __shfl_xor(t, 2); t += __shfl_xor(t, 4); t += __shfl_xor(t, 8); csum[bj][n][j] = t; }
            if (fr == 0) {
                GAS float* kp = kmp + ((size_t)((b * NBLK + (u.pm & 31)) * 2 + wr)) * 512 + ((u.pn & 1) * 4 + wc) * 64 + 16 * fq;
#pragma unroll
                for (int bj = 0; bj < 2; ++bj)
#pragma unroll
                    for (int n = 0; n < 2; ++n) *(GAS f32x4*)(kp + 8 * bj + 4 * n) = csum[bj][n];
            }
        }
    }
};

#define XB_TMO      128
#define XB_XCNT(j)  (256  + 64 * (j))
#define XB_XSUB(j)  (1280 + 64 * (j))
#define XB_XGEN(j)  (2304 + 64 * (j))
#define XB_TOP      3328
#define XB_TOPGEN   3392
#define XCD_BAR_WORDS 3456
#define XB_SPIN_CAP (1u << 18)
__device__ __forceinline__ unsigned xb_ld(unsigned* p)              { return __hip_atomic_load(p, __ATOMIC_RELAXED, __HIP_MEMORY_SCOPE_AGENT); }
__device__ __forceinline__ unsigned xb_add(unsigned* p, unsigned v) { return __hip_atomic_fetch_add(p, v, __ATOMIC_RELAXED, __HIP_MEMORY_SCOPE_AGENT); }
__device__ __forceinline__ unsigned xb_xcc_id() { return (unsigned)__builtin_amdgcn_s_getreg((3 << 11) | 20) & 0xFu; }
#define XB_SPIN(cond, bar) do { unsigned _sp = 0; while (cond) { __builtin_amdgcn_s_sleep(1); \
    if ((++_sp & 255u) == 0u) { if (xb_ld(&(bar)[XB_TMO])) break; if (_sp > XB_SPIN_CAP) { atomicAdd(&(bar)[XB_TMO], 1u); break; } } } } while (0)
struct XcdBarrier { unsigned* bar; unsigned x; volatile LAS unsigned* st; };
__device__ __forceinline__ XcdBarrier xcd_barrier_post(unsigned* bar, volatile LAS unsigned* st) {
    XcdBarrier b; b.bar = bar; b.x = xb_xcc_id(); b.st = st;
    if (threadIdx.x == 0) (void)xb_add(&bar[XB_XCNT(b.x)], 1u);
    return b;
}
__device__ __forceinline__ void xcd_barrier_complete(unsigned* bar, unsigned x, unsigned& nloc, unsigned& nx) {
    const unsigned G = gridDim.x * gridDim.y * gridDim.z;
    unsigned sum, cnt, mine, sp = 0u;
    for (;;) {
        sum = 0u; cnt = 0u; mine = 0u;
#pragma unroll
        for (unsigned j = 0; j < 16; ++j) { const unsigned c = xb_ld(&bar[XB_XCNT(j)]); sum += c; cnt += (c > 0u) ? 1u : 0u; mine = (j == x) ? c : mine; }
        if (sum == G) break;
        __builtin_amdgcn_s_sleep(1);
        if ((++sp & 255u) == 0u) { if (xb_ld(&bar[XB_TMO])) break; if (sp > XB_SPIN_CAP) { atomicAdd(&bar[XB_TMO], 1u); break; } }
    }
    nloc = mine > 0u ? mine : 1u; nx = cnt > 0u ? cnt : 1u;
}
__device__ __forceinline__ void xcd_barrier(const XcdBarrier& b) {
    asm volatile("s_waitcnt vmcnt(0)" ::: "memory");
    __syncthreads();
    if (threadIdx.x == 0) {
        unsigned* bar = b.bar;
        __builtin_amdgcn_s_waitcnt(0);
        unsigned nloc = b.st[0], nx = b.st[1];
        if (nloc == 0u) { xcd_barrier_complete(bar, b.x, nloc, nx); b.st[0] = nloc; b.st[1] = nx; }
        const unsigned old = xb_add(&bar[XB_XSUB(b.x)], 1u);
        const unsigned gen = old / nloc;
        if (old + 1u == (gen + 1u) * nloc) {
            __builtin_amdgcn_fence(__ATOMIC_RELEASE, "agent");
            asm volatile("s_waitcnt vmcnt(0)" ::: "memory");
            const unsigned og = xb_add(&bar[XB_TOP], 1u);
            const unsigned tg = og / nx;
            if (og + 1u == (tg + 1u) * nx) xb_add(&bar[XB_TOPGEN], 1u);
            else XB_SPIN(xb_ld(&bar[XB_TOPGEN]) == tg, bar);
            __builtin_amdgcn_fence(__ATOMIC_ACQUIRE, "agent");
            xb_add(&bar[XB_XGEN(b.x)], 1u);
            asm volatile("s_waitcnt vmcnt(0)" ::: "memory");
        } else {
            XB_SPIN(xb_ld(&bar[XB_XGEN(b.x)]) == gen, bar);
            __builtin_amdgcn_fence(__ATOMIC_ACQUIRE, "agent");
            asm volatile("s_waitcnt vmcnt(0)" ::: "memory");
        }
    }
    __syncthreads();
}

#define GIN(a_, i_) ((const GAS float*)(a_).in[i_])
struct Args { const float* in[20]; float* out; unsigned char* ws; int ph_lo, ph_hi; int shadow, pad; };
struct Frame {
    LAS unsigned char* lds; volatile LAS unsigned* MISC; unsigned* ctl;
    int tid, lane, wave, vcu, G;
    unsigned char* ws; GAS float* out;
};

__device__ __forceinline__ float round8(float x) { return round8a(x); }
__device__ __forceinline__ int p8(int l) { return (l & ~31) + 16 * ((l >> 2) & 1) + 4 * ((l >> 3) & 3) + (l & 3); }
__device__ __forceinline__ int phys_gu(int L) { const int isu = L >= DFF, hid = isu ? L - DFF : L, pn = hid >> 7, hh = hid & 127; return 256 * pn + 128 * isu + p8(hh); }
__device__ __forceinline__ int phys_in(int L) {
    const int reg = L >> 9, l = L & 511;
    const int preg = reg == 0 ? 0 : reg == 1 ? 2 : reg == 2 ? 3 : reg == 3 ? 1 : 4;
    if (reg <= 1) { const int head = l >> 6, d = l & 63, bj = d >> 5, i = d & 31; return 512 * preg + 256 * (head >> 2) + 128 * bj + 32 * (head & 3) + i; }
    return 512 * preg + p8(l);
}
enum PhysKind { PH_GU = 0, PH_P8 = 1, PH_IN = 2 };
template <int KIND> __device__ __forceinline__ int physmap(int L) { return KIND == PH_GU ? phys_gu(L) : KIND == PH_P8 ? p8(L) : phys_in(L); }

template <int KIND, bool LOWENT = false> __device__ __forceinline__ void p0_transpose_item(const GAS float* W, int K, int N, GAS h16* WT, const GAS float* kscale, LAS float* scr, int item, int lane) {
    const int nblk = N / 32, kb = item / nblk, nb = item % nblk, k0 = 64 * kb, n0 = 32 * nb;
    float wv[32];
#pragma unroll
    for (int i = 0; i < 32; ++i) { const int kk = 2 * i + (lane >> 5); wv[i] = W[(size_t)(k0 + kk) * N + n0 + (lane & 31)]; }
    if (kscale) {
#pragma unroll
        for (int i = 0; i < 32; ++i) wv[i] *= kscale[k0 + 2 * i + (lane >> 5)]; }
#pragma unroll
    for (int i = 0; i < 32; ++i) scr[(2 * i + (lane >> 5)) * 33 + (lane & 31)] = (LOWENT && MK_LOWENT) ? round8(wv[i]) : wv[i];
    LDS_WAIT(); asm volatile("" ::: "memory");
    const int c = lane & 7;
#pragma unroll
    for (int j = 0; j < 4; ++j) { const int n = (lane >> 3) + 8 * j; const LAS float* s = scr + (8 * c) * 33 + n;
        u32x4 o; o.x = pkh(s[0 * 33], s[1 * 33]); o.y = pkh(s[2 * 33], s[3 * 33]); o.z = pkh(s[4 * 33], s[5 * 33]); o.w = pkh(s[6 * 33], s[7 * 33]);
        *(GAS u32x4*)(WT + blk_off(physmap<KIND>(n0 + n), k0 + 8 * c, K / 64)) = o; }
    LDS_WAIT(); asm volatile("" ::: "memory");
}

__device__ __forceinline__ void p0_prologue(const Frame& F0, const Args& a) {
    Frame F = F0; F.tid = threadIdx.x; F.lane = F.tid & 63; F.wave = __builtin_amdgcn_readfirstlane(F.tid >> 6);
    const GAS float* c = GIN(a, 1); const GAS float* w_ada = GIN(a, 2);
    {
        LAS float* red = (LAS float*)F.lds;
        for (int item = F.vcu; item < 72 * 4; item += F.G) {
            const int cg = item % 72, kq = item / 72, hlf = F.lane >> 5, col = cg * 128 + (F.lane & 31) * 4;
            f32x4 acc[4] = {{0.f, 0.f, 0.f, 0.f}, {0.f, 0.f, 0.f, 0.f}, {0.f, 0.f, 0.f, 0.f}, {0.f, 0.f, 0.f, 0.f}};
            const int kbase = kq * 256 + F.wave * 32 + hlf;
#pragma unroll
            for (int i = 0; i < 16; ++i) { const int k = kbase + 2 * i; const f32x4 w4 = *(const GAS f32x4*)(w_ada + (size_t)k * (NMOD * D) + col);
#pragma unroll
                for (int b = 0; b < 4; ++b) { const float cv = c[b * D + k]; const float sv = cv / (1.f + __expf(-cv)); acc[b] += w4 * sv; } }
#pragma unroll
            for (int b = 0; b < 4; ++b)
#pragma unroll
                for (int j = 0; j < 4; ++j) acc[b][j] += __shfl_xor(acc[b][j], 32);
            if (hlf == 0) {
#pragma unroll
                for (int b = 0; b < 4; ++b) *(LAS f32x4*)(red + (F.wave * 4 + b) * 128 + (F.lane & 31) * 4) = acc[b];
            }
            __syncthreads();
            { const int b = F.tid >> 7, cc = F.tid & 127; float s = 0.f;
#pragma unroll
              for (int w = 0; w < 8; ++w) s += red[(w * 4 + b) * 128 + cc];
              ((GAS float*)(F.ws + WS_MODP))[(size_t)(kq * 4 + b) * (NMOD * D) + cg * 128 + cc] = s; }
            __syncthreads();
        }
    }
    LAS float* scr = (LAS float*)(F.lds + F.wave * 16384);
    const int gw = F.vcu * NWAVES + F.wave, NGW = F.G * NWAVES;
    constexpr int I_GU = (D / 64) * (NGU / 32), I_DN = (DFF / 64) * (D / 32), I_IN = (D / 64) * (INW / 32), I_OUT = (D / 64) * (D / 32);
    constexpr int NITEMS = 2 * I_GU + 2 * I_DN + I_IN + I_OUT;
    for (int it = gw; it < NITEMS; it += NGW) {
        int r = it;
        if (r < I_GU) { p0_transpose_item<PH_GU, true>(GIN(a, 5), D, NGU, (GAS h16*)(F.ws + WS_WGU1), nullptr, scr, r, F.lane); continue; } r -= I_GU;
        if (r < I_GU) { p0_transpose_item<PH_GU, true>(GIN(a, 17), D, NGU, (GAS h16*)(F.ws + WS_WGU2), nullptr, scr, r, F.lane); continue; } r -= I_GU;
        if (r < I_DN) { p0_transpose_item<PH_P8, true>(GIN(a, 6), DFF, D, (GAS h16*)(F.ws + WS_WD1), nullptr, scr, r, F.lane); continue; } r -= I_DN;
        if (r < I_DN) { p0_transpose_item<PH_P8, true>(GIN(a, 18), DFF, D, (GAS h16*)(F.ws + WS_WD2), nullptr, scr, r, F.lane); continue; } r -= I_DN;
        if (r < I_IN) { p0_transpose_item<PH_IN>(GIN(a, 8), D, INW, (GAS h16*)(F.ws + WS_WIN), nullptr, scr, r, F.lane); continue; } r -= I_IN;
        {
            const int kb = r / (D / 32); const GAS float* ks = (kb < 8) ? GIN(a, 13) : (GIN(a, 14) - 512);
            p0_transpose_item<PH_P8>(GIN(a, 15), D, D, (GAS h16*)(F.ws + WS_WOUT), ks, scr, r, F.lane); }
    }
    for (int pos = gw; pos < S; pos += NGW) {
        const int i = F.lane & 31;
        const float inv = (float)exp(-(double)i / 32.0 * 9.210340371976184);
        const float ang = (float)pos * inv;
        const double da = (double)ang;
        ((GAS float*)(F.ws + WS_ROPE))[(size_t)pos * 64 + F.lane] = (F.lane < 32) ? (float)cos(da) : (float)sin(da);
    }
    for (int e = gw * 64 + F.lane; e < NH * GC * GC; e += NGW * 64) { const int t = (e >> 7) & 127, s = e & 127; ((GAS h16*)(F.ws + WS_WS16))[e] = (s <= t) ? (h16)GIN(a, 11)[e] : (h16)0.f; }
}

__device__ __forceinline__ void p1_prep(const Frame& F0, const Args& a) {
    Frame F = F0; F.tid = threadIdx.x; F.lane = F.tid & 63; F.wave = __builtin_amdgcn_readfirstlane(F.tid >> 6);
    LAS float* modl = (LAS float*)F.lds;
    const GAS float* modp = (const GAS float*)(F.ws + WS_MODP); const GAS float* b_ada = GIN(a, 3);
    const size_t st = (size_t)4 * NMOD * D;
    for (int e = F.tid; e < 4 * 6 * D; e += NWAVES * 64) {
        const int b = e / (6 * D), sl = (e / D) % 6, k = e % D; const int mi = (sl < 3) ? 3 * sl : 3 * (sl - 3) + 1;
        const size_t o = (size_t)b * (NMOD * D) + mi * D + k;
        modl[e] = ((modp[o] + modp[o + st]) + (modp[o + 2 * st] + modp[o + 3 * st])) + b_ada[mi * D + k];
    }
    __syncthreads();
    if (F.vcu == 0) {
        GAS float* GT = (GAS float*)(F.ws + WS_GT); GAS float* GP = (GAS float*)(F.ws + WS_GP);
        for (int e = F.tid; e < 3 * 4 * D; e += NWAVES * 64) {
            const int j = e / (4 * D), b = (e / D) % 4, k = e % D; const int mi = 3 * j + 2;
            const size_t o = (size_t)b * (NMOD * D) + mi * D + k;
            GT[e] = ((modp[o] + modp[o + st]) + (modp[o + 2 * st] + modp[o + 3 * st])) + b_ada[mi * D + k];
            const GAS float* g = j == 0 ? GIN(a, 4) : j == 1 ? GIN(a, 7) : GIN(a, 16);
            GP[e] = g[k] * (1.f + modl[(b * 6 + 3 + j) * D + k]);
        }
    }
    const GAS float* x = GIN(a, 0); const GAS float* g1 = GIN(a, 4);
    GAS h16* XG = (GAS h16*)(F.ws + WS_HG); GAS float* R1 = (GAS float*)(F.ws + WS_R1);
    for (int chunk = F.vcu; chunk < M / 128; chunk += F.G) {
        const int b = chunk / (S / 128);
        f32x4 scl[2][2];
#pragma unroll
        for (int j = 0; j < 2; ++j)
#pragma unroll
            for (int h = 0; h < 2; ++h) { const int k = 8 * F.lane + 512 * j + 4 * h; const f32x4 gg = *(const GAS f32x4*)(g1 + k); const LAS float* sc = modl + (b * 6 + 3) * D + k;
                scl[j][h] = gg * ((f32x4){1.f + sc[0], 1.f + sc[1], 1.f + sc[2], 1.f + sc[3]}); }
        for (int rb = 0; rb < 16; rb += 4) {
            f32x4 v[4][2][2]; float q[4];
#pragma unroll
            for (int r4 = 0; r4 < 4; ++r4) { const GAS float* xr = x + (size_t)(chunk * 128 + F.wave * 16 + rb + r4) * D + 8 * F.lane;
#pragma unroll
                for (int j = 0; j < 2; ++j) { v[r4][j][0] = *(const GAS f32x4*)(xr + 512 * j); v[r4][j][1] = *(const GAS f32x4*)(xr + 512 * j + 4); } }
            asm volatile("" ::: "memory");
#pragma unroll
            for (int r4 = 0; r4 < 4; ++r4) { float t = 0.f;
#pragma unroll
                for (int j = 0; j < 2; ++j)
#pragma unroll
                    for (int h = 0; h < 2; ++h) t += (v[r4][j][h][0] * v[r4][j][h][0] + v[r4][j][h][1] * v[r4][j][h][1]) + (v[r4][j][h][2] * v[r4][j][h][2] + v[r4][j][h][3] * v[r4][j][h][3]);
                q[r4] = t; }
#pragma unroll
            for (int o = 1; o < 64; o <<= 1)
#pragma unroll
                for (int r4 = 0; r4 < 4; ++r4) q[r4] += __shfl_xor(q[r4], o);
#pragma unroll
            for (int r4 = 0; r4 < 4; ++r4) {
                const int row = chunk * 128 + F.wave * 16 + rb + r4;
                if (F.lane == 0) R1[row] = rsqrtf(q[r4] * (1.f / D) + EPS);
#pragma unroll
                for (int j = 0; j < 2; ++j) { const int k = 8 * F.lane + 512 * j; u32x4 w;
#pragma unroll
                    for (int h = 0; h < 2; ++h) { const f32x4 o = v[r4][j][h] * scl[j][h]; w[2 * h] = pkh8(o[0], o[1]); w[2 * h + 1] = pkh8(o[2], o[3]); }
                    *(GAS u32x4*)(XG + blk_off(row, k, D / 64)) = w; }
            }
        }
    }
    const int gw = F.vcu * NWAVES + F.wave, NGW = F.G * NWAVES;
    for (int it = gw; it < NGU + INW + NGU; it += NGW) {
        int n = it, j; const GAS h16* W; GAS float* B; int NN;
        if (n < NGU) { j = 0; W = (const GAS h16*)(F.ws + WS_WGU1); B = (GAS float*)(F.ws + WS_BIAS1); NN = NGU; }
        else if (n < NGU + INW) { n -= NGU; j = 1; W = (const GAS h16*)(F.ws + WS_WIN); B = (GAS float*)(F.ws + WS_BIAS2); NN = INW; }
        else { n -= NGU + INW; j = 2; W = (const GAS h16*)(F.ws + WS_WGU2); B = (GAS float*)(F.ws + WS_BIAS3); NN = NGU; }
        const h16x8 w0 = *(const GAS h16x8*)(W + blk_off(n, 16 * F.lane, D / 64)), w1 = *(const GAS h16x8*)(W + blk_off(n, 16 * F.lane + 8, D / 64));
        float s[4];
#pragma unroll
        for (int b = 0; b < 4; ++b) { const LAS float* sh = modl + (b * 6 + j) * D + 16 * F.lane; float t = 0.f;
#pragma unroll
            for (int e = 0; e < 8; ++e) t += sh[e] * (float)w0[e] + sh[8 + e] * (float)w1[e];
            s[b] = wave_sum(t); }
        if (F.lane == 0) { B[0 * NN + n] = s[0]; B[1 * NN + n] = s[1]; B[2 * NN + n] = s[2]; B[3 * NN + n] = s[3]; }
    }
    __syncthreads();
}

__device__ __forceinline__ void p_final(const Frame& F0, const Args& a) {
    Frame F = F0; F.tid = threadIdx.x; F.lane = F.tid & 63; F.wave = __builtin_amdgcn_readfirstlane(F.tid >> 6);
    const GAS h16* H = (const GAS h16*)(F.ws + WS_H); const GAS float* ssq = (const GAS float*)(F.ws + WS_SSQF); const GAS float* gf = GIN(a, 19);
    const int gw = F.vcu * NWAVES + F.wave, NGW = F.G * NWAVES;
    f32x4 g[2][2];
#pragma unroll
    for (int j = 0; j < 2; ++j)
#pragma unroll
        for (int h = 0; h < 2; ++h) g[j][h] = *(const GAS f32x4*)(gf + 8 * F.lane + 512 * j + 4 * h);
    for (int row = gw; row < M; row += NGW) {
        const float rs = rs16p(ssq + row);
#pragma unroll
        for (int j = 0; j < 2; ++j) { const h16x8 hv = *(const GAS h16x8*)(H + (size_t)row * D + 8 * F.lane + 512 * j);
            f32x4 o0 = (f32x4){(float)hv[0], (float)hv[1], (float)hv[2], (float)hv[3]} * rs * g[j][0], o1 = (f32x4){(float)hv[4], (float)hv[5], (float)hv[6], (float)hv[7]} * rs * g[j][1];
            *(GAS f32x4*)(a.out + (size_t)row * D + 8 * F.lane + 512 * j) = o0; *(GAS f32x4*)(a.out + (size_t)row * D + 8 * F.lane + 512 * j + 4) = o1; }
    }
}


typedef float f32x16 __attribute__((ext_vector_type(16)));
typedef short v4i16_t __attribute__((ext_vector_type(4)));
__device__ __forceinline__ h16x4 tr16(const LAS unsigned char* p) { return __builtin_bit_cast(h16x4, __builtin_amdgcn_ds_read_tr16_b64_v4i16((LAS v4i16_t*)p)); }
__device__ __forceinline__ int vt_off(int t, int c8) { return t * 128 + (((c8 >> 2) ^ ((t >> 1) & 1)) << 6) + ((c8 & 3) << 4); }

__device__ __forceinline__ void gmlp_phase(const Frame& F0, const Args& a, int shadow) {
    const int tid = threadIdx.x, lane = tid & 63, wave = __builtin_amdgcn_readfirstlane(tid >> 6), r32 = lane & 31, hi = lane >> 5;
    GAS h16* proj = (GAS h16*)(F0.ws + WS_PROJ); const GAS h16* W16 = (const GAS h16*)(F0.ws + WS_WS16); GAS float* RG = (GAS float*)(F0.ws + WS_RG);
    const GAS float* ln_g = GIN(a, 9); const GAS float* ln_b = GIN(a, 10); const GAS float* b_s = GIN(a, 12);
    LAS unsigned char* lds = F0.lds;
    LAS float* rowsq = (LAS float*)(lds + MISC_OFF + 128);
    LAS unsigned char* gstg = lds + MISC_OFF + 128 + 4096 + wave * 2048;
    f32x4 g0 = *(const GAS f32x4*)(ln_g + 8 * lane), g1 = *(const GAS f32x4*)(ln_g + 8 * lane + 4), b0 = *(const GAS f32x4*)(ln_b + 8 * lane), b1 = *(const GAS f32x4*)(ln_b + 8 * lane + 4);
    for (int unit = F0.vcu; unit < M / GC; unit += F0.G) {
        const size_t row0 = (size_t)unit * GC;
        {
            h16x8 hv[16]; float sm[16], mu[16], rsd[16];
#pragma unroll
            for (int rr = 0; rr < 16; ++rr) hv[rr] = *(const GAS h16x8*)(proj + (row0 + wave * 16 + rr) * INW + PG + 8 * lane);
#pragma unroll
            for (int rr = 0; rr < 16; ++rr) { float t = 0.f;
#pragma unroll
                for (int e = 0; e < 8; ++e) t += (float)hv[rr][e];
                sm[rr] = t; }
#pragma unroll
            for (int o = 1; o < 64; o <<= 1)
#pragma unroll
                for (int rr = 0; rr < 16; ++rr) sm[rr] += __shfl_xor(sm[rr], o);
#pragma unroll
            for (int rr = 0; rr < 16; ++rr) { mu[rr] = sm[rr] * (1.f / 512.f); float q = 0.f;
#pragma unroll
                for (int e = 0; e < 8; ++e) { const float d = (float)hv[rr][e] - mu[rr]; q += d * d; }
                sm[rr] = q; }
#pragma unroll
            for (int o = 1; o < 64; o <<= 1)
#pragma unroll
                for (int rr = 0; rr < 16; ++rr) sm[rr] += __shfl_xor(sm[rr], o);
#pragma unroll
            for (int rr = 0; rr < 16; ++rr) { rsd[rr] = rsqrtf(sm[rr] * (1.f / 512.f) + EPS);
                const int t = wave * 16 + rr; float v[8];
#pragma unroll
                for (int e = 0; e < 8; ++e) v[e] = ((float)hv[rr][e] - mu[rr]) * rsd[rr];
                u32x4 w; w[0] = pkh(v[0] * g0[0] + b0[0], v[1] * g0[1] + b0[1]); w[1] = pkh(v[2] * g0[2] + b0[2], v[3] * g0[3] + b0[3]);
                w[2] = pkh(v[4] * g1[0] + b1[0], v[5] * g1[1] + b1[1]); w[3] = pkh(v[6] * g1[2] + b1[2], v[7] * g1[3] + b1[3]);
                *(LAS u32x4*)(lds + (lane >> 3) * 16384 + vt_off(t, lane & 7)) = w; }
        }
        __syncthreads();
        const GAS h16* Wh = W16 + (size_t)wave * GC * GC;
        const LAS unsigned char* vt = lds + wave * 16384;
        const int q4 = (lane & 15) >> 2, p4 = lane & 3, g1b = (lane >> 4) & 1;
#pragma unroll
        for (int tb = 0; tb < 4; ++tb) {
            f32x16 acc[2];
#pragma unroll
            for (int d0 = 0; d0 < 2; ++d0)
#pragma unroll
                for (int e = 0; e < 16; ++e) acc[d0][e] = 0.f;
            h16x8 af[8];
#pragma unroll
            for (int ks = 0; ks < 8; ++ks) if (ks <= 2 * tb + 1) af[ks] = *(const GAS h16x8*)(Wh + (size_t)(32 * tb + r32) * GC + 16 * ks + 8 * hi);
#pragma unroll
            for (int ks = 0; ks < 8; ++ks) {
                if (ks <= 2 * tb + 1) {
#pragma unroll
                    for (int d0 = 0; d0 < 2; ++d0) {
                        const int srow = 16 * ks + 8 * hi + q4, c8 = 4 * d0 + 2 * g1b + (p4 >> 1);
                        const h16x4 lo = tr16(vt + vt_off(srow, c8) + (p4 & 1) * 8), hi4 = tr16(vt + vt_off(srow + 4, c8) + (p4 & 1) * 8);
                        const h16x8 bf = (h16x8){lo[0], lo[1], lo[2], lo[3], hi4[0], hi4[1], hi4[2], hi4[3]};
                        acc[d0] = __builtin_amdgcn_mfma_f32_32x32x16_f16(af[ks], bf, acc[d0], 0, 0, 0);
                    }
                }
            }
            float bsv[16];
#pragma unroll
            for (int e = 0; e < 16; ++e) bsv[e] = b_s[wave * GC + 32 * tb + (e & 3) + 8 * (e >> 2) + 4 * hi];
            h16x8 uv[2][2];
#pragma unroll
            for (int d0 = 0; d0 < 2; ++d0)
#pragma unroll
                for (int i = 0; i < 2; ++i) uv[d0][i] = *(const GAS h16x8*)(proj + (row0 + 32 * tb + (lane >> 2) + 16 * i) * INW + PU + wave * 64 + 32 * d0 + (lane & 3) * 8);
            asm volatile("" ::: "memory");
            float rq[2] = {0.f, 0.f};
#pragma unroll
            for (int d0 = 0; d0 < 2; ++d0) {
#pragma unroll
                for (int e = 0; e < 16; ++e) *(LAS h16*)(gstg + ((e & 3) + 8 * (e >> 2) + 4 * hi) * 64 + r32 * 2) = (h16)(acc[d0][e] + bsv[e]);
                LDS_WAIT();
#pragma unroll
                for (int i = 0; i < 2; ++i) { const int rw = (lane >> 2) + 16 * i; const h16x8 mx = *(const LAS h16x8*)(gstg + rw * 64 + (lane & 3) * 16);
                    float o[8]; float q = 0.f;
#pragma unroll
                    for (int e = 0; e < 8; ++e) { o[e] = (float)uv[d0][i][e] * (float)mx[e]; q += o[e] * o[e]; }
                    u32x4 w; w[0] = pkh(o[0], o[1]); w[1] = pkh(o[2], o[3]); w[2] = pkh(o[4], o[5]); w[3] = pkh(o[6], o[7]);
                    *(GAS u32x4*)(proj + (row0 + 32 * tb + rw) * INW + PU + wave * 64 + 32 * d0 + (lane & 3) * 8) = w;
                    q += __shfl_xor(q, 1); q += __shfl_xor(q, 2); rq[i] += q; }
                LDS_WAIT();
            }
            if ((lane & 3) == 0) { rowsq[wave * 128 + 32 * tb + (lane >> 2)] = rq[0]; rowsq[wave * 128 + 32 * tb + (lane >> 2) + 16] = rq[1]; }
        }
        __syncthreads();
        if (tid < 128) { float s8 = 0.f;
#pragma unroll
            for (int w = 0; w < 8; ++w) s8 += rowsq[w * 128 + tid];
            RG[row0 + tid] = s8; }
        __syncthreads();
    }
}


constexpr size_t DO_PO = 0, DO_PML = 96 * MiB;
constexpr int CW_CNT = 8192;
constexpr int LISTCAP = 8192;
constexpr int AL_K = 0, AL_V = 32768, AL_STG = 65536, AL_WSF = 98304, AL_START = 102400;
__device__ __forceinline__ int k_off(int key, int c8) { return key * 128 + ((c8 ^ (key & 7)) << 4); }

__device__ __forceinline__ void moba_gate_phase(const Frame& F0, int shadow) {
    const int tid = threadIdx.x, lane = tid & 63;
    const GAS h16* proj = (const GAS h16*)(F0.ws + WS_PROJ); const GAS float* kmp = (const GAS float*)(F0.ws + WS_KMP);
    unsigned* cnt = F0.ctl + CW_CNT + (shadow ? 1024 : 0); GAS unsigned short* lists = (GAS unsigned short*)(F0.ws + (shadow ? WS_HG : WS_LISTS));
    LAS float* km = (LAS float*)F0.lds;
    for (int item = F0.vcu, rnd = 0; item < NB * NH * (S / 512); item += F0.G, ++rnd) {
        const int sp0 = item % (S / 512), span = (rnd & 1) ? (S / 512 - 1 - sp0) : sp0, bh = item / (S / 512), b = bh >> 3, h = bh & 7;
        __syncthreads();
        for (int e = tid; e < NBLK * 64; e += NWAVES * 64) { const int n = e >> 6, d = e & 63; const GAS float* kp = kmp + (size_t)((b * NBLK + n) * 2) * 512 + h * 64 + d; km[e] = kp[0] + kp[512]; }
        __syncthreads();
        const int sq = span * 512 + tid, own = __builtin_amdgcn_readfirstlane(sq >> 8);
        float q[64];
        { const GAS h16* qp = proj + (size_t)(b * S + sq) * INW + PQ + h * 64;
#pragma unroll
          for (int c = 0; c < 8; ++c) { const h16x8 v = *(const GAS h16x8*)(qp + 8 * c);
#pragma unroll
              for (int e = 0; e < 8; ++e) q[8 * c + e] = (float)v[e]; } }
        float v0 = -3e38f, v1 = -3e38f, v2 = -3e38f; int i0 = -1, i1 = -1, i2 = -1;
        for (int n = 0; n < own; ++n) {
            float g0 = 0.f, g1 = 0.f, g2 = 0.f, g3 = 0.f;
#pragma unroll
            for (int c = 0; c < 16; ++c) { const f32x4 kv = *(const LAS f32x4*)(km + n * 64 + 4 * c); g0 += q[4 * c] * kv[0]; g1 += q[4 * c + 1] * kv[1]; g2 += q[4 * c + 2] * kv[2]; g3 += q[4 * c + 3] * kv[3]; }
            const float g = (g0 + g1) + (g2 + g3);
            if (g > v0) { v2 = v1; i2 = i1; v1 = v0; i1 = i0; v0 = g; i0 = n; }
            else if (g > v1) { v2 = v1; i2 = i1; v1 = g; i1 = n; }
            else if (g > v2) { v2 = g; i2 = n; }
        }
        int mycnt = 0, pos0 = 0, pos1 = 0, pos2 = 0;
        const unsigned long long ltmask = (1ull << lane) - 1ull;
        for (int n = 0; n < own; ++n) {
            const bool sel = (i0 == n) || (i1 == n) || (i2 == n);
            const unsigned long long mask = __ballot(sel);
            const int before = __popcll(mask & ltmask);
            if (lane == n) mycnt = __popcll(mask);
            if (i0 == n) pos0 = before; if (i1 == n) pos1 = before; if (i2 == n) pos2 = before;
        }
        unsigned base = 0u;
        if (lane < own && mycnt > 0) base = atomicAdd(cnt + bh * NBLK + lane, (unsigned)mycnt);
        const unsigned bb0 = (unsigned)__shfl((int)base, i0 & 63), bb1 = (unsigned)__shfl((int)base, i1 & 63), bb2 = (unsigned)__shfl((int)base, i2 & 63);
        if (i0 >= 0) lists[(size_t)(bh * NBLK + i0) * LISTCAP + bb0 + pos0] = (unsigned short)(sq | (0 << 13));
        if (i1 >= 0) lists[(size_t)(bh * NBLK + i1) * LISTCAP + bb1 + pos1] = (unsigned short)(sq | (1 << 13));
        if (i2 >= 0) lists[(size_t)(bh * NBLK + i2) * LISTCAP + bb2 + pos2] = (unsigned short)(sq | (2 << 13));
    }
    __syncthreads();
}

template <bool CAUSAL>
__device__ __forceinline__ void attn_tile(const LAS unsigned char* ldsK, const LAS unsigned char* ldsV, const h16x8 (&qf)[4], int wave, int lane, f32x16 (&o)[2], float& m_out, float& l_out) {
    const int r32 = lane & 31, hi = lane >> 5;
    int kbase[4];
#pragma unroll
    for (int ks = 0; ks < 4; ++ks) kbase[ks] = r32 * 128 + (((2 * ks + hi) ^ (r32 & 7)) << 4);
    f32x16 sacc[8];
#pragma unroll
    for (int kb = 0; kb < 8; ++kb) {
        f32x16 acc;
#pragma unroll
        for (int e = 0; e < 16; ++e) acc[e] = 0.f;
#pragma unroll
        for (int ks = 0; ks < 4; ++ks) { const h16x8 kf = *(const LAS h16x8*)(ldsK + kbase[ks] + kb * 4096); acc = __builtin_amdgcn_mfma_f32_32x32x16_f16(kf, qf[ks], acc, 0, 0, 0); }
        if (CAUSAL) {
            const int lim = 32 * (wave - kb) + r32;
#pragma unroll
            for (int e = 0; e < 16; ++e) { const int key = (e & 3) + 8 * (e >> 2) + 4 * hi; if (key > lim) acc[e] = -1e30f; }
        }
        sacc[kb] = acc;
    }
    float m = -3e38f;
#pragma unroll
    for (int kb = 0; kb < 8; ++kb)
#pragma unroll
        for (int e = 0; e < 16; ++e) m = fmaxf(m, sacc[kb][e]);
    m = fmaxf(m, __shfl_xor(m, 32));
    float ls = 0.f;
#pragma unroll
    for (int kb = 0; kb < 8; ++kb)
#pragma unroll
        for (int e = 0; e < 16; ++e) { const float pv = __builtin_amdgcn_exp2f(sacc[kb][e] - m); sacc[kb][e] = pv; ls += pv; }
    ls += __shfl_xor(ls, 32);
#pragma unroll
    for (int d0 = 0; d0 < 2; ++d0)
#pragma unroll
        for (int e = 0; e < 16; ++e) o[d0][e] = 0.f;
    const int q4 = (lane & 15) >> 2, p4 = lane & 3, g1b = (lane >> 4) & 1;
    int vbase[2];
#pragma unroll
    for (int d0 = 0; d0 < 2; ++d0) vbase[d0] = (4 * hi + q4) * 128 + ((d0 ^ ((q4 >> 1) & 1)) << 6) + ((2 * g1b + (p4 >> 1)) << 4) + (p4 & 1) * 8;
#pragma unroll
    for (int kb = 0; kb < 8; ++kb) {
        if (!CAUSAL || kb <= wave) {
#pragma unroll
            for (int s2 = 0; s2 < 2; ++s2) {
                h16x8 pa;
#pragma unroll
                for (int j = 0; j < 8; ++j) pa[j] = (h16)sacc[kb][8 * s2 + j];
#pragma unroll
                for (int d0 = 0; d0 < 2; ++d0) {
                    const h16x4 lo = tr16(ldsV + vbase[d0] + kb * 4096 + s2 * 2048), hi4 = tr16(ldsV + vbase[d0] + kb * 4096 + s2 * 2048 + 1024);
                    const h16x8 bf = (h16x8){lo[0], lo[1], lo[2], lo[3], hi4[0], hi4[1], hi4[2], hi4[3]};
                    o[d0] = __builtin_amdgcn_mfma_f32_32x32x16_f16(pa, bf, o[d0], 0, 0, 0);
                }
            }
        }
    }
    m_out = m; l_out = ls;
}
__device__ __forceinline__ void attn_tile_causal(const LAS unsigned char* ldsK, const LAS unsigned char* ldsV, const h16x8 (&qf)[4], int wave, int lane, f32x16 (&o)[2], float& m_out, float& l_out) {
    const int r32 = lane & 31, hi = lane >> 5;
    int kbase[4];
#pragma unroll
    for (int ks = 0; ks < 4; ++ks) kbase[ks] = r32 * 128 + (((2 * ks + hi) ^ (r32 & 7)) << 4);
    const int q4 = (lane & 15) >> 2, p4 = lane & 3, g1b = (lane >> 4) & 1;
    int vbase[2];
#pragma unroll
    for (int d0 = 0; d0 < 2; ++d0) vbase[d0] = (4 * hi + q4) * 128 + ((d0 ^ ((q4 >> 1) & 1)) << 6) + ((2 * g1b + (p4 >> 1)) << 4) + (p4 & 1) * 8;
    float m = -3e38f;
    for (int kb = 0; kb <= wave; ++kb) {
        f32x16 acc;
#pragma unroll
        for (int e = 0; e < 16; ++e) acc[e] = 0.f;
#pragma unroll
        for (int ks = 0; ks < 4; ++ks) { const h16x8 kf = *(const LAS h16x8*)(ldsK + kbase[ks] + kb * 4096); acc = __builtin_amdgcn_mfma_f32_32x32x16_f16(kf, qf[ks], acc, 0, 0, 0); }
        const int lim = (kb == wave) ? r32 : 64;
#pragma unroll
        for (int e = 0; e < 16; ++e) { const int key = (e & 3) + 8 * (e >> 2) + 4 * hi; if (key <= lim) m = fmaxf(m, acc[e]); }
    }
    m = fmaxf(m, __shfl_xor(m, 32));
    float ls = 0.f;
#pragma unroll
    for (int d0 = 0; d0 < 2; ++d0)
#pragma unroll
        for (int e = 0; e < 16; ++e) o[d0][e] = 0.f;
    for (int kb = 0; kb <= wave; ++kb) {
        f32x16 acc;
#pragma unroll
        for (int e = 0; e < 16; ++e) acc[e] = 0.f;
#pragma unroll
        for (int ks = 0; ks < 4; ++ks) { const h16x8 kf = *(const LAS h16x8*)(ldsK + kbase[ks] + kb * 4096); acc = __builtin_amdgcn_mfma_f32_32x32x16_f16(kf, qf[ks], acc, 0, 0, 0); }
        const int lim = (kb == wave) ? r32 : 64;
#pragma unroll
        for (int e = 0; e < 16; ++e) { const int key = (e & 3) + 8 * (e >> 2) + 4 * hi; const float pv = (key <= lim) ? __builtin_amdgcn_exp2f(acc[e] - m) : 0.f; acc[e] = pv; ls += pv; }
#pragma unroll
        for (int s2 = 0; s2 < 2; ++s2) {
            h16x8 pa;
#pragma unroll
            for (int j = 0; j < 8; ++j) pa[j] = (h16)acc[8 * s2 + j];
#pragma unroll
            for (int d0 = 0; d0 < 2; ++d0) {
                const h16x4 lo = tr16(ldsV + vbase[d0] + kb * 4096 + s2 * 2048), hi4 = tr16(ldsV + vbase[d0] + kb * 4096 + s2 * 2048 + 1024);
                const h16x8 bf = (h16x8){lo[0], lo[1], lo[2], lo[3], hi4[0], hi4[1], hi4[2], hi4[3]};
                o[d0] = __builtin_amdgcn_mfma_f32_32x32x16_f16(pa, bf, o[d0], 0, 0, 0);
            }
        }
    }
    ls += __shfl_xor(ls, 32);
    m_out = m; l_out = ls;
}
__device__ __forceinline__ void load_kv_block(LAS unsigned char* lds, const GAS h16* proj, size_t row0, int h, int tid) {
#pragma unroll
    for (int i = 0; i < 4; ++i) { const int idx = tid + 512 * i, key = idx >> 3, c8 = idx & 7; const GAS h16* rp = proj + (row0 + key) * INW + h * 64 + 8 * c8;
        const u32x4 kv = *(const GAS u32x4*)(rp + PK), vv = *(const GAS u32x4*)(rp + PV);
        *(LAS u32x4*)(lds + AL_K + k_off(key, c8)) = kv; *(LAS u32x4*)(lds + AL_V + vt_off(key, c8)) = vv; }
}
__device__ __forceinline__ void stage_o(LAS unsigned char* stg, LAS float* wsf, const f32x16 (&o)[2], float l, int lane) {
    const int r32 = lane & 31, hi = lane >> 5;
    if (hi == 0) wsf[r32] = 1.f / l;
    LDS_WAIT();
#pragma unroll
    for (int e = 0; e < 16; ++e) { const int qr = (e & 3) + 8 * (e >> 2) + 4 * hi; const float rl = wsf[qr];
        *(LAS h16*)(stg + qr * 128 + r32 * 2) = (h16)(o[0][e] * rl); *(LAS h16*)(stg + qr * 128 + 64 + r32 * 2) = (h16)(o[1][e] * rl); }
    LDS_WAIT();
}

struct KvRegs { u32x4 kv[4], vv[4]; };
__device__ __forceinline__ void kv_fetch(KvRegs& r, const GAS h16* proj, size_t row0, int h, int tid) {
#pragma unroll
    for (int i = 0; i < 4; ++i) { const int idx = tid + 512 * i, key = idx >> 3, c8 = idx & 7; const GAS h16* rp = proj + (row0 + key) * INW + h * 64 + 8 * c8;
        r.kv[i] = *(const GAS u32x4*)(rp + PK); r.vv[i] = *(const GAS u32x4*)(rp + PV); }
}
__device__ __forceinline__ void kv_commit(const KvRegs& r, LAS unsigned char* lds, int tid) {
#pragma unroll
    for (int i = 0; i < 4; ++i) { const int idx = tid + 512 * i, key = idx >> 3, c8 = idx & 7;
        *(LAS u32x4*)(lds + AL_K + k_off(key, c8)) = r.kv[i]; *(LAS u32x4*)(lds + AL_V + vt_off(key, c8)) = r.vv[i]; }
}
__device__ __forceinline__ void moba_b_phase(const Frame& F0, GAS float* dout) {
    const int tid = threadIdx.x, lane = tid & 63, wave = __builtin_amdgcn_readfirstlane(tid >> 6), r32 = lane & 31, hi = lane >> 5;
    const GAS h16* proj = (const GAS h16*)(F0.ws + WS_PROJ); const unsigned* cnt = F0.ctl + CW_CNT; const GAS unsigned short* lists = (const GAS unsigned short*)(F0.ws + WS_LISTS);
    GAS h16* PO = (GAS h16*)((unsigned char*)dout + DO_PO); GAS float* PML = (GAS float*)((unsigned char*)dout + DO_PML);
    LAS unsigned char* lds = F0.lds;
    LAS int* start = (LAS int*)(lds + AL_START);
    LAS float* wsf = (LAS float*)(lds + AL_WSF + wave * 512); LAS int* wsi = (LAS int*)(lds + AL_WSF + wave * 512 + 256);
    LAS unsigned char* stg = lds + AL_STG + wave * 4096;
    {
        const unsigned c0 = cnt[2 * tid], c1 = cnt[2 * tid + 1];
        const int t0 = (int)((c0 + 255u) >> 8), t1 = (int)((c1 + 255u) >> 8);
        int v = t0 + t1, inc = v;
#pragma unroll
        for (int o = 1; o < 64; o <<= 1) { const int u = __shfl_up(inc, o); if (lane >= o) inc += u; }
        LAS int* wtot = (LAS int*)(lds + AL_WSF);
        __syncthreads();
        if (lane == 63) wtot[wave] = inc;
        __syncthreads();
        int pre = 0;
        for (int w = 0; w < wave; ++w) pre += wtot[w];
        const int ex = pre + inc - v;
        __syncthreads();
        start[2 * tid] = ex; start[2 * tid + 1] = ex + t0;
        if (tid == 511) start[1024] = ex + v;
        __syncthreads();
    }
    const int nitems = start[1024];
    for (int item = F0.vcu; item < nitems; item += F0.G) {
        int lo = 0, hi_ = 1024;
        while (hi_ - lo > 1) { const int mid = (lo + hi_) >> 1; if (start[mid] <= item) lo = mid; else hi_ = mid; }
        const int l = lo, chunk = item - start[l];
        const int bh = l >> 5, n = l & 31, b = bh >> 3, h = bh & 7;
        const int nq = (int)cnt[l] - chunk * 256;
        const int qi = chunk * 256 + wave * 32 + r32;
        const bool valid = (wave * 32 + r32) < nq;
        const unsigned ent = lists[(size_t)l * LISTCAP + (valid ? qi : chunk * 256)];
        KvRegs kvr; kv_fetch(kvr, proj, (size_t)b * S + (size_t)n * MBLK, h, tid);
        const int sq = ent & 8191, rank = ent >> 13;
        h16x8 qf[4];
        { const GAS h16* qp = proj + (size_t)(b * S + sq) * INW + PQ + h * 64 + 8 * hi;
#pragma unroll
          for (int ks = 0; ks < 4; ++ks) qf[ks] = *(const GAS h16x8*)(qp + 16 * ks); }
        kv_commit(kvr, lds, tid);
        __syncthreads();
        if (wave * 32 < nq) {
            f32x16 o[2]; float m, lsum;
            attn_tile<false>(lds + AL_K, lds + AL_V, qf, wave, lane, o, m, lsum);
            const int slot = ((b * NH + h) * 3 + rank) * S + sq;
            if (hi == 0) { wsi[r32] = valid ? slot : -1; if (valid) { PML[(size_t)slot * 2] = m; PML[(size_t)slot * 2 + 1] = lsum; } }
            stage_o(stg, wsf, o, lsum, lane);
#pragma unroll
            for (int i = 0; i < 4; ++i) { const int row = i * 8 + (lane >> 3), ch = lane & 7; const int sl = wsi[row];
                if (sl >= 0) *(GAS u32x4*)(PO + (size_t)sl * 64 + ch * 8) = *(const LAS u32x4*)(stg + row * 128 + ch * 16); }
        }
        __syncthreads();
    }
}

__device__ __forceinline__ void moba_c_phase(const Frame& F0, const GAS float* dout, int shadow) {
    const int tid = threadIdx.x, lane = tid & 63, wave = __builtin_amdgcn_readfirstlane(tid >> 6), r32 = lane & 31, hi = lane >> 5;
    const int qblk = (wave < 4) ? wave : 11 - wave;
    GAS h16* proj = (GAS h16*)(F0.ws + WS_PROJ); GAS float* SSQA = (GAS float*)(F0.ws + WS_SSQA);
    const GAS h16* PO = (const GAS h16*)((const unsigned char*)dout + DO_PO); const GAS float* PML = (const GAS float*)((const unsigned char*)dout + DO_PML);
    LAS unsigned char* lds = F0.lds;
    LAS float* wsf = (LAS float*)(lds + AL_WSF + wave * 512);
    LAS unsigned char* stg = lds + AL_STG + wave * 4096;
    KvRegs kvr;
    if (F0.vcu < NB * NH * NBLK) { const int u0 = F0.vcu; kv_fetch(kvr, proj, (size_t)((u0 >> 5) >> 3) * S + (size_t)(u0 & 31) * MBLK, (u0 >> 5) & 7, tid); }
    for (int unit = F0.vcu; unit < NB * NH * NBLK; unit += F0.G) {
        const int qb = unit & 31, bh = unit >> 5, b = bh >> 3, h = bh & 7;
        const size_t row0 = (size_t)b * S + (size_t)qb * MBLK;
        kv_commit(kvr, lds, tid);
        { const int un = unit + F0.G; if (un < NB * NH * NBLK) kv_fetch(kvr, proj, (size_t)((un >> 5) >> 3) * S + (size_t)(un & 31) * MBLK, (un >> 5) & 7, tid); }
        h16x8 qf[4];
        { const GAS h16* qp = proj + (row0 + qblk * 32 + r32) * INW + PQ + h * 64 + 8 * hi;
#pragma unroll
          for (int ks = 0; ks < 4; ++ks) qf[ks] = *(const GAS h16x8*)(qp + 16 * ks); }
        __syncthreads();
        f32x16 o[2]; float m, lsum;
        attn_tile_causal(lds + AL_K, lds + AL_V, qf, qblk, lane, o, m, lsum);
        if (hi == 0) { wsf[32 + r32] = m; wsf[64 + r32] = lsum; }
        stage_o(stg, wsf, o, lsum, lane);
        const int nsel = qb < 3 ? qb : 3;
#pragma unroll
        for (int i0 = 0; i0 < 4; i0 += 2) {
            float mr[2][3], lr[2][3]; h16x8 pv[2][3];
#pragma unroll
            for (int ii = 0; ii < 2; ++ii) { const size_t grow = row0 + qblk * 32 + (i0 + ii) * 8 + (lane >> 3);
#pragma unroll
                for (int r = 0; r < 3; ++r) { if (r < nsel) { const size_t sl = ((size_t)(b * NH + h) * 3 + r) * S + (grow - (size_t)b * S); mr[ii][r] = PML[sl * 2]; lr[ii][r] = PML[sl * 2 + 1]; pv[ii][r] = *(const GAS h16x8*)(PO + sl * 64 + (lane & 7) * 8); } } }
            asm volatile("" ::: "memory");
#pragma unroll
            for (int ii = 0; ii < 2; ++ii) {
                const int row = (i0 + ii) * 8 + (lane >> 3), ch = lane & 7;
                const size_t grow = row0 + qblk * 32 + row;
                const float mo = wsf[32 + row], lo_ = wsf[64 + row];
                const h16x8 ov = *(const LAS h16x8*)(stg + row * 128 + ch * 16);
                float mmax = mo;
#pragma unroll
                for (int r = 0; r < 3; ++r) { if (r < nsel) mmax = fmaxf(mmax, mr[ii][r]); }
                float wo = lo_ * __builtin_amdgcn_exp2f(mo - mmax), L = wo;
                float acc[8];
#pragma unroll
                for (int e = 0; e < 8; ++e) acc[e] = wo * (float)ov[e];
#pragma unroll
                for (int r = 0; r < 3; ++r) { if (r < nsel) { const float wr_ = lr[ii][r] * __builtin_amdgcn_exp2f(mr[ii][r] - mmax); L += wr_;
#pragma unroll
                    for (int e = 0; e < 8; ++e) acc[e] += wr_ * (float)pv[ii][r][e]; } }
                const float rL = 1.f / L; float q = 0.f; u32x4 w;
#pragma unroll
                for (int e = 0; e < 8; ++e) { acc[e] *= rL; q += acc[e] * acc[e]; }
                w[0] = pkh(acc[0], acc[1]); w[1] = pkh(acc[2], acc[3]); w[2] = pkh(acc[4], acc[5]); w[3] = pkh(acc[6], acc[7]);
                if (shadow) *(GAS u32x4*)((GAS h16*)(F0.ws + WS_HG) + grow * 512 + h * 64 + ch * 8) = w;
                else *(GAS u32x4*)(proj + grow * INW + PQ + h * 64 + ch * 8) = w;
                q += __shfl_xor(q, 1); q += __shfl_xor(q, 2); q += __shfl_xor(q, 4);
                if (ch == 0) SSQA[grow * 8 + h] = q;
            }
        }
        __syncthreads();
    }
}


template <bool PART16, class Order> __device__ __forceinline__ void fill_rowscale(LAS float* tab, const Order& So, const GAS float* src, int maxu) {
    pg8::Unit uu;
    for (int i = 0; i < maxu && So.next(i, uu); ++i)
        if (threadIdx.x < 256) { const int row = uu.pm * 256 + (int)threadIdx.x; tab[i * 256 + threadIdx.x] = PART16 ? rs16p(src + row) : src[row]; }
    __syncthreads();
}
constexpr int TAB_OFF = MISC_OFF + 128, TAB_MAXU = 15;
static_assert(TAB_OFF + TAB_MAXU * 1024 <= LDS_BYTES, "row-scale table");

enum Phase { PH_P0 = 0, PH_P1, PH_G1A, PH_G1B, PH_INPROJ, PH_MIX_A, PH_MIX_B, PH_MIX_C, PH_OUTPROJ, PH_G2A, PH_G2B, PH_FINAL, PH_COUNT };
__global__ void __launch_bounds__(NWAVES * 64, 2) mega_fwd(Args args) {
    extern __shared__ __attribute__((aligned(16))) unsigned char lds[];
    Frame F;
    F.lds = (LAS unsigned char*)lds; F.MISC = (volatile LAS unsigned*)(F.lds + MISC_OFF);
    F.tid = threadIdx.x; F.lane = F.tid & 63; F.wave = __builtin_amdgcn_readfirstlane(F.tid >> 6);
    F.G = gridDim.x; { const int bx = blockIdx.x; F.vcu = (F.G % 8 == 0) ? (bx % 8) * (F.G / 8) + bx / 8 : bx; }
    F.ws = args.ws; F.out = (GAS float*)args.out; F.ctl = (unsigned*)(args.ws + WS_CTL);
    for (int u = F.tid; u < (LDS_BYTES - LDSCTL_OFF) / 4; u += NWAVES * 64) ((LAS unsigned*)(F.lds + LDSCTL_OFF))[u] = 0u;
    __syncthreads();
    XcdBarrier bar; bar.bar = F.ctl + CW_BAR; bar.x = 0; bar.st = nullptr;
    const int lo = args.ph_lo, hi = args.ph_hi;
    if (hi - lo > 1) bar = xcd_barrier_post(F.ctl + CW_BAR, F.MISC + 8);
#ifndef MK_PHASE_MASK
#define MK_PHASE_MASK 0xFFFF
#endif
#define IN(k) (((MK_PHASE_MASK >> (k)) & 1) && lo <= (k) && (k) < hi)
#define SEAM(k) do { if (IN(k) && IN((k) + 1)) xcd_barrier(bar); } while (0)
#define PHASE_PTRS() unsigned char* ws = args.ws; asm volatile("" : "+s"(ws)); const GAS float* GT = (const GAS float*)(ws + WS_GT); const GAS float* GP = (const GAS float*)(ws + WS_GP); (void)GT; (void)GP; F.ws = ws
    if (IN(PH_P0)) { PHASE_PTRS(); p0_prologue(F, args); SEAM(PH_P0); }
    if (IN(PH_P1)) { PHASE_PTRS(); p1_prep(F, args); SEAM(PH_P1); }
    if (IN(PH_G1A)) {
        PHASE_PTRS();
        pg8::Gemm g{(const GAS h16*)(ws + WS_HG), (const GAS h16*)(ws + WS_WGU1), 0, NGU, D}; pg8::StaticOrder So; So.init(M, NGU, F.G, (int)blockIdx.x); const pg8::TableOrder To = pg8::make_table(So, (LAS int*)(F.lds + LDSCTL_OFF));
#if MK_SHADOW == 1
        if (args.ph_lo == PH_G1A && args.ph_hi == PH_G1A + 1 && args.shadow) { EpiNull En; pg8::gemm_phase<EpiNull, true, MK_GPROBE>(F.lds, g, So, En); return; }
#endif
        fill_rowscale<false>((LAS float*)(F.lds + TAB_OFF), To, (const GAS float*)(ws + WS_R1), TAB_MAXU);
        EpiSwiglu E{(GAS h16*)(ws + WS_ACT), (const LAS float*)(F.lds + TAB_OFF), (const GAS float*)(ws + WS_BIAS1)};
        pg8::gemm_phase<EpiSwiglu, true, 0, pg8::TableOrder>(F.lds, g, To, E); SEAM(PH_G1A);
    }
    if (IN(PH_G1B)) {
        PHASE_PTRS();
        pg8::Gemm g{(const GAS h16*)(ws + WS_ACT), (const GAS h16*)(ws + WS_WD1), 0, D, DFF, MK_STAG}; pg8::StaticOrder So; So.init(M, D, F.G, (int)blockIdx.x); const pg8::TableOrder To = pg8::make_table(So, (LAS int*)(F.lds + LDSCTL_OFF));
#if MK_SHADOW == 8
        if (args.ph_lo == PH_G1B && args.ph_hi == PH_G1B + 1 && args.shadow) {
#if MK_GPROBE == 0
            EpiNull En; pg8::gemm_phase<EpiNull, true>(F.lds, g, So, En);
#else
            EpiResid<true, false, true, MK_GPROBE> Ev{GIN(args, 0), (GAS h16*)(ws + WS_H), (GAS h16*)(ws + WS_HG), GT + 0 * 4 * D, GP + 1 * 4 * D, (GAS float*)(ws + WS_SSQ2), nullptr, 0.5f};
            pg8::gemm_phase<EpiResid<true, false, true, MK_GPROBE>, true>(F.lds, g, So, Ev);
#endif
            return; }
#endif
        EpiResid<true, false, true> E{GIN(args, 0), (GAS h16*)(ws + WS_H), (GAS h16*)(ws + WS_HG), GT + 0 * 4 * D, GP + 1 * 4 * D, (GAS float*)(ws + WS_SSQ2), nullptr, 0.5f};
        pg8::gemm_phase<EpiResid<true, false, true>, true, 0, pg8::TableOrder>(F.lds, g, To, E); SEAM(PH_G1B);
    }
    if (IN(PH_INPROJ)) {
        PHASE_PTRS();
        pg8::Gemm g{(const GAS h16*)(ws + WS_HG), (const GAS h16*)(ws + WS_WIN), 0, INW, D}; pg8::StaticOrder So; So.init(M, INW, F.G, (int)blockIdx.x); const pg8::TableOrder To = pg8::make_table(So, (LAS int*)(F.lds + LDSCTL_OFF));
        fill_rowscale<true>((LAS float*)(F.lds + TAB_OFF), To, (const GAS float*)(ws + WS_SSQ2), TAB_MAXU);
        EpiInproj E{(GAS h16*)(ws + WS_PROJ), (const LAS float*)(F.lds + TAB_OFF), (const GAS float*)(ws + WS_BIAS2), (const GAS float*)(ws + WS_ROPE), (GAS float*)(ws + WS_KMP)};
        pg8::gemm_phase<EpiInproj, true, 0, pg8::TableOrder>(F.lds, g, To, E); SEAM(PH_INPROJ);
    }
    if (IN(PH_MIX_A)) { PHASE_PTRS(); if (!(args.shadow & 2)) gmlp_phase(F, args, args.shadow & 1); if (!(args.shadow & 4)) moba_gate_phase(F, args.shadow & 1); SEAM(PH_MIX_A); }
    if (IN(PH_MIX_B)) { PHASE_PTRS(); moba_b_phase(F, (GAS float*)args.out); SEAM(PH_MIX_B); }
    if (IN(PH_MIX_C)) { PHASE_PTRS(); moba_c_phase(F, (const GAS float*)args.out, args.shadow & 1); SEAM(PH_MIX_C); }
    if (IN(PH_OUTPROJ)) {
        PHASE_PTRS();
        pg8::Gemm g{(const GAS h16*)(ws + WS_PROJ), (const GAS h16*)(ws + WS_WOUT), INW, D, D}; pg8::StaticOrder So; So.init(M, D, F.G, (int)blockIdx.x); const pg8::TableOrder To = pg8::make_table(So, (LAS int*)(F.lds + LDSCTL_OFF));
        const LAS float* sct = (const LAS float*)(F.lds + MISC_OFF + 128);
        {   LAS float* t = (LAS float*)(F.lds + MISC_OFF + 128); const GAS float* ssqa = (const GAS float*)(ws + WS_SSQA); const GAS float* ssqg = (const GAS float*)(ws + WS_RG);
            pg8::Unit uu;
            for (int i = 0; i < 4 && To.next(i, uu); ++i)
                if (F.tid < 256) { const int row = uu.pm * 256 + F.tid; const f32x4 a = *(const GAS f32x4*)(ssqa + (size_t)row * 8), bq = *(const GAS f32x4*)(ssqa + (size_t)row * 8 + 4);
                    const float ra = rsqrtf((((a[0] + a[1]) + (a[2] + a[3])) + ((bq[0] + bq[1]) + (bq[2] + bq[3]))) * (1.f / 512.f) + EPS), rg = rsqrtf(ssqg[row] * (1.f / 512.f) + EPS);
                    t[i * 512 + F.tid] = ra / rg; t[i * 512 + 256 + F.tid] = rg; }
            __syncthreads(); }
        EpiResid<false, true, true> E{nullptr, (GAS h16*)(ws + WS_H), (GAS h16*)(ws + WS_HG), GT + 1 * 4 * D, GP + 2 * 4 * D, (GAS float*)(ws + WS_SSQ3), sct, 1.0f};
        pg8::gemm_phase<EpiResid<false, true, true>, true, 0, pg8::TableOrder>(F.lds, g, To, E); SEAM(PH_OUTPROJ);
    }
    if (IN(PH_G2A)) {
        PHASE_PTRS();
        pg8::Gemm g{(const GAS h16*)(ws + WS_HG), (const GAS h16*)(ws + WS_WGU2), 0, NGU, D}; pg8::StaticOrder So; So.init(M, NGU, F.G, (int)blockIdx.x); const pg8::TableOrder To = pg8::make_table(So, (LAS int*)(F.lds + LDSCTL_OFF));
        fill_rowscale<true>((LAS float*)(F.lds + TAB_OFF), To, (const GAS float*)(ws + WS_SSQ3), TAB_MAXU);
        EpiSwiglu E{(GAS h16*)(ws + WS_ACT), (const LAS float*)(F.lds + TAB_OFF), (const GAS float*)(ws + WS_BIAS3)};
        pg8::gemm_phase<EpiSwiglu, true, 0, pg8::TableOrder>(F.lds, g, To, E); SEAM(PH_G2A);
    }
    if (IN(PH_G2B)) {
        PHASE_PTRS();
        pg8::Gemm g{(const GAS h16*)(ws + WS_ACT), (const GAS h16*)(ws + WS_WD2), 0, D, DFF}; pg8::StaticOrder So; So.init(M, D, F.G, (int)blockIdx.x); const pg8::TableOrder To = pg8::make_table(So, (LAS int*)(F.lds + LDSCTL_OFF));
#if MK_FUSE_FINAL
        EpiFinal E{(const GAS h16*)(ws + WS_H), GT + 2 * 4 * D, GIN(args, 19), (GAS float*)args.out, (unsigned*)(ws + WS_SSQF), F.ctl + CW_PAN, F.ctl + CW_TMO,
                   (LAS float*)(F.lds + MISC_OFF + 128), (LAS float*)(F.lds + MISC_OFF + 128 + 4096), 0.5f};
        pg8::gemm_phase<EpiFinal, true, 0, pg8::TableOrder>(F.lds, g, To, E);
#else
        EpiResid<false, false, false> E{nullptr, (GAS h16*)(ws + WS_H), nullptr, GT + 2 * 4 * D, nullptr, (GAS float*)(ws + WS_SSQF), nullptr, 0.5f};
        pg8::gemm_phase<EpiResid<false, false, false>, true, 0, pg8::TableOrder>(F.lds, g, To, E); SEAM(PH_G2B);
#endif
    }
#if !MK_FUSE_FINAL
    if (IN(PH_FINAL)) { PHASE_PTRS(); p_final(F, args); }
#endif
#undef IN
#undef SEAM
}

extern "C" void kernel_launch(void* const* d_in, const int* in_sizes, int n_in, void* d_out, int out_size, void* d_ws, size_t ws_size, hipStream_t stream) {
    static int grid = 0;
    if (grid == 0) {
        if (n_in != 20 || out_size != M * D || ws_size < WS_END) { fprintf(stderr, "kernel_launch: unexpected shapes (n_in %d out %d ws %zu)\n", n_in, out_size, ws_size); grid = -1; return; }
        int dev = 0, cus = 0, per_cu = 0;
        hipGetDevice(&dev); hipDeviceGetAttribute(&cus, hipDeviceAttributeMultiprocessorCount, dev);
        if (hipFuncSetAttribute((const void*)mega_fwd, hipFuncAttributeMaxDynamicSharedMemorySize, LDS_BYTES) != hipSuccess) { fprintf(stderr, "kernel_launch: hipFuncSetAttribute failed\n"); grid = -1; return; }
        hipOccupancyMaxActiveBlocksPerMultiprocessor(&per_cu, (const void*)mega_fwd, NWAVES * 64, LDS_BYTES);
        (void)hipGetLastError();
        if (per_cu < 1) { fprintf(stderr, "kernel_launch: occupancy query says %d blocks/CU; nothing launched\n", per_cu); grid = -1; return; }
        grid = cus;
    }
    if (grid < 0) return;
    hipMemsetAsync((char*)d_ws + WS_CTL, 0, CTL_ZERO_BYTES, stream);
    Args a{};
    for (int i = 0; i < 20; ++i) a.in[i] = (const float*)d_in[i];
    a.out = (float*)d_out; a.ws = (unsigned char*)d_ws;
    unsigned char* ws = (unsigned char*)d_ws;
    auto run = [&](int lo, int hi) {
#if MK_PER_PHASE
        for (int p = lo; p < hi; ++p) {
            if (MK_SHADOW == 2 && p == PH_MIX_A) { a.ph_lo = p; a.ph_hi = p + 1; a.shadow = 1 | 4; hipLaunchKernelGGL(mega_fwd, dim3(grid), dim3(NWAVES * 64), LDS_BYTES, stream, a); a.shadow = 0; }
            if (MK_SHADOW == 10 && p == PH_MIX_A) { a.ph_lo = p; a.ph_hi = p + 1; a.shadow = 1 | 2 | 4; hipLaunchKernelGGL(mega_fwd, dim3(grid), dim3(NWAVES * 64), LDS_BYTES, stream, a); a.shadow = 0; }
            if (MK_SHADOW == 3 && p == PH_MIX_A) { a.ph_lo = p; a.ph_hi = p + 1; a.shadow = 1 | 2; hipLaunchKernelGGL(mega_fwd, dim3(grid), dim3(NWAVES * 64), LDS_BYTES, stream, a); a.shadow = 0; }
            if (MK_SHADOW == 4 && p == PH_MIX_C) { a.ph_lo = p; a.ph_hi = p + 1; a.shadow = 1; hipLaunchKernelGGL(mega_fwd, dim3(grid), dim3(NWAVES * 64), LDS_BYTES, stream, a); a.shadow = 0; }
            if (MK_SHADOW == 8 && p == PH_G1B) { a.ph_lo = p; a.ph_hi = p + 1; a.shadow = 1; hipLaunchKernelGGL(mega_fwd, dim3(grid), dim3(NWAVES * 64), LDS_BYTES, stream, a); a.shadow = 0; }
            if (MK_SHADOW == 1 && p == PH_G1A) { a.ph_lo = p; a.ph_hi = p + 1; a.shadow = 1; hipLaunchKernelGGL(mega_fwd, dim3(grid), dim3(NWAVES * 64), LDS_BYTES, stream, a); a.shadow = 0; }
            for (int rep = 0; rep < ((((MK_DUP_MASK) >> p) & 1) ? 2 : 1); ++rep) { a.ph_lo = p; a.ph_hi = p + 1; hipLaunchKernelGGL(mega_fwd, dim3(grid), dim3(NWAVES * 64), LDS_BYTES, stream, a); }
        }
#else
        a.ph_lo = lo; a.ph_hi = hi;
        void* kargs[] = {(void*)&a};
        hipError_t e = hipLaunchCooperativeKernel((const void*)mega_fwd, dim3(grid), dim3(NWAVES * 64), kargs, LDS_BYTES, stream);
        if (e != hipSuccess) fprintf(stderr, "kernel_launch: cooperative launch failed: %s (grid %d)\n", hipGetErrorString(e), grid);
#endif
    };
    run(PH_P0, PH_COUNT);
}
```

```cpp
#include <hip/hip_runtime.h>
#include <cstdio>
#include <cstdint>

#ifndef MK_DUP_MASK
#define MK_DUP_MASK 0
#endif
#ifndef MK_GPROBE
#define MK_GPROBE 0
#endif
#ifndef MK_SHADOW
#define MK_SHADOW 0
#endif
#ifndef MK_FUSE_FINAL
#define MK_FUSE_FINAL 1
#endif
#ifndef MK_STAG
#define MK_STAG 0
#endif
#ifndef MK_NT
#define MK_NT 0x0
#endif
#ifndef MK_LEBITS
#define MK_LEBITS 6u
#endif
#ifndef MK_LOWENT
#define MK_LOWENT 3
#endif
#ifndef MK_PER_PHASE
#define MK_PER_PHASE 0
#endif

#define GAS __attribute__((address_space(1)))
#define LAS __attribute__((address_space(3)))
typedef _Float16 h16;
typedef _Float16 h16x8 __attribute__((ext_vector_type(8)));
typedef _Float16 h16x4 __attribute__((ext_vector_type(4)));
typedef _Float16 h16x2 __attribute__((ext_vector_type(2)));
typedef float f32x4 __attribute__((ext_vector_type(4)));
typedef float f32x2 __attribute__((ext_vector_type(2)));
typedef unsigned u32x4 __attribute__((ext_vector_type(4)));
typedef unsigned u32x2 __attribute__((ext_vector_type(2)));

constexpr int D = 1024, NB = 4, S = 8192, M = NB * S, DFF = 2816, NGU = 2 * DFF, NMOD = 9;
constexpr int AW = 512, HD = 64, NH = 8, INW = 2560, MBLK = 256, NBLK = S / MBLK, GC = 128;
constexpr float EPS = 1e-6f;
constexpr float C2 = 0.125f * 1.4426950408889634f;
constexpr int PQ = 0, PU = 512, PK = 1024, PV = 1536, PG = 2048;

constexpr size_t MiB = 1u << 20, KiB = 1u << 10;
constexpr size_t WS_CTL = 0, CTL_ZERO_BYTES = 1 * MiB;
constexpr size_t WS_MODP = 1 * MiB;
constexpr size_t WS_GT = 2 * MiB, WS_GP = WS_GT + 64 * KiB;
constexpr size_t WS_BIAS1 = WS_GT + 128 * KiB, WS_BIAS2 = WS_GT + 256 * KiB, WS_BIAS3 = WS_GT + 320 * KiB;
constexpr size_t WS_R1 = 3 * MiB, WS_RG = WS_R1 + 128 * KiB;
constexpr size_t WS_SSQA = 4 * MiB;
constexpr size_t WS_SSQ2 = 5 * MiB, WS_SSQ3 = 7 * MiB, WS_SSQF = 9 * MiB;
constexpr size_t WS_KMP = 11 * MiB;
constexpr size_t WS_ROPE = 12 * MiB;
constexpr size_t WS_WS16 = 14 * MiB;
constexpr size_t WS_WGU1 = 16 * MiB, WS_WD1 = 27 * MiB, WS_WIN = 33 * MiB, WS_WOUT = 38 * MiB, WS_WGU2 = 40 * MiB, WS_WD2 = 51 * MiB;
constexpr size_t WS_HG = 64 * MiB, WS_H = 128 * MiB, WS_ACT = 192 * MiB, WS_PROJ = WS_ACT;
constexpr size_t WS_LISTS = 368 * MiB, WS_END = 384 * MiB;
static_assert(WS_WD2 + (size_t)D * DFF * 2 <= WS_HG && WS_ACT + (size_t)M * DFF * 2 <= WS_LISTS, "ws map");
constexpr int CW_TMO = 0, CW_BAR = 4096;

constexpr int RING_BYTES = 131072, LDSCTL_OFF = RING_BYTES, MISC_OFF = LDSCTL_OFF + 320, LDS_BYTES = 163840;
constexpr int NWAVES = 8;

#define LDS_WAIT() asm volatile("s_waitcnt lgkmcnt(0)" ::: "memory")
#define VM_WAIT() asm volatile("s_waitcnt vmcnt(0)" ::: "memory")

__device__ __forceinline__ float wave_sum(float v) {
#pragma unroll
    for (int o = 1; o < 64; o <<= 1) v += __shfl_xor(v, o);
    return v;
}
template <int SEL, class T> __device__ __forceinline__ void st_stream(GAS T* p, const T& v) { if ((MK_NT >> SEL) & 1) __builtin_nontemporal_store(v, p); else *p = v; }
__device__ __forceinline__ unsigned pkh(float lo, float hi) { h16x2 v; v.x = (h16)lo; v.y = (h16)hi; return __builtin_bit_cast(unsigned, v); }
__device__ __forceinline__ float round8a(float x) { constexpr unsigned drop = 24u - MK_LEBITS; unsigned u = __float_as_uint(x); u += ((1u << (drop - 1)) - 1u) + ((u >> drop) & 1u); u &= ~((1u << drop) - 1u); return __uint_as_float(u); }
__device__ __forceinline__ unsigned pkh8(float lo, float hi) {
    unsigned w = pkh(lo, hi);
    if (MK_LOWENT & 2) { constexpr unsigned drop = 11u - MK_LEBITS; w = (w + (0x00010001u << (drop - 1))) & (0x00010001u * (0xFFFFu & ~((1u << drop) - 1u))); }
    return w;
}
__device__ __forceinline__ float silu_fast(float x) { return x * __builtin_amdgcn_rcpf(1.f + __builtin_amdgcn_exp2f(-1.4426950408889634f * x)); }
__device__ __forceinline__ float gelu_fast(float x) {
    const float p = x * __builtin_fmaf(x * x, -0.1029432396f, -2.3022081981f);
    return x * __builtin_amdgcn_rcpf(1.f + __builtin_amdgcn_exp2f(p));
}
__device__ __forceinline__ float rs16p(const GAS float* p) {
    float t[16];
#pragma unroll
    for (int k = 0; k < 16; ++k) t[k] = p[(size_t)k * (4 * 8192)];
    const float a = ((t[0] + t[1]) + (t[2] + t[3])) + ((t[4] + t[5]) + (t[6] + t[7])), b = ((t[8] + t[9]) + (t[10] + t[11])) + ((t[12] + t[13]) + (t[14] + t[15]));
    return rsqrtf((a + b) * (1.f / 1024.f) + 1e-6f);
}
__device__ __forceinline__ float rs16(const GAS float* p) {
    const f32x4 s0 = *(const GAS f32x4*)(p), s1 = *(const GAS f32x4*)(p + 4), s2 = *(const GAS f32x4*)(p + 8), s3 = *(const GAS f32x4*)(p + 12);
    const f32x4 st = (s0 + s1) + (s2 + s3);
    return rsqrtf(((st[0] + st[1]) + (st[2] + st[3])) * (1.f / D) + EPS);
}


__device__ __forceinline__ size_t blk_off(int row, int k, int nt) { return (((size_t)(row >> 8) * nt + (k >> 6)) * 256 + (row & 255)) * 64 + (k & 63); }

namespace pg8 {
constexpr int BM = 256, BK = 64, HALF = 128, HTB = HALF * BK * 2, STAGE_BYTES = 8 * HTB, NXCD = 8, WGM = 8;
__host__ __device__ __forceinline__ int lds_byte(int r, int c) { const int st = (r >> 4) * 2 + (c >> 5), rr = r & 15, cc = c & 31, ob = rr * 64 + cc * 2; return st * 1024 + (ob ^ (((ob >> 9) & 1) << 5)); }
__host__ __device__ __forceinline__ void stage_rc(int b, int& R, int& C) { const int st = b / 1024, sb = b % 1024, swz = sb ^ (((sb >> 9) & 1) << 5); R = (st >> 1) * 16 + swz / 64; C = (st & 1) * 32 + (swz % 64) / 2; }
struct Unit { int pm, pn; };
struct Gemm { const GAS h16* A; const GAS h16* Bt; int lda, N, K; unsigned stag = 0; };
struct StaticOrder {
    int nM, nN, nwg, G, c;
    __device__ __forceinline__ void init(int M_, int N, int G_, int c_) { nM = M_ / BM; nN = N / BM; nwg = nM * nN; G = G_; c = c_; }
    __device__ __forceinline__ bool next(int i, Unit& u) const {
        const long L = (long)i * G + c; if (L >= nwg) return false;
        int wgid = (int)L; { const int q = nwg / NXCD, r = nwg % NXCD, xcd = wgid % NXCD, off = wgid / NXCD; wgid = (xcd < r ? xcd * (q + 1) : r * (q + 1) + (xcd - r) * q) + off; }
        const int nig = WGM * nN, gid = wgid / nig, fm = gid * WGM, gsz = (nM - fm) < WGM ? (nM - fm) : WGM;
        u.pm = fm + ((wgid % nig) % gsz); u.pn = (wgid % nig) / gsz; return true;
    }
};
struct TableOrder {
    const LAS int* tab; int n;
    __device__ __forceinline__ bool next(int i, Unit& u) const { if (i >= n) return false; u.pm = tab[2 * i]; u.pn = tab[2 * i + 1]; return true; }
};
__device__ __forceinline__ TableOrder make_table(const StaticOrder& So, LAS int* tab) {
    if (threadIdx.x < 16) { Unit u; u.pm = -1; u.pn = 0; const bool ok = So.next((int)threadIdx.x, u); tab[2 * threadIdx.x] = ok ? u.pm : -1; tab[2 * threadIdx.x + 1] = u.pn; }
    __syncthreads();
    int n = 0;
    while (n < 16 && tab[2 * n] >= 0) ++n;
    TableOrder T; T.tab = tab; T.n = __builtin_amdgcn_readfirstlane(n); return T;
}
template <class Epi, bool ALIGN_EPI, int PROBE = 0, class Order = StaticOrder>
__device__ __forceinline__ void gemm_phase(LAS unsigned char* lds, const Gemm g, const Order& S, const Epi& E) {
    const int tid = threadIdx.x, wid = __builtin_amdgcn_readfirstlane(tid >> 6), lane = tid & 63, wr = wid >> 2, wc = wid & 3, fr = lane & 15, fq = lane >> 4;
    const int K = g.K, nt = K / BK;
    unsigned voffA[2], voffB[2];
    const bool ablk = (g.lda == 0);
#pragma unroll
    for (int i = 0; i < 2; ++i) { int R, C; stage_rc(tid * 16 + i * 8192, R, C); voffA[i] = (unsigned)(R * (ablk ? BK : g.lda) + C) * 2u; voffB[i] = (unsigned)(R * BK + C) * 2u; }
    const size_t kstepB = (size_t)BM * BK * 2, kstepA = ablk ? kstepB : (size_t)(BK * 2);
    const size_t hstepB = (size_t)HALF * BK * 2, hstepA = ablk ? hstepB : (size_t)HALF * g.lda * 2;
    const size_t tstepB = (size_t)nt * kstepB, tstepA = ablk ? tstepB : 2 * hstepA;
    const unsigned ldsw = (unsigned)wid * 1024u;
    const int aoff = lds_byte(wr * 64 + fr, fq * 8), boff = lds_byte(wc * 32 + fr, fq * 8);
#define PG8_SA(b, h) (((b) * 2 + (h)) * HTB)
#define PG8_SB(b, h) ((4 + (b) * 2 + (h)) * HTB)
#define PG8_STAGE(bufoff, gbase, voff) do { if (PROBE != 2) _Pragma("unroll") for (int _i = 0; _i < 2; ++_i) \
        __builtin_amdgcn_global_load_lds((const unsigned*)((const char*)(gbase) + (voff)[_i]), (LAS unsigned*)(lds + (bufoff) + ldsw + _i * 8192), 16, 0, 0); } while (0)
#define PG8_LDA(dst, b, h) do { _Pragma("unroll") for (int m = 0; m < 4; ++m) _Pragma("unroll") for (int k = 0; k < 2; ++k) dst[m][k] = *(const LAS h16x8*)(lds + PG8_SA(b, h) + aoff + m * 2048 + k * 1024); } while (0)
#define PG8_LDB(dst, b, h) do { _Pragma("unroll") for (int n = 0; n < 2; ++n) _Pragma("unroll") for (int k = 0; k < 2; ++k) dst[n][k] = *(const LAS h16x8*)(lds + PG8_SB(b, h) + boff + n * 2048 + k * 1024); } while (0)
#define PG8_MMA(ai, bj, At, Bt) do { if (PROBE == 1 && (bj) == 1) break; __builtin_amdgcn_s_setprio(1); _Pragma("unroll") for (int m = 0; m < 4; ++m) _Pragma("unroll") for (int n = 0; n < 2; ++n) _Pragma("unroll") for (int k = 0; k < 2; ++k) \
        acc[ai][bj][m][n] = __builtin_amdgcn_mfma_f32_16x16x32_f16(Bt[n][k], At[m][k], acc[ai][bj][m][n], 0, 0, 0); __builtin_amdgcn_s_setprio(0); } while (0)
#define PG8_WAIT_V(n) asm volatile("s_waitcnt vmcnt(" #n ")" ::: "memory")
#define PG8_WAIT_L(n) asm volatile("s_waitcnt lgkmcnt(" #n ")" ::: "memory")
#define PG8_BAR __builtin_amdgcn_s_barrier()
#define PG8_SCHED __builtin_amdgcn_sched_barrier(0)
    Unit cur, nxt; int ui = 0;
    if (!S.next(0, cur)) return;
    if (g.stag) { const unsigned st = (unsigned)(cur.pm & 7); if (st) { const unsigned long long t0 = __builtin_amdgcn_s_memrealtime(), dl = (unsigned long long)st * g.stag; while (__builtin_amdgcn_s_memrealtime() - t0 < dl) __builtin_amdgcn_s_sleep(4); } }
    f32x4 acc[2][2][4][2];
#pragma unroll
    for (int a = 0; a < 2; ++a)
#pragma unroll
        for (int b = 0; b < 2; ++b)
#pragma unroll
            for (int m = 0; m < 4; ++m)
#pragma unroll
                for (int n = 0; n < 2; ++n) acc[a][b][m][n] = (f32x4){0.f, 0.f, 0.f, 0.f};
    h16x8 At[4][2], B0[2][2], B1[2][2];
    const char* cA = (const char*)g.A + (size_t)cur.pm * tstepA; const char* cB = (const char*)g.Bt + (size_t)cur.pn * tstepB;
    PG8_STAGE(PG8_SB(0, 0), cB, voffB); PG8_STAGE(PG8_SB(0, 1), cB + hstepB, voffB); PG8_STAGE(PG8_SA(0, 0), cA, voffA); PG8_STAGE(PG8_SA(0, 1), cA + hstepA, voffA);
    if (wr == 1) PG8_BAR;
    PG8_WAIT_V(2); PG8_BAR;
    PG8_STAGE(PG8_SB(1, 0), cB + kstepB, voffB); PG8_STAGE(PG8_SA(1, 0), cA + kstepA, voffA); PG8_STAGE(PG8_SB(1, 1), cB + hstepB + kstepB, voffB);
    PG8_WAIT_V(6); PG8_BAR;
    for (;;) {
        const bool has_next = S.next(ui + 1, nxt);
        const char* nA = has_next ? (const char*)g.A + (size_t)nxt.pm * tstepA : cA; const char* nB = has_next ? (const char*)g.Bt + (size_t)nxt.pn * tstepB : cB;
        for (int t = 0; t < nt; t += 2) {
            const bool last = (t == nt - 2);
            const char* a1 = cA + (size_t)(t + 1) * kstepA;
            const char* a2 = last ? nA : cA + (size_t)(t + 2) * kstepA; const char* b2 = last ? nB : cB + (size_t)(t + 2) * kstepB;
            const char* a3 = a2 + kstepA; const char* b3 = b2 + kstepB;
            if constexpr (Epi::MID) { if (t == nt / 2) E.mid(acc, cur, ui, wr, wc, fr, fq); }
            PG8_LDB(B0, 0, 0); PG8_LDB(B1, 0, 1); PG8_SCHED; PG8_LDA(At, 0, 0); PG8_STAGE(PG8_SA(1, 1), a1 + hstepA, voffA);
            PG8_WAIT_V(8); PG8_WAIT_L(0); PG8_BAR; PG8_MMA(0, 0, At, B0); PG8_MMA(0, 1, At, B1); PG8_BAR; PG8_SCHED;
            PG8_LDA(At, 0, 1); PG8_STAGE(PG8_SB(0, 0), b2, voffB); PG8_STAGE(PG8_SB(0, 1), b2 + hstepB, voffB); PG8_STAGE(PG8_SA(0, 0), a2, voffA);
            PG8_WAIT_V(8); PG8_WAIT_L(0); PG8_BAR; PG8_MMA(1, 0, At, B0); PG8_MMA(1, 1, At, B1); PG8_BAR; PG8_SCHED;
            PG8_LDB(B0, 1, 0); PG8_LDB(B1, 1, 1); PG8_SCHED; PG8_LDA(At, 1, 0); PG8_STAGE(PG8_SA(0, 1), a2 + hstepA, voffA);
            PG8_WAIT_V(8); PG8_WAIT_L(0); PG8_BAR; PG8_MMA(0, 0, At, B0); PG8_MMA(0, 1, At, B1); PG8_BAR; PG8_SCHED;
            PG8_LDA(At, 1, 1); PG8_STAGE(PG8_SB(1, 0), b3, voffB); PG8_STAGE(PG8_SB(1, 1), b3 + hstepB, voffB); PG8_STAGE(PG8_SA(1, 0), a3, voffA);
            PG8_WAIT_V(8); PG8_WAIT_L(0); PG8_BAR; PG8_MMA(1, 0, At, B0); PG8_MMA(1, 1, At, B1); PG8_BAR; PG8_SCHED;
        }
        if constexpr (ALIGN_EPI) { if (wr == 0) PG8_BAR; }
        E(acc, cur, ui, wr, wc, fr, fq);
        if (!has_next) break;
#pragma unroll
        for (int a = 0; a < 2; ++a)
#pragma unroll
            for (int b = 0; b < 2; ++b)
#pragma unroll
                for (int m = 0; m < 4; ++m)
#pragma unroll
                    for (int n = 0; n < 2; ++n) acc[a][b][m][n] = (f32x4){0.f, 0.f, 0.f, 0.f};
        cur = nxt; cA = nA; cB = nB; ++ui;
        if constexpr (ALIGN_EPI) { if (wr == 1) PG8_BAR; }
    }
    PG8_WAIT_V(0);
    if constexpr (!ALIGN_EPI) { if (wr == 0) PG8_BAR; }
    PG8_BAR;
#undef PG8_SA
#undef PG8_SB
#undef PG8_STAGE
#undef PG8_LDA
#undef PG8_LDB
#undef PG8_MMA
#undef PG8_WAIT_V
#undef PG8_WAIT_L
#undef PG8_BAR
#undef PG8_SCHED
}
}

typedef const f32x4 (&AccRef)[2][2][4][2];
struct EpiSwiglu {
    static constexpr bool MID = false;
    GAS h16* act; const LAS float* rtab; const GAS float* bias;
    __device__ __forceinline__ void mid(f32x4 (&)[2][2][4][2], const pg8::Unit&, int, int, int, int, int) const {}
    __device__ __forceinline__ void operator()(AccRef acc, const pg8::Unit& u, int ui, int wr, int wc, int fr, int fq) const {
        const int b = u.pm >> 5, row0 = u.pm * 256 + wr * 64 + fr;
        const GAS float* bp = bias + b * NGU + u.pn * 256 + wc * 32 + 4 * fq;
        f32x4 bv[2][2];
#pragma unroll
        for (int bj = 0; bj < 2; ++bj)
#pragma unroll
            for (int n = 0; n < 2; ++n) bv[bj][n] = *(const GAS f32x4*)(bp + bj * 128 + n * 16) * (bj ? -0.6931471805599453f : -1.4426950408889634f);
        const LAS float* rt = rtab + ui * 256 + wr * 64 + fr;
        const int hid0 = u.pn * 128 + wc * 32 + fq * 8;
#pragma unroll
        for (int ai = 0; ai < 2; ++ai)
#pragma unroll
            for (int m = 0; m < 4; ++m) {
                const int ro = ai * 128 + m * 16; const float rs = rt[ro], rsg = rs * -1.4426950408889634f, rsu = rs * -0.6931471805599453f;
                u32x4 w;
#pragma unroll
                for (int n = 0; n < 2; ++n) {
                    const f32x4 gq = acc[ai][0][m][n] * rsg + bv[0][n], uq = acc[ai][1][m][n] * rsu + bv[1][n];
                    float a4[4];
#pragma unroll
                    for (int e = 0; e < 4; ++e) a4[e] = (gq[e] * uq[e]) * __builtin_amdgcn_rcpf(1.f + __builtin_amdgcn_exp2f(gq[e]));
                    w[2 * n] = pkh8(a4[0], a4[1]); w[2 * n + 1] = pkh8(a4[2], a4[3]);
                }
                st_stream<3>((GAS u32x4*)(act + blk_off(row0 + ro, hid0, DFF / 64)), w);
            }
    }
};
struct EpiNull {
    static constexpr bool MID = false;
    __device__ __forceinline__ void mid(f32x4 (&)[2][2][4][2], const pg8::Unit&, int, int, int, int, int) const {}
    __device__ __forceinline__ void operator()(AccRef acc, const pg8::Unit& u, int ui, int wr, int wc, int fr, int fq) const {
#pragma unroll
        for (int ai = 0; ai < 2; ++ai)
#pragma unroll
            for (int bj = 0; bj < 2; ++bj)
#pragma unroll
                for (int m = 0; m < 4; ++m)
#pragma unroll
                    for (int n = 0; n < 2; ++n) asm volatile("" :: "v"(acc[ai][bj][m][n]));
    }
};
template <bool RES_F32, bool TWOSCALE, bool WRITE_HG, int PVAR = 0> struct EpiResid {
    static constexpr bool MID = TWOSCALE;
    const GAS float* xres; GAS h16* H; GAS h16* HG; const GAS float* cs; const GAS float* gp; GAS float* ssq; const LAS float* sct; float cmul;
    __device__ __forceinline__ void mid(f32x4 (&acc)[2][2][4][2], const pg8::Unit& u, int ui, int wr, int wc, int fr, int fq) const {
        if constexpr (TWOSCALE) {
            const LAS float* t = sct + ui * 512 + wr * 64 + fr;
#pragma unroll
            for (int ai = 0; ai < 2; ++ai)
#pragma unroll
                for (int m = 0; m < 4; ++m) { const float f = t[ai * 128 + m * 16];
#pragma unroll
                    for (int bj = 0; bj < 2; ++bj)
#pragma unroll
                        for (int n = 0; n < 2; ++n) acc[ai][bj][m][n] *= f; }
        }
    }
    __device__ __forceinline__ void operator()(AccRef acc, const pg8::Unit& u, int ui, int wr, int wc, int fr, int fq) const {
        const int b = u.pm >> 5, row0 = u.pm * 256 + wr * 64 + fr, col0 = u.pn * 256 + wc * 32 + 8 * fq;
        f32x4 csv[2][2], gpv[2][2];
#pragma unroll
        for (int bj = 0; bj < 2; ++bj)
#pragma unroll
            for (int n = 0; n < 2; ++n) { csv[bj][n] = *(const GAS f32x4*)(cs + b * D + col0 + bj * 128 + 4 * n) * cmul; if constexpr (WRITE_HG) gpv[bj][n] = *(const GAS f32x4*)(gp + b * D + col0 + bj * 128 + 4 * n); }
        constexpr int MB_ = RES_F32 ? 2 : 4;
        float qs[8];
#pragma unroll
        for (int ai = 0; ai < 2; ++ai)
#pragma unroll
        for (int m0 = 0; m0 < 4; m0 += MB_) {
            f32x4 rf[4][2][2]; h16x8 rh[4][2];
#pragma unroll
            for (int m = m0; m < m0 + MB_; ++m)
#pragma unroll
                for (int bj = 0; bj < 2; ++bj) { const size_t off = (size_t)(row0 + ai * 128 + m * 16) * D + col0 + bj * 128;
                    if constexpr (PVAR == 2 || PVAR == 6 || PVAR == 7) { rf[m][bj][0] = (f32x4){0.f, 0.f, 0.f, 0.f}; rf[m][bj][1] = rf[m][bj][0]; rh[m][bj] = (h16x8){0, 0, 0, 0, 0, 0, 0, 0}; }
                    else if constexpr (PVAR == 3) { const h16x8 t = *(const GAS h16x8*)(HG + blk_off(row0 + ai * 128 + m * 16, col0 + bj * 128, D / 64)); rf[m][bj][0] = (f32x4){(float)t[0], (float)t[1], (float)t[2], (float)t[3]}; rf[m][bj][1] = (f32x4){(float)t[4], (float)t[5], (float)t[6], (float)t[7]}; }
                    else if constexpr (RES_F32) { rf[m][bj][0] = *(const GAS f32x4*)(xres + off); rf[m][bj][1] = *(const GAS f32x4*)(xres + off + 4); }
                    else rh[m][bj] = *(const GAS h16x8*)(H + off); }
            asm volatile("" ::: "memory");
#pragma unroll
            for (int m = m0; m < m0 + MB_; ++m) {
                const int row = row0 + ai * 128 + m * 16; const size_t off = (size_t)row * D + col0;
                float rsc = 1.f; if constexpr (TWOSCALE) rsc = sct[ui * 512 + 256 + wr * 64 + fr + ai * 128 + m * 16];
                float q = 0.f;
#pragma unroll
                for (int bj = 0; bj < 2; ++bj) {
                    f32x4 r0, r1;
                    if constexpr (RES_F32) { r0 = rf[m][bj][0]; r1 = rf[m][bj][1]; }
                    else { const h16x8 hv = rh[m][bj]; r0 = (f32x4){(float)hv[0], (float)hv[1], (float)hv[2], (float)hv[3]}; r1 = (f32x4){(float)hv[4], (float)hv[5], (float)hv[6], (float)hv[7]}; }
                    const f32x4 v0 = r0 + csv[bj][0] * (acc[ai][bj][m][0] * rsc), v1 = r1 + csv[bj][1] * (acc[ai][bj][m][1] * rsc);
                    q += ((v0[0] * v0[0] + v0[1] * v0[1]) + (v0[2] * v0[2] + v0[3] * v0[3])) + ((v1[0] * v1[0] + v1[1] * v1[1]) + (v1[2] * v1[2] + v1[3] * v1[3]));
                    u32x4 w; w[0] = pkh(v0[0], v0[1]); w[1] = pkh(v0[2], v0[3]); w[2] = pkh(v1[0], v1[1]); w[3] = pkh(v1[2], v1[3]);
                    const int colp = u.pn * 256 + wc * 64 + 16 * fq + 8 * bj;
                    if constexpr (PVAR == 1) asm volatile("" :: "v"(w)); else if constexpr (PVAR == 4) *(GAS u32x4*)(H + blk_off(row, col0 + bj * 128, D / 64)) = w;
                    else if constexpr (PVAR == 5) *(GAS u32x4*)(H + (size_t)row * D + colp) = w; else if constexpr (PVAR == 7) __builtin_nontemporal_store(w, (GAS u32x4*)(H + off + bj * 128)); else st_stream<1>((GAS u32x4*)(H + off + bj * 128), w);
                    if constexpr (WRITE_HG) { const f32x4 g0 = v0 * gpv[bj][0], g1 = v1 * gpv[bj][1];
                        u32x4 wg;
                        if constexpr (TWOSCALE) { wg[0] = pkh8(g0[0], g0[1]); wg[1] = pkh8(g0[2], g0[3]); wg[2] = pkh8(g1[0], g1[1]); wg[3] = pkh8(g1[2], g1[3]); }
                        else { wg[0] = pkh(g0[0], g0[1]); wg[1] = pkh(g0[2], g0[3]); wg[2] = pkh(g1[0], g1[1]); wg[3] = pkh(g1[2], g1[3]); }
                        if constexpr (PVAR == 1 || PVAR == 6) asm volatile("" :: "v"(wg)); else if constexpr (PVAR == 7) __builtin_nontemporal_store(wg, (GAS u32x4*)(HG + blk_off(row, col0 + bj * 128, D / 64))); else if constexpr (PVAR == 5) *(GAS u32x4*)(HG + blk_off(row, colp, D / 64)) = wg; else st_stream<2>((GAS u32x4*)(HG + blk_off(row, col0 + bj * 128, D / 64)), wg); }
                }
                q += __shfl_xor(q, 16); q += __shfl_xor(q, 32);
                qs[ai * 4 + m] = q;
            }
        }
        if constexpr (PVAR != 1) {
            const float qa = fq == 0 ? qs[0] : fq == 1 ? qs[2] : fq == 2 ? qs[4] : qs[6], qb = fq == 0 ? qs[1] : fq == 1 ? qs[3] : fq == 2 ? qs[5] : qs[7];
            GAS float* sp = ssq + (size_t)(u.pn * 4 + wc) * M + row0 + (fq >> 1) * 128 + (fq & 1) * 32;
            sp[0] = qa; sp[16] = qb;
        }
    }
};
constexpr int CW_PAN = 16384;
struct EpiFinal {
    static constexpr bool MID = false;
    const GAS h16* H; const GAS float* cs; const GAS float* gfin; GAS float* out; unsigned* xs; unsigned* cnt; unsigned* tmo; LAS float* P; LAS float* Sx; float cmul;
    __device__ __forceinline__ void mid(f32x4 (&)[2][2][4][2], const pg8::Unit&, int, int, int, int, int) const {}
    __device__ __forceinline__ void operator()(f32x4 (&acc)[2][2][4][2], const pg8::Unit& u, int ui, int wr, int wc, int fr, int fq) const {
        const int b = u.pm >> 5, row0 = u.pm * 256 + wr * 64 + fr, col0 = u.pn * 256 + wc * 32 + 8 * fq;
        const int tid = threadIdx.x, lane = tid & 63, wid = __builtin_amdgcn_readfirstlane(tid >> 6);
        f32x4 csv[2][2];
#pragma unroll
        for (int bj = 0; bj < 2; ++bj)
#pragma unroll
            for (int n = 0; n < 2; ++n) csv[bj][n] = *(const GAS f32x4*)(cs + b * D + col0 + bj * 128 + 4 * n) * cmul;
#pragma unroll
        for (int ai = 0; ai < 2; ++ai) {
            h16x8 rh[4][2];
#pragma unroll
            for (int m = 0; m < 4; ++m)
#pragma unroll
                for (int bj = 0; bj < 2; ++bj) rh[m][bj] = *(const GAS h16x8*)(H + (size_t)(row0 + ai * 128 + m * 16) * D + col0 + bj * 128);
#pragma unroll
            for (int m = 0; m < 4; ++m) {
                float q = 0.f;
#pragma unroll
                for (int bj = 0; bj < 2; ++bj) { const h16x8 hv = rh[m][bj];
                    const f32x4 v0 = (f32x4){(float)hv[0], (float)hv[1], (float)hv[2], (float)hv[3]} + csv[bj][0] * acc[ai][bj][m][0], v1 = (f32x4){(float)hv[4], (float)hv[5], (float)hv[6], (float)hv[7]} + csv[bj][1] * acc[ai][bj][m][1];
                    acc[ai][bj][m][0] = v0; acc[ai][bj][m][1] = v1;
                    q += ((v0[0] * v0[0] + v0[1] * v0[1]) + (v0[2] * v0[2] + v0[3] * v0[3])) + ((v1[0] * v1[0] + v1[1] * v1[1]) + (v1[2] * v1[2] + v1[3] * v1[3])); }
                q += __shfl_xor(q, 16); q += __shfl_xor(q, 32);
                if (fq == 0) P[(ai * 128 + wr * 64 + m * 16 + fr) * 4 + wc] = q;
            }
        }
        asm volatile("s_waitcnt lgkmcnt(0)" ::: "memory"); __builtin_amdgcn_s_barrier(); asm volatile("" ::: "memory");
        if (tid < 256) {
            const f32x4 p4 = *(const LAS f32x4*)(P + tid * 4);
            __hip_atomic_store(xs + ((size_t)(u.pm * 256 + tid) * 4 + u.pn), __float_as_uint((p4[0] + p4[1]) + (p4[2] + p4[3])), __ATOMIC_RELAXED, __HIP_MEMORY_SCOPE_AGENT);
        }
        asm volatile("s_waitcnt vmcnt(0)" ::: "memory");
        if (wid < 4 && lane == 0) __hip_atomic_fetch_add(cnt + 64 * u.pm, 1u, __ATOMIC_RELAXED, __HIP_MEMORY_SCOPE_AGENT);
        if (wid == 0) {
            unsigned sp = 0u;
            while ((unsigned)__builtin_amdgcn_readfirstlane(__hip_atomic_load(cnt + 64 * u.pm, __ATOMIC_RELAXED, __HIP_MEMORY_SCOPE_AGENT)) < 16u) {
                __builtin_amdgcn_s_sleep(2);
                if (++sp > (1u << 16)) { if (lane == 0) __hip_atomic_store(tmo, 1u, __ATOMIC_RELAXED, __HIP_MEMORY_SCOPE_AGENT); break; }
            }
            __builtin_amdgcn_fence(__ATOMIC_ACQUIRE, "agent");
        }
        asm volatile("s_waitcnt vmcnt(0) lgkmcnt(0)" ::: "memory"); __builtin_amdgcn_s_barrier(); asm volatile("" ::: "memory");
        if (tid < 256) {
            const unsigned* sl = xs + (size_t)(u.pm * 256 + tid) * 4;
            const float s0 = __uint_as_float(__hip_atomic_load(sl + 0, __ATOMIC_RELAXED, __HIP_MEMORY_SCOPE_AGENT)), s1 = __uint_as_float(__hip_atomic_load(sl + 1, __ATOMIC_RELAXED, __HIP_MEMORY_SCOPE_AGENT)),
                        s2 = __uint_as_float(__hip_atomic_load(sl + 2, __ATOMIC_RELAXED, __HIP_MEMORY_SCOPE_AGENT)), s3 = __uint_as_float(__hip_atomic_load(sl + 3, __ATOMIC_RELAXED, __HIP_MEMORY_SCOPE_AGENT));
            Sx[tid] = rsqrtf(((s0 + s1) + (s2 + s3)) * (1.f / D) + EPS);
        }
        asm volatile("s_waitcnt vmcnt(0) lgkmcnt(0)" ::: "memory"); __builtin_amdgcn_s_barrier(); asm volatile("" ::: "memory");
        f32x4 gv[2][2];
#pragma unroll
        for (int bj = 0; bj < 2; ++bj)
#pragma unroll
            for (int n = 0; n < 2; ++n) gv[bj][n] = *(const GAS f32x4*)(gfin + col0 + bj * 128 + 4 * n);
#pragma unroll
        for (int ai = 0; ai < 2; ++ai)
#pragma unroll
            for (int m = 0; m < 4; ++m) { const int rl = ai * 128 + wr * 64 + m * 16 + fr; const float rs = Sx[rl]; GAS float* op = out + (size_t)(u.pm * 256 + rl) * D + col0;
#pragma unroll
                for (int bj = 0; bj < 2; ++bj) { st_stream<0>((GAS f32x4*)(op + bj * 128), acc[ai][bj][m][0] * rs * gv[bj][0]); st_stream<0>((GAS f32x4*)(op + bj * 128 + 4), acc[ai][bj][m][1] * rs * gv[bj][1]); } }
        asm volatile("s_waitcnt lgkmcnt(0)" ::: "memory"); __builtin_amdgcn_s_barrier(); asm volatile("" ::: "memory");
    }
};
struct EpiInproj {
    static constexpr bool MID = false;
    GAS h16* proj; const LAS float* rtab; const GAS float* bias; const GAS float* rope; GAS float* kmp;
    __device__ __forceinline__ void mid(f32x4 (&)[2][2][4][2], const pg8::Unit&, int, int, int, int, int) const {}
    __device__ __forceinline__ void operator()(AccRef acc, const pg8::Unit& u, int ui, int wr, int wc, int fr, int fq) const {
        const int b = u.pm >> 5, row0 = u.pm * 256 + wr * 64 + fr, region = u.pn >> 1;
        const GAS float* bp = bias + b * INW + u.pn * 256 + wc * 32 + 4 * fq;
        f32x4 bv[2][2];
#pragma unroll
        for (int bj = 0; bj < 2; ++bj)
#pragma unroll
            for (int n = 0; n < 2; ++n) bv[bj][n] = *(const GAS f32x4*)(bp + bj * 128 + n * 16);
        const bool is_rope = (region == 0) || (region == 2);
        const float qs = (region == 0) ? C2 : 1.f;
#pragma unroll
        for (int bj = 0; bj < 2; ++bj)
#pragma unroll
            for (int n = 0; n < 2; ++n) bv[bj][n] *= qs;
        f32x4 csum[2][2];
#pragma unroll
        for (int bj = 0; bj < 2; ++bj)
#pragma unroll
            for (int n = 0; n < 2; ++n) csum[bj][n] = (f32x4){0.f, 0.f, 0.f, 0.f};
        const LAS float* rt = rtab + ui * 256 + wr * 64 + fr;
#pragma unroll
        for (int ai = 0; ai < 2; ++ai)
#pragma unroll
        for (int m0 = 0; m0 < 4; m0 += 2) {
            f32x4 rcs[4][2], rsn[4][2];
            if (is_rope) {
#pragma unroll
                for (int m = m0; m < m0 + 2; ++m) { const GAS float* rp = rope + (size_t)((row0 + ai * 128 + m * 16) & (S - 1)) * 64 + 4 * fq;
#pragma unroll
                    for (int n = 0; n < 2; ++n) { rcs[m][n] = *(const GAS f32x4*)(rp + 16 * n); rsn[m][n] = *(const GAS f32x4*)(rp + 32 + 16 * n); } }
            }
            asm volatile("" ::: "memory");
#pragma unroll
            for (int m = m0; m < m0 + 2; ++m) {
                const int row = row0 + ai * 128 + m * 16;
                const float rs = rt[ai * 128 + m * 16] * qs;
                f32x4 v[2][2];
#pragma unroll
                for (int bj = 0; bj < 2; ++bj)
#pragma unroll
                    for (int n = 0; n < 2; ++n) v[bj][n] = acc[ai][bj][m][n] * rs + bv[bj][n];
                GAS h16* prow = proj + (size_t)row * INW + region * 512 + (u.pn & 1) * 256;
                if (is_rope) {
#pragma unroll
                    for (int n = 0; n < 2; ++n) {
                        const f32x4 cs4 = rcs[m][n], sn4 = rsn[m][n];
                        const f32x4 x1 = v[0][n], x2 = v[1][n];
                        v[0][n] = x1 * cs4 - x2 * sn4; v[1][n] = x2 * cs4 + x1 * sn4;
                    }
                    GAS h16* hp = prow + wc * 64 + 16 * fq;
#pragma unroll
                    for (int bj = 0; bj < 2; ++bj) { u32x4 w; w[0] = pkh(v[bj][0][0], v[bj][0][1]); w[1] = pkh(v[bj][0][2], v[bj][0][3]); w[2] = pkh(v[bj][1][0], v[bj][1][1]); w[3] = pkh(v[bj][1][2], v[bj][1][3]);
                        st_stream<4>((GAS u32x4*)(hp + 8 * bj), w); }
                    if (region == 2) {
#pragma unroll
                        for (int bj = 0; bj < 2; ++bj)
#pragma unroll
                            for (int n = 0; n < 2; ++n) csum[bj][n] += v[bj][n];
                    }
                } else {
                    if (region == 1 || region == 4) {
#pragma unroll
                        for (int bj = 0; bj < 2; ++bj)
#pragma unroll
                            for (int n = 0; n < 2; ++n)
#pragma unroll
                                for (int j = 0; j < 4; ++j) v[bj][n][j] = gelu_fast(v[bj][n][j]);
                    }
                    GAS h16* hp = prow + wc * 32 + 8 * fq;
#pragma unroll
                    for (int bj = 0; bj < 2; ++bj) { u32x4 w; w[0] = pkh(v[bj][0][0], v[bj][0][1]); w[1] = pkh(v[bj][0][2], v[bj][0][3]); w[2] = pkh(v[bj][1][0], v[bj][1][1]); w[3] = pkh(v[bj][1][2], v[bj][1][3]);
                        st_stream<4>((GAS u32x4*)(hp + 128 * bj), w); }
                }
            }
        }
        if (region == 2) {
#pragma unroll
            for (int bj = 0; bj < 2; ++bj)
#pragma unroll
                for (int n = 0; n < 2; ++n)
#pragma unroll
                    for (int j = 0; j < 4; ++j) { float t = csum[bj][n][j]; t += __shfl_xor(t, 1); t += __shfl_xor(t, 2); t += __shfl_xor(t, 4); t += __shfl_xor(t, 8); csum[bj][n][j] = t; }
            if (fr == 0) {
                GAS float* kp = kmp + ((size_t)((b * NBLK + (u.pm & 31)) * 2 + wr)) * 512 + ((u.pn & 1) * 4 + wc) * 64 + 16 * fq;
#pragma unroll
                for (int bj = 0; bj < 2; ++bj)
#pragma unroll
                    for (int n = 0; n < 2; ++n) *(GAS f32x4*)(kp + 8 * bj + 4 * n) = csum[bj][n];
            }
        }
    }
};

#define XB_TMO      128
#define XB_XCNT(j)  (256  + 64 * (j))
#define XB_XSUB(j)  (1280 + 64 * (j))
#define XB_XGEN(j)  (2304 + 64 * (j))
#define XB_TOP      3328
#define XB_TOPGEN   3392
#define XCD_BAR_WORDS 3456
#define XB_SPIN_CAP (1u << 18)
__device__ __forceinline__ unsigned xb_ld(unsigned* p)              { return __hip_atomic_load(p, __ATOMIC_RELAXED, __HIP_MEMORY_SCOPE_AGENT); }
__device__ __forceinline__ unsigned xb_add(unsigned* p, unsigned v) { return __hip_atomic_fetch_add(p, v, __ATOMIC_RELAXED, __HIP_MEMORY_SCOPE_AGENT); }
__device__ __forceinline__ unsigned xb_xcc_id() { return (unsigned)__builtin_amdgcn_s_getreg((3 << 11) | 20) & 0xFu; }
#define XB_SPIN(cond, bar) do { unsigned _sp = 0; while (cond) { __builtin_amdgcn_s_sleep(1); \
    if ((++_sp & 255u) == 0u) { if (xb_ld(&(bar)[XB_TMO])) break; if (_sp > XB_SPIN_CAP) { atomicAdd(&(bar)[XB_TMO], 1u); break; } } } } while (0)
struct XcdBarrier { unsigned* bar; unsigned x; volatile LAS unsigned* st; };
__device__ __forceinline__ XcdBarrier xcd_barrier_post(unsigned* bar, volatile LAS unsigned* st) {
    XcdBarrier b; b.bar = bar; b.x = xb_xcc_id(); b.st = st;
    if (threadIdx.x == 0) (void)xb_add(&bar[XB_XCNT(b.x)], 1u);
    return b;
}
__device__ __forceinline__ void xcd_barrier_complete(unsigned* bar, unsigned x, unsigned& nloc, unsigned& nx) {
    const unsigned G = gridDim.x * gridDim.y * gridDim.z;
    unsigned sum, cnt, mine, sp = 0u;
    for (;;) {
        sum = 0u; cnt = 0u; mine = 0u;
#pragma unroll
        for (unsigned j = 0; j < 16; ++j) { const unsigned c = xb_ld(&bar[XB_XCNT(j)]); sum += c; cnt += (c > 0u) ? 1u : 0u; mine = (j == x) ? c : mine; }
        if (sum == G) break;
        __builtin_amdgcn_s_sleep(1);
        if ((++sp & 255u) == 0u) { if (xb_ld(&bar[XB_TMO])) break; if (sp > XB_SPIN_CAP) { atomicAdd(&bar[XB_TMO], 1u); break; } }
    }
    nloc = mine > 0u ? mine : 1u; nx = cnt > 0u ? cnt : 1u;
}
__device__ __forceinline__ void xcd_barrier(const XcdBarrier& b) {
    asm volatile("s_waitcnt vmcnt(0)" ::: "memory");
    __syncthreads();
    if (threadIdx.x == 0) {
        unsigned* bar = b.bar;
        __builtin_amdgcn_s_waitcnt(0);
        unsigned nloc = b.st[0], nx = b.st[1];
        if (nloc == 0u) { xcd_barrier_complete(bar, b.x, nloc, nx); b.st[0] = nloc; b.st[1] = nx; }
        const unsigned old = xb_add(&bar[XB_XSUB(b.x)], 1u);
        const unsigned gen = old / nloc;
        if (old + 1u == (gen + 1u) * nloc) {
            __builtin_amdgcn_fence(__ATOMIC_RELEASE, "agent");
            asm volatile("s_waitcnt vmcnt(0)" ::: "memory");
            const unsigned og = xb_add(&bar[XB_TOP], 1u);
            const unsigned tg = og / nx;
            if (og + 1u == (tg + 1u) * nx) xb_add(&bar[XB_TOPGEN], 1u);
            else XB_SPIN(xb_ld(&bar[XB_TOPGEN]) == tg, bar);
            __builtin_amdgcn_fence(__ATOMIC_ACQUIRE, "agent");
            xb_add(&bar[XB_XGEN(b.x)], 1u);
            asm volatile("s_waitcnt vmcnt(0)" ::: "memory");
        } else {
            XB_SPIN(xb_ld(&bar[XB_XGEN(b.x)]) == gen, bar);
            __builtin_amdgcn_fence(__ATOMIC_ACQUIRE, "agent");
            asm volatile("s_waitcnt vmcnt(0)" ::: "memory");
        }
    }
    __syncthreads();
}

#define GIN(a_, i_) ((const GAS float*)(a_).in[i_])
struct Args { const float* in[20]; float* out; unsigned char* ws; int ph_lo, ph_hi; int shadow, pad; };
struct Frame {
    LAS unsigned char* lds; volatile LAS unsigned* MISC; unsigned* ctl;
    int tid, lane, wave, vcu, G;
    unsigned char* ws; GAS float* out;
};

__device__ __forceinline__ float round8(float x) { return round8a(x); }
__device__ __forceinline__ int p8(int l) { return (l & ~31) + 16 * ((l >> 2) & 1) + 4 * ((l >> 3) & 3) + (l & 3); }
__device__ __forceinline__ int phys_gu(int L) { const int isu = L >= DFF, hid = isu ? L - DFF : L, pn = hid >> 7, hh = hid & 127; return 256 * pn + 128 * isu + p8(hh); }
__device__ __forceinline__ int phys_in(int L) {
    const int reg = L >> 9, l = L & 511;
    const int preg = reg == 0 ? 0 : reg == 1 ? 2 : reg == 2 ? 3 : reg == 3 ? 1 : 4;
    if (reg <= 1) { const int head = l >> 6, d = l & 63, bj = d >> 5, i = d & 31; return 512 * preg + 256 * (head >> 2) + 128 * bj + 32 * (head & 3) + i; }
    return 512 * preg + p8(l);
}
enum PhysKind { PH_GU = 0, PH_P8 = 1, PH_IN = 2 };
template <int KIND> __device__ __forceinline__ int physmap(int L) { return KIND == PH_GU ? phys_gu(L) : KIND == PH_P8 ? p8(L) : phys_in(L); }

template <int KIND, bool LOWENT = false> __device__ __forceinline__ void p0_transpose_item(const GAS float* W, int K, int N, GAS h16* WT, const GAS float* kscale, LAS float* scr, int item, int lane) {
    const int nblk = N / 32, kb = item / nblk, nb = item % nblk, k0 = 64 * kb, n0 = 32 * nb;
    float wv[32];
#pragma unroll
    for (int i = 0; i < 32; ++i) { const int kk = 2 * i + (lane >> 5); wv[i] = W[(size_t)(k0 + kk) * N + n0 + (lane & 31)]; }
    if (kscale) {
#pragma unroll
        for (int i = 0; i < 32; ++i) wv[i] *= kscale[k0 + 2 * i + (lane >> 5)]; }
#pragma unroll
    for (int i = 0; i < 32; ++i) scr[(2 * i + (lane >> 5)) * 33 + (lane & 31)] = (LOWENT && MK_LOWENT) ? round8(wv[i]) : wv[i];
    LDS_WAIT(); asm volatile("" ::: "memory");
    const int c = lane & 7;
#pragma unroll
    for (int j = 0; j < 4; ++j) { const int n = (lane >> 3) + 8 * j; const LAS float* s = scr + (8 * c) * 33 + n;
        u32x4 o; o.x = pkh(s[0 * 33], s[1 * 33]); o.y = pkh(s[2 * 33], s[3 * 33]); o.z = pkh(s[4 * 33], s[5 * 33]); o.w = pkh(s[6 * 33], s[7 * 33]);
        *(GAS u32x4*)(WT + blk_off(physmap<KIND>(n0 + n), k0 + 8 * c, K / 64)) = o; }
    LDS_WAIT(); asm volatile("" ::: "memory");
}

__device__ __forceinline__ void p0_prologue(const Frame& F0, const Args& a) {
    Frame F = F0; F.tid = threadIdx.x; F.lane = F.tid & 63; F.wave = __builtin_amdgcn_readfirstlane(F.tid >> 6);
    const GAS float* c = GIN(a, 1); const GAS float* w_ada = GIN(a, 2);
    {
        LAS float* red = (LAS float*)F.lds;
        for (int item = F.vcu; item < 72 * 4; item += F.G) {
            const int cg = item % 72, kq = item / 72, hlf = F.lane >> 5, col = cg * 128 + (F.lane & 31) * 4;
            f32x4 acc[4] = {{0.f, 0.f, 0.f, 0.f}, {0.f, 0.f, 0.f, 0.f}, {0.f, 0.f, 0.f, 0.f}, {0.f, 0.f, 0.f, 0.f}};
            const int kbase = kq * 256 + F.wave * 32 + hlf;
#pragma unroll
            for (int i = 0; i < 16; ++i) { const int k = kbase + 2 * i; const f32x4 w4 = *(const GAS f32x4*)(w_ada + (size_t)k * (NMOD * D) + col);
#pragma unroll
                for (int b = 0; b < 4; ++b) { const float cv = c[b * D + k]; const float sv = cv / (1.f + __expf(-cv)); acc[b] += w4 * sv; } }
#pragma unroll
            for (int b = 0; b < 4; ++b)
#pragma unroll
                for (int j = 0; j < 4; ++j) acc[b][j] += __shfl_xor(acc[b][j], 32);
            if (hlf == 0) {
#pragma unroll
                for (int b = 0; b < 4; ++b) *(LAS f32x4*)(red + (F.wave * 4 + b) * 128 + (F.lane & 31) * 4) = acc[b];
            }
            __syncthreads();
            { const int b = F.tid >> 7, cc = F.tid & 127; float s = 0.f;
#pragma unroll
              for (int w = 0; w < 8; ++w) s += red[(w * 4 + b) * 128 + cc];
              ((GAS float*)(F.ws + WS_MODP))[(size_t)(kq * 4 + b) * (NMOD * D) + cg * 128 + cc] = s; }
            __syncthreads();
        }
    }
    LAS float* scr = (LAS float*)(F.lds + F.wave * 16384);
    const int gw = F.vcu * NWAVES + F.wave, NGW = F.G * NWAVES;
    constexpr int I_GU = (D / 64) * (NGU / 32), I_DN = (DFF / 64) * (D / 32), I_IN = (D / 64) * (INW / 32), I_OUT = (D / 64) * (D / 32);
    constexpr int NITEMS = 2 * I_GU + 2 * I_DN + I_IN + I_OUT;
    for (int it = gw; it < NITEMS; it += NGW) {
        int r = it;
        if (r < I_GU) { p0_transpose_item<PH_GU, true>(GIN(a, 5), D, NGU, (GAS h16*)(F.ws + WS_WGU1), nullptr, scr, r, F.lane); continue; } r -= I_GU;
        if (r < I_GU) { p0_transpose_item<PH_GU, true>(GIN(a, 17), D, NGU, (GAS h16*)(F.ws + WS_WGU2), nullptr, scr, r, F.lane); continue; } r -= I_GU;
        if (r < I_DN) { p0_transpose_item<PH_P8, true>(GIN(a, 6), DFF, D, (GAS h16*)(F.ws + WS_WD1), nullptr, scr, r, F.lane); continue; } r -= I_DN;
        if (r < I_DN) { p0_transpose_item<PH_P8, true>(GIN(a, 18), DFF, D, (GAS h16*)(F.ws + WS_WD2), nullptr, scr, r, F.lane); continue; } r -= I_DN;
        if (r < I_IN) { p0_transpose_item<PH_IN>(GIN(a, 8), D, INW, (GAS h16*)(F.ws + WS_WIN), nullptr, scr, r, F.lane); continue; } r -= I_IN;
        {
            const int kb = r / (D / 32); const GAS float* ks = (kb < 8) ? GIN(a, 13) : (GIN(a, 14) - 512);
            p0_transpose_item<PH_P8>(GIN(a, 15), D, D, (GAS h16*)(F.ws + WS_WOUT), ks, scr, r, F.lane); }
    }
    for (int pos = gw; pos < S; pos += NGW) {
        const int i = F.lane & 31;
        const float inv = (float)exp(-(double)i / 32.0 * 9.210340371976184);
        const float ang = (float)pos * inv;
        const double da = (double)ang;
        ((GAS float*)(F.ws + WS_ROPE))[(size_t)pos * 64 + F.lane] = (F.lane < 32) ? (float)cos(da) : (float)sin(da);
    }
    for (int e = gw * 64 + F.lane; e < NH * GC * GC; e += NGW * 64) { const int t = (e >> 7) & 127, s = e & 127; ((GAS h16*)(F.ws + WS_WS16))[e] = (s <= t) ? (h16)GIN(a, 11)[e] : (h16)0.f; }
}

__device__ __forceinline__ void p1_prep(const Frame& F0, const Args& a) {
    Frame F = F0; F.tid = threadIdx.x; F.lane = F.tid & 63; F.wave = __builtin_amdgcn_readfirstlane(F.tid >> 6);
    LAS float* modl = (LAS float*)F.lds;
    const GAS float* modp = (const GAS float*)(F.ws + WS_MODP); const GAS float* b_ada = GIN(a, 3);
    const size_t st = (size_t)4 * NMOD * D;
    const GAS float* x = GIN(a, 0); const GAS float* g1 = GIN(a, 4);
    GAS h16* XG = (GAS h16*)(F.ws + WS_HG); GAS float* R1 = (GAS float*)(F.ws + WS_R1);
    int chunk = F.vcu; const int cb = chunk / (S / 128);
    f32x4 v[2][4][2][2];
    auto xload = [&](int buf, int rb) {
#pragma unroll
        for (int r4 = 0; r4 < 4; ++r4) { const GAS float* xr = x + (size_t)(chunk * 128 + F.wave * 16 + rb + r4) * D + 8 * F.lane;
#pragma unroll
            for (int j = 0; j < 2; ++j) { v[buf][r4][j][0] = *(const GAS f32x4*)(xr + 512 * j); v[buf][r4][j][1] = *(const GAS f32x4*)(xr + 512 * j + 4); } }
    };
    if (chunk < M / 128) xload(0, 0);
#pragma unroll
    for (int t0 = 0; t0 < 7; t0 += 4) {
        f32x4 r[4][5]; int dst[4];
#pragma unroll
        for (int t = 0; t < 4; ++t) if (t0 + t < 7) {
            int i = F.tid + 512 * (t0 + t); const bool ok = i < 3328; i = ok ? i : 0;
            int bb, sl, mi; const int k = (i & 255) * 4;
            if (i < 3072) { bb = i / 768; sl = (i >> 8) % 3; mi = 3 * sl; } else { bb = cb; sl = 3; mi = 1; }
            const size_t o = (size_t)bb * (NMOD * D) + mi * D + k;
#pragma unroll
            for (int q = 0; q < 4; ++q) r[t][q] = *(const GAS f32x4*)(modp + o + q * st);
            r[t][4] = *(const GAS f32x4*)(b_ada + mi * D + k);
            dst[t] = ok ? ((bb * 6 + sl) * D + k) : -1;
        }
#pragma unroll
        for (int t = 0; t < 4; ++t) if (t0 + t < 7) { if (dst[t] >= 0) *(LAS f32x4*)(modl + dst[t]) = ((r[t][0] + r[t][1]) + (r[t][2] + r[t][3])) + r[t][4]; }
    }
    for (int e = F.vcu * 512 + F.tid; e < 3 * 4 * D; e += F.G * 512) {
        GAS float* GT = (GAS float*)(F.ws + WS_GT); GAS float* GP = (GAS float*)(F.ws + WS_GP);
        const int j = e / (4 * D), bb = (e / D) % 4, k = e % D;
        const size_t og = (size_t)bb * (NMOD * D) + (3 * j + 2) * D + k, os = og - D;
        const GAS float* g = j == 0 ? g1 : j == 1 ? GIN(a, 7) : GIN(a, 16);
        const float gt = ((modp[og] + modp[og + st]) + (modp[og + 2 * st] + modp[og + 3 * st])) + b_ada[(3 * j + 2) * D + k];
        const float sc = ((modp[os] + modp[os + st]) + (modp[os + 2 * st] + modp[os + 3 * st])) + b_ada[(3 * j + 1) * D + k];
        const float gg = g[k];
        GT[e] = gt; GP[e] = gg * (1.f + sc);
    }
    __syncthreads();
    for (bool first = true; chunk < M / 128; chunk += F.G, first = false) {
        const int cbb = chunk / (S / 128);
        if (!first) {
            __syncthreads();
            for (int i = F.tid; i < D; i += NWAVES * 64) { const size_t o = (size_t)cbb * (NMOD * D) + D + i; modl[(cb * 6 + 3) * D + i] = ((modp[o] + modp[o + st]) + (modp[o + 2 * st] + modp[o + 3 * st])) + b_ada[D + i]; }
            __syncthreads();
            xload(0, 0);
        }
        f32x4 scl[2][2];
#pragma unroll
        for (int j = 0; j < 2; ++j)
#pragma unroll
            for (int h = 0; h < 2; ++h) { const int k = 8 * F.lane + 512 * j + 4 * h; const f32x4 gg = *(const GAS f32x4*)(g1 + k); const LAS float* sc = modl + (cb * 6 + 3) * D + k;
                scl[j][h] = gg * ((f32x4){1.f + sc[0], 1.f + sc[1], 1.f + sc[2], 1.f + sc[3]}); }
#pragma unroll
        for (int ib = 0; ib < 4; ++ib) {
            const int cur = ib & 1, rb = ib * 4;
            if (ib < 3) xload(cur ^ 1, rb + 4);
            asm volatile("" ::: "memory");
            float q[4];
#pragma unroll
            for (int r4 = 0; r4 < 4; ++r4) { float t = 0.f;
#pragma unroll
                for (int j = 0; j < 2; ++j)
#pragma unroll
                    for (int h = 0; h < 2; ++h) { const f32x4 w = v[cur][r4][j][h]; t += (w[0] * w[0] + w[1] * w[1]) + (w[2] * w[2] + w[3] * w[3]); }
                q[r4] = t; }
#pragma unroll
            for (int o = 1; o < 64; o <<= 1)
#pragma unroll
                for (int r4 = 0; r4 < 4; ++r4) q[r4] += __shfl_xor(q[r4], o);
#pragma unroll
            for (int r4 = 0; r4 < 4; ++r4) {
                const int row = chunk * 128 + F.wave * 16 + rb + r4;
                if (F.lane == 0) R1[row] = rsqrtf(q[r4] * (1.f / D) + EPS);
#pragma unroll
                for (int j = 0; j < 2; ++j) { const int k = 8 * F.lane + 512 * j; u32x4 w;
#pragma unroll
                    for (int h = 0; h < 2; ++h) { const f32x4 o = v[cur][r4][j][h] * scl[j][h]; w[2 * h] = pkh8(o[0], o[1]); w[2 * h + 1] = pkh8(o[2], o[3]); }
                    *(GAS u32x4*)(XG + blk_off(row, k, D / 64)) = w; }
            }
            asm volatile("" ::: "memory");
        }
    }
    const int gw = F.vcu * NWAVES + F.wave, NGW = F.G * NWAVES;
    constexpr int NBR = NGU + INW + NGU;
    for (int it0 = gw; it0 < NBR; it0 += 4 * NGW) {
        h16x8 w0[4], w1[4];
#pragma unroll
        for (int t = 0; t < 4; ++t) {
            const int it = it0 + t * NGW; int n = it < NBR ? it : gw; const GAS h16* W;
            if (n < NGU) W = (const GAS h16*)(F.ws + WS_WGU1); else if (n < NGU + INW) { n -= NGU; W = (const GAS h16*)(F.ws + WS_WIN); } else { n -= NGU + INW; W = (const GAS h16*)(F.ws + WS_WGU2); }
            w0[t] = *(const GAS h16x8*)(W + blk_off(n, 16 * F.lane, D / 64)); w1[t] = *(const GAS h16x8*)(W + blk_off(n, 16 * F.lane + 8, D / 64));
        }
        asm volatile("" ::: "memory");
#pragma unroll
        for (int t = 0; t < 4; ++t) {
            const int it = it0 + t * NGW;
            if (it < NBR) {
                int n = it, j; GAS float* B; int NN;
                if (n < NGU) { j = 0; B = (GAS float*)(F.ws + WS_BIAS1); NN = NGU; }
                else if (n < NGU + INW) { n -= NGU; j = 1; B = (GAS float*)(F.ws + WS_BIAS2); NN = INW; }
                else { n -= NGU + INW; j = 2; B = (GAS float*)(F.ws + WS_BIAS3); NN = NGU; }
                float s4[4];
#pragma unroll
                for (int bb = 0; bb < 4; ++bb) { const LAS float* sh = modl + (bb * 6 + j) * D + 16 * F.lane; float tt = 0.f;
#pragma unroll
                    for (int e = 0; e < 8; ++e) tt += sh[e] * (float)w0[t][e] + sh[8 + e] * (float)w1[t][e];
                    s4[bb] = tt; }
#pragma unroll
                for (int o = 1; o < 64; o <<= 1)
#pragma unroll
                    for (int bb = 0; bb < 4; ++bb) s4[bb] += __shfl_xor(s4[bb], o);
                if (F.lane == 0) { B[0 * NN + n] = s4[0]; B[1 * NN + n] = s4[1]; B[2 * NN + n] = s4[2]; B[3 * NN + n] = s4[3]; }
            }
        }
    }
    __syncthreads();
}

__device__ __forceinline__ void p_final(const Frame& F0, const Args& a) {
    Frame F = F0; F.tid = threadIdx.x; F.lane = F.tid & 63; F.wave = __builtin_amdgcn_readfirstlane(F.tid >> 6);
    const GAS h16* H = (const GAS h16*)(F.ws + WS_H); const GAS float* ssq = (const GAS float*)(F.ws + WS_SSQF); const GAS float* gf = GIN(a, 19);
    const int gw = F.vcu * NWAVES + F.wave, NGW = F.G * NWAVES;
    f32x4 g[2][2];
#pragma unroll
    for (int j = 0; j < 2; ++j)
#pragma unroll
        for (int h = 0; h < 2; ++h) g[j][h] = *(const GAS f32x4*)(gf + 8 * F.lane + 512 * j + 4 * h);
    for (int row = gw; row < M; row += NGW) {
        const float rs = rs16p(ssq + row);
#pragma unroll
        for (int j = 0; j < 2; ++j) { const h16x8 hv = *(const GAS h16x8*)(H + (size_t)row * D + 8 * F.lane + 512 * j);
            f32x4 o0 = (f32x4){(float)hv[0], (float)hv[1], (float)hv[2], (float)hv[3]} * rs * g[j][0], o1 = (f32x4){(float)hv[4], (float)hv[5], (float)hv[6], (float)hv[7]} * rs * g[j][1];
            *(GAS f32x4*)(a.out + (size_t)row * D + 8 * F.lane + 512 * j) = o0; *(GAS f32x4*)(a.out + (size_t)row * D + 8 * F.lane + 512 * j + 4) = o1; }
    }
}


typedef float f32x16 __attribute__((ext_vector_type(16)));
typedef short v4i16_t __attribute__((ext_vector_type(4)));
__device__ __forceinline__ h16x4 tr16(const LAS unsigned char* p) { return __builtin_bit_cast(h16x4, __builtin_amdgcn_ds_read_tr16_b64_v4i16((LAS v4i16_t*)p)); }
__device__ __forceinline__ int vt_off(int t, int c8) { return t * 128 + (((c8 >> 2) ^ ((t >> 1) & 1)) << 6) + ((c8 & 3) << 4); }

__device__ __forceinline__ void gmlp_phase(const Frame& F0, const Args& a, int shadow) {
    const int tid = threadIdx.x, lane = tid & 63, wave = __builtin_amdgcn_readfirstlane(tid >> 6), r32 = lane & 31, hi = lane >> 5;
    GAS h16* proj = (GAS h16*)(F0.ws + WS_PROJ); const GAS h16* W16 = (const GAS h16*)(F0.ws + WS_WS16); GAS float* RG = (GAS float*)(F0.ws + WS_RG);
    const GAS float* ln_g = GIN(a, 9); const GAS float* ln_b = GIN(a, 10); const GAS float* b_s = GIN(a, 12);
    LAS unsigned char* lds = F0.lds;
    LAS float* rowsq = (LAS float*)(lds + MISC_OFF + 128);
    LAS unsigned char* gstg = lds + MISC_OFF + 128 + 4096 + wave * 2048;
    f32x4 g0 = *(const GAS f32x4*)(ln_g + 8 * lane), g1 = *(const GAS f32x4*)(ln_g + 8 * lane + 4), b0 = *(const GAS f32x4*)(ln_b + 8 * lane), b1 = *(const GAS f32x4*)(ln_b + 8 * lane + 4);
    for (int unit = F0.vcu; unit < M / GC; unit += F0.G) {
        const size_t row0 = (size_t)unit * GC;
        {
            h16x8 hv[16]; float sm[16], mu[16], rsd[16];
#pragma unroll
            for (int rr = 0; rr < 16; ++rr) hv[rr] = *(const GAS h16x8*)(proj + (row0 + wave * 16 + rr) * INW + PG + 8 * lane);
#pragma unroll
            for (int rr = 0; rr < 16; ++rr) { float t = 0.f;
#pragma unroll
                for (int e = 0; e < 8; ++e) t += (float)hv[rr][e];
                sm[rr] = t; }
#pragma unroll
            for (int o = 1; o < 64; o <<= 1)
#pragma unroll
                for (int rr = 0; rr < 16; ++rr) sm[rr] += __shfl_xor(sm[rr], o);
#pragma unroll
            for (int rr = 0; rr < 16; ++rr) { mu[rr] = sm[rr] * (1.f / 512.f); float q = 0.f;
#pragma unroll
                for (int e = 0; e < 8; ++e) { const float d = (float)hv[rr][e] - mu[rr]; q += d * d; }
                sm[rr] = q; }
#pragma unroll
            for (int o = 1; o < 64; o <<= 1)
#pragma unroll
                for (int rr = 0; rr < 16; ++rr) sm[rr] += __shfl_xor(sm[rr], o);
#pragma unroll
            for (int rr = 0; rr < 16; ++rr) { rsd[rr] = rsqrtf(sm[rr] * (1.f / 512.f) + EPS);
                const int t = wave * 16 + rr; float v[8];
#pragma unroll
                for (int e = 0; e < 8; ++e) v[e] = ((float)hv[rr][e] - mu[rr]) * rsd[rr];
                u32x4 w; w[0] = pkh(v[0] * g0[0] + b0[0], v[1] * g0[1] + b0[1]); w[1] = pkh(v[2] * g0[2] + b0[2], v[3] * g0[3] + b0[3]);
                w[2] = pkh(v[4] * g1[0] + b1[0], v[5] * g1[1] + b1[1]); w[3] = pkh(v[6] * g1[2] + b1[2], v[7] * g1[3] + b1[3]);
                *(LAS u32x4*)(lds + (lane >> 3) * 16384 + vt_off(t, lane & 7)) = w; }
        }
        __syncthreads();
        const GAS h16* Wh = W16 + (size_t)wave * GC * GC;
        const LAS unsigned char* vt = lds + wave * 16384;
        const int q4 = (lane & 15) >> 2, p4 = lane & 3, g1b = (lane >> 4) & 1;
#pragma unroll
        for (int tb = 0; tb < 4; ++tb) {
            f32x16 acc[2];
#pragma unroll
            for (int d0 = 0; d0 < 2; ++d0)
#pragma unroll
                for (int e = 0; e < 16; ++e) acc[d0][e] = 0.f;
            h16x8 af[8];
#pragma unroll
            for (int ks = 0; ks < 8; ++ks) if (ks <= 2 * tb + 1) af[ks] = *(const GAS h16x8*)(Wh + (size_t)(32 * tb + r32) * GC + 16 * ks + 8 * hi);
#pragma unroll
            for (int ks = 0; ks < 8; ++ks) {
                if (ks <= 2 * tb + 1) {
#pragma unroll
                    for (int d0 = 0; d0 < 2; ++d0) {
                        const int srow = 16 * ks + 8 * hi + q4, c8 = 4 * d0 + 2 * g1b + (p4 >> 1);
                        const h16x4 lo = tr16(vt + vt_off(srow, c8) + (p4 & 1) * 8), hi4 = tr16(vt + vt_off(srow + 4, c8) + (p4 & 1) * 8);
                        const h16x8 bf = (h16x8){lo[0], lo[1], lo[2], lo[3], hi4[0], hi4[1], hi4[2], hi4[3]};
                        acc[d0] = __builtin_amdgcn_mfma_f32_32x32x16_f16(af[ks], bf, acc[d0], 0, 0, 0);
                    }
                }
            }
            float bsv[16];
#pragma unroll
            for (int e = 0; e < 16; ++e) bsv[e] = b_s[wave * GC + 32 * tb + (e & 3) + 8 * (e >> 2) + 4 * hi];
            h16x8 uv[2][2];
#pragma unroll
            for (int d0 = 0; d0 < 2; ++d0)
#pragma unroll
                for (int i = 0; i < 2; ++i) uv[d0][i] = *(const GAS h16x8*)(proj + (row0 + 32 * tb + (lane >> 2) + 16 * i) * INW + PU + wave * 64 + 32 * d0 + (lane & 3) * 8);
            asm volatile("" ::: "memory");
            float rq[2] = {0.f, 0.f};
#pragma unroll
            for (int d0 = 0; d0 < 2; ++d0) {
#pragma unroll
                for (int e = 0; e < 16; ++e) *(LAS h16*)(gstg + ((e & 3) + 8 * (e >> 2) + 4 * hi) * 64 + r32 * 2) = (h16)(acc[d0][e] + bsv[e]);
                LDS_WAIT();
#pragma unroll
                for (int i = 0; i < 2; ++i) { const int rw = (lane >> 2) + 16 * i; const h16x8 mx = *(const LAS h16x8*)(gstg + rw * 64 + (lane & 3) * 16);
                    float o[8]; float q = 0.f;
#pragma unroll
                    for (int e = 0; e < 8; ++e) { o[e] = (float)uv[d0][i][e] * (float)mx[e]; q += o[e] * o[e]; }
                    u32x4 w; w[0] = pkh(o[0], o[1]); w[1] = pkh(o[2], o[3]); w[2] = pkh(o[4], o[5]); w[3] = pkh(o[6], o[7]);
                    *(GAS u32x4*)(proj + (row0 + 32 * tb + rw) * INW + PU + wave * 64 + 32 * d0 + (lane & 3) * 8) = w;
                    q += __shfl_xor(q, 1); q += __shfl_xor(q, 2); rq[i] += q; }
                LDS_WAIT();
            }
            if ((lane & 3) == 0) { rowsq[wave * 128 + 32 * tb + (lane >> 2)] = rq[0]; rowsq[wave * 128 + 32 * tb + (lane >> 2) + 16] = rq[1]; }
        }
        __syncthreads();
        if (tid < 128) { float s8 = 0.f;
#pragma unroll
            for (int w = 0; w < 8; ++w) s8 += rowsq[w * 128 + tid];
            RG[row0 + tid] = s8; }
        __syncthreads();
    }
}


constexpr size_t DO_PO = 0, DO_PML = 96 * MiB;
constexpr int CW_CNT = 8192;
constexpr int LISTCAP = 8192;
constexpr int AL_K = 0, AL_V = 32768, AL_STG = 65536, AL_WSF = 98304, AL_START = 102400;
__device__ __forceinline__ int k_off(int key, int c8) { return key * 128 + ((c8 ^ (key & 7)) << 4); }

__device__ __forceinline__ void moba_gate_phase(const Frame& F0, int shadow) {
    const int tid = threadIdx.x, lane = tid & 63;
    const GAS h16* proj = (const GAS h16*)(F0.ws + WS_PROJ); const GAS float* kmp = (const GAS float*)(F0.ws + WS_KMP);
    unsigned* cnt = F0.ctl + CW_CNT + (shadow ? 1024 : 0); GAS unsigned short* lists = (GAS unsigned short*)(F0.ws + (shadow ? WS_HG : WS_LISTS));
    LAS float* km = (LAS float*)F0.lds;
    for (int item = F0.vcu, rnd = 0; item < NB * NH * (S / 512); item += F0.G, ++rnd) {
        const int sp0 = item % (S / 512), span = (rnd & 1) ? (S / 512 - 1 - sp0) : sp0, bh = item / (S / 512), b = bh >> 3, h = bh & 7;
        __syncthreads();
        for (int e = tid; e < NBLK * 64; e += NWAVES * 64) { const int n = e >> 6, d = e & 63; const GAS float* kp = kmp + (size_t)((b * NBLK + n) * 2) * 512 + h * 64 + d; km[e] = kp[0] + kp[512]; }
        __syncthreads();
        const int sq = span * 512 + tid, own = __builtin_amdgcn_readfirstlane(sq >> 8);
        float q[64];
        { const GAS h16* qp = proj + (size_t)(b * S + sq) * INW + PQ + h * 64;
#pragma unroll
          for (int c = 0; c < 8; ++c) { const h16x8 v = *(const GAS h16x8*)(qp + 8 * c);
#pragma unroll
              for (int e = 0; e < 8; ++e) q[8 * c + e] = (float)v[e]; } }
        float v0 = -3e38f, v1 = -3e38f, v2 = -3e38f; int i0 = -1, i1 = -1, i2 = -1;
        for (int n = 0; n < own; ++n) {
            float g0 = 0.f, g1 = 0.f, g2 = 0.f, g3 = 0.f;
#pragma unroll
            for (int c = 0; c < 16; ++c) { const f32x4 kv = *(const LAS f32x4*)(km + n * 64 + 4 * c); g0 += q[4 * c] * kv[0]; g1 += q[4 * c + 1] * kv[1]; g2 += q[4 * c + 2] * kv[2]; g3 += q[4 * c + 3] * kv[3]; }
            const float g = (g0 + g1) + (g2 + g3);
            if (g > v0) { v2 = v1; i2 = i1; v1 = v0; i1 = i0; v0 = g; i0 = n; }
            else if (g > v1) { v2 = v1; i2 = i1; v1 = g; i1 = n; }
            else if (g > v2) { v2 = g; i2 = n; }
        }
        int mycnt = 0, pos0 = 0, pos1 = 0, pos2 = 0;
        const unsigned long long ltmask = (1ull << lane) - 1ull;
        for (int n = 0; n < own; ++n) {
            const bool sel = (i0 == n) || (i1 == n) || (i2 == n);
            const unsigned long long mask = __ballot(sel);
            const int before = __popcll(mask & ltmask);
            if (lane == n) mycnt = __popcll(mask);
            if (i0 == n) pos0 = before; if (i1 == n) pos1 = before; if (i2 == n) pos2 = before;
        }
        unsigned base = 0u;
        if (lane < own && mycnt > 0) base = atomicAdd(cnt + bh * NBLK + lane, (unsigned)mycnt);
        const unsigned bb0 = (unsigned)__shfl((int)base, i0 & 63), bb1 = (unsigned)__shfl((int)base, i1 & 63), bb2 = (unsigned)__shfl((int)base, i2 & 63);
        if (i0 >= 0) lists[(size_t)(bh * NBLK + i0) * LISTCAP + bb0 + pos0] = (unsigned short)(sq | (0 << 13));
        if (i1 >= 0) lists[(size_t)(bh * NBLK + i1) * LISTCAP + bb1 + pos1] = (unsigned short)(sq | (1 << 13));
        if (i2 >= 0) lists[(size_t)(bh * NBLK + i2) * LISTCAP + bb2 + pos2] = (unsigned short)(sq | (2 << 13));
    }
    __syncthreads();
}

template <bool CAUSAL>
__device__ __forceinline__ void attn_tile(const LAS unsigned char* ldsK, const LAS unsigned char* ldsV, const h16x8 (&qf)[4], int wave, int lane, f32x16 (&o)[2], float& m_out, float& l_out) {
    const int r32 = lane & 31, hi = lane >> 5;
    int kbase[4];
#pragma unroll
    for (int ks = 0; ks < 4; ++ks) kbase[ks] = r32 * 128 + (((2 * ks + hi) ^ (r32 & 7)) << 4);
    f32x16 sacc[8];
#pragma unroll
    for (int kb = 0; kb < 8; ++kb) {
        f32x16 acc;
#pragma unroll
        for (int e = 0; e < 16; ++e) acc[e] = 0.f;
#pragma unroll
        for (int ks = 0; ks < 4; ++ks) { const h16x8 kf = *(const LAS h16x8*)(ldsK + kbase[ks] + kb * 4096); acc = __builtin_amdgcn_mfma_f32_32x32x16_f16(kf, qf[ks], acc, 0, 0, 0); }
        if (CAUSAL) {
            const int lim = 32 * (wave - kb) + r32;
#pragma unroll
            for (int e = 0; e < 16; ++e) { const int key = (e & 3) + 8 * (e >> 2) + 4 * hi; if (key > lim) acc[e] = -1e30f; }
        }
        sacc[kb] = acc;
    }
    float m = -3e38f;
#pragma unroll
    for (int kb = 0; kb < 8; ++kb)
#pragma unroll
        for (int e = 0; e < 16; ++e) m = fmaxf(m, sacc[kb][e]);
    m = fmaxf(m, __shfl_xor(m, 32));
    float ls = 0.f;
#pragma unroll
    for (int kb = 0; kb < 8; ++kb)
#pragma unroll
        for (int e = 0; e < 16; ++e) { const float pv = __builtin_amdgcn_exp2f(sacc[kb][e] - m); sacc[kb][e] = pv; ls += pv; }
    ls += __shfl_xor(ls, 32);
#pragma unroll
    for (int d0 = 0; d0 < 2; ++d0)
#pragma unroll
        for (int e = 0; e < 16; ++e) o[d0][e] = 0.f;
    const int q4 = (lane & 15) >> 2, p4 = lane & 3, g1b = (lane >> 4) & 1;
    int vbase[2];
#pragma unroll
    for (int d0 = 0; d0 < 2; ++d0) vbase[d0] = (4 * hi + q4) * 128 + ((d0 ^ ((q4 >> 1) & 1)) << 6) + ((2 * g1b + (p4 >> 1)) << 4) + (p4 & 1) * 8;
#pragma unroll
    for (int kb = 0; kb < 8; ++kb) {
        if (!CAUSAL || kb <= wave) {
#pragma unroll
            for (int s2 = 0; s2 < 2; ++s2) {
                h16x8 pa;
#pragma unroll
                for (int j = 0; j < 8; ++j) pa[j] = (h16)sacc[kb][8 * s2 + j];
#pragma unroll
                for (int d0 = 0; d0 < 2; ++d0) {
                    const h16x4 lo = tr16(ldsV + vbase[d0] + kb * 4096 + s2 * 2048), hi4 = tr16(ldsV + vbase[d0] + kb * 4096 + s2 * 2048 + 1024);
                    const h16x8 bf = (h16x8){lo[0], lo[1], lo[2], lo[3], hi4[0], hi4[1], hi4[2], hi4[3]};
                    o[d0] = __builtin_amdgcn_mfma_f32_32x32x16_f16(pa, bf, o[d0], 0, 0, 0);
                }
            }
        }
    }
    m_out = m; l_out = ls;
}
__device__ __forceinline__ void attn_tile_causal(const LAS unsigned char* ldsK, const LAS unsigned char* ldsV, const h16x8 (&qf)[4], int wave, int lane, f32x16 (&o)[2], float& m_out, float& l_out) {
    const int r32 = lane & 31, hi = lane >> 5;
    int kbase[4];
#pragma unroll
    for (int ks = 0; ks < 4; ++ks) kbase[ks] = r32 * 128 + (((2 * ks + hi) ^ (r32 & 7)) << 4);
    const int q4 = (lane & 15) >> 2, p4 = lane & 3, g1b = (lane >> 4) & 1;
    int vbase[2];
#pragma unroll
    for (int d0 = 0; d0 < 2; ++d0) vbase[d0] = (4 * hi + q4) * 128 + ((d0 ^ ((q4 >> 1) & 1)) << 6) + ((2 * g1b + (p4 >> 1)) << 4) + (p4 & 1) * 8;
    float m = -3e38f;
    for (int kb = 0; kb <= wave; ++kb) {
        f32x16 acc;
#pragma unroll
        for (int e = 0; e < 16; ++e) acc[e] = 0.f;
#pragma unroll
        for (int ks = 0; ks < 4; ++ks) { const h16x8 kf = *(const LAS h16x8*)(ldsK + kbase[ks] + kb * 4096); acc = __builtin_amdgcn_mfma_f32_32x32x16_f16(kf, qf[ks], acc, 0, 0, 0); }
        const int lim = (kb == wave) ? r32 : 64;
#pragma unroll
        for (int e = 0; e < 16; ++e) { const int key = (e & 3) + 8 * (e >> 2) + 4 * hi; if (key <= lim) m = fmaxf(m, acc[e]); }
    }
    m = fmaxf(m, __shfl_xor(m, 32));
    float ls = 0.f;
#pragma unroll
    for (int d0 = 0; d0 < 2; ++d0)
#pragma unroll
        for (int e = 0; e < 16; ++e) o[d0][e] = 0.f;
    for (int kb = 0; kb <= wave; ++kb) {
        f32x16 acc;
#pragma unroll
        for (int e = 0; e < 16; ++e) acc[e] = 0.f;
#pragma unroll
        for (int ks = 0; ks < 4; ++ks) { const h16x8 kf = *(const LAS h16x8*)(ldsK + kbase[ks] + kb * 4096); acc = __builtin_amdgcn_mfma_f32_32x32x16_f16(kf, qf[ks], acc, 0, 0, 0); }
        const int lim = (kb == wave) ? r32 : 64;
#pragma unroll
        for (int e = 0; e < 16; ++e) { const int key = (e & 3) + 8 * (e >> 2) + 4 * hi; const float pv = (key <= lim) ? __builtin_amdgcn_exp2f(acc[e] - m) : 0.f; acc[e] = pv; ls += pv; }
#pragma unroll
        for (int s2 = 0; s2 < 2; ++s2) {
            h16x8 pa;
#pragma unroll
            for (int j = 0; j < 8; ++j) pa[j] = (h16)acc[8 * s2 + j];
#pragma unroll
            for (int d0 = 0; d0 < 2; ++d0) {
                const h16x4 lo = tr16(ldsV + vbase[d0] + kb * 4096 + s2 * 2048), hi4 = tr16(ldsV + vbase[d0] + kb * 4096 + s2 * 2048 + 1024);
                const h16x8 bf = (h16x8){lo[0], lo[1], lo[2], lo[3], hi4[0], hi4[1], hi4[2], hi4[3]};
                o[d0] = __builtin_amdgcn_mfma_f32_32x32x16_f16(pa, bf, o[d0], 0, 0, 0);
            }
        }
    }
    ls += __shfl_xor(ls, 32);
    m_out = m; l_out = ls;
}
__device__ __forceinline__ void load_kv_block(LAS unsigned char* lds, const GAS h16* proj, size_t row0, int h, int tid) {
#pragma unroll
    for (int i = 0; i < 4; ++i) { const int idx = tid + 512 * i, key = idx >> 3, c8 = idx & 7; const GAS h16* rp = proj + (row0 + key) * INW + h * 64 + 8 * c8;
        const u32x4 kv = *(const GAS u32x4*)(rp + PK), vv = *(const GAS u32x4*)(rp + PV);
        *(LAS u32x4*)(lds + AL_K + k_off(key, c8)) = kv; *(LAS u32x4*)(lds + AL_V + vt_off(key, c8)) = vv; }
}
__device__ __forceinline__ void stage_o(LAS unsigned char* stg, LAS float* wsf, const f32x16 (&o)[2], float l, int lane) {
    const int r32 = lane & 31, hi = lane >> 5;
    if (hi == 0) wsf[r32] = 1.f / l;
    LDS_WAIT();
#pragma unroll
    for (int e = 0; e < 16; ++e) { const int qr = (e & 3) + 8 * (e >> 2) + 4 * hi; const float rl = wsf[qr];
        *(LAS h16*)(stg + qr * 128 + r32 * 2) = (h16)(o[0][e] * rl); *(LAS h16*)(stg + qr * 128 + 64 + r32 * 2) = (h16)(o[1][e] * rl); }
    LDS_WAIT();
}

struct KvRegs { u32x4 kv[4], vv[4]; };
__device__ __forceinline__ void kv_fetch(KvRegs& r, const GAS h16* proj, size_t row0, int h, int tid) {
#pragma unroll
    for (int i = 0; i < 4; ++i) { const int idx = tid + 512 * i, key = idx >> 3, c8 = idx & 7; const GAS h16* rp = proj + (row0 + key) * INW + h * 64 + 8 * c8;
        r.kv[i] = *(const GAS u32x4*)(rp + PK); r.vv[i] = *(const GAS u32x4*)(rp + PV); }
}
__device__ __forceinline__ void kv_commit(const KvRegs& r, LAS unsigned char* lds, int tid) {
#pragma unroll
    for (int i = 0; i < 4; ++i) { const int idx = tid + 512 * i, key = idx >> 3, c8 = idx & 7;
        *(LAS u32x4*)(lds + AL_K + k_off(key, c8)) = r.kv[i]; *(LAS u32x4*)(lds + AL_V + vt_off(key, c8)) = r.vv[i]; }
}
__device__ __forceinline__ void moba_b_phase(const Frame& F0, GAS float* dout) {
    const int tid = threadIdx.x, lane = tid & 63, wave = __builtin_amdgcn_readfirstlane(tid >> 6), r32 = lane & 31, hi = lane >> 5;
    const GAS h16* proj = (const GAS h16*)(F0.ws + WS_PROJ); const unsigned* cnt = F0.ctl + CW_CNT; const GAS unsigned short* lists = (const GAS unsigned short*)(F0.ws + WS_LISTS);
    GAS h16* PO = (GAS h16*)((unsigned char*)dout + DO_PO); GAS float* PML = (GAS float*)((unsigned char*)dout + DO_PML);
    LAS unsigned char* lds = F0.lds;
    LAS int* start = (LAS int*)(lds + AL_START);
    LAS float* wsf = (LAS float*)(lds + AL_WSF + wave * 512); LAS int* wsi = (LAS int*)(lds + AL_WSF + wave * 512 + 256);
    LAS unsigned char* stg = lds + AL_STG + wave * 4096;
    {
        const unsigned c0 = cnt[2 * tid], c1 = cnt[2 * tid + 1];
        const int t0 = (int)((c0 + 255u) >> 8), t1 = (int)((c1 + 255u) >> 8);
        int v = t0 + t1, inc = v;
#pragma unroll
        for (int o = 1; o < 64; o <<= 1) { const int u = __shfl_up(inc, o); if (lane >= o) inc += u; }
        LAS int* wtot = (LAS int*)(lds + AL_WSF);
        __syncthreads();
        if (lane == 63) wtot[wave] = inc;
        __syncthreads();
        int pre = 0;
        for (int w = 0; w < wave; ++w) pre += wtot[w];
        const int ex = pre + inc - v;
        __syncthreads();
        start[2 * tid] = ex; start[2 * tid + 1] = ex + t0;
        if (tid == 511) start[1024] = ex + v;
        __syncthreads();
    }
    const int nitems = start[1024];
    for (int item = F0.vcu; item < nitems; item += F0.G) {
        int lo = 0, hi_ = 1024;
        while (hi_ - lo > 1) { const int mid = (lo + hi_) >> 1; if (start[mid] <= item) lo = mid; else hi_ = mid; }
        const int l = lo, chunk = item - start[l];
        const int bh = l >> 5, n = l & 31, b = bh >> 3, h = bh & 7;
        const int nq = (int)cnt[l] - chunk * 256;
        const int qi = chunk * 256 + wave * 32 + r32;
        const bool valid = (wave * 32 + r32) < nq;
        const unsigned ent = lists[(size_t)l * LISTCAP + (valid ? qi : chunk * 256)];
        KvRegs kvr; kv_fetch(kvr, proj, (size_t)b * S + (size_t)n * MBLK, h, tid);
        const int sq = ent & 8191, rank = ent >> 13;
        h16x8 qf[4];
        { const GAS h16* qp = proj + (size_t)(b * S + sq) * INW + PQ + h * 64 + 8 * hi;
#pragma unroll
          for (int ks = 0; ks < 4; ++ks) qf[ks] = *(const GAS h16x8*)(qp + 16 * ks); }
        kv_commit(kvr, lds, tid);
        __syncthreads();
        if (wave * 32 < nq) {
            f32x16 o[2]; float m, lsum;
            attn_tile<false>(lds + AL_K, lds + AL_V, qf, wave, lane, o, m, lsum);
            const int slot = ((b * NH + h) * 3 + rank) * S + sq;
            if (hi == 0) { wsi[r32] = valid ? slot : -1; if (valid) { PML[(size_t)slot * 2] = m; PML[(size_t)slot * 2 + 1] = lsum; } }
            stage_o(stg, wsf, o, lsum, lane);
#pragma unroll
            for (int i = 0; i < 4; ++i) { const int row = i * 8 + (lane >> 3), ch = lane & 7; const int sl = wsi[row];
                if (sl >= 0) *(GAS u32x4*)(PO + (size_t)sl * 64 + ch * 8) = *(const LAS u32x4*)(stg + row * 128 + ch * 16); }
        }
        __syncthreads();
    }
}

__device__ __forceinline__ void moba_c_phase(const Frame& F0, const GAS float* dout, int shadow) {
    const int tid = threadIdx.x, lane = tid & 63, wave = __builtin_amdgcn_readfirstlane(tid >> 6), r32 = lane & 31, hi = lane >> 5;
    const int qblk = (wave < 4) ? wave : 11 - wave;
    GAS h16* proj = (GAS h16*)(F0.ws + WS_PROJ); GAS float* SSQA = (GAS float*)(F0.ws + WS_SSQA);
    const GAS h16* PO = (const GAS h16*)((const unsigned char*)dout + DO_PO); const GAS float* PML = (const GAS float*)((const unsigned char*)dout + DO_PML);
    LAS unsigned char* lds = F0.lds;
    LAS float* wsf = (LAS float*)(lds + AL_WSF + wave * 512);
    LAS unsigned char* stg = lds + AL_STG + wave * 4096;
    KvRegs kvr;
    if (F0.vcu < NB * NH * NBLK) { const int u0 = F0.vcu; kv_fetch(kvr, proj, (size_t)((u0 >> 5) >> 3) * S + (size_t)(u0 & 31) * MBLK, (u0 >> 5) & 7, tid); }
    for (int unit = F0.vcu; unit < NB * NH * NBLK; unit += F0.G) {
        const int qb = unit & 31, bh = unit >> 5, b = bh >> 3, h = bh & 7;
        const size_t row0 = (size_t)b * S + (size_t)qb * MBLK;
        kv_commit(kvr, lds, tid);
        { const int un = unit + F0.G; if (un < NB * NH * NBLK) kv_fetch(kvr, proj, (size_t)((un >> 5) >> 3) * S + (size_t)(un & 31) * MBLK, (un >> 5) & 7, tid); }
        h16x8 qf[4];
        { const GAS h16* qp = proj + (row0 + qblk * 32 + r32) * INW + PQ + h * 64 + 8 * hi;
#pragma unroll
          for (int ks = 0; ks < 4; ++ks) qf[ks] = *(const GAS h16x8*)(qp + 16 * ks); }
        __syncthreads();
        f32x16 o[2]; float m, lsum;
        attn_tile_causal(lds + AL_K, lds + AL_V, qf, qblk, lane, o, m, lsum);
        if (hi == 0) { wsf[32 + r32] = m; wsf[64 + r32] = lsum; }
        stage_o(stg, wsf, o, lsum, lane);
        const int nsel = qb < 3 ? qb : 3;
#pragma unroll
        for (int i0 = 0; i0 < 4; i0 += 2) {
            float mr[2][3], lr[2][3]; h16x8 pv[2][3];
#pragma unroll
            for (int ii = 0; ii < 2; ++ii) { const size_t grow = row0 + qblk * 32 + (i0 + ii) * 8 + (lane >> 3);
#pragma unroll
                for (int r = 0; r < 3; ++r) { if (r < nsel) { const size_t sl = ((size_t)(b * NH + h) * 3 + r) * S + (grow - (size_t)b * S); mr[ii][r] = PML[sl * 2]; lr[ii][r] = PML[sl * 2 + 1]; pv[ii][r] = *(const GAS h16x8*)(PO + sl * 64 + (lane & 7) * 8); } } }
            asm volatile("" ::: "memory");
#pragma unroll
            for (int ii = 0; ii < 2; ++ii) {
                const int row = (i0 + ii) * 8 + (lane >> 3), ch = lane & 7;
                const size_t grow = row0 + qblk * 32 + row;
                const float mo = wsf[32 + row], lo_ = wsf[64 + row];
                const h16x8 ov = *(const LAS h16x8*)(stg + row * 128 + ch * 16);
                float mmax = mo;
#pragma unroll
                for (int r = 0; r < 3; ++r) { if (r < nsel) mmax = fmaxf(mmax, mr[ii][r]); }
                float wo = lo_ * __builtin_amdgcn_exp2f(mo - mmax), L = wo;
                float acc[8];
#pragma unroll
                for (int e = 0; e < 8; ++e) acc[e] = wo * (float)ov[e];
#pragma unroll
                for (int r = 0; r < 3; ++r) { if (r < nsel) { const float wr_ = lr[ii][r] * __builtin_amdgcn_exp2f(mr[ii][r] - mmax); L += wr_;
#pragma unroll
                    for (int e = 0; e < 8; ++e) acc[e] += wr_ * (float)pv[ii][r][e]; } }
                const float rL = 1.f / L; float q = 0.f; u32x4 w;
#pragma unroll
                for (int e = 0; e < 8; ++e) { acc[e] *= rL; q += acc[e] * acc[e]; }
                w[0] = pkh(acc[0], acc[1]); w[1] = pkh(acc[2], acc[3]); w[2] = pkh(acc[4], acc[5]); w[3] = pkh(acc[6], acc[7]);
                if (shadow) *(GAS u32x4*)((GAS h16*)(F0.ws + WS_HG) + grow * 512 + h * 64 + ch * 8) = w;
                else *(GAS u32x4*)(proj + grow * INW + PQ + h * 64 + ch * 8) = w;
                q += __shfl_xor(q, 1); q += __shfl_xor(q, 2); q += __shfl_xor(q, 4);
                if (ch == 0) SSQA[grow * 8 + h] = q;
            }
        }
        __syncthreads();
    }
}


template <bool PART16, class Order> __device__ __forceinline__ void fill_rowscale(LAS float* tab, const Order& So, const GAS float* src, int maxu) {
    pg8::Unit uu;
    for (int i = 0; i < maxu && So.next(i, uu); ++i)
        if (threadIdx.x < 256) { const int row = uu.pm * 256 + (int)threadIdx.x; tab[i * 256 + threadIdx.x] = PART16 ? rs16p(src + row) : src[row]; }
    __syncthreads();
}
constexpr int TAB_OFF = MISC_OFF + 128, TAB_MAXU = 15;
static_assert(TAB_OFF + TAB_MAXU * 1024 <= LDS_BYTES, "row-scale table");

enum Phase { PH_P0 = 0, PH_P1, PH_G1A, PH_G1B, PH_INPROJ, PH_MIX_A, PH_MIX_B, PH_MIX_C, PH_OUTPROJ, PH_G2A, PH_G2B, PH_FINAL, PH_COUNT };
__global__ void __launch_bounds__(NWAVES * 64, 2) mega_fwd(Args args) {
    extern __shared__ __attribute__((aligned(16))) unsigned char lds[];
    Frame F;
    F.lds = (LAS unsigned char*)lds; F.MISC = (volatile LAS unsigned*)(F.lds + MISC_OFF);
    F.tid = threadIdx.x; F.lane = F.tid & 63; F.wave = __builtin_amdgcn_readfirstlane(F.tid >> 6);
    F.G = gridDim.x; { const int bx = blockIdx.x; F.vcu = (F.G % 8 == 0) ? (bx % 8) * (F.G / 8) + bx / 8 : bx; }
    F.ws = args.ws; F.out = (GAS float*)args.out; F.ctl = (unsigned*)(args.ws + WS_CTL);
    for (int u = F.tid; u < (LDS_BYTES - LDSCTL_OFF) / 4; u += NWAVES * 64) ((LAS unsigned*)(F.lds + LDSCTL_OFF))[u] = 0u;
    __syncthreads();
    XcdBarrier bar; bar.bar = F.ctl + CW_BAR; bar.x = 0; bar.st = nullptr;
    const int lo = args.ph_lo, hi = args.ph_hi;
    if (hi - lo > 1) bar = xcd_barrier_post(F.ctl + CW_BAR, F.MISC + 8);
#ifndef MK_PHASE_MASK
#define MK_PHASE_MASK 0xFFFF
#endif
#define IN(k) (((MK_PHASE_MASK >> (k)) & 1) && lo <= (k) && (k) < hi)
#define SEAM(k) do { if (IN(k) && IN((k) + 1)) xcd_barrier(bar); } while (0)
#define PHASE_PTRS() unsigned char* ws = args.ws; asm volatile("" : "+s"(ws)); const GAS float* GT = (const GAS float*)(ws + WS_GT); const GAS float* GP = (const GAS float*)(ws + WS_GP); (void)GT; (void)GP; F.ws = ws
    if (IN(PH_P0)) { PHASE_PTRS(); p0_prologue(F, args); SEAM(PH_P0); }
    if (IN(PH_P1)) { PHASE_PTRS(); p1_prep(F, args); SEAM(PH_P1); }
    if (IN(PH_G1A)) {
        PHASE_PTRS();
        pg8::Gemm g{(const GAS h16*)(ws + WS_HG), (const GAS h16*)(ws + WS_WGU1), 0, NGU, D}; pg8::StaticOrder So; So.init(M, NGU, F.G, (int)blockIdx.x); const pg8::TableOrder To = pg8::make_table(So, (LAS int*)(F.lds + LDSCTL_OFF));
#if MK_SHADOW == 1
        if (args.ph_lo == PH_G1A && args.ph_hi == PH_G1A + 1 && args.shadow) { EpiNull En; pg8::gemm_phase<EpiNull, true, MK_GPROBE>(F.lds, g, So, En); return; }
#endif
        fill_rowscale<false>((LAS float*)(F.lds + TAB_OFF), To, (const GAS float*)(ws + WS_R1), TAB_MAXU);
        EpiSwiglu E{(GAS h16*)(ws + WS_ACT), (const LAS float*)(F.lds + TAB_OFF), (const GAS float*)(ws + WS_BIAS1)};
        pg8::gemm_phase<EpiSwiglu, true, 0, pg8::TableOrder>(F.lds, g, To, E); SEAM(PH_G1A);
    }
    if (IN(PH_G1B)) {
        PHASE_PTRS();
        pg8::Gemm g{(const GAS h16*)(ws + WS_ACT), (const GAS h16*)(ws + WS_WD1), 0, D, DFF, MK_STAG}; pg8::StaticOrder So; So.init(M, D, F.G, (int)blockIdx.x); const pg8::TableOrder To = pg8::make_table(So, (LAS int*)(F.lds + LDSCTL_OFF));
#if MK_SHADOW == 8
        if (args.ph_lo == PH_G1B && args.ph_hi == PH_G1B + 1 && args.shadow) {
#if MK_GPROBE == 0
            EpiNull En; pg8::gemm_phase<EpiNull, true>(F.lds, g, So, En);
#else
            EpiResid<true, false, true, MK_GPROBE> Ev{GIN(args, 0), (GAS h16*)(ws + WS_H), (GAS h16*)(ws + WS_HG), GT + 0 * 4 * D, GP + 1 * 4 * D, (GAS float*)(ws + WS_SSQ2), nullptr, 0.5f};
            pg8::gemm_phase<EpiResid<true, false, true, MK_GPROBE>, true>(F.lds, g, So, Ev);
#endif
            return; }
#endif
        EpiResid<true, false, true> E{GIN(args, 0), (GAS h16*)(ws + WS_H), (GAS h16*)(ws + WS_HG), GT + 0 * 4 * D, GP + 1 * 4 * D, (GAS float*)(ws + WS_SSQ2), nullptr, 0.5f};
        pg8::gemm_phase<EpiResid<true, false, true>, true, 0, pg8::TableOrder>(F.lds, g, To, E); SEAM(PH_G1B);
    }
    if (IN(PH_INPROJ)) {
        PHASE_PTRS();
        pg8::Gemm g{(const GAS h16*)(ws + WS_HG), (const GAS h16*)(ws + WS_WIN), 0, INW, D}; pg8::StaticOrder So; So.init(M, INW, F.G, (int)blockIdx.x); const pg8::TableOrder To = pg8::make_table(So, (LAS int*)(F.lds + LDSCTL_OFF));
        fill_rowscale<true>((LAS float*)(F.lds + TAB_OFF), To, (const GAS float*)(ws + WS_SSQ2), TAB_MAXU);
        EpiInproj E{(GAS h16*)(ws + WS_PROJ), (const LAS float*)(F.lds + TAB_OFF), (const GAS float*)(ws + WS_BIAS2), (const GAS float*)(ws + WS_ROPE), (GAS float*)(ws + WS_KMP)};
        pg8::gemm_phase<EpiInproj, true, 0, pg8::TableOrder>(F.lds, g, To, E); SEAM(PH_INPROJ);
    }
    if (IN(PH_MIX_A)) { PHASE_PTRS(); if (!(args.shadow & 2)) gmlp_phase(F, args, args.shadow & 1); if (!(args.shadow & 4)) moba_gate_phase(F, args.shadow & 1); SEAM(PH_MIX_A); }
    if (IN(PH_MIX_B)) { PHASE_PTRS(); moba_b_phase(F, (GAS float*)args.out); SEAM(PH_MIX_B); }
    if (IN(PH_MIX_C)) { PHASE_PTRS(); moba_c_phase(F, (const GAS float*)args.out, args.shadow & 1); SEAM(PH_MIX_C); }
    if (IN(PH_OUTPROJ)) {
        PHASE_PTRS();
        pg8::Gemm g{(const GAS h16*)(ws + WS_PROJ), (const GAS h16*)(ws + WS_WOUT), INW, D, D}; pg8::StaticOrder So; So.init(M, D, F.G, (int)blockIdx.x); const pg8::TableOrder To = pg8::make_table(So, (LAS int*)(F.lds + LDSCTL_OFF));
        const LAS float* sct = (const LAS float*)(F.lds + MISC_OFF + 128);
        {   LAS float* t = (LAS float*)(F.lds + MISC_OFF + 128); const GAS float* ssqa = (const GAS float*)(ws + WS_SSQA); const GAS float* ssqg = (const GAS float*)(ws + WS_RG);
            pg8::Unit uu;
            for (int i = 0; i < 4 && To.next(i, uu); ++i)
                if (F.tid < 256) { const int row = uu.pm * 256 + F.tid; const f32x4 a = *(const GAS f32x4*)(ssqa + (size_t)row * 8), bq = *(const GAS f32x4*)(ssqa + (size_t)row * 8 + 4);
                    const float ra = rsqrtf((((a[0] + a[1]) + (a[2] + a[3])) + ((bq[0] + bq[1]) + (bq[2] + bq[3]))) * (1.f / 512.f) + EPS), rg = rsqrtf(ssqg[row] * (1.f / 512.f) + EPS);
                    t[i * 512 + F.tid] = ra / rg; t[i * 512 + 256 + F.tid] = rg; }
            __syncthreads(); }
        EpiResid<false, true, true> E{nullptr, (GAS h16*)(ws + WS_H), (GAS h16*)(ws + WS_HG), GT + 1 * 4 * D, GP + 2 * 4 * D, (GAS float*)(ws + WS_SSQ3), sct, 1.0f};
        pg8::gemm_phase<EpiResid<false, true, true>, true, 0, pg8::TableOrder>(F.lds, g, To, E); SEAM(PH_OUTPROJ);
    }
    if (IN(PH_G2A)) {
        PHASE_PTRS();
        pg8::Gemm g{(const GAS h16*)(ws + WS_HG), (const GAS h16*)(ws + WS_WGU2), 0, NGU, D}; pg8::StaticOrder So; So.init(M, NGU, F.G, (int)blockIdx.x); const pg8::TableOrder To = pg8::make_table(So, (LAS int*)(F.lds + LDSCTL_OFF));
        fill_rowscale<true>((LAS float*)(F.lds + TAB_OFF), To, (const GAS float*)(ws + WS_SSQ3), TAB_MAXU);
        EpiSwiglu E{(GAS h16*)(ws + WS_ACT), (const LAS float*)(F.lds + TAB_OFF), (const GAS float*)(ws + WS_BIAS3)};
        pg8::gemm_phase<EpiSwiglu, true, 0, pg8::TableOrder>(F.lds, g, To, E); SEAM(PH_G2A);
    }
    if (IN(PH_G2B)) {
        PHASE_PTRS();
        pg8::Gemm g{(const GAS h16*)(ws + WS_ACT), (const GAS h16*)(ws + WS_WD2), 0, D, DFF}; pg8::StaticOrder So; So.init(M, D, F.G, (int)blockIdx.x); const pg8::TableOrder To = pg8::make_table(So, (LAS int*)(F.lds + LDSCTL_OFF));
#if MK_FUSE_FINAL
        EpiFinal E{(const GAS h16*)(ws + WS_H), GT + 2 * 4 * D, GIN(args, 19), (GAS float*)args.out, (unsigned*)(ws + WS_SSQF), F.ctl + CW_PAN, F.ctl + CW_TMO,
                   (LAS float*)(F.lds + MISC_OFF + 128), (LAS float*)(F.lds + MISC_OFF + 128 + 4096), 0.5f};
        pg8::gemm_phase<EpiFinal, true, 0, pg8::TableOrder>(F.lds, g, To, E);
#else
        EpiResid<false, false, false> E{nullptr, (GAS h16*)(ws + WS_H), nullptr, GT + 2 * 4 * D, nullptr, (GAS float*)(ws + WS_SSQF), nullptr, 0.5f};
        pg8::gemm_phase<EpiResid<false, false, false>, true, 0, pg8::TableOrder>(F.lds, g, To, E); SEAM(PH_G2B);
#endif
    }
#if !MK_FUSE_FINAL
    if (IN(PH_FINAL)) { PHASE_PTRS(); p_final(F, args); }
#endif
#undef IN
#undef SEAM
}

extern "C" void kernel_launch(void* const* d_in, const int* in_sizes, int n_in, void* d_out, int out_size, void* d_ws, size_t ws_size, hipStream_t stream) {
    static int grid = 0;
    if (grid == 0) {
        if (n_in != 20 || out_size != M * D || ws_size < WS_END) { fprintf(stderr, "kernel_launch: unexpected shapes (n_in %d out %d ws %zu)\n", n_in, out_size, ws_size); grid = -1; return; }
        int dev = 0, cus = 0, per_cu = 0;
        hipGetDevice(&dev); hipDeviceGetAttribute(&cus, hipDeviceAttributeMultiprocessorCount, dev);
        if (hipFuncSetAttribute((const void*)mega_fwd, hipFuncAttributeMaxDynamicSharedMemorySize, LDS_BYTES) != hipSuccess) { fprintf(stderr, "kernel_launch: hipFuncSetAttribute failed\n"); grid = -1; return; }
        hipOccupancyMaxActiveBlocksPerMultiprocessor(&per_cu, (const void*)mega_fwd, NWAVES * 64, LDS_BYTES);
        (void)hipGetLastError();
        if (per_cu < 1) { fprintf(stderr, "kernel_launch: occupancy query says %d blocks/CU; nothing launched\n", per_cu); grid = -1; return; }
        grid = cus;
    }
    if (grid < 0) return;
    hipMemsetAsync((char*)d_ws + WS_CTL, 0, CTL_ZERO_BYTES, stream);
    Args a{};
    for (int i = 0; i < 20; ++i) a.in[i] = (const float*)d_in[i];
    a.out = (float*)d_out; a.ws = (unsigned char*)d_ws;
    unsigned char* ws = (unsigned char*)d_ws;
    auto run = [&](int lo, int hi) {
#if MK_PER_PHASE
        for (int p = lo; p < hi; ++p) {
            if (MK_SHADOW == 2 && p == PH_MIX_A) { a.ph_lo = p; a.ph_hi = p + 1; a.shadow = 1 | 4; hipLaunchKernelGGL(mega_fwd, dim3(grid), dim3(NWAVES * 64), LDS_BYTES, stream, a); a.shadow = 0; }
            if (MK_SHADOW == 10 && p == PH_MIX_A) { a.ph_lo = p; a.ph_hi = p + 1; a.shadow = 1 | 2 | 4; hipLaunchKernelGGL(mega_fwd, dim3(grid), dim3(NWAVES * 64), LDS_BYTES, stream, a); a.shadow = 0; }
            if (MK_SHADOW == 3 && p == PH_MIX_A) { a.ph_lo = p; a.ph_hi = p + 1; a.shadow = 1 | 2; hipLaunchKernelGGL(mega_fwd, dim3(grid), dim3(NWAVES * 64), LDS_BYTES, stream, a); a.shadow = 0; }
            if (MK_SHADOW == 4 && p == PH_MIX_C) { a.ph_lo = p; a.ph_hi = p + 1; a.shadow = 1; hipLaunchKernelGGL(mega_fwd, dim3(grid), dim3(NWAVES * 64), LDS_BYTES, stream, a); a.shadow = 0; }
            if (MK_SHADOW == 8 && p == PH_G1B) { a.ph_lo = p; a.ph_hi = p + 1; a.shadow = 1; hipLaunchKernelGGL(mega_fwd, dim3(grid), dim3(NWAVES * 64), LDS_BYTES, stream, a); a.shadow = 0; }
            if (MK_SHADOW == 1 && p == PH_G1A) { a.ph_lo = p; a.ph_hi = p + 1; a.shadow = 1; hipLaunchKernelGGL(mega_fwd, dim3(grid), dim3(NWAVES * 64), LDS_BYTES, stream, a); a.shadow = 0; }
            for (int rep = 0; rep < ((((MK_DUP_MASK) >> p) & 1) ? 2 : 1); ++rep) { a.ph_lo = p; a.ph_hi = p + 1; hipLaunchKernelGGL(mega_fwd, dim3(grid), dim3(NWAVES * 64), LDS_BYTES, stream, a); }
        }
#else
        a.ph_lo = lo; a.ph_hi = hi;
        void* kargs[] = {(void*)&a};
        hipError_t e = hipLaunchCooperativeKernel((const void*)mega_fwd, dim3(grid), dim3(NWAVES * 64), kargs, LDS_BYTES, stream);
        if (e != hipSuccess) fprintf(stderr, "kernel_launch: cooperative launch failed: %s (grid %d)\n", hipGetErrorString(e), grid);
#endif
    };
    run(PH_P0, PH_COUNT);
}
```

```cpp
#include <hip/hip_runtime.h>
#include <cstdio>
#include <cstdint>

#ifndef MK_DUP_MASK
#define MK_DUP_MASK 0
#endif
#ifndef MK_GPROBE
#define MK_GPROBE 0
#endif
#ifndef MK_SHADOW
#define MK_SHADOW 0
#endif
#ifndef MK_FUSE_FINAL
#define MK_FUSE_FINAL 1
#endif
#ifndef MK_STAG
#define MK_STAG 0
#endif
#ifndef MK_NT
#define MK_NT 0x0
#endif
#ifndef MK_LEBITS
#define MK_LEBITS 5u
#endif
#ifndef MK_LOWENT
#define MK_LOWENT 3
#endif
#ifndef MK_PER_PHASE
#define MK_PER_PHASE 0
#endif

#define GAS __attribute__((address_space(1)))
#define LAS __attribute__((address_space(3)))
typedef _Float16 h16;
typedef _Float16 h16x8 __attribute__((ext_vector_type(8)));
typedef _Float16 h16x4 __attribute__((ext_vector_type(4)));
typedef _Float16 h16x2 __attribute__((ext_vector_type(2)));
typedef float f32x4 __attribute__((ext_vector_type(4)));
typedef float f32x2 __attribute__((ext_vector_type(2)));
typedef unsigned u32x4 __attribute__((ext_vector_type(4)));
typedef unsigned u32x2 __attribute__((ext_vector_type(2)));

constexpr int D = 1024, NB = 4, S = 8192, M = NB * S, DFF = 2816, NGU = 2 * DFF, NMOD = 9;
constexpr int AW = 512, HD = 64, NH = 8, INW = 2560, MBLK = 256, NBLK = S / MBLK, GC = 128;
constexpr float EPS = 1e-6f;
constexpr float C2 = 0.125f * 1.4426950408889634f;
constexpr int PQ = 0, PU = 512, PK = 1024, PV = 1536, PG = 2048;

constexpr size_t MiB = 1u << 20, KiB = 1u << 10;
constexpr size_t WS_CTL = 0, CTL_ZERO_BYTES = 128 * KiB;
constexpr size_t WS_MODP = 1 * MiB;
constexpr size_t WS_GT = 2 * MiB, WS_GP = WS_GT + 64 * KiB;
constexpr size_t WS_SH = WS_GT + 128 * KiB;
constexpr size_t WS_BIAS1 = WS_GT + 128 * KiB, WS_BIAS2 = WS_GT + 256 * KiB, WS_BIAS3 = WS_GT + 320 * KiB;
constexpr size_t WS_R1 = 3 * MiB, WS_RG = WS_R1 + 128 * KiB;
constexpr size_t WS_SSQA = 4 * MiB;
constexpr size_t WS_SSQ2 = 5 * MiB, WS_SSQ3 = 7 * MiB, WS_SSQF = 9 * MiB;
constexpr size_t WS_KMP = 11 * MiB;
constexpr size_t WS_ROPE = 12 * MiB;
constexpr size_t WS_WS16 = 14 * MiB;
constexpr size_t WS_WGU1 = 16 * MiB, WS_WD1 = 27 * MiB, WS_WIN = 33 * MiB, WS_WOUT = 38 * MiB, WS_WGU2 = 40 * MiB, WS_WD2 = 51 * MiB;
constexpr size_t WS_HG = 64 * MiB, WS_H = 128 * MiB, WS_ACT = 192 * MiB, WS_PROJ = WS_ACT;
constexpr size_t WS_AB = WS_ACT, WS_KB = WS_ACT + 64 * MiB, WS_VB = WS_ACT + 96 * MiB, WS_UB = WS_ACT + 128 * MiB, WS_GV = WS_ACT + 160 * MiB;
constexpr size_t OFF_KB = (WS_KB - WS_AB) / 2, OFF_VB = (WS_VB - WS_AB) / 2, OFF_UB = (WS_UB - WS_AB) / 2, OFF_GV = (WS_GV - WS_AB) / 2;
constexpr size_t WS_LISTS = 384 * MiB, WS_WINB = 400 * MiB, WS_END = 420 * MiB;
__device__ __forceinline__ size_t ab_off(size_t row, int kt, int d) { return ((row >> 8) * 16 + kt) * 16384 + (row & 255) * 64 + d; }
__device__ __forceinline__ size_t hb_off(size_t row, int h, int d) { return ((row >> 8) * 8 + h) * 16384 + (row & 255) * 64 + d; }
static_assert(WS_WD2 + (size_t)D * DFF * 2 <= WS_HG && WS_ACT + (size_t)M * DFF * 2 <= WS_LISTS, "ws map");
constexpr int CW_TMO = 0, CW_BAR = 4096;

constexpr int RING_BYTES = 131072, LDSCTL_OFF = RING_BYTES, MISC_OFF = LDSCTL_OFF + 320, LDS_BYTES = 163840;
constexpr int NWAVES = 8;

#define LDS_WAIT() asm volatile("s_waitcnt lgkmcnt(0)" ::: "memory")
#define VM_WAIT() asm volatile("s_waitcnt vmcnt(0)" ::: "memory")
#define VM_WAIT_KNOWN() do { __builtin_amdgcn_s_waitcnt(0x0F70); asm volatile("" ::: "memory"); } while (0)
#define RAW_BAR() do { asm volatile("s_waitcnt lgkmcnt(0)" ::: "memory"); __builtin_amdgcn_s_barrier(); asm volatile("" ::: "memory"); } while (0)

__device__ __forceinline__ float wave_sum(float v) {
#pragma unroll
    for (int o = 1; o < 64; o <<= 1) v += __shfl_xor(v, o);
    return v;
}
template <int SEL, class T> __device__ __forceinline__ void st_stream(GAS T* p, const T& v) { if ((MK_NT >> SEL) & 1) __builtin_nontemporal_store(v, p); else *p = v; }
__device__ __forceinline__ unsigned pkh(float lo, float hi) { h16x2 v; v.x = (h16)lo; v.y = (h16)hi; return __builtin_bit_cast(unsigned, v); }
__device__ __forceinline__ float round8a(float x) { constexpr unsigned drop = 24u - MK_LEBITS; unsigned u = __float_as_uint(x); u += ((1u << (drop - 1)) - 1u) + ((u >> drop) & 1u); u &= ~((1u << drop) - 1u); return __uint_as_float(u); }
__device__ __forceinline__ unsigned pkh8(float lo, float hi) {
    unsigned w = pkh(lo, hi);
    if (MK_LOWENT & 2) { constexpr unsigned drop = 11u - MK_LEBITS; w = (w + (0x00010001u << (drop - 1))) & (0x00010001u * (0xFFFFu & ~((1u << drop) - 1u))); }
    return w;
}
__device__ __forceinline__ float silu_fast(float x) { return x * __builtin_amdgcn_rcpf(1.f + __builtin_amdgcn_exp2f(-1.4426950408889634f * x)); }
__device__ __forceinline__ float gelu_fast(float x) {
    const float p = x * __builtin_fmaf(x * x, -0.1029432396f, -2.3022081981f);
    return x * __builtin_amdgcn_rcpf(1.f + __builtin_amdgcn_exp2f(p));
}
__device__ __forceinline__ float rs16p(const GAS float* p) {
    float t[16];
#pragma unroll
    for (int k = 0; k < 16; ++k) t[k] = p[(size_t)k * (4 * 8192)];
    const float a = ((t[0] + t[1]) + (t[2] + t[3])) + ((t[4] + t[5]) + (t[6] + t[7])), b = ((t[8] + t[9]) + (t[10] + t[11])) + ((t[12] + t[13]) + (t[14] + t[15]));
    return rsqrtf((a + b) * (1.f / 1024.f) + 1e-6f);
}
__device__ __forceinline__ float rs16(const GAS float* p) {
    const f32x4 s0 = *(const GAS f32x4*)(p), s1 = *(const GAS f32x4*)(p + 4), s2 = *(const GAS f32x4*)(p + 8), s3 = *(const GAS f32x4*)(p + 12);
    const f32x4 st = (s0 + s1) + (s2 + s3);
    return rsqrtf(((st[0] + st[1]) + (st[2] + st[3])) * (1.f / D) + EPS);
}


__device__ __forceinline__ size_t blk_off(int row, int k, int nt) { return (((size_t)(row >> 8) * nt + (k >> 6)) * 256 + (row & 255)) * 64 + (k & 63); }

namespace pg8 {
constexpr int BM = 256, BK = 64, HALF = 128, HTB = HALF * BK * 2, STAGE_BYTES = 8 * HTB, NXCD = 8, WGM = 8;
__host__ __device__ __forceinline__ int lds_byte(int r, int c) { const int st = (r >> 4) * 2 + (c >> 5), rr = r & 15, cc = c & 31, ob = rr * 64 + cc * 2; return st * 1024 + (ob ^ (((ob >> 9) & 1) << 5)); }
__host__ __device__ __forceinline__ void stage_rc(int b, int& R, int& C) { const int st = b / 1024, sb = b % 1024, swz = sb ^ (((sb >> 9) & 1) << 5); R = (st >> 1) * 16 + swz / 64; C = (st & 1) * 32 + (swz % 64) / 2; }
struct Unit { int pm, pn; };
struct Gemm { const GAS h16* A; const GAS h16* Bt; int lda, N, K; unsigned stag = 0; size_t bbs = 0; };
struct StaticOrder {
    int nM, nN, nwg, G, c;
    __device__ __forceinline__ void init(int M_, int N, int G_, int c_) { nM = M_ / BM; nN = N / BM; nwg = nM * nN; G = G_; c = c_; }
    __device__ __forceinline__ bool next(int i, Unit& u) const {
        const long L = (long)i * G + c; if (L >= nwg) return false;
        int wgid = (int)L; { const int q = nwg / NXCD, r = nwg % NXCD, xcd = wgid % NXCD, off = wgid / NXCD; wgid = (xcd < r ? xcd * (q + 1) : r * (q + 1) + (xcd - r) * q) + off; }
        const int nig = WGM * nN, gid = wgid / nig, fm = gid * WGM, gsz = (nM - fm) < WGM ? (nM - fm) : WGM;
        u.pm = fm + ((wgid % nig) % gsz); u.pn = (wgid % nig) / gsz; return true;
    }
};
struct TableOrder {
    const LAS int* tab; int n;
    __device__ __forceinline__ bool next(int i, Unit& u) const { if (i >= n) return false; u.pm = tab[2 * i]; u.pn = tab[2 * i + 1]; return true; }
};
__device__ __forceinline__ TableOrder make_table(const StaticOrder& So, LAS int* tab) {
    if (threadIdx.x < 16) { Unit u; u.pm = -1; u.pn = 0; const bool ok = So.next((int)threadIdx.x, u); tab[2 * threadIdx.x] = ok ? u.pm : -1; tab[2 * threadIdx.x + 1] = u.pn; }
    __syncthreads();
    int n = 0;
    while (n < 16 && tab[2 * n] >= 0) ++n;
    TableOrder T; T.tab = tab; T.n = __builtin_amdgcn_readfirstlane(n); return T;
}
template <class Epi, bool ALIGN_EPI, int PROBE = 0, class Order = StaticOrder>
__device__ __forceinline__ void gemm_phase(LAS unsigned char* lds, const Gemm g, const Order& S, const Epi& E) {
    const int tid = threadIdx.x, wid = __builtin_amdgcn_readfirstlane(tid >> 6), lane = tid & 63, wr = wid >> 2, wc = wid & 3, fr = lane & 15, fq = lane >> 4;
    const int K = g.K, nt = K / BK;
    unsigned voffA[2], voffB[2];
    const bool ablk = (g.lda == 0);
#pragma unroll
    for (int i = 0; i < 2; ++i) { int R, C; stage_rc(tid * 16 + i * 8192, R, C); voffA[i] = (unsigned)(R * (ablk ? BK : g.lda) + C) * 2u; voffB[i] = (unsigned)(R * BK + C) * 2u; }
    const size_t kstepB = (size_t)BM * BK * 2, kstepA = ablk ? kstepB : (size_t)(BK * 2);
    const size_t hstepB = (size_t)HALF * BK * 2, hstepA = ablk ? hstepB : (size_t)HALF * g.lda * 2;
    const size_t tstepB = (size_t)nt * kstepB, tstepA = ablk ? tstepB : 2 * hstepA;
    const unsigned ldsw = (unsigned)wid * 1024u;
    const int aoff = lds_byte(wr * 64 + fr, fq * 8), boff = lds_byte(wc * 32 + fr, fq * 8);
#define PG8_SA(b, h) (((b) * 2 + (h)) * HTB)
#define PG8_SB(b, h) ((4 + (b) * 2 + (h)) * HTB)
#define PG8_STAGE(bufoff, gbase, voff) do { if (PROBE != 2) _Pragma("unroll") for (int _i = 0; _i < 2; ++_i) \
        __builtin_amdgcn_global_load_lds((const unsigned*)((const char*)(gbase) + (voff)[_i]), (LAS unsigned*)(lds + (bufoff) + ldsw + _i * 8192), 16, 0, 0); } while (0)
#define PG8_LDA(dst, b, h) do { _Pragma("unroll") for (int m = 0; m < 4; ++m) _Pragma("unroll") for (int k = 0; k < 2; ++k) dst[m][k] = *(const LAS h16x8*)(lds + PG8_SA(b, h) + aoff + m * 2048 + k * 1024); } while (0)
#define PG8_LDB(dst, b, h) do { _Pragma("unroll") for (int n = 0; n < 2; ++n) _Pragma("unroll") for (int k = 0; k < 2; ++k) dst[n][k] = *(const LAS h16x8*)(lds + PG8_SB(b, h) + boff + n * 2048 + k * 1024); } while (0)
#define PG8_MMA(ai, bj, At, Bt) do { if (PROBE == 1 && (bj) == 1) break; __builtin_amdgcn_s_setprio(1); _Pragma("unroll") for (int m = 0; m < 4; ++m) _Pragma("unroll") for (int n = 0; n < 2; ++n) _Pragma("unroll") for (int k = 0; k < 2; ++k) \
        acc[ai][bj][m][n] = __builtin_amdgcn_mfma_f32_16x16x32_f16(Bt[n][k], At[m][k], acc[ai][bj][m][n], 0, 0, 0); __builtin_amdgcn_s_setprio(0); } while (0)
#define PG8_WAIT_V(n) asm volatile("s_waitcnt vmcnt(" #n ")" ::: "memory")
#define PG8_WAIT_L(n) asm volatile("s_waitcnt lgkmcnt(" #n ")" ::: "memory")
#define PG8_BAR __builtin_amdgcn_s_barrier()
#define PG8_SCHED __builtin_amdgcn_sched_barrier(0)
    Unit cur, nxt; int ui = 0;
    if (!S.next(0, cur)) return;
    if (g.stag) { const unsigned st = (unsigned)(cur.pm & 7); if (st) { const unsigned long long t0 = __builtin_amdgcn_s_memrealtime(), dl = (unsigned long long)st * g.stag; while (__builtin_amdgcn_s_memrealtime() - t0 < dl) __builtin_amdgcn_s_sleep(4); } }
    f32x4 acc[2][2][4][2];
#pragma unroll
    for (int a = 0; a < 2; ++a)
#pragma unroll
        for (int b = 0; b < 2; ++b)
#pragma unroll
            for (int m = 0; m < 4; ++m)
#pragma unroll
                for (int n = 0; n < 2; ++n) acc[a][b][m][n] = (f32x4){0.f, 0.f, 0.f, 0.f};
    h16x8 At[4][2], B0[2][2], B1[2][2];
    const char* cA = (const char*)g.A + (size_t)cur.pm * tstepA; const char* cB = (const char*)g.Bt + (size_t)(cur.pm >> 5) * g.bbs + (size_t)cur.pn * tstepB;
    PG8_STAGE(PG8_SB(0, 0), cB, voffB); PG8_STAGE(PG8_SB(0, 1), cB + hstepB, voffB); PG8_STAGE(PG8_SA(0, 0), cA, voffA); PG8_STAGE(PG8_SA(0, 1), cA + hstepA, voffA);
    if (wr == 1) PG8_BAR;
    PG8_WAIT_V(2); PG8_BAR;
    PG8_STAGE(PG8_SB(1, 0), cB + kstepB, voffB); PG8_STAGE(PG8_SA(1, 0), cA + kstepA, voffA); PG8_STAGE(PG8_SB(1, 1), cB + hstepB + kstepB, voffB);
    PG8_WAIT_V(6); PG8_BAR;
    for (;;) {
        const bool has_next = S.next(ui + 1, nxt);
        const char* nA = has_next ? (const char*)g.A + (size_t)nxt.pm * tstepA : cA; const char* nB = has_next ? (const char*)g.Bt + (size_t)(nxt.pm >> 5) * g.bbs + (size_t)nxt.pn * tstepB : cB;
        for (int t = 0; t < nt; t += 2) {
            const bool last = (t == nt - 2);
            const char* a1 = cA + (size_t)(t + 1) * kstepA;
            const char* a2 = last ? nA : cA + (size_t)(t + 2) * kstepA; const char* b2 = last ? nB : cB + (size_t)(t + 2) * kstepB;
            const char* a3 = a2 + kstepA; const char* b3 = b2 + kstepB;
            if constexpr (Epi::MID) { if (t == nt / 2) E.mid(acc, cur, ui, wr, wc, fr, fq); }
            PG8_LDB(B0, 0, 0); PG8_LDB(B1, 0, 1); PG8_SCHED; PG8_LDA(At, 0, 0); PG8_STAGE(PG8_SA(1, 1), a1 + hstepA, voffA);
            PG8_WAIT_V(8); PG8_WAIT_L(0); PG8_BAR; PG8_MMA(0, 0, At, B0); PG8_MMA(0, 1, At, B1); PG8_BAR; PG8_SCHED;
            PG8_LDA(At, 0, 1); PG8_STAGE(PG8_SB(0, 0), b2, voffB); PG8_STAGE(PG8_SB(0, 1), b2 + hstepB, voffB); PG8_STAGE(PG8_SA(0, 0), a2, voffA);
            PG8_WAIT_V(8); PG8_WAIT_L(0); PG8_BAR; PG8_MMA(1, 0, At, B0); PG8_MMA(1, 1, At, B1); PG8_BAR; PG8_SCHED;
            PG8_LDB(B0, 1, 0); PG8_LDB(B1, 1, 1); PG8_SCHED; PG8_LDA(At, 1, 0); PG8_STAGE(PG8_SA(0, 1), a2 + hstepA, voffA);
            PG8_WAIT_V(8); PG8_WAIT_L(0); PG8_BAR; PG8_MMA(0, 0, At, B0); PG8_MMA(0, 1, At, B1); PG8_BAR; PG8_SCHED;
            PG8_LDA(At, 1, 1); PG8_STAGE(PG8_SB(1, 0), b3, voffB); PG8_STAGE(PG8_SB(1, 1), b3 + hstepB, voffB); PG8_STAGE(PG8_SA(1, 0), a3, voffA);
            PG8_WAIT_V(8); PG8_WAIT_L(0); PG8_BAR; PG8_MMA(1, 0, At, B0); PG8_MMA(1, 1, At, B1); PG8_BAR; PG8_SCHED;
        }
        if constexpr (ALIGN_EPI) { if (wr == 0) PG8_BAR; }
        E(acc, cur, ui, wr, wc, fr, fq);
        if (!has_next) break;
#pragma unroll
        for (int a = 0; a < 2; ++a)
#pragma unroll
            for (int b = 0; b < 2; ++b)
#pragma unroll
                for (int m = 0; m < 4; ++m)
#pragma unroll
                    for (int n = 0; n < 2; ++n) acc[a][b][m][n] = (f32x4){0.f, 0.f, 0.f, 0.f};
        cur = nxt; cA = nA; cB = nB; ++ui;
        if constexpr (ALIGN_EPI) { if (wr == 1) PG8_BAR; }
    }
    PG8_WAIT_V(0);
    if constexpr (!ALIGN_EPI) { if (wr == 0) PG8_BAR; }
    PG8_BAR;
#undef PG8_SA
#undef PG8_SB
#undef PG8_STAGE
#undef PG8_LDA
#undef PG8_LDB
#undef PG8_MMA
#undef PG8_WAIT_V
#undef PG8_WAIT_L
#undef PG8_BAR
#undef PG8_SCHED
}
}

typedef const f32x4 (&AccRef)[2][2][4][2];
template <bool PLAIN> struct EpiSwiglu {
    static constexpr bool MID = false;
    GAS h16* act; const LAS float* rtab; const GAS float* bias;
    __device__ __forceinline__ void mid(f32x4 (&)[2][2][4][2], const pg8::Unit&, int, int, int, int, int) const {}
    __device__ __forceinline__ void operator()(AccRef acc, const pg8::Unit& u, int ui, int wr, int wc, int fr, int fq) const {
        const int b = u.pm >> 5, row0 = u.pm * 256 + wr * 64 + fr;
        f32x4 bv[2][2]; const LAS float* rt = rtab;
        if constexpr (!PLAIN) {
            const GAS float* bp = bias + b * NGU + u.pn * 256 + wc * 32 + 4 * fq;
#pragma unroll
            for (int bj = 0; bj < 2; ++bj)
#pragma unroll
                for (int n = 0; n < 2; ++n) bv[bj][n] = *(const GAS f32x4*)(bp + bj * 128 + n * 16) * (bj ? -0.6931471805599453f : -1.4426950408889634f);
            rt = rtab + ui * 256 + wr * 64 + fr;
        }
        const int hid0 = u.pn * 128 + wc * 32 + fq * 8;
#pragma unroll
        for (int ai = 0; ai < 2; ++ai)
#pragma unroll
            for (int m = 0; m < 4; ++m) {
                const int ro = ai * 128 + m * 16; float rsg = 0.f, rsu = 0.f; if constexpr (!PLAIN) { const float rs = rt[ro]; rsg = rs * -1.4426950408889634f; rsu = rs * -0.6931471805599453f; }
                u32x4 w;
#pragma unroll
                for (int n = 0; n < 2; ++n) {
                    f32x4 gq, uq; if constexpr (PLAIN) { gq = acc[ai][0][m][n]; uq = acc[ai][1][m][n]; } else { gq = acc[ai][0][m][n] * rsg + bv[0][n]; uq = acc[ai][1][m][n] * rsu + bv[1][n]; }
                    float a4[4];
#pragma unroll
                    for (int e = 0; e < 4; ++e) a4[e] = (gq[e] * uq[e]) * __builtin_amdgcn_rcpf(1.f + __builtin_amdgcn_exp2f(gq[e]));
                    w[2 * n] = pkh8(a4[0], a4[1]); w[2 * n + 1] = pkh8(a4[2], a4[3]);
                }
                st_stream<3>((GAS u32x4*)(act + blk_off(row0 + ro, hid0, DFF / 64)), w);
            }
    }
};
struct EpiNull {
    static constexpr bool MID = false;
    __device__ __forceinline__ void mid(f32x4 (&)[2][2][4][2], const pg8::Unit&, int, int, int, int, int) const {}
    __device__ __forceinline__ void operator()(AccRef acc, const pg8::Unit& u, int ui, int wr, int wc, int fr, int fq) const {
#pragma unroll
        for (int ai = 0; ai < 2; ++ai)
#pragma unroll
            for (int bj = 0; bj < 2; ++bj)
#pragma unroll
                for (int m = 0; m < 4; ++m)
#pragma unroll
                    for (int n = 0; n < 2; ++n) asm volatile("" :: "v"(acc[ai][bj][m][n]));
    }
};
template <bool RES_F32, bool TWOSCALE, bool WRITE_HG, int PVAR = 0> struct EpiResid {
    static constexpr bool MID = TWOSCALE;
    const GAS float* xres; GAS h16* H; GAS h16* HG; const GAS float* cs; const GAS float* gp; GAS float* ssq; const LAS float* sct; float cmul;
    __device__ __forceinline__ void mid(f32x4 (&acc)[2][2][4][2], const pg8::Unit& u, int ui, int wr, int wc, int fr, int fq) const {
        if constexpr (TWOSCALE) {
            const LAS float* t = sct + ui * 512 + wr * 64 + fr;
#pragma unroll
            for (int ai = 0; ai < 2; ++ai)
#pragma unroll
                for (int m = 0; m < 4; ++m) { const float f = t[ai * 128 + m * 16];
#pragma unroll
                    for (int bj = 0; bj < 2; ++bj)
#pragma unroll
                        for (int n = 0; n < 2; ++n) acc[ai][bj][m][n] *= f; }
        }
    }
    __device__ __forceinline__ void operator()(AccRef acc, const pg8::Unit& u, int ui, int wr, int wc, int fr, int fq) const {
        const int b = u.pm >> 5, row0 = u.pm * 256 + wr * 64 + fr, col0 = u.pn * 256 + wc * 32 + 8 * fq;
        f32x4 csv[2][2], gpv[2][2];
#pragma unroll
        for (int bj = 0; bj < 2; ++bj)
#pragma unroll
            for (int n = 0; n < 2; ++n) { csv[bj][n] = *(const GAS f32x4*)(cs + b * D + col0 + bj * 128 + 4 * n) * cmul; if constexpr (WRITE_HG) gpv[bj][n] = *(const GAS f32x4*)(gp + b * D + col0 + bj * 128 + 4 * n); }
        constexpr int MB_ = RES_F32 ? 2 : 4;
        float qs[8];
#pragma unroll
        for (int ai = 0; ai < 2; ++ai)
#pragma unroll
        for (int m0 = 0; m0 < 4; m0 += MB_) {
            f32x4 rf[4][2][2]; h16x8 rh[4][2];
#pragma unroll
            for (int m = m0; m < m0 + MB_; ++m)
#pragma unroll
                for (int bj = 0; bj < 2; ++bj) { const size_t off = (size_t)(row0 + ai * 128 + m * 16) * D + col0 + bj * 128;
                    if constexpr (PVAR == 2 || PVAR == 6 || PVAR == 7) { rf[m][bj][0] = (f32x4){0.f, 0.f, 0.f, 0.f}; rf[m][bj][1] = rf[m][bj][0]; rh[m][bj] = (h16x8){0, 0, 0, 0, 0, 0, 0, 0}; }
                    else if constexpr (PVAR == 3) { const h16x8 t = *(const GAS h16x8*)(HG + blk_off(row0 + ai * 128 + m * 16, col0 + bj * 128, D / 64)); rf[m][bj][0] = (f32x4){(float)t[0], (float)t[1], (float)t[2], (float)t[3]}; rf[m][bj][1] = (f32x4){(float)t[4], (float)t[5], (float)t[6], (float)t[7]}; }
                    else if constexpr (RES_F32) { rf[m][bj][0] = *(const GAS f32x4*)(xres + off); rf[m][bj][1] = *(const GAS f32x4*)(xres + off + 4); }
                    else rh[m][bj] = *(const GAS h16x8*)(H + blk_off(row0 + ai * 128 + m * 16, col0 + bj * 128, D / 64)); }
            asm volatile("" ::: "memory");
#pragma unroll
            for (int m = m0; m < m0 + MB_; ++m) {
                const int row = row0 + ai * 128 + m * 16; const size_t off = (size_t)row * D + col0;
                float rsc = 1.f; if constexpr (TWOSCALE) rsc = sct[ui * 512 + 256 + wr * 64 + fr + ai * 128 + m * 16];
                float q = 0.f;
#pragma unroll
                for (int bj = 0; bj < 2; ++bj) {
                    f32x4 r0, r1;
                    if constexpr (RES_F32) { r0 = rf[m][bj][0]; r1 = rf[m][bj][1]; }
                    else { const h16x8 hv = rh[m][bj]; r0 = (f32x4){(float)hv[0], (float)hv[1], (float)hv[2], (float)hv[3]}; r1 = (f32x4){(float)hv[4], (float)hv[5], (float)hv[6], (float)hv[7]}; }
                    const f32x4 v0 = r0 + csv[bj][0] * (acc[ai][bj][m][0] * rsc), v1 = r1 + csv[bj][1] * (acc[ai][bj][m][1] * rsc);
                    q += ((v0[0] * v0[0] + v0[1] * v0[1]) + (v0[2] * v0[2] + v0[3] * v0[3])) + ((v1[0] * v1[0] + v1[1] * v1[1]) + (v1[2] * v1[2] + v1[3] * v1[3]));
                    u32x4 w; w[0] = pkh(v0[0], v0[1]); w[1] = pkh(v0[2], v0[3]); w[2] = pkh(v1[0], v1[1]); w[3] = pkh(v1[2], v1[3]);
                    const int colp = u.pn * 256 + wc * 64 + 16 * fq + 8 * bj;
                    if constexpr (PVAR == 1) asm volatile("" :: "v"(w)); else if constexpr (PVAR == 4) *(GAS u32x4*)(H + blk_off(row, col0 + bj * 128, D / 64)) = w;
                    else if constexpr (PVAR == 5) *(GAS u32x4*)(H + (size_t)row * D + colp) = w; else if constexpr (PVAR == 7) __builtin_nontemporal_store(w, (GAS u32x4*)(H + off + bj * 128)); else st_stream<1>((GAS u32x4*)(H + blk_off(row, col0 + bj * 128, D / 64)), w);
                    if constexpr (WRITE_HG) { const f32x4 g0 = v0 * gpv[bj][0], g1 = v1 * gpv[bj][1];
                        u32x4 wg;
                        if constexpr (TWOSCALE) { wg[0] = pkh8(g0[0], g0[1]); wg[1] = pkh8(g0[2], g0[3]); wg[2] = pkh8(g1[0], g1[1]); wg[3] = pkh8(g1[2], g1[3]); }
                        else { wg[0] = pkh(g0[0], g0[1]); wg[1] = pkh(g0[2], g0[3]); wg[2] = pkh(g1[0], g1[1]); wg[3] = pkh(g1[2], g1[3]); }
                        if constexpr (PVAR == 1 || PVAR == 6) asm volatile("" :: "v"(wg)); else if constexpr (PVAR == 7) __builtin_nontemporal_store(wg, (GAS u32x4*)(HG + blk_off(row, col0 + bj * 128, D / 64))); else if constexpr (PVAR == 5) *(GAS u32x4*)(HG + blk_off(row, colp, D / 64)) = wg; else st_stream<2>((GAS u32x4*)(HG + blk_off(row, col0 + bj * 128, D / 64)), wg); }
                }
                q += __shfl_xor(q, 16); q += __shfl_xor(q, 32);
                qs[ai * 4 + m] = q;
            }
        }
        if constexpr (PVAR != 1) {
            const float qa = fq == 0 ? qs[0] : fq == 1 ? qs[2] : fq == 2 ? qs[4] : qs[6], qb = fq == 0 ? qs[1] : fq == 1 ? qs[3] : fq == 2 ? qs[5] : qs[7];
            GAS float* sp = ssq + (size_t)(u.pn * 4 + wc) * M + row0 + (fq >> 1) * 128 + (fq & 1) * 32;
            sp[0] = qa; sp[16] = qb;
        }
    }
};
static_assert((24576 + 128 * 64) * 4 <= (int)CTL_ZERO_BYTES, "control words inside the zeroed region");
constexpr int CW_PAN2 = 24576;
constexpr int CW_PAN = 16384;
struct EpiFinal {
    static constexpr bool MID = false;
    const GAS h16* H; const GAS float* cs; const GAS float* gfin; GAS float* out; unsigned* xs; unsigned* cnt; unsigned* tmo; LAS float* P; LAS float* Sx; float cmul;
    __device__ __forceinline__ void mid(f32x4 (&)[2][2][4][2], const pg8::Unit&, int, int, int, int, int) const {}
    __device__ __forceinline__ void operator()(f32x4 (&acc)[2][2][4][2], const pg8::Unit& u, int ui, int wr, int wc, int fr, int fq) const {
        const int b = u.pm >> 5, row0 = u.pm * 256 + wr * 64 + fr, col0 = u.pn * 256 + wc * 32 + 8 * fq;
        const int tid = threadIdx.x, lane = tid & 63, wid = __builtin_amdgcn_readfirstlane(tid >> 6);
        f32x4 csv[2][2];
#pragma unroll
        for (int bj = 0; bj < 2; ++bj)
#pragma unroll
            for (int n = 0; n < 2; ++n) csv[bj][n] = *(const GAS f32x4*)(cs + b * D + col0 + bj * 128 + 4 * n) * cmul;
#pragma unroll
        for (int ai = 0; ai < 2; ++ai) {
            h16x8 rh[4][2];
#pragma unroll
            for (int m = 0; m < 4; ++m)
#pragma unroll
                for (int bj = 0; bj < 2; ++bj) rh[m][bj] = *(const GAS h16x8*)(H + blk_off(row0 + ai * 128 + m * 16, col0 + bj * 128, D / 64));
#pragma unroll
            for (int m = 0; m < 4; ++m) {
                float q = 0.f;
#pragma unroll
                for (int bj = 0; bj < 2; ++bj) { const h16x8 hv = rh[m][bj];
                    const f32x4 v0 = (f32x4){(float)hv[0], (float)hv[1], (float)hv[2], (float)hv[3]} + csv[bj][0] * acc[ai][bj][m][0], v1 = (f32x4){(float)hv[4], (float)hv[5], (float)hv[6], (float)hv[7]} + csv[bj][1] * acc[ai][bj][m][1];
                    acc[ai][bj][m][0] = v0; acc[ai][bj][m][1] = v1;
                    q += ((v0[0] * v0[0] + v0[1] * v0[1]) + (v0[2] * v0[2] + v0[3] * v0[3])) + ((v1[0] * v1[0] + v1[1] * v1[1]) + (v1[2] * v1[2] + v1[3] * v1[3])); }
                q += __shfl_xor(q, 16); q += __shfl_xor(q, 32);
                if (fq == 0) P[(ai * 128 + wr * 64 + m * 16 + fr) * 4 + wc] = q;
            }
        }
        asm volatile("s_waitcnt lgkmcnt(0)" ::: "memory"); __builtin_amdgcn_s_barrier(); asm volatile("" ::: "memory");
        if (tid < 256) {
            const f32x4 p4 = *(const LAS f32x4*)(P + tid * 4);
            __hip_atomic_store(xs + ((size_t)(u.pm * 256 + tid) * 4 + u.pn), __float_as_uint((p4[0] + p4[1]) + (p4[2] + p4[3])), __ATOMIC_RELAXED, __HIP_MEMORY_SCOPE_AGENT);
        }
        asm volatile("s_waitcnt vmcnt(0)" ::: "memory");
        if (wid < 4 && lane == 0) __hip_atomic_fetch_add(cnt + 64 * u.pm, 1u, __ATOMIC_RELAXED, __HIP_MEMORY_SCOPE_AGENT);
        if (wid == 0) {
            unsigned sp = 0u;
            while ((unsigned)__builtin_amdgcn_readfirstlane(__hip_atomic_load(cnt + 64 * u.pm, __ATOMIC_RELAXED, __HIP_MEMORY_SCOPE_AGENT)) < 16u) {
                __builtin_amdgcn_s_sleep(2);
                if (++sp > (1u << 16)) { if (lane == 0) __hip_atomic_store(tmo, 1u, __ATOMIC_RELAXED, __HIP_MEMORY_SCOPE_AGENT); break; }
            }
            __builtin_amdgcn_fence(__ATOMIC_ACQUIRE, "agent");
        }
        asm volatile("s_waitcnt vmcnt(0) lgkmcnt(0)" ::: "memory"); __builtin_amdgcn_s_barrier(); asm volatile("" ::: "memory");
        if (tid < 256) {
            const unsigned* sl = xs + (size_t)(u.pm * 256 + tid) * 4;
            const float s0 = __uint_as_float(__hip_atomic_load(sl + 0, __ATOMIC_RELAXED, __HIP_MEMORY_SCOPE_AGENT)), s1 = __uint_as_float(__hip_atomic_load(sl + 1, __ATOMIC_RELAXED, __HIP_MEMORY_SCOPE_AGENT)),
                        s2 = __uint_as_float(__hip_atomic_load(sl + 2, __ATOMIC_RELAXED, __HIP_MEMORY_SCOPE_AGENT)), s3 = __uint_as_float(__hip_atomic_load(sl + 3, __ATOMIC_RELAXED, __HIP_MEMORY_SCOPE_AGENT));
            Sx[tid] = rsqrtf(((s0 + s1) + (s2 + s3)) * (1.f / D) + EPS);
        }
        asm volatile("s_waitcnt vmcnt(0) lgkmcnt(0)" ::: "memory"); __builtin_amdgcn_s_barrier(); asm volatile("" ::: "memory");
        f32x4 gv[2][2];
#pragma unroll
        for (int bj = 0; bj < 2; ++bj)
#pragma unroll
            for (int n = 0; n < 2; ++n) gv[bj][n] = *(const GAS f32x4*)(gfin + col0 + bj * 128 + 4 * n);
#pragma unroll
        for (int ai = 0; ai < 2; ++ai)
#pragma unroll
            for (int m = 0; m < 4; ++m) { const int rl = ai * 128 + wr * 64 + m * 16 + fr; const float rs = Sx[rl]; GAS float* op = out + (size_t)(u.pm * 256 + rl) * D + col0;
#pragma unroll
                for (int bj = 0; bj < 2; ++bj) { st_stream<0>((GAS f32x4*)(op + bj * 128), acc[ai][bj][m][0] * rs * gv[bj][0]); st_stream<0>((GAS f32x4*)(op + bj * 128 + 4), acc[ai][bj][m][1] * rs * gv[bj][1]); } }
        asm volatile("s_waitcnt lgkmcnt(0)" ::: "memory"); __builtin_amdgcn_s_barrier(); asm volatile("" ::: "memory");
    }
};
struct EpiOutX {
    static constexpr bool MID = true;
    GAS h16* H; GAS h16* HG; const GAS float* cs; const GAS float* gp; const GAS float* shp; unsigned* xs; unsigned* cnt; unsigned* tmo; const LAS float* sct; LAS float* P; LAS float* Sx; float cmul;
    __device__ __forceinline__ void mid(f32x4 (&acc)[2][2][4][2], const pg8::Unit& u, int ui, int wr, int wc, int fr, int fq) const {
        const LAS float* t = sct + ui * 512 + wr * 64 + fr;
#pragma unroll
        for (int ai = 0; ai < 2; ++ai)
#pragma unroll
            for (int m = 0; m < 4; ++m) { const float f = t[ai * 128 + m * 16];
#pragma unroll
                for (int bj = 0; bj < 2; ++bj)
#pragma unroll
                    for (int n = 0; n < 2; ++n) acc[ai][bj][m][n] *= f; }
    }
    __device__ __forceinline__ void operator()(f32x4 (&acc)[2][2][4][2], const pg8::Unit& u, int ui, int wr, int wc, int fr, int fq) const {
        const int b = u.pm >> 5, row0 = u.pm * 256 + wr * 64 + fr, col0 = u.pn * 256 + wc * 32 + 8 * fq;
        const int tid = threadIdx.x, lane = tid & 63, wid = __builtin_amdgcn_readfirstlane(tid >> 6);
        f32x4 csv[2][2];
#pragma unroll
        for (int bj = 0; bj < 2; ++bj)
#pragma unroll
            for (int n = 0; n < 2; ++n) csv[bj][n] = *(const GAS f32x4*)(cs + b * D + col0 + bj * 128 + 4 * n) * cmul;
#pragma unroll
        for (int ai = 0; ai < 2; ++ai) {
            h16x8 rh[4][2];
#pragma unroll
            for (int m = 0; m < 4; ++m)
#pragma unroll
                for (int bj = 0; bj < 2; ++bj) rh[m][bj] = *(const GAS h16x8*)(H + blk_off(row0 + ai * 128 + m * 16, col0 + bj * 128, D / 64));
#pragma unroll
            for (int m = 0; m < 4; ++m) {
                const float rsc = sct[ui * 512 + 256 + wr * 64 + fr + ai * 128 + m * 16];
                float q = 0.f;
#pragma unroll
                for (int bj = 0; bj < 2; ++bj) { const h16x8 hv = rh[m][bj];
                    const f32x4 v0 = (f32x4){(float)hv[0], (float)hv[1], (float)hv[2], (float)hv[3]} + csv[bj][0] * (acc[ai][bj][m][0] * rsc), v1 = (f32x4){(float)hv[4], (float)hv[5], (float)hv[6], (float)hv[7]} + csv[bj][1] * (acc[ai][bj][m][1] * rsc);
                    acc[ai][bj][m][0] = v0; acc[ai][bj][m][1] = v1;
                    q += ((v0[0] * v0[0] + v0[1] * v0[1]) + (v0[2] * v0[2] + v0[3] * v0[3])) + ((v1[0] * v1[0] + v1[1] * v1[1]) + (v1[2] * v1[2] + v1[3] * v1[3])); }
                q += __shfl_xor(q, 16); q += __shfl_xor(q, 32);
                if (fq == 0) P[(ai * 128 + wr * 64 + m * 16 + fr) * 4 + wc] = q;
            }
        }
        asm volatile("s_waitcnt lgkmcnt(0)" ::: "memory"); __builtin_amdgcn_s_barrier(); asm volatile("" ::: "memory");
        if (tid < 256) {
            const f32x4 p4 = *(const LAS f32x4*)(P + tid * 4);
            __hip_atomic_store(xs + ((size_t)(u.pm * 256 + tid) * 4 + u.pn), __float_as_uint((p4[0] + p4[1]) + (p4[2] + p4[3])), __ATOMIC_RELAXED, __HIP_MEMORY_SCOPE_AGENT);
        }
        asm volatile("s_waitcnt vmcnt(0)" ::: "memory");
        if (wid < 4 && lane == 0) __hip_atomic_fetch_add(cnt + 64 * u.pm, 1u, __ATOMIC_RELAXED, __HIP_MEMORY_SCOPE_AGENT);
        if (wid == 0) {
            unsigned sp = 0u;
            while ((unsigned)__builtin_amdgcn_readfirstlane(__hip_atomic_load(cnt + 64 * u.pm, __ATOMIC_RELAXED, __HIP_MEMORY_SCOPE_AGENT)) < 16u) {
                __builtin_amdgcn_s_sleep(2);
                if (++sp > (1u << 16)) { if (lane == 0) __hip_atomic_store(tmo, 1u, __ATOMIC_RELAXED, __HIP_MEMORY_SCOPE_AGENT); break; }
            }
            __builtin_amdgcn_fence(__ATOMIC_ACQUIRE, "agent");
        }
        asm volatile("s_waitcnt vmcnt(0) lgkmcnt(0)" ::: "memory"); __builtin_amdgcn_s_barrier(); asm volatile("" ::: "memory");
        if (tid < 256) {
            const unsigned* sl = xs + (size_t)(u.pm * 256 + tid) * 4;
            const float s0 = __uint_as_float(__hip_atomic_load(sl + 0, __ATOMIC_RELAXED, __HIP_MEMORY_SCOPE_AGENT)), s1 = __uint_as_float(__hip_atomic_load(sl + 1, __ATOMIC_RELAXED, __HIP_MEMORY_SCOPE_AGENT)),
                        s2 = __uint_as_float(__hip_atomic_load(sl + 2, __ATOMIC_RELAXED, __HIP_MEMORY_SCOPE_AGENT)), s3 = __uint_as_float(__hip_atomic_load(sl + 3, __ATOMIC_RELAXED, __HIP_MEMORY_SCOPE_AGENT));
            Sx[tid] = rsqrtf(((s0 + s1) + (s2 + s3)) * (1.f / D) + EPS);
        }
        asm volatile("s_waitcnt vmcnt(0) lgkmcnt(0)" ::: "memory"); __builtin_amdgcn_s_barrier(); asm volatile("" ::: "memory");
        f32x4 gpv[2][2], shv[2][2];
#pragma unroll
        for (int bj = 0; bj < 2; ++bj)
#pragma unroll
            for (int n = 0; n < 2; ++n) { gpv[bj][n] = *(const GAS f32x4*)(gp + b * D + col0 + bj * 128 + 4 * n); shv[bj][n] = *(const GAS f32x4*)(shp + b * D + col0 + bj * 128 + 4 * n); }
#pragma unroll
        for (int ai = 0; ai < 2; ++ai)
#pragma unroll
            for (int m = 0; m < 4; ++m) { const int rl = ai * 128 + wr * 64 + m * 16 + fr; const float rs = Sx[rl]; const int row = u.pm * 256 + rl;
#pragma unroll
                for (int bj = 0; bj < 2; ++bj) { const f32x4 v0 = acc[ai][bj][m][0], v1 = acc[ai][bj][m][1];
                    u32x4 w; w[0] = pkh(v0[0], v0[1]); w[1] = pkh(v0[2], v0[3]); w[2] = pkh(v1[0], v1[1]); w[3] = pkh(v1[2], v1[3]);
                    st_stream<1>((GAS u32x4*)(H + blk_off(row, col0 + bj * 128, D / 64)), w);
                    const f32x4 g0 = v0 * (gpv[bj][0] * rs) + shv[bj][0], g1 = v1 * (gpv[bj][1] * rs) + shv[bj][1];
                    u32x4 wg; wg[0] = pkh8(g0[0], g0[1]); wg[1] = pkh8(g0[2], g0[3]); wg[2] = pkh8(g1[0], g1[1]); wg[3] = pkh8(g1[2], g1[3]);
                    st_stream<2>((GAS u32x4*)(HG + blk_off(row, col0 + bj * 128, D / 64)), wg); } }
        asm volatile("s_waitcnt lgkmcnt(0)" ::: "memory"); __builtin_amdgcn_s_barrier(); asm volatile("" ::: "memory");
    }
};
template <int PVAR = 0> struct EpiInproj {
    static constexpr bool MID = false;
    GAS h16* proj; const LAS float* rtab; const GAS float* bias; const GAS float* rope; GAS float* kmp; const LAS float* dtab;
    __device__ __forceinline__ void mid(f32x4 (&)[2][2][4][2], const pg8::Unit&, int, int, int, int, int) const {}
    __device__ __forceinline__ void operator()(AccRef acc, const pg8::Unit& u, int ui, int wr, int wc, int fr, int fq) const {
        const int b = u.pm >> 5, row0 = u.pm * 256 + wr * 64 + fr, region = u.pn >> 1;
        const GAS float* bp = bias + b * INW + u.pn * 256 + wc * 32 + 4 * fq;
        f32x4 bv[2][2];
#pragma unroll
        for (int bj = 0; bj < 2; ++bj)
#pragma unroll
            for (int n = 0; n < 2; ++n) bv[bj][n] = *(const GAS f32x4*)(bp + bj * 128 + n * 16);
        const bool is_rope = (region == 0) || (region == 2);
        const float qs = (region == 0) ? C2 : 1.f;
#pragma unroll
        for (int bj = 0; bj < 2; ++bj)
#pragma unroll
            for (int n = 0; n < 2; ++n) bv[bj][n] *= qs;
        f32x4 csum[2][2];
#pragma unroll
        for (int bj = 0; bj < 2; ++bj)
#pragma unroll
            for (int n = 0; n < 2; ++n) csum[bj][n] = (f32x4){0.f, 0.f, 0.f, 0.f};
        const int hsel = (u.pn & 1) * 4, rin0 = wr * 64 + fr;
        GAS h16* ubase; int rstride = 64, bjs;
        if (is_rope) { ubase = (region == 0 ? proj + (size_t)(u.pm * 16 + hsel + wc) * 16384 : proj + OFF_KB + (size_t)(u.pm * 8 + hsel + wc) * 16384) + rin0 * 64 + 16 * fq; bjs = 8; }
        else if (region == 4) { ubase = proj + OFF_GV + ((size_t)u.pm * 256 + rin0) * 512 + hsel * 64 + 32 * wc + 8 * fq; rstride = 512; bjs = 128; }
        else { ubase = proj + (region == 1 ? OFF_UB : OFF_VB) + (size_t)(u.pm * 8 + hsel + (wc >> 1)) * 16384 + rin0 * 64 + 32 * (wc & 1) + 8 * fq; bjs = 2 * 16384; }
        const LAS float* rt = rtab + ui * 256 + wr * 64 + fr;
        f32x4 bcs[2], bsn[2];
        if (is_rope) { const GAS float* rp = rope + (size_t)(row0 & (S - 1)) * 64 + 4 * fq;
#pragma unroll
            for (int n = 0; n < 2; ++n) { if constexpr (PVAR == 1) { bcs[n] = (f32x4){1.f, 1.f, 1.f, 1.f}; bsn[n] = (f32x4){0.f, 0.f, 0.f, 0.f}; } else { bcs[n] = *(const GAS f32x4*)(rp + 16 * n); bsn[n] = *(const GAS f32x4*)(rp + 32 + 16 * n); } } }
#pragma unroll
        for (int ri = 0; ri < 8; ++ri) {
            const int ai = ri >> 2, m = ri & 3;
            {
                const int row = row0 + ai * 128 + m * 16;
                const float rs = rt[ai * 128 + m * 16] * qs;
                f32x4 v[2][2];
#pragma unroll
                for (int bj = 0; bj < 2; ++bj)
#pragma unroll
                    for (int n = 0; n < 2; ++n) v[bj][n] = acc[ai][bj][m][n] * rs + bv[bj][n];
                GAS h16* hp = ubase + (ai * 128 + m * 16) * rstride;
                if (is_rope) {
#pragma unroll
                    for (int n = 0; n < 2; ++n) {
                        const LAS float* dp = dtab + ri * 64 + 4 * fq + 16 * n;
                        const f32x4 dc = *(const LAS f32x4*)dp, ds = *(const LAS f32x4*)(dp + 32);
                        const f32x4 x1 = v[0][n], x2 = v[1][n];
                        const f32x4 y1 = x1 * bcs[n] - x2 * bsn[n], y2 = x2 * bcs[n] + x1 * bsn[n];
                        v[0][n] = y1 * dc - y2 * ds; v[1][n] = y2 * dc + y1 * ds;
                    }
#pragma unroll
                    for (int bj = 0; bj < 2; ++bj) { u32x4 w; w[0] = pkh(v[bj][0][0], v[bj][0][1]); w[1] = pkh(v[bj][0][2], v[bj][0][3]); w[2] = pkh(v[bj][1][0], v[bj][1][1]); w[3] = pkh(v[bj][1][2], v[bj][1][3]);
                        if constexpr (PVAR == 3) asm volatile("" :: "v"(w)); else st_stream<4>((GAS u32x4*)(hp + bjs * bj), w); }
                    if (region == 2) {
#pragma unroll
                        for (int bj = 0; bj < 2; ++bj)
#pragma unroll
                            for (int n = 0; n < 2; ++n) csum[bj][n] += v[bj][n];
                    }
                } else {
                    if ((region == 1 || region == 4) && PVAR != 2) {
#pragma unroll
                        for (int bj = 0; bj < 2; ++bj)
#pragma unroll
                            for (int n = 0; n < 2; ++n)
#pragma unroll
                                for (int j = 0; j < 4; ++j) v[bj][n][j] = gelu_fast(v[bj][n][j]);
                    }
#pragma unroll
                    for (int bj = 0; bj < 2; ++bj) { u32x4 w; w[0] = pkh(v[bj][0][0], v[bj][0][1]); w[1] = pkh(v[bj][0][2], v[bj][0][3]); w[2] = pkh(v[bj][1][0], v[bj][1][1]); w[3] = pkh(v[bj][1][2], v[bj][1][3]);
                        if constexpr (PVAR == 3) asm volatile("" :: "v"(w)); else st_stream<4>((GAS u32x4*)(hp + bjs * bj), w); }
                }
            }
        }
        if (region == 2 && PVAR != 4) {
#pragma unroll
            for (int bj = 0; bj < 2; ++bj)
#pragma unroll
                for (int n = 0; n < 2; ++n)
#pragma unroll
                    for (int j = 0; j < 4; ++j) { float t = csum[bj][n][j]; t += __shfl_xor(t, 1); t += __shfl_xor(t, 2); t += __shfl_xor(t, 4); t += __shfl_xor(t, 8); csum[bj][n][j] = t; }
            if (fr == 0) {
                GAS float* kp = kmp + ((size_t)((b * NBLK + (u.pm & 31)) * 2 + wr)) * 512 + ((u.pn & 1) * 4 + wc) * 64 + 16 * fq;
#pragma unroll
                for (int bj = 0; bj < 2; ++bj)
#pragma unroll
                    for (int n = 0; n < 2; ++n) *(GAS f32x4*)(kp + 8 * bj + 4 * n) = csum[bj][n];
            }
        }
    }
};

#define XB_TMO      128
#define XB_XCNT(j)  (256  + 64 * (j))
#define XB_XSUB(j)  (1280 + 64 * (j))
#define XB_XGEN(j)  (2304 + 64 * (j))
#define XB_TOP      3328
#define XB_TOPGEN   3392
#define XCD_BAR_WORDS 3456
#define XB_SPIN_CAP (1u << 18)
__device__ __forceinline__ unsigned xb_ld(unsigned* p)              { return __hip_atomic_load(p, __ATOMIC_RELAXED, __HIP_MEMORY_SCOPE_AGENT); }
__device__ __forceinline__ unsigned xb_add(unsigned* p, unsigned v) { return __hip_atomic_fetch_add(p, v, __ATOMIC_RELAXED, __HIP_MEMORY_SCOPE_AGENT); }
__device__ __forceinline__ unsigned xb_xcc_id() { return (unsigned)__builtin_amdgcn_s_getreg((3 << 11) | 20) & 0xFu; }
#define XB_SPIN(cond, bar) do { unsigned _sp = 0; while (cond) { __builtin_amdgcn_s_sleep(1); \
    if ((++_sp & 255u) == 0u) { if (xb_ld(&(bar)[XB_TMO])) break; if (_sp > XB_SPIN_CAP) { atomicAdd(&(bar)[XB_TMO], 1u); break; } } } } while (0)
struct XcdBarrier { unsigned* bar; unsigned x; volatile LAS unsigned* st; };
__device__ __forceinline__ XcdBarrier xcd_barrier_post(unsigned* bar, volatile LAS unsigned* st) {
    XcdBarrier b; b.bar = bar; b.x = xb_xcc_id(); b.st = st;
    if (threadIdx.x == 0) (void)xb_add(&bar[XB_XCNT(b.x)], 1u);
    return b;
}
__device__ __forceinline__ void xcd_barrier_complete(unsigned* bar, unsigned x, unsigned& nloc, unsigned& nx) {
    const unsigned G = gridDim.x * gridDim.y * gridDim.z;
    unsigned sum, cnt, mine, sp = 0u;
    for (;;) {
        sum = 0u; cnt = 0u; mine = 0u;
#pragma unroll
        for (unsigned j = 0; j < 16; ++j) { const unsigned c = xb_ld(&bar[XB_XCNT(j)]); sum += c; cnt += (c > 0u) ? 1u : 0u; mine = (j == x) ? c : mine; }
        if (sum == G) break;
        __builtin_amdgcn_s_sleep(1);
        if ((++sp & 255u) == 0u) { if (xb_ld(&bar[XB_TMO])) break; if (sp > XB_SPIN_CAP) { atomicAdd(&bar[XB_TMO], 1u); break; } }
    }
    nloc = mine > 0u ? mine : 1u; nx = cnt > 0u ? cnt : 1u;
}
__device__ __forceinline__ void xcd_barrier(const XcdBarrier& b) {
    asm volatile("s_waitcnt vmcnt(0)" ::: "memory");
    __syncthreads();
    if (threadIdx.x == 0) {
        unsigned* bar = b.bar;
        __builtin_amdgcn_s_waitcnt(0);
        unsigned nloc = b.st[0], nx = b.st[1];
        if (nloc == 0u) { xcd_barrier_complete(bar, b.x, nloc, nx); b.st[0] = nloc; b.st[1] = nx; }
        const unsigned old = xb_add(&bar[XB_XSUB(b.x)], 1u);
        const unsigned gen = old / nloc;
        if (old + 1u == (gen + 1u) * nloc) {
            __builtin_amdgcn_fence(__ATOMIC_RELEASE, "agent");
            asm volatile("s_waitcnt vmcnt(0)" ::: "memory");
            const unsigned og = xb_add(&bar[XB_TOP], 1u);
            const unsigned tg = og / nx;
            if (og + 1u == (tg + 1u) * nx) xb_add(&bar[XB_TOPGEN], 1u);
            else XB_SPIN(xb_ld(&bar[XB_TOPGEN]) == tg, bar);
            __builtin_amdgcn_fence(__ATOMIC_ACQUIRE, "agent");
            xb_add(&bar[XB_XGEN(b.x)], 1u);
            asm volatile("s_waitcnt vmcnt(0)" ::: "memory");
        } else {
            XB_SPIN(xb_ld(&bar[XB_XGEN(b.x)]) == gen, bar);
            __builtin_amdgcn_fence(__ATOMIC_ACQUIRE, "agent");
            asm volatile("s_waitcnt vmcnt(0)" ::: "memory");
        }
    }
    __syncthreads();
}

#define GIN(a_, i_) ((const GAS float*)(a_).in[i_])
struct Args { const float* in[20]; float* out; unsigned char* ws; int ph_lo, ph_hi; int shadow, pad; };
struct Frame {
    LAS unsigned char* lds; volatile LAS unsigned* MISC; unsigned* ctl;
    int tid, lane, wave, vcu, G;
    unsigned char* ws; GAS float* out;
};

__device__ __forceinline__ float round8(float x) { return round8a(x); }
__device__ __forceinline__ int p8(int l) { return (l & ~31) + 16 * ((l >> 2) & 1) + 4 * ((l >> 3) & 3) + (l & 3); }
__device__ __forceinline__ int phys_gu(int L) { const int isu = L >= DFF, hid = isu ? L - DFF : L, pn = hid >> 7, hh = hid & 127; return 256 * pn + 128 * isu + p8(hh); }
__device__ __forceinline__ int phys_in(int L) {
    const int reg = L >> 9, l = L & 511;
    const int preg = reg == 0 ? 0 : reg == 1 ? 2 : reg == 2 ? 3 : reg == 3 ? 1 : 4;
    if (reg <= 1) { const int head = l >> 6, d = l & 63, bj = d >> 5, i = d & 31; return 512 * preg + 256 * (head >> 2) + 128 * bj + 32 * (head & 3) + i; }
    return 512 * preg + p8(l);
}
enum PhysKind { PH_GU = 0, PH_P8 = 1, PH_IN = 2 };
template <int KIND> __device__ __forceinline__ int physmap(int L) { return KIND == PH_GU ? phys_gu(L) : KIND == PH_P8 ? p8(L) : phys_in(L); }

template <int KIND, bool LOWENT = false, bool GUSCALE = false> __device__ __forceinline__ void p0_transpose_item(const GAS float* W, int K, int N, GAS h16* WT, const GAS float* kscale, LAS float* scr, int item, int lane) {
    const int nblk = N / 32, kb = item / nblk, nb = item % nblk, k0 = 64 * kb, n0 = 32 * nb;
    float wv[32];
#pragma unroll
    for (int i = 0; i < 32; ++i) { const int kk = 2 * i + (lane >> 5); wv[i] = W[(size_t)(k0 + kk) * N + n0 + (lane & 31)]; }
    if (kscale) {
#pragma unroll
        for (int i = 0; i < 32; ++i) wv[i] *= kscale[k0 + 2 * i + (lane >> 5)]; }
    const float gus = !GUSCALE ? 1.f : ((physmap<KIND>(n0 + (lane & 31)) & 255) >= 128 ? -0.6931471805599453f : -1.4426950408889634f);
#pragma unroll
    for (int i = 0; i < 32; ++i) { const float wz = GUSCALE ? wv[i] * gus : wv[i]; scr[(2 * i + (lane >> 5)) * 33 + (lane & 31)] = (LOWENT && MK_LOWENT) ? round8(wz) : wz; }
    LDS_WAIT(); asm volatile("" ::: "memory");
    const int c = lane & 7;
#pragma unroll
    for (int j = 0; j < 4; ++j) { const int n = (lane >> 3) + 8 * j; const LAS float* s = scr + (8 * c) * 33 + n;
        u32x4 o; o.x = pkh(s[0 * 33], s[1 * 33]); o.y = pkh(s[2 * 33], s[3 * 33]); o.z = pkh(s[4 * 33], s[5 * 33]); o.w = pkh(s[6 * 33], s[7 * 33]);
        *(GAS u32x4*)(WT + blk_off(physmap<KIND>(n0 + n), k0 + 8 * c, K / 64)) = o; }
    LDS_WAIT(); asm volatile("" ::: "memory");
}

__device__ __forceinline__ void p0_prologue(const Frame& F0, const Args& a) {
    Frame F = F0; F.tid = threadIdx.x; F.lane = F.tid & 63; F.wave = __builtin_amdgcn_readfirstlane(F.tid >> 6);
    const GAS float* c = GIN(a, 1); const GAS float* w_ada = GIN(a, 2);
    {
        LAS float* red = (LAS float*)F.lds;
        LAS float* svt = (LAS float*)(F.lds + 16384);
#define ADA_LOAD(dst_, item_) do { const int cg_ = (item_) % 72, kq_ = (item_) / 72, col_ = cg_ * 128 + (F.lane & 31) * 4, kb_ = kq_ * 256 + F.wave * 32 + (F.lane >> 5); \
            _Pragma("unroll") for (int i_ = 0; i_ < 16; ++i_) dst_[i_] = *(const GAS f32x4*)(w_ada + (size_t)(kb_ + 2 * i_) * (NMOD * D) + col_); } while (0)
        f32x4 wcur[16], wnxt[16];
        if (F.vcu < 72 * 4) ADA_LOAD(wcur, F.vcu);
        asm volatile("" ::: "memory");
        for (int e = F.tid; e < 4 * D; e += NWAVES * 64) { const float cv = c[e]; svt[e] = cv / (1.f + __expf(-cv)); }
        __syncthreads();
        for (int item = F.vcu; item < 72 * 4; item += F.G) {
            const int cg = item % 72, kq = item / 72, hlf = F.lane >> 5;
            if (item + F.G < 72 * 4) ADA_LOAD(wnxt, item + F.G);
            asm volatile("" ::: "memory");
            f32x4 acc[4] = {{0.f, 0.f, 0.f, 0.f}, {0.f, 0.f, 0.f, 0.f}, {0.f, 0.f, 0.f, 0.f}, {0.f, 0.f, 0.f, 0.f}};
            const int kbase = kq * 256 + F.wave * 32 + hlf;
#pragma unroll
            for (int i = 0; i < 16; ++i) { const int k = kbase + 2 * i; const f32x4 w4 = wcur[i];
#pragma unroll
                for (int b = 0; b < 4; ++b) { const float sv = svt[b * D + k]; acc[b] += w4 * sv; } }
#pragma unroll
            for (int b = 0; b < 4; ++b)
#pragma unroll
                for (int j = 0; j < 4; ++j) acc[b][j] += __shfl_xor(acc[b][j], 32);
            if (hlf == 0) {
#pragma unroll
                for (int b = 0; b < 4; ++b) *(LAS f32x4*)(red + (F.wave * 4 + b) * 128 + (F.lane & 31) * 4) = acc[b];
            }
            __syncthreads();
            { const int b = F.tid >> 7, cc = F.tid & 127; float s = 0.f;
#pragma unroll
              for (int w = 0; w < 8; ++w) s += red[(w * 4 + b) * 128 + cc];
              ((GAS float*)(F.ws + WS_MODP))[(size_t)(kq * 4 + b) * (NMOD * D) + cg * 128 + cc] = s; }
            __syncthreads();
#pragma unroll
            for (int i = 0; i < 16; ++i) wcur[i] = wnxt[i];
        }
#undef ADA_LOAD
    }
    LAS float* scr = (LAS float*)(F.lds + F.wave * 16384);
    const int gw = F.vcu * NWAVES + F.wave, NGW = F.G * NWAVES;
    constexpr int I_GU = (D / 64) * (NGU / 32), I_DN = (DFF / 64) * (D / 32), I_IN = (D / 64) * (INW / 32), I_OUT = (D / 64) * (D / 32);
    constexpr int NITEMS = 2 * I_GU + 2 * I_DN + I_IN + I_OUT;
    for (int it = gw; it < NITEMS; it += NGW) {
        int r = it;
        if (r < I_GU) { p0_transpose_item<PH_GU, true, true>(GIN(a, 5), D, NGU, (GAS h16*)(F.ws + WS_WGU1), nullptr, scr, r, F.lane); continue; } r -= I_GU;
        if (r < I_GU) { p0_transpose_item<PH_GU, true, true>(GIN(a, 17), D, NGU, (GAS h16*)(F.ws + WS_WGU2), nullptr, scr, r, F.lane); continue; } r -= I_GU;
        if (r < I_DN) { p0_transpose_item<PH_P8, true>(GIN(a, 6), DFF, D, (GAS h16*)(F.ws + WS_WD1), nullptr, scr, r, F.lane); continue; } r -= I_DN;
        if (r < I_DN) { p0_transpose_item<PH_P8, true>(GIN(a, 18), DFF, D, (GAS h16*)(F.ws + WS_WD2), nullptr, scr, r, F.lane); continue; } r -= I_DN;
        if (r < I_IN) { p0_transpose_item<PH_IN>(GIN(a, 8), D, INW, (GAS h16*)(F.ws + WS_WIN), nullptr, scr, r, F.lane); continue; } r -= I_IN;
        {
            const int kb = r / (D / 32); const GAS float* ks = (kb < 8) ? GIN(a, 13) : (GIN(a, 14) - 512);
            p0_transpose_item<PH_P8>(GIN(a, 15), D, D, (GAS h16*)(F.ws + WS_WOUT), ks, scr, r, F.lane); }
    }
    {
        const int i = F.lane & 31;
        const float inv = (float)exp(-(double)i / 32.0 * 9.210340371976184);
        const double qoff = (F.lane < 32) ? 1.5707963267948966 : 0.0;
        for (int pos = gw; pos < S; pos += NGW) {
            const float ang = (float)pos * inv;
            const double da = (double)ang;
            const double q = __builtin_rint(da * 0.15915494309189535);
            const double r = __builtin_fma(-q, 6.283185307179586, da) + qoff;
            ((GAS float*)(F.ws + WS_ROPE))[(size_t)pos * 64 + F.lane] = sinf((float)r);
        }
    }
    for (int e = gw * 64 + F.lane; e < NH * GC * GC; e += NGW * 64) { const int t = (e >> 7) & 127, s = e & 127; ((GAS h16*)(F.ws + WS_WS16))[e] = (s <= t) ? (h16)GIN(a, 11)[e] : (h16)0.f; }
}

__device__ __forceinline__ void p1_prep(const Frame& F0, const Args& a) {
    Frame F = F0; F.tid = threadIdx.x; F.lane = F.tid & 63; F.wave = __builtin_amdgcn_readfirstlane(F.tid >> 6);
    LAS float* modl = (LAS float*)F.lds;
    const GAS float* modp = (const GAS float*)(F.ws + WS_MODP); const GAS float* b_ada = GIN(a, 3);
    const size_t st = (size_t)4 * NMOD * D;
    const GAS float* x = GIN(a, 0); const GAS float* g1 = GIN(a, 4);
    GAS h16* XG = (GAS h16*)(F.ws + WS_HG);
    int chunk = F.vcu; const int cb = chunk / (S / 128);
    f32x4 v[2][4][2][2];
    auto xload = [&](int buf, int rb) {
#pragma unroll
        for (int r4 = 0; r4 < 4; ++r4) { const GAS float* xr = x + (size_t)(chunk * 128 + F.wave * 16 + rb + r4) * D + 8 * F.lane;
#pragma unroll
            for (int j = 0; j < 2; ++j) { v[buf][r4][j][0] = *(const GAS f32x4*)(xr + 512 * j); v[buf][r4][j][1] = *(const GAS f32x4*)(xr + 512 * j + 4); } }
    };
    if (chunk < M / 128) xload(0, 0);
    float gl[16]; const int ge = F.vcu * 512 + F.tid; const bool gok = ge < 3 * 4 * D;
    if (gok) { const int j = ge / (4 * D), bb = (ge / D) % 4, k = ge % D; const size_t og = (size_t)bb * (NMOD * D) + (3 * j + 2) * D + k, os = og - D, oh = og - 2 * D;
        const GAS float* g = j == 0 ? g1 : j == 1 ? GIN(a, 7) : GIN(a, 16);
#pragma unroll
        for (int q = 0; q < 4; ++q) { gl[q] = modp[og + q * st]; gl[5 + q] = modp[os + q * st]; gl[10 + q] = modp[oh + q * st]; }
        gl[4] = b_ada[(3 * j + 2) * D + k]; gl[9] = b_ada[(3 * j + 1) * D + k]; gl[14] = b_ada[(3 * j) * D + k]; gl[15] = g[k]; }
    asm volatile("" ::: "memory");
#pragma unroll
    for (int t0 = 0; t0 < 7; t0 += 4) {
        f32x4 r[4][5]; int dst[4];
#pragma unroll
        for (int t = 0; t < 4; ++t) if (t0 + t < 7) {
            int i = F.tid + 512 * (t0 + t); const bool ok = i < 3328; i = ok ? i : 0;
            int bb, sl, mi; const int k = (i & 255) * 4;
            if (i < 2048) { bb = i >> 9; sl = (i >> 8) & 1; mi = 3 * sl; } else if (i < 2304) { bb = cb; sl = 3; mi = 1; } else { bb = (i - 2304) >> 8; sl = 4; mi = 4; }
            const size_t o = (size_t)bb * (NMOD * D) + mi * D + k;
#pragma unroll
            for (int q = 0; q < 4; ++q) r[t][q] = *(const GAS f32x4*)(modp + o + q * st);
            r[t][4] = *(const GAS f32x4*)(b_ada + mi * D + k);
            dst[t] = ok ? ((bb * 6 + sl) * D + k) : -1;
        }
#pragma unroll
        for (int t = 0; t < 4; ++t) if (t0 + t < 7) { if (dst[t] >= 0) *(LAS f32x4*)(modl + dst[t]) = ((r[t][0] + r[t][1]) + (r[t][2] + r[t][3])) + r[t][4]; }
    }
    if (gok) { ((GAS float*)(F.ws + WS_GT))[ge] = ((gl[0] + gl[1]) + (gl[2] + gl[3])) + gl[4];
        ((GAS float*)(F.ws + WS_GP))[ge] = gl[15] * (1.f + (((gl[5] + gl[6]) + (gl[7] + gl[8])) + gl[9]));
        ((GAS float*)(F.ws + WS_SH))[ge] = ((gl[10] + gl[11]) + (gl[12] + gl[13])) + gl[14]; }
    for (int e = ge + F.G * 512; e < 3 * 4 * D; e += F.G * 512) {
        GAS float* GT = (GAS float*)(F.ws + WS_GT); GAS float* GP = (GAS float*)(F.ws + WS_GP);
        const int j = e / (4 * D), bb = (e / D) % 4, k = e % D;
        const size_t og = (size_t)bb * (NMOD * D) + (3 * j + 2) * D + k, os = og - D;
        const GAS float* g = j == 0 ? g1 : j == 1 ? GIN(a, 7) : GIN(a, 16);
        const float gt = ((modp[og] + modp[og + st]) + (modp[og + 2 * st] + modp[og + 3 * st])) + b_ada[(3 * j + 2) * D + k];
        const float sc = ((modp[os] + modp[os + st]) + (modp[os + 2 * st] + modp[os + 3 * st])) + b_ada[(3 * j + 1) * D + k];
        const size_t oh = og - 2 * D;
        const float sh = ((modp[oh] + modp[oh + st]) + (modp[oh + 2 * st] + modp[oh + 3 * st])) + b_ada[(3 * j) * D + k];
        const float gg = g[k];
        GT[e] = gt; GP[e] = gg * (1.f + sc); ((GAS float*)(F.ws + WS_SH))[e] = sh;
    }
    __syncthreads();
    for (bool first = true; chunk < M / 128; chunk += F.G, first = false) {
        const int cbb = chunk / (S / 128);
        if (!first) {
            __syncthreads();
            for (int i = F.tid; i < D; i += NWAVES * 64) { const size_t o = (size_t)cbb * (NMOD * D) + D + i; modl[(cb * 6 + 3) * D + i] = ((modp[o] + modp[o + st]) + (modp[o + 2 * st] + modp[o + 3 * st])) + b_ada[D + i]; }
            __syncthreads();
            xload(0, 0);
        }
        f32x4 scl[2][2], shv[2][2];
#pragma unroll
        for (int j = 0; j < 2; ++j)
#pragma unroll
            for (int h = 0; h < 2; ++h) { const int k = 8 * F.lane + 512 * j + 4 * h; const f32x4 gg = *(const GAS f32x4*)(g1 + k); const LAS float* sc = modl + (cb * 6 + 3) * D + k;
                scl[j][h] = gg * ((f32x4){1.f + sc[0], 1.f + sc[1], 1.f + sc[2], 1.f + sc[3]}); shv[j][h] = *(const LAS f32x4*)(modl + (cbb * 6 + 0) * D + k); }
#pragma unroll
        for (int ib = 0; ib < 4; ++ib) {
            const int cur = ib & 1, rb = ib * 4;
            if (ib < 3) xload(cur ^ 1, rb + 4);
            asm volatile("" ::: "memory");
            float q[4];
#pragma unroll
            for (int r4 = 0; r4 < 4; ++r4) { float t = 0.f;
#pragma unroll
                for (int j = 0; j < 2; ++j)
#pragma unroll
                    for (int h = 0; h < 2; ++h) { const f32x4 w = v[cur][r4][j][h]; t += (w[0] * w[0] + w[1] * w[1]) + (w[2] * w[2] + w[3] * w[3]); }
                q[r4] = t; }
#pragma unroll
            for (int o = 1; o < 64; o <<= 1)
#pragma unroll
                for (int r4 = 0; r4 < 4; ++r4) q[r4] += __shfl_xor(q[r4], o);
#pragma unroll
            for (int r4 = 0; r4 < 4; ++r4) {
                const int row = chunk * 128 + F.wave * 16 + rb + r4;
                const float rs = rsqrtf(q[r4] * (1.f / D) + EPS);
#pragma unroll
                for (int j = 0; j < 2; ++j) { const int k = 8 * F.lane + 512 * j; u32x4 w;
#pragma unroll
                    for (int h = 0; h < 2; ++h) { const f32x4 o = v[cur][r4][j][h] * (scl[j][h] * rs) + shv[j][h]; w[2 * h] = pkh8(o[0], o[1]); w[2 * h + 1] = pkh8(o[2], o[3]); }
                    *(GAS u32x4*)(XG + blk_off(row, k, D / 64)) = w; }
            }
            asm volatile("" ::: "memory");
        }
    }
    const int gw = F.vcu * NWAVES + F.wave, NGW = F.G * NWAVES;
    constexpr int NBR = NGU + INW + NGU;
    constexpr int NB2 = NGU + INW;
    for (int it0 = NGU + gw; it0 < NB2; it0 += 4 * NGW) {
        h16x8 w0[4], w1[4];
#pragma unroll
        for (int t = 0; t < 4; ++t) {
            const int it = it0 + t * NGW; int n = it < NB2 ? it : gw; const GAS h16* W;
            if (n < NGU) W = (const GAS h16*)(F.ws + WS_WGU1); else if (n < NGU + INW) { n -= NGU; W = (const GAS h16*)(F.ws + WS_WIN); } else { n -= NGU + INW; W = (const GAS h16*)(F.ws + WS_WGU2); }
            w0[t] = *(const GAS h16x8*)(W + blk_off(n, 16 * F.lane, D / 64)); w1[t] = *(const GAS h16x8*)(W + blk_off(n, 16 * F.lane + 8, D / 64));
        }
        asm volatile("" ::: "memory");
#pragma unroll
        for (int t = 0; t < 4; ++t) {
            const int it = it0 + t * NGW;
            if (it < NB2) {
                int n = it, j; GAS float* B; int NN;
                if (n < NGU) { j = 0; B = (GAS float*)(F.ws + WS_BIAS1); NN = NGU; }
                else if (n < NGU + INW) { n -= NGU; j = 1; B = (GAS float*)(F.ws + WS_BIAS2); NN = INW; }
                else { n -= NGU + INW; j = 2; B = (GAS float*)(F.ws + WS_BIAS3); NN = NGU; }
                float s4[4];
#pragma unroll
                for (int bb = 0; bb < 4; ++bb) { const LAS float* sh = modl + (bb * 6 + j) * D + 16 * F.lane; float tt = 0.f;
#pragma unroll
                    for (int e = 0; e < 8; ++e) tt += sh[e] * (float)w0[t][e] + sh[8 + e] * (float)w1[t][e];
                    s4[bb] = tt; }
#pragma unroll
                for (int o = 1; o < 64; o <<= 1)
#pragma unroll
                    for (int bb = 0; bb < 4; ++bb) s4[bb] += __shfl_xor(s4[bb], o);
                if (F.lane == 0) { B[0 * NN + n] = s4[0]; B[1 * NN + n] = s4[1]; B[2 * NN + n] = s4[2]; B[3 * NN + n] = s4[3]; }
            }
        }
    }
    {   const GAS h16* WIN = (const GAS h16*)(F.ws + WS_WIN); GAS h16* WINB = (GAS h16*)(F.ws + WS_WINB); const GAS float* g2 = GIN(a, 7);
        for (int c8 = F.vcu * (NWAVES * 64) + F.tid; c8 < INW * D / 8; c8 += F.G * (NWAVES * 64)) {
            const int k0 = ((c8 >> 11) & 15) * 64 + (c8 & 7) * 8;
            const h16x8 w = *(const GAS h16x8*)(WIN + (size_t)c8 * 8);
            const f32x4 ga = *(const GAS f32x4*)(g2 + k0), gb = *(const GAS f32x4*)(g2 + k0 + 4);
            u32x4 o4[4];
#pragma unroll
            for (int bb = 0; bb < 4; ++bb) { const LAS float* sc = modl + (bb * 6 + 4) * D + k0;
                o4[bb][0] = pkh((float)w[0] * (ga[0] * (1.f + sc[0])), (float)w[1] * (ga[1] * (1.f + sc[1]))); o4[bb][1] = pkh((float)w[2] * (ga[2] * (1.f + sc[2])), (float)w[3] * (ga[3] * (1.f + sc[3])));
                o4[bb][2] = pkh((float)w[4] * (gb[0] * (1.f + sc[4])), (float)w[5] * (gb[1] * (1.f + sc[5]))); o4[bb][3] = pkh((float)w[6] * (gb[2] * (1.f + sc[6])), (float)w[7] * (gb[3] * (1.f + sc[7]))); }
#pragma unroll
            for (int bb = 0; bb < 4; ++bb) *(GAS u32x4*)(WINB + (size_t)bb * INW * D + (size_t)c8 * 8) = o4[bb];
        }
    }
    __syncthreads();
}

__device__ __forceinline__ void p_final(const Frame& F0, const Args& a) {
    Frame F = F0; F.tid = threadIdx.x; F.lane = F.tid & 63; F.wave = __builtin_amdgcn_readfirstlane(F.tid >> 6);
    const GAS h16* H = (const GAS h16*)(F.ws + WS_H); const GAS float* ssq = (const GAS float*)(F.ws + WS_SSQF); const GAS float* gf = GIN(a, 19);
    const int gw = F.vcu * NWAVES + F.wave, NGW = F.G * NWAVES;
    f32x4 g[2][2];
#pragma unroll
    for (int j = 0; j < 2; ++j)
#pragma unroll
        for (int h = 0; h < 2; ++h) g[j][h] = *(const GAS f32x4*)(gf + 8 * F.lane + 512 * j + 4 * h);
    for (int row = gw; row < M; row += NGW) {
        const float rs = rs16p(ssq + row);
#pragma unroll
        for (int j = 0; j < 2; ++j) { const h16x8 hv = *(const GAS h16x8*)(H + (size_t)row * D + 8 * F.lane + 512 * j);
            f32x4 o0 = (f32x4){(float)hv[0], (float)hv[1], (float)hv[2], (float)hv[3]} * rs * g[j][0], o1 = (f32x4){(float)hv[4], (float)hv[5], (float)hv[6], (float)hv[7]} * rs * g[j][1];
            *(GAS f32x4*)(a.out + (size_t)row * D + 8 * F.lane + 512 * j) = o0; *(GAS f32x4*)(a.out + (size_t)row * D + 8 * F.lane + 512 * j + 4) = o1; }
    }
}


typedef float f32x16 __attribute__((ext_vector_type(16)));
typedef short v4i16_t __attribute__((ext_vector_type(4)));
__device__ __forceinline__ h16x4 tr16(const LAS unsigned char* p) { return __builtin_bit_cast(h16x4, __builtin_amdgcn_ds_read_tr16_b64_v4i16((LAS v4i16_t*)p)); }
__device__ __forceinline__ int vt_off(int t, int c8) { return t * 128 + (((c8 >> 2) ^ ((t >> 1) & 1)) << 6) + ((c8 & 3) << 4); }

__device__ __forceinline__ void gmlp_phase(const Frame& F0, const Args& a, int shadow) {
    const int tid = threadIdx.x, lane = tid & 63, wave = __builtin_amdgcn_readfirstlane(tid >> 6), r32 = lane & 31, hi = lane >> 5;
    GAS h16* proj = (GAS h16*)(F0.ws + WS_PROJ); const GAS h16* W16 = (const GAS h16*)(F0.ws + WS_WS16); GAS float* RG = (GAS float*)(F0.ws + WS_RG);
    const GAS float* ln_g = GIN(a, 9); const GAS float* ln_b = GIN(a, 10); const GAS float* b_s = GIN(a, 12);
    LAS unsigned char* lds = F0.lds;
    LAS float* rowsq = (LAS float*)(lds + MISC_OFF + 128);
    LAS unsigned char* gstg = lds + MISC_OFF + 128 + 4096 + wave * 2048;
    f32x4 g0 = *(const GAS f32x4*)(ln_g + 8 * lane), g1 = *(const GAS f32x4*)(ln_g + 8 * lane + 4), b0 = *(const GAS f32x4*)(ln_b + 8 * lane), b1 = *(const GAS f32x4*)(ln_b + 8 * lane + 4);
    LAS float* bsl = (LAS float*)(lds + MISC_OFF + 128 + 4096 + 16384);
    bsl[tid] = b_s[tid]; bsl[tid + 512] = b_s[tid + 512];
    for (int unit = F0.vcu; unit < M / GC; unit += F0.G) {
        const size_t row0 = (size_t)unit * GC;
        h16x8 uv[4][2][2];
        h16x8 af[20];
        {
            h16x8 hv[16]; float sm[16], mu[16], rsd[16];
#pragma unroll
            for (int rr = 0; rr < 16; ++rr) hv[rr] = *(const GAS h16x8*)(proj + OFF_GV + (row0 + wave * 16 + rr) * 512 + 8 * lane);
#pragma unroll
            for (int tb = 0; tb < 2; ++tb)
#pragma unroll
                for (int d0 = 0; d0 < 2; ++d0)
#pragma unroll
                    for (int i = 0; i < 2; ++i) uv[tb][d0][i] = *(const GAS h16x8*)(proj + OFF_UB + hb_off(row0 + 32 * tb + (lane >> 2) + 16 * i, wave, 32 * d0 + (lane & 3) * 8));
            asm volatile("" ::: "memory");
#pragma unroll
            for (int rr = 0; rr < 16; ++rr) { float t = 0.f;
#pragma unroll
                for (int e = 0; e < 8; ++e) t += (float)hv[rr][e];
                sm[rr] = t; }
#pragma unroll
            for (int o = 1; o < 64; o <<= 1)
#pragma unroll
                for (int rr = 0; rr < 16; ++rr) sm[rr] += __shfl_xor(sm[rr], o);
#pragma unroll
            for (int rr = 0; rr < 16; ++rr) { mu[rr] = sm[rr] * (1.f / 512.f); float q = 0.f;
#pragma unroll
                for (int e = 0; e < 8; ++e) { const float d = (float)hv[rr][e] - mu[rr]; q += d * d; }
                sm[rr] = q; }
#pragma unroll
            for (int o = 1; o < 64; o <<= 1)
#pragma unroll
                for (int rr = 0; rr < 16; ++rr) sm[rr] += __shfl_xor(sm[rr], o);
#pragma unroll
            for (int rr = 0; rr < 16; ++rr) { rsd[rr] = rsqrtf(sm[rr] * (1.f / 512.f) + EPS);
                const int t = wave * 16 + rr; float v[8];
#pragma unroll
                for (int e = 0; e < 8; ++e) v[e] = ((float)hv[rr][e] - mu[rr]) * rsd[rr];
                u32x4 w; w[0] = pkh(v[0] * g0[0] + b0[0], v[1] * g0[1] + b0[1]); w[1] = pkh(v[2] * g0[2] + b0[2], v[3] * g0[3] + b0[3]);
                w[2] = pkh(v[4] * g1[0] + b1[0], v[5] * g1[1] + b1[1]); w[3] = pkh(v[6] * g1[2] + b1[2], v[7] * g1[3] + b1[3]);
                *(LAS u32x4*)(lds + (lane >> 3) * 16384 + vt_off(t, lane & 7)) = w; }
        }
        int ll = lane; asm volatile("" : "+v"(ll));
        const GAS h16* Wh = W16 + (size_t)wave * GC * GC + (size_t)(ll & 31) * GC + 8 * (ll >> 5);
#pragma unroll
        for (int tb = 0; tb < 4; ++tb)
#pragma unroll
            for (int ks = 0; ks < 2 * tb + 2; ++ks) af[tb * (tb + 1) + ks] = *(const GAS h16x8*)(Wh + (size_t)(32 * tb) * GC + 16 * ks);
        const GAS h16* up2 = proj + OFF_UB + hb_off(row0 + (ll >> 2), wave, (ll & 3) * 8);
#pragma unroll
        for (int tb = 2; tb < 4; ++tb)
#pragma unroll
            for (int d0 = 0; d0 < 2; ++d0)
#pragma unroll
                for (int i = 0; i < 2; ++i) uv[tb][d0][i] = *(const GAS h16x8*)(up2 + (size_t)(32 * tb + 16 * i) * 64 + 32 * d0);
        asm volatile("" ::: "memory");
        __syncthreads();
        const LAS unsigned char* vt = lds + wave * 16384;
        const int q4 = (lane & 15) >> 2, p4 = lane & 3, g1b = (lane >> 4) & 1;
#pragma unroll
        for (int tb = 0; tb < 4; ++tb) {
            f32x16 acc[2];
#pragma unroll
            for (int d0 = 0; d0 < 2; ++d0)
#pragma unroll
                for (int e = 0; e < 16; ++e) acc[d0][e] = 0.f;
#pragma unroll
            for (int ks = 0; ks < 8; ++ks) {
                if (ks <= 2 * tb + 1) {
#pragma unroll
                    for (int d0 = 0; d0 < 2; ++d0) {
                        const int srow = 16 * ks + 8 * hi + q4, c8 = 4 * d0 + 2 * g1b + (p4 >> 1);
                        const h16x4 lo = tr16(vt + vt_off(srow, c8) + (p4 & 1) * 8), hi4 = tr16(vt + vt_off(srow + 4, c8) + (p4 & 1) * 8);
                        const h16x8 bf = (h16x8){lo[0], lo[1], lo[2], lo[3], hi4[0], hi4[1], hi4[2], hi4[3]};
                        acc[d0] = __builtin_amdgcn_mfma_f32_32x32x16_f16(af[tb * (tb + 1) + ks], bf, acc[d0], 0, 0, 0);
                    }
                }
            }
            float bsv[16];
#pragma unroll
            for (int e = 0; e < 16; ++e) bsv[e] = bsl[wave * GC + 32 * tb + (e & 3) + 8 * (e >> 2) + 4 * hi];
            float rq[2] = {0.f, 0.f};
#pragma unroll
            for (int d0 = 0; d0 < 2; ++d0) {
#pragma unroll
                for (int e = 0; e < 16; ++e) *(LAS h16*)(gstg + ((e & 3) + 8 * (e >> 2) + 4 * hi) * 64 + r32 * 2) = (h16)(acc[d0][e] + bsv[e]);
                LDS_WAIT();
#pragma unroll
                for (int i = 0; i < 2; ++i) { const int rw = (lane >> 2) + 16 * i; const h16x8 mx = *(const LAS h16x8*)(gstg + rw * 64 + (lane & 3) * 16);
                    float o[8]; float q = 0.f;
#pragma unroll
                    for (int e = 0; e < 8; ++e) { o[e] = (float)uv[tb][d0][i][e] * (float)mx[e]; q += o[e] * o[e]; }
                    u32x4 w; w[0] = pkh(o[0], o[1]); w[1] = pkh(o[2], o[3]); w[2] = pkh(o[4], o[5]); w[3] = pkh(o[6], o[7]);
                    if (shadow) *(GAS u32x4*)((GAS h16*)(F0.ws + WS_HG) + (row0 + 32 * tb + rw) * 512 + wave * 64 + 32 * d0 + (lane & 3) * 8) = w;
                    else *(GAS u32x4*)(proj + ab_off(row0 + 32 * tb + rw, 8 + wave, 32 * d0 + (lane & 3) * 8)) = w;
                    q += __shfl_xor(q, 1); q += __shfl_xor(q, 2); rq[i] += q; }
                LDS_WAIT();
            }
            if ((lane & 3) == 0) { rowsq[wave * 128 + 32 * tb + (lane >> 2)] = rq[0]; rowsq[wave * 128 + 32 * tb + (lane >> 2) + 16] = rq[1]; }
        }
        __syncthreads();
        if (tid < 128) { float s8 = 0.f;
#pragma unroll
            for (int w = 0; w < 8; ++w) s8 += rowsq[w * 128 + tid];
            if (shadow) ((GAS float*)(F0.ws + WS_HG + (48u << 20)))[row0 + tid] = s8; else RG[row0 + tid] = s8; }
        __syncthreads();
    }
}


constexpr size_t DO_PO = 0, DO_PML = 96 * MiB;
constexpr int CW_CNT = 8192;
constexpr int LISTCAP = 8192;
constexpr int AL_K = 0, AL_V = 32768, AL_STG = 65536, AL_WSF = 98304, AL_START = 102400;
constexpr int TAB_OFF_B = 131072 + 320 + 128 + 64;
__device__ __forceinline__ int k_off(int key, int c8) { return key * 128 + ((c8 ^ (key & 7)) << 4); }

__device__ __forceinline__ void moba_gate_phase(const Frame& F0, int shadow) {
    const int tid = threadIdx.x, lane = tid & 63, wave = __builtin_amdgcn_readfirstlane(tid >> 6), r32 = lane & 31, hi = lane >> 5;
    const GAS h16* proj = (const GAS h16*)(F0.ws + WS_PROJ); const GAS float* kmp = (const GAS float*)(F0.ws + WS_KMP);
    unsigned* cnt = F0.ctl + CW_CNT + (shadow ? 1024 : 0); GAS unsigned short* lists = (GAS unsigned short*)(F0.ws + (shadow ? WS_HG : WS_LISTS));
    LAS unsigned char* kmh = F0.lds; LAS unsigned char* kml = F0.lds + 4096;
    constexpr int NIT = NB * NH * (S / 512);
    for (int item = F0.vcu, rnd = 0; item < NIT; item += F0.G, ++rnd) {
        const int sp0 = item % (S / 512), span = (rnd & 1) ? (S / 512 - 1 - sp0) : sp0, bh = item / (S / 512), b = bh >> 3, h = bh & 7;
        float kr[8]; h16x8 qf[2][4];
#pragma unroll
        for (int i = 0; i < 4; ++i) { const int e_ = tid + i * NWAVES * 64, n_ = e_ >> 6, d_ = e_ & 63; const GAS float* kp = kmp + (size_t)((b * NBLK + n_) * 2) * 512 + h * 64 + d_; kr[2 * i] = kp[0]; kr[2 * i + 1] = kp[512]; }
#pragma unroll
        for (int g = 0; g < 2; ++g) { const GAS h16* qp = proj + ab_off((size_t)(b * S + span * 512 + wave * 64 + g * 32 + r32), h, 8 * hi);
#pragma unroll
            for (int ks = 0; ks < 4; ++ks) qf[g][ks] = *(const GAS h16x8*)(qp + 16 * ks); }
        RAW_BAR();
#pragma unroll
        for (int i = 0; i < 4; ++i) { const int e_ = tid + i * NWAVES * 64, n_ = e_ >> 6, d_ = e_ & 63; const float v = kr[2 * i] + kr[2 * i + 1]; const h16 vh = (h16)v; const h16 vl = (h16)(v - (float)vh);
            const int off = k_off(n_, d_ >> 3) + (d_ & 7) * 2; *(LAS h16*)(kmh + off) = vh; *(LAS h16*)(kml + off) = vl; }
        RAW_BAR();
        const int sq = span * 512 + tid, own = __builtin_amdgcn_readfirstlane(sq >> 8);
        h16x8 kfh[4], kfl[4];
#pragma unroll
        for (int ks = 0; ks < 4; ++ks) { const int off = k_off(r32, 2 * ks + hi); kfh[ks] = *(const LAS h16x8*)(kmh + off); kfl[ks] = *(const LAS h16x8*)(kml + off); }
        float v0 = -3e38f, v1 = -3e38f, v2 = -3e38f; int i0 = -1, i1 = -1, i2 = -1;
#pragma unroll
        for (int g = 0; g < 2; ++g) {
            f32x16 acc;
#pragma unroll
            for (int e = 0; e < 16; ++e) acc[e] = 0.f;
#pragma unroll
            for (int ks = 0; ks < 4; ++ks) { acc = __builtin_amdgcn_mfma_f32_32x32x16_f16(kfh[ks], qf[g][ks], acc, 0, 0, 0); acc = __builtin_amdgcn_mfma_f32_32x32x16_f16(kfl[ks], qf[g][ks], acc, 0, 0, 0); }
            float a0 = -3e38f, a1 = -3e38f, a2 = -3e38f; int j0 = -1, j1 = -1, j2 = -1;
#pragma unroll
            for (int e = 0; e < 16; ++e) { const int n = (e & 3) + 8 * (e >> 2) + 4 * hi; const float gsc = acc[e];
                if (n < own) {
                    if (gsc > a0) { a2 = a1; j2 = j1; a1 = a0; j1 = j0; a0 = gsc; j0 = n; }
                    else if (gsc > a1) { a2 = a1; j2 = j1; a1 = gsc; j1 = n; }
                    else if (gsc > a2) { a2 = gsc; j2 = n; } } }
            const float b0 = __shfl_xor(a0, 32), b1 = __shfl_xor(a1, 32), b2 = __shfl_xor(a2, 32); const int k0 = __shfl_xor(j0, 32), k1 = __shfl_xor(j1, 32), k2 = __shfl_xor(j2, 32);
            float m0, m1, m2; int n0, n1, n2;
            {   float xa[3] = {a0, a1, a2}, xb[3] = {b0, b1, b2}; int ia[3] = {j0, j1, j2}, ib[3] = {k0, k1, k2};
                float mv[3]; int mn[3]; int pa = 0, pb = 0;
#pragma unroll
                for (int t = 0; t < 3; ++t) {
                    const float va = pa == 0 ? xa[0] : pa == 1 ? xa[1] : xa[2], vb = pb == 0 ? xb[0] : pb == 1 ? xb[1] : xb[2];
                    const int na = pa == 0 ? ia[0] : pa == 1 ? ia[1] : ia[2], nb = pb == 0 ? ib[0] : pb == 1 ? ib[1] : ib[2];
                    const bool ta = (na >= 0) && ((nb < 0) || (va > vb) || (va == vb && na < nb));
                    mv[t] = ta ? va : vb; mn[t] = ta ? na : nb; pa += ta ? 1 : 0; pb += ta ? 0 : 1;
                }
                m0 = mv[0]; m1 = mv[1]; m2 = mv[2]; n0 = mn[0]; n1 = mn[1]; n2 = mn[2]; }
            if (hi == g) { v0 = m0; v1 = m1; v2 = m2; i0 = n0; i1 = n1; i2 = n2; }
        }
        (void)v0; (void)v1; (void)v2;
        int mycnt = 0, pos0 = 0, pos1 = 0, pos2 = 0;
        const unsigned long long ltmask = (1ull << lane) - 1ull;
        for (int n = 0; n < own; ++n) {
            const bool sel = (i0 == n) || (i1 == n) || (i2 == n);
            const unsigned long long mask = __ballot(sel);
            const int before = __popcll(mask & ltmask);
            if (lane == n) mycnt = __popcll(mask);
            if (i0 == n) pos0 = before; if (i1 == n) pos1 = before; if (i2 == n) pos2 = before;
        }
        unsigned base = 0u;
        if (lane < own && mycnt > 0) base = atomicAdd(cnt + bh * NBLK + lane, (unsigned)mycnt);
        const unsigned bb0 = (unsigned)__shfl((int)base, i0 & 63), bb1 = (unsigned)__shfl((int)base, i1 & 63), bb2 = (unsigned)__shfl((int)base, i2 & 63);
        if (i0 >= 0) lists[(size_t)(bh * NBLK + i0) * LISTCAP + bb0 + pos0] = (unsigned short)(sq | (0 << 13));
        if (i1 >= 0) lists[(size_t)(bh * NBLK + i1) * LISTCAP + bb1 + pos1] = (unsigned short)(sq | (1 << 13));
        if (i2 >= 0) lists[(size_t)(bh * NBLK + i2) * LISTCAP + bb2 + pos2] = (unsigned short)(sq | (2 << 13));
    }
    __syncthreads();
}

template <bool CAUSAL, bool QPRE = false>
__device__ __forceinline__ void attn_tile(const LAS unsigned char* ldsK, const LAS unsigned char* ldsV, const h16x8 (&qf)[4], int wave, int lane, f32x16 (&o)[2], float& m_out, float& l_out,
                                          const GAS h16* qnext = nullptr, bool do_pre = false, h16x8* qfn = nullptr) {
    const int r32 = lane & 31, hi = lane >> 5;
    int kbase[4];
#pragma unroll
    for (int ks = 0; ks < 4; ++ks) kbase[ks] = r32 * 128 + (((2 * ks + hi) ^ (r32 & 7)) << 4);
    f32x16 sacc[8];
#pragma unroll
    for (int kb = 0; kb < 8; ++kb) {
        f32x16 acc;
#pragma unroll
        for (int e = 0; e < 16; ++e) acc[e] = 0.f;
#pragma unroll
        for (int ks = 0; ks < 4; ++ks) { const h16x8 kf = *(const LAS h16x8*)(ldsK + kbase[ks] + kb * 4096); acc = __builtin_amdgcn_mfma_f32_32x32x16_f16(kf, qf[ks], acc, 0, 0, 0); }
        if (CAUSAL) {
            const int lim = 32 * (wave - kb) + r32;
#pragma unroll
            for (int e = 0; e < 16; ++e) { const int key = (e & 3) + 8 * (e >> 2) + 4 * hi; if (key > lim) acc[e] = -1e30f; }
        }
        sacc[kb] = acc;
    }
    if constexpr (QPRE) {
        asm volatile("" ::: "memory");
        if (do_pre) {
#pragma unroll
            for (int ks = 0; ks < 4; ++ks) qfn[ks] = *(const GAS h16x8*)(qnext + 16 * ks);
        }
        asm volatile("" ::: "memory");
    }
    float m = -3e38f;
#pragma unroll
    for (int kb = 0; kb < 8; ++kb)
#pragma unroll
        for (int e = 0; e < 16; ++e) m = fmaxf(m, sacc[kb][e]);
    m = fmaxf(m, __shfl_xor(m, 32));
    float ls = 0.f;
#pragma unroll
    for (int d0 = 0; d0 < 2; ++d0)
#pragma unroll
        for (int e = 0; e < 16; ++e) o[d0][e] = 0.f;
    const int q4 = (lane & 15) >> 2, p4 = lane & 3, g1b = (lane >> 4) & 1;
    int vbase[2];
#pragma unroll
    for (int d0 = 0; d0 < 2; ++d0) vbase[d0] = (4 * hi + q4) * 128 + ((d0 ^ ((q4 >> 1) & 1)) << 6) + ((2 * g1b + (p4 >> 1)) << 4) + (p4 & 1) * 8;
#pragma unroll
    for (int kb = 0; kb < 8; ++kb) {
#pragma unroll
        for (int e = 0; e < 16; ++e) { const float pv = __builtin_amdgcn_exp2f(sacc[kb][e] - m); sacc[kb][e] = pv; ls += pv; }
        if (!CAUSAL || kb <= wave) {
#pragma unroll
            for (int s2 = 0; s2 < 2; ++s2) {
                h16x8 pa;
#pragma unroll
                for (int j = 0; j < 8; ++j) pa[j] = (h16)sacc[kb][8 * s2 + j];
#pragma unroll
                for (int d0 = 0; d0 < 2; ++d0) {
                    const h16x4 lo = tr16(ldsV + vbase[d0] + kb * 4096 + s2 * 2048), hi4 = tr16(ldsV + vbase[d0] + kb * 4096 + s2 * 2048 + 1024);
                    const h16x8 bf = (h16x8){lo[0], lo[1], lo[2], lo[3], hi4[0], hi4[1], hi4[2], hi4[3]};
                    o[d0] = __builtin_amdgcn_mfma_f32_32x32x16_f16(pa, bf, o[d0], 0, 0, 0);
                }
            }
        }
    }
    ls += __shfl_xor(ls, 32);
    m_out = m; l_out = ls;
}
__device__ __forceinline__ void attn_tile_causal(const LAS unsigned char* ldsK, const LAS unsigned char* ldsV, const h16x8 (&qf)[4], int wave, int lane, f32x16 (&o)[2], float& m_out, float& l_out, LAS float* wsf) {
    const int r32 = lane & 31, hi = lane >> 5;
    int kbase[4];
#pragma unroll
    for (int ks = 0; ks < 4; ++ks) kbase[ks] = r32 * 128 + (((2 * ks + hi) ^ (r32 & 7)) << 4);
    const int q4 = (lane & 15) >> 2, p4 = lane & 3, g1b = (lane >> 4) & 1;
    int vbase[2];
#pragma unroll
    for (int d0 = 0; d0 < 2; ++d0) vbase[d0] = (4 * hi + q4) * 128 + ((d0 ^ ((q4 >> 1) & 1)) << 6) + ((2 * g1b + (p4 >> 1)) << 4) + (p4 & 1) * 8;
    float m = -3e38f, ls = 0.f;
#pragma unroll
    for (int d0 = 0; d0 < 2; ++d0)
#pragma unroll
        for (int e = 0; e < 16; ++e) o[d0][e] = 0.f;
    for (int kb = 0; kb <= wave; ++kb) {
        f32x16 acc;
#pragma unroll
        for (int e = 0; e < 16; ++e) acc[e] = 0.f;
#pragma unroll
        for (int ks = 0; ks < 4; ++ks) { const h16x8 kf = *(const LAS h16x8*)(ldsK + kbase[ks] + kb * 4096); acc = __builtin_amdgcn_mfma_f32_32x32x16_f16(kf, qf[ks], acc, 0, 0, 0); }
        const int lim = (kb == wave) ? r32 : 64;
        float bm = -3e38f;
#pragma unroll
        for (int e = 0; e < 16; ++e) { const int key = (e & 3) + 8 * (e >> 2) + 4 * hi; if (key <= lim) bm = fmaxf(bm, acc[e]); }
        bm = fmaxf(bm, __shfl_xor(bm, 32));
        const float mn = fmaxf(m, bm), alpha = __builtin_amdgcn_exp2f(m - mn);
        m = mn;
        if (hi == 0) wsf[96 + r32] = alpha;
        float bs = 0.f;
#pragma unroll
        for (int e = 0; e < 16; ++e) { const int key = (e & 3) + 8 * (e >> 2) + 4 * hi; const float pv = (key <= lim) ? __builtin_amdgcn_exp2f(acc[e] - m) : 0.f; acc[e] = pv; bs += pv; }
        ls = ls * alpha + bs;
        LDS_WAIT();
#pragma unroll
        for (int g = 0; g < 4; ++g) { const f32x4 a4 = *(const LAS f32x4*)(wsf + 96 + 8 * g + 4 * hi);
#pragma unroll
            for (int j = 0; j < 4; ++j) { o[0][4 * g + j] *= a4[j]; o[1][4 * g + j] *= a4[j]; } }
#pragma unroll
        for (int s2 = 0; s2 < 2; ++s2) {
            h16x8 pa;
#pragma unroll
            for (int j = 0; j < 8; ++j) pa[j] = (h16)acc[8 * s2 + j];
#pragma unroll
            for (int d0 = 0; d0 < 2; ++d0) {
                const h16x4 lo = tr16(ldsV + vbase[d0] + kb * 4096 + s2 * 2048), hi4 = tr16(ldsV + vbase[d0] + kb * 4096 + s2 * 2048 + 1024);
                const h16x8 bf = (h16x8){lo[0], lo[1], lo[2], lo[3], hi4[0], hi4[1], hi4[2], hi4[3]};
                o[d0] = __builtin_amdgcn_mfma_f32_32x32x16_f16(pa, bf, o[d0], 0, 0, 0);
            }
        }
    }
    ls += __shfl_xor(ls, 32);
    m_out = m; l_out = ls;
}
__device__ __forceinline__ void load_kv_block(LAS unsigned char* lds, const GAS h16* proj, size_t row0, int h, int tid) {
#pragma unroll
    for (int i = 0; i < 4; ++i) { const int idx = tid + 512 * i, key = idx >> 3, c8 = idx & 7; const size_t ro = hb_off(row0 + key, h, 8 * c8);
        const u32x4 kv = *(const GAS u32x4*)(proj + OFF_KB + ro), vv = *(const GAS u32x4*)(proj + OFF_VB + ro);
        *(LAS u32x4*)(lds + AL_K + k_off(key, c8)) = kv; *(LAS u32x4*)(lds + AL_V + vt_off(key, c8)) = vv; }
}
__device__ __forceinline__ void stage_o(LAS unsigned char* stg, LAS float* wsf, const f32x16 (&o)[2], float l, int lane) {
    const int r32 = lane & 31, hi = lane >> 5;
    if (hi == 0) wsf[r32] = 1.f / l;
    LDS_WAIT();
#pragma unroll
    for (int e = 0; e < 16; ++e) { const int qr = (e & 3) + 8 * (e >> 2) + 4 * hi; const float rl = wsf[qr];
        *(LAS h16*)(stg + qr * 128 + r32 * 2) = (h16)(o[0][e] * rl); *(LAS h16*)(stg + qr * 128 + 64 + r32 * 2) = (h16)(o[1][e] * rl); }
    LDS_WAIT();
}

struct KvRegs { u32x4 kv[4], vv[4]; };
__device__ __forceinline__ void kv_fetch(KvRegs& r, const GAS h16* proj, size_t row0, int h, int tid) {
#pragma unroll
    for (int i = 0; i < 4; ++i) { const int idx = tid + 512 * i, key = idx >> 3, c8 = idx & 7; const size_t ro = hb_off(row0 + key, h, 8 * c8);
        r.kv[i] = *(const GAS u32x4*)(proj + OFF_KB + ro); r.vv[i] = *(const GAS u32x4*)(proj + OFF_VB + ro); }
}
__device__ __forceinline__ void kv_commit(const KvRegs& r, LAS unsigned char* lds, int tid) {
#pragma unroll
    for (int i = 0; i < 4; ++i) { const int idx = tid + 512 * i, key = idx >> 3, c8 = idx & 7;
        *(LAS u32x4*)(lds + AL_K + k_off(key, c8)) = r.kv[i]; *(LAS u32x4*)(lds + AL_V + vt_off(key, c8)) = r.vv[i]; }
}
__device__ __forceinline__ void kv_dma(LAS unsigned char* ldsK, LAS unsigned char* ldsV, const GAS h16* proj, size_t row0, int h, int wave, int lane) {
#pragma unroll
    for (int i = 0; i < 4; ++i) {
        const int blk = wave + 8 * i, kk = lane >> 3, pos = lane & 7;
        const GAS h16* rp = proj + hb_off(row0 + blk * 8 + kk, h, 0);
        const int ck = pos ^ kk, cv = (((pos >> 2) ^ ((kk >> 1) & 1)) << 2) | (pos & 3);
        const GAS h16* gk = rp + OFF_KB + 8 * ck; const GAS h16* gv = rp + OFF_VB + 8 * cv;
        const unsigned mk = (unsigned)(size_t)(ldsK + blk * 1024), mv = (unsigned)(size_t)(ldsV + blk * 1024);
        asm volatile("s_mov_b32 m0, %1\n\ts_nop 0\n\tglobal_load_lds_dwordx4 %0, off" :: "v"(gk), "s"(mk) : "memory", "m0");
        asm volatile("s_mov_b32 m0, %1\n\ts_nop 0\n\tglobal_load_lds_dwordx4 %0, off" :: "v"(gv), "s"(mv) : "memory", "m0");
    }
}
constexpr int BL_WSF = TAB_OFF_B, BL_ITAB = TAB_OFF_B + 4096, BL_STG = TAB_OFF_B + 4096 + 1024, BL_START = BL_STG;
__device__ __forceinline__ void moba_b_phase(const Frame& F0, GAS float* dout) {
    const int tid = threadIdx.x, lane = tid & 63, wave = __builtin_amdgcn_readfirstlane(tid >> 6), r32 = lane & 31, hi = lane >> 5;
    const GAS h16* proj = (const GAS h16*)(F0.ws + WS_PROJ); const unsigned* cnt = F0.ctl + CW_CNT; const GAS unsigned short* lists = (const GAS unsigned short*)(F0.ws + WS_LISTS);
    GAS h16* PO = (GAS h16*)((unsigned char*)dout + DO_PO); GAS float* PML = (GAS float*)((unsigned char*)dout + DO_PML);
    LAS unsigned char* lds = F0.lds;
    LAS int* start = (LAS int*)(lds + BL_START);
    LAS float* wsf = (LAS float*)(lds + BL_WSF + wave * 512); LAS int* wsi = (LAS int*)(lds + BL_WSF + wave * 512 + 256);
    LAS unsigned char* stg = lds + BL_STG + wave * 2048;
    {
        const unsigned c0 = cnt[2 * tid], c1 = cnt[2 * tid + 1];
        const int t0 = (int)((c0 + 511u) >> 9), t1 = (int)((c1 + 511u) >> 9);
        int v = t0 + t1, inc = v;
#pragma unroll
        for (int o = 1; o < 64; o <<= 1) { const int u = __shfl_up(inc, o); if (lane >= o) inc += u; }
        LAS int* wtot = (LAS int*)(lds + BL_WSF);
        __syncthreads();
        if (lane == 63) wtot[wave] = inc;
        __syncthreads();
        int pre = 0;
        for (int w = 0; w < wave; ++w) pre += wtot[w];
        const int ex = pre + inc - v;
        __syncthreads();
        start[2 * tid] = ex; start[2 * tid + 1] = ex + t0;
        if (tid == 511) start[1024] = ex + v;
        __syncthreads();
    }
    const int nitems = start[1024];
    LAS int* itab = (LAS int*)(lds + BL_ITAB);
    const int nfull = nitems / F0.G, nk = nfull + ((((F0.vcu + nfull) % F0.G) < (nitems % F0.G)) ? 1 : 0);
    if (tid < 64 && tid < nk) {
        const int item_ = tid * F0.G + (F0.vcu + tid) % F0.G; int lo_ = 0, hi__ = 1024;
        while (hi__ - lo_ > 1) { const int mid_ = (lo_ + hi__) >> 1; if (start[mid_] <= item_) lo_ = mid_; else hi__ = mid_; }
        const int ch_ = item_ - start[lo_];
        itab[4 * tid] = lo_; itab[4 * tid + 1] = ch_; itab[4 * tid + 2] = (int)cnt[lo_] - ch_ * 512;
    }
    __syncthreads();
#define MB_ITEM(k_, l_, chunk_, b_, h_, n_, nq_) do { l_ = __builtin_amdgcn_readfirstlane(itab[4 * (k_)]); chunk_ = __builtin_amdgcn_readfirstlane(itab[4 * (k_) + 1]); nq_ = __builtin_amdgcn_readfirstlane(itab[4 * (k_) + 2]); \
        n_ = l_ & 31; b_ = l_ >> 8; h_ = (l_ >> 5) & 7; } while (0)
#define MB_ENT(l_, chunk_, nq_, g_) lists[(size_t)(l_) * LISTCAP + (chunk_) * 512 + ((((g_) * 256 + wave * 32 + r32) < (nq_)) ? (g_) * 256 + wave * 32 + r32 : 0)]
#define MB_QPTR(b_, h_, e_) (proj + ab_off((size_t)((b_) * S + (int)((e_) & 8191)), (h_), 8 * hi))
    auto store_group = [&](const f32x16 (&o)[2], float m, float lsum, unsigned ent, int g, int b, int h, int nq) {
        int ln = lane; asm volatile("" : "+v"(ln));
        const bool valid = (g * 256 + wave * 32 + (ln & 31)) < nq;
        const int sq = ent & 8191, rank = ent >> 13;
        const int slot = ((b * NH + h) * 3 + rank) * S + sq;
        if ((ln >> 5) == 0) { wsi[ln & 31] = valid ? slot : -1; wsf[ln & 31] = 1.f / lsum; if (valid) { PML[(size_t)slot * 2] = m; PML[(size_t)slot * 2 + 1] = lsum; } }
        LDS_WAIT();
#pragma unroll
        for (int ps = 0; ps < 2; ++ps) {
#pragma unroll
            for (int e = 8 * ps; e < 8 * ps + 8; ++e) { const int qr = (e & 3) + 8 * (e >> 2) + 4 * (ln >> 5); const float rl = wsf[qr];
                *(LAS h16*)(stg + (qr - 16 * ps) * 128 + (ln & 31) * 2) = (h16)(o[0][e] * rl); *(LAS h16*)(stg + (qr - 16 * ps) * 128 + 64 + (ln & 31) * 2) = (h16)(o[1][e] * rl); }
            LDS_WAIT();
#pragma unroll
            for (int i = 0; i < 2; ++i) { const int row = i * 8 + (ln >> 3), ch = ln & 7; const int sl = wsi[16 * ps + row];
                if (sl >= 0) *(GAS u32x4*)(PO + (size_t)sl * 64 + ch * 8) = *(const LAS u32x4*)(stg + row * 128 + ch * 16); }
            LDS_WAIT();
        }
    };
    if (nk > 0 && nk <= 64) {
        int l, chunk, b, h, n, nq, par = 0;
        MB_ITEM(0, l, chunk, b, h, n, nq);
        kv_dma(lds, lds + 32768, proj, (size_t)b * S + (size_t)n * MBLK, h, wave, lane);
        unsigned e00 = MB_ENT(l, chunk, nq, 0), e01 = MB_ENT(l, chunk, nq, 1), e10 = 0, e11 = 0;
        if (nk > 1) { int l1, c1, b1, h1, n1, q1; MB_ITEM(1, l1, c1, b1, h1, n1, q1); e10 = MB_ENT(l1, c1, q1, 0); e11 = MB_ENT(l1, c1, q1, 1); }
        h16x8 qf[4];
        { const GAS h16* qp = MB_QPTR(b, h, e00);
#pragma unroll
          for (int ks = 0; ks < 4; ++ks) qf[ks] = *(const GAS h16x8*)(qp + 16 * ks); }
        VM_WAIT_KNOWN();
        for (int k = 0;; ++k) {
            LAS unsigned char* kb_ = lds + par * 65536;
            RAW_BAR();
            const bool has = k + 1 < nk;
            MB_ITEM(k, l, chunk, b, h, n, nq);
            const bool two = nq > 256;
            int l1 = l, c1 = chunk, b1 = b, h1 = h, n1 = n, q1 = nq; unsigned e20 = 0, e21 = 0;
            if (k + 2 < nk) { int l2, c2, b2, h2, n2, q2; MB_ITEM(k + 2, l2, c2, b2, h2, n2, q2); e20 = MB_ENT(l2, c2, q2, 0); e21 = MB_ENT(l2, c2, q2, 1); }
            asm volatile("" ::: "memory");
            if (has) {
                MB_ITEM(k + 1, l1, c1, b1, h1, n1, q1);
                int t2 = lane; asm volatile("" : "+v"(t2));
                kv_dma(lds + (par ^ 1) * 65536, lds + (par ^ 1) * 65536 + 32768, proj, (size_t)b1 * S + (size_t)n1 * MBLK, h1, wave, t2);
            }
            f32x16 o[2]; float m = 0.f, lsum = 1.f; h16x8 qfn[4];
            {
                const GAS h16* qnext = two ? MB_QPTR(b, h, e01) : MB_QPTR(b1, h1, e10);
                attn_tile<false, true>(kb_, kb_ + 32768, qf, wave, lane, o, m, lsum, qnext, two || has, qfn);
            }
            if (!two) VM_WAIT_KNOWN();
            store_group(o, m, lsum, e00, 0, b, h, nq);
#pragma unroll
            for (int ks = 0; ks < 4; ++ks) qf[ks] = qfn[ks];
            if (two) {
                const GAS h16* qnext = MB_QPTR(b1, h1, e10);
                attn_tile<false, true>(kb_, kb_ + 32768, qf, wave, lane, o, m, lsum, qnext, has, qfn);
                VM_WAIT_KNOWN();
                store_group(o, m, lsum, e01, 1, b, h, nq);
#pragma unroll
                for (int ks = 0; ks < 4; ++ks) qf[ks] = qfn[ks];
            }
            if (!has) break;
            e00 = e10; e01 = e11; e10 = e20; e11 = e21; par ^= 1;
        }
    }
#undef MB_ITEM
#undef MB_ENT
#undef MB_QPTR
    __syncthreads();
}

__device__ __forceinline__ void moba_c_phase(const Frame& F0, const GAS float* dout, int shadow) {
    const int tid = threadIdx.x, lane = tid & 63, wave = __builtin_amdgcn_readfirstlane(tid >> 6), r32 = lane & 31, hi = lane >> 5;
    const int qblk = (wave < 4) ? wave : 11 - wave;
    GAS h16* proj = (GAS h16*)(F0.ws + WS_PROJ); GAS float* SSQA = (GAS float*)(F0.ws + WS_SSQA);
    const GAS h16* PO = (const GAS h16*)((const unsigned char*)dout + DO_PO); const GAS float* PML = (const GAS float*)((const unsigned char*)dout + DO_PML);
    LAS unsigned char* lds = F0.lds;
    LAS float* wsf = (LAS float*)(lds + BL_WSF + wave * 512);
    typedef float f32x2_ __attribute__((ext_vector_type(2)));
    constexpr int NU = NB * NH * NBLK;
    int unit = F0.vcu, par = 0;
    if (unit < NU) {
        h16x8 qf[4];
        {   const int qb = unit & 31, bh = unit >> 5, b = bh >> 3, h = bh & 7; const size_t row0 = (size_t)b * S + (size_t)qb * MBLK;
            kv_dma(lds, lds + 32768, proj, row0, h, wave, lane);
            const GAS h16* qp = proj + ab_off(row0 + qblk * 32 + r32, h, 8 * hi);
#pragma unroll
            for (int ks = 0; ks < 4; ++ks) qf[ks] = *(const GAS h16x8*)(qp + 16 * ks); }
        VM_WAIT_KNOWN();
        for (;;) {
            LAS unsigned char* kb_ = lds + par * 65536;
            const int qb = unit & 31, bh = unit >> 5, b = bh >> 3, h = bh & 7;
            const size_t row0 = (size_t)b * S + (size_t)qb * MBLK;
            const int nsel = (shadow && MK_GPROBE == 2) ? 0 : (qb < 3 ? qb : 3);
            RAW_BAR();
            const int un = unit + F0.G; const bool has = un < NU;
            h16x8 qn[4];
            if (has) {
                const int qb2 = un & 31, bh2 = un >> 5, b2 = bh2 >> 3, h2 = bh2 & 7; const size_t row2 = (size_t)b2 * S + (size_t)qb2 * MBLK;
                int t2 = lane; asm volatile("" : "+v"(t2));
                kv_dma(lds + (par ^ 1) * 65536, lds + (par ^ 1) * 65536 + 32768, proj, row2, h2, wave, t2);
                const GAS h16* qp = proj + ab_off(row2 + qblk * 32 + (t2 & 31), h2, 8 * (t2 >> 5));
#pragma unroll
                for (int ks = 0; ks < 4; ++ks) qn[ks] = *(const GAS h16x8*)(qp + 16 * ks);
            }
            f32x2_ ml[4][3]; h16x8 pv[4][3];
            {   int t3 = lane; asm volatile("" : "+v"(t3));
#pragma unroll
                for (int i = 0; i < 4; ++i) { const size_t srow = (size_t)qb * MBLK + qblk * 32 + i * 8 + (t3 >> 3);
#pragma unroll
                    for (int r = 0; r < 3; ++r) { if (r < nsel) { const size_t sl = ((size_t)(b * NH + h) * 3 + r) * S + srow; ml[i][r] = *(const GAS f32x2_*)(PML + sl * 2); pv[i][r] = *(const GAS h16x8*)(PO + sl * 64 + (t3 & 7) * 8); } } } }
            asm volatile("" ::: "memory");
            f32x16 o[2]; float m, lsum;
            if (shadow && MK_GPROBE == 1) { for (int e9 = 0; e9 < 16; ++e9) { o[0][e9] = (float)qf[0][0]; o[1][e9] = (float)qf[1][1]; } m = 0.f; lsum = 1.f; }
            else attn_tile_causal(kb_, kb_ + 32768, qf, qblk, lane, o, m, lsum, wsf);
            VM_WAIT_KNOWN();
            RAW_BAR();
            int ln = lane; asm volatile("" : "+v"(ln));
            LAS unsigned char* stg = kb_ + wave * 4096;
            if ((ln >> 5) == 0) { wsf[32 + (ln & 31)] = m; wsf[64 + (ln & 31)] = lsum; }
            stage_o(stg, wsf, o, lsum, ln);
#pragma unroll
            for (int i = 0; i < 4; ++i) {
                const int row = i * 8 + (ln >> 3), ch = ln & 7;
                const size_t grow = row0 + qblk * 32 + row;
                const float mo = wsf[32 + row], lo_ = wsf[64 + row];
                const h16x8 ov = *(const LAS h16x8*)(stg + row * 128 + ch * 16);
                float mmax = mo;
#pragma unroll
                for (int r = 0; r < 3; ++r) { if (r < nsel) mmax = fmaxf(mmax, ml[i][r][0]); }
                float wo = lo_ * __builtin_amdgcn_exp2f(mo - mmax), L = wo;
                float acc[8];
#pragma unroll
                for (int e2 = 0; e2 < 8; ++e2) acc[e2] = wo * (float)ov[e2];
#pragma unroll
                for (int r = 0; r < 3; ++r) { if (r < nsel) { const float wr_ = ml[i][r][1] * __builtin_amdgcn_exp2f(ml[i][r][0] - mmax); L += wr_;
#pragma unroll
                    for (int e2 = 0; e2 < 8; ++e2) acc[e2] += wr_ * (float)pv[i][r][e2]; } }
                const float rL = 1.f / L; float q = 0.f; u32x4 w;
#pragma unroll
                for (int e2 = 0; e2 < 8; ++e2) { acc[e2] *= rL; q += acc[e2] * acc[e2]; }
                w[0] = pkh(acc[0], acc[1]); w[1] = pkh(acc[2], acc[3]); w[2] = pkh(acc[4], acc[5]); w[3] = pkh(acc[6], acc[7]);
                if (shadow && MK_GPROBE == 3) asm volatile("" :: "v"(w));
                else if (shadow) *(GAS u32x4*)((GAS h16*)(F0.ws + WS_HG) + grow * 512 + h * 64 + ch * 8) = w;
                else *(GAS u32x4*)(proj + ab_off(grow, h, ch * 8)) = w;
                q += __shfl_xor(q, 1); q += __shfl_xor(q, 2); q += __shfl_xor(q, 4);
                if (ch == 0) SSQA[grow * 8 + h] = q;
            }
            if (!has) break;
#pragma unroll
            for (int ks = 0; ks < 4; ++ks) qf[ks] = qn[ks];
            unit = un; par ^= 1;
        }
    }
    __syncthreads();
}


template <bool PART16, class Order> __device__ __forceinline__ void fill_rowscale(LAS float* tab, const Order& So, const GAS float* src, int maxu) {
    int nu = 0; { pg8::Unit uu; while (nu < maxu && So.next(nu, uu)) ++nu; }
    const int total = nu * 256;
    constexpr int NP = PART16 ? 16 : 1, EB = 3;
    for (int e0 = threadIdx.x; e0 < total; e0 += EB * NWAVES * 64) {
        float t[EB][NP];
#pragma unroll
        for (int q = 0; q < EB; ++q) {
            int e = e0 + q * NWAVES * 64; e = e < total ? e : e0;
            pg8::Unit uu; So.next(e >> 8, uu);
            const GAS float* p = src + uu.pm * 256 + (e & 255);
#pragma unroll
            for (int k = 0; k < NP; ++k) t[q][k] = p[(size_t)k * M];
        }
#pragma unroll
        for (int q = 0; q < EB; ++q) {
            const int e = e0 + q * NWAVES * 64;
            if (e < total) {
                if constexpr (PART16) {
                    const float a = ((t[q][0] + t[q][1]) + (t[q][2] + t[q][3])) + ((t[q][4] + t[q][5]) + (t[q][6] + t[q][7])), b = ((t[q][8] + t[q][9]) + (t[q][10] + t[q][11])) + ((t[q][12] + t[q][13]) + (t[q][14] + t[q][15]));
                    tab[e] = rsqrtf((a + b) * (1.f / D) + EPS);
                } else tab[e] = t[q][0];
            }
        }
    }
    __syncthreads();
}
constexpr int TAB_OFF = MISC_OFF + 128, TAB_MAXU = 15;
static_assert(TAB_OFF + TAB_MAXU * 1024 + 2048 <= LDS_BYTES, "row-scale table + rope delta table");
static_assert(TAB_OFF_B >= TAB_OFF && BL_STG + 8 * 2048 <= LDS_BYTES, "phase B tables sit above the barrier words");

enum Phase { PH_P0 = 0, PH_P1, PH_G1A, PH_G1B, PH_INPROJ, PH_MIX_A, PH_MIX_B, PH_MIX_C, PH_OUTPROJ, PH_G2A, PH_G2B, PH_FINAL, PH_COUNT };
__global__ void __launch_bounds__(NWAVES * 64, 2) mega_fwd(Args args) {
    extern __shared__ __attribute__((aligned(16))) unsigned char lds[];
    Frame F;
    F.lds = (LAS unsigned char*)lds; F.MISC = (volatile LAS unsigned*)(F.lds + MISC_OFF);
    F.tid = threadIdx.x; F.lane = F.tid & 63; F.wave = __builtin_amdgcn_readfirstlane(F.tid >> 6);
    F.G = gridDim.x; { const int bx = blockIdx.x; F.vcu = (F.G % 8 == 0) ? (bx % 8) * (F.G / 8) + bx / 8 : bx; }
    F.ws = args.ws; F.out = (GAS float*)args.out; F.ctl = (unsigned*)(args.ws + WS_CTL);
    for (int u = F.tid; u < (LDS_BYTES - LDSCTL_OFF) / 4; u += NWAVES * 64) ((LAS unsigned*)(F.lds + LDSCTL_OFF))[u] = 0u;
    __syncthreads();
    XcdBarrier bar; bar.bar = F.ctl + CW_BAR; bar.x = 0; bar.st = nullptr;
    const int lo = args.ph_lo, hi = args.ph_hi;
    if (hi - lo > 1) bar = xcd_barrier_post(F.ctl + CW_BAR, F.MISC + 8);
#ifndef MK_XBAR
#define MK_XBAR 0
#endif
#ifndef MK_PHASE_MASK
#define MK_PHASE_MASK 0xFFFF
#endif
#define IN(k) (((MK_PHASE_MASK >> (k)) & 1) && lo <= (k) && (k) < hi)
#define SEAM(k) do { if (IN(k) && IN((k) + 1)) xcd_barrier(bar); } while (0)
#define PHASE_PTRS() unsigned char* ws = args.ws; asm volatile("" : "+s"(ws)); const GAS float* GT = (const GAS float*)(ws + WS_GT); const GAS float* GP = (const GAS float*)(ws + WS_GP); (void)GT; (void)GP; F.ws = ws
    if (IN(PH_P0)) { PHASE_PTRS(); p0_prologue(F, args); SEAM(PH_P0); }
    if (IN(PH_P1)) { PHASE_PTRS(); p1_prep(F, args); SEAM(PH_P1);
#if MK_XBAR
        if (IN(PH_P1) && IN(PH_P1 + 1)) for (int i = 0; i < MK_XBAR; ++i) xcd_barrier(bar);
#endif
    }
    if (IN(PH_G1A)) {
        PHASE_PTRS();
        pg8::Gemm g{(const GAS h16*)(ws + WS_HG), (const GAS h16*)(ws + WS_WGU1), 0, NGU, D}; pg8::StaticOrder So; So.init(M, NGU, F.G, (int)blockIdx.x); const pg8::TableOrder To = pg8::make_table(So, (LAS int*)(F.lds + LDSCTL_OFF));
#if MK_SHADOW == 1
        if (args.ph_lo == PH_G1A && args.ph_hi == PH_G1A + 1 && args.shadow) { EpiNull En; pg8::gemm_phase<EpiNull, true, MK_GPROBE>(F.lds, g, So, En); return; }
#endif
        EpiSwiglu<true> E{(GAS h16*)(ws + WS_ACT), nullptr, nullptr};
        pg8::gemm_phase<EpiSwiglu<true>, true, 0, pg8::TableOrder>(F.lds, g, To, E); SEAM(PH_G1A);
    }
    if (IN(PH_G1B)) {
        PHASE_PTRS();
        pg8::Gemm g{(const GAS h16*)(ws + WS_ACT), (const GAS h16*)(ws + WS_WD1), 0, D, DFF, MK_STAG}; pg8::StaticOrder So; So.init(M, D, F.G, (int)blockIdx.x); const pg8::TableOrder To = pg8::make_table(So, (LAS int*)(F.lds + LDSCTL_OFF));
#if MK_SHADOW == 8
        if (args.ph_lo == PH_G1B && args.ph_hi == PH_G1B + 1 && args.shadow) {
#if MK_GPROBE == 0
            EpiNull En; pg8::gemm_phase<EpiNull, true>(F.lds, g, So, En);
#else
            EpiResid<true, false, true, MK_GPROBE> Ev{GIN(args, 0), (GAS h16*)(ws + WS_H), (GAS h16*)(ws + WS_HG), GT + 0 * 4 * D, GP + 1 * 4 * D, (GAS float*)(ws + WS_SSQ2), nullptr, 0.5f};
            pg8::gemm_phase<EpiResid<true, false, true, MK_GPROBE>, true>(F.lds, g, So, Ev);
#endif
            return; }
#endif
        EpiResid<true, false, false> E{GIN(args, 0), (GAS h16*)(ws + WS_H), nullptr, GT + 0 * 4 * D, nullptr, (GAS float*)(ws + WS_SSQ2), nullptr, 0.5f};
        pg8::gemm_phase<EpiResid<true, false, false>, true, 0, pg8::TableOrder>(F.lds, g, To, E); SEAM(PH_G1B);
    }
    if (IN(PH_INPROJ)) {
        PHASE_PTRS();
        pg8::Gemm g{(const GAS h16*)(ws + WS_H), (const GAS h16*)(ws + WS_WINB), 0, INW, D, 0u, (size_t)INW * D * 2}; pg8::StaticOrder So; So.init(M, INW, F.G, (int)blockIdx.x); const pg8::TableOrder To = pg8::make_table(So, (LAS int*)(F.lds + LDSCTL_OFF));
        { LAS float* dt = (LAS float*)(F.lds + TAB_OFF + TAB_MAXU * 1024); const int k = F.tid >> 6; dt[F.tid] = ((const GAS float*)(ws + WS_ROPE))[((k >> 2) * 128 + (k & 3) * 16) * 64 + (F.tid & 63)]; }
        fill_rowscale<true>((LAS float*)(F.lds + TAB_OFF), To, (const GAS float*)(ws + WS_SSQ2), TAB_MAXU);
#if MK_SHADOW == 9
        if (args.ph_lo == PH_INPROJ && args.ph_hi == PH_INPROJ + 1 && args.shadow) {
#if MK_GPROBE == 0
            EpiNull En; pg8::gemm_phase<EpiNull, true, 0, pg8::TableOrder>(F.lds, g, To, En);
#else
            EpiInproj<MK_GPROBE> Ev{(GAS h16*)(ws + WS_PROJ), (const LAS float*)(F.lds + TAB_OFF), (const GAS float*)(ws + WS_BIAS2), (const GAS float*)(ws + WS_ROPE), (GAS float*)(ws + WS_KMP), (const LAS float*)(F.lds + TAB_OFF + TAB_MAXU * 1024)};
            pg8::gemm_phase<EpiInproj<MK_GPROBE>, true, 0, pg8::TableOrder>(F.lds, g, To, Ev);
#endif
            return; }
#endif
        EpiInproj<> E{(GAS h16*)(ws + WS_PROJ), (const LAS float*)(F.lds + TAB_OFF), (const GAS float*)(ws + WS_BIAS2), (const GAS float*)(ws + WS_ROPE), (GAS float*)(ws + WS_KMP), (const LAS float*)(F.lds + TAB_OFF + TAB_MAXU * 1024)};
        pg8::gemm_phase<EpiInproj<>, true, 0, pg8::TableOrder>(F.lds, g, To, E); SEAM(PH_INPROJ);
    }
    if (IN(PH_MIX_A)) { PHASE_PTRS(); if (!(args.shadow & 2)) gmlp_phase(F, args, args.shadow & 1); if (!(args.shadow & 4)) moba_gate_phase(F, args.shadow & 1); SEAM(PH_MIX_A); }
    if (IN(PH_MIX_B)) { PHASE_PTRS(); moba_b_phase(F, (GAS float*)args.out); SEAM(PH_MIX_B); }
    if (IN(PH_MIX_C)) { PHASE_PTRS(); moba_c_phase(F, (const GAS float*)args.out, args.shadow & 1); SEAM(PH_MIX_C); }
    if (IN(PH_OUTPROJ)) {
        PHASE_PTRS();
        pg8::Gemm g{(const GAS h16*)(ws + WS_AB), (const GAS h16*)(ws + WS_WOUT), 0, D, D}; pg8::StaticOrder So; So.init(M, D, F.G, (int)blockIdx.x); const pg8::TableOrder To = pg8::make_table(So, (LAS int*)(F.lds + LDSCTL_OFF));
        const LAS float* sct = (const LAS float*)(F.lds + MISC_OFF + 128);
        {   LAS float* t = (LAS float*)(F.lds + MISC_OFF + 128); const GAS float* ssqa = (const GAS float*)(ws + WS_SSQA); const GAS float* ssqg = (const GAS float*)(ws + WS_RG);
            pg8::Unit uu;
            for (int i = 0; i < 4 && To.next(i, uu); ++i)
                if (F.tid < 256) { const int row = uu.pm * 256 + F.tid; const f32x4 a = *(const GAS f32x4*)(ssqa + (size_t)row * 8), bq = *(const GAS f32x4*)(ssqa + (size_t)row * 8 + 4);
                    const float ra = rsqrtf((((a[0] + a[1]) + (a[2] + a[3])) + ((bq[0] + bq[1]) + (bq[2] + bq[3]))) * (1.f / 512.f) + EPS), rg = rsqrtf(ssqg[row] * (1.f / 512.f) + EPS);
                    t[i * 512 + F.tid] = ra / rg; t[i * 512 + 256 + F.tid] = rg; }
            __syncthreads(); }
        EpiOutX E{(GAS h16*)(ws + WS_H), (GAS h16*)(ws + WS_HG), GT + 1 * 4 * D, GP + 2 * 4 * D, (const GAS float*)(ws + WS_SH) + 2 * 4 * D, (unsigned*)(ws + WS_SSQ3), F.ctl + CW_PAN2, F.ctl + CW_TMO, sct,
                  (LAS float*)(F.lds + MISC_OFF + 128 + 8192), (LAS float*)(F.lds + MISC_OFF + 128 + 8192 + 4096), 1.0f};
        pg8::gemm_phase<EpiOutX, true, 0, pg8::TableOrder>(F.lds, g, To, E); SEAM(PH_OUTPROJ);
    }
    if (IN(PH_G2A)) {
        PHASE_PTRS();
        pg8::Gemm g{(const GAS h16*)(ws + WS_HG), (const GAS h16*)(ws + WS_WGU2), 0, NGU, D}; pg8::StaticOrder So; So.init(M, NGU, F.G, (int)blockIdx.x); const pg8::TableOrder To = pg8::make_table(So, (LAS int*)(F.lds + LDSCTL_OFF));
        EpiSwiglu<true> E{(GAS h16*)(ws + WS_ACT), nullptr, nullptr};
        pg8::gemm_phase<EpiSwiglu<true>, true, 0, pg8::TableOrder>(F.lds, g, To, E); SEAM(PH_G2A);
    }
    if (IN(PH_G2B)) {
        PHASE_PTRS();
        pg8::Gemm g{(const GAS h16*)(ws + WS_ACT), (const GAS h16*)(ws + WS_WD2), 0, D, DFF}; pg8::StaticOrder So; So.init(M, D, F.G, (int)blockIdx.x); const pg8::TableOrder To = pg8::make_table(So, (LAS int*)(F.lds + LDSCTL_OFF));
#if MK_FUSE_FINAL
        EpiFinal E{(const GAS h16*)(ws + WS_H), GT + 2 * 4 * D, GIN(args, 19), (GAS float*)args.out, (unsigned*)(ws + WS_SSQF), F.ctl + CW_PAN, F.ctl + CW_TMO,
                   (LAS float*)(F.lds + MISC_OFF + 128), (LAS float*)(F.lds + MISC_OFF + 128 + 4096), 0.5f};
        pg8::gemm_phase<EpiFinal, true, 0, pg8::TableOrder>(F.lds, g, To, E);
#else
        EpiResid<false, false, false> E{nullptr, (GAS h16*)(ws + WS_H), nullptr, GT + 2 * 4 * D, nullptr, (GAS float*)(ws + WS_SSQF), nullptr, 0.5f};
        pg8::gemm_phase<EpiResid<false, false, false>, true, 0, pg8::TableOrder>(F.lds, g, To, E); SEAM(PH_G2B);
#endif
    }
#if !MK_FUSE_FINAL
    if (IN(PH_FINAL)) { PHASE_PTRS(); p_final(F, args); }
#endif
#undef IN
#undef SEAM
}

extern "C" void kernel_launch(void* const* d_in, const int* in_sizes, int n_in, void* d_out, int out_size, void* d_ws, size_t ws_size, hipStream_t stream) {
    static int grid = 0;
    if (grid == 0) {
        if (n_in != 20 || out_size != M * D || ws_size < WS_END) { fprintf(stderr, "kernel_launch: unexpected shapes (n_in %d out %d ws %zu)\n", n_in, out_size, ws_size); grid = -1; return; }
        int dev = 0, cus = 0, per_cu = 0;
        hipGetDevice(&dev); hipDeviceGetAttribute(&cus, hipDeviceAttributeMultiprocessorCount, dev);
        if (hipFuncSetAttribute((const void*)mega_fwd, hipFuncAttributeMaxDynamicSharedMemorySize, LDS_BYTES) != hipSuccess) { fprintf(stderr, "kernel_launch: hipFuncSetAttribute failed\n"); grid = -1; return; }
        hipOccupancyMaxActiveBlocksPerMultiprocessor(&per_cu, (const void*)mega_fwd, NWAVES * 64, LDS_BYTES);
        (void)hipGetLastError();
        if (per_cu < 1) { fprintf(stderr, "kernel_launch: occupancy query says %d blocks/CU; nothing launched\n", per_cu); grid = -1; return; }
        if (cus != 256) { fprintf(stderr, "kernel_launch: this build is laid out for 256 CUs (found %d); nothing launched\n", cus); grid = -1; return; }
        grid = cus;
    }
    if (grid < 0) return;
    hipMemsetAsync((char*)d_ws + WS_CTL, 0, CTL_ZERO_BYTES, stream);
    Args a{};
    for (int i = 0; i < 20; ++i) a.in[i] = (const float*)d_in[i];
    a.out = (float*)d_out; a.ws = (unsigned char*)d_ws;
    unsigned char* ws = (unsigned char*)d_ws;
    auto run = [&](int lo, int hi) {
#if MK_PER_PHASE
        for (int p = lo; p < hi; ++p) {
            if (MK_SHADOW == 2 && p == PH_MIX_A) { a.ph_lo = p; a.ph_hi = p + 1; a.shadow = 1 | 4; hipLaunchKernelGGL(mega_fwd, dim3(grid), dim3(NWAVES * 64), LDS_BYTES, stream, a); a.shadow = 0; }
            if (MK_SHADOW == 10 && p == PH_MIX_A) { a.ph_lo = p; a.ph_hi = p + 1; a.shadow = 1 | 2 | 4; hipLaunchKernelGGL(mega_fwd, dim3(grid), dim3(NWAVES * 64), LDS_BYTES, stream, a); a.shadow = 0; }
            if (MK_SHADOW == 3 && p == PH_MIX_A) { a.ph_lo = p; a.ph_hi = p + 1; a.shadow = 1 | 2; hipLaunchKernelGGL(mega_fwd, dim3(grid), dim3(NWAVES * 64), LDS_BYTES, stream, a); a.shadow = 0; }
            if (MK_SHADOW == 4 && p == PH_MIX_C) { a.ph_lo = p; a.ph_hi = p + 1; a.shadow = 1; hipLaunchKernelGGL(mega_fwd, dim3(grid), dim3(NWAVES * 64), LDS_BYTES, stream, a); a.shadow = 0; }
            if (MK_SHADOW == 9 && p == PH_INPROJ) { a.ph_lo = p; a.ph_hi = p + 1; a.shadow = 1; hipLaunchKernelGGL(mega_fwd, dim3(grid), dim3(NWAVES * 64), LDS_BYTES, stream, a); a.shadow = 0; }
            if (MK_SHADOW == 8 && p == PH_G1B) { a.ph_lo = p; a.ph_hi = p + 1; a.shadow = 1; hipLaunchKernelGGL(mega_fwd, dim3(grid), dim3(NWAVES * 64), LDS_BYTES, stream, a); a.shadow = 0; }
            if (MK_SHADOW == 1 && p == PH_G1A) { a.ph_lo = p; a.ph_hi = p + 1; a.shadow = 1; hipLaunchKernelGGL(mega_fwd, dim3(grid), dim3(NWAVES * 64), LDS_BYTES, stream, a); a.shadow = 0; }
            for (int rep = 0; rep < ((((MK_DUP_MASK) >> p) & 1) ? 2 : 1); ++rep) { a.ph_lo = p; a.ph_hi = p + 1; hipLaunchKernelGGL(mega_fwd, dim3(grid), dim3(NWAVES * 64), LDS_BYTES, stream, a); }
        }
#else
        a.ph_lo = lo; a.ph_hi = hi;
        void* kargs[] = {(void*)&a};
        hipError_t e = hipLaunchCooperativeKernel((const void*)mega_fwd, dim3(grid), dim3(NWAVES * 64), kargs, LDS_BYTES, stream);
        if (e != hipSuccess) fprintf(stderr, "kernel_launch: cooperative launch failed: %s (grid %d)\n", hipGetErrorString(e), grid);
#endif
    };
    run(PH_P0, PH_COUNT);
}
```
